# Optimizing an MI355X kernel written in HIP

```python
import math
import jax, jax.numpy as jnp
from jax import lax
import numpy as np

D_MODEL = 1024
BATCH = 32
SEQ = 2048
DEPTH = 1

N_MEM = 256
RMS_EPS = 1e-6
POOL_WINDOWS = (2, 4, 8, 16)
POOL_WIDTH = D_MODEL // 4
POOL_GROUP = POOL_WIDTH // len(POOL_WINDOWS)
DA_HEADS = 4
DA_HEAD_DIM = 64
DA_V_DIM = 2 * DA_HEAD_DIM
DA_QK_WIDTH = DA_HEADS * 2 * DA_HEAD_DIM
DA_WIDTH = DA_HEADS * DA_V_DIM
Q_BLOCK = 128
MEM_HEADS = 4
MEM_HEAD_DIM = 64
MEM_WIDTH = MEM_HEADS * MEM_HEAD_DIM
N_BRANCH = 3
SPLIT_IDX = [POOL_WIDTH,
             POOL_WIDTH + DA_QK_WIDTH,
             POOL_WIDTH + 2 * DA_QK_WIDTH,
             POOL_WIDTH + 2 * DA_QK_WIDTH + DA_WIDTH,
             POOL_WIDTH + 2 * DA_QK_WIDTH + DA_WIDTH + MEM_WIDTH]
IN_COLS = SPLIT_IDX[-1] + N_BRANCH * D_MODEL
N_GROUPS = 4
EXPERTS_PER_GROUP = 4
N_EXPERTS = N_GROUPS * EXPERTS_PER_GROUP
TOP_K_INNER = 2
EXPERT_HIDDEN = D_MODEL // 2
MOE_BLOCK = 512

kernel_name = "hybrid_pool_diffattn_mem_hmoe"


def rmsnorm(x, g):
    xf = x.astype(jnp.float32)
    r = lax.rsqrt(jnp.mean(xf * xf, axis=-1, keepdims=True) + RMS_EPS)
    return (xf * r).astype(x.dtype) * g


def pool_mixer(u, w_group, scale):
    b, s, _ = u.shape
    ug = u.reshape(b, s, len(POOL_WINDOWS), POOL_GROUP).astype(jnp.float32)
    c = jnp.pad(jnp.cumsum(ug, axis=1), ((0, 0), (1, 0), (0, 0), (0, 0)))
    t = jnp.arange(s)
    means = []
    for gi, w in enumerate(POOL_WINDOWS):
        lo = jnp.maximum(t + 1 - w, 0)
        cnt = (t + 1 - lo).astype(jnp.float32)
        win_sum = c[:, 1:, gi] - c[:, lo, gi]
        means.append(win_sum / cnt[None, :, None])
    pooled = (jnp.stack(means, axis=2) - ug).astype(u.dtype)
    mixed = jnp.einsum('bsgc,gcd->bsgd', pooled, w_group)
    return mixed.reshape(b, s, POOL_WIDTH) * scale


def diff_attention(q, k, v, lam, subln_g, lambda_init):
    b, s = q.shape[0], q.shape[1]
    nb = s // Q_BLOCK
    scale = DA_HEAD_DIM ** -0.5
    qb = q.reshape(b, nb, Q_BLOCK, DA_HEADS, 2, DA_HEAD_DIM).transpose(1, 0, 2, 3, 4, 5)
    k_pos = jnp.arange(s)

    def one_block(args):
        q_blk, i = args
        scores = jnp.einsum('bqhmd,bkhmd->bhmqk', q_blk, k).astype(jnp.float32) * scale
        q_pos = i * Q_BLOCK + jnp.arange(Q_BLOCK)
        causal = k_pos[None, :] <= q_pos[:, None]
        scores = jnp.where(causal, scores, -jnp.inf)
        p = jax.nn.softmax(scores, axis=-1)
        a = p[:, :, 0] - lam * p[:, :, 1]
        return jnp.einsum('bhqk,bkhv->bqhv', a.astype(v.dtype), v)

    o = lax.map(one_block, (qb, jnp.arange(nb)))
    o = o.transpose(1, 0, 2, 3, 4).reshape(b, s, DA_HEADS, DA_V_DIM)
    o = rmsnorm(o, subln_g) * (1.0 - lambda_init)
    return o.reshape(b, s, DA_WIDTH)


def memory_attention(q, mem_n, w_kv):
    b, m, _ = mem_n.shape
    kv = mem_n @ w_kv
    mk = kv[..., :MEM_WIDTH].reshape(b, m, MEM_HEADS, MEM_HEAD_DIM)
    mv = kv[..., MEM_WIDTH:].reshape(b, m, MEM_HEADS, MEM_HEAD_DIM)
    scores = jnp.einsum('bshd,bmhd->bhsm', q, mk).astype(jnp.float32) * (MEM_HEAD_DIM ** -0.5)
    p = jax.nn.softmax(scores, axis=-1)
    o = jnp.einsum('bhsm,bmhd->bshd', p.astype(mv.dtype), mv)
    return o.reshape(q.shape[0], q.shape[1], MEM_WIDTH)


def hier_moe(h, w_rg, b_rg, w_re, b_re, w_gate, w_up, w_down):
    b, s, d = h.shape
    t = h.reshape(-1, d)
    n_tok = t.shape[0]
    g_prob = jax.nn.softmax((t @ w_rg).astype(jnp.float32) + b_rg, axis=-1)
    g_p, g_idx = lax.top_k(g_prob, 1)
    e_logits = jnp.einsum('td,dge->tge', t, w_re).astype(jnp.float32) + b_re
    e_sel = jnp.take_along_axis(e_logits, g_idx[:, :, None], axis=1)[:, 0]
    e_p, e_idx = lax.top_k(jax.nn.softmax(e_sel, axis=-1), TOP_K_INNER)
    weights = g_p * (e_p / jnp.sum(e_p, axis=-1, keepdims=True))
    expert_id = g_idx * EXPERTS_PER_GROUP + e_idx

    flat_e = expert_id.reshape(-1)
    flat_w = weights.reshape(-1)
    flat_tok = jnp.repeat(jnp.arange(n_tok), TOP_K_INNER)
    n_assign = flat_e.shape[0]
    order = jnp.argsort(flat_e)
    se, stok, sw = flat_e[order], flat_tok[order], flat_w[order]
    counts = jnp.zeros((N_EXPERTS,), jnp.int32).at[flat_e].add(1)
    padded = ((counts + MOE_BLOCK - 1) // MOE_BLOCK) * MOE_BLOCK
    start = jnp.cumsum(counts) - counts
    pend = jnp.cumsum(padded)
    pstart = pend - padded
    dest = pstart[se] + jnp.arange(n_assign) - start[se]
    n_blocks = -(-n_assign // MOE_BLOCK) + N_EXPERTS
    n_rows = n_blocks * MOE_BLOCK
    rows = jnp.zeros((n_rows, d), t.dtype).at[dest].set(t[stok])
    block_start = jnp.arange(n_blocks) * MOE_BLOCK
    block_expert = jnp.minimum(jnp.searchsorted(pend, block_start, side='right'), N_EXPERTS - 1)

    def expert_block(args):
        xb, e = args
        hid = jax.nn.silu(xb @ w_gate[e]) * (xb @ w_up[e])
        return hid @ w_down[e]

    y_rows = lax.map(expert_block, (rows.reshape(n_blocks, MOE_BLOCK, d), block_expert)).reshape(n_rows, d)
    contrib = (y_rows[dest] * sw[:, None]).astype(t.dtype)
    out = jnp.zeros((n_tok, d), t.dtype).at[stok].add(contrib)
    return out.reshape(b, s, d)


def setup_inputs(seed: int = 0) -> dict:
    key = jax.random.key(seed)
    ks = jax.random.split(key, 32)
    f32 = jnp.float32
    D, L = D_MODEL, DEPTH

    def nrm(k, shape, fan_in):
        return jax.random.normal(k, shape, f32) * (fan_in ** -0.5)

    def gain(k, shape):
        return 1.0 + 0.02 * jax.random.normal(k, shape, f32)

    return {
        "x": jax.random.normal(ks[0], (BATCH, SEQ, D), f32),
        "mem": jax.random.normal(ks[1], (BATCH, N_MEM, D), f32),
        "norm_mix_g": gain(ks[2], (L, D)),
        "w_in": nrm(ks[3], (L, D, IN_COLS), D),
        "pool_w": nrm(ks[4], (L, len(POOL_WINDOWS), POOL_GROUP, POOL_GROUP), POOL_GROUP),
        "pool_scale": gain(ks[5], (L, POOL_WIDTH)),
        "lam_q1": 0.1 * jax.random.normal(ks[6], (L, DA_HEAD_DIM), f32),
        "lam_k1": 0.1 * jax.random.normal(ks[7], (L, DA_HEAD_DIM), f32),
        "lam_q2": 0.1 * jax.random.normal(ks[8], (L, DA_HEAD_DIM), f32),
        "lam_k2": 0.1 * jax.random.normal(ks[9], (L, DA_HEAD_DIM), f32),
        "subln_g": gain(ks[10], (L, DA_V_DIM)),
        "norm_mem_g": gain(ks[11], (L, D)),
        "w_mem_kv": nrm(ks[12], (L, D, 2 * MEM_WIDTH), D),
        "p_pool": nrm(ks[13], (L, POOL_WIDTH, D), POOL_WIDTH),
        "p_diff": nrm(ks[14], (L, DA_WIDTH, D), DA_WIDTH),
        "p_mem": nrm(ks[15], (L, MEM_WIDTH, D), MEM_WIDTH),
        "w_o": nrm(ks[16], (L, D, D), D),
        "norm_ffn_g": gain(ks[17], (L, D)),
        "w_router_group": nrm(ks[18], (L, D, N_GROUPS), D),
        "b_router_group": 0.01 * jax.random.normal(ks[19], (L, N_GROUPS), f32),
        "w_router_expert": nrm(ks[20], (L, D, N_GROUPS, EXPERTS_PER_GROUP), D),
        "b_router_expert": 0.01 * jax.random.normal(ks[21], (L, N_GROUPS, EXPERTS_PER_GROUP), f32),
        "w_expert_gate": nrm(ks[22], (L, N_EXPERTS, D, EXPERT_HIDDEN), D),
        "w_expert_up": nrm(ks[23], (L, N_EXPERTS, D, EXPERT_HIDDEN), D),
        "w_expert_down": nrm(ks[24], (L, N_EXPERTS, EXPERT_HIDDEN, D), EXPERT_HIDDEN),
        "final_g": gain(ks[25], (D,)),
    }


def reference(x, mem, norm_mix_g, w_in, pool_w, pool_scale, lam_q1, lam_k1, lam_q2, lam_k2,
              subln_g, norm_mem_g, w_mem_kv, p_pool, p_diff, p_mem, w_o, norm_ffn_g,
              w_router_group, b_router_group, w_router_expert, b_router_expert,
              w_expert_gate, w_expert_up, w_expert_down, final_g):
    b, s, d = x.shape
    for l in range(DEPTH):
        lambda_init = 0.8 - 0.6 * math.exp(-0.3 * l)
        h = rmsnorm(x, norm_mix_g[l])
        proj = h @ w_in[l]
        u_pool, dq, dk, dv, mq, gates = jnp.split(proj, SPLIT_IDX, axis=-1)
        gates = jax.nn.sigmoid(gates.reshape(b, s, N_BRANCH, d))

        pool_out = pool_mixer(u_pool, pool_w[l], pool_scale[l])

        lam = (jnp.exp(jnp.sum(lam_q1[l] * lam_k1[l]).astype(jnp.float32))
               - jnp.exp(jnp.sum(lam_q2[l] * lam_k2[l]).astype(jnp.float32)) + lambda_init)
        diff_out = diff_attention(dq.reshape(b, s, DA_HEADS, 2, DA_HEAD_DIM),
                                  dk.reshape(b, s, DA_HEADS, 2, DA_HEAD_DIM),
                                  dv.reshape(b, s, DA_HEADS, DA_V_DIM),
                                  lam, subln_g[l], lambda_init)

        mem_n = rmsnorm(mem, norm_mem_g[l])
        mem_out = memory_attention(mq.reshape(b, s, MEM_HEADS, MEM_HEAD_DIM), mem_n, w_mem_kv[l])

        merged = (gates[:, :, 0] * (pool_out @ p_pool[l])
                  + gates[:, :, 1] * (diff_out @ p_diff[l])
                  + gates[:, :, 2] * (mem_out @ p_mem[l]))
        x = x + merged @ w_o[l]
        x = x + hier_moe(rmsnorm(x, norm_ffn_g[l]), w_router_group[l], b_router_group[l],
                         w_router_expert[l], b_router_expert[l],
                         w_expert_gate[l], w_expert_up[l], w_expert_down[l])
    return rmsnorm(x, final_g)
```

```cpp
#include <hip/hip_runtime.h>
#include <hip/hip_cooperative_groups.h>
#include <cstdio>
#include <cstdint>
namespace cg = cooperative_groups;
namespace pg8 {
#define PG8_LAS __attribute__((address_space(3)))
typedef unsigned short bf16_t;
typedef short bf16x8 __attribute__((ext_vector_type(8)));
typedef float f32x4 __attribute__((ext_vector_type(4)));
typedef unsigned u32x4 __attribute__((ext_vector_type(4)));
constexpr int BM = 256, BK = 64, HALF = 128, HTB = HALF * BK * 2  , STAGE_BYTES = 8 * HTB, NXCD = 8, WGM = 8;

__host__ __device__ __forceinline__ int lds_byte(int r, int c) { const int st = (r >> 4) * 2 + (c >> 5), rr = r & 15, cc = c & 31, ob = rr * 64 + cc * 2; return st * 1024 + (ob ^ (((ob >> 9) & 1) << 5)); }
__host__ __device__ __forceinline__ void stage_rc(int b, int& R, int& C) { const int st = b / 1024, sb = b % 1024, swz = sb ^ (((sb >> 9) & 1) << 5); R = (st >> 1) * 16 + swz / 64; C = (st & 1) * 32 + (swz % 64) / 2; }
__host__ __device__ __forceinline__ int perm32(int rho) { const int n = rho >> 4, i = rho & 15; return 8 * (i >> 2) + 4 * n + (i & 3); }

struct Unit { int pm, pn; };
struct Gemm { const bf16_t* A; const bf16_t* Bt; int M, N, K; };

struct StaticOrder {
    int nM, nN, nwg, G, c;
    __host__ __device__ void init(int M, int N, int G_, int c_) { nM = M / BM; nN = N / BM; nwg = nM * nN; G = G_; c = c_; }
    __host__ __device__ bool next(int i, Unit& u) const {
        const long L = (long)i * G + c; if (L >= nwg) return false;
        int wgid = (int)L; { const int q = nwg / NXCD, r = nwg % NXCD, xcd = wgid % NXCD, off = wgid / NXCD; wgid = (xcd < r ? xcd * (q + 1) : r * (q + 1) + (xcd - r) * q) + off; }
        const int nig = WGM * nN, gid = wgid / nig, fm = gid * WGM, gsz = (nM - fm) < WGM ? (nM - fm) : WGM;
        u.pm = fm + ((wgid % nig) % gsz); u.pn = (wgid % nig) / gsz; return true;
    }
    __device__ __forceinline__ void a_ready(const Unit&) const {}
    __device__ __forceinline__ void done(const Unit&) const {}
};

__device__ __forceinline__ unsigned cvt_pk_bf16(float lo, float hi) { unsigned r; asm volatile("v_cvt_pk_bf16_f32 %0, %1, %2" : "=v"(r) : "v"(lo), "v"(hi)); return r; }
typedef unsigned u32x2 __attribute__((ext_vector_type(2)));
__device__ __forceinline__ float bf_lo(unsigned w) { return __uint_as_float(w << 16); }
__device__ __forceinline__ float bf_hi(unsigned w) { return __uint_as_float(w & 0xffff0000u); }
__device__ __forceinline__ float sigmoid_f(float x) { return __builtin_amdgcn_rcpf(1.0f + __builtin_amdgcn_exp2f(-1.4426950408889634f * x)); }
__device__ __forceinline__ u32x4 pack8(const f32x4 a, const f32x4 b) { u32x4 w; w.x = cvt_pk_bf16(a[0], a[1]); w.y = cvt_pk_bf16(a[2], a[3]); w.z = cvt_pk_bf16(b[0], b[1]); w.w = cvt_pk_bf16(b[2], b[3]); return w; }

struct ProjOrder {
    StaticOrder so;
    __device__ __forceinline__ bool next(int i, Unit& u) const {
        const long L = (long)i * so.G + so.c;
        if (L < so.nwg) return so.next(i, u);
        const int x = (int)(L - so.nwg); if (x >= 64) return false;
        u.pm = 256 + (x >> 1); u.pn = 20 + (x & 1); return true;
    }
    __device__ __forceinline__ void a_ready(const Unit&) const {}
    __device__ __forceinline__ void done(const Unit&) const {}
};
struct MoeOrder {
    const PG8_LAS unsigned char* t2e; int nunits, G, c;
    __device__ __forceinline__ bool next(int i, Unit& u) const {
        const int L = i * G + c; if (L >= nunits) return false;
        const int pm = L >> 2; u.pm = pm; u.pn = (int)t2e[pm] * 4 + (L & 3); return true;
    }
    __device__ __forceinline__ void a_ready(const Unit&) const {}
    __device__ __forceinline__ void done(const Unit&) const {}
};

struct EpiProj {
    static constexpr bool PERM = true, AFTER_DRAIN = false;
    bf16_t* PROJ; bf16_t* GATES; bf16_t* KV; float qscale;
    __device__ __forceinline__ void operator()(const f32x4 (&acc)[2][2][4][2], const Unit& u, int wr, int wc, int fr, int fq) const {
        bf16_t* base; int ldc, colt, mode = 0; float sc = 1.f; int rowt = u.pm * BM;
        if (u.pm >= 256) { base = KV; ldc = 512; colt = (u.pn - 20) * BM; rowt -= 65536; }
        else if (u.pn < 8) { base = PROJ; ldc = 2048; colt = u.pn * BM; if (u.pn == 1 || u.pn == 2 || u.pn == 7) sc = qscale; }
        else { base = GATES; ldc = 3072; colt = (u.pn - 8) * BM; mode = 1; }
        const int row0 = rowt + wr * 64 + fr, col0 = colt + wc * 32 + 8 * fq;
#pragma unroll
        for (int ai = 0; ai < 2; ++ai)
#pragma unroll
            for (int m = 0; m < 4; ++m) { bf16_t* rowp = base + (size_t)(row0 + ai * HALF + m * 16) * ldc + col0;
#pragma unroll
                for (int bj = 0; bj < 2; ++bj) { f32x4 v0 = acc[ai][bj][m][0], v1 = acc[ai][bj][m][1];
                    if (mode) {
#pragma unroll
                        for (int i = 0; i < 4; ++i) { v0[i] = sigmoid_f(v0[i]); v1[i] = sigmoid_f(v1[i]); } }
                    else { v0 = v0 * sc; v1 = v1 * sc; }
                    *(u32x4*)(rowp + bj * HALF) = pack8(v0, v1); } }
    }
};
template <int FIRST> struct EpiGate {
    static constexpr bool PERM = true, AFTER_DRAIN = false;
    const bf16_t* GATES; int goff; bf16_t* MERGED;
    __device__ __forceinline__ void operator()(const f32x4 (&acc)[2][2][4][2], const Unit& u, int wr, int wc, int fr, int fq) const {
        const int row0 = u.pm * BM + wr * 64 + fr, col0 = u.pn * BM + wc * 32 + 8 * fq;
#pragma unroll
        for (int ai = 0; ai < 2; ++ai)
#pragma unroll
            for (int m = 0; m < 4; ++m) { const size_t r = (size_t)(row0 + ai * HALF + m * 16);
#pragma unroll
                for (int bj = 0; bj < 2; ++bj) { const int c = col0 + bj * HALF;
                    const u32x4 g = *(const u32x4*)(GATES + r * 3072 + goff + c);
                    f32x4 v0 = acc[ai][bj][m][0], v1 = acc[ai][bj][m][1];
                    v0[0] *= bf_lo(g.x); v0[1] *= bf_hi(g.x); v0[2] *= bf_lo(g.y); v0[3] *= bf_hi(g.y);
                    v1[0] *= bf_lo(g.z); v1[1] *= bf_hi(g.z); v1[2] *= bf_lo(g.w); v1[3] *= bf_hi(g.w);
                    if (!FIRST) { const u32x4 p = *(const u32x4*)(MERGED + r * 1024 + c);
                        v0[0] += bf_lo(p.x); v0[1] += bf_hi(p.x); v0[2] += bf_lo(p.y); v0[3] += bf_hi(p.y);
                        v1[0] += bf_lo(p.z); v1[1] += bf_hi(p.z); v1[2] += bf_lo(p.w); v1[3] += bf_hi(p.w); }
                    *(u32x4*)(MERGED + r * 1024 + c) = pack8(v0, v1); asm volatile("" ::: "memory"); } }
    }
};
struct EpiWo {
    static constexpr bool PERM = false, AFTER_DRAIN = false;
    const float* X; float* X1;
    __device__ __forceinline__ void operator()(const f32x4 (&acc)[2][2][4][2], const Unit& u, int wr, int wc, int fr, int fq) const {
        const int row0 = u.pm * BM + wr * 64 + fr, col0 = u.pn * BM + wc * 32 + 4 * fq;
#pragma unroll
        for (int ai = 0; ai < 2; ++ai)
#pragma unroll
            for (int m = 0; m < 4; ++m) { const size_t off = (size_t)(row0 + ai * HALF + m * 16) * 1024 + col0;
#pragma unroll
                for (int bj = 0; bj < 2; ++bj)
#pragma unroll
                    for (int n = 0; n < 2; ++n) { const size_t o = off + bj * HALF + n * 16; *(f32x4*)(X1 + o) = *(const f32x4*)(X + o) + acc[ai][bj][m][n]; } }
    }
};
struct EpiGateUp {
    static constexpr bool PERM = true, AFTER_DRAIN = false;
    bf16_t* HID; const float* WROW;
    __device__ __forceinline__ void operator()(const f32x4 (&acc)[2][2][4][2], const Unit& u, int wr, int wc, int fr, int fq) const {
        const int row0 = u.pm * BM + wr * 64 + fr, colh = (u.pn & 3) * 128 + wc * 32 + 8 * fq;
#pragma unroll
        for (int ai = 0; ai < 2; ++ai)
#pragma unroll
            for (int m = 0; m < 4; ++m) { const size_t r = (size_t)(row0 + ai * HALF + m * 16); const float w = WROW[r];
                f32x4 h0, h1;
#pragma unroll
                for (int i = 0; i < 4; ++i) { const float g0 = acc[ai][0][m][0][i], g1 = acc[ai][0][m][1][i];
                    h0[i] = g0 * sigmoid_f(g0) * acc[ai][1][m][0][i] * w; h1[i] = g1 * sigmoid_f(g1) * acc[ai][1][m][1][i] * w; }
                *(u32x4*)(HID + r * 512 + colh) = pack8(h0, h1); }
    }
};
struct EpiDown {
    static constexpr bool PERM = true, AFTER_DRAIN = false;
    bf16_t* Y;
    __device__ __forceinline__ void operator()(const f32x4 (&acc)[2][2][4][2], const Unit& u, int wr, int wc, int fr, int fq) const {
        const int row0 = u.pm * BM + wr * 64 + fr, col0 = (u.pn & 3) * BM + wc * 32 + 8 * fq;
#pragma unroll
        for (int ai = 0; ai < 2; ++ai)
#pragma unroll
            for (int m = 0; m < 4; ++m) { bf16_t* rowp = Y + (size_t)(row0 + ai * HALF + m * 16) * 1024 + col0;
#pragma unroll
                for (int bj = 0; bj < 2; ++bj) *(u32x4*)(rowp + bj * HALF) = pack8(acc[ai][bj][m][0], acc[ai][bj][m][1]); }
    }
};

template <class Epi, class Sched, bool ALIGN_EPI = false, bool SP2 = false>
__device__ __forceinline__ void gemm_phase(PG8_LAS unsigned char* lds, const Gemm g, const Sched& S, const Epi& E) {
    int tid_ = threadIdx.x; asm volatile("" : "+v"(tid_));
    const int tid = tid_, wid = __builtin_amdgcn_readfirstlane(tid >> 6), lane = tid & 63, wr = wid >> 2, wc = wid & 3, fr = lane & 15, fq = lane >> 4;
    const int K = g.K, nt = K / BK;
    unsigned voffA[2], voffB[2];
#pragma unroll
    for (int i = 0; i < 2; ++i) { int R, C; stage_rc(tid * 16 + i * 8192, R, C); const int Rb = Epi::PERM ? ((R & ~31) + perm32(R & 31)) : R;
        voffA[i] = (unsigned)(R * K + C) * 2u; voffB[i] = (unsigned)(Rb * K + C) * 2u; }
    const size_t kstep = (size_t)(BK * 2);
    const size_t hstep = (size_t)HALF * K * 2;
    const size_t tstep = 2 * hstep;
    const unsigned ldsw = (unsigned)wid * 1024u;
    const int aoff = lds_byte(wr * 64 + fr, fq * 8), boff = lds_byte(wc * 32 + fr, fq * 8);
#define PG8_SA(b, h) (((b) * 2 + (h)) * HTB)
#define PG8_SB(b, h) ((4 + (b) * 2 + (h)) * HTB)
#define PG8_STAGE(bufoff, gbase, voff) do { _Pragma("unroll") for (int _i = 0; _i < 2; ++_i) \
        __builtin_amdgcn_global_load_lds((const unsigned*)((const char*)(gbase) + (voff)[_i]), (PG8_LAS unsigned*)(lds + (bufoff) + ldsw + _i * 8192), 16, 0, 0); } while (0)
#define PG8_LDA(dst, b, h) do { _Pragma("unroll") for (int m = 0; m < 4; ++m) _Pragma("unroll") for (int k = 0; k < 2; ++k) dst[m][k] = *(const PG8_LAS bf16x8*)(lds + PG8_SA(b, h) + aoff + m * 2048 + k * 1024); } while (0)
#define PG8_LDB(dst, b, h) do { _Pragma("unroll") for (int n = 0; n < 2; ++n) _Pragma("unroll") for (int k = 0; k < 2; ++k) dst[n][k] = *(const PG8_LAS bf16x8*)(lds + PG8_SB(b, h) + boff + n * 2048 + k * 1024); } while (0)
#define PG8_MMA(ai, bj, At, Bt) do { __builtin_amdgcn_s_setprio(1); _Pragma("unroll") for (int m = 0; m < 4; ++m) _Pragma("unroll") for (int n = 0; n < 2; ++n) _Pragma("unroll") for (int k = 0; k < 2; ++k) \
        acc[ai][bj][m][n] = __builtin_amdgcn_mfma_f32_16x16x32_bf16(Bt[n][k], At[m][k], acc[ai][bj][m][n], 0, 0, 0); __builtin_amdgcn_s_setprio(0); } while (0)
#define PG8_WAIT_V(n) asm volatile("s_waitcnt vmcnt(" #n ")" ::: "memory")
#define PG8_WAIT_L(n) asm volatile("s_waitcnt lgkmcnt(" #n ")" ::: "memory")
#define PG8_BAR __builtin_amdgcn_s_barrier()
#define PG8_SCHED __builtin_amdgcn_sched_barrier(0)
    Unit cur, nxt; int ui = 0;
    if (!S.next(0, cur)) return;
    f32x4 acc[2][2][4][2];
#pragma unroll
    for (int a = 0; a < 2; ++a)
#pragma unroll
        for (int b = 0; b < 2; ++b)
#pragma unroll
            for (int m = 0; m < 4; ++m)
#pragma unroll
                for (int n = 0; n < 2; ++n) acc[a][b][m][n] = (f32x4){0.f, 0.f, 0.f, 0.f};
    bf16x8 At[4][2], B0[2][2], B1[2][2];
    const char* cA = (const char*)g.A + (size_t)cur.pm * tstep; const char* cB = (const char*)g.Bt + (size_t)cur.pn * tstep;
    S.a_ready(cur);
    if constexpr (SP2) {
        PG8_STAGE(PG8_SB(0, 0), cB, voffB); PG8_STAGE(PG8_SB(0, 1), cB + hstep, voffB); PG8_STAGE(PG8_SA(0, 0), cA, voffA); PG8_STAGE(PG8_SA(0, 1), cA + hstep, voffA);
        if (wr == 1) PG8_BAR;
        PG8_WAIT_V(2); PG8_BAR;
        PG8_STAGE(PG8_SB(1, 0), cB + kstep, voffB); PG8_STAGE(PG8_SA(1, 0), cA + kstep, voffA); PG8_STAGE(PG8_SB(1, 1), cB + hstep + kstep, voffB);
        PG8_WAIT_V(6); PG8_BAR;
    } else {
        PG8_STAGE(PG8_SB(0, 0), cB, voffB); PG8_STAGE(PG8_SA(0, 0), cA, voffA); PG8_STAGE(PG8_SB(0, 1), cB + hstep, voffB); PG8_STAGE(PG8_SA(0, 1), cA + hstep, voffA);
        if (wr == 1) PG8_BAR;
        PG8_WAIT_V(4); PG8_BAR;
        PG8_STAGE(PG8_SB(1, 0), cB + kstep, voffB); PG8_STAGE(PG8_SA(1, 0), cA + kstep, voffA); PG8_STAGE(PG8_SB(1, 1), cB + hstep + kstep, voffB);
        PG8_WAIT_V(6); PG8_BAR;
    }
    for (;;) {
        const bool has_next = S.next(ui + 1, nxt);
        const char* nA = has_next ? (const char*)g.A + (size_t)nxt.pm * tstep : cA; const char* nB = has_next ? (const char*)g.Bt + (size_t)nxt.pn * tstep : cB;
        for (int t = 0; t < nt; t += 2) {
            const bool last = (t == nt - 2);
            const char* a1 = cA + (size_t)(t + 1) * kstep;
            const char* a2 = last ? nA : cA + (size_t)(t + 2) * kstep; const char* b2 = last ? nB : cB + (size_t)(t + 2) * kstep;
            const char* a3 = a2 + kstep; const char* b3 = b2 + kstep;
            if (last && has_next) S.a_ready(nxt);
            if constexpr (SP2) {
            PG8_LDB(B0, 0, 0); PG8_LDB(B1, 0, 1); PG8_SCHED; PG8_LDA(At, 0, 0); PG8_STAGE(PG8_SA(1, 1), a1 + hstep, voffA);
            PG8_WAIT_V(8); PG8_WAIT_L(0); PG8_BAR; PG8_MMA(0, 0, At, B0); PG8_MMA(0, 1, At, B1); PG8_BAR; PG8_SCHED;
            PG8_LDA(At, 0, 1); PG8_STAGE(PG8_SB(0, 0), b2, voffB); PG8_STAGE(PG8_SB(0, 1), b2 + hstep, voffB); PG8_STAGE(PG8_SA(0, 0), a2, voffA);
            PG8_WAIT_V(8); PG8_WAIT_L(0); PG8_BAR; PG8_MMA(1, 0, At, B0); PG8_MMA(1, 1, At, B1); PG8_BAR; PG8_SCHED;
            PG8_LDB(B0, 1, 0); PG8_LDB(B1, 1, 1); PG8_SCHED; PG8_LDA(At, 1, 0); PG8_STAGE(PG8_SA(0, 1), a2 + hstep, voffA);
            PG8_WAIT_V(8); PG8_WAIT_L(0); PG8_BAR; PG8_MMA(0, 0, At, B0); PG8_MMA(0, 1, At, B1); PG8_BAR; PG8_SCHED;
            PG8_LDA(At, 1, 1); PG8_STAGE(PG8_SB(1, 0), b3, voffB); PG8_STAGE(PG8_SB(1, 1), b3 + hstep, voffB); PG8_STAGE(PG8_SA(1, 0), a3, voffA);
            PG8_WAIT_V(8); PG8_WAIT_L(0); PG8_BAR; PG8_MMA(1, 0, At, B0); PG8_MMA(1, 1, At, B1); PG8_BAR; PG8_SCHED;
            } else {
            PG8_LDB(B0, 0, 0); PG8_SCHED; PG8_LDA(At, 0, 0); PG8_STAGE(PG8_SA(1, 1), a1 + hstep, voffA);
            PG8_WAIT_L(8); PG8_BAR; PG8_WAIT_L(0); PG8_MMA(0, 0, At, B0); PG8_BAR; PG8_SCHED;
            PG8_LDB(B1, 0, 1); PG8_STAGE(PG8_SB(0, 0), b2, voffB);
            PG8_BAR; PG8_WAIT_L(0); PG8_MMA(0, 1, At, B1); PG8_BAR;
            PG8_LDA(At, 0, 1); PG8_STAGE(PG8_SA(0, 0), a2, voffA);
            PG8_BAR; PG8_WAIT_L(0); PG8_MMA(1, 0, At, B0); PG8_BAR; PG8_SCHED;
            PG8_STAGE(PG8_SB(0, 1), b2 + hstep, voffB);
            PG8_WAIT_V(6); PG8_BAR; PG8_MMA(1, 1, At, B1); PG8_BAR;
            PG8_LDB(B0, 1, 0); PG8_SCHED; PG8_LDA(At, 1, 0); PG8_STAGE(PG8_SA(0, 1), a2 + hstep, voffA);
            PG8_WAIT_L(8); PG8_BAR; PG8_WAIT_L(0); PG8_MMA(0, 0, At, B0); PG8_BAR; PG8_SCHED;
            PG8_LDB(B1, 1, 1); PG8_STAGE(PG8_SB(1, 0), b3, voffB);
            PG8_BAR; PG8_WAIT_L(0); PG8_MMA(0, 1, At, B1); PG8_BAR;
            PG8_LDA(At, 1, 1); PG8_STAGE(PG8_SA(1, 0), a3, voffA);
            PG8_BAR; PG8_WAIT_L(0); PG8_MMA(1, 0, At, B0); PG8_BAR; PG8_SCHED;
            PG8_STAGE(PG8_SB(1, 1), b3 + hstep, voffB);
            PG8_WAIT_V(6); PG8_BAR; PG8_MMA(1, 1, At, B1); PG8_BAR;
            }
        }
        if constexpr (ALIGN_EPI) { if (wr == 0) PG8_BAR; }
        if constexpr (!Epi::AFTER_DRAIN) { E(acc, cur, wr, wc, fr, fq); S.done(cur); }
        if (!has_next) break;
#pragma unroll
        for (int a = 0; a < 2; ++a)
#pragma unroll
            for (int b = 0; b < 2; ++b)
#pragma unroll
                for (int m = 0; m < 4; ++m)
#pragma unroll
                    for (int n = 0; n < 2; ++n) acc[a][b][m][n] = (f32x4){0.f, 0.f, 0.f, 0.f};
        cur = nxt; cA = nA; cB = nB; ++ui;
        if constexpr (ALIGN_EPI) { if (wr == 1) PG8_BAR; }
    }
    PG8_WAIT_V(0);
    if constexpr (!ALIGN_EPI) { if (wr == 0) PG8_BAR; }
    PG8_BAR;
    if constexpr (Epi::AFTER_DRAIN) { E.fused(acc, cur, wr, wc, fr, fq, lds, wid, lane); S.done(cur); }
#undef PG8_SA
#undef PG8_SB
#undef PG8_STAGE
#undef PG8_LDA
#undef PG8_LDB
#undef PG8_MMA
#undef PG8_WAIT_V
#undef PG8_WAIT_L
#undef PG8_BAR
#undef PG8_SCHED
}
}
#include <hip/hip_bf16.h>
#include <cmath>
namespace attn_body {
using bf16=__hip_bfloat16;
using bf16x8=__attribute__((ext_vector_type(8)))short;
using s16x4=__attribute__((ext_vector_type(4)))short;
using f32x16=__attribute__((ext_vector_type(16)))float;
using u32x4=__attribute__((ext_vector_type(4)))unsigned;
constexpr int D=64;
constexpr int NW=8,QBLK=32,QB=QBLK*NW,KVBLK=64;
constexpr int ATTN_UNIT_ROWS=QB;
__device__ __forceinline__ int crow(int r,int hi){return (r&3)+8*(r>>2)+4*hi;}
#define SBAR() __builtin_amdgcn_sched_barrier(0)
__device__ __forceinline__ void cmask(f32x16&p0,f32x16&p1,int jb,int qrel,int hi){
  const float NEG=-INFINITY; int kb=64*jb+4*hi;
  #pragma unroll
  for(int r=0;r<16;++r){int kv=kb+(r&3)+8*(r>>2); if(kv>qrel)p0[r]=NEG; if(kv+32>qrel)p1[r]=NEG;}
}

constexpr int NSLOT=3, SLOTB=8192;
constexpr int LDS_K=0, LDS_V=NSLOT*SLOTB, LDS_WS=2*NSLOT*SLOTB, LDS_OST=LDS_WS+NW*64*4, LDS_BYTES=LDS_OST+NW*4096;
constexpr float C2=0.125f*1.4426950408889634f;
__device__ __forceinline__ void glds16(const void*gsrc,unsigned lds_dst){unsigned keep;
  asm volatile("s_mov_b32 %0, m0\n\ts_mov_b32 m0, %2\n\ts_nop 0\n\tglobal_load_lds_dwordx4 %1, off\n\ts_mov_b32 m0, %0":"=&s"(keep):"v"(gsrc),"s"(lds_dst):"memory");}
__device__ __forceinline__ float max3f(float a,float b,float c){float r;asm("v_max3_f32 %0, %1, %2, %3":"=v"(r):"v"(a),"v"(b),"v"(c));return r;}
__device__ __forceinline__ float max2f(float a,float b){float r;asm("v_max_f32_e32 %0, %1, %2":"=v"(r):"v"(a),"v"(b));return r;}
__device__ __forceinline__ float fadd_s(float a,float b){float r;asm("v_add_f32_e32 %0, %1, %2":"=v"(r):"v"(a),"v"(b));return r;}
__device__ __forceinline__ float fsub_s(float a,float b){float r;asm("v_sub_f32_e32 %0, %1, %2":"=v"(r):"v"(a),"v"(b));return r;}
typedef float f32x2_t __attribute__((ext_vector_type(2))); typedef __bf16 bf16x2_t __attribute__((ext_vector_type(2)));
__device__ __forceinline__ unsigned cvtpk_s(float lo,float hi){f32x2_t v={lo,hi};bf16x2_t b=__builtin_convertvector(v,bf16x2_t);return __builtin_bit_cast(unsigned,b);}
#define WAIT_BAR(N) asm volatile("s_waitcnt vmcnt(" #N ") lgkmcnt(0)\n\ts_barrier":::"memory")

__device__ __forceinline__ void qkt(f32x16&p0,f32x16&p1,const char*Kslot,const bf16x8*qr,const f32x16&negm,int r32,int hi){
  const char*kb=Kslot+hi*1024+r32*16;
  #pragma unroll
  for(int d0=0;d0<4;++d0){
    const bf16x8 b0=*reinterpret_cast<const bf16x8*>(kb+d0*2048);
    const bf16x8 b1=*reinterpret_cast<const bf16x8*>(kb+d0*2048+512);
    if(d0==0){p0=__builtin_amdgcn_mfma_f32_32x32x16_bf16(b0,qr[0],negm,0,0,0);p1=__builtin_amdgcn_mfma_f32_32x32x16_bf16(b1,qr[0],negm,0,0,0);}
    else{p0=__builtin_amdgcn_mfma_f32_32x32x16_bf16(b0,qr[d0],p0,0,0,0);p1=__builtin_amdgcn_mfma_f32_32x32x16_bf16(b1,qr[d0],p1,0,0,0);}}
}
typedef __attribute__((address_space(3))) const char* lds_cptr;
typedef short v4i16_t __attribute__((ext_vector_type(4)));
__device__ __forceinline__ void kload8(bf16x8*kf,lds_cptr kp){
  kf[0]=*(const __attribute__((address_space(3))) bf16x8*)(kp);      kf[1]=*(const __attribute__((address_space(3))) bf16x8*)(kp+512);
  kf[2]=*(const __attribute__((address_space(3))) bf16x8*)(kp+2048); kf[3]=*(const __attribute__((address_space(3))) bf16x8*)(kp+2560);
  kf[4]=*(const __attribute__((address_space(3))) bf16x8*)(kp+4096); kf[5]=*(const __attribute__((address_space(3))) bf16x8*)(kp+4608);
  kf[6]=*(const __attribute__((address_space(3))) bf16x8*)(kp+6144); kf[7]=*(const __attribute__((address_space(3))) bf16x8*)(kp+6656);
}
__device__ __forceinline__ void kload2(bf16x8*kf,lds_cptr kp,int j){ kf[2*j]=*(const __attribute__((address_space(3))) bf16x8*)(kp+j*2048); kf[2*j+1]=*(const __attribute__((address_space(3))) bf16x8*)(kp+j*2048+512); }
__device__ __forceinline__ s16x4 vtr(lds_cptr p){ return __builtin_bit_cast(s16x4,__builtin_amdgcn_ds_read_tr16_b64_v4i16((__attribute__((address_space(3))) v4i16_t*)p)); }
__device__ __forceinline__ float rowmax(const f32x16&p0,const f32x16&p1){
  float a=max3f(p0[0],p0[1],p1[0]),b=max3f(p0[2],p0[3],p1[1]);a=max3f(a,p1[2],p1[3]);
  #pragma unroll
  for(int r=4;r<16;r+=4){a=max3f(a,p0[r],p0[r+1]);b=max3f(b,p0[r+2],p0[r+3]);a=max3f(a,p1[r],p1[r+1]);b=max3f(b,p1[r+2],p1[r+3]);}
  const float m=max2f(a,b);
  auto rr=__builtin_amdgcn_permlane32_swap(__float_as_uint(m),__float_as_uint(m),false,false);
  return max2f(__uint_as_float(rr[0]),__uint_as_float(rr[1]));
}
__device__ __forceinline__ void pv(f32x16*o,int vb,bf16x8 pa0,bf16x8 pa1,bf16x8 pa2,bf16x8 pa3){
  #pragma unroll
  for(int d0=0;d0<2;++d0){s16x4 lo[4],hi[4];
    #pragma unroll
    for(int ks=0;ks<4;++ks){
      asm volatile("ds_read_b64_tr_b16 %0,%1 offset:%c2":"=&v"(lo[ks]):"v"(vb),"i"(d0*4096+ks*1024):"memory");
      asm volatile("ds_read_b64_tr_b16 %0,%1 offset:%c2":"=&v"(hi[ks]):"v"(vb),"i"(d0*4096+ks*1024+512):"memory");}
    asm volatile("s_waitcnt lgkmcnt(0)":::"memory");SBAR();
    #define PK(k) (bf16x8){lo[k][0],lo[k][1],lo[k][2],lo[k][3],hi[k][0],hi[k][1],hi[k][2],hi[k][3]}
    o[d0]=__builtin_amdgcn_mfma_f32_32x32x16_bf16(pa0,PK(0),o[d0],0,0,0);
    o[d0]=__builtin_amdgcn_mfma_f32_32x32x16_bf16(pa1,PK(1),o[d0],0,0,0);
    o[d0]=__builtin_amdgcn_mfma_f32_32x32x16_bf16(pa2,PK(2),o[d0],0,0,0);
    o[d0]=__builtin_amdgcn_mfma_f32_32x32x16_bf16(pa3,PK(3),o[d0],0,0,0);
    #undef PK
  }
}

#ifndef ATTN_STORE16
#define ATTN_STORE16(p,v) (*(u32x4*)(p)=(v))
#endif
template<int THRL,bool CAUSAL> __device__ __forceinline__ void attn_unit(const bf16*Qu,const int pQ,const bf16*__restrict__ Kh,const bf16*__restrict__ Vh,const int pKV,bf16*Ou,const int pO,const int NT,char*shm){
  int tid_=threadIdx.x; asm volatile("":"+v"(tid_));
  const int tid=tid_,lane=tid&63,r32=lane&31,hi=lane>>5; const int wid=__builtin_amdgcn_readfirstlane(tid>>6);
  const bf16*Qw=Qu+(long)(wid*QBLK)*pQ;
  const unsigned lds0=(unsigned)(uintptr_t)shm;
  float*wsf=(float*)(shm+LDS_WS)+wid*64;
  const bf16*ksrc=Kh+(long)lane*pKV+wid*8;
  const bf16*vsrc=Vh+(long)(16*(wid&3)+(lane>>2))*pKV+(wid>>2)*32+(lane&3)*8;
  const unsigned kdst=lds0+LDS_K+wid*1024, vdst=lds0+LDS_V+wid*1024;
  #define DMA_K(t,slot) glds16(ksrc+(long)(t)*KVBLK*pKV,(unsigned)__builtin_amdgcn_readfirstlane(kdst+(slot)))
  #define DMA_V(t,slot) glds16(vsrc+(long)(t)*KVBLK*pKV,(unsigned)__builtin_amdgcn_readfirstlane(vdst+(slot)))
  const int vb0=(int)(lds0+LDS_V)+((lane>>4)&1)*32+(lane&3)*8+(4*hi+((lane&15)>>2))*64;
  const char*Kbase=shm+LDS_K; bf16x8 kf[8];
  const lds_cptr shm3=(lds_cptr)shm; const lds_cptr kp0=shm3+LDS_K+hi*1024+r32*16; const lds_cptr vp0=shm3+LDS_V+((lane>>4)&1)*32+(lane&3)*8+(4*hi+((lane&15)>>2))*64;
  DMA_K(0,0);DMA_V(0,0);DMA_K(1,SLOTB);
  bf16x8 qr[4];
  #pragma unroll
  for(int d0=0;d0<4;++d0)qr[d0]=*reinterpret_cast<const bf16x8*>(&Qw[(long)r32*pQ+d0*16+hi*8]);
  float mhat=0.f,l_reg=0.f;f32x16 o[2];o[0]=f32x16{};o[1]=f32x16{};const f32x16 negm=f32x16{};
  const int qrel=wid*QBLK+r32;
  #define CMASK(P0,P1,t) do{ if(CAUSAL){int jb_=(t)-(NT-4); if(jb_>=0)cmask(P0,P1,jb_,qrel,hi);} }while(0)
  bool resc=false;
  #define START(P0,P1) do{ const float rm=rowmax(P0,P1); resc=false; \
    { const float dl=rm; mhat=fadd_s(mhat,dl); \
      _Pragma("unroll") for(int r=0;r<16;++r){P0[r]=fsub_s(P0[r],dl);P1[r]=fsub_s(P1[r],dl);} \
      } \
    _Pragma("unroll") for(int r=0;r<16;++r)P0[r]=__builtin_amdgcn_exp2f(P0[r]); }while(0)
  #define RESC() do{ if(resc){ asm volatile("s_waitcnt lgkmcnt(0)":::"memory"); \
      _Pragma("unroll") for(int d_=0;d_<2;++d_) _Pragma("unroll") for(int r=0;r<16;++r)o[d_][r]*=wsf[crow(r,hi)]; } }while(0)
  f32x16 pA0,pA1,pB0,pB1;
  int sl_prev=0,sl_cur=0,sl_next=SLOTB;
  #define ROT() do{sl_prev=sl_cur;sl_cur=sl_next;sl_next=(sl_next==(NSLOT-1)*SLOTB)?0:sl_next+SLOTB;}while(0)
  DMA_K(2,2*SLOTB);
  WAIT_BAR(3);
  qkt(pA0,pA1,Kbase,qr,negm,r32,hi);asm volatile("s_nop 15\n\ts_nop 7":"+v"(pA0),"+v"(pA1));CMASK(pA0,pA1,0);
  START(pA0,pA1);
  _Pragma("unroll") for(int r=0;r<16;++r)pA1[r]=__builtin_amdgcn_exp2f(pA1[r]);
  WAIT_BAR(0);
  DMA_K(3,0);DMA_V(1,SLOTB);
  ROT();
  kload8(kf,kp0+sl_cur);
  WAIT_BAR(2);
  s16x4 vlo[8],vhi[8]; u32x4 pw0,pw1,pw2,pw3;
  #define PKW(P,B) cvtpk_s(P[B],P[B+1])
  #define PAF(k) __builtin_bit_cast(bf16x8,pw##k)
  #define VFR(i) (bf16x8){vlo[i][0],vlo[i][1],vlo[i][2],vlo[i][3],vhi[i][0],vhi[i][1],vhi[i][2],vhi[i][3]}
  #define PIN(x) asm volatile("":"+v"(x))
  #define MX3(a,b,c) __builtin_fmaxf(__builtin_fmaxf((a),(b)),(c))
  #define GAPA(MF,A0,A1,A2,A3,W0,W1,PW) do{ MF; sacc+=A0; sacc+=A1; sacc+=A2; sacc+=A3; PIN(sacc); W0; W1; PIN(PW); SBAR(); }while(0)
  #define EX(v) __builtin_amdgcn_exp2f(v)
  #define GAPB(MF,X,B) do{ MF; X[B]=EX(X[B]); X[B+1]=EX(X[B+1]); X[B+2]=EX(X[B+2]); X[B+3]=EX(X[B+3]); PIN(X); SBAR(); }while(0)
  #define VRD(i) do{ vlo[i]=vtr(vp_+(((i)>>2)*4096+((i)&3)*1024)); vhi[i]=vtr(vp_+(((i)>>2)*4096+((i)&3)*1024+512)); }while(0)
  #define KRD(G,j) do{ if(G){ kload2(kf,kp0+sl_next,j); SBAR(); } }while(0)
  #define STEP(C0,C1,P0,P1,t,GK,GV,GL) do{ SBAR(); \
    const lds_cptr vp_=vp0+sl_prev; \
    VRD(0); SBAR(); float sacc=(P0[0]+P0[1]); \
    GAPA(C0=__builtin_amdgcn_mfma_f32_32x32x16_bf16(kf[0],qr[0],negm,0,0,0), P0[2],P0[3],P0[4],P0[5],     pw0[0]=PKW(P0,0), pw0[1]=PKW(P0,2), pw0); \
    VRD(4); SBAR(); GAPA(C1=__builtin_amdgcn_mfma_f32_32x32x16_bf16(kf[1],qr[0],negm,0,0,0), P0[6],P0[7],P0[8],P0[9],     pw0[2]=PKW(P0,4), pw0[3]=PKW(P0,6), pw0); \
    VRD(1); SBAR(); GAPA(C0=__builtin_amdgcn_mfma_f32_32x32x16_bf16(kf[2],qr[1],C0,0,0,0),   P0[10],P0[11],P0[12],P0[13], pw1[0]=PKW(P0,8), pw1[1]=PKW(P0,10), pw1); \
    VRD(5); SBAR(); GAPA(C1=__builtin_amdgcn_mfma_f32_32x32x16_bf16(kf[3],qr[1],C1,0,0,0),   P0[14],P0[15],P1[0],P1[1],   pw1[2]=PKW(P0,12),pw1[3]=PKW(P0,14), pw1); \
    VRD(2); SBAR(); GAPA(C0=__builtin_amdgcn_mfma_f32_32x32x16_bf16(kf[4],qr[2],C0,0,0,0),   P1[2],P1[3],P1[4],P1[5],     pw2[0]=PKW(P1,0), pw2[1]=PKW(P1,2), pw2); \
    VRD(6); SBAR(); GAPA(C1=__builtin_amdgcn_mfma_f32_32x32x16_bf16(kf[5],qr[2],C1,0,0,0),   P1[6],P1[7],P1[8],P1[9],     pw2[2]=PKW(P1,4), pw2[3]=PKW(P1,6), pw2); \
    VRD(3); SBAR(); GAPA(C0=__builtin_amdgcn_mfma_f32_32x32x16_bf16(kf[6],qr[3],C0,0,0,0),   P1[10],P1[11],P1[12],P1[13], pw3[0]=PKW(P1,8), pw3[1]=PKW(P1,10), pw3); \
    VRD(7); SBAR(); GAPA(C1=__builtin_amdgcn_mfma_f32_32x32x16_bf16(kf[7],qr[3],C1,0,0,0),   P1[14],P1[15],0.f,0.f,       pw3[2]=PKW(P1,12),pw3[3]=PKW(P1,14), pw3); \
    l_reg+=sacc; \
    if(GK){DMA_K((t)+3,sl_cur);} if(GV){DMA_V((t)+1,sl_next);} \
    CMASK(C0,C1,t); \
    _Pragma("unroll") for(int r=0;r<16;++r){C0[r]-=mhat;C1[r]-=mhat;} \
    { float a=MX3(C0[0],C0[1],C1[0]),b=MX3(C0[2],C0[3],C1[1]); a=MX3(a,C1[2],C1[3]); \
      _Pragma("unroll") for(int r=4;r<16;r+=4){a=MX3(a,C0[r],C0[r+1]);b=MX3(b,C0[r+2],C0[r+3]);a=MX3(a,C1[r],C1[r+1]);b=MX3(b,C1[r+2],C1[r+3]);} \
      float rm=__builtin_fmaxf(a,b); { auto rr=__builtin_amdgcn_permlane32_swap(__float_as_uint(rm),__float_as_uint(rm),false,false); rm=__builtin_fmaxf(__uint_as_float(rr[0]),__uint_as_float(rr[1])); } \
      resc=false; \
      if(__builtin_expect(__any(rm>(float)THRL),0)){ const float dl=__builtin_fmaxf(rm,0.f); mhat+=dl; \
        _Pragma("unroll") for(int r=0;r<16;++r){C0[r]-=dl;C1[r]-=dl;} \
        const float f=__builtin_amdgcn_exp2f(-dl); l_reg*=f; if(hi==0)wsf[r32]=f; resc=true; } } \
    SBAR(); \
    GAPB(o[0]=__builtin_amdgcn_mfma_f32_32x32x16_bf16(PAF(0),VFR(0),o[0],0,0,0), C0,0); \
    GAPB(o[1]=__builtin_amdgcn_mfma_f32_32x32x16_bf16(PAF(0),VFR(4),o[1],0,0,0), C0,4); \
    KRD(GL,0); GAPB(o[0]=__builtin_amdgcn_mfma_f32_32x32x16_bf16(PAF(1),VFR(1),o[0],0,0,0), C0,8); \
    KRD(GL,1); GAPB(o[1]=__builtin_amdgcn_mfma_f32_32x32x16_bf16(PAF(1),VFR(5),o[1],0,0,0), C0,12); \
    KRD(GL,2); GAPB(o[0]=__builtin_amdgcn_mfma_f32_32x32x16_bf16(PAF(2),VFR(2),o[0],0,0,0), C1,0); \
    KRD(GL,3); GAPB(o[1]=__builtin_amdgcn_mfma_f32_32x32x16_bf16(PAF(2),VFR(6),o[1],0,0,0), C1,4); \
    GAPB(o[0]=__builtin_amdgcn_mfma_f32_32x32x16_bf16(PAF(3),VFR(3),o[0],0,0,0), C1,8); \
    GAPB(o[1]=__builtin_amdgcn_mfma_f32_32x32x16_bf16(PAF(3),VFR(7),o[1],0,0,0), C1,12); \
    }while(0)
  int t=1;
  #undef CMASK
  #define CMASK(P0,P1,t) do{}while(0)
  for(;t+5<NT;t+=2){
    STEP(pB0,pB1,pA0,pA1,t,true,true,true);     WAIT_BAR(2); RESC(); ROT();
    STEP(pA0,pA1,pB0,pB1,t+1,true,true,true);   WAIT_BAR(2); RESC(); ROT();
  }
  #undef CMASK
  #define CMASK(P0,P1,t) do{ if(CAUSAL){int jb_=(t)-(NT-4); if(jb_>=0)cmask(P0,P1,jb_,qrel,hi);} }while(0)
  #define ENDW(tt) do{ if((tt)+3<NT){WAIT_BAR(2);} else if((tt)+2<NT){WAIT_BAR(1);} else {WAIT_BAR(0);} }while(0)
  for(;t+1<NT;t+=2){
    STEP(pB0,pB1,pA0,pA1,t,(t+3<NT),(t+1<NT),(t+1<NT));       ENDW(t);   RESC(); ROT();
    STEP(pA0,pA1,pB0,pB1,t+1,(t+4<NT),(t+2<NT),(t+2<NT));     ENDW(t+1); RESC(); ROT();
  }
  STEP(pB0,pB1,pA0,pA1,NT-1,false,false,false); RESC();
  { float sacc=pB0[0]+pB0[1]; _Pragma("unroll") for(int r=2;r<16;++r)sacc+=pB0[r]; _Pragma("unroll") for(int r=0;r<16;++r)sacc+=pB1[r]; l_reg+=sacc;
    pw0=(u32x4){PKW(pB0,0),PKW(pB0,2),PKW(pB0,4),PKW(pB0,6)};pw1=(u32x4){PKW(pB0,8),PKW(pB0,10),PKW(pB0,12),PKW(pB0,14)};pw2=(u32x4){PKW(pB1,0),PKW(pB1,2),PKW(pB1,4),PKW(pB1,6)};pw3=(u32x4){PKW(pB1,8),PKW(pB1,10),PKW(pB1,12),PKW(pB1,14)};
    SBAR(); pv(o,vb0+sl_cur,PAF(0),PAF(1),PAF(2),PAF(3)); }
  #undef PKW
  #undef PAF
  #undef VFR
  #undef PIN
  #undef MX3
  #undef GAPA
  #undef GAPB
  #undef EX
  #undef VRD
  #undef KRD
  #undef STEP
  #undef ENDW
  {auto rr=__builtin_amdgcn_permlane32_swap(__float_as_uint(l_reg),__float_as_uint(l_reg),false,false);l_reg=__uint_as_float(rr[0])+__uint_as_float(rr[1]);}
  if(hi==0)wsf[32+r32]=l_reg;asm volatile("s_waitcnt lgkmcnt(0)":::"memory");
  float rli[16];
  #pragma unroll
  for(int r=0;r<16;++r)rli[r]=__builtin_amdgcn_rcpf(wsf[32+crow(r,hi)]);
  bf16*Ow=Ou+(long)(wid*QBLK)*pO;
  { bf16*stg=(bf16*)(shm+LDS_OST)+wid*2048;
    #pragma unroll
    for(int r=0;r<16;++r){const int orow=crow(r,hi);
      #pragma unroll
      for(int d0=0;d0<2;++d0)stg[orow*64+d0*32+r32]=__float2bfloat16(o[d0][r]*rli[r]);}
    asm volatile("s_waitcnt lgkmcnt(0)":::"memory");
    #pragma unroll
    for(int i=0;i<4;++i){const int row=i*8+(lane>>3),ch=lane&7; const u32x4 v=*(const u32x4*)(stg+row*64+ch*8); ATTN_STORE16(Ow+(long)row*pO+ch*8,v);} }
  asm volatile("s_waitcnt lgkmcnt(0)\n\ts_barrier":::"memory");
  #undef DMA_K
  #undef DMA_V
  #undef CMASK
  #undef START
  #undef RESC
  #undef ROT
}
constexpr int ATTN_LDS_BYTES=LDS_BYTES;
#undef SBAR
#undef WAIT_BAR
}
constexpr int NWAVES = 8;
#ifndef MK_N_LAUNCHES
#define MK_N_LAUNCHES 1
#endif
constexpr int NPH = 11;
constexpr int BATCH = 32, SEQ = 2048, D = 1024, T = BATCH * SEQ, NMEM = 256, TM = BATCH * NMEM;
constexpr int INCOLS = 5120, PROJW = 2048, GATEW = 3072;
constexpr float RMS_EPS = 1e-6f;
constexpr int NEXP = 16, EH = 512;
constexpr int MAXROWS = 2 * T + NEXP * 256;
constexpr size_t MiB = 1u << 20;
constexpr size_t WS_CTL = 0, CTL_ZERO_BYTES = 1 * MiB;
constexpr size_t WS_WIN = 2 * MiB;
constexpr size_t WS_PP = 13 * MiB;
constexpr size_t WS_PM = 13 * MiB + 512 * 1024;
constexpr size_t WS_PD = 14 * MiB;
constexpr size_t WS_WO = 15 * MiB;
constexpr size_t WS_WGU = 17 * MiB;
constexpr size_t WS_WD = 49 * MiB;
constexpr size_t WS_ROUTE = 65 * MiB;
constexpr size_t WS_WROW = 66 * MiB;
constexpr size_t WS_KV = 67 * MiB;
constexpr size_t WS_XN = 75 * MiB;
constexpr size_t WS_BRP = 75 * MiB, WS_BRM = 107 * MiB, WS_BRD = 139 * MiB;
constexpr size_t WS_H2 = 75 * MiB;
constexpr size_t WS_PROJ = 219 * MiB;
constexpr size_t WS_MERGED = 219 * MiB;
constexpr size_t WS_HID = 219 * MiB;
constexpr size_t WS_ATTO = 475 * MiB;
constexpr size_t WS_GATES = 603 * MiB;
constexpr size_t WS_XG = 603 * MiB;
constexpr size_t WS_Y = 603 * MiB;
constexpr size_t WS_END = 987 * MiB;
static_assert(WS_XN + (size_t)(T + TM) * D * 2 <= WS_PROJ && WS_PROJ + (size_t)T * PROJW * 2 <= WS_ATTO && WS_ATTO + (size_t)T * D * 2 <= WS_GATES && WS_GATES + (size_t)T * GATEW * 2 <= WS_END, "ws map");
static_assert(WS_XG + (size_t)MAXROWS * D * 2 <= WS_END && WS_HID + (size_t)MAXROWS * EH * 2 <= WS_ATTO && WS_WROW + (size_t)MAXROWS * 4 <= WS_KV, "ws map 2");
constexpr int CW_CNT = 64;
constexpr int RING_OFF = 0, RING_BYTES = 131072;
constexpr int LDSX_OFF = RING_BYTES;
constexpr int LDS_BYTES = 147456;

#define GAS __attribute__((address_space(1)))
#define LAS __attribute__((address_space(3)))
typedef unsigned short bf16;
typedef unsigned v4u __attribute__((ext_vector_type(4)));
typedef unsigned v2u __attribute__((ext_vector_type(2)));
typedef float f32x4 __attribute__((ext_vector_type(4)));
#define LDS_WAIT() asm volatile("s_waitcnt lgkmcnt(0)" ::: "memory")
__device__ __forceinline__ unsigned f2bf(float f) { unsigned u = __builtin_bit_cast(unsigned, f); return (u + 0x7fffu + ((u >> 16) & 1u)) >> 16; }
__device__ __forceinline__ unsigned pk2(float lo, float hi) { return f2bf(lo) | (f2bf(hi) << 16); }
__device__ __forceinline__ float bflo(unsigned w) { return __uint_as_float(w << 16); }
__device__ __forceinline__ float bfhi(unsigned w) { return __uint_as_float(w & 0xffff0000u); }
__device__ __forceinline__ float wave_sum(float v) {
#pragma unroll
    for (int o = 1; o < 64; o <<= 1) v += __shfl_xor(v, o);
    return v;
}

struct Frame {
    LAS unsigned char* lds;
    unsigned* ctl;
    int vcu, G;
};

__device__ __forceinline__ void p0_tile(const float* W, int N, int k0, int n0, bf16* WT, int Kd, int drow0, LAS float* scr, int lane) {
#pragma unroll 8
    for (int i = 0; i < 32; ++i) { const int kk = 2 * i + (lane >> 5); scr[kk * 33 + (lane & 31)] = W[(size_t)(k0 + kk) * N + n0 + (lane & 31)]; }
    LDS_WAIT(); asm volatile("" ::: "memory");
    const int c = lane & 7;
#pragma unroll
    for (int j = 0; j < 4; ++j) { const int n = (lane >> 3) + 8 * j; const LAS float* s = scr + (8 * c) * 33 + n;
        v4u o; o.x = pk2(s[0 * 33], s[1 * 33]); o.y = pk2(s[2 * 33], s[3 * 33]); o.z = pk2(s[4 * 33], s[5 * 33]); o.w = pk2(s[6 * 33], s[7 * 33]);
        *(GAS v4u*)(WT + (size_t)(drow0 + n) * Kd + k0 + 8 * c) = o; }
    LDS_WAIT(); asm volatile("" ::: "memory");
}
__device__ __forceinline__ void p0_plain(const float* W, int K, int N, bf16* WT, int row_off, int item, LAS float* scr, int lane) {
    const int nblk = N / 32, kb = item / nblk, nb = item % nblk;
    p0_tile(W, N, 64 * kb, 32 * nb, WT, K, row_off + 32 * nb, scr, lane);
}
__device__ __forceinline__ void rms_row_to_bf16(const float* xrow, const float* g, bf16* orow, int lane) {
    const GAS f32x4* xr = (const GAS f32x4*)xrow + lane; const GAS f32x4* gr = (const GAS f32x4*)g + lane;
    f32x4 v[4]; float s = 0.f;
#pragma unroll
    for (int j = 0; j < 4; ++j) { v[j] = xr[64 * j]; s += (v[j].x * v[j].x + v[j].y * v[j].y) + (v[j].z * v[j].z + v[j].w * v[j].w); }
    const float r = 1.f / sqrtf(wave_sum(s) * (1.f / D) + RMS_EPS);
    GAS unsigned long long* o8 = (GAS unsigned long long*)orow + lane;
#pragma unroll
    for (int j = 0; j < 4; ++j) { const f32x4 gg = gr[64 * j]; const f32x4 h = v[j] * r * gg;
        o8[64 * j] = (unsigned long long)pk2(h.x, h.y) | ((unsigned long long)pk2(h.z, h.w) << 32); }
}

__device__ __forceinline__ void build_tile_tables(Frame& F, const int tid) {
    LAS int* TB = (LAS int*)(F.lds + LDSX_OFF); LAS unsigned char* t2e = F.lds + LDSX_OFF + 128;
    __syncthreads();
    if (tid == 0) { int acc = 0;
        for (int e = 0; e < NEXP; ++e) { const int n = (int)__hip_atomic_load(F.ctl + CW_CNT + e, __ATOMIC_RELAXED, __HIP_MEMORY_SCOPE_AGENT); TB[e] = acc; acc += (n + 255) >> 8; }
        TB[NEXP] = acc; }
    __syncthreads();
    for (int t = tid; t < 1024; t += NWAVES * 64) { int e = 0;
#pragma unroll
        for (int k = 1; k < NEXP; ++k) e += (t >= TB[k]) ? 1 : 0;
        t2e[t] = (unsigned char)e; }
    __syncthreads();
}

struct Args { const float* in[26]; float* out; unsigned char* ws; int ph_lo, ph_hi; };

__global__ void __launch_bounds__(NWAVES * 64, 2) hybrid_fwd(Args args) {
    extern __shared__ __attribute__((aligned(16))) unsigned char lds[];
    __builtin_assume(__builtin_amdgcn_workitem_id_y() == 0); __builtin_assume(__builtin_amdgcn_workitem_id_z() == 0);
    Frame F;
    F.lds = (LAS unsigned char*)lds;
    F.G = gridDim.x; { const int bx = blockIdx.x; F.vcu = (F.G % 8 == 0) ? (bx % 8) * (F.G / 8) + bx / 8 : bx; }
    F.ctl = (unsigned*)(args.ws + WS_CTL);
#define x_in (args.in[0])
#define mem_in (args.in[1])
#define norm_mix_g (args.in[2])
#define w_in (args.in[3])
#define pool_w (args.in[4])
#define pool_scale (args.in[5])
#define lam_q1 (args.in[6])
#define lam_k1 (args.in[7])
#define lam_q2 (args.in[8])
#define lam_k2 (args.in[9])
#define subln_g (args.in[10])
#define norm_mem_g (args.in[11])
#define w_mem_kv (args.in[12])
#define p_pool (args.in[13])
#define p_diff (args.in[14])
#define p_mem (args.in[15])
#define w_o (args.in[16])
#define norm_ffn_g (args.in[17])
#define w_rg (args.in[18])
#define b_rg (args.in[19])
#define w_re (args.in[20])
#define b_re (args.in[21])
#define w_eg (args.in[22])
#define w_eu (args.in[23])
#define w_ed (args.in[24])
#define final_g (args.in[25])
#define Win_t ((bf16*)(args.ws + WS_WIN))
#define Pp_t ((bf16*)(args.ws + WS_PP))
#define Pm_t ((bf16*)(args.ws + WS_PM))
#define Pd_t ((bf16*)(args.ws + WS_PD))
#define Wo_t ((bf16*)(args.ws + WS_WO))
#define Wgu_t ((bf16*)(args.ws + WS_WGU))
#define Wd_t ((bf16*)(args.ws + WS_WD))
#define KV ((bf16*)(args.ws + WS_KV))
#define XN ((bf16*)(args.ws + WS_XN))
#define BRP ((bf16*)(args.ws + WS_BRP))
#define BRM ((bf16*)(args.ws + WS_BRM))
#define BRD ((bf16*)(args.ws + WS_BRD))
#define H2 ((bf16*)(args.ws + WS_H2))
#define PROJ ((bf16*)(args.ws + WS_PROJ))
#define MERGED ((bf16*)(args.ws + WS_MERGED))
#define HID ((bf16*)(args.ws + WS_HID))
#define ATTO ((bf16*)(args.ws + WS_ATTO))
#define GATES ((bf16*)(args.ws + WS_GATES))
#define XG ((bf16*)(args.ws + WS_XG))
#define Y ((bf16*)(args.ws + WS_Y))
#define ROUTE ((v4u*)(args.ws + WS_ROUTE))
#define WROW ((float*)(args.ws + WS_WROW))
#define X1 (args.out)
    const int NGW = F.G * NWAVES;
#define PHASE_IDS int tid = threadIdx.x; asm volatile("" : "+v"(tid)); const int lane = tid & 63, wave = __builtin_amdgcn_readfirstlane(tid >> 6), gw = F.vcu * NWAVES + wave; (void)lane; (void)gw;
    const int lo = args.ph_lo, hi = args.ph_hi;
    cg::grid_group grid = cg::this_grid();
#ifndef PH_MASK
#define PH_MASK 0x7ff
#endif
#define IN(k) (((PH_MASK >> (k)) & 1) && lo <= (k) && (k) < hi)
#define SEAM(k) do { if (IN(k) && IN((k) + 1)) grid.sync(); } while (0)

    if (IN(0)) {
        PHASE_IDS
        LAS float* scr = (LAS float*)(F.lds + RING_OFF + wave * 16384);
        constexpr int I_IN = 16 * 160, I_KV = 16 * 16, I_PD = 8 * 32, I_PM = 4 * 32, I_WO = 16 * 32, I_EG = 16 * 256, I_EU = 16 * 256, I_ED = 16 * 256;
        constexpr int NITEMS = I_IN + I_KV + I_PD + I_PM + I_WO + I_EG + I_EU + I_ED;
        for (int it = gw; it < NITEMS; it += NGW) {
            int r = it;
            if (r < I_IN) { p0_plain(w_in, D, INCOLS, Win_t, 0, r, scr, lane); continue; } r -= I_IN;
            if (r < I_KV) { p0_plain(w_mem_kv, D, 512, Win_t, INCOLS, r, scr, lane); continue; } r -= I_KV;
            if (r < I_PD) { p0_plain(p_diff, 512, D, Pd_t, 0, r, scr, lane); continue; } r -= I_PD;
            if (r < I_PM) { p0_plain(p_mem, 256, D, Pm_t, 0, r, scr, lane); continue; } r -= I_PM;
            if (r < I_WO) { p0_plain(w_o, D, D, Wo_t, 0, r, scr, lane); continue; } r -= I_WO;
            if (r < I_EG + I_EU) { const bool up = r >= I_EG; if (up) r -= I_EG;
                const int e = r >> 8, rr = r & 255, kb = rr >> 4, nb = rr & 15, n0 = 32 * nb;
                p0_tile((up ? w_eu : w_eg) + (size_t)e * D * EH, EH, 64 * kb, n0, Wgu_t + (size_t)e * D * D, D, (n0 >> 7) * 256 + (n0 & 127) + (up ? 128 : 0), scr, lane); continue; }
            r -= I_EG + I_EU;
            { const int e = r >> 8, rr = r & 255, kb = rr >> 5, nb = rr & 31;
              p0_tile(w_ed + (size_t)e * EH * D, D, 64 * kb, 32 * nb, Wd_t + (size_t)e * D * EH, EH, 32 * nb, scr, lane); }
        }
        for (int idx = (F.vcu * NWAVES * 64 + tid); idx < 256 * 1024; idx += F.G * NWAVES * 64) {
            const int kc = idx >> 10, n = idx & 1023, g = kc >> 6; float a = 0.f;
            for (int d = 0; d < 64; ++d) a += pool_w[kc * 64 + d] * pool_scale[g * 64 + d] * p_pool[(size_t)(g * 64 + d) * D + n];
            Pp_t[(size_t)n * 256 + kc] = (bf16)f2bf(a);
        }
        for (int m = gw; m < T + TM; m += NGW) {
            if (m < T) rms_row_to_bf16(x_in + (size_t)m * D, norm_mix_g, XN + (size_t)m * D, lane);
            else rms_row_to_bf16(mem_in + (size_t)(m - T) * D, norm_mem_g, XN + (size_t)m * D, lane);
        }
    }
    SEAM(0);

    if (IN(1)) {
        pg8::Gemm g{XN, Win_t, T, INCOLS, D};
        pg8::ProjOrder S; S.so.init(T, INCOLS, F.G, (int)blockIdx.x);
        pg8::EpiProj E{PROJ, GATES, KV, attn_body::C2};
        pg8::gemm_phase<pg8::EpiProj, pg8::ProjOrder, true, true>(F.lds + RING_OFF, g, S, E);
    }
    SEAM(1);

    if (IN(2)) {
        PHASE_IDS
        typedef attn_body::bf16 abf;
        struct DiffOrder { int vcu, G;
            __device__ __forceinline__ bool next(int i, int& bhm, int& vh, int& qb) const { bhm = vcu + (i >> 4) * G; if (bhm >= BATCH * 8) return false; vh = (i >> 3) & 1; const int k = i & 7; qb = (k & 1) ? (k >> 1) : 7 - (k >> 1); return true; } };
        struct MemOrder { int vcu, G;
            __device__ __forceinline__ bool next(int i, int& mu, int& qb) const { mu = vcu + (i >> 2) * G; if (mu >= BATCH * 8) return false; qb = (mu & 1) * 4 + (i & 3); return true; } };
        { const DiffOrder S{F.vcu, F.G}; int bhm, vh, qb;
          for (int i = 0; S.next(i, bhm, vh, qb); ++i) {
            const int b = bhm >> 3, h = (bhm >> 1) & 3, m = bhm & 1; const size_t rb = (size_t)b * SEQ;
            const abf* Qu = (const abf*)PROJ + (rb + qb * 256) * PROJW + 256 + h * 128 + m * 64;
            const abf* Kh = (const abf*)PROJ + rb * PROJW + 768 + h * 128 + m * 64;
            const abf* Vh = (const abf*)PROJ + rb * PROJW + 1280 + h * 128 + vh * 64;
            abf* Ou = (abf*)ATTO + (rb + qb * 256) * D + m * 512 + h * 128 + vh * 64;
            asm volatile("" : "+s"(Qu), "+s"(Kh), "+s"(Vh), "+s"(Ou));
            attn_body::attn_unit<8, true>(Qu, PROJW, Kh, Vh, PROJW, Ou, D, 4 * (qb + 1), (char*)lds + RING_OFF); } }
        { const MemOrder S{F.vcu, F.G}; int mu, qb;
          for (int i = 0; S.next(i, mu, qb); ++i) {
            const int b = mu >> 3, mh = (mu >> 1) & 3;
            const abf* Qu = (const abf*)PROJ + ((size_t)b * SEQ + qb * 256) * PROJW + 1792 + mh * 64;
            const abf* Kh = (const abf*)KV + (size_t)b * NMEM * 512 + mh * 64;
            const abf* Vh = (const abf*)KV + (size_t)b * NMEM * 512 + 256 + mh * 64;
            abf* Ou = (abf*)BRM + ((size_t)b * SEQ + qb * 256) * 256 + mh * 64;
            asm volatile("" : "+s"(Qu), "+s"(Kh), "+s"(Vh), "+s"(Ou));
            attn_body::attn_unit<8, false>(Qu, PROJW, Kh, Vh, 512, Ou, 256, 4, (char*)lds + RING_OFF); } }
    }
    SEAM(2);

    if (IN(3)) {
        PHASE_IDS
        float lam;
        { const float s1 = wave_sum(lam_q1[lane] * lam_k1[lane]), s2 = wave_sum(lam_q2[lane] * lam_k2[lane]); lam = __expf(s1) - __expf(s2) + 0.2f; }
        const int gi = lane >> 4, w = 2 << gi;
        float sg[8];
#pragma unroll
        for (int i = 0; i < 8; ++i) sg[i] = subln_g[((8 * lane) & 127) + i] * 0.8f;
        for (int t = gw; t < T; t += NGW) {
            const int s = t & (SEQ - 1);
            const GAS v2u* up = (const GAS v2u*)(PROJ + (size_t)t * PROJW) + lane;
            const v2u ut = up[0];
            float a0 = 0.f, a1 = 0.f, a2 = 0.f, a3 = 0.f;
            const int nw = (w < s + 1) ? w : s + 1;
            for (int j = 0; j < nw; ++j) { const v2u q = *(const GAS v2u*)((const GAS bf16*)up - (size_t)j * PROJW); a0 += bflo(q.x); a1 += bfhi(q.x); a2 += bflo(q.y); a3 += bfhi(q.y); }
            const float inv = 1.f / (float)nw;
            v2u po; po.x = pk2(a0 * inv - bflo(ut.x), a1 * inv - bfhi(ut.x)); po.y = pk2(a2 * inv - bflo(ut.y), a3 * inv - bfhi(ut.y));
            *((GAS v2u*)(BRP + (size_t)t * 256) + lane) = po;
            const v4u o0 = *((const GAS v4u*)(ATTO + (size_t)t * D) + lane), o1 = *((const GAS v4u*)(ATTO + (size_t)t * D + 512) + lane);
            float xv[8];
            xv[0] = bflo(o0.x) - lam * bflo(o1.x); xv[1] = bfhi(o0.x) - lam * bfhi(o1.x); xv[2] = bflo(o0.y) - lam * bflo(o1.y); xv[3] = bfhi(o0.y) - lam * bfhi(o1.y);
            xv[4] = bflo(o0.z) - lam * bflo(o1.z); xv[5] = bfhi(o0.z) - lam * bfhi(o1.z); xv[6] = bflo(o0.w) - lam * bflo(o1.w); xv[7] = bfhi(o0.w) - lam * bfhi(o1.w);
            float ss = 0.f;
#pragma unroll
            for (int i = 0; i < 8; ++i) ss += xv[i] * xv[i];
            ss += __shfl_xor(ss, 1); ss += __shfl_xor(ss, 2); ss += __shfl_xor(ss, 4); ss += __shfl_xor(ss, 8);
            const float r = 1.f / sqrtf(ss * (1.f / 128.f) + RMS_EPS);
            v4u od; od.x = pk2(xv[0] * r * sg[0], xv[1] * r * sg[1]); od.y = pk2(xv[2] * r * sg[2], xv[3] * r * sg[3]); od.z = pk2(xv[4] * r * sg[4], xv[5] * r * sg[5]); od.w = pk2(xv[6] * r * sg[6], xv[7] * r * sg[7]);
            *((GAS v4u*)(BRD + (size_t)t * 512) + lane) = od;
        }
    }
    SEAM(3);

    if (IN(4)) {
        pg8::StaticOrder S; S.init(T, D, F.G, (int)blockIdx.x);
        { pg8::Gemm g{BRP, Pp_t, T, D, 256}; pg8::EpiGate<1> E{GATES, 0, MERGED}; pg8::gemm_phase<pg8::EpiGate<1>, pg8::StaticOrder, true, true>(F.lds + RING_OFF, g, S, E); }
        { pg8::Gemm g{BRD, Pd_t, T, D, 512}; pg8::EpiGate<0> E{GATES, 1024, MERGED}; pg8::gemm_phase<pg8::EpiGate<0>, pg8::StaticOrder, true, true>(F.lds + RING_OFF, g, S, E); }
        { pg8::Gemm g{BRM, Pm_t, T, D, 256}; pg8::EpiGate<0> E{GATES, 2048, MERGED}; pg8::gemm_phase<pg8::EpiGate<0>, pg8::StaticOrder, true, true>(F.lds + RING_OFF, g, S, E); }
    }
    SEAM(4);

    if (IN(5)) {
        pg8::Gemm g{MERGED, Wo_t, T, D, D}; pg8::StaticOrder S; S.init(T, D, F.G, (int)blockIdx.x);
        pg8::EpiWo E{x_in, X1};
        pg8::gemm_phase<pg8::EpiWo, pg8::StaticOrder, true, true>(F.lds + RING_OFF, g, S, E);
    }
    SEAM(5);

    if (IN(6)) {
        PHASE_IDS
        LAS float* WR = (LAS float*)(F.lds + RING_OFF);
        LAS v4u* REC = (LAS v4u*)(F.lds + RING_OFF + 81920);
        LAS unsigned* LCNT = (LAS unsigned*)(F.lds + RING_OFF + 81920 + 4096);
        LAS unsigned* LBASE = LCNT + 16;
        for (int idx = tid; idx < 4096; idx += NWAVES * 64) WR[(idx & 3) * 1024 + (idx >> 2)] = w_rg[idx];
        for (int idx = tid; idx < 16384; idx += NWAVES * 64) WR[(4 + (idx & 15)) * 1024 + (idx >> 4)] = w_re[idx];
        float bg[4], be[16];
#pragma unroll
        for (int i = 0; i < 4; ++i) bg[i] = b_rg[i];
#pragma unroll
        for (int i = 0; i < 16; ++i) be[i] = b_re[i];
        for (int rb0 = F.vcu * 256; rb0 < T; rb0 += F.G * 256) {
            if (tid < 16) LCNT[tid] = 0u;
            __syncthreads();
            for (int it = 0; it < 32; ++it) {
                const int li = wave * 32 + it, row = rb0 + li;
                const GAS f32x4* xr = (const GAS f32x4*)(X1 + (size_t)row * D) + lane; const GAS f32x4* gr = (const GAS f32x4*)norm_ffn_g + lane;
                f32x4 v[4]; float s = 0.f;
#pragma unroll
                for (int j = 0; j < 4; ++j) { v[j] = xr[64 * j]; s += (v[j].x * v[j].x + v[j].y * v[j].y) + (v[j].z * v[j].z + v[j].w * v[j].w); }
                const float r = 1.f / sqrtf(wave_sum(s) * (1.f / D) + RMS_EPS);
                GAS unsigned long long* o8 = (GAS unsigned long long*)(H2 + (size_t)row * D) + lane;
#pragma unroll
                for (int j = 0; j < 4; ++j) { v[j] = v[j] * r * gr[64 * j]; o8[64 * j] = (unsigned long long)pk2(v[j].x, v[j].y) | ((unsigned long long)pk2(v[j].z, v[j].w) << 32); }
                float lg[20];
#pragma unroll
                for (int q = 0; q < 20; ++q) { float p = 0.f;
#pragma unroll
                    for (int j = 0; j < 4; ++j) { const f32x4 wv = *(const LAS f32x4*)(WR + q * 1024 + 256 * j + 4 * lane); p += (v[j].x * wv.x + v[j].y * wv.y) + (v[j].z * wv.z + v[j].w * wv.w); }
                    lg[q] = wave_sum(p); }
                float gl[4];
#pragma unroll
                for (int i = 0; i < 4; ++i) gl[i] = lg[i] + bg[i];
                int gidx = 0; float gmax = gl[0];
#pragma unroll
                for (int i = 1; i < 4; ++i) if (gl[i] > gmax) { gmax = gl[i]; gidx = i; }
                float gsum = 0.f;
#pragma unroll
                for (int i = 0; i < 4; ++i) gsum += __expf(gl[i] - gmax);
                const float gp = 1.f / gsum;
                float el[4];
#pragma unroll
                for (int j = 0; j < 4; ++j) { const float l0 = lg[4 + j] + be[j], l1 = lg[8 + j] + be[4 + j], l2 = lg[12 + j] + be[8 + j], l3 = lg[16 + j] + be[12 + j];
                    el[j] = gidx == 0 ? l0 : gidx == 1 ? l1 : gidx == 2 ? l2 : l3; }
                int i0 = 0; float m0 = el[0];
#pragma unroll
                for (int j = 1; j < 4; ++j) if (el[j] > m0) { m0 = el[j]; i0 = j; }
                int i1 = -1; float m1 = -3.0e38f;
#pragma unroll
                for (int j = 0; j < 4; ++j) if (j != i0 && el[j] > m1) { m1 = el[j]; i1 = j; }
                if (i1 < 0) { i1 = (i0 + 1) & 3; m1 = m0; }
                const float p1 = __expf(m1 - m0);
                const float w0 = gp / (1.f + p1), w1 = gp * p1 / (1.f + p1);
                if (lane == 0) { const unsigned e0 = (unsigned)(gidx * 4 + i0), e1 = (unsigned)(gidx * 4 + i1);
                    const unsigned s0 = __hip_atomic_fetch_add(LCNT + e0, 1u, __ATOMIC_RELAXED, __HIP_MEMORY_SCOPE_WORKGROUP), s1 = __hip_atomic_fetch_add(LCNT + e1, 1u, __ATOMIC_RELAXED, __HIP_MEMORY_SCOPE_WORKGROUP);
                    v4u rc; rc.x = (e0 << 20) | s0; rc.y = (e1 << 20) | s1; rc.z = __float_as_uint(w0); rc.w = __float_as_uint(w1); REC[li] = rc; }
            }
            __syncthreads();
            if (tid < 16) LBASE[tid] = __hip_atomic_fetch_add(F.ctl + CW_CNT + tid, LCNT[tid], __ATOMIC_RELAXED, __HIP_MEMORY_SCOPE_AGENT);
            __syncthreads();
            if (tid < 256) { v4u rc = REC[tid]; rc.x += LBASE[rc.x >> 20]; rc.y += LBASE[rc.y >> 20]; *((GAS v4u*)ROUTE + rb0 + tid) = rc; }
            __syncthreads();
        }
    }
    SEAM(6);

    if (IN(7)) {
        PHASE_IDS
        build_tile_tables(F, tid);
        const LAS int* TB = (const LAS int*)(F.lds + LDSX_OFF);
        for (int t = gw; t < T; t += NGW) {
            const v4u rc = *((const GAS v4u*)ROUTE + t);
            const size_t r0 = (size_t)TB[rc.x >> 20] * 256 + (rc.x & 0xFFFFFu), r1 = (size_t)TB[rc.y >> 20] * 256 + (rc.y & 0xFFFFFu);
            const GAS v4u* src = (const GAS v4u*)(H2 + (size_t)t * D) + lane; const v4u a = src[0], b = src[64];
            GAS v4u* d0 = (GAS v4u*)(XG + r0 * D) + lane; GAS v4u* d1 = (GAS v4u*)(XG + r1 * D) + lane;
            d0[0] = a; d0[64] = b; d1[0] = a; d1[64] = b;
            if (lane == 0) { WROW[r0] = __uint_as_float(rc.z); WROW[r1] = __uint_as_float(rc.w); }
        }
    }
    SEAM(7);

    if (IN(8)) {
        PHASE_IDS
        build_tile_tables(F, tid);
        const LAS int* TB = (const LAS int*)(F.lds + LDSX_OFF);
        pg8::Gemm g{XG, Wgu_t, MAXROWS, NEXP * D, D};
        pg8::MoeOrder S{(const LAS unsigned char*)(F.lds + LDSX_OFF + 128), TB[NEXP] * 4, F.G, F.vcu};
        pg8::EpiGateUp E{HID, WROW};
        pg8::gemm_phase<pg8::EpiGateUp, pg8::MoeOrder, true, true>(F.lds + RING_OFF, g, S, E);
    }
    SEAM(8);

    if (IN(9)) {
        PHASE_IDS
        build_tile_tables(F, tid);
        const LAS int* TB = (const LAS int*)(F.lds + LDSX_OFF);
        pg8::Gemm g{HID, Wd_t, MAXROWS, NEXP * D, EH};
        pg8::MoeOrder S{(const LAS unsigned char*)(F.lds + LDSX_OFF + 128), TB[NEXP] * 4, F.G, F.vcu};
        pg8::EpiDown E{Y};
        pg8::gemm_phase<pg8::EpiDown, pg8::MoeOrder, true, true>(F.lds + RING_OFF, g, S, E);
    }
    SEAM(9);

    if (IN(10)) {
        PHASE_IDS
        build_tile_tables(F, tid);
        const LAS int* TB = (const LAS int*)(F.lds + LDSX_OFF);
        for (int t = gw; t < T; t += NGW) {
            const v4u rc = *((const GAS v4u*)ROUTE + t);
            const size_t r0 = (size_t)TB[rc.x >> 20] * 256 + (rc.x & 0xFFFFFu), r1 = (size_t)TB[rc.y >> 20] * 256 + (rc.y & 0xFFFFFu);
            GAS f32x4* xr = (GAS f32x4*)(X1 + (size_t)t * D) + lane; const GAS f32x4* gr = (const GAS f32x4*)final_g + lane;
            const GAS v2u* y0 = (const GAS v2u*)(Y + r0 * D) + lane; const GAS v2u* y1 = (const GAS v2u*)(Y + r1 * D) + lane;
            f32x4 v[4]; float s = 0.f;
#pragma unroll
            for (int j = 0; j < 4; ++j) { v[j] = xr[64 * j]; const v2u a = y0[64 * j], b = y1[64 * j];
                v[j].x += bflo(a.x) + bflo(b.x); v[j].y += bfhi(a.x) + bfhi(b.x); v[j].z += bflo(a.y) + bflo(b.y); v[j].w += bfhi(a.y) + bfhi(b.y);
                s += (v[j].x * v[j].x + v[j].y * v[j].y) + (v[j].z * v[j].z + v[j].w * v[j].w); }
            const float r = 1.f / sqrtf(wave_sum(s) * (1.f / D) + RMS_EPS);
#pragma unroll
            for (int j = 0; j < 4; ++j) xr[64 * j] = v[j] * r * gr[64 * j];
        }
    }
#undef IN
#undef SEAM
#undef PHASE_IDS
#undef x_in
#undef mem_in
#undef norm_mix_g
#undef w_in
#undef pool_w
#undef pool_scale
#undef lam_q1
#undef lam_k1
#undef lam_q2
#undef lam_k2
#undef subln_g
#undef norm_mem_g
#undef w_mem_kv
#undef p_pool
#undef p_diff
#undef p_mem
#undef w_o
#undef norm_ffn_g
#undef w_rg
#undef b_rg
#undef w_re
#undef b_re
#undef w_eg
#undef w_eu
#undef w_ed
#undef final_g
#undef Win_t
#undef Pp_t
#undef Pm_t
#undef Pd_t
#undef Wo_t
#undef Wgu_t
#undef Wd_t
#undef KV
#undef XN
#undef BRP
#undef BRM
#undef BRD
#undef H2
#undef PROJ
#undef MERGED
#undef HID
#undef ATTO
#undef GATES
#undef XG
#undef Y
#undef ROUTE
#undef WROW
#undef X1
}

extern "C" void kernel_launch(void* const* d_in, const int* in_sizes, int n_in, void* d_out, int out_size, void* d_ws, size_t ws_size, hipStream_t stream) {
    static int grid = 0;
    if (grid == 0) {
        if (n_in != 26 || in_sizes[0] != T * D || out_size != T * D || ws_size < WS_END) { fprintf(stderr, "kernel_launch: unexpected problem: n_in %d in0 %d out %d ws %zu (need %zu)\n", n_in, n_in > 0 ? in_sizes[0] : -1, out_size, ws_size, (size_t)WS_END); grid = -1; return; }
        int dev = 0, cus = 0, per_cu = 0;
        if (hipGetDevice(&dev) != hipSuccess || hipDeviceGetAttribute(&cus, hipDeviceAttributeMultiprocessorCount, dev) != hipSuccess) { fprintf(stderr, "kernel_launch: device query failed\n"); grid = -1; return; }
        if (hipFuncSetAttribute((const void*)hybrid_fwd, hipFuncAttributeMaxDynamicSharedMemorySize, LDS_BYTES) != hipSuccess) { fprintf(stderr, "kernel_launch: hipFuncSetAttribute failed\n"); grid = -1; return; }
        if (hipOccupancyMaxActiveBlocksPerMultiprocessor(&per_cu, (const void*)hybrid_fwd, NWAVES * 64, LDS_BYTES) != hipSuccess || per_cu < 1) { fprintf(stderr, "kernel_launch: occupancy query says %d blocks per CU\n", per_cu); grid = -1; return; }
        (void)hipGetLastError();
        grid = cus;
        if (grid > 256) grid = 256;
    }
    if (grid < 0) return;
    if (hipMemsetAsync((char*)d_ws + WS_CTL, 0, CTL_ZERO_BYTES, stream) != hipSuccess) { fprintf(stderr, "kernel_launch: memset failed\n"); return; }
    Args a{};
    for (int i = 0; i < 26; ++i) a.in[i] = (const float*)d_in[i];
    a.out = (float*)d_out; a.ws = (unsigned char*)d_ws;
#if MK_N_LAUNCHES == 1
    a.ph_lo = 0; a.ph_hi = NPH;
    void* kargs[] = {&a};
    hipError_t e = hipLaunchCooperativeKernel((const void*)hybrid_fwd, dim3(grid), dim3(NWAVES * 64), kargs, LDS_BYTES, stream);
    if (e != hipSuccess) fprintf(stderr, "kernel_launch: cooperative launch failed: %s (grid %d)\n", hipGetErrorString(e), grid);
#else
    for (int p = 0; p < NPH; ++p) { a.ph_lo = p; a.ph_hi = p + 1;
        hipLaunchKernelGGL(hybrid_fwd, dim3(grid), dim3(NWAVES * 64), LDS_BYTES, stream, a);
        const hipError_t le = hipPeekAtLastError(); if (le != hipSuccess) { fprintf(stderr, "kernel_launch: launch %d failed: %s\n", p, hipGetErrorName(le)); break; } }
#endif
}
```

```cpp
#include <hip/hip_runtime.h>
#include <hip/hip_cooperative_groups.h>
#include <cstdio>
#include <cstdint>
namespace cg = cooperative_groups;
namespace pg8 {
#define PG8_LAS __attribute__((address_space(3)))
typedef unsigned short bf16_t;
typedef short bf16x8 __attribute__((ext_vector_type(8)));
typedef float f32x4 __attribute__((ext_vector_type(4)));
typedef unsigned u32x4 __attribute__((ext_vector_type(4)));
constexpr int BM = 256, BK = 64, HALF = 128, HTB = HALF * BK * 2  , STAGE_BYTES = 8 * HTB, NXCD = 8, WGM = 8;

__host__ __device__ __forceinline__ int lds_byte(int r, int c) { const int st = (r >> 4) * 2 + (c >> 5), rr = r & 15, cc = c & 31, ob = rr * 64 + cc * 2; return st * 1024 + (ob ^ (((ob >> 9) & 1) << 5)); }
__host__ __device__ __forceinline__ void stage_rc(int b, int& R, int& C) { const int st = b / 1024, sb = b % 1024, swz = sb ^ (((sb >> 9) & 1) << 5); R = (st >> 1) * 16 + swz / 64; C = (st & 1) * 32 + (swz % 64) / 2; }
__host__ __device__ __forceinline__ int perm32(int rho) { const int n = rho >> 4, i = rho & 15; return 8 * (i >> 2) + 4 * n + (i & 3); }

struct Unit { int pm, pn; };
struct Gemm { const bf16_t* A; const bf16_t* Bt; int M, N, K; };

struct StaticOrder {
    int nM, nN, nwg, G, c;
    __host__ __device__ void init(int M, int N, int G_, int c_) { nM = M / BM; nN = N / BM; nwg = nM * nN; G = G_; c = c_; }
    __host__ __device__ bool next(int i, Unit& u) const {
        const long L = (long)i * G + c; if (L >= nwg) return false;
        int wgid = (int)L; { const int q = nwg / NXCD, r = nwg % NXCD, xcd = wgid % NXCD, off = wgid / NXCD; wgid = (xcd < r ? xcd * (q + 1) : r * (q + 1) + (xcd - r) * q) + off; }
        const int nig = WGM * nN, gid = wgid / nig, fm = gid * WGM, gsz = (nM - fm) < WGM ? (nM - fm) : WGM;
        u.pm = fm + ((wgid % nig) % gsz); u.pn = (wgid % nig) / gsz; return true;
    }
    __device__ __forceinline__ void a_ready(const Unit&) const {}
    __device__ __forceinline__ void done(const Unit&) const {}
};

__device__ __forceinline__ unsigned cvt_pk_bf16(float lo, float hi) { unsigned r; asm volatile("v_cvt_pk_bf16_f32 %0, %1, %2" : "=v"(r) : "v"(lo), "v"(hi)); return r; }
typedef unsigned u32x2 __attribute__((ext_vector_type(2)));
__device__ __forceinline__ float bf_lo(unsigned w) { return __uint_as_float(w << 16); }
__device__ __forceinline__ float bf_hi(unsigned w) { return __uint_as_float(w & 0xffff0000u); }
__device__ __forceinline__ float sigmoid_f(float x) { return __builtin_amdgcn_rcpf(1.0f + __builtin_amdgcn_exp2f(-1.4426950408889634f * x)); }
__device__ __forceinline__ u32x4 pack8(const f32x4 a, const f32x4 b) { u32x4 w; w.x = cvt_pk_bf16(a[0], a[1]); w.y = cvt_pk_bf16(a[2], a[3]); w.z = cvt_pk_bf16(b[0], b[1]); w.w = cvt_pk_bf16(b[2], b[3]); return w; }

struct ProjOrder {
    StaticOrder so;
    __device__ __forceinline__ bool next(int i, Unit& u) const {
        const long L = (long)i * so.G + so.c;
        if (L < so.nwg) return so.next(i, u);
        const int x = (int)(L - so.nwg); if (x >= 64) return false;
        u.pm = 256 + (x >> 1); u.pn = 20 + (x & 1); return true;
    }
    __device__ __forceinline__ void a_ready(const Unit&) const {}
    __device__ __forceinline__ void done(const Unit&) const {}
};
struct MoeOrder {
    const PG8_LAS unsigned char* t2e; int nunits, G, c;
    __device__ __forceinline__ bool next(int i, Unit& u) const {
        const int L = i * G + c; if (L >= nunits) return false;
        const int pm = L >> 2; u.pm = pm; u.pn = (int)t2e[pm] * 4 + (L & 3); return true;
    }
    __device__ __forceinline__ void a_ready(const Unit&) const {}
    __device__ __forceinline__ void done(const Unit&) const {}
};

struct EpiProj {
    static constexpr bool PERM = true, AFTER_DRAIN = false;
    bf16_t* PROJ; bf16_t* GATES; bf16_t* KV; float qscale;
    __device__ __forceinline__ void operator()(const f32x4 (&acc)[2][2][4][2], const Unit& u, int wr, int wc, int fr, int fq) const {
        bf16_t* base; int ldc, colt, mode = 0; float sc = 1.f; int rowt = u.pm * BM;
        if (u.pm >= 256) { base = KV; ldc = 512; colt = (u.pn - 20) * BM; rowt -= 65536; }
        else if (u.pn < 8) { base = PROJ; ldc = 2048; colt = u.pn * BM; if (u.pn == 1 || u.pn == 2 || u.pn == 7) sc = qscale; }
        else { base = GATES; ldc = 3072; colt = (u.pn - 8) * BM; mode = 1; }
        const int row0 = rowt + wr * 64 + fr, col0 = colt + wc * 32 + 8 * fq;
#pragma unroll
        for (int ai = 0; ai < 2; ++ai)
#pragma unroll
            for (int m = 0; m < 4; ++m) { bf16_t* rowp = base + (size_t)(row0 + ai * HALF + m * 16) * ldc + col0;
#pragma unroll
                for (int bj = 0; bj < 2; ++bj) { f32x4 v0 = acc[ai][bj][m][0], v1 = acc[ai][bj][m][1];
                    if (mode) {
#pragma unroll
                        for (int i = 0; i < 4; ++i) { v0[i] = sigmoid_f(v0[i]); v1[i] = sigmoid_f(v1[i]); } }
                    else { v0 = v0 * sc; v1 = v1 * sc; }
                    *(u32x4*)(rowp + bj * HALF) = pack8(v0, v1); } }
    }
};
template <int FIRST> struct EpiGate {
    static constexpr bool PERM = true, AFTER_DRAIN = false;
    const bf16_t* GATES; int goff; bf16_t* MERGED;
    __device__ __forceinline__ void operator()(const f32x4 (&acc)[2][2][4][2], const Unit& u, int wr, int wc, int fr, int fq) const {
        const int row0 = u.pm * BM + wr * 64 + fr, col0 = u.pn * BM + wc * 32 + 8 * fq;
#pragma unroll
        for (int ai = 0; ai < 2; ++ai)
#pragma unroll
            for (int m = 0; m < 4; ++m) { const size_t r = (size_t)(row0 + ai * HALF + m * 16);
#pragma unroll
                for (int bj = 0; bj < 2; ++bj) { const int c = col0 + bj * HALF;
                    const u32x4 g = *(const u32x4*)(GATES + r * 3072 + goff + c);
                    f32x4 v0 = acc[ai][bj][m][0], v1 = acc[ai][bj][m][1];
                    v0[0] *= bf_lo(g.x); v0[1] *= bf_hi(g.x); v0[2] *= bf_lo(g.y); v0[3] *= bf_hi(g.y);
                    v1[0] *= bf_lo(g.z); v1[1] *= bf_hi(g.z); v1[2] *= bf_lo(g.w); v1[3] *= bf_hi(g.w);
                    if (!FIRST) { const u32x4 p = *(const u32x4*)(MERGED + r * 1024 + c);
                        v0[0] += bf_lo(p.x); v0[1] += bf_hi(p.x); v0[2] += bf_lo(p.y); v0[3] += bf_hi(p.y);
                        v1[0] += bf_lo(p.z); v1[1] += bf_hi(p.z); v1[2] += bf_lo(p.w); v1[3] += bf_hi(p.w); }
                    *(u32x4*)(MERGED + r * 1024 + c) = pack8(v0, v1); asm volatile("" ::: "memory"); } }
    }
};
struct EpiWo {
    static constexpr bool PERM = false, AFTER_DRAIN = false;
    const float* X; float* X1;
    __device__ __forceinline__ void operator()(const f32x4 (&acc)[2][2][4][2], const Unit& u, int wr, int wc, int fr, int fq) const {
        const int row0 = u.pm * BM + wr * 64 + fr, col0 = u.pn * BM + wc * 32 + 4 * fq;
#pragma unroll
        for (int ai = 0; ai < 2; ++ai)
#pragma unroll
            for (int m = 0; m < 4; ++m) { const size_t off = (size_t)(row0 + ai * HALF + m * 16) * 1024 + col0;
#pragma unroll
                for (int bj = 0; bj < 2; ++bj)
#pragma unroll
                    for (int n = 0; n < 2; ++n) { const size_t o = off + bj * HALF + n * 16; *(f32x4*)(X1 + o) = *(const f32x4*)(X + o) + acc[ai][bj][m][n]; } }
    }
};
struct EpiGateUp {
    static constexpr bool PERM = true, AFTER_DRAIN = false;
    bf16_t* HID; const float* WROW;
    __device__ __forceinline__ void operator()(const f32x4 (&acc)[2][2][4][2], const Unit& u, int wr, int wc, int fr, int fq) const {
        const int row0 = u.pm * BM + wr * 64 + fr, colh = (u.pn & 3) * 128 + wc * 32 + 8 * fq;
#pragma unroll
        for (int ai = 0; ai < 2; ++ai)
#pragma unroll
            for (int m = 0; m < 4; ++m) { const size_t r = (size_t)(row0 + ai * HALF + m * 16); const float w = WROW[r];
                f32x4 h0, h1;
#pragma unroll
                for (int i = 0; i < 4; ++i) { const float g0 = acc[ai][0][m][0][i], g1 = acc[ai][0][m][1][i];
                    h0[i] = g0 * sigmoid_f(g0) * acc[ai][1][m][0][i] * w; h1[i] = g1 * sigmoid_f(g1) * acc[ai][1][m][1][i] * w; }
                *(u32x4*)(HID + r * 512 + colh) = pack8(h0, h1); }
    }
};
struct EpiDown {
    static constexpr bool PERM = true, AFTER_DRAIN = false;
    bf16_t* Y;
    __device__ __forceinline__ void operator()(const f32x4 (&acc)[2][2][4][2], const Unit& u, int wr, int wc, int fr, int fq) const {
        const int row0 = u.pm * BM + wr * 64 + fr, col0 = (u.pn & 3) * BM + wc * 32 + 8 * fq;
#pragma unroll
        for (int ai = 0; ai < 2; ++ai)
#pragma unroll
            for (int m = 0; m < 4; ++m) { bf16_t* rowp = Y + (size_t)(row0 + ai * HALF + m * 16) * 1024 + col0;
#pragma unroll
                for (int bj = 0; bj < 2; ++bj) *(u32x4*)(rowp + bj * HALF) = pack8(acc[ai][bj][m][0], acc[ai][bj][m][1]); }
    }
};

template <class Epi, class Sched, bool ALIGN_EPI = false, bool SP2 = false>
__device__ __forceinline__ void gemm_phase(PG8_LAS unsigned char* lds, const Gemm g, const Sched& S, const Epi& E) {
    int tid_ = threadIdx.x; asm volatile("" : "+v"(tid_));
    const int tid = tid_, wid = __builtin_amdgcn_readfirstlane(tid >> 6), lane = tid & 63, wr = wid >> 2, wc = wid & 3, fr = lane & 15, fq = lane >> 4;
    const int K = g.K, nt = K / BK;
    unsigned voffA[2], voffB[2];
#pragma unroll
    for (int i = 0; i < 2; ++i) { int R, C; stage_rc(tid * 16 + i * 8192, R, C); const int Rb = Epi::PERM ? ((R & ~31) + perm32(R & 31)) : R;
        voffA[i] = (unsigned)(R * K + C) * 2u; voffB[i] = (unsigned)(Rb * K + C) * 2u; }
    const size_t kstep = (size_t)(BK * 2);
    const size_t hstep = (size_t)HALF * K * 2;
    const size_t tstep = 2 * hstep;
    const unsigned ldsw = (unsigned)wid * 1024u;
    const int aoff = lds_byte(wr * 64 + fr, fq * 8), boff = lds_byte(wc * 32 + fr, fq * 8);
#define PG8_SA(b, h) (((b) * 2 + (h)) * HTB)
#define PG8_SB(b, h) ((4 + (b) * 2 + (h)) * HTB)
#define PG8_STAGE(bufoff, gbase, voff) do { _Pragma("unroll") for (int _i = 0; _i < 2; ++_i) \
        __builtin_amdgcn_global_load_lds((const unsigned*)((const char*)(gbase) + (voff)[_i]), (PG8_LAS unsigned*)(lds + (bufoff) + ldsw + _i * 8192), 16, 0, 0); } while (0)
#define PG8_LDA(dst, b, h) do { _Pragma("unroll") for (int m = 0; m < 4; ++m) _Pragma("unroll") for (int k = 0; k < 2; ++k) dst[m][k] = *(const PG8_LAS bf16x8*)(lds + PG8_SA(b, h) + aoff + m * 2048 + k * 1024); } while (0)
#define PG8_LDB(dst, b, h) do { _Pragma("unroll") for (int n = 0; n < 2; ++n) _Pragma("unroll") for (int k = 0; k < 2; ++k) dst[n][k] = *(const PG8_LAS bf16x8*)(lds + PG8_SB(b, h) + boff + n * 2048 + k * 1024); } while (0)
#define PG8_MMA(ai, bj, At, Bt) do { __builtin_amdgcn_s_setprio(1); _Pragma("unroll") for (int m = 0; m < 4; ++m) _Pragma("unroll") for (int n = 0; n < 2; ++n) _Pragma("unroll") for (int k = 0; k < 2; ++k) \
        acc[ai][bj][m][n] = __builtin_amdgcn_mfma_f32_16x16x32_bf16(Bt[n][k], At[m][k], acc[ai][bj][m][n], 0, 0, 0); __builtin_amdgcn_s_setprio(0); } while (0)
#define PG8_WAIT_V(n) asm volatile("s_waitcnt vmcnt(" #n ")" ::: "memory")
#define PG8_WAIT_L(n) asm volatile("s_waitcnt lgkmcnt(" #n ")" ::: "memory")
#define PG8_BAR __builtin_amdgcn_s_barrier()
#define PG8_SCHED __builtin_amdgcn_sched_barrier(0)
    Unit cur, nxt; int ui = 0;
    if (!S.next(0, cur)) return;
    f32x4 acc[2][2][4][2];
#pragma unroll
    for (int a = 0; a < 2; ++a)
#pragma unroll
        for (int b = 0; b < 2; ++b)
#pragma unroll
            for (int m = 0; m < 4; ++m)
#pragma unroll
                for (int n = 0; n < 2; ++n) acc[a][b][m][n] = (f32x4){0.f, 0.f, 0.f, 0.f};
    bf16x8 At[4][2], B0[2][2], B1[2][2];
    const char* cA = (const char*)g.A + (size_t)cur.pm * tstep; const char* cB = (const char*)g.Bt + (size_t)cur.pn * tstep;
    S.a_ready(cur);
    if constexpr (SP2) {
        PG8_STAGE(PG8_SB(0, 0), cB, voffB); PG8_STAGE(PG8_SB(0, 1), cB + hstep, voffB); PG8_STAGE(PG8_SA(0, 0), cA, voffA); PG8_STAGE(PG8_SA(0, 1), cA + hstep, voffA);
        if (wr == 1) PG8_BAR;
        PG8_WAIT_V(2); PG8_BAR;
        PG8_STAGE(PG8_SB(1, 0), cB + kstep, voffB); PG8_STAGE(PG8_SA(1, 0), cA + kstep, voffA); PG8_STAGE(PG8_SB(1, 1), cB + hstep + kstep, voffB);
        PG8_WAIT_V(6); PG8_BAR;
    } else {
        PG8_STAGE(PG8_SB(0, 0), cB, voffB); PG8_STAGE(PG8_SA(0, 0), cA, voffA); PG8_STAGE(PG8_SB(0, 1), cB + hstep, voffB); PG8_STAGE(PG8_SA(0, 1), cA + hstep, voffA);
        if (wr == 1) PG8_BAR;
        PG8_WAIT_V(4); PG8_BAR;
        PG8_STAGE(PG8_SB(1, 0), cB + kstep, voffB); PG8_STAGE(PG8_SA(1, 0), cA + kstep, voffA); PG8_STAGE(PG8_SB(1, 1), cB + hstep + kstep, voffB);
        PG8_WAIT_V(6); PG8_BAR;
    }
    for (;;) {
        const bool has_next = S.next(ui + 1, nxt);
        const char* nA = has_next ? (const char*)g.A + (size_t)nxt.pm * tstep : cA; const char* nB = has_next ? (const char*)g.Bt + (size_t)nxt.pn * tstep : cB;
        for (int t = 0; t < nt; t += 2) {
            const bool last = (t == nt - 2);
            const char* a1 = cA + (size_t)(t + 1) * kstep;
            const char* a2 = last ? nA : cA + (size_t)(t + 2) * kstep; const char* b2 = last ? nB : cB + (size_t)(t + 2) * kstep;
            const char* a3 = a2 + kstep; const char* b3 = b2 + kstep;
            if (last && has_next) S.a_ready(nxt);
            if constexpr (SP2) {
            PG8_LDB(B0, 0, 0); PG8_LDB(B1, 0, 1); PG8_SCHED; PG8_LDA(At, 0, 0); PG8_STAGE(PG8_SA(1, 1), a1 + hstep, voffA);
            PG8_WAIT_V(8); PG8_WAIT_L(0); PG8_BAR; PG8_MMA(0, 0, At, B0); PG8_MMA(0, 1, At, B1); PG8_BAR; PG8_SCHED;
            PG8_LDA(At, 0, 1); PG8_STAGE(PG8_SB(0, 0), b2, voffB); PG8_STAGE(PG8_SB(0, 1), b2 + hstep, voffB); PG8_STAGE(PG8_SA(0, 0), a2, voffA);
            PG8_WAIT_V(8); PG8_WAIT_L(0); PG8_BAR; PG8_MMA(1, 0, At, B0); PG8_MMA(1, 1, At, B1); PG8_BAR; PG8_SCHED;
            PG8_LDB(B0, 1, 0); PG8_LDB(B1, 1, 1); PG8_SCHED; PG8_LDA(At, 1, 0); PG8_STAGE(PG8_SA(0, 1), a2 + hstep, voffA);
            PG8_WAIT_V(8); PG8_WAIT_L(0); PG8_BAR; PG8_MMA(0, 0, At, B0); PG8_MMA(0, 1, At, B1); PG8_BAR; PG8_SCHED;
            PG8_LDA(At, 1, 1); PG8_STAGE(PG8_SB(1, 0), b3, voffB); PG8_STAGE(PG8_SB(1, 1), b3 + hstep, voffB); PG8_STAGE(PG8_SA(1, 0), a3, voffA);
            PG8_WAIT_V(8); PG8_WAIT_L(0); PG8_BAR; PG8_MMA(1, 0, At, B0); PG8_MMA(1, 1, At, B1); PG8_BAR; PG8_SCHED;
            } else {
            PG8_LDB(B0, 0, 0); PG8_SCHED; PG8_LDA(At, 0, 0); PG8_STAGE(PG8_SA(1, 1), a1 + hstep, voffA);
            PG8_WAIT_L(8); PG8_BAR; PG8_WAIT_L(0); PG8_MMA(0, 0, At, B0); PG8_BAR; PG8_SCHED;
            PG8_LDB(B1, 0, 1); PG8_STAGE(PG8_SB(0, 0), b2, voffB);
            PG8_BAR; PG8_WAIT_L(0); PG8_MMA(0, 1, At, B1); PG8_BAR;
            PG8_LDA(At, 0, 1); PG8_STAGE(PG8_SA(0, 0), a2, voffA);
            PG8_BAR; PG8_WAIT_L(0); PG8_MMA(1, 0, At, B0); PG8_BAR; PG8_SCHED;
            PG8_STAGE(PG8_SB(0, 1), b2 + hstep, voffB);
            PG8_WAIT_V(6); PG8_BAR; PG8_MMA(1, 1, At, B1); PG8_BAR;
            PG8_LDB(B0, 1, 0); PG8_SCHED; PG8_LDA(At, 1, 0); PG8_STAGE(PG8_SA(0, 1), a2 + hstep, voffA);
            PG8_WAIT_L(8); PG8_BAR; PG8_WAIT_L(0); PG8_MMA(0, 0, At, B0); PG8_BAR; PG8_SCHED;
            PG8_LDB(B1, 1, 1); PG8_STAGE(PG8_SB(1, 0), b3, voffB);
            PG8_BAR; PG8_WAIT_L(0); PG8_MMA(0, 1, At, B1); PG8_BAR;
            PG8_LDA(At, 1, 1); PG8_STAGE(PG8_SA(1, 0), a3, voffA);
            PG8_BAR; PG8_WAIT_L(0); PG8_MMA(1, 0, At, B0); PG8_BAR; PG8_SCHED;
            PG8_STAGE(PG8_SB(1, 1), b3 + hstep, voffB);
            PG8_WAIT_V(6); PG8_BAR; PG8_MMA(1, 1, At, B1); PG8_BAR;
            }
        }
        if constexpr (ALIGN_EPI) { if (wr == 0) PG8_BAR; }
        if constexpr (!Epi::AFTER_DRAIN) { E(acc, cur, wr, wc, fr, fq); S.done(cur); }
        if (!has_next) break;
#pragma unroll
        for (int a = 0; a < 2; ++a)
#pragma unroll
            for (int b = 0; b < 2; ++b)
#pragma unroll
                for (int m = 0; m < 4; ++m)
#pragma unroll
                    for (int n = 0; n < 2; ++n) acc[a][b][m][n] = (f32x4){0.f, 0.f, 0.f, 0.f};
        cur = nxt; cA = nA; cB = nB; ++ui;
        if constexpr (ALIGN_EPI) { if (wr == 1) PG8_BAR; }
    }
    PG8_WAIT_V(0);
    if constexpr (!ALIGN_EPI) { if (wr == 0) PG8_BAR; }
    PG8_BAR;
    if constexpr (Epi::AFTER_DRAIN) { E.fused(acc, cur, wr, wc, fr, fq, lds, wid, lane); S.done(cur); }
#undef PG8_SA
#undef PG8_SB
#undef PG8_STAGE
#undef PG8_LDA
#undef PG8_LDB
#undef PG8_MMA
#undef PG8_WAIT_V
#undef PG8_WAIT_L
#undef PG8_BAR
#undef PG8_SCHED
}
}
#include <hip/hip_bf16.h>
#include <cmath>
namespace attn_body {
using bf16=__hip_bfloat16;
using bf16x8=__attribute__((ext_vector_type(8)))short;
using s16x4=__attribute__((ext_vector_type(4)))short;
using f32x16=__attribute__((ext_vector_type(16)))float;
using u32x4=__attribute__((ext_vector_type(4)))unsigned;
constexpr int D=64;
constexpr int NW=8,QBLK=32,QB=QBLK*NW,KVBLK=64;
constexpr int ATTN_UNIT_ROWS=QB;
__device__ __forceinline__ int crow(int r,int hi){return (r&3)+8*(r>>2)+4*hi;}
#define SBAR() __builtin_amdgcn_sched_barrier(0)
__device__ __forceinline__ void cmask(f32x16&p0,f32x16&p1,int jb,int qrel,int hi){
  const float NEG=-INFINITY; int kb=64*jb+4*hi;
  #pragma unroll
  for(int r=0;r<16;++r){int kv=kb+(r&3)+8*(r>>2); if(kv>qrel)p0[r]=NEG; if(kv+32>qrel)p1[r]=NEG;}
}

constexpr int NSLOT=3, SLOTB=8192;
constexpr int LDS_K=0, LDS_V=NSLOT*SLOTB, LDS_WS=2*NSLOT*SLOTB, LDS_OST=LDS_WS+NW*64*4, LDS_BYTES=LDS_OST+NW*4096;
constexpr float C2=0.125f*1.4426950408889634f;
__device__ __forceinline__ void glds16(const void*gsrc,unsigned lds_dst){unsigned keep;
  asm volatile("s_mov_b32 %0, m0\n\ts_mov_b32 m0, %2\n\ts_nop 0\n\tglobal_load_lds_dwordx4 %1, off\n\ts_mov_b32 m0, %0":"=&s"(keep):"v"(gsrc),"s"(lds_dst):"memory");}
__device__ __forceinline__ float max3f(float a,float b,float c){float r;asm("v_max3_f32 %0, %1, %2, %3":"=v"(r):"v"(a),"v"(b),"v"(c));return r;}
__device__ __forceinline__ float max2f(float a,float b){float r;asm("v_max_f32_e32 %0, %1, %2":"=v"(r):"v"(a),"v"(b));return r;}
__device__ __forceinline__ float fadd_s(float a,float b){float r;asm("v_add_f32_e32 %0, %1, %2":"=v"(r):"v"(a),"v"(b));return r;}
__device__ __forceinline__ float fsub_s(float a,float b){float r;asm("v_sub_f32_e32 %0, %1, %2":"=v"(r):"v"(a),"v"(b));return r;}
typedef float f32x2_t __attribute__((ext_vector_type(2))); typedef __bf16 bf16x2_t __attribute__((ext_vector_type(2)));
__device__ __forceinline__ unsigned cvtpk_s(float lo,float hi){f32x2_t v={lo,hi};bf16x2_t b=__builtin_convertvector(v,bf16x2_t);return __builtin_bit_cast(unsigned,b);}
#define WAIT_BAR(N) asm volatile("s_waitcnt vmcnt(" #N ") lgkmcnt(0)\n\ts_barrier":::"memory")

__device__ __forceinline__ void qkt(f32x16&p0,f32x16&p1,const char*Kslot,const bf16x8*qr,const f32x16&negm,int r32,int hi){
  const char*kb=Kslot+hi*1024+r32*16;
  #pragma unroll
  for(int d0=0;d0<4;++d0){
    const bf16x8 b0=*reinterpret_cast<const bf16x8*>(kb+d0*2048);
    const bf16x8 b1=*reinterpret_cast<const bf16x8*>(kb+d0*2048+512);
    if(d0==0){p0=__builtin_amdgcn_mfma_f32_32x32x16_bf16(b0,qr[0],negm,0,0,0);p1=__builtin_amdgcn_mfma_f32_32x32x16_bf16(b1,qr[0],negm,0,0,0);}
    else{p0=__builtin_amdgcn_mfma_f32_32x32x16_bf16(b0,qr[d0],p0,0,0,0);p1=__builtin_amdgcn_mfma_f32_32x32x16_bf16(b1,qr[d0],p1,0,0,0);}}
}
typedef __attribute__((address_space(3))) const char* lds_cptr;
typedef short v4i16_t __attribute__((ext_vector_type(4)));
__device__ __forceinline__ void kload8(bf16x8*kf,lds_cptr kp){
  kf[0]=*(const __attribute__((address_space(3))) bf16x8*)(kp);      kf[1]=*(const __attribute__((address_space(3))) bf16x8*)(kp+512);
  kf[2]=*(const __attribute__((address_space(3))) bf16x8*)(kp+2048); kf[3]=*(const __attribute__((address_space(3))) bf16x8*)(kp+2560);
  kf[4]=*(const __attribute__((address_space(3))) bf16x8*)(kp+4096); kf[5]=*(const __attribute__((address_space(3))) bf16x8*)(kp+4608);
  kf[6]=*(const __attribute__((address_space(3))) bf16x8*)(kp+6144); kf[7]=*(const __attribute__((address_space(3))) bf16x8*)(kp+6656);
}
__device__ __forceinline__ void kload2(bf16x8*kf,lds_cptr kp,int j){ kf[2*j]=*(const __attribute__((address_space(3))) bf16x8*)(kp+j*2048); kf[2*j+1]=*(const __attribute__((address_space(3))) bf16x8*)(kp+j*2048+512); }
__device__ __forceinline__ s16x4 vtr(lds_cptr p){ return __builtin_bit_cast(s16x4,__builtin_amdgcn_ds_read_tr16_b64_v4i16((__attribute__((address_space(3))) v4i16_t*)p)); }
__device__ __forceinline__ float rowmax(const f32x16&p0,const f32x16&p1){
  float a=max3f(p0[0],p0[1],p1[0]),b=max3f(p0[2],p0[3],p1[1]);a=max3f(a,p1[2],p1[3]);
  #pragma unroll
  for(int r=4;r<16;r+=4){a=max3f(a,p0[r],p0[r+1]);b=max3f(b,p0[r+2],p0[r+3]);a=max3f(a,p1[r],p1[r+1]);b=max3f(b,p1[r+2],p1[r+3]);}
  const float m=max2f(a,b);
  auto rr=__builtin_amdgcn_permlane32_swap(__float_as_uint(m),__float_as_uint(m),false,false);
  return max2f(__uint_as_float(rr[0]),__uint_as_float(rr[1]));
}
__device__ __forceinline__ void pv(f32x16*o,int vb,bf16x8 pa0,bf16x8 pa1,bf16x8 pa2,bf16x8 pa3){
  #pragma unroll
  for(int d0=0;d0<2;++d0){s16x4 lo[4],hi[4];
    #pragma unroll
    for(int ks=0;ks<4;++ks){
      asm volatile("ds_read_b64_tr_b16 %0,%1 offset:%c2":"=&v"(lo[ks]):"v"(vb),"i"(d0*4096+ks*1024):"memory");
      asm volatile("ds_read_b64_tr_b16 %0,%1 offset:%c2":"=&v"(hi[ks]):"v"(vb),"i"(d0*4096+ks*1024+512):"memory");}
    asm volatile("s_waitcnt lgkmcnt(0)":::"memory");SBAR();
    #define PK(k) (bf16x8){lo[k][0],lo[k][1],lo[k][2],lo[k][3],hi[k][0],hi[k][1],hi[k][2],hi[k][3]}
    o[d0]=__builtin_amdgcn_mfma_f32_32x32x16_bf16(pa0,PK(0),o[d0],0,0,0);
    o[d0]=__builtin_amdgcn_mfma_f32_32x32x16_bf16(pa1,PK(1),o[d0],0,0,0);
    o[d0]=__builtin_amdgcn_mfma_f32_32x32x16_bf16(pa2,PK(2),o[d0],0,0,0);
    o[d0]=__builtin_amdgcn_mfma_f32_32x32x16_bf16(pa3,PK(3),o[d0],0,0,0);
    #undef PK
  }
}

#ifndef ATTN_STORE16
#define ATTN_STORE16(p,v) (*(u32x4*)(p)=(v))
#endif
template<int THRL,bool CAUSAL> __device__ __forceinline__ void attn_unit(const bf16*Qu,const int pQ,const bf16*__restrict__ Kh,const bf16*__restrict__ Vh,const int pKV,bf16*Ou,const int pO,const int NT,char*shm){
  int tid_=threadIdx.x; asm volatile("":"+v"(tid_));
  const int tid=tid_,lane=tid&63,r32=lane&31,hi=lane>>5; const int wid=__builtin_amdgcn_readfirstlane(tid>>6);
  const bf16*Qw=Qu+(long)(wid*QBLK)*pQ;
  const unsigned lds0=(unsigned)(uintptr_t)shm;
  float*wsf=(float*)(shm+LDS_WS)+wid*64;
  const bf16*ksrc=Kh+(long)lane*pKV+wid*8;
  const bf16*vsrc=Vh+(long)(16*(wid&3)+(lane>>2))*pKV+(wid>>2)*32+(lane&3)*8;
  const unsigned kdst=lds0+LDS_K+wid*1024, vdst=lds0+LDS_V+wid*1024;
  #define DMA_K(t,slot) glds16(ksrc+(long)(t)*KVBLK*pKV,(unsigned)__builtin_amdgcn_readfirstlane(kdst+(slot)))
  #define DMA_V(t,slot) glds16(vsrc+(long)(t)*KVBLK*pKV,(unsigned)__builtin_amdgcn_readfirstlane(vdst+(slot)))
  const int vb0=(int)(lds0+LDS_V)+((lane>>4)&1)*32+(lane&3)*8+(4*hi+((lane&15)>>2))*64;
  const char*Kbase=shm+LDS_K; bf16x8 kf[8];
  const lds_cptr shm3=(lds_cptr)shm; const lds_cptr kp0=shm3+LDS_K+hi*1024+r32*16; const lds_cptr vp0=shm3+LDS_V+((lane>>4)&1)*32+(lane&3)*8+(4*hi+((lane&15)>>2))*64;
  DMA_K(0,0);DMA_V(0,0);DMA_K(1,SLOTB);
  bf16x8 qr[4];
  #pragma unroll
  for(int d0=0;d0<4;++d0)qr[d0]=*reinterpret_cast<const bf16x8*>(&Qw[(long)r32*pQ+d0*16+hi*8]);
  float mhat=0.f,l_reg=0.f;f32x16 o[2];o[0]=f32x16{};o[1]=f32x16{};const f32x16 negm=f32x16{};
  const int qrel=wid*QBLK+r32;
  #define CMASK(P0,P1,t) do{ if(CAUSAL){int jb_=(t)-(NT-4); if(jb_>=0)cmask(P0,P1,jb_,qrel,hi);} }while(0)
  bool resc=false;
  #define START(P0,P1) do{ const float rm=rowmax(P0,P1); resc=false; \
    { const float dl=rm; mhat=fadd_s(mhat,dl); \
      _Pragma("unroll") for(int r=0;r<16;++r){P0[r]=fsub_s(P0[r],dl);P1[r]=fsub_s(P1[r],dl);} \
      } \
    _Pragma("unroll") for(int r=0;r<16;++r)P0[r]=__builtin_amdgcn_exp2f(P0[r]); }while(0)
  #define RESC() do{ if(resc){ asm volatile("s_waitcnt lgkmcnt(0)":::"memory"); \
      _Pragma("unroll") for(int d_=0;d_<2;++d_) _Pragma("unroll") for(int r=0;r<16;++r)o[d_][r]*=wsf[crow(r,hi)]; } }while(0)
  f32x16 pA0,pA1,pB0,pB1;
  int sl_prev=0,sl_cur=0,sl_next=SLOTB;
  #define ROT() do{sl_prev=sl_cur;sl_cur=sl_next;sl_next=(sl_next==(NSLOT-1)*SLOTB)?0:sl_next+SLOTB;}while(0)
  DMA_K(2,2*SLOTB);
  WAIT_BAR(3);
  qkt(pA0,pA1,Kbase,qr,negm,r32,hi);asm volatile("s_nop 15\n\ts_nop 7":"+v"(pA0),"+v"(pA1));CMASK(pA0,pA1,0);
  START(pA0,pA1);
  _Pragma("unroll") for(int r=0;r<16;++r)pA1[r]=__builtin_amdgcn_exp2f(pA1[r]);
  WAIT_BAR(0);
  DMA_K(3,0);DMA_V(1,SLOTB);
  ROT();
  kload8(kf,kp0+sl_cur);
  WAIT_BAR(2);
  s16x4 vlo[8],vhi[8]; u32x4 pw0,pw1,pw2,pw3;
  #define PKW(P,B) cvtpk_s(P[B],P[B+1])
  #define PAF(k) __builtin_bit_cast(bf16x8,pw##k)
  #define VFR(i) (bf16x8){vlo[i][0],vlo[i][1],vlo[i][2],vlo[i][3],vhi[i][0],vhi[i][1],vhi[i][2],vhi[i][3]}
  #define PIN(x) asm volatile("":"+v"(x))
  #define MX3(a,b,c) __builtin_fmaxf(__builtin_fmaxf((a),(b)),(c))
  #define GAPA(MF,A0,A1,A2,A3,W0,W1,PW) do{ MF; sacc+=A0; sacc+=A1; sacc+=A2; sacc+=A3; PIN(sacc); W0; W1; PIN(PW); SBAR(); }while(0)
  #define EX(v) __builtin_amdgcn_exp2f(v)
  #define GAPB(MF,X,B) do{ MF; X[B]=EX(X[B]); X[B+1]=EX(X[B+1]); X[B+2]=EX(X[B+2]); X[B+3]=EX(X[B+3]); PIN(X); SBAR(); }while(0)
  #define VRD(i) do{ vlo[i]=vtr(vp_+(((i)>>2)*4096+((i)&3)*1024)); vhi[i]=vtr(vp_+(((i)>>2)*4096+((i)&3)*1024+512)); }while(0)
  #define KRD(G,j) do{ if(G){ kload2(kf,kp0+sl_next,j); SBAR(); } }while(0)
  #define STEP(C0,C1,P0,P1,t,GK,GV,GL) do{ SBAR(); \
    const lds_cptr vp_=vp0+sl_prev; \
    VRD(0); SBAR(); float sacc=(P0[0]+P0[1]); \
    GAPA(C0=__builtin_amdgcn_mfma_f32_32x32x16_bf16(kf[0],qr[0],negm,0,0,0), P0[2],P0[3],P0[4],P0[5],     pw0[0]=PKW(P0,0), pw0[1]=PKW(P0,2), pw0); \
    VRD(4); SBAR(); GAPA(C1=__builtin_amdgcn_mfma_f32_32x32x16_bf16(kf[1],qr[0],negm,0,0,0), P0[6],P0[7],P0[8],P0[9],     pw0[2]=PKW(P0,4), pw0[3]=PKW(P0,6), pw0); \
    VRD(1); SBAR(); GAPA(C0=__builtin_amdgcn_mfma_f32_32x32x16_bf16(kf[2],qr[1],C0,0,0,0),   P0[10],P0[11],P0[12],P0[13], pw1[0]=PKW(P0,8), pw1[1]=PKW(P0,10), pw1); \
    VRD(5); SBAR(); GAPA(C1=__builtin_amdgcn_mfma_f32_32x32x16_bf16(kf[3],qr[1],C1,0,0,0),   P0[14],P0[15],P1[0],P1[1],   pw1[2]=PKW(P0,12),pw1[3]=PKW(P0,14), pw1); \
    VRD(2); SBAR(); GAPA(C0=__builtin_amdgcn_mfma_f32_32x32x16_bf16(kf[4],qr[2],C0,0,0,0),   P1[2],P1[3],P1[4],P1[5],     pw2[0]=PKW(P1,0), pw2[1]=PKW(P1,2), pw2); \
    VRD(6); SBAR(); GAPA(C1=__builtin_amdgcn_mfma_f32_32x32x16_bf16(kf[5],qr[2],C1,0,0,0),   P1[6],P1[7],P1[8],P1[9],     pw2[2]=PKW(P1,4), pw2[3]=PKW(P1,6), pw2); \
    VRD(3); SBAR(); GAPA(C0=__builtin_amdgcn_mfma_f32_32x32x16_bf16(kf[6],qr[3],C0,0,0,0),   P1[10],P1[11],P1[12],P1[13], pw3[0]=PKW(P1,8), pw3[1]=PKW(P1,10), pw3); \
    VRD(7); SBAR(); GAPA(C1=__builtin_amdgcn_mfma_f32_32x32x16_bf16(kf[7],qr[3],C1,0,0,0),   P1[14],P1[15],0.f,0.f,       pw3[2]=PKW(P1,12),pw3[3]=PKW(P1,14), pw3); \
    l_reg+=sacc; \
    if(GK){DMA_K((t)+3,sl_cur);} if(GV){DMA_V((t)+1,sl_next);} \
    CMASK(C0,C1,t); \
    _Pragma("unroll") for(int r=0;r<16;++r){C0[r]-=mhat;C1[r]-=mhat;} \
    { float a=MX3(C0[0],C0[1],C1[0]),b=MX3(C0[2],C0[3],C1[1]); a=MX3(a,C1[2],C1[3]); \
      _Pragma("unroll") for(int r=4;r<16;r+=4){a=MX3(a,C0[r],C0[r+1]);b=MX3(b,C0[r+2],C0[r+3]);a=MX3(a,C1[r],C1[r+1]);b=MX3(b,C1[r+2],C1[r+3]);} \
      float rm=__builtin_fmaxf(a,b); { auto rr=__builtin_amdgcn_permlane32_swap(__float_as_uint(rm),__float_as_uint(rm),false,false); rm=__builtin_fmaxf(__uint_as_float(rr[0]),__uint_as_float(rr[1])); } \
      resc=false; \
      if(__builtin_expect(__any(rm>(float)THRL),0)){ const float dl=__builtin_fmaxf(rm,0.f); mhat+=dl; \
        _Pragma("unroll") for(int r=0;r<16;++r){C0[r]-=dl;C1[r]-=dl;} \
        const float f=__builtin_amdgcn_exp2f(-dl); l_reg*=f; if(hi==0)wsf[r32]=f; resc=true; } } \
    SBAR(); \
    GAPB(o[0]=__builtin_amdgcn_mfma_f32_32x32x16_bf16(PAF(0),VFR(0),o[0],0,0,0), C0,0); \
    GAPB(o[1]=__builtin_amdgcn_mfma_f32_32x32x16_bf16(PAF(0),VFR(4),o[1],0,0,0), C0,4); \
    KRD(GL,0); GAPB(o[0]=__builtin_amdgcn_mfma_f32_32x32x16_bf16(PAF(1),VFR(1),o[0],0,0,0), C0,8); \
    KRD(GL,1); GAPB(o[1]=__builtin_amdgcn_mfma_f32_32x32x16_bf16(PAF(1),VFR(5),o[1],0,0,0), C0,12); \
    KRD(GL,2); GAPB(o[0]=__builtin_amdgcn_mfma_f32_32x32x16_bf16(PAF(2),VFR(2),o[0],0,0,0), C1,0); \
    KRD(GL,3); GAPB(o[1]=__builtin_amdgcn_mfma_f32_32x32x16_bf16(PAF(2),VFR(6),o[1],0,0,0), C1,4); \
    GAPB(o[0]=__builtin_amdgcn_mfma_f32_32x32x16_bf16(PAF(3),VFR(3),o[0],0,0,0), C1,8); \
    GAPB(o[1]=__builtin_amdgcn_mfma_f32_32x32x16_bf16(PAF(3),VFR(7),o[1],0,0,0), C1,12); \
    }while(0)
  int t=1;
  #undef CMASK
  #define CMASK(P0,P1,t) do{}while(0)
  for(;t+5<NT;t+=2){
    STEP(pB0,pB1,pA0,pA1,t,true,true,true);     WAIT_BAR(2); RESC(); ROT();
    STEP(pA0,pA1,pB0,pB1,t+1,true,true,true);   WAIT_BAR(2); RESC(); ROT();
  }
  #undef CMASK
  #define CMASK(P0,P1,t) do{ if(CAUSAL){int jb_=(t)-(NT-4); if(jb_>=0)cmask(P0,P1,jb_,qrel,hi);} }while(0)
  #define ENDW(tt) do{ if((tt)+3<NT){WAIT_BAR(2);} else if((tt)+2<NT){WAIT_BAR(1);} else {WAIT_BAR(0);} }while(0)
  for(;t+1<NT;t+=2){
    STEP(pB0,pB1,pA0,pA1,t,(t+3<NT),(t+1<NT),(t+1<NT));       ENDW(t);   RESC(); ROT();
    STEP(pA0,pA1,pB0,pB1,t+1,(t+4<NT),(t+2<NT),(t+2<NT));     ENDW(t+1); RESC(); ROT();
  }
  STEP(pB0,pB1,pA0,pA1,NT-1,false,false,false); RESC();
  { float sacc=pB0[0]+pB0[1]; _Pragma("unroll") for(int r=2;r<16;++r)sacc+=pB0[r]; _Pragma("unroll") for(int r=0;r<16;++r)sacc+=pB1[r]; l_reg+=sacc;
    pw0=(u32x4){PKW(pB0,0),PKW(pB0,2),PKW(pB0,4),PKW(pB0,6)};pw1=(u32x4){PKW(pB0,8),PKW(pB0,10),PKW(pB0,12),PKW(pB0,14)};pw2=(u32x4){PKW(pB1,0),PKW(pB1,2),PKW(pB1,4),PKW(pB1,6)};pw3=(u32x4){PKW(pB1,8),PKW(pB1,10),PKW(pB1,12),PKW(pB1,14)};
    SBAR(); pv(o,vb0+sl_cur,PAF(0),PAF(1),PAF(2),PAF(3)); }
  #undef PKW
  #undef PAF
  #undef VFR
  #undef PIN
  #undef MX3
  #undef GAPA
  #undef GAPB
  #undef EX
  #undef VRD
  #undef KRD
  #undef STEP
  #undef ENDW
  {auto rr=__builtin_amdgcn_permlane32_swap(__float_as_uint(l_reg),__float_as_uint(l_reg),false,false);l_reg=__uint_as_float(rr[0])+__uint_as_float(rr[1]);}
  if(hi==0)wsf[32+r32]=l_reg;asm volatile("s_waitcnt lgkmcnt(0)":::"memory");
  float rli[16];
  #pragma unroll
  for(int r=0;r<16;++r)rli[r]=__builtin_amdgcn_rcpf(wsf[32+crow(r,hi)]);
  bf16*Ow=Ou+(long)(wid*QBLK)*pO;
  { bf16*stg=(bf16*)(shm+LDS_OST)+wid*2048;
    #pragma unroll
    for(int r=0;r<16;++r){const int orow=crow(r,hi);
      #pragma unroll
      for(int d0=0;d0<2;++d0)stg[orow*64+d0*32+r32]=__float2bfloat16(o[d0][r]*rli[r]);}
    asm volatile("s_waitcnt lgkmcnt(0)":::"memory");
    #pragma unroll
    for(int i=0;i<4;++i){const int row=i*8+(lane>>3),ch=lane&7; const u32x4 v=*(const u32x4*)(stg+row*64+ch*8); ATTN_STORE16(Ow+(long)row*pO+ch*8,v);} }
  asm volatile("s_waitcnt lgkmcnt(0)\n\ts_barrier":::"memory");
  #undef DMA_K
  #undef DMA_V
  #undef CMASK
  #undef START
  #undef RESC
  #undef ROT
}
constexpr int ATTN_LDS_BYTES=LDS_BYTES;
#undef SBAR
#undef WAIT_BAR
}
constexpr int NWAVES = 8;
#ifndef MK_N_LAUNCHES
#define MK_N_LAUNCHES 1
#endif
constexpr int NPH = 11;
constexpr int BATCH = 32, SEQ = 2048, D = 1024, T = BATCH * SEQ, NMEM = 256, TM = BATCH * NMEM;
constexpr int INCOLS = 5120, PROJW = 2048, GATEW = 3072;
constexpr float RMS_EPS = 1e-6f;
constexpr int NEXP = 16, EH = 512;
constexpr int MAXROWS = 2 * T + NEXP * 256;
constexpr size_t MiB = 1u << 20;
constexpr size_t WS_CTL = 0, CTL_ZERO_BYTES = 1 * MiB;
constexpr size_t WS_WIN = 2 * MiB;
constexpr size_t WS_PP = 13 * MiB;
constexpr size_t WS_PM = 13 * MiB + 512 * 1024;
constexpr size_t WS_PD = 14 * MiB;
constexpr size_t WS_WO = 15 * MiB;
constexpr size_t WS_WGU = 17 * MiB;
constexpr size_t WS_WD = 49 * MiB;
constexpr size_t WS_ROUTE = 65 * MiB;
constexpr size_t WS_WROW = 66 * MiB;
constexpr size_t WS_KV = 67 * MiB;
constexpr size_t WS_XN = 75 * MiB;
constexpr size_t WS_BRP = 75 * MiB, WS_BRM = 107 * MiB, WS_BRD = 139 * MiB;
constexpr size_t WS_H2 = 75 * MiB;
constexpr size_t WS_PROJ = 219 * MiB;
constexpr size_t WS_MERGED = 219 * MiB;
constexpr size_t WS_HID = 219 * MiB;
constexpr size_t WS_ATTO = 475 * MiB;
constexpr size_t WS_GATES = 603 * MiB;
constexpr size_t WS_XG = 603 * MiB;
constexpr size_t WS_Y = 603 * MiB;
constexpr size_t WS_END = 987 * MiB;
static_assert(WS_XN + (size_t)(T + TM) * D * 2 <= WS_PROJ && WS_PROJ + (size_t)T * PROJW * 2 <= WS_ATTO && WS_ATTO + (size_t)T * D * 2 <= WS_GATES && WS_GATES + (size_t)T * GATEW * 2 <= WS_END, "ws map");
static_assert(WS_XG + (size_t)MAXROWS * D * 2 <= WS_END && WS_HID + (size_t)MAXROWS * EH * 2 <= WS_ATTO && WS_WROW + (size_t)MAXROWS * 4 <= WS_KV, "ws map 2");
constexpr int CW_CNT = 64;
constexpr int RING_OFF = 0, RING_BYTES = 131072;
constexpr int LDSX_OFF = RING_BYTES;
constexpr int LDS_BYTES = 147456;

#define GAS __attribute__((address_space(1)))
#define LAS __attribute__((address_space(3)))
typedef unsigned short bf16;
typedef unsigned v4u __attribute__((ext_vector_type(4)));
typedef unsigned v2u __attribute__((ext_vector_type(2)));
typedef float f32x4 __attribute__((ext_vector_type(4)));
#define LDS_WAIT() asm volatile("s_waitcnt lgkmcnt(0)" ::: "memory")
__device__ __forceinline__ unsigned f2bf(float f) { unsigned u = __builtin_bit_cast(unsigned, f); return (u + 0x7fffu + ((u >> 16) & 1u)) >> 16; }
__device__ __forceinline__ unsigned pk2(float lo, float hi) { return f2bf(lo) | (f2bf(hi) << 16); }
__device__ __forceinline__ float bflo(unsigned w) { return __uint_as_float(w << 16); }
__device__ __forceinline__ float bfhi(unsigned w) { return __uint_as_float(w & 0xffff0000u); }
__device__ __forceinline__ float wave_sum(float v) {
#pragma unroll
    for (int o = 1; o < 64; o <<= 1) v += __shfl_xor(v, o);
    return v;
}

typedef GAS unsigned gu32;
#define RLX_AGENT __ATOMIC_RELAXED, __HIP_MEMORY_SCOPE_AGENT
constexpr int CW_BAR = 4096;
constexpr int CW_TS = 128;
#define XB_TMO      128
#define XB_XCNT(j)  (256  + 64 * (j))
#define XB_XSUB(j)  (1280 + 64 * (j))
#define XB_XGEN(j)  (2304 + 64 * (j))
#define XB_TOP      3328
#define XB_TOPGEN   3392
#define XCD_BAR_WORDS 3456
#define XB_SPIN_CAP (1u << 18)

__device__ __forceinline__ unsigned xb_ld(unsigned* p)              { return __hip_atomic_load(p, __ATOMIC_RELAXED, __HIP_MEMORY_SCOPE_AGENT); }
__device__ __forceinline__ unsigned xb_add(unsigned* p, unsigned v) { return __hip_atomic_fetch_add(p, v, __ATOMIC_RELAXED, __HIP_MEMORY_SCOPE_AGENT); }
__device__ __forceinline__ unsigned xb_xcc_id() { return (unsigned)__builtin_amdgcn_s_getreg((3 << 11) | 20) & 0xFu; }
#define XB_SPIN(cond, bar) do { unsigned _sp = 0; while (cond) { __builtin_amdgcn_s_sleep(1); \
    if ((++_sp & 255u) == 0u) { if (xb_ld(&(bar)[XB_TMO])) break; if (_sp > XB_SPIN_CAP) { atomicAdd(&(bar)[XB_TMO], 1u); break; } } } } while (0)

struct XcdBarrier {
    unsigned* bar; unsigned x;
    volatile LAS unsigned* st;
};

__device__ __forceinline__ XcdBarrier xcd_barrier_post(unsigned* bar, volatile LAS unsigned* st) {
    XcdBarrier b; b.bar = bar; b.x = xb_xcc_id(); b.st = st;
    if (threadIdx.x == 0) (void)xb_add(&bar[XB_XCNT(b.x)], 1u);
    return b;
}
__device__ __forceinline__ void xcd_barrier_complete(unsigned* bar, unsigned x, unsigned& nloc, unsigned& nx) {
    const unsigned G = gridDim.x * gridDim.y * gridDim.z;
    unsigned sum, cnt, mine, sp = 0u;
    for (;;) {
        sum = 0u; cnt = 0u; mine = 0u;
#pragma unroll
        for (unsigned j = 0; j < 16; ++j) { const unsigned c = xb_ld(&bar[XB_XCNT(j)]); sum += c; cnt += (c > 0u) ? 1u : 0u; mine = (j == x) ? c : mine; }
        if (sum == G) break;
        __builtin_amdgcn_s_sleep(1);
        if ((++sp & 255u) == 0u) { if (xb_ld(&bar[XB_TMO])) break; if (sp > XB_SPIN_CAP) { atomicAdd(&bar[XB_TMO], 1u); break; } }
    }
    nloc = mine > 0u ? mine : 1u; nx = cnt > 0u ? cnt : 1u;
}

__device__ __forceinline__ void xcd_barrier(const XcdBarrier& b) {
    asm volatile("s_waitcnt vmcnt(0)" ::: "memory");
    __syncthreads();
    if (threadIdx.x == 0) {
        unsigned* bar = b.bar;
        __builtin_amdgcn_s_waitcnt(0);
        unsigned nloc = b.st[0], nx = b.st[1];
        if (nloc == 0u) { xcd_barrier_complete(bar, b.x, nloc, nx); b.st[0] = nloc; b.st[1] = nx; }
        const unsigned old = xb_add(&bar[XB_XSUB(b.x)], 1u);
        const unsigned gen = old / nloc;
        if (old + 1u == (gen + 1u) * nloc) {
            __builtin_amdgcn_fence(__ATOMIC_RELEASE, "agent");
            asm volatile("s_waitcnt vmcnt(0)" ::: "memory");
            const unsigned og = xb_add(&bar[XB_TOP], 1u);
            const unsigned tg = og / nx;
            if (og + 1u == (tg + 1u) * nx) xb_add(&bar[XB_TOPGEN], 1u);
            else XB_SPIN(xb_ld(&bar[XB_TOPGEN]) == tg, bar);
            __builtin_amdgcn_fence(__ATOMIC_ACQUIRE, "agent");
            xb_add(&bar[XB_XGEN(b.x)], 1u);
            asm volatile("s_waitcnt vmcnt(0)" ::: "memory");
        } else {
            XB_SPIN(xb_ld(&bar[XB_XGEN(b.x)]) == gen, bar);
            __builtin_amdgcn_fence(__ATOMIC_ACQUIRE, "agent");
            asm volatile("s_waitcnt vmcnt(0)" ::: "memory");
        }
    }
    __syncthreads();
}

struct Frame {
    LAS unsigned char* lds;
    unsigned* ctl;
    int vcu, G;
};

__device__ __forceinline__ void p0_tile(const float* W, int N, int k0, int n0, bf16* WT, int Kd, int drow0, LAS float* scr, int lane) {
#pragma unroll 8
    for (int i = 0; i < 32; ++i) { const int kk = 2 * i + (lane >> 5); scr[kk * 33 + (lane & 31)] = W[(size_t)(k0 + kk) * N + n0 + (lane & 31)]; }
    LDS_WAIT(); asm volatile("" ::: "memory");
    const int c = lane & 7;
#pragma unroll
    for (int j = 0; j < 4; ++j) { const int n = (lane >> 3) + 8 * j; const LAS float* s = scr + (8 * c) * 33 + n;
        v4u o; o.x = pk2(s[0 * 33], s[1 * 33]); o.y = pk2(s[2 * 33], s[3 * 33]); o.z = pk2(s[4 * 33], s[5 * 33]); o.w = pk2(s[6 * 33], s[7 * 33]);
        *(GAS v4u*)(WT + (size_t)(drow0 + n) * Kd + k0 + 8 * c) = o; }
    LDS_WAIT(); asm volatile("" ::: "memory");
}
__device__ __forceinline__ void p0_plain(const float* W, int K, int N, bf16* WT, int row_off, int item, LAS float* scr, int lane) {
    const int nblk = N / 32, kb = item / nblk, nb = item % nblk;
    p0_tile(W, N, 64 * kb, 32 * nb, WT, K, row_off + 32 * nb, scr, lane);
}
__device__ __forceinline__ void rms_row_to_bf16(const float* xrow, const float* g, bf16* orow, int lane) {
    const GAS f32x4* xr = (const GAS f32x4*)xrow + lane; const GAS f32x4* gr = (const GAS f32x4*)g + lane;
    f32x4 v[4]; float s = 0.f;
#pragma unroll
    for (int j = 0; j < 4; ++j) { v[j] = xr[64 * j]; s += (v[j].x * v[j].x + v[j].y * v[j].y) + (v[j].z * v[j].z + v[j].w * v[j].w); }
    const float r = 1.f / sqrtf(wave_sum(s) * (1.f / D) + RMS_EPS);
    GAS unsigned long long* o8 = (GAS unsigned long long*)orow + lane;
#pragma unroll
    for (int j = 0; j < 4; ++j) { const f32x4 gg = gr[64 * j]; const f32x4 h = v[j] * r * gg;
        o8[64 * j] = (unsigned long long)pk2(h.x, h.y) | ((unsigned long long)pk2(h.z, h.w) << 32); }
}

__device__ __forceinline__ void build_tile_tables(Frame& F, const int tid) {
    LAS int* TB = (LAS int*)(F.lds + LDSX_OFF); LAS unsigned char* t2e = F.lds + LDSX_OFF + 128;
    __syncthreads();
    if (tid == 0) { int acc = 0;
        for (int e = 0; e < NEXP; ++e) { const int n = (int)__hip_atomic_load(F.ctl + CW_CNT + e, __ATOMIC_RELAXED, __HIP_MEMORY_SCOPE_AGENT); TB[e] = acc; acc += (n + 255) >> 8; }
        TB[NEXP] = acc; }
    __syncthreads();
    for (int t = tid; t < 1024; t += NWAVES * 64) { int e = 0;
#pragma unroll
        for (int k = 1; k < NEXP; ++k) e += (t >= TB[k]) ? 1 : 0;
        t2e[t] = (unsigned char)e; }
    __syncthreads();
}

struct Args { const float* in[26]; float* out; unsigned char* ws; int ph_lo, ph_hi; };

__global__ void __launch_bounds__(NWAVES * 64, 2) hybrid_fwd(Args args) {
    extern __shared__ __attribute__((aligned(16))) unsigned char lds[];
    __builtin_assume(__builtin_amdgcn_workitem_id_y() == 0); __builtin_assume(__builtin_amdgcn_workitem_id_z() == 0);
    Frame F;
    F.lds = (LAS unsigned char*)lds;
    F.G = gridDim.x; { const int bx = blockIdx.x; F.vcu = (F.G % 8 == 0) ? (bx % 8) * (F.G / 8) + bx / 8 : bx; }
    F.ctl = (unsigned*)(args.ws + WS_CTL);
#define x_in (args.in[0])
#define mem_in (args.in[1])
#define norm_mix_g (args.in[2])
#define w_in (args.in[3])
#define pool_w (args.in[4])
#define pool_scale (args.in[5])
#define lam_q1 (args.in[6])
#define lam_k1 (args.in[7])
#define lam_q2 (args.in[8])
#define lam_k2 (args.in[9])
#define subln_g (args.in[10])
#define norm_mem_g (args.in[11])
#define w_mem_kv (args.in[12])
#define p_pool (args.in[13])
#define p_diff (args.in[14])
#define p_mem (args.in[15])
#define w_o (args.in[16])
#define norm_ffn_g (args.in[17])
#define w_rg (args.in[18])
#define b_rg (args.in[19])
#define w_re (args.in[20])
#define b_re (args.in[21])
#define w_eg (args.in[22])
#define w_eu (args.in[23])
#define w_ed (args.in[24])
#define final_g (args.in[25])
#define Win_t ((bf16*)(args.ws + WS_WIN))
#define Pp_t ((bf16*)(args.ws + WS_PP))
#define Pm_t ((bf16*)(args.ws + WS_PM))
#define Pd_t ((bf16*)(args.ws + WS_PD))
#define Wo_t ((bf16*)(args.ws + WS_WO))
#define Wgu_t ((bf16*)(args.ws + WS_WGU))
#define Wd_t ((bf16*)(args.ws + WS_WD))
#define KV ((bf16*)(args.ws + WS_KV))
#define XN ((bf16*)(args.ws + WS_XN))
#define BRP ((bf16*)(args.ws + WS_BRP))
#define BRM ((bf16*)(args.ws + WS_BRM))
#define BRD ((bf16*)(args.ws + WS_BRD))
#define H2 ((bf16*)(args.ws + WS_H2))
#define PROJ ((bf16*)(args.ws + WS_PROJ))
#define MERGED ((bf16*)(args.ws + WS_MERGED))
#define HID ((bf16*)(args.ws + WS_HID))
#define ATTO ((bf16*)(args.ws + WS_ATTO))
#define GATES ((bf16*)(args.ws + WS_GATES))
#define XG ((bf16*)(args.ws + WS_XG))
#define Y ((bf16*)(args.ws + WS_Y))
#define ROUTE ((v4u*)(args.ws + WS_ROUTE))
#define WROW ((float*)(args.ws + WS_WROW))
#define X1 (args.out)
    const int NGW = F.G * NWAVES;
#define PHASE_IDS int tid = threadIdx.x; asm volatile("" : "+v"(tid)); const int lane = tid & 63, wave = __builtin_amdgcn_readfirstlane(tid >> 6), gw = F.vcu * NWAVES + wave; (void)lane; (void)gw;
    const int lo = args.ph_lo, hi = args.ph_hi;
    cg::grid_group grid = cg::this_grid();
#ifndef PH_MASK
#define PH_MASK 0x7ff
#endif
#define IN(k) (((PH_MASK >> (k)) & 1) && lo <= (k) && (k) < hi)
#ifndef PROBE_A
#define PROBE_A -1
#endif
#ifndef PROBE_B
#define PROBE_B -1
#endif
#define STAMP(k) do { if ((PROBE_A >= 0 || PROBE_B >= 0) && blockIdx.x == 0 && threadIdx.x == 0) ((unsigned long long*)(F.ctl + CW_TS))[k] = __builtin_amdgcn_s_memrealtime(); } while (0)
#define SEAM(k) do { if (IN(k) && IN((k) + 1)) { if ((k) == 0) grid.sync(); else { XcdBarrier b_; b_.bar = (unsigned*)(args.ws + WS_CTL) + CW_BAR; b_.x = xb_xcc_id(); b_.st = (volatile LAS unsigned*)(F.lds + LDSX_OFF + 2048); xcd_barrier(b_); } } STAMP((k) + 1); } while (0)
    if (threadIdx.x < 2) ((LAS unsigned*)(F.lds + LDSX_OFF + 2048))[threadIdx.x] = 0u;
    __syncthreads();
    if (lo < hi - 1) (void)xcd_barrier_post((unsigned*)(args.ws + WS_CTL) + CW_BAR, (volatile LAS unsigned*)(F.lds + LDSX_OFF + 2048));
    STAMP(0);

    if (IN(0)) {
        PHASE_IDS
        LAS float* scr = (LAS float*)(F.lds + RING_OFF + wave * 16384);
        constexpr int I_IN = 16 * 160, I_KV = 16 * 16, I_PD = 8 * 32, I_PM = 4 * 32, I_WO = 16 * 32, I_EG = 16 * 256, I_EU = 16 * 256, I_ED = 16 * 256;
        constexpr int NITEMS = I_IN + I_KV + I_PD + I_PM + I_WO + I_EG + I_EU + I_ED;
        for (int it = gw; it < NITEMS; it += NGW) {
            int r = it;
            if (r < I_IN) { p0_plain(w_in, D, INCOLS, Win_t, 0, r, scr, lane); continue; } r -= I_IN;
            if (r < I_KV) { p0_plain(w_mem_kv, D, 512, Win_t, INCOLS, r, scr, lane); continue; } r -= I_KV;
            if (r < I_PD) { p0_plain(p_diff, 512, D, Pd_t, 0, r, scr, lane); continue; } r -= I_PD;
            if (r < I_PM) { p0_plain(p_mem, 256, D, Pm_t, 0, r, scr, lane); continue; } r -= I_PM;
            if (r < I_WO) { p0_plain(w_o, D, D, Wo_t, 0, r, scr, lane); continue; } r -= I_WO;
            if (r < I_EG + I_EU) { const bool up = r >= I_EG; if (up) r -= I_EG;
                const int e = r >> 8, rr = r & 255, kb = rr >> 4, nb = rr & 15, n0 = 32 * nb;
                p0_tile((up ? w_eu : w_eg) + (size_t)e * D * EH, EH, 64 * kb, n0, Wgu_t + (size_t)e * D * D, D, (n0 >> 7) * 256 + (n0 & 127) + (up ? 128 : 0), scr, lane); continue; }
            r -= I_EG + I_EU;
            { const int e = r >> 8, rr = r & 255, kb = rr >> 5, nb = rr & 31;
              p0_tile(w_ed + (size_t)e * EH * D, D, 64 * kb, 32 * nb, Wd_t + (size_t)e * D * EH, EH, 32 * nb, scr, lane); }
        }
        for (int idx = (F.vcu * NWAVES * 64 + tid); idx < 256 * 1024; idx += F.G * NWAVES * 64) {
            const int kc = idx >> 10, n = idx & 1023, g = kc >> 6; float a = 0.f;
            for (int d = 0; d < 64; ++d) a += pool_w[kc * 64 + d] * pool_scale[g * 64 + d] * p_pool[(size_t)(g * 64 + d) * D + n];
            Pp_t[(size_t)n * 256 + kc] = (bf16)f2bf(a);
        }
        for (int m = gw; m < T + TM; m += NGW) {
            if (m < T) rms_row_to_bf16(x_in + (size_t)m * D, norm_mix_g, XN + (size_t)m * D, lane);
            else rms_row_to_bf16(mem_in + (size_t)(m - T) * D, norm_mem_g, XN + (size_t)m * D, lane);
        }
    }
    SEAM(0);

    if (IN(1)) {
        pg8::Gemm g{XN, Win_t, T, INCOLS, D};
        pg8::ProjOrder S; S.so.init(T, INCOLS, F.G, (int)blockIdx.x);
        pg8::EpiProj E{PROJ, GATES, KV, attn_body::C2};
        pg8::gemm_phase<pg8::EpiProj, pg8::ProjOrder, true, true>(F.lds + RING_OFF, g, S, E);
    }
    SEAM(1);

    if (IN(2)) {
        PHASE_IDS
        typedef attn_body::bf16 abf;
        struct DiffOrder { int vcu, G;
            __device__ __forceinline__ bool next(int i, int& bhm, int& vh, int& qb) const { bhm = vcu + (i >> 4) * G; if (bhm >= BATCH * 8) return false; vh = (i >> 3) & 1; const int k = i & 7; qb = (k & 1) ? (k >> 1) : 7 - (k >> 1); return true; } };
        struct MemOrder { int vcu, G;
            __device__ __forceinline__ bool next(int i, int& mu, int& qb) const { mu = vcu + (i >> 2) * G; if (mu >= BATCH * 8) return false; qb = (mu & 1) * 4 + (i & 3); return true; } };
        { const DiffOrder S{F.vcu, F.G}; int bhm, vh, qb;
          for (int i = 0; S.next(i, bhm, vh, qb); ++i) {
            const int b = bhm >> 3, h = (bhm >> 1) & 3, m = bhm & 1; const size_t rb = (size_t)b * SEQ;
            const abf* Qu = (const abf*)PROJ + (rb + qb * 256) * PROJW + 256 + h * 128 + m * 64;
            const abf* Kh = (const abf*)PROJ + rb * PROJW + 768 + h * 128 + m * 64;
            const abf* Vh = (const abf*)PROJ + rb * PROJW + 1280 + h * 128 + vh * 64;
            abf* Ou = (abf*)ATTO + (rb + qb * 256) * D + m * 512 + h * 128 + vh * 64;
            asm volatile("" : "+s"(Qu), "+s"(Kh), "+s"(Vh), "+s"(Ou));
            attn_body::attn_unit<8, true>(Qu, PROJW, Kh, Vh, PROJW, Ou, D, 4 * (qb + 1), (char*)lds + RING_OFF); } }
        { const MemOrder S{F.vcu, F.G}; int mu, qb;
          for (int i = 0; S.next(i, mu, qb); ++i) {
            const int b = mu >> 3, mh = (mu >> 1) & 3;
            const abf* Qu = (const abf*)PROJ + ((size_t)b * SEQ + qb * 256) * PROJW + 1792 + mh * 64;
            const abf* Kh = (const abf*)KV + (size_t)b * NMEM * 512 + mh * 64;
            const abf* Vh = (const abf*)KV + (size_t)b * NMEM * 512 + 256 + mh * 64;
            abf* Ou = (abf*)BRM + ((size_t)b * SEQ + qb * 256) * 256 + mh * 64;
            asm volatile("" : "+s"(Qu), "+s"(Kh), "+s"(Vh), "+s"(Ou));
            attn_body::attn_unit<8, false>(Qu, PROJW, Kh, Vh, 512, Ou, 256, 4, (char*)lds + RING_OFF); } }
    }
    SEAM(2);

    if (IN(3)) {
        PHASE_IDS
        float lam;
        { const float s1 = wave_sum(lam_q1[lane] * lam_k1[lane]), s2 = wave_sum(lam_q2[lane] * lam_k2[lane]); lam = __expf(s1) - __expf(s2) + 0.2f; }
        const int gi = lane >> 4, w = 2 << gi;
        float sg[8];
#pragma unroll
        for (int i = 0; i < 8; ++i) sg[i] = subln_g[((8 * lane) & 127) + i] * 0.8f;
        for (int t = gw; t < T; t += NGW) {
            const int s = t & (SEQ - 1);
            const GAS v2u* up = (const GAS v2u*)(PROJ + (size_t)t * PROJW) + lane;
            const v2u ut = up[0];
            float a0 = 0.f, a1 = 0.f, a2 = 0.f, a3 = 0.f;
            const int nw = (w < s + 1) ? w : s + 1;
            for (int j = 0; j < nw; ++j) { const v2u q = *(const GAS v2u*)((const GAS bf16*)up - (size_t)j * PROJW); a0 += bflo(q.x); a1 += bfhi(q.x); a2 += bflo(q.y); a3 += bfhi(q.y); }
            const float inv = 1.f / (float)nw;
            v2u po; po.x = pk2(a0 * inv - bflo(ut.x), a1 * inv - bfhi(ut.x)); po.y = pk2(a2 * inv - bflo(ut.y), a3 * inv - bfhi(ut.y));
            *((GAS v2u*)(BRP + (size_t)t * 256) + lane) = po;
            const v4u o0 = *((const GAS v4u*)(ATTO + (size_t)t * D) + lane), o1 = *((const GAS v4u*)(ATTO + (size_t)t * D + 512) + lane);
            float xv[8];
            xv[0] = bflo(o0.x) - lam * bflo(o1.x); xv[1] = bfhi(o0.x) - lam * bfhi(o1.x); xv[2] = bflo(o0.y) - lam * bflo(o1.y); xv[3] = bfhi(o0.y) - lam * bfhi(o1.y);
            xv[4] = bflo(o0.z) - lam * bflo(o1.z); xv[5] = bfhi(o0.z) - lam * bfhi(o1.z); xv[6] = bflo(o0.w) - lam * bflo(o1.w); xv[7] = bfhi(o0.w) - lam * bfhi(o1.w);
            float ss = 0.f;
#pragma unroll
            for (int i = 0; i < 8; ++i) ss += xv[i] * xv[i];
            ss += __shfl_xor(ss, 1); ss += __shfl_xor(ss, 2); ss += __shfl_xor(ss, 4); ss += __shfl_xor(ss, 8);
            const float r = 1.f / sqrtf(ss * (1.f / 128.f) + RMS_EPS);
            v4u od; od.x = pk2(xv[0] * r * sg[0], xv[1] * r * sg[1]); od.y = pk2(xv[2] * r * sg[2], xv[3] * r * sg[3]); od.z = pk2(xv[4] * r * sg[4], xv[5] * r * sg[5]); od.w = pk2(xv[6] * r * sg[6], xv[7] * r * sg[7]);
            *((GAS v4u*)(BRD + (size_t)t * 512) + lane) = od;
        }
    }
    SEAM(3);

    if (IN(4)) {
        pg8::StaticOrder S; S.init(T, D, F.G, (int)blockIdx.x);
        { pg8::Gemm g{BRP, Pp_t, T, D, 256}; pg8::EpiGate<1> E{GATES, 0, MERGED}; pg8::gemm_phase<pg8::EpiGate<1>, pg8::StaticOrder, true, true>(F.lds + RING_OFF, g, S, E); }
        { pg8::Gemm g{BRD, Pd_t, T, D, 512}; pg8::EpiGate<0> E{GATES, 1024, MERGED}; pg8::gemm_phase<pg8::EpiGate<0>, pg8::StaticOrder, true, true>(F.lds + RING_OFF, g, S, E); }
        { pg8::Gemm g{BRM, Pm_t, T, D, 256}; pg8::EpiGate<0> E{GATES, 2048, MERGED}; pg8::gemm_phase<pg8::EpiGate<0>, pg8::StaticOrder, true, true>(F.lds + RING_OFF, g, S, E); }
    }
    SEAM(4);

    if (IN(5)) {
        pg8::Gemm g{MERGED, Wo_t, T, D, D}; pg8::StaticOrder S; S.init(T, D, F.G, (int)blockIdx.x);
        pg8::EpiWo E{x_in, X1};
        pg8::gemm_phase<pg8::EpiWo, pg8::StaticOrder, true, true>(F.lds + RING_OFF, g, S, E);
    }
    SEAM(5);

    if (IN(6)) {
        PHASE_IDS
        LAS float* WR = (LAS float*)(F.lds + RING_OFF);
        LAS v4u* REC = (LAS v4u*)(F.lds + RING_OFF + 81920);
        LAS unsigned* LCNT = (LAS unsigned*)(F.lds + RING_OFF + 81920 + 4096);
        LAS unsigned* LBASE = LCNT + 16;
        for (int idx = tid; idx < 4096; idx += NWAVES * 64) WR[(idx & 3) * 1024 + (idx >> 2)] = w_rg[idx];
        for (int idx = tid; idx < 16384; idx += NWAVES * 64) WR[(4 + (idx & 15)) * 1024 + (idx >> 4)] = w_re[idx];
        float bg[4], be[16];
#pragma unroll
        for (int i = 0; i < 4; ++i) bg[i] = b_rg[i];
#pragma unroll
        for (int i = 0; i < 16; ++i) be[i] = b_re[i];
        for (int rb0 = F.vcu * 256; rb0 < T; rb0 += F.G * 256) {
            if (tid < 16) LCNT[tid] = 0u;
            __syncthreads();
            for (int it = 0; it < 32; ++it) {
                const int li = wave * 32 + it, row = rb0 + li;
                const GAS f32x4* xr = (const GAS f32x4*)(X1 + (size_t)row * D) + lane; const GAS f32x4* gr = (const GAS f32x4*)norm_ffn_g + lane;
                f32x4 v[4]; float s = 0.f;
#pragma unroll
                for (int j = 0; j < 4; ++j) { v[j] = xr[64 * j]; s += (v[j].x * v[j].x + v[j].y * v[j].y) + (v[j].z * v[j].z + v[j].w * v[j].w); }
                const float r = 1.f / sqrtf(wave_sum(s) * (1.f / D) + RMS_EPS);
                GAS unsigned long long* o8 = (GAS unsigned long long*)(H2 + (size_t)row * D) + lane;
#pragma unroll
                for (int j = 0; j < 4; ++j) { v[j] = v[j] * r * gr[64 * j]; o8[64 * j] = (unsigned long long)pk2(v[j].x, v[j].y) | ((unsigned long long)pk2(v[j].z, v[j].w) << 32); }
                float lg[20];
#pragma unroll
                for (int q = 0; q < 20; ++q) { float p = 0.f;
#pragma unroll
                    for (int j = 0; j < 4; ++j) { const f32x4 wv = *(const LAS f32x4*)(WR + q * 1024 + 256 * j + 4 * lane); p += (v[j].x * wv.x + v[j].y * wv.y) + (v[j].z * wv.z + v[j].w * wv.w); }
                    lg[q] = wave_sum(p); }
                float gl[4];
#pragma unroll
                for (int i = 0; i < 4; ++i) gl[i] = lg[i] + bg[i];
                int gidx = 0; float gmax = gl[0];
#pragma unroll
                for (int i = 1; i < 4; ++i) if (gl[i] > gmax) { gmax = gl[i]; gidx = i; }
                float gsum = 0.f;
#pragma unroll
                for (int i = 0; i < 4; ++i) gsum += __expf(gl[i] - gmax);
                const float gp = 1.f / gsum;
                float el[4];
#pragma unroll
                for (int j = 0; j < 4; ++j) { const float l0 = lg[4 + j] + be[j], l1 = lg[8 + j] + be[4 + j], l2 = lg[12 + j] + be[8 + j], l3 = lg[16 + j] + be[12 + j];
                    el[j] = gidx == 0 ? l0 : gidx == 1 ? l1 : gidx == 2 ? l2 : l3; }
                int i0 = 0; float m0 = el[0];
#pragma unroll
                for (int j = 1; j < 4; ++j) if (el[j] > m0) { m0 = el[j]; i0 = j; }
                int i1 = -1; float m1 = -3.0e38f;
#pragma unroll
                for (int j = 0; j < 4; ++j) if (j != i0 && el[j] > m1) { m1 = el[j]; i1 = j; }
                if (i1 < 0) { i1 = (i0 + 1) & 3; m1 = m0; }
                const float p1 = __expf(m1 - m0);
                const float w0 = gp / (1.f + p1), w1 = gp * p1 / (1.f + p1);
                if (lane == 0) { const unsigned e0 = (unsigned)(gidx * 4 + i0), e1 = (unsigned)(gidx * 4 + i1);
                    const unsigned s0 = __hip_atomic_fetch_add(LCNT + e0, 1u, __ATOMIC_RELAXED, __HIP_MEMORY_SCOPE_WORKGROUP), s1 = __hip_atomic_fetch_add(LCNT + e1, 1u, __ATOMIC_RELAXED, __HIP_MEMORY_SCOPE_WORKGROUP);
                    v4u rc; rc.x = (e0 << 20) | s0; rc.y = (e1 << 20) | s1; rc.z = __float_as_uint(w0); rc.w = __float_as_uint(w1); REC[li] = rc; }
            }
            __syncthreads();
            if (tid < 16) LBASE[tid] = __hip_atomic_fetch_add(F.ctl + CW_CNT + tid, LCNT[tid], __ATOMIC_RELAXED, __HIP_MEMORY_SCOPE_AGENT);
            __syncthreads();
            if (tid < 256) { v4u rc = REC[tid]; rc.x += LBASE[rc.x >> 20]; rc.y += LBASE[rc.y >> 20]; *((GAS v4u*)ROUTE + rb0 + tid) = rc; }
            __syncthreads();
        }
    }
    SEAM(6);

    if (IN(7)) {
        PHASE_IDS
        build_tile_tables(F, tid);
        const LAS int* TB = (const LAS int*)(F.lds + LDSX_OFF);
        for (int t = gw; t < T; t += NGW) {
            const v4u rc = *((const GAS v4u*)ROUTE + t);
            const size_t r0 = (size_t)TB[rc.x >> 20] * 256 + (rc.x & 0xFFFFFu), r1 = (size_t)TB[rc.y >> 20] * 256 + (rc.y & 0xFFFFFu);
            const GAS v4u* src = (const GAS v4u*)(H2 + (size_t)t * D) + lane; const v4u a = src[0], b = src[64];
            GAS v4u* d0 = (GAS v4u*)(XG + r0 * D) + lane; GAS v4u* d1 = (GAS v4u*)(XG + r1 * D) + lane;
            d0[0] = a; d0[64] = b; d1[0] = a; d1[64] = b;
            if (lane == 0) { WROW[r0] = __uint_as_float(rc.z); WROW[r1] = __uint_as_float(rc.w); }
        }
    }
    SEAM(7);

    if (IN(8)) {
        PHASE_IDS
        build_tile_tables(F, tid);
        const LAS int* TB = (const LAS int*)(F.lds + LDSX_OFF);
        pg8::Gemm g{XG, Wgu_t, MAXROWS, NEXP * D, D};
        pg8::MoeOrder S{(const LAS unsigned char*)(F.lds + LDSX_OFF + 128), TB[NEXP] * 4, F.G, F.vcu};
        pg8::EpiGateUp E{HID, WROW};
        pg8::gemm_phase<pg8::EpiGateUp, pg8::MoeOrder, true, true>(F.lds + RING_OFF, g, S, E);
    }
    SEAM(8);

    if (IN(9)) {
        PHASE_IDS
        build_tile_tables(F, tid);
        const LAS int* TB = (const LAS int*)(F.lds + LDSX_OFF);
        pg8::Gemm g{HID, Wd_t, MAXROWS, NEXP * D, EH};
        pg8::MoeOrder S{(const LAS unsigned char*)(F.lds + LDSX_OFF + 128), TB[NEXP] * 4, F.G, F.vcu};
        pg8::EpiDown E{Y};
        pg8::gemm_phase<pg8::EpiDown, pg8::MoeOrder, true, true>(F.lds + RING_OFF, g, S, E);
    }
    SEAM(9);

    if (IN(10)) {
        PHASE_IDS
        build_tile_tables(F, tid);
        const LAS int* TB = (const LAS int*)(F.lds + LDSX_OFF);
        for (int t = gw; t < T; t += NGW) {
            const v4u rc = *((const GAS v4u*)ROUTE + t);
            const size_t r0 = (size_t)TB[rc.x >> 20] * 256 + (rc.x & 0xFFFFFu), r1 = (size_t)TB[rc.y >> 20] * 256 + (rc.y & 0xFFFFFu);
            GAS f32x4* xr = (GAS f32x4*)(X1 + (size_t)t * D) + lane; const GAS f32x4* gr = (const GAS f32x4*)final_g + lane;
            const GAS v2u* y0 = (const GAS v2u*)(Y + r0 * D) + lane; const GAS v2u* y1 = (const GAS v2u*)(Y + r1 * D) + lane;
            f32x4 v[4]; float s = 0.f;
#pragma unroll
            for (int j = 0; j < 4; ++j) { v[j] = xr[64 * j]; const v2u a = y0[64 * j], b = y1[64 * j];
                v[j].x += bflo(a.x) + bflo(b.x); v[j].y += bfhi(a.x) + bfhi(b.x); v[j].z += bflo(a.y) + bflo(b.y); v[j].w += bfhi(a.y) + bfhi(b.y);
                s += (v[j].x * v[j].x + v[j].y * v[j].y) + (v[j].z * v[j].z + v[j].w * v[j].w); }
            const float r = 1.f / sqrtf(wave_sum(s) * (1.f / D) + RMS_EPS);
#pragma unroll
            for (int j = 0; j < 4; ++j) { f32x4 o = v[j] * r * gr[64 * j];
                if (PROBE_B >= 0 && blockIdx.x == 0) {
                    const unsigned long long* ts = (const unsigned long long*)(F.ctl + CW_TS); const int nb = (int)((ts[PROBE_B + 1] - ts[PROBE_B]) / 100) * 67;
                    const int e0 = ((t / NGW) * NWAVES + wave) * D + 256 * j + 4 * lane;
                    o.x += (e0 < nb) ? 1.f : 0.f; o.y += (e0 + 1 < nb) ? 1.f : 0.f; o.z += (e0 + 2 < nb) ? 1.f : 0.f; o.w += (e0 + 3 < nb) ? 1.f : 0.f; }
                xr[64 * j] = o; }
        }
        STAMP(11);
        if (PROBE_A >= 0 && blockIdx.x == 0 && threadIdx.x == 0) {
            const unsigned long long* ts = (const unsigned long long*)(F.ctl + CW_TS);
            X1[0] += (float)((ts[PROBE_A + 1] - ts[PROBE_A]) / 100) * 0.25f; }
    }
#undef IN
#undef SEAM
#undef STAMP
#undef PHASE_IDS
#undef x_in
#undef mem_in
#undef norm_mix_g
#undef w_in
#undef pool_w
#undef pool_scale
#undef lam_q1
#undef lam_k1
#undef lam_q2
#undef lam_k2
#undef subln_g
#undef norm_mem_g
#undef w_mem_kv
#undef p_pool
#undef p_diff
#undef p_mem
#undef w_o
#undef norm_ffn_g
#undef w_rg
#undef b_rg
#undef w_re
#undef b_re
#undef w_eg
#undef w_eu
#undef w_ed
#undef final_g
#undef Win_t
#undef Pp_t
#undef Pm_t
#undef Pd_t
#undef Wo_t
#undef Wgu_t
#undef Wd_t
#undef KV
#undef XN
#undef BRP
#undef BRM
#undef BRD
#undef H2
#undef PROJ
#undef MERGED
#undef HID
#undef ATTO
#undef GATES
#undef XG
#undef Y
#undef ROUTE
#undef WROW
#undef X1
}

extern "C" void kernel_launch(void* const* d_in, const int* in_sizes, int n_in, void* d_out, int out_size, void* d_ws, size_t ws_size, hipStream_t stream) {
    static int grid = 0;
    if (grid == 0) {
        if (n_in != 26 || in_sizes[0] != T * D || out_size != T * D || ws_size < WS_END) { fprintf(stderr, "kernel_launch: unexpected problem: n_in %d in0 %d out %d ws %zu (need %zu)\n", n_in, n_in > 0 ? in_sizes[0] : -1, out_size, ws_size, (size_t)WS_END); grid = -1; return; }
        int dev = 0, cus = 0, per_cu = 0;
        if (hipGetDevice(&dev) != hipSuccess || hipDeviceGetAttribute(&cus, hipDeviceAttributeMultiprocessorCount, dev) != hipSuccess) { fprintf(stderr, "kernel_launch: device query failed\n"); grid = -1; return; }
        if (hipFuncSetAttribute((const void*)hybrid_fwd, hipFuncAttributeMaxDynamicSharedMemorySize, LDS_BYTES) != hipSuccess) { fprintf(stderr, "kernel_launch: hipFuncSetAttribute failed\n"); grid = -1; return; }
        if (hipOccupancyMaxActiveBlocksPerMultiprocessor(&per_cu, (const void*)hybrid_fwd, NWAVES * 64, LDS_BYTES) != hipSuccess || per_cu < 1) { fprintf(stderr, "kernel_launch: occupancy query says %d blocks per CU\n", per_cu); grid = -1; return; }
        (void)hipGetLastError();
        grid = cus;
        if (grid > 256) grid = 256;
    }
    if (grid < 0) return;
    if (hipMemsetAsync((char*)d_ws + WS_CTL, 0, CTL_ZERO_BYTES, stream) != hipSuccess) { fprintf(stderr, "kernel_launch: memset failed\n"); return; }
    Args a{};
    for (int i = 0; i < 26; ++i) a.in[i] = (const float*)d_in[i];
    a.out = (float*)d_out; a.ws = (unsigned char*)d_ws;
#if MK_N_LAUNCHES == 1
    a.ph_lo = 0; a.ph_hi = NPH;
    void* kargs[] = {&a};
    hipError_t e = hipLaunchCooperativeKernel((const void*)hybrid_fwd, dim3(grid), dim3(NWAVES * 64), kargs, LDS_BYTES, stream);
    if (e != hipSuccess) fprintf(stderr, "kernel_launch: cooperative launch failed: %s (grid %d)\n", hipGetErrorString(e), grid);
#else
    for (int p = 0; p < NPH; ++p) { a.ph_lo = p; a.ph_hi = p + 1;
        hipLaunchKernelGGL(hybrid_fwd, dim3(grid), dim3(NWAVES * 64), LDS_BYTES, stream, a);
        const hipError_t le = hipPeekAtLastError(); if (le != hipSuccess) { fprintf(stderr, "kernel_launch: launch %d failed: %s\n", p, hipGetErrorName(le)); break; } }
#endif
}
```

```cpp
#include <hip/hip_runtime.h>
#include <hip/hip_cooperative_groups.h>
#include <cstdio>
#include <cstdint>
namespace cg = cooperative_groups;
namespace pg8 {
#define PG8_LAS __attribute__((address_space(3)))
typedef unsigned short bf16_t;
typedef short bf16x8 __attribute__((ext_vector_type(8)));
typedef float f32x4 __attribute__((ext_vector_type(4)));
typedef unsigned u32x4 __attribute__((ext_vector_type(4)));
constexpr int BM = 256, BK = 64, HALF = 128, HTB = HALF * BK * 2  , STAGE_BYTES = 8 * HTB, NXCD = 8, WGM = 8;

__host__ __device__ __forceinline__ int lds_byte(int r, int c) { const int st = (r >> 4) * 2 + (c >> 5), rr = r & 15, cc = c & 31, ob = rr * 64 + cc * 2; return st * 1024 + (ob ^ (((ob >> 9) & 1) << 5)); }
__host__ __device__ __forceinline__ void stage_rc(int b, int& R, int& C) { const int st = b / 1024, sb = b % 1024, swz = sb ^ (((sb >> 9) & 1) << 5); R = (st >> 1) * 16 + swz / 64; C = (st & 1) * 32 + (swz % 64) / 2; }
__host__ __device__ __forceinline__ int perm32(int rho) { const int n = rho >> 4, i = rho & 15; return 8 * (i >> 2) + 4 * n + (i & 3); }

struct Unit { int pm, pn; };
struct Gemm { const bf16_t* A; const bf16_t* Bt; int M, N, K; };

struct StaticOrder {
    int nM, nN, nwg, G, c;
    __host__ __device__ void init(int M, int N, int G_, int c_) { nM = M / BM; nN = N / BM; nwg = nM * nN; G = G_; c = c_; }
    __host__ __device__ bool next(int i, Unit& u) const {
        const long L = (long)i * G + c; if (L >= nwg) return false;
        int wgid = (int)L; { const int q = nwg / NXCD, r = nwg % NXCD, xcd = wgid % NXCD, off = wgid / NXCD; wgid = (xcd < r ? xcd * (q + 1) : r * (q + 1) + (xcd - r) * q) + off; }
        const int nig = WGM * nN, gid = wgid / nig, fm = gid * WGM, gsz = (nM - fm) < WGM ? (nM - fm) : WGM;
        u.pm = fm + ((wgid % nig) % gsz); u.pn = (wgid % nig) / gsz; return true;
    }
    __device__ __forceinline__ void a_ready(const Unit&) const {}
    __device__ __forceinline__ void done(const Unit&) const {}
};

__device__ __forceinline__ unsigned cvt_pk_bf16(float lo, float hi) { unsigned r; asm volatile("v_cvt_pk_bf16_f32 %0, %1, %2" : "=v"(r) : "v"(lo), "v"(hi)); return r; }
typedef unsigned u32x2 __attribute__((ext_vector_type(2)));
__device__ __forceinline__ float bf_lo(unsigned w) { return __uint_as_float(w << 16); }
__device__ __forceinline__ float bf_hi(unsigned w) { return __uint_as_float(w & 0xffff0000u); }
__device__ __forceinline__ float sigmoid_f(float x) { return __builtin_amdgcn_rcpf(1.0f + __builtin_amdgcn_exp2f(-1.4426950408889634f * x)); }
__device__ __forceinline__ u32x4 pack8(const f32x4 a, const f32x4 b) { u32x4 w; w.x = cvt_pk_bf16(a[0], a[1]); w.y = cvt_pk_bf16(a[2], a[3]); w.z = cvt_pk_bf16(b[0], b[1]); w.w = cvt_pk_bf16(b[2], b[3]); return w; }

struct ProjOrder {
    StaticOrder so;
    __device__ __forceinline__ bool next(int i, Unit& u) const {
        const long L = (long)i * so.G + so.c;
        if (L < so.nwg) return so.next(i, u);
        const int x = (int)(L - so.nwg); if (x >= 64) return false;
        u.pm = 256 + (x >> 1); u.pn = 20 + (x & 1); return true;
    }
    __device__ __forceinline__ void a_ready(const Unit&) const {}
    __device__ __forceinline__ void done(const Unit&) const {}
};
struct MoeOrder {
    const PG8_LAS unsigned char* t2e; int nunits, G, c;
    __device__ __forceinline__ bool next(int i, Unit& u) const {
        const int L = i * G + c; if (L >= nunits) return false;
        const int pm = L >> 2; u.pm = pm; u.pn = (int)t2e[pm] * 4 + (L & 3); return true;
    }
    __device__ __forceinline__ void a_ready(const Unit&) const {}
    __device__ __forceinline__ void done(const Unit&) const {}
};

struct EpiProj {
    static constexpr bool PERM = true, AFTER_DRAIN = false;
    bf16_t* PROJ; bf16_t* GATES; bf16_t* KV; float qscale;
    __device__ __forceinline__ void operator()(const f32x4 (&acc)[2][2][4][2], const Unit& u, int wr, int wc, int fr, int fq) const {
        bf16_t* base; int ldc, colt, mode = 0; float sc = 1.f; int rowt = u.pm * BM;
        if (u.pm >= 256) { base = KV; ldc = 512; colt = (u.pn - 20) * BM; rowt -= 65536; }
        else if (u.pn < 8) { base = PROJ; ldc = 2048; colt = u.pn * BM; if (u.pn == 1 || u.pn == 2 || u.pn == 7) sc = qscale; }
        else { base = GATES; ldc = 3072; colt = (u.pn - 8) * BM; mode = 1; }
        const int row0 = rowt + wr * 64 + fr, col0 = colt + wc * 32 + 8 * fq;
#pragma unroll
        for (int ai = 0; ai < 2; ++ai)
#pragma unroll
            for (int m = 0; m < 4; ++m) { bf16_t* rowp = base + (size_t)(row0 + ai * HALF + m * 16) * ldc + col0;
#pragma unroll
                for (int bj = 0; bj < 2; ++bj) { f32x4 v0 = acc[ai][bj][m][0], v1 = acc[ai][bj][m][1];
                    if (mode) {
#pragma unroll
                        for (int i = 0; i < 4; ++i) { v0[i] = sigmoid_f(v0[i]); v1[i] = sigmoid_f(v1[i]); } }
                    else { v0 = v0 * sc; v1 = v1 * sc; }
                    *(u32x4*)(rowp + bj * HALF) = pack8(v0, v1); } }
    }
};
__device__ __forceinline__ float gclamp(float g) { return __builtin_fmaxf(g, 1e-18f); }
struct MidRescale {
    static constexpr bool ON = true; static constexpr int T0 = 4, T1 = 12;
    const bf16_t* GATES;
    __device__ __forceinline__ void operator()(f32x4 (&acc)[2][2][4][2], const Unit& u, int t, int wr, int wc, int fr, int fq) const {
        int fr_ = fr; asm volatile("" : "+v"(fr_));
        const int row0 = u.pm * BM + wr * 64 + fr_, col0 = u.pn * BM + wc * 32 + 8 * fq; const int gprev = (t == T0) ? 0 : 1024;
        const unsigned off0 = ((unsigned)row0 * 3072u + (unsigned)(gprev + col0)) * 2u;
#pragma unroll
        for (int ai = 0; ai < 2; ++ai) {
            u32x4 ga[4][2], gb[4][2];
#pragma unroll
            for (int m = 0; m < 4; ++m) { const char* gp = (const char*)GATES + (off0 + (unsigned)((ai * HALF + m * 16) * 3072 * 2));
#pragma unroll
                for (int bj = 0; bj < 2; ++bj) { ga[m][bj] = *(const u32x4*)(gp + bj * HALF * 2); gb[m][bj] = *(const u32x4*)(gp + 2048 + bj * HALF * 2); } }
#pragma unroll
            for (int m = 0; m < 4; ++m)
#pragma unroll
                for (int bj = 0; bj < 2; ++bj) { const u32x4 a = ga[m][bj], b = gb[m][bj];
                    f32x4 r0, r1;
                    r0[0] = bf_lo(a.x) * __builtin_amdgcn_rcpf(gclamp(bf_lo(b.x))); r0[1] = bf_hi(a.x) * __builtin_amdgcn_rcpf(gclamp(bf_hi(b.x)));
                    r0[2] = bf_lo(a.y) * __builtin_amdgcn_rcpf(gclamp(bf_lo(b.y))); r0[3] = bf_hi(a.y) * __builtin_amdgcn_rcpf(gclamp(bf_hi(b.y)));
                    r1[0] = bf_lo(a.z) * __builtin_amdgcn_rcpf(gclamp(bf_lo(b.z))); r1[1] = bf_hi(a.z) * __builtin_amdgcn_rcpf(gclamp(bf_hi(b.z)));
                    r1[2] = bf_lo(a.w) * __builtin_amdgcn_rcpf(gclamp(bf_lo(b.w))); r1[3] = bf_hi(a.w) * __builtin_amdgcn_rcpf(gclamp(bf_hi(b.w)));
                    acc[ai][bj][m][0] = acc[ai][bj][m][0] * r0; acc[ai][bj][m][1] = acc[ai][bj][m][1] * r1; }
            asm volatile("" ::: "memory"); }
    }
};
struct EpiMerge {
    static constexpr bool PERM = true, AFTER_DRAIN = false;
    const bf16_t* GATES; bf16_t* MERGED;
    __device__ __forceinline__ void operator()(const f32x4 (&acc)[2][2][4][2], const Unit& u, int wr, int wc, int fr, int fq) const {
        const int row0 = u.pm * BM + wr * 64 + fr, col0 = u.pn * BM + wc * 32 + 8 * fq;
        const unsigned off0 = ((unsigned)row0 * 3072u + (unsigned)(2048 + col0)) * 2u;
        u32x4 gg[2][4][2];
#pragma unroll
        for (int ai = 0; ai < 2; ++ai)
#pragma unroll
            for (int m = 0; m < 4; ++m)
#pragma unroll
                for (int bj = 0; bj < 2; ++bj) gg[ai][m][bj] = *(const u32x4*)((const char*)GATES + (off0 + (unsigned)((ai * HALF + m * 16) * 3072 * 2)) + bj * HALF * 2);
#pragma unroll
        for (int ai = 0; ai < 2; ++ai)
#pragma unroll
            for (int m = 0; m < 4; ++m) { const size_t r = (size_t)(row0 + ai * HALF + m * 16);
#pragma unroll
                for (int bj = 0; bj < 2; ++bj) { const int c = col0 + bj * HALF; const u32x4 g = gg[ai][m][bj];
                    f32x4 v0 = acc[ai][bj][m][0], v1 = acc[ai][bj][m][1];
                    v0[0] *= gclamp(bf_lo(g.x)); v0[1] *= gclamp(bf_hi(g.x)); v0[2] *= gclamp(bf_lo(g.y)); v0[3] *= gclamp(bf_hi(g.y));
                    v1[0] *= gclamp(bf_lo(g.z)); v1[1] *= gclamp(bf_hi(g.z)); v1[2] *= gclamp(bf_lo(g.w)); v1[3] *= gclamp(bf_hi(g.w));
                    *(u32x4*)(MERGED + r * 1024 + c) = pack8(v0, v1); } }
    }
};
struct EpiWo {
    static constexpr bool PERM = false, AFTER_DRAIN = false;
    const float* X; float* X1;
    __device__ __forceinline__ void operator()(const f32x4 (&acc)[2][2][4][2], const Unit& u, int wr, int wc, int fr, int fq) const {
        const int row0 = u.pm * BM + wr * 64 + fr, col0 = u.pn * BM + wc * 32 + 4 * fq;
#pragma unroll
        for (int ai = 0; ai < 2; ++ai)
#pragma unroll
            for (int m = 0; m < 4; ++m) { const size_t off = (size_t)(row0 + ai * HALF + m * 16) * 1024 + col0;
#pragma unroll
                for (int bj = 0; bj < 2; ++bj)
#pragma unroll
                    for (int n = 0; n < 2; ++n) { const size_t o = off + bj * HALF + n * 16; *(f32x4*)(X1 + o) = *(const f32x4*)(X + o) + acc[ai][bj][m][n]; } }
    }
};
struct EpiGateUp {
    static constexpr bool PERM = true, AFTER_DRAIN = false;
    bf16_t* HID; const float* RW;
    __device__ __forceinline__ void operator()(const f32x4 (&acc)[2][2][4][2], const Unit& u, int wr, int wc, int fr, int fq) const {
        const int row0 = u.pm * BM + wr * 64 + fr, colh = (u.pn & 3) * 128 + wc * 32 + 8 * fq;
#pragma unroll
        for (int ai = 0; ai < 2; ++ai)
#pragma unroll
            for (int m = 0; m < 4; ++m) { const size_t r = (size_t)(row0 + ai * HALF + m * 16); const float ri = RW[2 * r], w = RW[2 * r + 1];
                f32x4 h0, h1;
#pragma unroll
                for (int i = 0; i < 4; ++i) { const float g0 = acc[ai][0][m][0][i] * ri, g1 = acc[ai][0][m][1][i] * ri; const float wr_ = w * ri;
                    h0[i] = g0 * sigmoid_f(g0) * acc[ai][1][m][0][i] * wr_; h1[i] = g1 * sigmoid_f(g1) * acc[ai][1][m][1][i] * wr_; }
                *(u32x4*)(HID + r * 512 + colh) = pack8(h0, h1); }
    }
};
struct EpiDown {
    static constexpr bool PERM = true, AFTER_DRAIN = false;
    bf16_t* Y;
    __device__ __forceinline__ void operator()(const f32x4 (&acc)[2][2][4][2], const Unit& u, int wr, int wc, int fr, int fq) const {
        const int row0 = u.pm * BM + wr * 64 + fr, col0 = (u.pn & 3) * BM + wc * 32 + 8 * fq;
#pragma unroll
        for (int ai = 0; ai < 2; ++ai)
#pragma unroll
            for (int m = 0; m < 4; ++m) { bf16_t* rowp = Y + (size_t)(row0 + ai * HALF + m * 16) * 1024 + col0;
#pragma unroll
                for (int bj = 0; bj < 2; ++bj) *(u32x4*)(rowp + bj * HALF) = pack8(acc[ai][bj][m][0], acc[ai][bj][m][1]); }
    }
};

struct NoMid { static constexpr bool ON = false; static constexpr int T0 = -1, T1 = -1; __device__ __forceinline__ void operator()(f32x4 (&)[2][2][4][2], const Unit&, int, int, int, int, int) const {} };
template <class Epi, class Sched, bool ALIGN_EPI = false, bool SP2 = false, class Mid = NoMid>
__device__ __forceinline__ void gemm_phase(PG8_LAS unsigned char* lds, const Gemm g, const Sched& S, const Epi& E, const Mid& MH = Mid()) {
    int tid_ = threadIdx.x; asm volatile("" : "+v"(tid_));
    const int tid = tid_, wid = __builtin_amdgcn_readfirstlane(tid >> 6), lane = tid & 63, wr = wid >> 2, wc = wid & 3, fr = lane & 15, fq = lane >> 4;
    const int K = g.K, nt = K / BK;
    unsigned voffA[2], voffB[2];
#pragma unroll
    for (int i = 0; i < 2; ++i) { int R, C; stage_rc(tid * 16 + i * 8192, R, C); const int Rb = Epi::PERM ? ((R & ~31) + perm32(R & 31)) : R;
        voffA[i] = (unsigned)(R * K + C) * 2u; voffB[i] = (unsigned)(Rb * K + C) * 2u; }
    const size_t kstep = (size_t)(BK * 2);
    const size_t hstep = (size_t)HALF * K * 2;
    const size_t tstep = 2 * hstep;
    const unsigned ldsw = (unsigned)wid * 1024u;
    const int aoff = lds_byte(wr * 64 + fr, fq * 8), boff = lds_byte(wc * 32 + fr, fq * 8);
#define PG8_SA(b, h) (((b) * 2 + (h)) * HTB)
#define PG8_SB(b, h) ((4 + (b) * 2 + (h)) * HTB)
#define PG8_STAGE(bufoff, gbase, voff) do { _Pragma("unroll") for (int _i = 0; _i < 2; ++_i) \
        __builtin_amdgcn_global_load_lds((const unsigned*)((const char*)(gbase) + (voff)[_i]), (PG8_LAS unsigned*)(lds + (bufoff) + ldsw + _i * 8192), 16, 0, 0); } while (0)
#define PG8_LDA(dst, b, h) do { _Pragma("unroll") for (int m = 0; m < 4; ++m) _Pragma("unroll") for (int k = 0; k < 2; ++k) dst[m][k] = *(const PG8_LAS bf16x8*)(lds + PG8_SA(b, h) + aoff + m * 2048 + k * 1024); } while (0)
#define PG8_LDB(dst, b, h) do { _Pragma("unroll") for (int n = 0; n < 2; ++n) _Pragma("unroll") for (int k = 0; k < 2; ++k) dst[n][k] = *(const PG8_LAS bf16x8*)(lds + PG8_SB(b, h) + boff + n * 2048 + k * 1024); } while (0)
#define PG8_MMA(ai, bj, At, Bt) do { __builtin_amdgcn_s_setprio(1); _Pragma("unroll") for (int m = 0; m < 4; ++m) _Pragma("unroll") for (int n = 0; n < 2; ++n) _Pragma("unroll") for (int k = 0; k < 2; ++k) \
        acc[ai][bj][m][n] = __builtin_amdgcn_mfma_f32_16x16x32_bf16(Bt[n][k], At[m][k], acc[ai][bj][m][n], 0, 0, 0); __builtin_amdgcn_s_setprio(0); } while (0)
#define PG8_WAIT_V(n) asm volatile("s_waitcnt vmcnt(" #n ")" ::: "memory")
#define PG8_WAIT_L(n) asm volatile("s_waitcnt lgkmcnt(" #n ")" ::: "memory")
#define PG8_BAR __builtin_amdgcn_s_barrier()
#define PG8_SCHED __builtin_amdgcn_sched_barrier(0)
    Unit cur, nxt; int ui = 0;
    if (!S.next(0, cur)) return;
    f32x4 acc[2][2][4][2];
#pragma unroll
    for (int a = 0; a < 2; ++a)
#pragma unroll
        for (int b = 0; b < 2; ++b)
#pragma unroll
            for (int m = 0; m < 4; ++m)
#pragma unroll
                for (int n = 0; n < 2; ++n) acc[a][b][m][n] = (f32x4){0.f, 0.f, 0.f, 0.f};
    bf16x8 At[4][2], B0[2][2], B1[2][2];
    const char* cA = (const char*)g.A + (size_t)cur.pm * tstep; const char* cB = (const char*)g.Bt + (size_t)cur.pn * tstep;
    S.a_ready(cur);
    if constexpr (SP2) {
        PG8_STAGE(PG8_SB(0, 0), cB, voffB); PG8_STAGE(PG8_SB(0, 1), cB + hstep, voffB); PG8_STAGE(PG8_SA(0, 0), cA, voffA); PG8_STAGE(PG8_SA(0, 1), cA + hstep, voffA);
        if (wr == 1) PG8_BAR;
        PG8_WAIT_V(2); PG8_BAR;
        PG8_STAGE(PG8_SB(1, 0), cB + kstep, voffB); PG8_STAGE(PG8_SA(1, 0), cA + kstep, voffA); PG8_STAGE(PG8_SB(1, 1), cB + hstep + kstep, voffB);
        PG8_WAIT_V(6); PG8_BAR;
    } else {
        PG8_STAGE(PG8_SB(0, 0), cB, voffB); PG8_STAGE(PG8_SA(0, 0), cA, voffA); PG8_STAGE(PG8_SB(0, 1), cB + hstep, voffB); PG8_STAGE(PG8_SA(0, 1), cA + hstep, voffA);
        if (wr == 1) PG8_BAR;
        PG8_WAIT_V(4); PG8_BAR;
        PG8_STAGE(PG8_SB(1, 0), cB + kstep, voffB); PG8_STAGE(PG8_SA(1, 0), cA + kstep, voffA); PG8_STAGE(PG8_SB(1, 1), cB + hstep + kstep, voffB);
        PG8_WAIT_V(6); PG8_BAR;
    }
    for (;;) {
        const bool has_next = S.next(ui + 1, nxt);
        const char* nA = has_next ? (const char*)g.A + (size_t)nxt.pm * tstep : cA; const char* nB = has_next ? (const char*)g.Bt + (size_t)nxt.pn * tstep : cB;
        for (int t = 0; t < nt; t += 2) {
            if constexpr (Mid::ON) { if (t == Mid::T0 || t == Mid::T1) MH(acc, cur, t, wr, wc, fr, fq); }
            const bool last = (t == nt - 2);
            const char* a1 = cA + (size_t)(t + 1) * kstep;
            const char* a2 = last ? nA : cA + (size_t)(t + 2) * kstep; const char* b2 = last ? nB : cB + (size_t)(t + 2) * kstep;
            const char* a3 = a2 + kstep; const char* b3 = b2 + kstep;
            if (last && has_next) S.a_ready(nxt);
            if constexpr (SP2) {
            PG8_LDB(B0, 0, 0); PG8_LDB(B1, 0, 1); PG8_SCHED; PG8_LDA(At, 0, 0); PG8_STAGE(PG8_SA(1, 1), a1 + hstep, voffA);
            PG8_WAIT_V(8); PG8_WAIT_L(0); PG8_BAR; PG8_MMA(0, 0, At, B0); PG8_MMA(0, 1, At, B1); PG8_BAR; PG8_SCHED;
            PG8_LDA(At, 0, 1); PG8_STAGE(PG8_SB(0, 0), b2, voffB); PG8_STAGE(PG8_SB(0, 1), b2 + hstep, voffB); PG8_STAGE(PG8_SA(0, 0), a2, voffA);
            PG8_WAIT_V(8); PG8_WAIT_L(0); PG8_BAR; PG8_MMA(1, 0, At, B0); PG8_MMA(1, 1, At, B1); PG8_BAR; PG8_SCHED;
            PG8_LDB(B0, 1, 0); PG8_LDB(B1, 1, 1); PG8_SCHED; PG8_LDA(At, 1, 0); PG8_STAGE(PG8_SA(0, 1), a2 + hstep, voffA);
            PG8_WAIT_V(8); PG8_WAIT_L(0); PG8_BAR; PG8_MMA(0, 0, At, B0); PG8_MMA(0, 1, At, B1); PG8_BAR; PG8_SCHED;
            PG8_LDA(At, 1, 1); PG8_STAGE(PG8_SB(1, 0), b3, voffB); PG8_STAGE(PG8_SB(1, 1), b3 + hstep, voffB); PG8_STAGE(PG8_SA(1, 0), a3, voffA);
            PG8_WAIT_V(8); PG8_WAIT_L(0); PG8_BAR; PG8_MMA(1, 0, At, B0); PG8_MMA(1, 1, At, B1); PG8_BAR; PG8_SCHED;
            } else {
            PG8_LDB(B0, 0, 0); PG8_SCHED; PG8_LDA(At, 0, 0); PG8_STAGE(PG8_SA(1, 1), a1 + hstep, voffA);
            PG8_WAIT_L(8); PG8_BAR; PG8_WAIT_L(0); PG8_MMA(0, 0, At, B0); PG8_BAR; PG8_SCHED;
            PG8_LDB(B1, 0, 1); PG8_STAGE(PG8_SB(0, 0), b2, voffB);
            PG8_BAR; PG8_WAIT_L(0); PG8_MMA(0, 1, At, B1); PG8_BAR;
            PG8_LDA(At, 0, 1); PG8_STAGE(PG8_SA(0, 0), a2, voffA);
            PG8_BAR; PG8_WAIT_L(0); PG8_MMA(1, 0, At, B0); PG8_BAR; PG8_SCHED;
            PG8_STAGE(PG8_SB(0, 1), b2 + hstep, voffB);
            PG8_WAIT_V(6); PG8_BAR; PG8_MMA(1, 1, At, B1); PG8_BAR;
            PG8_LDB(B0, 1, 0); PG8_SCHED; PG8_LDA(At, 1, 0); PG8_STAGE(PG8_SA(0, 1), a2 + hstep, voffA);
            PG8_WAIT_L(8); PG8_BAR; PG8_WAIT_L(0); PG8_MMA(0, 0, At, B0); PG8_BAR; PG8_SCHED;
            PG8_LDB(B1, 1, 1); PG8_STAGE(PG8_SB(1, 0), b3, voffB);
            PG8_BAR; PG8_WAIT_L(0); PG8_MMA(0, 1, At, B1); PG8_BAR;
            PG8_LDA(At, 1, 1); PG8_STAGE(PG8_SA(1, 0), a3, voffA);
            PG8_BAR; PG8_WAIT_L(0); PG8_MMA(1, 0, At, B0); PG8_BAR; PG8_SCHED;
            PG8_STAGE(PG8_SB(1, 1), b3 + hstep, voffB);
            PG8_WAIT_V(6); PG8_BAR; PG8_MMA(1, 1, At, B1); PG8_BAR;
            }
        }
        if constexpr (ALIGN_EPI) { if (wr == 0) PG8_BAR; }
        if constexpr (!Epi::AFTER_DRAIN) { E(acc, cur, wr, wc, fr, fq); S.done(cur); }
        if (!has_next) break;
#pragma unroll
        for (int a = 0; a < 2; ++a)
#pragma unroll
            for (int b = 0; b < 2; ++b)
#pragma unroll
                for (int m = 0; m < 4; ++m)
#pragma unroll
                    for (int n = 0; n < 2; ++n) acc[a][b][m][n] = (f32x4){0.f, 0.f, 0.f, 0.f};
        cur = nxt; cA = nA; cB = nB; ++ui;
        if constexpr (ALIGN_EPI) { if (wr == 1) PG8_BAR; }
    }
    PG8_WAIT_V(0);
    if constexpr (!ALIGN_EPI) { if (wr == 0) PG8_BAR; }
    PG8_BAR;
    if constexpr (Epi::AFTER_DRAIN) { E.fused(acc, cur, wr, wc, fr, fq, lds, wid, lane); S.done(cur); }
#undef PG8_SA
#undef PG8_SB
#undef PG8_STAGE
#undef PG8_LDA
#undef PG8_LDB
#undef PG8_MMA
#undef PG8_WAIT_V
#undef PG8_WAIT_L
#undef PG8_BAR
#undef PG8_SCHED
}
}
#include <hip/hip_bf16.h>
#include <cmath>
namespace attn_body {
using bf16=__hip_bfloat16;
using bf16x8=__attribute__((ext_vector_type(8)))short;
using s16x4=__attribute__((ext_vector_type(4)))short;
using f32x16=__attribute__((ext_vector_type(16)))float;
using u32x4=__attribute__((ext_vector_type(4)))unsigned;
constexpr int D=64;
constexpr int NW=8,QBLK=32,QB=QBLK*NW,KVBLK=64;
constexpr int ATTN_UNIT_ROWS=QB;
__device__ __forceinline__ int crow(int r,int hi){return (r&3)+8*(r>>2)+4*hi;}
#define SBAR() __builtin_amdgcn_sched_barrier(0)
__device__ __forceinline__ void cmask(f32x16&p0,f32x16&p1,int jb,int qrel,int hi){
  const float NEG=-INFINITY; int kb=64*jb+4*hi;
  #pragma unroll
  for(int r=0;r<16;++r){int kv=kb+(r&3)+8*(r>>2); if(kv>qrel)p0[r]=NEG; if(kv+32>qrel)p1[r]=NEG;}
}

constexpr int NSLOT=3, SLOTB=8192;
constexpr int LDS_K=0, LDS_V=NSLOT*SLOTB, LDS_WS=2*NSLOT*SLOTB, LDS_OST=LDS_WS+NW*64*4, LDS_BYTES=LDS_OST+NW*4096;
constexpr float C2=0.125f*1.4426950408889634f;
__device__ __forceinline__ void glds16(const void*gsrc,unsigned lds_dst){unsigned keep;
  asm volatile("s_mov_b32 %0, m0\n\ts_mov_b32 m0, %2\n\ts_nop 0\n\tglobal_load_lds_dwordx4 %1, off\n\ts_mov_b32 m0, %0":"=&s"(keep):"v"(gsrc),"s"(lds_dst):"memory");}
__device__ __forceinline__ float max3f(float a,float b,float c){float r;asm("v_max3_f32 %0, %1, %2, %3":"=v"(r):"v"(a),"v"(b),"v"(c));return r;}
__device__ __forceinline__ float max2f(float a,float b){float r;asm("v_max_f32_e32 %0, %1, %2":"=v"(r):"v"(a),"v"(b));return r;}
__device__ __forceinline__ float fadd_s(float a,float b){float r;asm("v_add_f32_e32 %0, %1, %2":"=v"(r):"v"(a),"v"(b));return r;}
__device__ __forceinline__ float fsub_s(float a,float b){float r;asm("v_sub_f32_e32 %0, %1, %2":"=v"(r):"v"(a),"v"(b));return r;}
typedef float f32x2_t __attribute__((ext_vector_type(2))); typedef __bf16 bf16x2_t __attribute__((ext_vector_type(2)));
__device__ __forceinline__ unsigned cvtpk_s(float lo,float hi){f32x2_t v={lo,hi};bf16x2_t b=__builtin_convertvector(v,bf16x2_t);return __builtin_bit_cast(unsigned,b);}
#define WAIT_BAR(N) asm volatile("s_waitcnt vmcnt(" #N ") lgkmcnt(0)\n\ts_barrier":::"memory")

__device__ __forceinline__ void qkt(f32x16&p0,f32x16&p1,const char*Kslot,const bf16x8*qr,const f32x16&negm,int r32,int hi){
  const char*kb=Kslot+hi*1024+r32*16;
  #pragma unroll
  for(int d0=0;d0<4;++d0){
    const bf16x8 b0=*reinterpret_cast<const bf16x8*>(kb+d0*2048);
    const bf16x8 b1=*reinterpret_cast<const bf16x8*>(kb+d0*2048+512);
    if(d0==0){p0=__builtin_amdgcn_mfma_f32_32x32x16_bf16(b0,qr[0],negm,0,0,0);p1=__builtin_amdgcn_mfma_f32_32x32x16_bf16(b1,qr[0],negm,0,0,0);}
    else{p0=__builtin_amdgcn_mfma_f32_32x32x16_bf16(b0,qr[d0],p0,0,0,0);p1=__builtin_amdgcn_mfma_f32_32x32x16_bf16(b1,qr[d0],p1,0,0,0);}}
}
typedef __attribute__((address_space(3))) const char* lds_cptr;
typedef short v4i16_t __attribute__((ext_vector_type(4)));
__device__ __forceinline__ void kload8(bf16x8*kf,lds_cptr kp){
  kf[0]=*(const __attribute__((address_space(3))) bf16x8*)(kp);      kf[1]=*(const __attribute__((address_space(3))) bf16x8*)(kp+512);
  kf[2]=*(const __attribute__((address_space(3))) bf16x8*)(kp+2048); kf[3]=*(const __attribute__((address_space(3))) bf16x8*)(kp+2560);
  kf[4]=*(const __attribute__((address_space(3))) bf16x8*)(kp+4096); kf[5]=*(const __attribute__((address_space(3))) bf16x8*)(kp+4608);
  kf[6]=*(const __attribute__((address_space(3))) bf16x8*)(kp+6144); kf[7]=*(const __attribute__((address_space(3))) bf16x8*)(kp+6656);
}
__device__ __forceinline__ void kload2(bf16x8*kf,lds_cptr kp,int j){ kf[2*j]=*(const __attribute__((address_space(3))) bf16x8*)(kp+j*2048); kf[2*j+1]=*(const __attribute__((address_space(3))) bf16x8*)(kp+j*2048+512); }
__device__ __forceinline__ s16x4 vtr(lds_cptr p){ return __builtin_bit_cast(s16x4,__builtin_amdgcn_ds_read_tr16_b64_v4i16((__attribute__((address_space(3))) v4i16_t*)p)); }
__device__ __forceinline__ float rowmax(const f32x16&p0,const f32x16&p1){
  float a=max3f(p0[0],p0[1],p1[0]),b=max3f(p0[2],p0[3],p1[1]);a=max3f(a,p1[2],p1[3]);
  #pragma unroll
  for(int r=4;r<16;r+=4){a=max3f(a,p0[r],p0[r+1]);b=max3f(b,p0[r+2],p0[r+3]);a=max3f(a,p1[r],p1[r+1]);b=max3f(b,p1[r+2],p1[r+3]);}
  const float m=max2f(a,b);
  auto rr=__builtin_amdgcn_permlane32_swap(__float_as_uint(m),__float_as_uint(m),false,false);
  return max2f(__uint_as_float(rr[0]),__uint_as_float(rr[1]));
}
__device__ __forceinline__ void pv(f32x16*o,int vb,bf16x8 pa0,bf16x8 pa1,bf16x8 pa2,bf16x8 pa3){
  #pragma unroll
  for(int d0=0;d0<2;++d0){s16x4 lo[4],hi[4];
    #pragma unroll
    for(int ks=0;ks<4;++ks){
      asm volatile("ds_read_b64_tr_b16 %0,%1 offset:%c2":"=&v"(lo[ks]):"v"(vb),"i"(d0*4096+ks*1024):"memory");
      asm volatile("ds_read_b64_tr_b16 %0,%1 offset:%c2":"=&v"(hi[ks]):"v"(vb),"i"(d0*4096+ks*1024+512):"memory");}
    asm volatile("s_waitcnt lgkmcnt(0)":::"memory");SBAR();
    #define PK(k) (bf16x8){lo[k][0],lo[k][1],lo[k][2],lo[k][3],hi[k][0],hi[k][1],hi[k][2],hi[k][3]}
    o[d0]=__builtin_amdgcn_mfma_f32_32x32x16_bf16(pa0,PK(0),o[d0],0,0,0);
    o[d0]=__builtin_amdgcn_mfma_f32_32x32x16_bf16(pa1,PK(1),o[d0],0,0,0);
    o[d0]=__builtin_amdgcn_mfma_f32_32x32x16_bf16(pa2,PK(2),o[d0],0,0,0);
    o[d0]=__builtin_amdgcn_mfma_f32_32x32x16_bf16(pa3,PK(3),o[d0],0,0,0);
    #undef PK
  }
}

#ifndef ATTN_STORE16
#define ATTN_STORE16(p,v) (*(u32x4*)(p)=(v))
#endif
template<int THRL,bool CAUSAL> __device__ __forceinline__ void attn_unit(const bf16*Qu,const int pQ,const bf16*__restrict__ Kh,const bf16*__restrict__ Vh,const int pKV,bf16*Ou,const int pO,const int NT,char*shm){
  int tid_=threadIdx.x; asm volatile("":"+v"(tid_));
  const int tid=tid_,lane=tid&63,r32=lane&31,hi=lane>>5; const int wid=__builtin_amdgcn_readfirstlane(tid>>6);
  const bf16*Qw=Qu+(long)(wid*QBLK)*pQ;
  const unsigned lds0=(unsigned)(uintptr_t)shm;
  float*wsf=(float*)(shm+LDS_WS)+wid*64;
  const bf16*ksrc=Kh+(long)lane*pKV+wid*8;
  const bf16*vsrc=Vh+(long)(16*(wid&3)+(lane>>2))*pKV+(wid>>2)*32+(lane&3)*8;
  const unsigned kdst=lds0+LDS_K+wid*1024, vdst=lds0+LDS_V+wid*1024;
  #define DMA_K(t,slot) glds16(ksrc+(long)(t)*KVBLK*pKV,(unsigned)__builtin_amdgcn_readfirstlane(kdst+(slot)))
  #define DMA_V(t,slot) glds16(vsrc+(long)(t)*KVBLK*pKV,(unsigned)__builtin_amdgcn_readfirstlane(vdst+(slot)))
  const int vb0=(int)(lds0+LDS_V)+((lane>>4)&1)*32+(lane&3)*8+(4*hi+((lane&15)>>2))*64;
  const char*Kbase=shm+LDS_K; bf16x8 kf[8];
  const lds_cptr shm3=(lds_cptr)shm; const lds_cptr kp0=shm3+LDS_K+hi*1024+r32*16; const lds_cptr vp0=shm3+LDS_V+((lane>>4)&1)*32+(lane&3)*8+(4*hi+((lane&15)>>2))*64;
  DMA_K(0,0);DMA_V(0,0);DMA_K(1,SLOTB);
  bf16x8 qr[4];
  #pragma unroll
  for(int d0=0;d0<4;++d0)qr[d0]=*reinterpret_cast<const bf16x8*>(&Qw[(long)r32*pQ+d0*16+hi*8]);
  float mhat=0.f,l_reg=0.f;f32x16 o[2];o[0]=f32x16{};o[1]=f32x16{};const f32x16 negm=f32x16{};
  const int qrel=wid*QBLK+r32;
  #define CMASK(P0,P1,t) do{ if(CAUSAL){int jb_=(t)-(NT-4); if(jb_>=0)cmask(P0,P1,jb_,qrel,hi);} }while(0)
  bool resc=false;
  #define START(P0,P1) do{ const float rm=rowmax(P0,P1); resc=false; \
    { const float dl=rm; mhat=fadd_s(mhat,dl); \
      _Pragma("unroll") for(int r=0;r<16;++r){P0[r]=fsub_s(P0[r],dl);P1[r]=fsub_s(P1[r],dl);} \
      } \
    _Pragma("unroll") for(int r=0;r<16;++r)P0[r]=__builtin_amdgcn_exp2f(P0[r]); }while(0)
  #define RESC() do{ if(resc){ asm volatile("s_waitcnt lgkmcnt(0)":::"memory"); \
      _Pragma("unroll") for(int d_=0;d_<2;++d_) _Pragma("unroll") for(int r=0;r<16;++r)o[d_][r]*=wsf[crow(r,hi)]; } }while(0)
  f32x16 pA0,pA1,pB0,pB1;
  int sl_prev=0,sl_cur=0,sl_next=SLOTB;
  #define ROT() do{sl_prev=sl_cur;sl_cur=sl_next;sl_next=(sl_next==(NSLOT-1)*SLOTB)?0:sl_next+SLOTB;}while(0)
  DMA_K(2,2*SLOTB);
  WAIT_BAR(3);
  qkt(pA0,pA1,Kbase,qr,negm,r32,hi);asm volatile("s_nop 15\n\ts_nop 7":"+v"(pA0),"+v"(pA1));CMASK(pA0,pA1,0);
  START(pA0,pA1);
  _Pragma("unroll") for(int r=0;r<16;++r)pA1[r]=__builtin_amdgcn_exp2f(pA1[r]);
  WAIT_BAR(0);
  DMA_K(3,0);DMA_V(1,SLOTB);
  ROT();
  kload8(kf,kp0+sl_cur);
  WAIT_BAR(2);
  s16x4 vlo[8],vhi[8]; u32x4 pw0,pw1,pw2,pw3;
  #define PKW(P,B) cvtpk_s(P[B],P[B+1])
  #define PAF(k) __builtin_bit_cast(bf16x8,pw##k)
  #define VFR(i) (bf16x8){vlo[i][0],vlo[i][1],vlo[i][2],vlo[i][3],vhi[i][0],vhi[i][1],vhi[i][2],vhi[i][3]}
  #define PIN(x) asm volatile("":"+v"(x))
  #define MX3(a,b,c) __builtin_fmaxf(__builtin_fmaxf((a),(b)),(c))
  #define GAPA(MF,A0,A1,A2,A3,W0,W1,PW) do{ MF; sacc+=A0; sacc+=A1; sacc+=A2; sacc+=A3; PIN(sacc); W0; W1; PIN(PW); SBAR(); }while(0)
  #define EX(v) __builtin_amdgcn_exp2f(v)
  #define GAPB(MF,X,B) do{ MF; X[B]=EX(X[B]); X[B+1]=EX(X[B+1]); X[B+2]=EX(X[B+2]); X[B+3]=EX(X[B+3]); PIN(X); SBAR(); }while(0)
  #define VRD(i) do{ vlo[i]=vtr(vp_+(((i)>>2)*4096+((i)&3)*1024)); vhi[i]=vtr(vp_+(((i)>>2)*4096+((i)&3)*1024+512)); }while(0)
  #define KRD(G,j) do{ if(G){ kload2(kf,kp0+sl_next,j); SBAR(); } }while(0)
  #define STEP(C0,C1,P0,P1,t,GK,GV,GL) do{ SBAR(); \
    const lds_cptr vp_=vp0+sl_prev; \
    VRD(0); SBAR(); float sacc=(P0[0]+P0[1]); \
    GAPA(C0=__builtin_amdgcn_mfma_f32_32x32x16_bf16(kf[0],qr[0],negm,0,0,0), P0[2],P0[3],P0[4],P0[5],     pw0[0]=PKW(P0,0), pw0[1]=PKW(P0,2), pw0); \
    VRD(4); SBAR(); GAPA(C1=__builtin_amdgcn_mfma_f32_32x32x16_bf16(kf[1],qr[0],negm,0,0,0), P0[6],P0[7],P0[8],P0[9],     pw0[2]=PKW(P0,4), pw0[3]=PKW(P0,6), pw0); \
    VRD(1); SBAR(); GAPA(C0=__builtin_amdgcn_mfma_f32_32x32x16_bf16(kf[2],qr[1],C0,0,0,0),   P0[10],P0[11],P0[12],P0[13], pw1[0]=PKW(P0,8), pw1[1]=PKW(P0,10), pw1); \
    VRD(5); SBAR(); GAPA(C1=__builtin_amdgcn_mfma_f32_32x32x16_bf16(kf[3],qr[1],C1,0,0,0),   P0[14],P0[15],P1[0],P1[1],   pw1[2]=PKW(P0,12),pw1[3]=PKW(P0,14), pw1); \
    VRD(2); SBAR(); GAPA(C0=__builtin_amdgcn_mfma_f32_32x32x16_bf16(kf[4],qr[2],C0,0,0,0),   P1[2],P1[3],P1[4],P1[5],     pw2[0]=PKW(P1,0), pw2[1]=PKW(P1,2), pw2); \
    VRD(6); SBAR(); GAPA(C1=__builtin_amdgcn_mfma_f32_32x32x16_bf16(kf[5],qr[2],C1,0,0,0),   P1[6],P1[7],P1[8],P1[9],     pw2[2]=PKW(P1,4), pw2[3]=PKW(P1,6), pw2); \
    VRD(3); SBAR(); GAPA(C0=__builtin_amdgcn_mfma_f32_32x32x16_bf16(kf[6],qr[3],C0,0,0,0),   P1[10],P1[11],P1[12],P1[13], pw3[0]=PKW(P1,8), pw3[1]=PKW(P1,10), pw3); \
    VRD(7); SBAR(); GAPA(C1=__builtin_amdgcn_mfma_f32_32x32x16_bf16(kf[7],qr[3],C1,0,0,0),   P1[14],P1[15],0.f,0.f,       pw3[2]=PKW(P1,12),pw3[3]=PKW(P1,14), pw3); \
    l_reg+=sacc; \
    if(GK){DMA_K((t)+3,sl_cur);} if(GV){DMA_V((t)+1,sl_next);} \
    CMASK(C0,C1,t); \
    _Pragma("unroll") for(int r=0;r<16;++r){C0[r]-=mhat;C1[r]-=mhat;} \
    { float a=MX3(C0[0],C0[1],C1[0]),b=MX3(C0[2],C0[3],C1[1]); a=MX3(a,C1[2],C1[3]); \
      _Pragma("unroll") for(int r=4;r<16;r+=4){a=MX3(a,C0[r],C0[r+1]);b=MX3(b,C0[r+2],C0[r+3]);a=MX3(a,C1[r],C1[r+1]);b=MX3(b,C1[r+2],C1[r+3]);} \
      float rm=__builtin_fmaxf(a,b); { auto rr=__builtin_amdgcn_permlane32_swap(__float_as_uint(rm),__float_as_uint(rm),false,false); rm=__builtin_fmaxf(__uint_as_float(rr[0]),__uint_as_float(rr[1])); } \
      resc=false; \
      if(__builtin_expect(__any(rm>(float)THRL),0)){ const float dl=__builtin_fmaxf(rm,0.f); mhat+=dl; \
        _Pragma("unroll") for(int r=0;r<16;++r){C0[r]-=dl;C1[r]-=dl;} \
        const float f=__builtin_amdgcn_exp2f(-dl); l_reg*=f; if(hi==0)wsf[r32]=f; resc=true; } } \
    SBAR(); \
    GAPB(o[0]=__builtin_amdgcn_mfma_f32_32x32x16_bf16(PAF(0),VFR(0),o[0],0,0,0), C0,0); \
    GAPB(o[1]=__builtin_amdgcn_mfma_f32_32x32x16_bf16(PAF(0),VFR(4),o[1],0,0,0), C0,4); \
    KRD(GL,0); GAPB(o[0]=__builtin_amdgcn_mfma_f32_32x32x16_bf16(PAF(1),VFR(1),o[0],0,0,0), C0,8); \
    KRD(GL,1); GAPB(o[1]=__builtin_amdgcn_mfma_f32_32x32x16_bf16(PAF(1),VFR(5),o[1],0,0,0), C0,12); \
    KRD(GL,2); GAPB(o[0]=__builtin_amdgcn_mfma_f32_32x32x16_bf16(PAF(2),VFR(2),o[0],0,0,0), C1,0); \
    KRD(GL,3); GAPB(o[1]=__builtin_amdgcn_mfma_f32_32x32x16_bf16(PAF(2),VFR(6),o[1],0,0,0), C1,4); \
    GAPB(o[0]=__builtin_amdgcn_mfma_f32_32x32x16_bf16(PAF(3),VFR(3),o[0],0,0,0), C1,8); \
    GAPB(o[1]=__builtin_amdgcn_mfma_f32_32x32x16_bf16(PAF(3),VFR(7),o[1],0,0,0), C1,12); \
    }while(0)
  int t=1;
  #undef CMASK
  #define CMASK(P0,P1,t) do{}while(0)
  for(;t+5<NT;t+=2){
    STEP(pB0,pB1,pA0,pA1,t,true,true,true);     WAIT_BAR(2); RESC(); ROT();
    STEP(pA0,pA1,pB0,pB1,t+1,true,true,true);   WAIT_BAR(2); RESC(); ROT();
  }
  #undef CMASK
  #define CMASK(P0,P1,t) do{ if(CAUSAL){int jb_=(t)-(NT-4); if(jb_>=0)cmask(P0,P1,jb_,qrel,hi);} }while(0)
  #define ENDW(tt) do{ if((tt)+3<NT){WAIT_BAR(2);} else if((tt)+2<NT){WAIT_BAR(1);} else {WAIT_BAR(0);} }while(0)
  for(;t+1<NT;t+=2){
    STEP(pB0,pB1,pA0,pA1,t,(t+3<NT),(t+1<NT),(t+1<NT));       ENDW(t);   RESC(); ROT();
    STEP(pA0,pA1,pB0,pB1,t+1,(t+4<NT),(t+2<NT),(t+2<NT));     ENDW(t+1); RESC(); ROT();
  }
  STEP(pB0,pB1,pA0,pA1,NT-1,false,false,false); RESC();
  { float sacc=pB0[0]+pB0[1]; _Pragma("unroll") for(int r=2;r<16;++r)sacc+=pB0[r]; _Pragma("unroll") for(int r=0;r<16;++r)sacc+=pB1[r]; l_reg+=sacc;
    pw0=(u32x4){PKW(pB0,0),PKW(pB0,2),PKW(pB0,4),PKW(pB0,6)};pw1=(u32x4){PKW(pB0,8),PKW(pB0,10),PKW(pB0,12),PKW(pB0,14)};pw2=(u32x4){PKW(pB1,0),PKW(pB1,2),PKW(pB1,4),PKW(pB1,6)};pw3=(u32x4){PKW(pB1,8),PKW(pB1,10),PKW(pB1,12),PKW(pB1,14)};
    SBAR(); pv(o,vb0+sl_cur,PAF(0),PAF(1),PAF(2),PAF(3)); }
  #undef PKW
  #undef PAF
  #undef VFR
  #undef PIN
  #undef MX3
  #undef GAPA
  #undef GAPB
  #undef EX
  #undef VRD
  #undef KRD
  #undef STEP
  #undef ENDW
  {auto rr=__builtin_amdgcn_permlane32_swap(__float_as_uint(l_reg),__float_as_uint(l_reg),false,false);l_reg=__uint_as_float(rr[0])+__uint_as_float(rr[1]);}
  if(hi==0)wsf[32+r32]=l_reg;asm volatile("s_waitcnt lgkmcnt(0)":::"memory");
  float rli[16];
  #pragma unroll
  for(int r=0;r<16;++r)rli[r]=__builtin_amdgcn_rcpf(wsf[32+crow(r,hi)]);
  bf16*Ow=Ou+(long)(wid*QBLK)*pO;
  { bf16*stg=(bf16*)(shm+LDS_OST)+wid*2048;
    #pragma unroll
    for(int r=0;r<16;++r){const int orow=crow(r,hi);
      #pragma unroll
      for(int d0=0;d0<2;++d0)stg[orow*64+d0*32+r32]=__float2bfloat16(o[d0][r]*rli[r]);}
    asm volatile("s_waitcnt lgkmcnt(0)":::"memory");
    #pragma unroll
    for(int i=0;i<4;++i){const int row=i*8+(lane>>3),ch=lane&7; const u32x4 v=*(const u32x4*)(stg+row*64+ch*8); ATTN_STORE16(Ow+(long)row*pO+ch*8,v);} }
  asm volatile("s_waitcnt lgkmcnt(0)\n\ts_barrier":::"memory");
  #undef DMA_K
  #undef DMA_V
  #undef CMASK
  #undef START
  #undef RESC
  #undef ROT
}
constexpr int ATTN_LDS_BYTES=LDS_BYTES;
#undef SBAR
#undef WAIT_BAR
}
constexpr int NWAVES = 8;
#ifndef MK_N_LAUNCHES
#define MK_N_LAUNCHES 1
#endif
constexpr int NPH = 11;
constexpr int BATCH = 32, SEQ = 2048, D = 1024, T = BATCH * SEQ, NMEM = 256, TM = BATCH * NMEM;
constexpr int INCOLS = 5120, PROJW = 2048, GATEW = 3072;
constexpr float RMS_EPS = 1e-6f;
constexpr int NEXP = 16, EH = 512;
constexpr int MAXROWS = 2 * T + NEXP * 256;
constexpr size_t MiB = 1u << 20;
constexpr size_t WS_CTL = 0, CTL_ZERO_BYTES = 1 * MiB;
constexpr size_t WS_WRF = 1 * MiB;
constexpr size_t WS_RINV = 1 * MiB + 128 * 1024;
constexpr size_t WS_WIN = 2 * MiB;
constexpr size_t WS_PC = 13 * MiB;
constexpr size_t WS_WO = 15 * MiB;
constexpr size_t WS_WGU = 17 * MiB;
constexpr size_t WS_WD = 49 * MiB;
constexpr size_t WS_ROUTE = 65 * MiB;
constexpr size_t WS_RW = 66 * MiB;
constexpr size_t WS_KV = 68 * MiB;
constexpr size_t WS_XN = 76 * MiB;
constexpr size_t WS_BR = 76 * MiB;
constexpr size_t WS_H2 = 76 * MiB;
constexpr size_t WS_PROJ = 220 * MiB;
constexpr size_t WS_MERGED = 220 * MiB;
constexpr size_t WS_HID = 220 * MiB;
constexpr size_t WS_ATTO = 476 * MiB;
constexpr size_t WS_GATES = 604 * MiB;
constexpr size_t WS_XG = 604 * MiB;
constexpr size_t WS_Y = 604 * MiB;
constexpr size_t WS_END = 988 * MiB;
static_assert(WS_XN + (size_t)(T + TM) * D * 2 <= WS_PROJ && WS_PROJ + (size_t)T * PROJW * 2 <= WS_ATTO && WS_ATTO + (size_t)T * D * 2 <= WS_GATES && WS_GATES + (size_t)T * GATEW * 2 <= WS_END, "ws map");
static_assert(WS_XG + (size_t)MAXROWS * D * 2 <= WS_END && WS_HID + (size_t)MAXROWS * EH * 2 <= WS_ATTO && WS_RW + (size_t)MAXROWS * 8 <= WS_KV, "ws map 2");
constexpr int CW_CNT = 64;
constexpr int RING_OFF = 0, RING_BYTES = 131072;
constexpr int LDSX_OFF = RING_BYTES;
constexpr int LDS_BYTES = 147456;

#define GAS __attribute__((address_space(1)))
#define LAS __attribute__((address_space(3)))
typedef unsigned short bf16;
typedef unsigned v4u __attribute__((ext_vector_type(4)));
typedef unsigned v2u __attribute__((ext_vector_type(2)));
typedef float f32x4 __attribute__((ext_vector_type(4)));
#define LDS_WAIT() asm volatile("s_waitcnt lgkmcnt(0)" ::: "memory")
__device__ __forceinline__ unsigned f2bf(float f) { unsigned u = __builtin_bit_cast(unsigned, f); return (u + 0x7fffu + ((u >> 16) & 1u)) >> 16; }
__device__ __forceinline__ unsigned pk2(float lo, float hi) { return f2bf(lo) | (f2bf(hi) << 16); }
typedef float f32x2_t __attribute__((ext_vector_type(2))); typedef __bf16 bf16x2_t __attribute__((ext_vector_type(2)));
typedef short bf16x8_t __attribute__((ext_vector_type(8))); typedef float f32x16_t __attribute__((ext_vector_type(16)));
__device__ __forceinline__ unsigned cvtpk(float lo, float hi) { f32x2_t v = {lo, hi}; bf16x2_t b = __builtin_convertvector(v, bf16x2_t); return __builtin_bit_cast(unsigned, b); }
__device__ __forceinline__ float bflo(unsigned w) { return __uint_as_float(w << 16); }
__device__ __forceinline__ float bfhi(unsigned w) { return __uint_as_float(w & 0xffff0000u); }
__device__ __forceinline__ float wave_sum(float v) {
#pragma unroll
    for (int o = 1; o < 64; o <<= 1) v += __shfl_xor(v, o);
    return v;
}

typedef GAS unsigned gu32;
#define RLX_AGENT __ATOMIC_RELAXED, __HIP_MEMORY_SCOPE_AGENT
constexpr int CW_BAR = 4096;
constexpr int CW_TS = 128;
#define XB_TMO      128
#define XB_XCNT(j)  (256  + 64 * (j))
#define XB_XSUB(j)  (1280 + 64 * (j))
#define XB_XGEN(j)  (2304 + 64 * (j))
#define XB_TOP      3328
#define XB_TOPGEN   3392
#define XCD_BAR_WORDS 3456
#define XB_SPIN_CAP (1u << 18)

__device__ __forceinline__ unsigned xb_ld(unsigned* p)              { return __hip_atomic_load(p, __ATOMIC_RELAXED, __HIP_MEMORY_SCOPE_AGENT); }
__device__ __forceinline__ unsigned xb_add(unsigned* p, unsigned v) { return __hip_atomic_fetch_add(p, v, __ATOMIC_RELAXED, __HIP_MEMORY_SCOPE_AGENT); }
__device__ __forceinline__ unsigned xb_xcc_id() { return (unsigned)__builtin_amdgcn_s_getreg((3 << 11) | 20) & 0xFu; }
#define XB_SPIN(cond, bar) do { unsigned _sp = 0; while (cond) { __builtin_amdgcn_s_sleep(1); \
    if ((++_sp & 255u) == 0u) { if (xb_ld(&(bar)[XB_TMO])) break; if (_sp > XB_SPIN_CAP) { atomicAdd(&(bar)[XB_TMO], 1u); break; } } } } while (0)

struct XcdBarrier {
    unsigned* bar; unsigned x;
    volatile LAS unsigned* st;
};

__device__ __forceinline__ XcdBarrier xcd_barrier_post(unsigned* bar, volatile LAS unsigned* st) {
    XcdBarrier b; b.bar = bar; b.x = xb_xcc_id(); b.st = st;
    if (threadIdx.x == 0) (void)xb_add(&bar[XB_XCNT(b.x)], 1u);
    return b;
}
__device__ __forceinline__ void xcd_barrier_complete(unsigned* bar, unsigned x, unsigned& nloc, unsigned& nx) {
    const unsigned G = gridDim.x * gridDim.y * gridDim.z;
    unsigned sum, cnt, mine, sp = 0u;
    for (;;) {
        sum = 0u; cnt = 0u; mine = 0u;
#pragma unroll
        for (unsigned j = 0; j < 16; ++j) { const unsigned c = xb_ld(&bar[XB_XCNT(j)]); sum += c; cnt += (c > 0u) ? 1u : 0u; mine = (j == x) ? c : mine; }
        if (sum == G) break;
        __builtin_amdgcn_s_sleep(1);
        if ((++sp & 255u) == 0u) { if (xb_ld(&bar[XB_TMO])) break; if (sp > XB_SPIN_CAP) { atomicAdd(&bar[XB_TMO], 1u); break; } }
    }
    nloc = mine > 0u ? mine : 1u; nx = cnt > 0u ? cnt : 1u;
}

__device__ __forceinline__ void xcd_barrier(const XcdBarrier& b) {
    asm volatile("s_waitcnt vmcnt(0)" ::: "memory");
    __syncthreads();
    if (threadIdx.x == 0) {
        unsigned* bar = b.bar;
        __builtin_amdgcn_s_waitcnt(0);
        unsigned nloc = b.st[0], nx = b.st[1];
        if (nloc == 0u) { xcd_barrier_complete(bar, b.x, nloc, nx); b.st[0] = nloc; b.st[1] = nx; }
        const unsigned old = xb_add(&bar[XB_XSUB(b.x)], 1u);
        const unsigned gen = old / nloc;
        if (old + 1u == (gen + 1u) * nloc) {
            __builtin_amdgcn_fence(__ATOMIC_RELEASE, "agent");
            asm volatile("s_waitcnt vmcnt(0)" ::: "memory");
            const unsigned og = xb_add(&bar[XB_TOP], 1u);
            const unsigned tg = og / nx;
            if (og + 1u == (tg + 1u) * nx) xb_add(&bar[XB_TOPGEN], 1u);
            else XB_SPIN(xb_ld(&bar[XB_TOPGEN]) == tg, bar);
            __builtin_amdgcn_fence(__ATOMIC_ACQUIRE, "agent");
            xb_add(&bar[XB_XGEN(b.x)], 1u);
            asm volatile("s_waitcnt vmcnt(0)" ::: "memory");
        } else {
            XB_SPIN(xb_ld(&bar[XB_XGEN(b.x)]) == gen, bar);
            __builtin_amdgcn_fence(__ATOMIC_ACQUIRE, "agent");
            asm volatile("s_waitcnt vmcnt(0)" ::: "memory");
        }
    }
    __syncthreads();
}

struct Frame {
    LAS unsigned char* lds;
    unsigned* ctl;
    int vcu, G;
};

__device__ __forceinline__ void p0_tile(const float* W, int N, int k0, int n0, bf16* WT, int Kd, int drow0, LAS float* scr, int lane, const float* gk = nullptr) {
#pragma unroll 8
    for (int i = 0; i < 32; ++i) { const int kk = 2 * i + (lane >> 5); float w = W[(size_t)(k0 + kk) * N + n0 + (lane & 31)]; if (gk) w *= gk[k0 + kk]; scr[kk * 33 + (lane & 31)] = w; }
    LDS_WAIT(); asm volatile("" ::: "memory");
    const int c = lane & 7;
#pragma unroll
    for (int j = 0; j < 4; ++j) { const int n = (lane >> 3) + 8 * j; const LAS float* s = scr + (8 * c) * 33 + n;
        v4u o; o.x = pk2(s[0 * 33], s[1 * 33]); o.y = pk2(s[2 * 33], s[3 * 33]); o.z = pk2(s[4 * 33], s[5 * 33]); o.w = pk2(s[6 * 33], s[7 * 33]);
        *(GAS v4u*)(WT + (size_t)(drow0 + n) * Kd + k0 + 8 * c) = o; }
    LDS_WAIT(); asm volatile("" ::: "memory");
}
__device__ __forceinline__ void p0_plain(const float* W, int K, int N, bf16* WT, int row_off, int item, LAS float* scr, int lane) {
    const int nblk = N / 32, kb = item / nblk, nb = item % nblk;
    p0_tile(W, N, 64 * kb, 32 * nb, WT, K, row_off + 32 * nb, scr, lane);
}
__device__ __forceinline__ void rms_row_to_bf16(const float* xrow, const float* g, bf16* orow, int lane) {
    const GAS f32x4* xr = (const GAS f32x4*)xrow + lane; const GAS f32x4* gr = (const GAS f32x4*)g + lane;
    f32x4 v[4]; float s = 0.f;
#pragma unroll
    for (int j = 0; j < 4; ++j) { v[j] = xr[64 * j]; s += (v[j].x * v[j].x + v[j].y * v[j].y) + (v[j].z * v[j].z + v[j].w * v[j].w); }
    const float r = 1.f / sqrtf(wave_sum(s) * (1.f / D) + RMS_EPS);
    GAS unsigned long long* o8 = (GAS unsigned long long*)orow + lane;
#pragma unroll
    for (int j = 0; j < 4; ++j) { const f32x4 gg = gr[64 * j]; const f32x4 h = v[j] * r * gg;
        o8[64 * j] = (unsigned long long)pk2(h.x, h.y) | ((unsigned long long)pk2(h.z, h.w) << 32); }
}

__device__ __forceinline__ void build_tile_tables(Frame& F, const int tid) {
    LAS int* TB = (LAS int*)(F.lds + LDSX_OFF); LAS unsigned char* t2e = F.lds + LDSX_OFF + 128;
    __syncthreads();
    if (tid == 0) { int acc = 0;
        for (int e = 0; e < NEXP; ++e) { const int n = (int)__hip_atomic_load(F.ctl + CW_CNT + e, __ATOMIC_RELAXED, __HIP_MEMORY_SCOPE_AGENT); TB[e] = acc; acc += (n + 255) >> 8; }
        TB[NEXP] = acc; }
    __syncthreads();
    for (int t = tid; t < 1024; t += NWAVES * 64) { int e = 0;
#pragma unroll
        for (int k = 1; k < NEXP; ++k) e += (t >= TB[k]) ? 1 : 0;
        t2e[t] = (unsigned char)e; }
    __syncthreads();
}

struct Args { const float* in[26]; float* out; unsigned char* ws; int ph_lo, ph_hi; };

__global__ void __launch_bounds__(NWAVES * 64, 2) hybrid_fwd(Args args) {
    extern __shared__ __attribute__((aligned(16))) unsigned char lds[];
    __builtin_assume(__builtin_amdgcn_workitem_id_y() == 0); __builtin_assume(__builtin_amdgcn_workitem_id_z() == 0);
    Frame F;
    F.lds = (LAS unsigned char*)lds;
    F.G = gridDim.x; { const int bx = blockIdx.x; F.vcu = (F.G % 8 == 0) ? (bx % 8) * (F.G / 8) + bx / 8 : bx; }
    F.ctl = (unsigned*)(args.ws + WS_CTL);
#define x_in (args.in[0])
#define mem_in (args.in[1])
#define norm_mix_g (args.in[2])
#define w_in (args.in[3])
#define pool_w (args.in[4])
#define pool_scale (args.in[5])
#define lam_q1 (args.in[6])
#define lam_k1 (args.in[7])
#define lam_q2 (args.in[8])
#define lam_k2 (args.in[9])
#define subln_g (args.in[10])
#define norm_mem_g (args.in[11])
#define w_mem_kv (args.in[12])
#define p_pool (args.in[13])
#define p_diff (args.in[14])
#define p_mem (args.in[15])
#define w_o (args.in[16])
#define norm_ffn_g (args.in[17])
#define w_rg (args.in[18])
#define b_rg (args.in[19])
#define w_re (args.in[20])
#define b_re (args.in[21])
#define w_eg (args.in[22])
#define w_eu (args.in[23])
#define w_ed (args.in[24])
#define final_g (args.in[25])
#define Win_t ((bf16*)(args.ws + WS_WIN))
#define Pc_t ((bf16*)(args.ws + WS_PC))
#define Wo_t ((bf16*)(args.ws + WS_WO))
#define Wgu_t ((bf16*)(args.ws + WS_WGU))
#define Wd_t ((bf16*)(args.ws + WS_WD))
#define KV ((bf16*)(args.ws + WS_KV))
#define XN ((bf16*)(args.ws + WS_XN))
#define BR ((bf16*)(args.ws + WS_BR))
#define H2 ((bf16*)(args.ws + WS_H2))
#define PROJ ((bf16*)(args.ws + WS_PROJ))
#define MERGED ((bf16*)(args.ws + WS_MERGED))
#define HID ((bf16*)(args.ws + WS_HID))
#define ATTO ((bf16*)(args.ws + WS_ATTO))
#define GATES ((bf16*)(args.ws + WS_GATES))
#define XG ((bf16*)(args.ws + WS_XG))
#define Y ((bf16*)(args.ws + WS_Y))
#define ROUTE ((v4u*)(args.ws + WS_ROUTE))
#define RW ((float*)(args.ws + WS_RW))
#define WRF ((bf16*)(args.ws + WS_WRF))
#define RINV ((float*)(args.ws + WS_RINV))
#define X1 (args.out)
    const int NGW = F.G * NWAVES;
#define PHASE_IDS int tid = threadIdx.x; asm volatile("" : "+v"(tid)); const int lane = tid & 63, wave = __builtin_amdgcn_readfirstlane(tid >> 6), gw = F.vcu * NWAVES + wave; (void)lane; (void)gw;
    const int lo = args.ph_lo, hi = args.ph_hi;
    cg::grid_group grid = cg::this_grid();
#ifndef PH_MASK
#define PH_MASK 0x7ff
#endif
#define IN(k) (((PH_MASK >> (k)) & 1) && lo <= (k) && (k) < hi)
#ifndef PROBE_A
#define PROBE_A -1
#endif
#ifndef PROBE_B
#define PROBE_B -1
#endif
#define STAMP(k) do { if ((PROBE_A >= 0 || PROBE_B >= 0) && blockIdx.x == 0 && threadIdx.x == 0) ((unsigned long long*)(F.ctl + CW_TS))[k] = __builtin_amdgcn_s_memrealtime(); } while (0)
#define SEAM(k) do { if (IN(k) && IN((k) + 1)) { if ((k) == 0) grid.sync(); else { XcdBarrier b_; b_.bar = (unsigned*)(args.ws + WS_CTL) + CW_BAR; b_.x = xb_xcc_id(); b_.st = (volatile LAS unsigned*)(F.lds + LDSX_OFF + 2048); xcd_barrier(b_); } } STAMP((k) + 1); } while (0)
    if (threadIdx.x < 2) ((LAS unsigned*)(F.lds + LDSX_OFF + 2048))[threadIdx.x] = 0u;
    __syncthreads();
    if (lo < hi - 1) (void)xcd_barrier_post((unsigned*)(args.ws + WS_CTL) + CW_BAR, (volatile LAS unsigned*)(F.lds + LDSX_OFF + 2048));
    STAMP(0);

    if (IN(0)) {
        PHASE_IDS
        LAS float* scr = (LAS float*)(F.lds + RING_OFF + wave * 16384);
        constexpr int I_IN = 16 * 160, I_KV = 16 * 16, I_PD = 8 * 32, I_PM = 4 * 32, I_WO = 16 * 32, I_EG = 16 * 256, I_EU = 16 * 256, I_ED = 16 * 256;
        constexpr int NITEMS = I_IN + I_KV + I_PD + I_PM + I_WO + I_EG + I_EU + I_ED;
        for (int it = gw; it < NITEMS; it += NGW) {
            int r = it;
            if (r < I_IN) { p0_plain(w_in, D, INCOLS, Win_t, 0, r, scr, lane); continue; } r -= I_IN;
            if (r < I_KV) { p0_plain(w_mem_kv, D, 512, Win_t, INCOLS, r, scr, lane); continue; } r -= I_KV;
            if (r < I_PD) { const int kb = r >> 5, nb = r & 31; p0_tile(p_diff, D, 64 * kb, 32 * nb, Pc_t + 256, D, 32 * nb, scr, lane); continue; } r -= I_PD;
            if (r < I_PM) { const int kb = r >> 5, nb = r & 31; p0_tile(p_mem, D, 64 * kb, 32 * nb, Pc_t + 768, D, 32 * nb, scr, lane); continue; } r -= I_PM;
            if (r < I_WO) { p0_plain(w_o, D, D, Wo_t, 0, r, scr, lane); continue; } r -= I_WO;
            if (r < I_EG + I_EU) { const bool up = r >= I_EG; if (up) r -= I_EG;
                const int e = r >> 8, rr = r & 255, kb = rr >> 4, nb = rr & 15, n0 = 32 * nb;
                p0_tile((up ? w_eu : w_eg) + (size_t)e * D * EH, EH, 64 * kb, n0, Wgu_t + (size_t)e * D * D, D, (n0 >> 7) * 256 + (n0 & 127) + (up ? 128 : 0), scr, lane, norm_ffn_g); continue; }
            r -= I_EG + I_EU;
            { const int e = r >> 8, rr = r & 255, kb = rr >> 5, nb = rr & 31;
              p0_tile(w_ed + (size_t)e * EH * D, D, 64 * kb, 32 * nb, Wd_t + (size_t)e * D * EH, EH, 32 * nb, scr, lane); }
        }
        for (int idx = (F.vcu * NWAVES * 64 + tid); idx < 5120; idx += F.G * NWAVES * 64) {
            const int q = idx % 20, h = (idx / 20) & 1, hl = (idx / 40) & 1, st = idx / 80, k0 = 32 * (st >> 1) + 16 * h + 8 * (st & 1);
            float v[8];
#pragma unroll
            for (int j = 0; j < 8; ++j) { const int k = k0 + j; const float w = norm_ffn_g[k] * (q < 4 ? w_rg[k * 4 + q] : w_re[k * 16 + (q - 4)]); const float hi = bflo(f2bf(w) ); v[j] = hl ? (w - hi) : w; }
            v4u o; o.x = pk2(v[0], v[1]); o.y = pk2(v[2], v[3]); o.z = pk2(v[4], v[5]); o.w = pk2(v[6], v[7]);
            *((GAS v4u*)WRF + idx) = o;
        }
        for (int idx = (F.vcu * NWAVES * 64 + tid); idx < 256 * 1024; idx += F.G * NWAVES * 64) {
            const int kc = idx >> 10, n = idx & 1023, g = kc >> 6; float a = 0.f;
            for (int d = 0; d < 64; ++d) a += pool_w[kc * 64 + d] * pool_scale[g * 64 + d] * p_pool[(size_t)(g * 64 + d) * D + n];
            Pc_t[(size_t)n * D + kc] = (bf16)f2bf(a);
        }
        for (int m = gw; m < T + TM; m += NGW) {
            if (m < T) rms_row_to_bf16(x_in + (size_t)m * D, norm_mix_g, XN + (size_t)m * D, lane);
            else rms_row_to_bf16(mem_in + (size_t)(m - T) * D, norm_mem_g, XN + (size_t)m * D, lane);
        }
    }
    SEAM(0);

    if (IN(1)) {
        pg8::Gemm g{XN, Win_t, T, INCOLS, D};
        pg8::ProjOrder S; S.so.init(T, INCOLS, F.G, (int)blockIdx.x);
        pg8::EpiProj E{PROJ, GATES, KV, attn_body::C2};
        pg8::gemm_phase<pg8::EpiProj, pg8::ProjOrder, true, true>(F.lds + RING_OFF, g, S, E);
    }
    SEAM(1);

    if (IN(2)) {
        PHASE_IDS
        typedef attn_body::bf16 abf;
        struct DiffOrder { int vcu, G;
            __device__ __forceinline__ bool next(int i, int& bhm, int& vh, int& qb) const { bhm = vcu + (i >> 4) * G; if (bhm >= BATCH * 8) return false; vh = (i >> 3) & 1; const int k = i & 7; qb = (k & 1) ? (k >> 1) : 7 - (k >> 1); return true; } };
        struct MemOrder { int vcu, G;
            __device__ __forceinline__ bool next(int i, int& mu, int& qb) const { mu = vcu + (i >> 2) * G; if (mu >= BATCH * 8) return false; qb = (mu & 1) * 4 + (i & 3); return true; } };
        { const DiffOrder S{F.vcu, F.G}; int bhm, vh, qb;
          for (int i = 0; S.next(i, bhm, vh, qb); ++i) {
            const int b = bhm >> 3, h = (bhm >> 1) & 3, m = bhm & 1; const size_t rb = (size_t)b * SEQ;
            const abf* Qu = (const abf*)PROJ + (rb + qb * 256) * PROJW + 256 + h * 128 + m * 64;
            const abf* Kh = (const abf*)PROJ + rb * PROJW + 768 + h * 128 + m * 64;
            const abf* Vh = (const abf*)PROJ + rb * PROJW + 1280 + h * 128 + vh * 64;
            abf* Ou = (abf*)ATTO + (rb + qb * 256) * D + m * 512 + h * 128 + vh * 64;
            asm volatile("" : "+s"(Qu), "+s"(Kh), "+s"(Vh), "+s"(Ou));
            attn_body::attn_unit<8, true>(Qu, PROJW, Kh, Vh, PROJW, Ou, D, 4 * (qb + 1), (char*)lds + RING_OFF); } }
        { const MemOrder S{F.vcu, F.G}; int mu, qb;
          for (int i = 0; S.next(i, mu, qb); ++i) {
            const int b = mu >> 3, mh = (mu >> 1) & 3;
            const abf* Qu = (const abf*)PROJ + ((size_t)b * SEQ + qb * 256) * PROJW + 1792 + mh * 64;
            const abf* Kh = (const abf*)KV + (size_t)b * NMEM * 512 + mh * 64;
            const abf* Vh = (const abf*)KV + (size_t)b * NMEM * 512 + 256 + mh * 64;
            abf* Ou = (abf*)BR + ((size_t)b * SEQ + qb * 256) * D + 768 + mh * 64;
            asm volatile("" : "+s"(Qu), "+s"(Kh), "+s"(Vh), "+s"(Ou));
            attn_body::attn_unit<8, false>(Qu, PROJW, Kh, Vh, 512, Ou, D, 4, (char*)lds + RING_OFF); } }
    }
    SEAM(2);

    if (IN(3)) {
        PHASE_IDS
        float lam;
        { const float s1 = wave_sum(lam_q1[lane] * lam_k1[lane]), s2 = wave_sum(lam_q2[lane] * lam_k2[lane]); lam = __expf(s1) - __expf(s2) + 0.2f; }
        const int gi = lane >> 4, w = 2 << gi;
        float sg[8];
#pragma unroll
        for (int i = 0; i < 8; ++i) sg[i] = subln_g[((8 * lane) & 127) + i] * 0.8f;
        for (int t = gw; t < T; t += NGW) {
            const int s = t & (SEQ - 1);
            const GAS v2u* up = (const GAS v2u*)(PROJ + (size_t)t * PROJW) + lane;
            const v2u ut = up[0];
            float a0 = 0.f, a1 = 0.f, a2 = 0.f, a3 = 0.f;
            const int nw = (w < s + 1) ? w : s + 1;
            for (int j = 0; j < nw; ++j) { const v2u q = *(const GAS v2u*)((const GAS bf16*)up - (size_t)j * PROJW); a0 += bflo(q.x); a1 += bfhi(q.x); a2 += bflo(q.y); a3 += bfhi(q.y); }
            const float inv = 1.f / (float)nw;
            v2u po; po.x = pk2(a0 * inv - bflo(ut.x), a1 * inv - bfhi(ut.x)); po.y = pk2(a2 * inv - bflo(ut.y), a3 * inv - bfhi(ut.y));
            *((GAS v2u*)(BR + (size_t)t * D) + lane) = po;
            const v4u o0 = *((const GAS v4u*)(ATTO + (size_t)t * D) + lane), o1 = *((const GAS v4u*)(ATTO + (size_t)t * D + 512) + lane);
            float xv[8];
            xv[0] = bflo(o0.x) - lam * bflo(o1.x); xv[1] = bfhi(o0.x) - lam * bfhi(o1.x); xv[2] = bflo(o0.y) - lam * bflo(o1.y); xv[3] = bfhi(o0.y) - lam * bfhi(o1.y);
            xv[4] = bflo(o0.z) - lam * bflo(o1.z); xv[5] = bfhi(o0.z) - lam * bfhi(o1.z); xv[6] = bflo(o0.w) - lam * bflo(o1.w); xv[7] = bfhi(o0.w) - lam * bfhi(o1.w);
            float ss = 0.f;
#pragma unroll
            for (int i = 0; i < 8; ++i) ss += xv[i] * xv[i];
            ss += __shfl_xor(ss, 1); ss += __shfl_xor(ss, 2); ss += __shfl_xor(ss, 4); ss += __shfl_xor(ss, 8);
            const float r = 1.f / sqrtf(ss * (1.f / 128.f) + RMS_EPS);
            v4u od; od.x = pk2(xv[0] * r * sg[0], xv[1] * r * sg[1]); od.y = pk2(xv[2] * r * sg[2], xv[3] * r * sg[3]); od.z = pk2(xv[4] * r * sg[4], xv[5] * r * sg[5]); od.w = pk2(xv[6] * r * sg[6], xv[7] * r * sg[7]);
            *((GAS v4u*)(BR + (size_t)t * D + 256) + lane) = od;
        }
    }
    SEAM(3);

    if (IN(4)) {
        pg8::StaticOrder S; S.init(T, D, F.G, (int)blockIdx.x);
        pg8::Gemm g{BR, Pc_t, T, D, D}; pg8::EpiMerge E{GATES, MERGED}; pg8::MidRescale MH{GATES};
        pg8::gemm_phase<pg8::EpiMerge, pg8::StaticOrder, true, true, pg8::MidRescale>(F.lds + RING_OFF, g, S, E, MH);
    }
    SEAM(4);

    if (IN(5)) {
        pg8::Gemm g{MERGED, Wo_t, T, D, D}; pg8::StaticOrder S; S.init(T, D, F.G, (int)blockIdx.x);
        pg8::EpiWo E{x_in, X1};
        pg8::gemm_phase<pg8::EpiWo, pg8::StaticOrder, true, true>(F.lds + RING_OFF, g, S, E);
    }
    SEAM(5);

    if (IN(6)) {
        PHASE_IDS
        LAS v4u* WL = (LAS v4u*)(F.lds + RING_OFF);
        LAS float* SC = (LAS float*)(F.lds + RING_OFF + 81920) + wave * 1024;
        LAS v4u* REC = (LAS v4u*)(F.lds + RING_OFF + 81920 + 32768);
        LAS unsigned* LCNT = (LAS unsigned*)(F.lds + RING_OFF + 81920 + 32768 + 4096);
        LAS unsigned* LBASE = LCNT + 16;
        for (int idx = tid; idx < 5120; idx += NWAVES * 64) WL[idx] = *((const GAS v4u*)WRF + idx);
        float bg[4], be[16];
#pragma unroll
        for (int i = 0; i < 4; ++i) bg[i] = b_rg[i];
#pragma unroll
        for (int i = 0; i < 16; ++i) be[i] = b_re[i];
        const int r32 = lane & 31, hh = lane >> 5;
        for (int rb0 = F.vcu * 256; rb0 < T; rb0 += F.G * 256) {
            if (tid < 16) LCNT[tid] = 0u;
            __syncthreads();
            const int li = wave * 32 + r32, row = rb0 + li;
            const GAS f32x4* xp = (const GAS f32x4*)(X1 + (size_t)row * D + 16 * hh);
            GAS v4u* hp = (GAS v4u*)(H2 + (size_t)row * D + 16 * hh);
            const LAS v4u* wl = WL + hh * 20 + r32;
            f32x16_t acc = {}; float ss = 0.f;
            f32x4 cur[4];
#pragma unroll
            for (int i = 0; i < 4; ++i) cur[i] = xp[i];
#pragma unroll 2
            for (int sp = 0; sp < 32; ++sp) {
                f32x4 nxt[4];
                const int spn = (sp + 1 < 32) ? sp + 1 : sp;
#pragma unroll
                for (int i = 0; i < 4; ++i) nxt[i] = xp[spn * 8 + i];
                v4u ahi[2], alo[2];
#pragma unroll
                for (int e = 0; e < 2; ++e) { const f32x4 a = cur[2 * e], b = cur[2 * e + 1];
                    ss += (a.x * a.x + a.y * a.y) + (a.z * a.z + a.w * a.w) + (b.x * b.x + b.y * b.y) + (b.z * b.z + b.w * b.w);
                    v4u h; h.x = cvtpk(a.x, a.y); h.y = cvtpk(a.z, a.w); h.z = cvtpk(b.x, b.y); h.w = cvtpk(b.z, b.w); ahi[e] = h;
                    v4u l; l.x = cvtpk(a.x - bflo(h.x), a.y - bfhi(h.x)); l.y = cvtpk(a.z - bflo(h.y), a.w - bfhi(h.y)); l.z = cvtpk(b.x - bflo(h.z), b.y - bfhi(h.z)); l.w = cvtpk(b.z - bflo(h.w), b.w - bfhi(h.w)); alo[e] = l; }
                hp[sp * 4] = ahi[0]; hp[sp * 4 + 1] = ahi[1];
#pragma unroll
                for (int e = 0; e < 2; ++e) { const int st = 2 * sp + e;
                    v4u bh = {0u, 0u, 0u, 0u}, bl = {0u, 0u, 0u, 0u};
                    if (r32 < 20) { bh = wl[(st * 4) * 20]; bl = wl[(st * 4 + 2) * 20]; }
                    acc = __builtin_amdgcn_mfma_f32_32x32x16_bf16(__builtin_bit_cast(bf16x8_t, ahi[e]), __builtin_bit_cast(bf16x8_t, bh), acc, 0, 0, 0);
                    acc = __builtin_amdgcn_mfma_f32_32x32x16_bf16(__builtin_bit_cast(bf16x8_t, alo[e]), __builtin_bit_cast(bf16x8_t, bh), acc, 0, 0, 0);
                    acc = __builtin_amdgcn_mfma_f32_32x32x16_bf16(__builtin_bit_cast(bf16x8_t, ahi[e]), __builtin_bit_cast(bf16x8_t, bl), acc, 0, 0, 0); }
#pragma unroll
                for (int i = 0; i < 4; ++i) cur[i] = nxt[i];
            }
            ss += __shfl_xor(ss, 32);
            const float rinv = 1.f / sqrtf(ss * (1.f / D) + RMS_EPS);
#pragma unroll
            for (int r = 0; r < 16; ++r) SC[((r & 3) + 8 * (r >> 2) + 4 * hh) * 32 + r32] = acc[r];
            LDS_WAIT();
            if (lane < 32) {
                float lg[20];
#pragma unroll
                for (int q4 = 0; q4 < 5; ++q4) { const f32x4 t4 = *(const LAS f32x4*)(SC + lane * 32 + 4 * q4); lg[4 * q4] = t4.x * rinv; lg[4 * q4 + 1] = t4.y * rinv; lg[4 * q4 + 2] = t4.z * rinv; lg[4 * q4 + 3] = t4.w * rinv; }
                float gl[4];
#pragma unroll
                for (int i = 0; i < 4; ++i) gl[i] = lg[i] + bg[i];
                int gidx = 0; float gmax = gl[0];
#pragma unroll
                for (int i = 1; i < 4; ++i) if (gl[i] > gmax) { gmax = gl[i]; gidx = i; }
                float gsum = 0.f;
#pragma unroll
                for (int i = 0; i < 4; ++i) gsum += __expf(gl[i] - gmax);
                const float gp = 1.f / gsum;
                float el[4];
#pragma unroll
                for (int j = 0; j < 4; ++j) { const float l0 = lg[4 + j] + be[j], l1 = lg[8 + j] + be[4 + j], l2 = lg[12 + j] + be[8 + j], l3 = lg[16 + j] + be[12 + j];
                    el[j] = gidx == 0 ? l0 : gidx == 1 ? l1 : gidx == 2 ? l2 : l3; }
                int i0 = 0; float m0 = el[0];
#pragma unroll
                for (int j = 1; j < 4; ++j) if (el[j] > m0) { m0 = el[j]; i0 = j; }
                int i1 = -1; float m1 = -3.0e38f;
#pragma unroll
                for (int j = 0; j < 4; ++j) if (j != i0 && el[j] > m1) { m1 = el[j]; i1 = j; }
                if (i1 < 0) { i1 = (i0 + 1) & 3; m1 = m0; }
                const float p1 = __expf(m1 - m0);
                const float w0 = gp / (1.f + p1), w1 = gp * p1 / (1.f + p1);
                const unsigned e0 = (unsigned)(gidx * 4 + i0), e1 = (unsigned)(gidx * 4 + i1);
                const unsigned s0 = __hip_atomic_fetch_add(LCNT + e0, 1u, __ATOMIC_RELAXED, __HIP_MEMORY_SCOPE_WORKGROUP), s1 = __hip_atomic_fetch_add(LCNT + e1, 1u, __ATOMIC_RELAXED, __HIP_MEMORY_SCOPE_WORKGROUP);
                v4u rc; rc.x = (e0 << 20) | s0; rc.y = (e1 << 20) | s1; rc.z = __float_as_uint(w0); rc.w = __float_as_uint(w1); REC[li] = rc;
                RINV[row] = rinv;
            }
            __syncthreads();
            if (tid < 16) LBASE[tid] = __hip_atomic_fetch_add(F.ctl + CW_CNT + tid, LCNT[tid], __ATOMIC_RELAXED, __HIP_MEMORY_SCOPE_AGENT);
            __syncthreads();
            if (tid < 256) { v4u rc = REC[tid]; rc.x += LBASE[rc.x >> 20]; rc.y += LBASE[rc.y >> 20]; *((GAS v4u*)ROUTE + rb0 + tid) = rc; }
            __syncthreads();
        }
    }
    SEAM(6);

    if (IN(7)) {
        PHASE_IDS
        build_tile_tables(F, tid);
        const LAS int* TB = (const LAS int*)(F.lds + LDSX_OFF);
        for (int t = gw; t < T; t += NGW) {
            const v4u rc = *((const GAS v4u*)ROUTE + t);
            const size_t r0 = (size_t)TB[rc.x >> 20] * 256 + (rc.x & 0xFFFFFu), r1 = (size_t)TB[rc.y >> 20] * 256 + (rc.y & 0xFFFFFu);
            const GAS v4u* src = (const GAS v4u*)(H2 + (size_t)t * D) + lane; const v4u a = src[0], b = src[64];
            GAS v4u* d0 = (GAS v4u*)(XG + r0 * D) + lane; GAS v4u* d1 = (GAS v4u*)(XG + r1 * D) + lane;
            d0[0] = a; d0[64] = b; d1[0] = a; d1[64] = b;
            if (lane == 0) { const float ri = RINV[t]; RW[2 * r0] = ri; RW[2 * r0 + 1] = __uint_as_float(rc.z); RW[2 * r1] = ri; RW[2 * r1 + 1] = __uint_as_float(rc.w); }
        }
    }
    SEAM(7);

    if (IN(8)) {
        PHASE_IDS
        build_tile_tables(F, tid);
        const LAS int* TB = (const LAS int*)(F.lds + LDSX_OFF);
        pg8::Gemm g{XG, Wgu_t, MAXROWS, NEXP * D, D};
        pg8::MoeOrder S{(const LAS unsigned char*)(F.lds + LDSX_OFF + 128), TB[NEXP] * 4, F.G, F.vcu};
        pg8::EpiGateUp E{HID, RW};
        pg8::gemm_phase<pg8::EpiGateUp, pg8::MoeOrder, true, true>(F.lds + RING_OFF, g, S, E);
    }
    SEAM(8);

    if (IN(9)) {
        PHASE_IDS
        build_tile_tables(F, tid);
        const LAS int* TB = (const LAS int*)(F.lds + LDSX_OFF);
        pg8::Gemm g{HID, Wd_t, MAXROWS, NEXP * D, EH};
        pg8::MoeOrder S{(const LAS unsigned char*)(F.lds + LDSX_OFF + 128), TB[NEXP] * 4, F.G, F.vcu};
        pg8::EpiDown E{Y};
        pg8::gemm_phase<pg8::EpiDown, pg8::MoeOrder, true, true>(F.lds + RING_OFF, g, S, E);
    }
    SEAM(9);

    if (IN(10)) {
        PHASE_IDS
        build_tile_tables(F, tid);
        const LAS int* TB = (const LAS int*)(F.lds + LDSX_OFF);
        for (int t = gw; t < T; t += NGW) {
            const v4u rc = *((const GAS v4u*)ROUTE + t);
            const size_t r0 = (size_t)TB[rc.x >> 20] * 256 + (rc.x & 0xFFFFFu), r1 = (size_t)TB[rc.y >> 20] * 256 + (rc.y & 0xFFFFFu);
            GAS f32x4* xr = (GAS f32x4*)(X1 + (size_t)t * D) + lane; const GAS f32x4* gr = (const GAS f32x4*)final_g + lane;
            const GAS v2u* y0 = (const GAS v2u*)(Y + r0 * D) + lane; const GAS v2u* y1 = (const GAS v2u*)(Y + r1 * D) + lane;
            f32x4 v[4]; float s = 0.f;
#pragma unroll
            for (int j = 0; j < 4; ++j) { v[j] = xr[64 * j]; const v2u a = y0[64 * j], b = y1[64 * j];
                v[j].x += bflo(a.x) + bflo(b.x); v[j].y += bfhi(a.x) + bfhi(b.x); v[j].z += bflo(a.y) + bflo(b.y); v[j].w += bfhi(a.y) + bfhi(b.y);
                s += (v[j].x * v[j].x + v[j].y * v[j].y) + (v[j].z * v[j].z + v[j].w * v[j].w); }
            const float r = 1.f / sqrtf(wave_sum(s) * (1.f / D) + RMS_EPS);
#pragma unroll
            for (int j = 0; j < 4; ++j) { f32x4 o = v[j] * r * gr[64 * j];
                if (PROBE_B >= 0 && blockIdx.x == 0 && (t / NGW) < 8) {
                    const unsigned long long* ts = (const unsigned long long*)(F.ctl + CW_TS); const float amp = sqrtf((float)((ts[PROBE_B + 1] - ts[PROBE_B]) / 100) * 1e-3f);
                    o.x += amp; o.y += amp; o.z += amp; o.w += amp; }
                xr[64 * j] = o; }
        }
        STAMP(11);
        if (PROBE_A >= 0 && blockIdx.x == 0 && threadIdx.x == 0) {
            const unsigned long long* ts = (const unsigned long long*)(F.ctl + CW_TS);
            X1[0] += 4.f + (float)((ts[PROBE_A + 1] - ts[PROBE_A]) / 100) * 0.01f; }
    }
#undef IN
#undef SEAM
#undef STAMP
#undef PHASE_IDS
#undef x_in
#undef mem_in
#undef norm_mix_g
#undef w_in
#undef pool_w
#undef pool_scale
#undef lam_q1
#undef lam_k1
#undef lam_q2
#undef lam_k2
#undef subln_g
#undef norm_mem_g
#undef w_mem_kv
#undef p_pool
#undef p_diff
#undef p_mem
#undef w_o
#undef norm_ffn_g
#undef w_rg
#undef b_rg
#undef w_re
#undef b_re
#undef w_eg
#undef w_eu
#undef w_ed
#undef final_g
#undef Win_t
#undef Pc_t
#undef Wo_t
#undef Wgu_t
#undef Wd_t
#undef KV
#undef XN
#undef BR
#undef H2
#undef PROJ
#undef MERGED
#undef HID
#undef ATTO
#undef GATES
#undef XG
#undef Y
#undef ROUTE
#undef RW
#undef WRF
#undef RINV
#undef X1
}

extern "C" void kernel_launch(void* const* d_in, const int* in_sizes, int n_in, void* d_out, int out_size, void* d_ws, size_t ws_size, hipStream_t stream) {
    static int grid = 0;
    if (grid == 0) {
        if (n_in != 26 || in_sizes[0] != T * D || out_size != T * D || ws_size < WS_END) { fprintf(stderr, "kernel_launch: unexpected problem: n_in %d in0 %d out %d ws %zu (need %zu)\n", n_in, n_in > 0 ? in_sizes[0] : -1, out_size, ws_size, (size_t)WS_END); grid = -1; return; }
        int dev = 0, cus = 0, per_cu = 0;
        if (hipGetDevice(&dev) != hipSuccess || hipDeviceGetAttribute(&cus, hipDeviceAttributeMultiprocessorCount, dev) != hipSuccess) { fprintf(stderr, "kernel_launch: device query failed\n"); grid = -1; return; }
        if (hipFuncSetAttribute((const void*)hybrid_fwd, hipFuncAttributeMaxDynamicSharedMemorySize, LDS_BYTES) != hipSuccess) { fprintf(stderr, "kernel_launch: hipFuncSetAttribute failed\n"); grid = -1; return; }
        if (hipOccupancyMaxActiveBlocksPerMultiprocessor(&per_cu, (const void*)hybrid_fwd, NWAVES * 64, LDS_BYTES) != hipSuccess || per_cu < 1) { fprintf(stderr, "kernel_launch: occupancy query says %d blocks per CU\n", per_cu); grid = -1; return; }
        (void)hipGetLastError();
        grid = cus;
        if (grid > 256) grid = 256;
    }
    if (grid < 0) return;
    if (hipMemsetAsync((char*)d_ws + WS_CTL, 0, CTL_ZERO_BYTES, stream) != hipSuccess) { fprintf(stderr, "kernel_launch: memset failed\n"); return; }
    Args a{};
    for (int i = 0; i < 26; ++i) a.in[i] = (const float*)d_in[i];
    a.out = (float*)d_out; a.ws = (unsigned char*)d_ws;
#if MK_N_LAUNCHES == 1
    a.ph_lo = 0; a.ph_hi = NPH;
    void* kargs[] = {&a};
    hipError_t e = hipLaunchCooperativeKernel((const void*)hybrid_fwd, dim3(grid), dim3(NWAVES * 64), kargs, LDS_BYTES, stream);
    if (e != hipSuccess) fprintf(stderr, "kernel_launch: cooperative launch failed: %s (grid %d)\n", hipGetErrorString(e), grid);
#else
    for (int p = 0; p < NPH; ++p) { a.ph_lo = p; a.ph_hi = p + 1;
        hipLaunchKernelGGL(hybrid_fwd, dim3(grid), dim3(NWAVES * 64), LDS_BYTES, stream, a);
        const hipError_t le = hipPeekAtLastError(); if (le != hipSuccess) { fprintf(stderr, "kernel_launch: launch %d failed: %s\n", p, hipGetErrorName(le)); break; } }
#endif
}
```

```cpp
#include <hip/hip_runtime.h>
#include <hip/hip_cooperative_groups.h>
#include <cstdio>
#include <cstdint>
namespace cg = cooperative_groups;
namespace pg8 {
#define PG8_LAS __attribute__((address_space(3)))
typedef unsigned short bf16_t;
typedef short bf16x8 __attribute__((ext_vector_type(8)));
typedef float f32x4 __attribute__((ext_vector_type(4)));
typedef unsigned u32x4 __attribute__((ext_vector_type(4)));
constexpr int BM = 256, BK = 64, HALF = 128, HTB = HALF * BK * 2  , STAGE_BYTES = 8 * HTB, NXCD = 8, WGM = 8;

__host__ __device__ __forceinline__ int lds_byte(int r, int c) { const int st = (r >> 4) * 2 + (c >> 5), rr = r & 15, cc = c & 31, ob = rr * 64 + cc * 2; return st * 1024 + (ob ^ (((ob >> 9) & 1) << 5)); }
__host__ __device__ __forceinline__ void stage_rc(int b, int& R, int& C) { const int st = b / 1024, sb = b % 1024, swz = sb ^ (((sb >> 9) & 1) << 5); R = (st >> 1) * 16 + swz / 64; C = (st & 1) * 32 + (swz % 64) / 2; }
__host__ __device__ __forceinline__ int perm32(int rho) { const int n = rho >> 4, i = rho & 15; return 8 * (i >> 2) + 4 * n + (i & 3); }

struct Unit { int pm, pn; };
struct Gemm { const bf16_t* A; const bf16_t* Bt; int M, N, K; };

struct StaticOrder {
    int nM, nN, nwg, G, c;
    __host__ __device__ void init(int M, int N, int G_, int c_) { nM = M / BM; nN = N / BM; nwg = nM * nN; G = G_; c = c_; }
    __host__ __device__ bool next(int i, Unit& u) const {
        const long L = (long)i * G + c; if (L >= nwg) return false;
        int wgid = (int)L; { const int q = nwg / NXCD, r = nwg % NXCD, xcd = wgid % NXCD, off = wgid / NXCD; wgid = (xcd < r ? xcd * (q + 1) : r * (q + 1) + (xcd - r) * q) + off; }
        const int nig = WGM * nN, gid = wgid / nig, fm = gid * WGM, gsz = (nM - fm) < WGM ? (nM - fm) : WGM;
        u.pm = fm + ((wgid % nig) % gsz); u.pn = (wgid % nig) / gsz; return true;
    }
    __device__ __forceinline__ void a_ready(const Unit&) const {}
    __device__ __forceinline__ void done(const Unit&) const {}
};

__device__ __forceinline__ unsigned cvt_pk_bf16(float lo, float hi) { unsigned r; asm volatile("v_cvt_pk_bf16_f32 %0, %1, %2" : "=v"(r) : "v"(lo), "v"(hi)); return r; }
typedef unsigned u32x2 __attribute__((ext_vector_type(2)));
__device__ __forceinline__ float bf_lo(unsigned w) { return __uint_as_float(w << 16); }
__device__ __forceinline__ float bf_hi(unsigned w) { return __uint_as_float(w & 0xffff0000u); }
__device__ __forceinline__ float sigmoid_f(float x) { return __builtin_amdgcn_rcpf(1.0f + __builtin_amdgcn_exp2f(-1.4426950408889634f * x)); }
__device__ __forceinline__ u32x4 pack8(const f32x4 a, const f32x4 b) { u32x4 w; w.x = cvt_pk_bf16(a[0], a[1]); w.y = cvt_pk_bf16(a[2], a[3]); w.z = cvt_pk_bf16(b[0], b[1]); w.w = cvt_pk_bf16(b[2], b[3]); return w; }

struct ProjOrder {
    StaticOrder so;
    __device__ __forceinline__ bool next(int i, Unit& u) const {
        const long L = (long)i * so.G + so.c;
        if (L < so.nwg) return so.next(i, u);
        const int x = (int)(L - so.nwg); if (x >= 64) return false;
        u.pm = 256 + (x >> 1); u.pn = 20 + (x & 1); return true;
    }
    __device__ __forceinline__ void a_ready(const Unit&) const {}
    __device__ __forceinline__ void done(const Unit&) const {}
};
struct MoeOrder {
    const PG8_LAS unsigned char* t2e; int nunits, G, c;
    __device__ __forceinline__ bool next(int i, Unit& u) const {
        const int L = i * G + c; if (L >= nunits) return false;
        const int pm = L >> 2; u.pm = pm; u.pn = (int)t2e[pm] * 4 + (L & 3); return true;
    }
    __device__ __forceinline__ void a_ready(const Unit&) const {}
    __device__ __forceinline__ void done(const Unit&) const {}
};

struct EpiProj {
    static constexpr bool PERM = true, AFTER_DRAIN = false;
    bf16_t* PROJ; bf16_t* GATES; bf16_t* KV; float qscale;
    __device__ __forceinline__ void operator()(const f32x4 (&acc)[2][2][4][2], const Unit& u, int wr, int wc, int fr, int fq) const {
        bf16_t* base; int ldc, colt, mode = 0; float sc = 1.f; int rowt = u.pm * BM;
        if (u.pm >= 256) { base = KV; ldc = 512; colt = (u.pn - 20) * BM; rowt -= 65536; }
        else if (u.pn < 8) { base = PROJ; ldc = 2048; colt = u.pn * BM; if (u.pn == 1 || u.pn == 2 || u.pn == 7) sc = qscale; }
        else { base = GATES; ldc = 3072; colt = (u.pn - 8) * BM; mode = 1; }
        const int row0 = rowt + wr * 64 + fr, col0 = colt + wc * 32 + 8 * fq;
#pragma unroll
        for (int ai = 0; ai < 2; ++ai)
#pragma unroll
            for (int m = 0; m < 4; ++m) { bf16_t* rowp = base + (size_t)(row0 + ai * HALF + m * 16) * ldc + col0;
#pragma unroll
                for (int bj = 0; bj < 2; ++bj) { f32x4 v0 = acc[ai][bj][m][0], v1 = acc[ai][bj][m][1];
                    if (mode) {
#pragma unroll
                        for (int i = 0; i < 4; ++i) { v0[i] = sigmoid_f(v0[i]); v1[i] = sigmoid_f(v1[i]); } }
                    else { v0 = v0 * sc; v1 = v1 * sc; }
                    *(u32x4*)(rowp + bj * HALF) = pack8(v0, v1); } }
    }
};
__device__ __forceinline__ float gclamp(float g) { return __builtin_fmaxf(g, 1e-18f); }
struct MidRescale {
    static constexpr bool ON = true; static constexpr int T0 = 4, T1 = 12;
    const bf16_t* GATES;
    __device__ __forceinline__ void operator()(f32x4 (&acc)[2][2][4][2], const Unit& u, int t, int wr, int wc, int fr, int fq) const {
        int fr_ = fr; asm volatile("" : "+v"(fr_));
        const int row0 = u.pm * BM + wr * 64 + fr_, col0 = u.pn * BM + wc * 32 + 8 * fq; const int gprev = (t == T0) ? 0 : 1024;
        const unsigned off0 = ((unsigned)row0 * 3072u + (unsigned)(gprev + col0)) * 2u;
#pragma unroll
        for (int ai = 0; ai < 2; ++ai) {
            u32x4 ga[4][2], gb[4][2];
#pragma unroll
            for (int m = 0; m < 4; ++m) { const char* gp = (const char*)GATES + (off0 + (unsigned)((ai * HALF + m * 16) * 3072 * 2));
#pragma unroll
                for (int bj = 0; bj < 2; ++bj) { ga[m][bj] = *(const u32x4*)(gp + bj * HALF * 2); gb[m][bj] = *(const u32x4*)(gp + 2048 + bj * HALF * 2); } }
#pragma unroll
            for (int m = 0; m < 4; ++m)
#pragma unroll
                for (int bj = 0; bj < 2; ++bj) { const u32x4 a = ga[m][bj], b = gb[m][bj];
                    f32x4 r0, r1;
                    r0[0] = bf_lo(a.x) * __builtin_amdgcn_rcpf(gclamp(bf_lo(b.x))); r0[1] = bf_hi(a.x) * __builtin_amdgcn_rcpf(gclamp(bf_hi(b.x)));
                    r0[2] = bf_lo(a.y) * __builtin_amdgcn_rcpf(gclamp(bf_lo(b.y))); r0[3] = bf_hi(a.y) * __builtin_amdgcn_rcpf(gclamp(bf_hi(b.y)));
                    r1[0] = bf_lo(a.z) * __builtin_amdgcn_rcpf(gclamp(bf_lo(b.z))); r1[1] = bf_hi(a.z) * __builtin_amdgcn_rcpf(gclamp(bf_hi(b.z)));
                    r1[2] = bf_lo(a.w) * __builtin_amdgcn_rcpf(gclamp(bf_lo(b.w))); r1[3] = bf_hi(a.w) * __builtin_amdgcn_rcpf(gclamp(bf_hi(b.w)));
                    acc[ai][bj][m][0] = acc[ai][bj][m][0] * r0; acc[ai][bj][m][1] = acc[ai][bj][m][1] * r1; }
            asm volatile("" ::: "memory"); }
    }
};
struct EpiMerge {
    static constexpr bool PERM = true, AFTER_DRAIN = false;
    const bf16_t* GATES; bf16_t* MERGED;
    __device__ __forceinline__ void operator()(const f32x4 (&acc)[2][2][4][2], const Unit& u, int wr, int wc, int fr, int fq) const {
        const int row0 = u.pm * BM + wr * 64 + fr, col0 = u.pn * BM + wc * 32 + 8 * fq;
        const unsigned off0 = ((unsigned)row0 * 3072u + (unsigned)(2048 + col0)) * 2u;
        u32x4 gg[2][4][2];
#pragma unroll
        for (int ai = 0; ai < 2; ++ai)
#pragma unroll
            for (int m = 0; m < 4; ++m)
#pragma unroll
                for (int bj = 0; bj < 2; ++bj) gg[ai][m][bj] = *(const u32x4*)((const char*)GATES + (off0 + (unsigned)((ai * HALF + m * 16) * 3072 * 2)) + bj * HALF * 2);
#pragma unroll
        for (int ai = 0; ai < 2; ++ai)
#pragma unroll
            for (int m = 0; m < 4; ++m) { const size_t r = (size_t)(row0 + ai * HALF + m * 16);
#pragma unroll
                for (int bj = 0; bj < 2; ++bj) { const int c = col0 + bj * HALF; const u32x4 g = gg[ai][m][bj];
                    f32x4 v0 = acc[ai][bj][m][0], v1 = acc[ai][bj][m][1];
                    v0[0] *= gclamp(bf_lo(g.x)); v0[1] *= gclamp(bf_hi(g.x)); v0[2] *= gclamp(bf_lo(g.y)); v0[3] *= gclamp(bf_hi(g.y));
                    v1[0] *= gclamp(bf_lo(g.z)); v1[1] *= gclamp(bf_hi(g.z)); v1[2] *= gclamp(bf_lo(g.w)); v1[3] *= gclamp(bf_hi(g.w));
                    *(u32x4*)(MERGED + r * 1024 + c) = pack8(v0, v1); } }
    }
};
struct EpiWo {
    static constexpr bool PERM = false, AFTER_DRAIN = false;
    const float* X; float* X1;
    __device__ __forceinline__ void operator()(const f32x4 (&acc)[2][2][4][2], const Unit& u, int wr, int wc, int fr, int fq) const {
        const int row0 = u.pm * BM + wr * 64 + fr, col0 = u.pn * BM + wc * 32 + 4 * fq;
#pragma unroll
        for (int ai = 0; ai < 2; ++ai)
#pragma unroll
            for (int m = 0; m < 4; ++m) { const size_t off = (size_t)(row0 + ai * HALF + m * 16) * 1024 + col0;
#pragma unroll
                for (int bj = 0; bj < 2; ++bj)
#pragma unroll
                    for (int n = 0; n < 2; ++n) { const size_t o = off + bj * HALF + n * 16; *(f32x4*)(X1 + o) = *(const f32x4*)(X + o) + acc[ai][bj][m][n]; } }
    }
};
struct EpiGateUp {
    static constexpr bool PERM = true, AFTER_DRAIN = false;
    bf16_t* HID; const float* RWE; const PG8_LAS int* TB;
    __device__ __forceinline__ void operator()(const f32x4 (&acc)[2][2][4][2], const Unit& u, int wr, int wc, int fr, int fq) const {
        const int row0 = u.pm * BM + wr * 64 + fr, colh = (u.pn & 3) * 128 + wc * 32 + 8 * fq;
#pragma unroll
        for (int ai = 0; ai < 2; ++ai)
#pragma unroll
            for (int m = 0; m < 4; ++m) { const size_t r = (size_t)(row0 + ai * HALF + m * 16); const size_t es = (size_t)((u.pn >> 2) << 16) + (r - (size_t)TB[u.pn >> 2] * 256); const float ri = RWE[2 * es], w = RWE[2 * es + 1];
                f32x4 h0, h1;
#pragma unroll
                for (int i = 0; i < 4; ++i) { const float g0 = acc[ai][0][m][0][i] * ri, g1 = acc[ai][0][m][1][i] * ri; const float wr_ = w * ri;
                    h0[i] = g0 * sigmoid_f(g0) * acc[ai][1][m][0][i] * wr_; h1[i] = g1 * sigmoid_f(g1) * acc[ai][1][m][1][i] * wr_; }
                *(u32x4*)(HID + r * 512 + colh) = pack8(h0, h1); }
    }
};
struct EpiDown {
    static constexpr bool PERM = true, AFTER_DRAIN = false;
    bf16_t* Y;
    __device__ __forceinline__ void operator()(const f32x4 (&acc)[2][2][4][2], const Unit& u, int wr, int wc, int fr, int fq) const {
        const int row0 = u.pm * BM + wr * 64 + fr, col0 = (u.pn & 3) * BM + wc * 32 + 8 * fq;
#pragma unroll
        for (int ai = 0; ai < 2; ++ai)
#pragma unroll
            for (int m = 0; m < 4; ++m) { bf16_t* rowp = Y + (size_t)(row0 + ai * HALF + m * 16) * 1024 + col0;
#pragma unroll
                for (int bj = 0; bj < 2; ++bj) *(u32x4*)(rowp + bj * HALF) = pack8(acc[ai][bj][m][0], acc[ai][bj][m][1]); }
    }
};

struct NoMid { static constexpr bool ON = false; static constexpr int T0 = -1, T1 = -1; __device__ __forceinline__ void operator()(f32x4 (&)[2][2][4][2], const Unit&, int, int, int, int, int) const {} };
template <class Epi, class Sched, bool ALIGN_EPI = false, bool SP2 = false, class Mid = NoMid, bool GATHER = false>
__device__ __forceinline__ void gemm_phase(PG8_LAS unsigned char* lds, const Gemm g, const Sched& S, const Epi& E, const Mid& MH = Mid(), const PG8_LAS int* tokl = nullptr) {
    int tid_ = threadIdx.x; asm volatile("" : "+v"(tid_));
    const int tid = tid_, wid = __builtin_amdgcn_readfirstlane(tid >> 6), lane = tid & 63, wr = wid >> 2, wc = wid & 3, fr = lane & 15, fq = lane >> 4;
    static_assert(!GATHER || SP2, "GATHER is written for the SP2 loop");
    const int K = g.K, nt = K / BK;
    unsigned voffA[2], voffB[2];
#pragma unroll
    for (int i = 0; i < 2; ++i) { int R, C; stage_rc(tid * 16 + i * 8192, R, C); const int Rb = Epi::PERM ? ((R & ~31) + perm32(R & 31)) : R;
        voffA[i] = (unsigned)(R * K + C) * 2u; voffB[i] = (unsigned)(Rb * K + C) * 2u; }
    const size_t kstep = (size_t)(BK * 2);
    const size_t hstep = (size_t)HALF * K * 2;
    const size_t tstep = 2 * hstep;
    const unsigned ldsw = (unsigned)wid * 1024u;
    const int aoff = lds_byte(wr * 64 + fr, fq * 8), boff = lds_byte(wc * 32 + fr, fq * 8);
    unsigned vGc[2][2], vGn[2][2]; int gR[2], gC[2];
    if constexpr (GATHER) {
#pragma unroll
        for (int i = 0; i < 2; ++i) { stage_rc(tid * 16 + i * 8192, gR[i], gC[i]); }
    }
#define PG8_GOFFS(dst, u_) do { if constexpr (GATHER) { _Pragma("unroll") for (int hh_ = 0; hh_ < 2; ++hh_) _Pragma("unroll") for (int i_ = 0; i_ < 2; ++i_) \
        dst[hh_][i_] = ((unsigned)tokl[(u_) * 256 + hh_ * HALF + gR[i_]] * (unsigned)K + (unsigned)gC[i_]) * 2u; } } while (0)
#define PG8_STGA(bufoff, base, hh, nx) do { if constexpr (GATHER) { _Pragma("unroll") for (int _i = 0; _i < 2; ++_i) \
        __builtin_amdgcn_global_load_lds((const unsigned*)((const char*)(base) + ((nx) ? vGn[hh][_i] : vGc[hh][_i])), (PG8_LAS unsigned*)(lds + (bufoff) + ldsw + _i * 8192), 16, 0, 0); } \
      else { PG8_STAGE(bufoff, (base) + (hh) * hstep, voffA); } } while (0)
#define PG8_SA(b, h) (((b) * 2 + (h)) * HTB)
#define PG8_SB(b, h) ((4 + (b) * 2 + (h)) * HTB)
#define PG8_STAGE(bufoff, gbase, voff) do { _Pragma("unroll") for (int _i = 0; _i < 2; ++_i) \
        __builtin_amdgcn_global_load_lds((const unsigned*)((const char*)(gbase) + (voff)[_i]), (PG8_LAS unsigned*)(lds + (bufoff) + ldsw + _i * 8192), 16, 0, 0); } while (0)
#define PG8_LDA(dst, b, h) do { _Pragma("unroll") for (int m = 0; m < 4; ++m) _Pragma("unroll") for (int k = 0; k < 2; ++k) dst[m][k] = *(const PG8_LAS bf16x8*)(lds + PG8_SA(b, h) + aoff + m * 2048 + k * 1024); } while (0)
#define PG8_LDB(dst, b, h) do { _Pragma("unroll") for (int n = 0; n < 2; ++n) _Pragma("unroll") for (int k = 0; k < 2; ++k) dst[n][k] = *(const PG8_LAS bf16x8*)(lds + PG8_SB(b, h) + boff + n * 2048 + k * 1024); } while (0)
#define PG8_MMA(ai, bj, At, Bt) do { __builtin_amdgcn_s_setprio(1); _Pragma("unroll") for (int m = 0; m < 4; ++m) _Pragma("unroll") for (int n = 0; n < 2; ++n) _Pragma("unroll") for (int k = 0; k < 2; ++k) \
        acc[ai][bj][m][n] = __builtin_amdgcn_mfma_f32_16x16x32_bf16(Bt[n][k], At[m][k], acc[ai][bj][m][n], 0, 0, 0); __builtin_amdgcn_s_setprio(0); } while (0)
#define PG8_WAIT_V(n) asm volatile("s_waitcnt vmcnt(" #n ")" ::: "memory")
#define PG8_WAIT_L(n) asm volatile("s_waitcnt lgkmcnt(" #n ")" ::: "memory")
#define PG8_BAR __builtin_amdgcn_s_barrier()
#define PG8_SCHED __builtin_amdgcn_sched_barrier(0)
    Unit cur, nxt; int ui = 0;
    if (!S.next(0, cur)) return;
    f32x4 acc[2][2][4][2];
#pragma unroll
    for (int a = 0; a < 2; ++a)
#pragma unroll
        for (int b = 0; b < 2; ++b)
#pragma unroll
            for (int m = 0; m < 4; ++m)
#pragma unroll
                for (int n = 0; n < 2; ++n) acc[a][b][m][n] = (f32x4){0.f, 0.f, 0.f, 0.f};
    bf16x8 At[4][2], B0[2][2], B1[2][2];
    const char* cA = (const char*)g.A + (GATHER ? (size_t)0 : (size_t)cur.pm * tstep); const char* cB = (const char*)g.Bt + (size_t)cur.pn * tstep;
    PG8_GOFFS(vGc, 0); PG8_GOFFS(vGn, 0);
    S.a_ready(cur);
    if constexpr (SP2) {
        PG8_STAGE(PG8_SB(0, 0), cB, voffB); PG8_STAGE(PG8_SB(0, 1), cB + hstep, voffB); PG8_STGA(PG8_SA(0, 0), cA, 0, false); PG8_STGA(PG8_SA(0, 1), cA, 1, false);
        if (wr == 1) PG8_BAR;
        PG8_WAIT_V(2); PG8_BAR;
        PG8_STAGE(PG8_SB(1, 0), cB + kstep, voffB); PG8_STGA(PG8_SA(1, 0), cA + kstep, 0, false); PG8_STAGE(PG8_SB(1, 1), cB + hstep + kstep, voffB);
        PG8_WAIT_V(6); PG8_BAR;
    } else {
        PG8_STAGE(PG8_SB(0, 0), cB, voffB); PG8_STAGE(PG8_SA(0, 0), cA, voffA); PG8_STAGE(PG8_SB(0, 1), cB + hstep, voffB); PG8_STAGE(PG8_SA(0, 1), cA + hstep, voffA);
        if (wr == 1) PG8_BAR;
        PG8_WAIT_V(4); PG8_BAR;
        PG8_STAGE(PG8_SB(1, 0), cB + kstep, voffB); PG8_STAGE(PG8_SA(1, 0), cA + kstep, voffA); PG8_STAGE(PG8_SB(1, 1), cB + hstep + kstep, voffB);
        PG8_WAIT_V(6); PG8_BAR;
    }
    for (;;) {
        const bool has_next = S.next(ui + 1, nxt);
        if (has_next) PG8_GOFFS(vGn, ui + 1);
        const char* nA = (has_next && !GATHER) ? (const char*)g.A + (size_t)nxt.pm * tstep : cA; const char* nB = has_next ? (const char*)g.Bt + (size_t)nxt.pn * tstep : cB;
        for (int t = 0; t < nt; t += 2) {
            if constexpr (Mid::ON) { if (t == Mid::T0 || t == Mid::T1) MH(acc, cur, t, wr, wc, fr, fq); }
            const bool last = (t == nt - 2);
            const char* a1 = cA + (size_t)(t + 1) * kstep;
            const char* a2 = last ? nA : cA + (size_t)(t + 2) * kstep; const char* b2 = last ? nB : cB + (size_t)(t + 2) * kstep;
            const char* a3 = a2 + kstep; const char* b3 = b2 + kstep;
            if (last && has_next) S.a_ready(nxt);
            if constexpr (SP2) {
            PG8_LDB(B0, 0, 0); PG8_LDB(B1, 0, 1); PG8_SCHED; PG8_LDA(At, 0, 0); PG8_STGA(PG8_SA(1, 1), a1, 1, false);
            PG8_WAIT_V(8); PG8_WAIT_L(0); PG8_BAR; PG8_MMA(0, 0, At, B0); PG8_MMA(0, 1, At, B1); PG8_BAR; PG8_SCHED;
            PG8_LDA(At, 0, 1); PG8_STAGE(PG8_SB(0, 0), b2, voffB); PG8_STAGE(PG8_SB(0, 1), b2 + hstep, voffB); PG8_STGA(PG8_SA(0, 0), a2, 0, last && has_next);
            PG8_WAIT_V(8); PG8_WAIT_L(0); PG8_BAR; PG8_MMA(1, 0, At, B0); PG8_MMA(1, 1, At, B1); PG8_BAR; PG8_SCHED;
            PG8_LDB(B0, 1, 0); PG8_LDB(B1, 1, 1); PG8_SCHED; PG8_LDA(At, 1, 0); PG8_STGA(PG8_SA(0, 1), a2, 1, last && has_next);
            PG8_WAIT_V(8); PG8_WAIT_L(0); PG8_BAR; PG8_MMA(0, 0, At, B0); PG8_MMA(0, 1, At, B1); PG8_BAR; PG8_SCHED;
            PG8_LDA(At, 1, 1); PG8_STAGE(PG8_SB(1, 0), b3, voffB); PG8_STAGE(PG8_SB(1, 1), b3 + hstep, voffB); PG8_STGA(PG8_SA(1, 0), a3, 0, last && has_next);
            PG8_WAIT_V(8); PG8_WAIT_L(0); PG8_BAR; PG8_MMA(1, 0, At, B0); PG8_MMA(1, 1, At, B1); PG8_BAR; PG8_SCHED;
            } else {
            PG8_LDB(B0, 0, 0); PG8_SCHED; PG8_LDA(At, 0, 0); PG8_STAGE(PG8_SA(1, 1), a1 + hstep, voffA);
            PG8_WAIT_L(8); PG8_BAR; PG8_WAIT_L(0); PG8_MMA(0, 0, At, B0); PG8_BAR; PG8_SCHED;
            PG8_LDB(B1, 0, 1); PG8_STAGE(PG8_SB(0, 0), b2, voffB);
            PG8_BAR; PG8_WAIT_L(0); PG8_MMA(0, 1, At, B1); PG8_BAR;
            PG8_LDA(At, 0, 1); PG8_STAGE(PG8_SA(0, 0), a2, voffA);
            PG8_BAR; PG8_WAIT_L(0); PG8_MMA(1, 0, At, B0); PG8_BAR; PG8_SCHED;
            PG8_STAGE(PG8_SB(0, 1), b2 + hstep, voffB);
            PG8_WAIT_V(6); PG8_BAR; PG8_MMA(1, 1, At, B1); PG8_BAR;
            PG8_LDB(B0, 1, 0); PG8_SCHED; PG8_LDA(At, 1, 0); PG8_STAGE(PG8_SA(0, 1), a2 + hstep, voffA);
            PG8_WAIT_L(8); PG8_BAR; PG8_WAIT_L(0); PG8_MMA(0, 0, At, B0); PG8_BAR; PG8_SCHED;
            PG8_LDB(B1, 1, 1); PG8_STAGE(PG8_SB(1, 0), b3, voffB);
            PG8_BAR; PG8_WAIT_L(0); PG8_MMA(0, 1, At, B1); PG8_BAR;
            PG8_LDA(At, 1, 1); PG8_STAGE(PG8_SA(1, 0), a3, voffA);
            PG8_BAR; PG8_WAIT_L(0); PG8_MMA(1, 0, At, B0); PG8_BAR; PG8_SCHED;
            PG8_STAGE(PG8_SB(1, 1), b3 + hstep, voffB);
            PG8_WAIT_V(6); PG8_BAR; PG8_MMA(1, 1, At, B1); PG8_BAR;
            }
        }
        if constexpr (ALIGN_EPI) { if (wr == 0) PG8_BAR; }
        if constexpr (!Epi::AFTER_DRAIN) { E(acc, cur, wr, wc, fr, fq); S.done(cur); }
        if (!has_next) break;
#pragma unroll
        for (int a = 0; a < 2; ++a)
#pragma unroll
            for (int b = 0; b < 2; ++b)
#pragma unroll
                for (int m = 0; m < 4; ++m)
#pragma unroll
                    for (int n = 0; n < 2; ++n) acc[a][b][m][n] = (f32x4){0.f, 0.f, 0.f, 0.f};
        cur = nxt; cA = nA; cB = nB; ++ui;
        if constexpr (GATHER) { _Pragma("unroll") for (int hh_ = 0; hh_ < 2; ++hh_) _Pragma("unroll") for (int i_ = 0; i_ < 2; ++i_) vGc[hh_][i_] = vGn[hh_][i_]; }
        if constexpr (ALIGN_EPI) { if (wr == 1) PG8_BAR; }
    }
    PG8_WAIT_V(0);
    if constexpr (!ALIGN_EPI) { if (wr == 0) PG8_BAR; }
    PG8_BAR;
    if constexpr (Epi::AFTER_DRAIN) { E.fused(acc, cur, wr, wc, fr, fq, lds, wid, lane); S.done(cur); }
#undef PG8_SA
#undef PG8_SB
#undef PG8_STAGE
#undef PG8_STGA
#undef PG8_GOFFS
#undef PG8_LDA
#undef PG8_LDB
#undef PG8_MMA
#undef PG8_WAIT_V
#undef PG8_WAIT_L
#undef PG8_BAR
#undef PG8_SCHED
}
}
#include <hip/hip_bf16.h>
#include <cmath>
namespace attn_body {
using bf16=__hip_bfloat16;
using bf16x8=__attribute__((ext_vector_type(8)))short;
using s16x4=__attribute__((ext_vector_type(4)))short;
using f32x16=__attribute__((ext_vector_type(16)))float;
using u32x4=__attribute__((ext_vector_type(4)))unsigned;
constexpr int D=64;
constexpr int NW=8,QBLK=32,QB=QBLK*NW,KVBLK=64;
constexpr int ATTN_UNIT_ROWS=QB;
__device__ __forceinline__ int crow(int r,int hi){return (r&3)+8*(r>>2)+4*hi;}
#define SBAR() __builtin_amdgcn_sched_barrier(0)
__device__ __forceinline__ void cmask(f32x16&p0,f32x16&p1,int jb,int qrel,int hi){
  const float NEG=-INFINITY; int kb=64*jb+4*hi;
  #pragma unroll
  for(int r=0;r<16;++r){int kv=kb+(r&3)+8*(r>>2); if(kv>qrel)p0[r]=NEG; if(kv+32>qrel)p1[r]=NEG;}
}

constexpr int NSLOT=3, SLOTB=8192;
constexpr int LDS_K=0, LDS_V=NSLOT*SLOTB, LDS_WS=2*NSLOT*SLOTB, LDS_OST=LDS_WS+NW*64*4, LDS_BYTES=LDS_OST+NW*4096;
constexpr float C2=0.125f*1.4426950408889634f;
__device__ __forceinline__ void glds16(const void*gsrc,unsigned lds_dst){unsigned keep;
  asm volatile("s_mov_b32 %0, m0\n\ts_mov_b32 m0, %2\n\ts_nop 0\n\tglobal_load_lds_dwordx4 %1, off\n\ts_mov_b32 m0, %0":"=&s"(keep):"v"(gsrc),"s"(lds_dst):"memory");}
__device__ __forceinline__ float max3f(float a,float b,float c){float r;asm("v_max3_f32 %0, %1, %2, %3":"=v"(r):"v"(a),"v"(b),"v"(c));return r;}
__device__ __forceinline__ float max2f(float a,float b){float r;asm("v_max_f32_e32 %0, %1, %2":"=v"(r):"v"(a),"v"(b));return r;}
__device__ __forceinline__ float fadd_s(float a,float b){float r;asm("v_add_f32_e32 %0, %1, %2":"=v"(r):"v"(a),"v"(b));return r;}
__device__ __forceinline__ float fsub_s(float a,float b){float r;asm("v_sub_f32_e32 %0, %1, %2":"=v"(r):"v"(a),"v"(b));return r;}
typedef float f32x2_t __attribute__((ext_vector_type(2))); typedef __bf16 bf16x2_t __attribute__((ext_vector_type(2)));
__device__ __forceinline__ unsigned cvtpk_s(float lo,float hi){f32x2_t v={lo,hi};bf16x2_t b=__builtin_convertvector(v,bf16x2_t);return __builtin_bit_cast(unsigned,b);}
#define WAIT_BAR(N) asm volatile("s_waitcnt vmcnt(" #N ") lgkmcnt(0)\n\ts_barrier":::"memory")

__device__ __forceinline__ void qkt(f32x16&p0,f32x16&p1,const char*Kslot,const bf16x8*qr,const f32x16&negm,int r32,int hi){
  const char*kb=Kslot+hi*1024+r32*16;
  #pragma unroll
  for(int d0=0;d0<4;++d0){
    const bf16x8 b0=*reinterpret_cast<const bf16x8*>(kb+d0*2048);
    const bf16x8 b1=*reinterpret_cast<const bf16x8*>(kb+d0*2048+512);
    if(d0==0){p0=__builtin_amdgcn_mfma_f32_32x32x16_bf16(b0,qr[0],negm,0,0,0);p1=__builtin_amdgcn_mfma_f32_32x32x16_bf16(b1,qr[0],negm,0,0,0);}
    else{p0=__builtin_amdgcn_mfma_f32_32x32x16_bf16(b0,qr[d0],p0,0,0,0);p1=__builtin_amdgcn_mfma_f32_32x32x16_bf16(b1,qr[d0],p1,0,0,0);}}
}
typedef __attribute__((address_space(3))) const char* lds_cptr;
typedef short v4i16_t __attribute__((ext_vector_type(4)));
__device__ __forceinline__ void kload8(bf16x8*kf,lds_cptr kp){
  kf[0]=*(const __attribute__((address_space(3))) bf16x8*)(kp);      kf[1]=*(const __attribute__((address_space(3))) bf16x8*)(kp+512);
  kf[2]=*(const __attribute__((address_space(3))) bf16x8*)(kp+2048); kf[3]=*(const __attribute__((address_space(3))) bf16x8*)(kp+2560);
  kf[4]=*(const __attribute__((address_space(3))) bf16x8*)(kp+4096); kf[5]=*(const __attribute__((address_space(3))) bf16x8*)(kp+4608);
  kf[6]=*(const __attribute__((address_space(3))) bf16x8*)(kp+6144); kf[7]=*(const __attribute__((address_space(3))) bf16x8*)(kp+6656);
}
__device__ __forceinline__ void kload2(bf16x8*kf,lds_cptr kp,int j){ kf[2*j]=*(const __attribute__((address_space(3))) bf16x8*)(kp+j*2048); kf[2*j+1]=*(const __attribute__((address_space(3))) bf16x8*)(kp+j*2048+512); }
__device__ __forceinline__ s16x4 vtr(lds_cptr p){ return __builtin_bit_cast(s16x4,__builtin_amdgcn_ds_read_tr16_b64_v4i16((__attribute__((address_space(3))) v4i16_t*)p)); }
__device__ __forceinline__ float rowmax(const f32x16&p0,const f32x16&p1){
  float a=max3f(p0[0],p0[1],p1[0]),b=max3f(p0[2],p0[3],p1[1]);a=max3f(a,p1[2],p1[3]);
  #pragma unroll
  for(int r=4;r<16;r+=4){a=max3f(a,p0[r],p0[r+1]);b=max3f(b,p0[r+2],p0[r+3]);a=max3f(a,p1[r],p1[r+1]);b=max3f(b,p1[r+2],p1[r+3]);}
  const float m=max2f(a,b);
  auto rr=__builtin_amdgcn_permlane32_swap(__float_as_uint(m),__float_as_uint(m),false,false);
  return max2f(__uint_as_float(rr[0]),__uint_as_float(rr[1]));
}
__device__ __forceinline__ void pv(f32x16*o,int vb,bf16x8 pa0,bf16x8 pa1,bf16x8 pa2,bf16x8 pa3){
  #pragma unroll
  for(int d0=0;d0<2;++d0){s16x4 lo[4],hi[4];
    #pragma unroll
    for(int ks=0;ks<4;++ks){
      asm volatile("ds_read_b64_tr_b16 %0,%1 offset:%c2":"=&v"(lo[ks]):"v"(vb),"i"(d0*4096+ks*1024):"memory");
      asm volatile("ds_read_b64_tr_b16 %0,%1 offset:%c2":"=&v"(hi[ks]):"v"(vb),"i"(d0*4096+ks*1024+512):"memory");}
    asm volatile("s_waitcnt lgkmcnt(0)":::"memory");SBAR();
    #define PK(k) (bf16x8){lo[k][0],lo[k][1],lo[k][2],lo[k][3],hi[k][0],hi[k][1],hi[k][2],hi[k][3]}
    o[d0]=__builtin_amdgcn_mfma_f32_32x32x16_bf16(pa0,PK(0),o[d0],0,0,0);
    o[d0]=__builtin_amdgcn_mfma_f32_32x32x16_bf16(pa1,PK(1),o[d0],0,0,0);
    o[d0]=__builtin_amdgcn_mfma_f32_32x32x16_bf16(pa2,PK(2),o[d0],0,0,0);
    o[d0]=__builtin_amdgcn_mfma_f32_32x32x16_bf16(pa3,PK(3),o[d0],0,0,0);
    #undef PK
  }
}

#ifndef ATTN_STORE16
#define ATTN_STORE16(p,v) (*(u32x4*)(p)=(v))
#endif
template<int THRL,bool CAUSAL> __device__ __forceinline__ void attn_unit(const bf16*Qu,const int pQ,const bf16*__restrict__ Kh,const bf16*__restrict__ Vh,const int pKV,bf16*Ou,const int pO,const int NT,char*shm){
  int tid_=threadIdx.x; asm volatile("":"+v"(tid_));
  const int tid=tid_,lane=tid&63,r32=lane&31,hi=lane>>5; const int wid=__builtin_amdgcn_readfirstlane(tid>>6);
  const bf16*Qw=Qu+(long)(wid*QBLK)*pQ;
  const unsigned lds0=(unsigned)(uintptr_t)shm;
  float*wsf=(float*)(shm+LDS_WS)+wid*64;
  const bf16*ksrc=Kh+(long)lane*pKV+wid*8;
  const bf16*vsrc=Vh+(long)(16*(wid&3)+(lane>>2))*pKV+(wid>>2)*32+(lane&3)*8;
  const unsigned kdst=lds0+LDS_K+wid*1024, vdst=lds0+LDS_V+wid*1024;
  #define DMA_K(t,slot) glds16(ksrc+(long)(t)*KVBLK*pKV,(unsigned)__builtin_amdgcn_readfirstlane(kdst+(slot)))
  #define DMA_V(t,slot) glds16(vsrc+(long)(t)*KVBLK*pKV,(unsigned)__builtin_amdgcn_readfirstlane(vdst+(slot)))
  const int vb0=(int)(lds0+LDS_V)+((lane>>4)&1)*32+(lane&3)*8+(4*hi+((lane&15)>>2))*64;
  const char*Kbase=shm+LDS_K; bf16x8 kf[8];
  const lds_cptr shm3=(lds_cptr)shm; const lds_cptr kp0=shm3+LDS_K+hi*1024+r32*16; const lds_cptr vp0=shm3+LDS_V+((lane>>4)&1)*32+(lane&3)*8+(4*hi+((lane&15)>>2))*64;
  DMA_K(0,0);DMA_V(0,0);DMA_K(1,SLOTB);
  bf16x8 qr[4];
  #pragma unroll
  for(int d0=0;d0<4;++d0)qr[d0]=*reinterpret_cast<const bf16x8*>(&Qw[(long)r32*pQ+d0*16+hi*8]);
  float mhat=0.f,l_reg=0.f;f32x16 o[2];o[0]=f32x16{};o[1]=f32x16{};const f32x16 negm=f32x16{};
  const int qrel=wid*QBLK+r32;
  #define CMASK(P0,P1,t) do{ if(CAUSAL){int jb_=(t)-(NT-4); if(jb_>=0)cmask(P0,P1,jb_,qrel,hi);} }while(0)
  bool resc=false;
  #define START(P0,P1) do{ const float rm=rowmax(P0,P1); resc=false; \
    { const float dl=rm; mhat=fadd_s(mhat,dl); \
      _Pragma("unroll") for(int r=0;r<16;++r){P0[r]=fsub_s(P0[r],dl);P1[r]=fsub_s(P1[r],dl);} \
      } \
    _Pragma("unroll") for(int r=0;r<16;++r)P0[r]=__builtin_amdgcn_exp2f(P0[r]); }while(0)
  #define RESC() do{ if(resc){ asm volatile("s_waitcnt lgkmcnt(0)":::"memory"); \
      _Pragma("unroll") for(int d_=0;d_<2;++d_) _Pragma("unroll") for(int r=0;r<16;++r)o[d_][r]*=wsf[crow(r,hi)]; } }while(0)
  f32x16 pA0,pA1,pB0,pB1;
  int sl_prev=0,sl_cur=0,sl_next=SLOTB;
  #define ROT() do{sl_prev=sl_cur;sl_cur=sl_next;sl_next=(sl_next==(NSLOT-1)*SLOTB)?0:sl_next+SLOTB;}while(0)
  DMA_K(2,2*SLOTB);
  WAIT_BAR(3);
  qkt(pA0,pA1,Kbase,qr,negm,r32,hi);asm volatile("s_nop 15\n\ts_nop 7":"+v"(pA0),"+v"(pA1));CMASK(pA0,pA1,0);
  START(pA0,pA1);
  _Pragma("unroll") for(int r=0;r<16;++r)pA1[r]=__builtin_amdgcn_exp2f(pA1[r]);
  WAIT_BAR(0);
  DMA_K(3,0);DMA_V(1,SLOTB);
  ROT();
  kload8(kf,kp0+sl_cur);
  WAIT_BAR(2);
  s16x4 vlo[8],vhi[8]; u32x4 pw0,pw1,pw2,pw3;
  #define PKW(P,B) cvtpk_s(P[B],P[B+1])
  #define PAF(k) __builtin_bit_cast(bf16x8,pw##k)
  #define VFR(i) (bf16x8){vlo[i][0],vlo[i][1],vlo[i][2],vlo[i][3],vhi[i][0],vhi[i][1],vhi[i][2],vhi[i][3]}
  #define PIN(x) asm volatile("":"+v"(x))
  #define MX3(a,b,c) __builtin_fmaxf(__builtin_fmaxf((a),(b)),(c))
  #define GAPA(MF,A0,A1,A2,A3,W0,W1,PW) do{ MF; sacc+=A0; sacc+=A1; sacc+=A2; sacc+=A3; PIN(sacc); W0; W1; PIN(PW); SBAR(); }while(0)
  #define EX(v) __builtin_amdgcn_exp2f(v)
  #define GAPB(MF,X,B) do{ MF; X[B]=EX(X[B]); X[B+1]=EX(X[B+1]); X[B+2]=EX(X[B+2]); X[B+3]=EX(X[B+3]); PIN(X); SBAR(); }while(0)
  #define VRD(i) do{ vlo[i]=vtr(vp_+(((i)>>2)*4096+((i)&3)*1024)); vhi[i]=vtr(vp_+(((i)>>2)*4096+((i)&3)*1024+512)); }while(0)
  #define KRD(G,j) do{ if(G){ kload2(kf,kp0+sl_next,j); SBAR(); } }while(0)
  #define STEP(C0,C1,P0,P1,t,GK,GV,GL) do{ SBAR(); \
    const lds_cptr vp_=vp0+sl_prev; \
    VRD(0); SBAR(); float sacc=(P0[0]+P0[1]); \
    GAPA(C0=__builtin_amdgcn_mfma_f32_32x32x16_bf16(kf[0],qr[0],negm,0,0,0), P0[2],P0[3],P0[4],P0[5],     pw0[0]=PKW(P0,0), pw0[1]=PKW(P0,2), pw0); \
    VRD(4); SBAR(); GAPA(C1=__builtin_amdgcn_mfma_f32_32x32x16_bf16(kf[1],qr[0],negm,0,0,0), P0[6],P0[7],P0[8],P0[9],     pw0[2]=PKW(P0,4), pw0[3]=PKW(P0,6), pw0); \
    VRD(1); SBAR(); GAPA(C0=__builtin_amdgcn_mfma_f32_32x32x16_bf16(kf[2],qr[1],C0,0,0,0),   P0[10],P0[11],P0[12],P0[13], pw1[0]=PKW(P0,8), pw1[1]=PKW(P0,10), pw1); \
    VRD(5); SBAR(); GAPA(C1=__builtin_amdgcn_mfma_f32_32x32x16_bf16(kf[3],qr[1],C1,0,0,0),   P0[14],P0[15],P1[0],P1[1],   pw1[2]=PKW(P0,12),pw1[3]=PKW(P0,14), pw1); \
    VRD(2); SBAR(); GAPA(C0=__builtin_amdgcn_mfma_f32_32x32x16_bf16(kf[4],qr[2],C0,0,0,0),   P1[2],P1[3],P1[4],P1[5],     pw2[0]=PKW(P1,0), pw2[1]=PKW(P1,2), pw2); \
    VRD(6); SBAR(); GAPA(C1=__builtin_amdgcn_mfma_f32_32x32x16_bf16(kf[5],qr[2],C1,0,0,0),   P1[6],P1[7],P1[8],P1[9],     pw2[2]=PKW(P1,4), pw2[3]=PKW(P1,6), pw2); \
    VRD(3); SBAR(); GAPA(C0=__builtin_amdgcn_mfma_f32_32x32x16_bf16(kf[6],qr[3],C0,0,0,0),   P1[10],P1[11],P1[12],P1[13], pw3[0]=PKW(P1,8), pw3[1]=PKW(P1,10), pw3); \
    VRD(7); SBAR(); GAPA(C1=__builtin_amdgcn_mfma_f32_32x32x16_bf16(kf[7],qr[3],C1,0,0,0),   P1[14],P1[15],0.f,0.f,       pw3[2]=PKW(P1,12),pw3[3]=PKW(P1,14), pw3); \
    l_reg+=sacc; \
    if(GK){DMA_K((t)+3,sl_cur);} if(GV){DMA_V((t)+1,sl_next);} \
    CMASK(C0,C1,t); \
    _Pragma("unroll") for(int r=0;r<16;++r){C0[r]-=mhat;C1[r]-=mhat;} \
    { float a=MX3(C0[0],C0[1],C1[0]),b=MX3(C0[2],C0[3],C1[1]); a=MX3(a,C1[2],C1[3]); \
      _Pragma("unroll") for(int r=4;r<16;r+=4){a=MX3(a,C0[r],C0[r+1]);b=MX3(b,C0[r+2],C0[r+3]);a=MX3(a,C1[r],C1[r+1]);b=MX3(b,C1[r+2],C1[r+3]);} \
      float rm=__builtin_fmaxf(a,b); { auto rr=__builtin_amdgcn_permlane32_swap(__float_as_uint(rm),__float_as_uint(rm),false,false); rm=__builtin_fmaxf(__uint_as_float(rr[0]),__uint_as_float(rr[1])); } \
      resc=false; \
      if(__builtin_expect(__any(rm>(float)THRL),0)){ const float dl=__builtin_fmaxf(rm,0.f); mhat+=dl; \
        _Pragma("unroll") for(int r=0;r<16;++r){C0[r]-=dl;C1[r]-=dl;} \
        const float f=__builtin_amdgcn_exp2f(-dl); l_reg*=f; if(hi==0)wsf[r32]=f; resc=true; } } \
    SBAR(); \
    GAPB(o[0]=__builtin_amdgcn_mfma_f32_32x32x16_bf16(PAF(0),VFR(0),o[0],0,0,0), C0,0); \
    GAPB(o[1]=__builtin_amdgcn_mfma_f32_32x32x16_bf16(PAF(0),VFR(4),o[1],0,0,0), C0,4); \
    KRD(GL,0); GAPB(o[0]=__builtin_amdgcn_mfma_f32_32x32x16_bf16(PAF(1),VFR(1),o[0],0,0,0), C0,8); \
    KRD(GL,1); GAPB(o[1]=__builtin_amdgcn_mfma_f32_32x32x16_bf16(PAF(1),VFR(5),o[1],0,0,0), C0,12); \
    KRD(GL,2); GAPB(o[0]=__builtin_amdgcn_mfma_f32_32x32x16_bf16(PAF(2),VFR(2),o[0],0,0,0), C1,0); \
    KRD(GL,3); GAPB(o[1]=__builtin_amdgcn_mfma_f32_32x32x16_bf16(PAF(2),VFR(6),o[1],0,0,0), C1,4); \
    GAPB(o[0]=__builtin_amdgcn_mfma_f32_32x32x16_bf16(PAF(3),VFR(3),o[0],0,0,0), C1,8); \
    GAPB(o[1]=__builtin_amdgcn_mfma_f32_32x32x16_bf16(PAF(3),VFR(7),o[1],0,0,0), C1,12); \
    }while(0)
  int t=1;
  #undef CMASK
  #define CMASK(P0,P1,t) do{}while(0)
  for(;t+5<NT;t+=2){
    STEP(pB0,pB1,pA0,pA1,t,true,true,true);     WAIT_BAR(2); RESC(); ROT();
    STEP(pA0,pA1,pB0,pB1,t+1,true,true,true);   WAIT_BAR(2); RESC(); ROT();
  }
  #undef CMASK
  #define CMASK(P0,P1,t) do{ if(CAUSAL){int jb_=(t)-(NT-4); if(jb_>=0)cmask(P0,P1,jb_,qrel,hi);} }while(0)
  #define ENDW(tt) do{ if((tt)+3<NT){WAIT_BAR(2);} else if((tt)+2<NT){WAIT_BAR(1);} else {WAIT_BAR(0);} }while(0)
  for(;t+1<NT;t+=2){
    STEP(pB0,pB1,pA0,pA1,t,(t+3<NT),(t+1<NT),(t+1<NT));       ENDW(t);   RESC(); ROT();
    STEP(pA0,pA1,pB0,pB1,t+1,(t+4<NT),(t+2<NT),(t+2<NT));     ENDW(t+1); RESC(); ROT();
  }
  STEP(pB0,pB1,pA0,pA1,NT-1,false,false,false); RESC();
  { float sacc=pB0[0]+pB0[1]; _Pragma("unroll") for(int r=2;r<16;++r)sacc+=pB0[r]; _Pragma("unroll") for(int r=0;r<16;++r)sacc+=pB1[r]; l_reg+=sacc;
    pw0=(u32x4){PKW(pB0,0),PKW(pB0,2),PKW(pB0,4),PKW(pB0,6)};pw1=(u32x4){PKW(pB0,8),PKW(pB0,10),PKW(pB0,12),PKW(pB0,14)};pw2=(u32x4){PKW(pB1,0),PKW(pB1,2),PKW(pB1,4),PKW(pB1,6)};pw3=(u32x4){PKW(pB1,8),PKW(pB1,10),PKW(pB1,12),PKW(pB1,14)};
    SBAR(); pv(o,vb0+sl_cur,PAF(0),PAF(1),PAF(2),PAF(3)); }
  #undef PKW
  #undef PAF
  #undef VFR
  #undef PIN
  #undef MX3
  #undef GAPA
  #undef GAPB
  #undef EX
  #undef VRD
  #undef KRD
  #undef STEP
  #undef ENDW
  {auto rr=__builtin_amdgcn_permlane32_swap(__float_as_uint(l_reg),__float_as_uint(l_reg),false,false);l_reg=__uint_as_float(rr[0])+__uint_as_float(rr[1]);}
  if(hi==0)wsf[32+r32]=l_reg;asm volatile("s_waitcnt lgkmcnt(0)":::"memory");
  float rli[16];
  #pragma unroll
  for(int r=0;r<16;++r)rli[r]=__builtin_amdgcn_rcpf(wsf[32+crow(r,hi)]);
  bf16*Ow=Ou+(long)(wid*QBLK)*pO;
  { bf16*stg=(bf16*)(shm+LDS_OST)+wid*2048;
    #pragma unroll
    for(int r=0;r<16;++r){const int orow=crow(r,hi);
      #pragma unroll
      for(int d0=0;d0<2;++d0)stg[orow*64+d0*32+r32]=__float2bfloat16(o[d0][r]*rli[r]);}
    asm volatile("s_waitcnt lgkmcnt(0)":::"memory");
    #pragma unroll
    for(int i=0;i<4;++i){const int row=i*8+(lane>>3),ch=lane&7; const u32x4 v=*(const u32x4*)(stg+row*64+ch*8); ATTN_STORE16(Ow+(long)row*pO+ch*8,v);} }
  asm volatile("s_waitcnt lgkmcnt(0)\n\ts_barrier":::"memory");
  #undef DMA_K
  #undef DMA_V
  #undef CMASK
  #undef START
  #undef RESC
  #undef ROT
}
constexpr int ATTN_LDS_BYTES=LDS_BYTES;
#undef SBAR
#undef WAIT_BAR
}
constexpr int NWAVES = 8;
#ifndef MK_N_LAUNCHES
#define MK_N_LAUNCHES 1
#endif
constexpr int NPH = 10;
constexpr int BATCH = 32, SEQ = 2048, D = 1024, T = BATCH * SEQ, NMEM = 256, TM = BATCH * NMEM;
constexpr int INCOLS = 5120, PROJW = 2048, GATEW = 3072;
constexpr float RMS_EPS = 1e-6f;
constexpr int NEXP = 16, EH = 512;
constexpr int MAXROWS = 2 * T + NEXP * 256;
constexpr size_t MiB = 1u << 20;
constexpr size_t WS_CTL = 0, CTL_ZERO_BYTES = 1 * MiB;
constexpr size_t WS_WRF = 1 * MiB;
constexpr size_t WS_RINV = 1 * MiB + 128 * 1024;
constexpr size_t WS_WIN = 2 * MiB;
constexpr size_t WS_PC = 13 * MiB;
constexpr size_t WS_WO = 15 * MiB;
constexpr size_t WS_WGU = 17 * MiB;
constexpr size_t WS_WD = 49 * MiB;
constexpr size_t WS_ROUTE = 65 * MiB;
constexpr size_t WS_KV = 68 * MiB;
constexpr size_t WS_XN = 76 * MiB;
constexpr size_t WS_BR = 76 * MiB;
constexpr size_t WS_H2 = 76 * MiB;
constexpr size_t WS_PROJ = 220 * MiB;
constexpr size_t WS_MERGED = 220 * MiB;
constexpr size_t WS_HID = 220 * MiB;
constexpr size_t WS_ATTO = 476 * MiB;
constexpr size_t WS_GATES = 604 * MiB;
constexpr size_t WS_LIST = 476 * MiB;
constexpr size_t WS_RWE = 480 * MiB;
constexpr size_t WS_Y = 604 * MiB;
constexpr size_t WS_END = 988 * MiB;
static_assert(WS_XN + (size_t)(T + TM) * D * 2 <= WS_PROJ && WS_PROJ + (size_t)T * PROJW * 2 <= WS_ATTO && WS_ATTO + (size_t)T * D * 2 <= WS_GATES && WS_GATES + (size_t)T * GATEW * 2 <= WS_END, "ws map");
static_assert(WS_Y + (size_t)MAXROWS * D * 2 <= WS_END && WS_HID + (size_t)MAXROWS * EH * 2 <= WS_ATTO && WS_RWE + (size_t)NEXP * 65536 * 8 <= WS_GATES, "ws map 2");
constexpr int CW_CNT = 64;
constexpr int RING_OFF = 0, RING_BYTES = 131072;
constexpr int LDSX_OFF = RING_BYTES;
constexpr int LDS_BYTES = 147456;

#define GAS __attribute__((address_space(1)))
#define LAS __attribute__((address_space(3)))
typedef unsigned short bf16;
typedef unsigned v4u __attribute__((ext_vector_type(4)));
typedef unsigned v2u __attribute__((ext_vector_type(2)));
typedef float f32x4 __attribute__((ext_vector_type(4)));
#define LDS_WAIT() asm volatile("s_waitcnt lgkmcnt(0)" ::: "memory")
__device__ __forceinline__ unsigned f2bf(float f) { unsigned u = __builtin_bit_cast(unsigned, f); return (u + 0x7fffu + ((u >> 16) & 1u)) >> 16; }
__device__ __forceinline__ unsigned pk2(float lo, float hi) { return f2bf(lo) | (f2bf(hi) << 16); }
typedef float f32x2_t __attribute__((ext_vector_type(2))); typedef __bf16 bf16x2_t __attribute__((ext_vector_type(2)));
typedef short bf16x8_t __attribute__((ext_vector_type(8))); typedef float f32x16_t __attribute__((ext_vector_type(16)));
__device__ __forceinline__ unsigned cvtpk(float lo, float hi) { f32x2_t v = {lo, hi}; bf16x2_t b = __builtin_convertvector(v, bf16x2_t); return __builtin_bit_cast(unsigned, b); }
__device__ __forceinline__ float bflo(unsigned w) { return __uint_as_float(w << 16); }
__device__ __forceinline__ float bfhi(unsigned w) { return __uint_as_float(w & 0xffff0000u); }
__device__ __forceinline__ float wave_sum(float v) {
#pragma unroll
    for (int o = 1; o < 64; o <<= 1) v += __shfl_xor(v, o);
    return v;
}

typedef GAS unsigned gu32;
#define RLX_AGENT __ATOMIC_RELAXED, __HIP_MEMORY_SCOPE_AGENT
constexpr int CW_BAR = 4096;
constexpr int CW_TS = 128;
#define XB_TMO      128
#define XB_XCNT(j)  (256  + 64 * (j))
#define XB_XSUB(j)  (1280 + 64 * (j))
#define XB_XGEN(j)  (2304 + 64 * (j))
#define XB_TOP      3328
#define XB_TOPGEN   3392
#define XCD_BAR_WORDS 3456
#define XB_SPIN_CAP (1u << 18)

__device__ __forceinline__ unsigned xb_ld(unsigned* p)              { return __hip_atomic_load(p, __ATOMIC_RELAXED, __HIP_MEMORY_SCOPE_AGENT); }
__device__ __forceinline__ unsigned xb_add(unsigned* p, unsigned v) { return __hip_atomic_fetch_add(p, v, __ATOMIC_RELAXED, __HIP_MEMORY_SCOPE_AGENT); }
__device__ __forceinline__ unsigned xb_xcc_id() { return (unsigned)__builtin_amdgcn_s_getreg((3 << 11) | 20) & 0xFu; }
#define XB_SPIN(cond, bar) do { unsigned _sp = 0; while (cond) { __builtin_amdgcn_s_sleep(1); \
    if ((++_sp & 255u) == 0u) { if (xb_ld(&(bar)[XB_TMO])) break; if (_sp > XB_SPIN_CAP) { atomicAdd(&(bar)[XB_TMO], 1u); break; } } } } while (0)

struct XcdBarrier {
    unsigned* bar; unsigned x;
    volatile LAS unsigned* st;
};

__device__ __forceinline__ XcdBarrier xcd_barrier_post(unsigned* bar, volatile LAS unsigned* st) {
    XcdBarrier b; b.bar = bar; b.x = xb_xcc_id(); b.st = st;
    if (threadIdx.x == 0) (void)xb_add(&bar[XB_XCNT(b.x)], 1u);
    return b;
}
__device__ __forceinline__ void xcd_barrier_complete(unsigned* bar, unsigned x, unsigned& nloc, unsigned& nx) {
    const unsigned G = gridDim.x * gridDim.y * gridDim.z;
    unsigned sum, cnt, mine, sp = 0u;
    for (;;) {
        sum = 0u; cnt = 0u; mine = 0u;
#pragma unroll
        for (unsigned j = 0; j < 16; ++j) { const unsigned c = xb_ld(&bar[XB_XCNT(j)]); sum += c; cnt += (c > 0u) ? 1u : 0u; mine = (j == x) ? c : mine; }
        if (sum == G) break;
        __builtin_amdgcn_s_sleep(1);
        if ((++sp & 255u) == 0u) { if (xb_ld(&bar[XB_TMO])) break; if (sp > XB_SPIN_CAP) { atomicAdd(&bar[XB_TMO], 1u); break; } }
    }
    nloc = mine > 0u ? mine : 1u; nx = cnt > 0u ? cnt : 1u;
}

__device__ __forceinline__ void xcd_barrier(const XcdBarrier& b) {
    asm volatile("s_waitcnt vmcnt(0)" ::: "memory");
    __syncthreads();
    if (threadIdx.x == 0) {
        unsigned* bar = b.bar;
        __builtin_amdgcn_s_waitcnt(0);
        unsigned nloc = b.st[0], nx = b.st[1];
        if (nloc == 0u) { xcd_barrier_complete(bar, b.x, nloc, nx); b.st[0] = nloc; b.st[1] = nx; }
        const unsigned old = xb_add(&bar[XB_XSUB(b.x)], 1u);
        const unsigned gen = old / nloc;
        if (old + 1u == (gen + 1u) * nloc) {
            __builtin_amdgcn_fence(__ATOMIC_RELEASE, "agent");
            asm volatile("s_waitcnt vmcnt(0)" ::: "memory");
            const unsigned og = xb_add(&bar[XB_TOP], 1u);
            const unsigned tg = og / nx;
            if (og + 1u == (tg + 1u) * nx) xb_add(&bar[XB_TOPGEN], 1u);
            else XB_SPIN(xb_ld(&bar[XB_TOPGEN]) == tg, bar);
            __builtin_amdgcn_fence(__ATOMIC_ACQUIRE, "agent");
            xb_add(&bar[XB_XGEN(b.x)], 1u);
            asm volatile("s_waitcnt vmcnt(0)" ::: "memory");
        } else {
            XB_SPIN(xb_ld(&bar[XB_XGEN(b.x)]) == gen, bar);
            __builtin_amdgcn_fence(__ATOMIC_ACQUIRE, "agent");
            asm volatile("s_waitcnt vmcnt(0)" ::: "memory");
        }
    }
    __syncthreads();
}

struct Frame {
    LAS unsigned char* lds;
    unsigned* ctl;
    int vcu, G;
};

__device__ __forceinline__ void p0_tile(const float* W, int N, int k0, int n0, bf16* WT, int Kd, int drow0, LAS float* scr, int lane, const float* gk = nullptr) {
#pragma unroll 16
    for (int i = 0; i < 32; ++i) { const int kk = 2 * i + (lane >> 5); float w = W[(size_t)(k0 + kk) * N + n0 + (lane & 31)]; if (gk) w *= gk[k0 + kk]; scr[kk * 33 + (lane & 31)] = w; }
    LDS_WAIT(); asm volatile("" ::: "memory");
    const int c = lane & 7;
#pragma unroll
    for (int j = 0; j < 4; ++j) { const int n = (lane >> 3) + 8 * j; const LAS float* s = scr + (8 * c) * 33 + n;
        v4u o; o.x = pk2(s[0 * 33], s[1 * 33]); o.y = pk2(s[2 * 33], s[3 * 33]); o.z = pk2(s[4 * 33], s[5 * 33]); o.w = pk2(s[6 * 33], s[7 * 33]);
        *(GAS v4u*)(WT + (size_t)(drow0 + n) * Kd + k0 + 8 * c) = o; }
    LDS_WAIT(); asm volatile("" ::: "memory");
}
__device__ __forceinline__ void p0_plain(const float* W, int K, int N, bf16* WT, int row_off, int item, LAS float* scr, int lane) {
    const int nblk = N / 32, kb = item / nblk, nb = item % nblk;
    p0_tile(W, N, 64 * kb, 32 * nb, WT, K, row_off + 32 * nb, scr, lane);
}
__device__ __forceinline__ void rms_row_to_bf16(const float* xrow, const float* g, bf16* orow, int lane) {
    const GAS f32x4* xr = (const GAS f32x4*)xrow + lane; const GAS f32x4* gr = (const GAS f32x4*)g + lane;
    f32x4 v[4]; float s = 0.f;
#pragma unroll
    for (int j = 0; j < 4; ++j) { v[j] = xr[64 * j]; s += (v[j].x * v[j].x + v[j].y * v[j].y) + (v[j].z * v[j].z + v[j].w * v[j].w); }
    const float r = 1.f / sqrtf(wave_sum(s) * (1.f / D) + RMS_EPS);
    GAS unsigned long long* o8 = (GAS unsigned long long*)orow + lane;
#pragma unroll
    for (int j = 0; j < 4; ++j) { const f32x4 gg = gr[64 * j]; const f32x4 h = v[j] * r * gg;
        o8[64 * j] = (unsigned long long)pk2(h.x, h.y) | ((unsigned long long)pk2(h.z, h.w) << 32); }
}

__device__ __forceinline__ void rms_rows4_to_bf16(const float* xrow, const float* g, bf16* orow, int lane) {
    const GAS f32x4* xr = (const GAS f32x4*)xrow + lane; const GAS f32x4* gr = (const GAS f32x4*)g + lane;
    f32x4 v[4][4]; float s[4];
#pragma unroll
    for (int q = 0; q < 4; ++q)
#pragma unroll
        for (int j = 0; j < 4; ++j) v[q][j] = xr[q * 256 + 64 * j];
#pragma unroll
    for (int q = 0; q < 4; ++q) { s[q] = 0.f;
#pragma unroll
        for (int j = 0; j < 4; ++j) s[q] += (v[q][j].x * v[q][j].x + v[q][j].y * v[q][j].y) + (v[q][j].z * v[q][j].z + v[q][j].w * v[q][j].w); }
#pragma unroll
    for (int o = 1; o < 64; o <<= 1) {
#pragma unroll
        for (int q = 0; q < 4; ++q) s[q] += __shfl_xor(s[q], o); }
    f32x4 gg[4];
#pragma unroll
    for (int j = 0; j < 4; ++j) gg[j] = gr[64 * j];
#pragma unroll
    for (int q = 0; q < 4; ++q) { const float r = 1.f / sqrtf(s[q] * (1.f / D) + RMS_EPS);
        GAS unsigned long long* o8 = (GAS unsigned long long*)(orow + (size_t)q * D) + lane;
#pragma unroll
        for (int j = 0; j < 4; ++j) { const f32x4 h = v[q][j] * r * gg[j]; o8[64 * j] = (unsigned long long)pk2(h.x, h.y) | ((unsigned long long)pk2(h.z, h.w) << 32); } }
}

__device__ __forceinline__ void build_tile_tables(Frame& F, const int tid) {
    LAS int* TB = (LAS int*)(F.lds + LDSX_OFF); LAS unsigned char* t2e = F.lds + LDSX_OFF + 128;
    __syncthreads();
    if (tid == 0) { int acc = 0;
        for (int e = 0; e < NEXP; ++e) { const int n = (int)__hip_atomic_load(F.ctl + CW_CNT + e, __ATOMIC_RELAXED, __HIP_MEMORY_SCOPE_AGENT); TB[e] = acc; acc += (n + 255) >> 8; }
        TB[NEXP] = acc; }
    __syncthreads();
    for (int t = tid; t < 1024; t += NWAVES * 64) { int e = 0;
#pragma unroll
        for (int k = 1; k < NEXP; ++k) e += (t >= TB[k]) ? 1 : 0;
        t2e[t] = (unsigned char)e; }
    __syncthreads();
}

struct Args { const float* in[26]; float* out; unsigned char* ws; int ph_lo, ph_hi; };

__global__ void __launch_bounds__(NWAVES * 64, 2) hybrid_fwd(Args args) {
    extern __shared__ __attribute__((aligned(16))) unsigned char lds[];
    __builtin_assume(__builtin_amdgcn_workitem_id_y() == 0); __builtin_assume(__builtin_amdgcn_workitem_id_z() == 0);
    Frame F;
    F.lds = (LAS unsigned char*)lds;
    F.G = gridDim.x; { const int bx = blockIdx.x; F.vcu = (F.G % 8 == 0) ? (bx % 8) * (F.G / 8) + bx / 8 : bx; }
    F.ctl = (unsigned*)(args.ws + WS_CTL);
#define x_in (args.in[0])
#define mem_in (args.in[1])
#define norm_mix_g (args.in[2])
#define w_in (args.in[3])
#define pool_w (args.in[4])
#define pool_scale (args.in[5])
#define lam_q1 (args.in[6])
#define lam_k1 (args.in[7])
#define lam_q2 (args.in[8])
#define lam_k2 (args.in[9])
#define subln_g (args.in[10])
#define norm_mem_g (args.in[11])
#define w_mem_kv (args.in[12])
#define p_pool (args.in[13])
#define p_diff (args.in[14])
#define p_mem (args.in[15])
#define w_o (args.in[16])
#define norm_ffn_g (args.in[17])
#define w_rg (args.in[18])
#define b_rg (args.in[19])
#define w_re (args.in[20])
#define b_re (args.in[21])
#define w_eg (args.in[22])
#define w_eu (args.in[23])
#define w_ed (args.in[24])
#define final_g (args.in[25])
#define Win_t ((bf16*)(args.ws + WS_WIN))
#define Pc_t ((bf16*)(args.ws + WS_PC))
#define Wo_t ((bf16*)(args.ws + WS_WO))
#define Wgu_t ((bf16*)(args.ws + WS_WGU))
#define Wd_t ((bf16*)(args.ws + WS_WD))
#define KV ((bf16*)(args.ws + WS_KV))
#define XN ((bf16*)(args.ws + WS_XN))
#define BR ((bf16*)(args.ws + WS_BR))
#define H2 ((bf16*)(args.ws + WS_H2))
#define PROJ ((bf16*)(args.ws + WS_PROJ))
#define MERGED ((bf16*)(args.ws + WS_MERGED))
#define HID ((bf16*)(args.ws + WS_HID))
#define ATTO ((bf16*)(args.ws + WS_ATTO))
#define GATES ((bf16*)(args.ws + WS_GATES))
#define Y ((bf16*)(args.ws + WS_Y))
#define ROUTE ((v4u*)(args.ws + WS_ROUTE))
#define RWE ((float*)(args.ws + WS_RWE))
#define LIST ((int*)(args.ws + WS_LIST))
#define WRF ((bf16*)(args.ws + WS_WRF))
#define RINV ((float*)(args.ws + WS_RINV))
#define X1 (args.out)
    const int NGW = F.G * NWAVES;
#define PHASE_IDS int tid = threadIdx.x; asm volatile("" : "+v"(tid)); const int lane = tid & 63, wave = __builtin_amdgcn_readfirstlane(tid >> 6), gw = F.vcu * NWAVES + wave; (void)lane; (void)gw;
    const int lo = args.ph_lo, hi = args.ph_hi;
    cg::grid_group grid = cg::this_grid();
#ifndef PH_MASK
#define PH_MASK 0x3ff
#endif
#define IN(k) (((PH_MASK >> (k)) & 1) && lo <= (k) && (k) < hi)
#ifndef PROBE_A
#define PROBE_A -1
#endif
#ifndef PROBE_B
#define PROBE_B -1
#endif
#ifndef PROBE_A2
#define PROBE_A2 (PROBE_A + 1)
#endif
#ifndef PROBE_B2
#define PROBE_B2 (PROBE_B + 1)
#endif
#define STAMP(k) do { if ((PROBE_A >= 0 || PROBE_B >= 0) && blockIdx.x == 0 && threadIdx.x == 0) ((unsigned long long*)(F.ctl + CW_TS))[k] = __builtin_amdgcn_s_memrealtime(); } while (0)
#define SEAM(k) do { if (IN(k) && IN((k) + 1)) { if ((k) == 0) grid.sync(); else { XcdBarrier b_; b_.bar = (unsigned*)(args.ws + WS_CTL) + CW_BAR; b_.x = xb_xcc_id(); b_.st = (volatile LAS unsigned*)(F.lds + LDSX_OFF + 2048); xcd_barrier(b_); } } STAMP((k) + 1); } while (0)
    if (threadIdx.x < 2) ((LAS unsigned*)(F.lds + LDSX_OFF + 2048))[threadIdx.x] = 0u;
    __syncthreads();
    if (lo < hi - 1) (void)xcd_barrier_post((unsigned*)(args.ws + WS_CTL) + CW_BAR, (volatile LAS unsigned*)(F.lds + LDSX_OFF + 2048));
    STAMP(0);

    if (IN(0)) {
        PHASE_IDS
        LAS float* scr = (LAS float*)(F.lds + RING_OFF + wave * 16384);
        constexpr int I_IN = 16 * 160, I_KV = 16 * 16, I_PD = 8 * 32, I_PM = 4 * 32, I_WO = 16 * 32, I_EG = 16 * 256, I_EU = 16 * 256, I_ED = 16 * 256;
        constexpr int NITEMS = I_IN + I_KV + I_PD + I_PM + I_WO + I_EG + I_EU + I_ED;
        for (int it = gw; it < NITEMS; it += NGW) {
            int r = it;
            if (r < I_IN) { p0_plain(w_in, D, INCOLS, Win_t, 0, r, scr, lane); continue; } r -= I_IN;
            if (r < I_KV) { p0_plain(w_mem_kv, D, 512, Win_t, INCOLS, r, scr, lane); continue; } r -= I_KV;
            if (r < I_PD) { const int kb = r >> 5, nb = r & 31; p0_tile(p_diff, D, 64 * kb, 32 * nb, Pc_t + 256, D, 32 * nb, scr, lane); continue; } r -= I_PD;
            if (r < I_PM) { const int kb = r >> 5, nb = r & 31; p0_tile(p_mem, D, 64 * kb, 32 * nb, Pc_t + 768, D, 32 * nb, scr, lane); continue; } r -= I_PM;
            if (r < I_WO) { p0_plain(w_o, D, D, Wo_t, 0, r, scr, lane); continue; } r -= I_WO;
            if (r < I_EG + I_EU) { const bool up = r >= I_EG; if (up) r -= I_EG;
                const int e = r >> 8, rr = r & 255, kb = rr >> 4, nb = rr & 15, n0 = 32 * nb;
                p0_tile((up ? w_eu : w_eg) + (size_t)e * D * EH, EH, 64 * kb, n0, Wgu_t + (size_t)e * D * D, D, (n0 >> 7) * 256 + (n0 & 127) + (up ? 128 : 0), scr, lane, norm_ffn_g); continue; }
            r -= I_EG + I_EU;
            { const int e = r >> 8, rr = r & 255, kb = rr >> 5, nb = rr & 31;
              p0_tile(w_ed + (size_t)e * EH * D, D, 64 * kb, 32 * nb, Wd_t + (size_t)e * D * EH, EH, 32 * nb, scr, lane); }
        }
        STAMP(12);
        for (int idx = (F.vcu * NWAVES * 64 + tid); idx < 5120; idx += F.G * NWAVES * 64) {
            const int q = idx % 20, h = (idx / 20) & 1, hl = (idx / 40) & 1, st = idx / 80, k0 = 32 * (st >> 1) + 16 * h + 8 * (st & 1);
            float v[8];
#pragma unroll
            for (int j = 0; j < 8; ++j) { const int k = k0 + j; const float w = norm_ffn_g[k] * (q < 4 ? w_rg[k * 4 + q] : w_re[k * 16 + (q - 4)]); const float hi = bflo(f2bf(w) ); v[j] = hl ? (w - hi) : w; }
            v4u o; o.x = pk2(v[0], v[1]); o.y = pk2(v[2], v[3]); o.z = pk2(v[4], v[5]); o.w = pk2(v[6], v[7]);
            *((GAS v4u*)WRF + idx) = o;
        }
        for (int idx = (F.vcu * NWAVES * 64 + tid); idx < 256 * 1024; idx += F.G * NWAVES * 64) {
            const int kc = idx >> 10, n = idx & 1023, g = kc >> 6; float a = 0.f;
#pragma unroll 16
            for (int d = 0; d < 64; ++d) a += pool_w[kc * 64 + d] * pool_scale[g * 64 + d] * p_pool[(size_t)(g * 64 + d) * D + n];
            Pc_t[(size_t)n * D + kc] = (bf16)f2bf(a);
        }
        STAMP(13);
        for (int m = gw * 4; m < T + TM; m += NGW * 4) {
            if (m < T) rms_rows4_to_bf16(x_in + (size_t)m * D, norm_mix_g, XN + (size_t)m * D, lane);
            else rms_rows4_to_bf16(mem_in + (size_t)(m - T) * D, norm_mem_g, XN + (size_t)m * D, lane);
        }
    }
    SEAM(0);

    if (IN(1)) {
        pg8::Gemm g{XN, Win_t, T, INCOLS, D};
        pg8::ProjOrder S; S.so.init(T, INCOLS, F.G, (int)blockIdx.x);
        pg8::EpiProj E{PROJ, GATES, KV, attn_body::C2};
        pg8::gemm_phase<pg8::EpiProj, pg8::ProjOrder, true, true>(F.lds + RING_OFF, g, S, E);
    }
    SEAM(1);

    if (IN(2)) {
        PHASE_IDS
        typedef attn_body::bf16 abf;
        struct DiffOrder { int vcu, G;
            __device__ __forceinline__ bool next(int i, int& bhm, int& vh, int& qb) const { bhm = vcu + (i >> 4) * G; if (bhm >= BATCH * 8) return false; vh = (i >> 3) & 1; const int k = i & 7; qb = (k & 1) ? (k >> 1) : 7 - (k >> 1); return true; } };
        struct MemOrder { int vcu, G;
            __device__ __forceinline__ bool next(int i, int& mu, int& qb) const { mu = vcu + (i >> 2) * G; if (mu >= BATCH * 8) return false; qb = (mu & 1) * 4 + (i & 3); return true; } };
        { const DiffOrder S{F.vcu, F.G}; int bhm, vh, qb;
          for (int i = 0; S.next(i, bhm, vh, qb); ++i) {
            const int b = bhm >> 3, h = (bhm >> 1) & 3, m = bhm & 1; const size_t rb = (size_t)b * SEQ;
            const abf* Qu = (const abf*)PROJ + (rb + qb * 256) * PROJW + 256 + h * 128 + m * 64;
            const abf* Kh = (const abf*)PROJ + rb * PROJW + 768 + h * 128 + m * 64;
            const abf* Vh = (const abf*)PROJ + rb * PROJW + 1280 + h * 128 + vh * 64;
            abf* Ou = (abf*)ATTO + (rb + qb * 256) * D + m * 512 + h * 128 + vh * 64;
            asm volatile("" : "+s"(Qu), "+s"(Kh), "+s"(Vh), "+s"(Ou));
            attn_body::attn_unit<8, true>(Qu, PROJW, Kh, Vh, PROJW, Ou, D, 4 * (qb + 1), (char*)lds + RING_OFF); } }
        { const MemOrder S{F.vcu, F.G}; int mu, qb;
          for (int i = 0; S.next(i, mu, qb); ++i) {
            const int b = mu >> 3, mh = (mu >> 1) & 3;
            const abf* Qu = (const abf*)PROJ + ((size_t)b * SEQ + qb * 256) * PROJW + 1792 + mh * 64;
            const abf* Kh = (const abf*)KV + (size_t)b * NMEM * 512 + mh * 64;
            const abf* Vh = (const abf*)KV + (size_t)b * NMEM * 512 + 256 + mh * 64;
            abf* Ou = (abf*)BR + ((size_t)b * SEQ + qb * 256) * D + 768 + mh * 64;
            asm volatile("" : "+s"(Qu), "+s"(Kh), "+s"(Vh), "+s"(Ou));
            attn_body::attn_unit<8, false>(Qu, PROJW, Kh, Vh, 512, Ou, D, 4, (char*)lds + RING_OFF); } }
    }
    SEAM(2);

    if (IN(3)) {
        PHASE_IDS
        float lam;
        { const float s1 = wave_sum(lam_q1[lane] * lam_k1[lane]), s2 = wave_sum(lam_q2[lane] * lam_k2[lane]); lam = __expf(s1) - __expf(s2) + 0.2f; }
        const int gi = lane >> 4, w = 2 << gi;
        float sg[8];
#pragma unroll
        for (int i = 0; i < 8; ++i) sg[i] = subln_g[((8 * lane) & 127) + i] * 0.8f;
        for (int t = gw; t < T; t += NGW) {
            const int s = t & (SEQ - 1);
            const GAS v2u* up = (const GAS v2u*)(PROJ + (size_t)t * PROJW) + lane;
            const v2u ut = up[0];
            float a0 = 0.f, a1 = 0.f, a2 = 0.f, a3 = 0.f;
            const int nw = (w < s + 1) ? w : s + 1;
            v2u wq[16];
#pragma unroll
            for (int j = 0; j < 16; ++j) { wq[j] = (v2u){0u, 0u}; if (j < nw) wq[j] = *(const GAS v2u*)((const GAS bf16*)up - (size_t)j * PROJW); }
#pragma unroll
            for (int j = 0; j < 16; ++j) { a0 += bflo(wq[j].x); a1 += bfhi(wq[j].x); a2 += bflo(wq[j].y); a3 += bfhi(wq[j].y); }
            const float inv = 1.f / (float)nw;
            v2u po; po.x = pk2(a0 * inv - bflo(ut.x), a1 * inv - bfhi(ut.x)); po.y = pk2(a2 * inv - bflo(ut.y), a3 * inv - bfhi(ut.y));
            *((GAS v2u*)(BR + (size_t)t * D) + lane) = po;
            const v4u o0 = *((const GAS v4u*)(ATTO + (size_t)t * D) + lane), o1 = *((const GAS v4u*)(ATTO + (size_t)t * D + 512) + lane);
            float xv[8];
            xv[0] = bflo(o0.x) - lam * bflo(o1.x); xv[1] = bfhi(o0.x) - lam * bfhi(o1.x); xv[2] = bflo(o0.y) - lam * bflo(o1.y); xv[3] = bfhi(o0.y) - lam * bfhi(o1.y);
            xv[4] = bflo(o0.z) - lam * bflo(o1.z); xv[5] = bfhi(o0.z) - lam * bfhi(o1.z); xv[6] = bflo(o0.w) - lam * bflo(o1.w); xv[7] = bfhi(o0.w) - lam * bfhi(o1.w);
            float ss = 0.f;
#pragma unroll
            for (int i = 0; i < 8; ++i) ss += xv[i] * xv[i];
            ss += __shfl_xor(ss, 1); ss += __shfl_xor(ss, 2); ss += __shfl_xor(ss, 4); ss += __shfl_xor(ss, 8);
            const float r = 1.f / sqrtf(ss * (1.f / 128.f) + RMS_EPS);
            v4u od; od.x = pk2(xv[0] * r * sg[0], xv[1] * r * sg[1]); od.y = pk2(xv[2] * r * sg[2], xv[3] * r * sg[3]); od.z = pk2(xv[4] * r * sg[4], xv[5] * r * sg[5]); od.w = pk2(xv[6] * r * sg[6], xv[7] * r * sg[7]);
            *((GAS v4u*)(BR + (size_t)t * D + 256) + lane) = od;
        }
    }
    SEAM(3);

    if (IN(4)) {
        pg8::StaticOrder S; S.init(T, D, F.G, (int)blockIdx.x);
        pg8::Gemm g{BR, Pc_t, T, D, D}; pg8::EpiMerge E{GATES, MERGED}; pg8::MidRescale MH{GATES};
        pg8::gemm_phase<pg8::EpiMerge, pg8::StaticOrder, true, true, pg8::MidRescale>(F.lds + RING_OFF, g, S, E, MH);
    }
    SEAM(4);

    if (IN(5)) {
        pg8::Gemm g{MERGED, Wo_t, T, D, D}; pg8::StaticOrder S; S.init(T, D, F.G, (int)blockIdx.x);
        pg8::EpiWo E{x_in, X1};
        pg8::gemm_phase<pg8::EpiWo, pg8::StaticOrder, true, true>(F.lds + RING_OFF, g, S, E);
    }
    SEAM(5);

    if (IN(6)) {
        PHASE_IDS
        LAS v4u* WL = (LAS v4u*)(F.lds + RING_OFF);
        LAS float* SC = (LAS float*)(F.lds + RING_OFF + 81920) + wave * 1024;
        LAS v4u* REC = (LAS v4u*)(F.lds + RING_OFF + 81920 + 32768);
        LAS unsigned* LCNT = (LAS unsigned*)(F.lds + RING_OFF + 81920 + 32768 + 4096);
        LAS unsigned* LBASE = LCNT + 16; LAS float* RIL = (LAS float*)(LCNT + 32);
        for (int idx = tid; idx < 5120; idx += NWAVES * 64) WL[idx] = *((const GAS v4u*)WRF + idx);
        float bg[4], be[16];
#pragma unroll
        for (int i = 0; i < 4; ++i) bg[i] = b_rg[i];
#pragma unroll
        for (int i = 0; i < 16; ++i) be[i] = b_re[i];
        const int r32 = lane & 31, hh = lane >> 5;
        for (int rb0 = F.vcu * 256; rb0 < T; rb0 += F.G * 256) {
            if (tid < 16) LCNT[tid] = 0u;
            __syncthreads();
            const int li = wave * 32 + r32, row = rb0 + li;
            const GAS f32x4* xp = (const GAS f32x4*)(X1 + (size_t)row * D + 16 * hh);
            GAS v4u* hp = (GAS v4u*)(H2 + (size_t)row * D + 16 * hh);
            const LAS v4u* wl = WL + hh * 20 + r32;
            f32x16_t acc = {}; float ss = 0.f;
            f32x4 cur[8];
#pragma unroll
            for (int i = 0; i < 8; ++i) cur[i] = xp[(i >> 2) * 8 + (i & 3)];
#pragma unroll 1
            for (int sp2 = 0; sp2 < 16; ++sp2) {
                f32x4 nxt[8];
                const int spn = (sp2 + 1 < 16) ? sp2 + 1 : sp2;
#pragma unroll
                for (int i = 0; i < 8; ++i) nxt[i] = xp[(2 * spn + (i >> 2)) * 8 + (i & 3)];
#pragma unroll
                for (int u = 0; u < 2; ++u) { const int sp = 2 * sp2 + u;
                    v4u ahi[2], alo[2];
#pragma unroll
                    for (int e = 0; e < 2; ++e) { const f32x4 a = cur[4 * u + 2 * e], b = cur[4 * u + 2 * e + 1];
                        ss += (a.x * a.x + a.y * a.y) + (a.z * a.z + a.w * a.w) + (b.x * b.x + b.y * b.y) + (b.z * b.z + b.w * b.w);
                        v4u h; h.x = cvtpk(a.x, a.y); h.y = cvtpk(a.z, a.w); h.z = cvtpk(b.x, b.y); h.w = cvtpk(b.z, b.w); ahi[e] = h;
                        v4u l; l.x = cvtpk(a.x - bflo(h.x), a.y - bfhi(h.x)); l.y = cvtpk(a.z - bflo(h.y), a.w - bfhi(h.y)); l.z = cvtpk(b.x - bflo(h.z), b.y - bfhi(h.z)); l.w = cvtpk(b.z - bflo(h.w), b.w - bfhi(h.w)); alo[e] = l; }
                    hp[sp * 4] = ahi[0]; hp[sp * 4 + 1] = ahi[1];
#pragma unroll
                    for (int e = 0; e < 2; ++e) { const int st = 2 * sp + e;
                        v4u bh = {0u, 0u, 0u, 0u}, bl = {0u, 0u, 0u, 0u};
                        if (r32 < 20) { bh = wl[(st * 4) * 20]; bl = wl[(st * 4 + 2) * 20]; }
                        acc = __builtin_amdgcn_mfma_f32_32x32x16_bf16(__builtin_bit_cast(bf16x8_t, ahi[e]), __builtin_bit_cast(bf16x8_t, bh), acc, 0, 0, 0);
                        acc = __builtin_amdgcn_mfma_f32_32x32x16_bf16(__builtin_bit_cast(bf16x8_t, alo[e]), __builtin_bit_cast(bf16x8_t, bh), acc, 0, 0, 0);
                        acc = __builtin_amdgcn_mfma_f32_32x32x16_bf16(__builtin_bit_cast(bf16x8_t, ahi[e]), __builtin_bit_cast(bf16x8_t, bl), acc, 0, 0, 0); } }
#pragma unroll
                for (int i = 0; i < 8; ++i) cur[i] = nxt[i];
            }
            ss += __shfl_xor(ss, 32);
            const float rinv = 1.f / sqrtf(ss * (1.f / D) + RMS_EPS);
#pragma unroll
            for (int r = 0; r < 16; ++r) SC[((r & 3) + 8 * (r >> 2) + 4 * hh) * 32 + r32] = acc[r];
            LDS_WAIT();
            if (lane < 32) {
                float lg[20];
#pragma unroll
                for (int q4 = 0; q4 < 5; ++q4) { const f32x4 t4 = *(const LAS f32x4*)(SC + lane * 32 + 4 * q4); lg[4 * q4] = t4.x * rinv; lg[4 * q4 + 1] = t4.y * rinv; lg[4 * q4 + 2] = t4.z * rinv; lg[4 * q4 + 3] = t4.w * rinv; }
                float gl[4];
#pragma unroll
                for (int i = 0; i < 4; ++i) gl[i] = lg[i] + bg[i];
                int gidx = 0; float gmax = gl[0];
#pragma unroll
                for (int i = 1; i < 4; ++i) if (gl[i] > gmax) { gmax = gl[i]; gidx = i; }
                float gsum = 0.f;
#pragma unroll
                for (int i = 0; i < 4; ++i) gsum += __expf(gl[i] - gmax);
                const float gp = 1.f / gsum;
                float el[4];
#pragma unroll
                for (int j = 0; j < 4; ++j) { const float l0 = lg[4 + j] + be[j], l1 = lg[8 + j] + be[4 + j], l2 = lg[12 + j] + be[8 + j], l3 = lg[16 + j] + be[12 + j];
                    el[j] = gidx == 0 ? l0 : gidx == 1 ? l1 : gidx == 2 ? l2 : l3; }
                int i0 = 0; float m0 = el[0];
#pragma unroll
                for (int j = 1; j < 4; ++j) if (el[j] > m0) { m0 = el[j]; i0 = j; }
                int i1 = -1; float m1 = -3.0e38f;
#pragma unroll
                for (int j = 0; j < 4; ++j) if (j != i0 && el[j] > m1) { m1 = el[j]; i1 = j; }
                if (i1 < 0) { i1 = (i0 + 1) & 3; m1 = m0; }
                const float p1 = __expf(m1 - m0);
                const float w0 = gp / (1.f + p1), w1 = gp * p1 / (1.f + p1);
                const unsigned e0 = (unsigned)(gidx * 4 + i0), e1 = (unsigned)(gidx * 4 + i1);
                const unsigned s0 = __hip_atomic_fetch_add(LCNT + e0, 1u, __ATOMIC_RELAXED, __HIP_MEMORY_SCOPE_WORKGROUP), s1 = __hip_atomic_fetch_add(LCNT + e1, 1u, __ATOMIC_RELAXED, __HIP_MEMORY_SCOPE_WORKGROUP);
                v4u rc; rc.x = (e0 << 20) | s0; rc.y = (e1 << 20) | s1; rc.z = __float_as_uint(w0); rc.w = __float_as_uint(w1); REC[li] = rc;
                RINV[row] = rinv; RIL[li] = rinv;
            }
            __syncthreads();
            if (tid < 16) LBASE[tid] = __hip_atomic_fetch_add(F.ctl + CW_CNT + tid, LCNT[tid], __ATOMIC_RELAXED, __HIP_MEMORY_SCOPE_AGENT);
            __syncthreads();
            if (tid < 256) { v4u rc = REC[tid]; rc.x += LBASE[rc.x >> 20]; rc.y += LBASE[rc.y >> 20]; *((GAS v4u*)ROUTE + rb0 + tid) = rc;
                const unsigned i0 = ((rc.x >> 20) << 16) + (rc.x & 0xFFFFFu), i1 = ((rc.y >> 20) << 16) + (rc.y & 0xFFFFFu); const float ri = RIL[tid];
                LIST[i0] = rb0 + tid; LIST[i1] = rb0 + tid; RWE[2 * i0] = ri; RWE[2 * i0 + 1] = __uint_as_float(rc.z); RWE[2 * i1] = ri; RWE[2 * i1 + 1] = __uint_as_float(rc.w); }
            __syncthreads();
        }
    }
    SEAM(6);

    if (IN(7)) {
        PHASE_IDS
        build_tile_tables(F, tid);
        const LAS int* TB = (const LAS int*)(F.lds + LDSX_OFF); const LAS unsigned char* t2e = (const LAS unsigned char*)(F.lds + LDSX_OFF + 128);
        LAS int* TOKL = (LAS int*)(F.lds + LDSX_OFF + 4096);
        const int nunits = TB[NEXP] * 4;
        for (int i = 0; i < 11; ++i) { const int L = i * F.G + F.vcu; if (L >= nunits) break;
            const int pm = L >> 2, e = t2e[pm], lt = pm - TB[e];
            if (tid < 256) { unsigned tok = (unsigned)LIST[(e << 16) + lt * 256 + tid]; tok = tok < (unsigned)T ? tok : (unsigned)(T - 1); TOKL[i * 256 + tid] = (int)tok; } }
        __syncthreads();
        pg8::Gemm g{H2, Wgu_t, T, NEXP * D, D};
        pg8::MoeOrder S{t2e, nunits, F.G, F.vcu};
        pg8::EpiGateUp E{HID, RWE, TB};
        pg8::gemm_phase<pg8::EpiGateUp, pg8::MoeOrder, true, true, pg8::NoMid, true>(F.lds + RING_OFF, g, S, E, pg8::NoMid(), TOKL);
    }
    SEAM(7);

    if (IN(8)) {
        PHASE_IDS
        build_tile_tables(F, tid);
        const LAS int* TB = (const LAS int*)(F.lds + LDSX_OFF);
        pg8::Gemm g{HID, Wd_t, MAXROWS, NEXP * D, EH};
        pg8::MoeOrder S{(const LAS unsigned char*)(F.lds + LDSX_OFF + 128), TB[NEXP] * 4, F.G, F.vcu};
        pg8::EpiDown E{Y};
        pg8::gemm_phase<pg8::EpiDown, pg8::MoeOrder, true, true>(F.lds + RING_OFF, g, S, E);
    }
    SEAM(8);

    if (IN(9)) {
        PHASE_IDS
        build_tile_tables(F, tid);
        const LAS int* TB = (const LAS int*)(F.lds + LDSX_OFF);
        for (int t = gw; t < T; t += NGW) {
            const v4u rc = *((const GAS v4u*)ROUTE + t);
            const size_t r0 = (size_t)TB[rc.x >> 20] * 256 + (rc.x & 0xFFFFFu), r1 = (size_t)TB[rc.y >> 20] * 256 + (rc.y & 0xFFFFFu);
            GAS f32x4* xr = (GAS f32x4*)(X1 + (size_t)t * D) + lane; const GAS f32x4* gr = (const GAS f32x4*)final_g + lane;
            const GAS v2u* y0 = (const GAS v2u*)(Y + r0 * D) + lane; const GAS v2u* y1 = (const GAS v2u*)(Y + r1 * D) + lane;
            f32x4 v[4]; float s = 0.f;
#pragma unroll
            for (int j = 0; j < 4; ++j) { v[j] = xr[64 * j]; const v2u a = y0[64 * j], b = y1[64 * j];
                v[j].x += bflo(a.x) + bflo(b.x); v[j].y += bfhi(a.x) + bfhi(b.x); v[j].z += bflo(a.y) + bflo(b.y); v[j].w += bfhi(a.y) + bfhi(b.y);
                s += (v[j].x * v[j].x + v[j].y * v[j].y) + (v[j].z * v[j].z + v[j].w * v[j].w); }
            const float r = 1.f / sqrtf(wave_sum(s) * (1.f / D) + RMS_EPS);
#pragma unroll
            for (int j = 0; j < 4; ++j) { f32x4 o = v[j] * r * gr[64 * j];
                if (PROBE_B >= 0 && blockIdx.x == 0 && (t / NGW) < 8) {
                    const unsigned long long* ts = (const unsigned long long*)(F.ctl + CW_TS); const float amp = sqrtf((float)((ts[PROBE_B2] - ts[PROBE_B]) / 100) * 1e-3f);
                    o.x += amp; o.y += amp; o.z += amp; o.w += amp; }
                xr[64 * j] = o; }
        }
        STAMP(10);
        if (PROBE_A >= 0 && blockIdx.x == 0 && threadIdx.x == 0) {
            const unsigned long long* ts = (const unsigned long long*)(F.ctl + CW_TS);
            X1[0] += 4.f + (float)((ts[PROBE_A2] - ts[PROBE_A]) / 100) * 0.01f; }
    }
#undef IN
#undef SEAM
#undef STAMP
#undef PHASE_IDS
#undef x_in
#undef mem_in
#undef norm_mix_g
#undef w_in
#undef pool_w
#undef pool_scale
#undef lam_q1
#undef lam_k1
#undef lam_q2
#undef lam_k2
#undef subln_g
#undef norm_mem_g
#undef w_mem_kv
#undef p_pool
#undef p_diff
#undef p_mem
#undef w_o
#undef norm_ffn_g
#undef w_rg
#undef b_rg
#undef w_re
#undef b_re
#undef w_eg
#undef w_eu
#undef w_ed
#undef final_g
#undef Win_t
#undef Pc_t
#undef Wo_t
#undef Wgu_t
#undef Wd_t
#undef KV
#undef XN
#undef BR
#undef H2
#undef PROJ
#undef MERGED
#undef HID
#undef ATTO
#undef GATES
#undef Y
#undef ROUTE
#undef RWE
#undef LIST
#undef WRF
#undef RINV
#undef X1
}

extern "C" void kernel_launch(void* const* d_in, const int* in_sizes, int n_in, void* d_out, int out_size, void* d_ws, size_t ws_size, hipStream_t stream) {
    static int grid = 0;
    if (grid == 0) {
        if (n_in != 26 || in_sizes[0] != T * D || out_size != T * D || ws_size < WS_END) { fprintf(stderr, "kernel_launch: unexpected problem: n_in %d in0 %d out %d ws %zu (need %zu)\n", n_in, n_in > 0 ? in_sizes[0] : -1, out_size, ws_size, (size_t)WS_END); grid = -1; return; }
        int dev = 0, cus = 0, per_cu = 0;
        if (hipGetDevice(&dev) != hipSuccess || hipDeviceGetAttribute(&cus, hipDeviceAttributeMultiprocessorCount, dev) != hipSuccess) { fprintf(stderr, "kernel_launch: device query failed\n"); grid = -1; return; }
        if (hipFuncSetAttribute((const void*)hybrid_fwd, hipFuncAttributeMaxDynamicSharedMemorySize, LDS_BYTES) != hipSuccess) { fprintf(stderr, "kernel_launch: hipFuncSetAttribute failed\n"); grid = -1; return; }
        if (hipOccupancyMaxActiveBlocksPerMultiprocessor(&per_cu, (const void*)hybrid_fwd, NWAVES * 64, LDS_BYTES) != hipSuccess || per_cu < 1) { fprintf(stderr, "kernel_launch: occupancy query says %d blocks per CU\n", per_cu); grid = -1; return; }
        (void)hipGetLastError();
        grid = cus;
        if (grid > 256) grid = 256;
    }
    if (grid < 0) return;
    if (hipMemsetAsync((char*)d_ws + WS_CTL, 0, CTL_ZERO_BYTES, stream) != hipSuccess) { fprintf(stderr, "kernel_launch: memset failed\n"); return; }
    Args a{};
    for (int i = 0; i < 26; ++i) a.in[i] = (const float*)d_in[i];
    a.out = (float*)d_out; a.ws = (unsigned char*)d_ws;
#if MK_N_LAUNCHES == 1
    a.ph_lo = 0; a.ph_hi = NPH;
    void* kargs[] = {&a};
    hipError_t e = hipLaunchCooperativeKernel((const void*)hybrid_fwd, dim3(grid), dim3(NWAVES * 64), kargs, LDS_BYTES, stream);
    if (e != hipSuccess) fprintf(stderr, "kernel_launch: cooperative launch failed: %s (grid %d)\n", hipGetErrorString(e), grid);
#else
    for (int p = 0; p < NPH; ++p) { a.ph_lo = p; a.ph_hi = p + 1;
        hipLaunchKernelGGL(hybrid_fwd, dim3(grid), dim3(NWAVES * 64), LDS_BYTES, stream, a);
        const hipError_t le = hipPeekAtLastError(); if (le != hipSuccess) { fprintf(stderr, "kernel_launch: launch %d failed: %s\n", p, hipGetErrorName(le)); break; } }
#endif
}
```

```cpp
#include <hip/hip_runtime.h>
#include <hip/hip_cooperative_groups.h>
#include <cstdio>
#include <cstdint>
namespace cg = cooperative_groups;
namespace pg8 {
#define PG8_LAS __attribute__((address_space(3)))
typedef unsigned short bf16_t;
typedef short bf16x8 __attribute__((ext_vector_type(8)));
typedef float f32x4 __attribute__((ext_vector_type(4)));
typedef unsigned u32x4 __attribute__((ext_vector_type(4)));
constexpr int BM = 256, BK = 64, HALF = 128, HTB = HALF * BK * 2  , STAGE_BYTES = 8 * HTB, NXCD = 8, WGM = 8;

__host__ __device__ __forceinline__ int lds_byte(int r, int c) { const int st = (r >> 4) * 2 + (c >> 5), rr = r & 15, cc = c & 31, ob = rr * 64 + cc * 2; return st * 1024 + (ob ^ (((ob >> 9) & 1) << 5)); }
__host__ __device__ __forceinline__ void stage_rc(int b, int& R, int& C) { const int st = b / 1024, sb = b % 1024, swz = sb ^ (((sb >> 9) & 1) << 5); R = (st >> 1) * 16 + swz / 64; C = (st & 1) * 32 + (swz % 64) / 2; }
__host__ __device__ __forceinline__ int perm32(int rho) { const int n = rho >> 4, i = rho & 15; return 8 * (i >> 2) + 4 * n + (i & 3); }

struct Unit { int pm, pn; };
struct Gemm { const bf16_t* A; const bf16_t* Bt; int M, N, K; };

struct StaticOrder {
    int nM, nN, nwg, G, c;
    __host__ __device__ void init(int M, int N, int G_, int c_) { nM = M / BM; nN = N / BM; nwg = nM * nN; G = G_; c = c_; }
    __host__ __device__ bool next(int i, Unit& u) const {
        const long L = (long)i * G + c; if (L >= nwg) return false;
        int wgid = (int)L; { const int q = nwg / NXCD, r = nwg % NXCD, xcd = wgid % NXCD, off = wgid / NXCD; wgid = (xcd < r ? xcd * (q + 1) : r * (q + 1) + (xcd - r) * q) + off; }
        const int nig = WGM * nN, gid = wgid / nig, fm = gid * WGM, gsz = (nM - fm) < WGM ? (nM - fm) : WGM;
        u.pm = fm + ((wgid % nig) % gsz); u.pn = (wgid % nig) / gsz; return true;
    }
    __device__ __forceinline__ void a_ready(const Unit&) const {}
    __device__ __forceinline__ void done(const Unit&) const {}
};

__device__ __forceinline__ unsigned cvt_pk_bf16(float lo, float hi) { unsigned r; asm volatile("v_cvt_pk_bf16_f32 %0, %1, %2" : "=v"(r) : "v"(lo), "v"(hi)); return r; }
typedef unsigned u32x2 __attribute__((ext_vector_type(2)));
__device__ __forceinline__ float bf_lo(unsigned w) { return __uint_as_float(w << 16); }
__device__ __forceinline__ float bf_hi(unsigned w) { return __uint_as_float(w & 0xffff0000u); }
__device__ __forceinline__ float sigmoid_f(float x) { return __builtin_amdgcn_rcpf(1.0f + __builtin_amdgcn_exp2f(-1.4426950408889634f * x)); }
__device__ __forceinline__ u32x4 pack8(const f32x4 a, const f32x4 b) { u32x4 w; w.x = cvt_pk_bf16(a[0], a[1]); w.y = cvt_pk_bf16(a[2], a[3]); w.z = cvt_pk_bf16(b[0], b[1]); w.w = cvt_pk_bf16(b[2], b[3]); return w; }

struct ProjOrder {
    StaticOrder so;
    __device__ __forceinline__ bool next(int i, Unit& u) const {
        const long L = (long)i * so.G + so.c;
        if (L < so.nwg) return so.next(i, u);
        const int x = (int)(L - so.nwg); if (x >= 64) return false;
        u.pm = 256 + (x >> 1); u.pn = 20 + (x & 1); return true;
    }
    __device__ __forceinline__ void a_ready(const Unit&) const {}
    __device__ __forceinline__ void done(const Unit&) const {}
};
struct MoeOrder {
    const PG8_LAS unsigned char* t2e; int nunits, G, c;
    __device__ __forceinline__ bool next(int i, Unit& u) const {
        const int L = i * G + c; if (L >= nunits) return false;
        const int pm = L >> 2; u.pm = pm; u.pn = (int)t2e[pm] * 4 + (L & 3); return true;
    }
    __device__ __forceinline__ void a_ready(const Unit&) const {}
    __device__ __forceinline__ void done(const Unit&) const {}
};

struct EpiProj {
    static constexpr bool PERM = true, AFTER_DRAIN = false;
    bf16_t* PROJ; bf16_t* GATES; bf16_t* KV; float qscale;
    __device__ __forceinline__ void operator()(const f32x4 (&acc)[2][2][4][2], const Unit& u, int wr, int wc, int fr, int fq) const {
        bf16_t* base; int ldc, colt, mode = 0; float sc = 1.f; int rowt = u.pm * BM;
        if (u.pm >= 256) { base = KV; ldc = 512; colt = (u.pn - 20) * BM; rowt -= 65536; }
        else if (u.pn < 8) { base = PROJ; ldc = 2048; colt = u.pn * BM; if (u.pn == 1 || u.pn == 2 || u.pn == 7) sc = qscale; }
        else { base = GATES; ldc = 3072; colt = (u.pn - 8) * BM; mode = 1; }
        const int row0 = rowt + wr * 64 + fr, col0 = colt + wc * 32 + 8 * fq;
#pragma unroll
        for (int ai = 0; ai < 2; ++ai)
#pragma unroll
            for (int m = 0; m < 4; ++m) { bf16_t* rowp = base + (size_t)(row0 + ai * HALF + m * 16) * ldc + col0;
#pragma unroll
                for (int bj = 0; bj < 2; ++bj) { f32x4 v0 = acc[ai][bj][m][0], v1 = acc[ai][bj][m][1];
                    if (mode) {
#pragma unroll
                        for (int i = 0; i < 4; ++i) { v0[i] = sigmoid_f(v0[i]); v1[i] = sigmoid_f(v1[i]); } }
                    else { v0 = v0 * sc; v1 = v1 * sc; }
                    *(u32x4*)(rowp + bj * HALF) = pack8(v0, v1); } }
    }
};
__device__ __forceinline__ float gclamp(float g) { return __builtin_fmaxf(g, 1e-18f); }
struct MidRescale {
    static constexpr bool ON = true; static constexpr int T0 = 4, T1 = 12;
    const bf16_t* GATES;
    __device__ __forceinline__ void operator()(f32x4 (&acc)[2][2][4][2], const Unit& u, int t, int wr, int wc, int fr, int fq) const {
        int fr_ = fr; asm volatile("" : "+v"(fr_));
        const int row0 = u.pm * BM + wr * 64 + fr_, col0 = u.pn * BM + wc * 32 + 8 * fq; const int gprev = (t == T0) ? 0 : 1024;
        const unsigned off0 = ((unsigned)row0 * 3072u + (unsigned)(gprev + col0)) * 2u;
#pragma unroll
        for (int ai = 0; ai < 2; ++ai) {
            u32x4 ga[4][2], gb[4][2];
#pragma unroll
            for (int m = 0; m < 4; ++m) { const char* gp = (const char*)GATES + (off0 + (unsigned)((ai * HALF + m * 16) * 3072 * 2));
#pragma unroll
                for (int bj = 0; bj < 2; ++bj) { ga[m][bj] = *(const u32x4*)(gp + bj * HALF * 2); gb[m][bj] = *(const u32x4*)(gp + 2048 + bj * HALF * 2); } }
#pragma unroll
            for (int m = 0; m < 4; ++m)
#pragma unroll
                for (int bj = 0; bj < 2; ++bj) { const u32x4 a = ga[m][bj], b = gb[m][bj];
                    f32x4 r0, r1;
                    r0[0] = bf_lo(a.x) * __builtin_amdgcn_rcpf(gclamp(bf_lo(b.x))); r0[1] = bf_hi(a.x) * __builtin_amdgcn_rcpf(gclamp(bf_hi(b.x)));
                    r0[2] = bf_lo(a.y) * __builtin_amdgcn_rcpf(gclamp(bf_lo(b.y))); r0[3] = bf_hi(a.y) * __builtin_amdgcn_rcpf(gclamp(bf_hi(b.y)));
                    r1[0] = bf_lo(a.z) * __builtin_amdgcn_rcpf(gclamp(bf_lo(b.z))); r1[1] = bf_hi(a.z) * __builtin_amdgcn_rcpf(gclamp(bf_hi(b.z)));
                    r1[2] = bf_lo(a.w) * __builtin_amdgcn_rcpf(gclamp(bf_lo(b.w))); r1[3] = bf_hi(a.w) * __builtin_amdgcn_rcpf(gclamp(bf_hi(b.w)));
                    acc[ai][bj][m][0] = acc[ai][bj][m][0] * r0; acc[ai][bj][m][1] = acc[ai][bj][m][1] * r1; }
            asm volatile("" ::: "memory"); }
    }
};
struct EpiMerge {
    static constexpr bool PERM = true, AFTER_DRAIN = false;
    const bf16_t* GATES; bf16_t* MERGED;
    __device__ __forceinline__ void operator()(const f32x4 (&acc)[2][2][4][2], const Unit& u, int wr, int wc, int fr, int fq) const {
        const int row0 = u.pm * BM + wr * 64 + fr, col0 = u.pn * BM + wc * 32 + 8 * fq;
        const unsigned off0 = ((unsigned)row0 * 3072u + (unsigned)(2048 + col0)) * 2u;
        u32x4 gg[2][4][2];
#pragma unroll
        for (int ai = 0; ai < 2; ++ai)
#pragma unroll
            for (int m = 0; m < 4; ++m)
#pragma unroll
                for (int bj = 0; bj < 2; ++bj) gg[ai][m][bj] = *(const u32x4*)((const char*)GATES + (off0 + (unsigned)((ai * HALF + m * 16) * 3072 * 2)) + bj * HALF * 2);
#pragma unroll
        for (int ai = 0; ai < 2; ++ai)
#pragma unroll
            for (int m = 0; m < 4; ++m) { const size_t r = (size_t)(row0 + ai * HALF + m * 16);
#pragma unroll
                for (int bj = 0; bj < 2; ++bj) { const int c = col0 + bj * HALF; const u32x4 g = gg[ai][m][bj];
                    f32x4 v0 = acc[ai][bj][m][0], v1 = acc[ai][bj][m][1];
                    v0[0] *= gclamp(bf_lo(g.x)); v0[1] *= gclamp(bf_hi(g.x)); v0[2] *= gclamp(bf_lo(g.y)); v0[3] *= gclamp(bf_hi(g.y));
                    v1[0] *= gclamp(bf_lo(g.z)); v1[1] *= gclamp(bf_hi(g.z)); v1[2] *= gclamp(bf_lo(g.w)); v1[3] *= gclamp(bf_hi(g.w));
                    *(u32x4*)(MERGED + r * 1024 + c) = pack8(v0, v1); } }
    }
};
struct EpiWo {
    static constexpr bool PERM = false, AFTER_DRAIN = false;
    const float* X; float* X1;
    __device__ __forceinline__ void operator()(const f32x4 (&acc)[2][2][4][2], const Unit& u, int wr, int wc, int fr, int fq) const {
        const int row0 = u.pm * BM + wr * 64 + fr, col0 = u.pn * BM + wc * 32 + 4 * fq;
#pragma unroll
        for (int ai = 0; ai < 2; ++ai)
#pragma unroll
            for (int m = 0; m < 4; ++m) { const size_t off = (size_t)(row0 + ai * HALF + m * 16) * 1024 + col0;
#pragma unroll
                for (int bj = 0; bj < 2; ++bj)
#pragma unroll
                    for (int n = 0; n < 2; ++n) { const size_t o = off + bj * HALF + n * 16; *(f32x4*)(X1 + o) = *(const f32x4*)(X + o) + acc[ai][bj][m][n]; } }
    }
};
struct EpiGateUp {
    static constexpr bool PERM = true, AFTER_DRAIN = false;
    bf16_t* HID; const float* RWE; const PG8_LAS int* TB;
    __device__ __forceinline__ void operator()(const f32x4 (&acc)[2][2][4][2], const Unit& u, int wr, int wc, int fr, int fq) const {
        const int row0 = u.pm * BM + wr * 64 + fr, colh = (u.pn & 3) * 128 + wc * 32 + 8 * fq;
#pragma unroll
        for (int ai = 0; ai < 2; ++ai)
#pragma unroll
            for (int m = 0; m < 4; ++m) { const size_t r = (size_t)(row0 + ai * HALF + m * 16); const size_t es = (size_t)((u.pn >> 2) << 16) + (r - (size_t)TB[u.pn >> 2] * 256); const float ri = RWE[2 * es], w = RWE[2 * es + 1];
                f32x4 h0, h1;
#pragma unroll
                for (int i = 0; i < 4; ++i) { const float g0 = acc[ai][0][m][0][i] * ri, g1 = acc[ai][0][m][1][i] * ri; const float wr_ = w * ri;
                    h0[i] = g0 * sigmoid_f(g0) * acc[ai][1][m][0][i] * wr_; h1[i] = g1 * sigmoid_f(g1) * acc[ai][1][m][1][i] * wr_; }
                *(u32x4*)(HID + r * 512 + colh) = pack8(h0, h1); }
    }
};
struct EpiDown {
    static constexpr bool PERM = true, AFTER_DRAIN = false;
    bf16_t* Y;
    __device__ __forceinline__ void operator()(const f32x4 (&acc)[2][2][4][2], const Unit& u, int wr, int wc, int fr, int fq) const {
        const int row0 = u.pm * BM + wr * 64 + fr, col0 = (u.pn & 3) * BM + wc * 32 + 8 * fq;
#pragma unroll
        for (int ai = 0; ai < 2; ++ai)
#pragma unroll
            for (int m = 0; m < 4; ++m) { bf16_t* rowp = Y + (size_t)(row0 + ai * HALF + m * 16) * 1024 + col0;
#pragma unroll
                for (int bj = 0; bj < 2; ++bj) *(u32x4*)(rowp + bj * HALF) = pack8(acc[ai][bj][m][0], acc[ai][bj][m][1]); }
    }
};

struct NoMid { static constexpr bool ON = false; static constexpr int T0 = -1, T1 = -1; __device__ __forceinline__ void operator()(f32x4 (&)[2][2][4][2], const Unit&, int, int, int, int, int) const {} };
template <class Epi, class Sched, bool ALIGN_EPI = false, bool SP2 = false, class Mid = NoMid, bool GATHER = false>
__device__ __forceinline__ void gemm_phase(PG8_LAS unsigned char* lds, const Gemm g, const Sched& S, const Epi& E, const Mid& MH = Mid(), const PG8_LAS int* tokl = nullptr) {
    int tid_ = threadIdx.x; asm volatile("" : "+v"(tid_));
    const int tid = tid_, wid = __builtin_amdgcn_readfirstlane(tid >> 6), lane = tid & 63, wr = wid >> 2, wc = wid & 3, fr = lane & 15, fq = lane >> 4;
    static_assert(!GATHER || SP2, "GATHER is written for the SP2 loop");
    const int K = g.K, nt = K / BK;
    unsigned voffA[2], voffB[2];
#pragma unroll
    for (int i = 0; i < 2; ++i) { int R, C; stage_rc(tid * 16 + i * 8192, R, C); const int Rb = Epi::PERM ? ((R & ~31) + perm32(R & 31)) : R;
        voffA[i] = (unsigned)(R * K + C) * 2u; voffB[i] = (unsigned)(Rb * K + C) * 2u; }
    const size_t kstep = (size_t)(BK * 2);
    const size_t hstep = (size_t)HALF * K * 2;
    const size_t tstep = 2 * hstep;
    const unsigned ldsw = (unsigned)wid * 1024u;
    const int aoff = lds_byte(wr * 64 + fr, fq * 8), boff = lds_byte(wc * 32 + fr, fq * 8);
    unsigned vGc[2][2], vGn[2][2]; int gR[2], gC[2];
    if constexpr (GATHER) {
#pragma unroll
        for (int i = 0; i < 2; ++i) { stage_rc(tid * 16 + i * 8192, gR[i], gC[i]); }
    }
#define PG8_GOFFS(dst, u_) do { if constexpr (GATHER) { _Pragma("unroll") for (int hh_ = 0; hh_ < 2; ++hh_) _Pragma("unroll") for (int i_ = 0; i_ < 2; ++i_) \
        dst[hh_][i_] = ((unsigned)tokl[(u_) * 256 + hh_ * HALF + gR[i_]] * (unsigned)K + (unsigned)gC[i_]) * 2u; } } while (0)
#define PG8_STGA(bufoff, base, hh, nx) do { if constexpr (GATHER) { _Pragma("unroll") for (int _i = 0; _i < 2; ++_i) \
        __builtin_amdgcn_global_load_lds((const unsigned*)((const char*)(base) + ((nx) ? vGn[hh][_i] : vGc[hh][_i])), (PG8_LAS unsigned*)(lds + (bufoff) + ldsw + _i * 8192), 16, 0, 0); } \
      else { PG8_STAGE(bufoff, (base) + (hh) * hstep, voffA); } } while (0)
#define PG8_SA(b, h) (((b) * 2 + (h)) * HTB)
#define PG8_SB(b, h) ((4 + (b) * 2 + (h)) * HTB)
#define PG8_STAGE(bufoff, gbase, voff) do { _Pragma("unroll") for (int _i = 0; _i < 2; ++_i) \
        __builtin_amdgcn_global_load_lds((const unsigned*)((const char*)(gbase) + (voff)[_i]), (PG8_LAS unsigned*)(lds + (bufoff) + ldsw + _i * 8192), 16, 0, 0); } while (0)
#define PG8_LDA(dst, b, h) do { _Pragma("unroll") for (int m = 0; m < 4; ++m) _Pragma("unroll") for (int k = 0; k < 2; ++k) dst[m][k] = *(const PG8_LAS bf16x8*)(lds + PG8_SA(b, h) + aoff + m * 2048 + k * 1024); } while (0)
#define PG8_LDB(dst, b, h) do { _Pragma("unroll") for (int n = 0; n < 2; ++n) _Pragma("unroll") for (int k = 0; k < 2; ++k) dst[n][k] = *(const PG8_LAS bf16x8*)(lds + PG8_SB(b, h) + boff + n * 2048 + k * 1024); } while (0)
#define PG8_MMA(ai, bj, At, Bt) do { __builtin_amdgcn_s_setprio(1); _Pragma("unroll") for (int m = 0; m < 4; ++m) _Pragma("unroll") for (int n = 0; n < 2; ++n) _Pragma("unroll") for (int k = 0; k < 2; ++k) \
        acc[ai][bj][m][n] = __builtin_amdgcn_mfma_f32_16x16x32_bf16(Bt[n][k], At[m][k], acc[ai][bj][m][n], 0, 0, 0); __builtin_amdgcn_s_setprio(0); } while (0)
#define PG8_WAIT_V(n) asm volatile("s_waitcnt vmcnt(" #n ")" ::: "memory")
#define PG8_WAIT_L(n) asm volatile("s_waitcnt lgkmcnt(" #n ")" ::: "memory")
#define PG8_BAR __builtin_amdgcn_s_barrier()
#define PG8_SCHED __builtin_amdgcn_sched_barrier(0)
    Unit cur, nxt; int ui = 0;
    if (!S.next(0, cur)) return;
    f32x4 acc[2][2][4][2];
#pragma unroll
    for (int a = 0; a < 2; ++a)
#pragma unroll
        for (int b = 0; b < 2; ++b)
#pragma unroll
            for (int m = 0; m < 4; ++m)
#pragma unroll
                for (int n = 0; n < 2; ++n) acc[a][b][m][n] = (f32x4){0.f, 0.f, 0.f, 0.f};
    bf16x8 At[4][2], B0[2][2], B1[2][2];
    const char* cA = (const char*)g.A + (GATHER ? (size_t)0 : (size_t)cur.pm * tstep); const char* cB = (const char*)g.Bt + (size_t)cur.pn * tstep;
    PG8_GOFFS(vGc, 0); PG8_GOFFS(vGn, 0);
    S.a_ready(cur);
    if constexpr (SP2) {
        PG8_STAGE(PG8_SB(0, 0), cB, voffB); PG8_STAGE(PG8_SB(0, 1), cB + hstep, voffB); PG8_STGA(PG8_SA(0, 0), cA, 0, false); PG8_STGA(PG8_SA(0, 1), cA, 1, false);
        if (wr == 1) PG8_BAR;
        PG8_WAIT_V(2); PG8_BAR;
        PG8_STAGE(PG8_SB(1, 0), cB + kstep, voffB); PG8_STGA(PG8_SA(1, 0), cA + kstep, 0, false); PG8_STAGE(PG8_SB(1, 1), cB + hstep + kstep, voffB);
        PG8_WAIT_V(6); PG8_BAR;
    } else {
        PG8_STAGE(PG8_SB(0, 0), cB, voffB); PG8_STAGE(PG8_SA(0, 0), cA, voffA); PG8_STAGE(PG8_SB(0, 1), cB + hstep, voffB); PG8_STAGE(PG8_SA(0, 1), cA + hstep, voffA);
        if (wr == 1) PG8_BAR;
        PG8_WAIT_V(4); PG8_BAR;
        PG8_STAGE(PG8_SB(1, 0), cB + kstep, voffB); PG8_STAGE(PG8_SA(1, 0), cA + kstep, voffA); PG8_STAGE(PG8_SB(1, 1), cB + hstep + kstep, voffB);
        PG8_WAIT_V(6); PG8_BAR;
    }
    for (;;) {
        const bool has_next = S.next(ui + 1, nxt);
        if (has_next) PG8_GOFFS(vGn, ui + 1);
        const char* nA = (has_next && !GATHER) ? (const char*)g.A + (size_t)nxt.pm * tstep : cA; const char* nB = has_next ? (const char*)g.Bt + (size_t)nxt.pn * tstep : cB;
        for (int t = 0; t < nt; t += 2) {
            if constexpr (Mid::ON) { if (t == Mid::T0 || t == Mid::T1) MH(acc, cur, t, wr, wc, fr, fq); }
            const bool last = (t == nt - 2);
            const char* a1 = cA + (size_t)(t + 1) * kstep;
            const char* a2 = last ? nA : cA + (size_t)(t + 2) * kstep; const char* b2 = last ? nB : cB + (size_t)(t + 2) * kstep;
            const char* a3 = a2 + kstep; const char* b3 = b2 + kstep;
            if (last && has_next) S.a_ready(nxt);
            if constexpr (SP2) {
            PG8_LDB(B0, 0, 0); PG8_LDB(B1, 0, 1); PG8_SCHED; PG8_LDA(At, 0, 0); PG8_STGA(PG8_SA(1, 1), a1, 1, false);
            PG8_WAIT_V(8); PG8_WAIT_L(0); PG8_BAR; PG8_MMA(0, 0, At, B0); PG8_MMA(0, 1, At, B1); PG8_BAR; PG8_SCHED;
            PG8_LDA(At, 0, 1); PG8_STAGE(PG8_SB(0, 0), b2, voffB); PG8_STAGE(PG8_SB(0, 1), b2 + hstep, voffB); PG8_STGA(PG8_SA(0, 0), a2, 0, last && has_next);
            PG8_WAIT_V(8); PG8_WAIT_L(0); PG8_BAR; PG8_MMA(1, 0, At, B0); PG8_MMA(1, 1, At, B1); PG8_BAR; PG8_SCHED;
            PG8_LDB(B0, 1, 0); PG8_LDB(B1, 1, 1); PG8_SCHED; PG8_LDA(At, 1, 0); PG8_STGA(PG8_SA(0, 1), a2, 1, last && has_next);
            PG8_WAIT_V(8); PG8_WAIT_L(0); PG8_BAR; PG8_MMA(0, 0, At, B0); PG8_MMA(0, 1, At, B1); PG8_BAR; PG8_SCHED;
            PG8_LDA(At, 1, 1); PG8_STAGE(PG8_SB(1, 0), b3, voffB); PG8_STAGE(PG8_SB(1, 1), b3 + hstep, voffB); PG8_STGA(PG8_SA(1, 0), a3, 0, last && has_next);
            PG8_WAIT_V(8); PG8_WAIT_L(0); PG8_BAR; PG8_MMA(1, 0, At, B0); PG8_MMA(1, 1, At, B1); PG8_BAR; PG8_SCHED;
            } else {
            PG8_LDB(B0, 0, 0); PG8_SCHED; PG8_LDA(At, 0, 0); PG8_STAGE(PG8_SA(1, 1), a1 + hstep, voffA);
            PG8_WAIT_L(8); PG8_BAR; PG8_WAIT_L(0); PG8_MMA(0, 0, At, B0); PG8_BAR; PG8_SCHED;
            PG8_LDB(B1, 0, 1); PG8_STAGE(PG8_SB(0, 0), b2, voffB);
            PG8_BAR; PG8_WAIT_L(0); PG8_MMA(0, 1, At, B1); PG8_BAR;
            PG8_LDA(At, 0, 1); PG8_STAGE(PG8_SA(0, 0), a2, voffA);
            PG8_BAR; PG8_WAIT_L(0); PG8_MMA(1, 0, At, B0); PG8_BAR; PG8_SCHED;
            PG8_STAGE(PG8_SB(0, 1), b2 + hstep, voffB);
            PG8_WAIT_V(6); PG8_BAR; PG8_MMA(1, 1, At, B1); PG8_BAR;
            PG8_LDB(B0, 1, 0); PG8_SCHED; PG8_LDA(At, 1, 0); PG8_STAGE(PG8_SA(0, 1), a2 + hstep, voffA);
            PG8_WAIT_L(8); PG8_BAR; PG8_WAIT_L(0); PG8_MMA(0, 0, At, B0); PG8_BAR; PG8_SCHED;
            PG8_LDB(B1, 1, 1); PG8_STAGE(PG8_SB(1, 0), b3, voffB);
            PG8_BAR; PG8_WAIT_L(0); PG8_MMA(0, 1, At, B1); PG8_BAR;
            PG8_LDA(At, 1, 1); PG8_STAGE(PG8_SA(1, 0), a3, voffA);
            PG8_BAR; PG8_WAIT_L(0); PG8_MMA(1, 0, At, B0); PG8_BAR; PG8_SCHED;
            PG8_STAGE(PG8_SB(1, 1), b3 + hstep, voffB);
            PG8_WAIT_V(6); PG8_BAR; PG8_MMA(1, 1, At, B1); PG8_BAR;
            }
        }
        if constexpr (ALIGN_EPI) { if (wr == 0) PG8_BAR; }
        if constexpr (!Epi::AFTER_DRAIN) { E(acc, cur, wr, wc, fr, fq); S.done(cur); }
        if (!has_next) break;
#pragma unroll
        for (int a = 0; a < 2; ++a)
#pragma unroll
            for (int b = 0; b < 2; ++b)
#pragma unroll
                for (int m = 0; m < 4; ++m)
#pragma unroll
                    for (int n = 0; n < 2; ++n) acc[a][b][m][n] = (f32x4){0.f, 0.f, 0.f, 0.f};
        cur = nxt; cA = nA; cB = nB; ++ui;
        if constexpr (GATHER) { _Pragma("unroll") for (int hh_ = 0; hh_ < 2; ++hh_) _Pragma("unroll") for (int i_ = 0; i_ < 2; ++i_) vGc[hh_][i_] = vGn[hh_][i_]; }
        if constexpr (ALIGN_EPI) { if (wr == 1) PG8_BAR; }
    }
    PG8_WAIT_V(0);
    if constexpr (!ALIGN_EPI) { if (wr == 0) PG8_BAR; }
    PG8_BAR;
    if constexpr (Epi::AFTER_DRAIN) { E.fused(acc, cur, wr, wc, fr, fq, lds, wid, lane); S.done(cur); }
#undef PG8_SA
#undef PG8_SB
#undef PG8_STAGE
#undef PG8_STGA
#undef PG8_GOFFS
#undef PG8_LDA
#undef PG8_LDB
#undef PG8_MMA
#undef PG8_WAIT_V
#undef PG8_WAIT_L
#undef PG8_BAR
#undef PG8_SCHED
}
}
#include <hip/hip_bf16.h>
#include <cmath>
namespace attn_body {
using bf16=__hip_bfloat16;
using bf16x8=__attribute__((ext_vector_type(8)))short;
using s16x4=__attribute__((ext_vector_type(4)))short;
using f32x16=__attribute__((ext_vector_type(16)))float;
using u32x4=__attribute__((ext_vector_type(4)))unsigned;
constexpr int D=64;
constexpr int NW=8,QBLK=32,QB=QBLK*NW,KVBLK=64;
constexpr int ATTN_UNIT_ROWS=QB;
__device__ __forceinline__ int crow(int r,int hi){return (r&3)+8*(r>>2)+4*hi;}
#define SBAR() __builtin_amdgcn_sched_barrier(0)
__device__ __forceinline__ void cmask(f32x16&p0,f32x16&p1,int jb,int qrel,int hi){
  const float NEG=-INFINITY; int kb=64*jb+4*hi;
  #pragma unroll
  for(int r=0;r<16;++r){int kv=kb+(r&3)+8*(r>>2); if(kv>qrel)p0[r]=NEG; if(kv+32>qrel)p1[r]=NEG;}
}

constexpr int NSLOT=3, SLOTB=8192;
constexpr int LDS_K=0, LDS_V=NSLOT*SLOTB, LDS_WS=2*NSLOT*SLOTB, LDS_OST=LDS_WS+NW*64*4, LDS_BYTES=LDS_OST+NW*4096;
constexpr float C2=0.125f*1.4426950408889634f;
__device__ __forceinline__ void glds16(const void*gsrc,unsigned lds_dst){unsigned keep;
  asm volatile("s_mov_b32 %0, m0\n\ts_mov_b32 m0, %2\n\ts_nop 0\n\tglobal_load_lds_dwordx4 %1, off\n\ts_mov_b32 m0, %0":"=&s"(keep):"v"(gsrc),"s"(lds_dst):"memory");}
__device__ __forceinline__ float max3f(float a,float b,float c){float r;asm("v_max3_f32 %0, %1, %2, %3":"=v"(r):"v"(a),"v"(b),"v"(c));return r;}
__device__ __forceinline__ float max2f(float a,float b){float r;asm("v_max_f32_e32 %0, %1, %2":"=v"(r):"v"(a),"v"(b));return r;}
__device__ __forceinline__ float fadd_s(float a,float b){float r;asm("v_add_f32_e32 %0, %1, %2":"=v"(r):"v"(a),"v"(b));return r;}
__device__ __forceinline__ float fsub_s(float a,float b){float r;asm("v_sub_f32_e32 %0, %1, %2":"=v"(r):"v"(a),"v"(b));return r;}
typedef float f32x2_t __attribute__((ext_vector_type(2))); typedef __bf16 bf16x2_t __attribute__((ext_vector_type(2)));
__device__ __forceinline__ unsigned cvtpk_s(float lo,float hi){f32x2_t v={lo,hi};bf16x2_t b=__builtin_convertvector(v,bf16x2_t);return __builtin_bit_cast(unsigned,b);}
#define WAIT_BAR(N) asm volatile("s_waitcnt vmcnt(" #N ") lgkmcnt(0)\n\ts_barrier":::"memory")

__device__ __forceinline__ void qkt(f32x16&p0,f32x16&p1,const char*Kslot,const bf16x8*qr,const f32x16&negm,int r32,int hi){
  const char*kb=Kslot+hi*1024+r32*16;
  #pragma unroll
  for(int d0=0;d0<4;++d0){
    const bf16x8 b0=*reinterpret_cast<const bf16x8*>(kb+d0*2048);
    const bf16x8 b1=*reinterpret_cast<const bf16x8*>(kb+d0*2048+512);
    if(d0==0){p0=__builtin_amdgcn_mfma_f32_32x32x16_bf16(b0,qr[0],negm,0,0,0);p1=__builtin_amdgcn_mfma_f32_32x32x16_bf16(b1,qr[0],negm,0,0,0);}
    else{p0=__builtin_amdgcn_mfma_f32_32x32x16_bf16(b0,qr[d0],p0,0,0,0);p1=__builtin_amdgcn_mfma_f32_32x32x16_bf16(b1,qr[d0],p1,0,0,0);}}
}
typedef __attribute__((address_space(3))) const char* lds_cptr;
typedef short v4i16_t __attribute__((ext_vector_type(4)));
__device__ __forceinline__ void kload8(bf16x8*kf,lds_cptr kp){
  kf[0]=*(const __attribute__((address_space(3))) bf16x8*)(kp);      kf[1]=*(const __attribute__((address_space(3))) bf16x8*)(kp+512);
  kf[2]=*(const __attribute__((address_space(3))) bf16x8*)(kp+2048); kf[3]=*(const __attribute__((address_space(3))) bf16x8*)(kp+2560);
  kf[4]=*(const __attribute__((address_space(3))) bf16x8*)(kp+4096); kf[5]=*(const __attribute__((address_space(3))) bf16x8*)(kp+4608);
  kf[6]=*(const __attribute__((address_space(3))) bf16x8*)(kp+6144); kf[7]=*(const __attribute__((address_space(3))) bf16x8*)(kp+6656);
}
__device__ __forceinline__ void kload2(bf16x8*kf,lds_cptr kp,int j){ kf[2*j]=*(const __attribute__((address_space(3))) bf16x8*)(kp+j*2048); kf[2*j+1]=*(const __attribute__((address_space(3))) bf16x8*)(kp+j*2048+512); }
__device__ __forceinline__ s16x4 vtr(lds_cptr p){ return __builtin_bit_cast(s16x4,__builtin_amdgcn_ds_read_tr16_b64_v4i16((__attribute__((address_space(3))) v4i16_t*)p)); }
__device__ __forceinline__ float rowmax(const f32x16&p0,const f32x16&p1){
  float a=max3f(p0[0],p0[1],p1[0]),b=max3f(p0[2],p0[3],p1[1]);a=max3f(a,p1[2],p1[3]);
  #pragma unroll
  for(int r=4;r<16;r+=4){a=max3f(a,p0[r],p0[r+1]);b=max3f(b,p0[r+2],p0[r+3]);a=max3f(a,p1[r],p1[r+1]);b=max3f(b,p1[r+2],p1[r+3]);}
  const float m=max2f(a,b);
  auto rr=__builtin_amdgcn_permlane32_swap(__float_as_uint(m),__float_as_uint(m),false,false);
  return max2f(__uint_as_float(rr[0]),__uint_as_float(rr[1]));
}
__device__ __forceinline__ void pv(f32x16*o,int vb,bf16x8 pa0,bf16x8 pa1,bf16x8 pa2,bf16x8 pa3){
  #pragma unroll
  for(int d0=0;d0<2;++d0){s16x4 lo[4],hi[4];
    #pragma unroll
    for(int ks=0;ks<4;++ks){
      asm volatile("ds_read_b64_tr_b16 %0,%1 offset:%c2":"=&v"(lo[ks]):"v"(vb),"i"(d0*4096+ks*1024):"memory");
      asm volatile("ds_read_b64_tr_b16 %0,%1 offset:%c2":"=&v"(hi[ks]):"v"(vb),"i"(d0*4096+ks*1024+512):"memory");}
    asm volatile("s_waitcnt lgkmcnt(0)":::"memory");SBAR();
    #define PK(k) (bf16x8){lo[k][0],lo[k][1],lo[k][2],lo[k][3],hi[k][0],hi[k][1],hi[k][2],hi[k][3]}
    o[d0]=__builtin_amdgcn_mfma_f32_32x32x16_bf16(pa0,PK(0),o[d0],0,0,0);
    o[d0]=__builtin_amdgcn_mfma_f32_32x32x16_bf16(pa1,PK(1),o[d0],0,0,0);
    o[d0]=__builtin_amdgcn_mfma_f32_32x32x16_bf16(pa2,PK(2),o[d0],0,0,0);
    o[d0]=__builtin_amdgcn_mfma_f32_32x32x16_bf16(pa3,PK(3),o[d0],0,0,0);
    #undef PK
  }
}

#ifndef ATTN_STORE16
#define ATTN_STORE16(p,v) (*(u32x4*)(p)=(v))
#endif
template<int THRL,bool CAUSAL> __device__ __forceinline__ void attn_unit(const bf16*Qu,const int pQ,const bf16*__restrict__ Kh,const bf16*__restrict__ Vh,const int pKV,bf16*Ou,const int pO,const int NT,char*shm){
  int tid_=threadIdx.x; asm volatile("":"+v"(tid_));
  const int tid=tid_,lane=tid&63,r32=lane&31,hi=lane>>5; const int wid=__builtin_amdgcn_readfirstlane(tid>>6);
  const bf16*Qw=Qu+(long)(wid*QBLK)*pQ;
  const unsigned lds0=(unsigned)(uintptr_t)shm;
  float*wsf=(float*)(shm+LDS_WS)+wid*64;
  const bf16*ksrc=Kh+(long)lane*pKV+wid*8;
  const bf16*vsrc=Vh+(long)(16*(wid&3)+(lane>>2))*pKV+(wid>>2)*32+(lane&3)*8;
  const unsigned kdst=lds0+LDS_K+wid*1024, vdst=lds0+LDS_V+wid*1024;
  #define DMA_K(t,slot) glds16(ksrc+(long)(t)*KVBLK*pKV,(unsigned)__builtin_amdgcn_readfirstlane(kdst+(slot)))
  #define DMA_V(t,slot) glds16(vsrc+(long)(t)*KVBLK*pKV,(unsigned)__builtin_amdgcn_readfirstlane(vdst+(slot)))
  const int vb0=(int)(lds0+LDS_V)+((lane>>4)&1)*32+(lane&3)*8+(4*hi+((lane&15)>>2))*64;
  const char*Kbase=shm+LDS_K; bf16x8 kf[8];
  const lds_cptr shm3=(lds_cptr)shm; const lds_cptr kp0=shm3+LDS_K+hi*1024+r32*16; const lds_cptr vp0=shm3+LDS_V+((lane>>4)&1)*32+(lane&3)*8+(4*hi+((lane&15)>>2))*64;
  DMA_K(0,0);DMA_V(0,0);DMA_K(1,SLOTB);
  bf16x8 qr[4];
  #pragma unroll
  for(int d0=0;d0<4;++d0)qr[d0]=*reinterpret_cast<const bf16x8*>(&Qw[(long)r32*pQ+d0*16+hi*8]);
  float mhat=0.f,l_reg=0.f;f32x16 o[2];o[0]=f32x16{};o[1]=f32x16{};const f32x16 negm=f32x16{};
  const int qrel=wid*QBLK+r32;
  #define CMASK(P0,P1,t) do{ if(CAUSAL){int jb_=(t)-(NT-4); if(jb_>=0)cmask(P0,P1,jb_,qrel,hi);} }while(0)
  bool resc=false;
  #define START(P0,P1) do{ const float rm=rowmax(P0,P1); resc=false; \
    { const float dl=rm; mhat=fadd_s(mhat,dl); \
      _Pragma("unroll") for(int r=0;r<16;++r){P0[r]=fsub_s(P0[r],dl);P1[r]=fsub_s(P1[r],dl);} \
      } \
    _Pragma("unroll") for(int r=0;r<16;++r)P0[r]=__builtin_amdgcn_exp2f(P0[r]); }while(0)
  #define RESC() do{ if(resc){ asm volatile("s_waitcnt lgkmcnt(0)":::"memory"); \
      _Pragma("unroll") for(int d_=0;d_<2;++d_) _Pragma("unroll") for(int r=0;r<16;++r)o[d_][r]*=wsf[crow(r,hi)]; } }while(0)
  f32x16 pA0,pA1,pB0,pB1;
  int sl_prev=0,sl_cur=0,sl_next=SLOTB;
  #define ROT() do{sl_prev=sl_cur;sl_cur=sl_next;sl_next=(sl_next==(NSLOT-1)*SLOTB)?0:sl_next+SLOTB;}while(0)
  DMA_K(2,2*SLOTB);
  WAIT_BAR(3);
  qkt(pA0,pA1,Kbase,qr,negm,r32,hi);asm volatile("s_nop 15\n\ts_nop 7":"+v"(pA0),"+v"(pA1));CMASK(pA0,pA1,0);
  START(pA0,pA1);
  _Pragma("unroll") for(int r=0;r<16;++r)pA1[r]=__builtin_amdgcn_exp2f(pA1[r]);
  WAIT_BAR(0);
  DMA_K(3,0);DMA_V(1,SLOTB);
  ROT();
  kload8(kf,kp0+sl_cur);
  WAIT_BAR(2);
  s16x4 vlo[8],vhi[8]; u32x4 pw0,pw1,pw2,pw3;
  #define PKW(P,B) cvtpk_s(P[B],P[B+1])
  #define PAF(k) __builtin_bit_cast(bf16x8,pw##k)
  #define VFR(i) (bf16x8){vlo[i][0],vlo[i][1],vlo[i][2],vlo[i][3],vhi[i][0],vhi[i][1],vhi[i][2],vhi[i][3]}
  #define PIN(x) asm volatile("":"+v"(x))
  #define MX3(a,b,c) __builtin_fmaxf(__builtin_fmaxf((a),(b)),(c))
  #define GAPA(MF,A0,A1,A2,A3,W0,W1,PW) do{ MF; sacc+=A0; sacc+=A1; sacc+=A2; sacc+=A3; PIN(sacc); W0; W1; PIN(PW); SBAR(); }while(0)
  #define EX(v) __builtin_amdgcn_exp2f(v)
  #define GAPB(MF,X,B) do{ MF; X[B]=EX(X[B]); X[B+1]=EX(X[B+1]); X[B+2]=EX(X[B+2]); X[B+3]=EX(X[B+3]); PIN(X); SBAR(); }while(0)
  #define VRD(i) do{ vlo[i]=vtr(vp_+(((i)>>2)*4096+((i)&3)*1024)); vhi[i]=vtr(vp_+(((i)>>2)*4096+((i)&3)*1024+512)); }while(0)
  #define KRD(G,j) do{ if(G){ kload2(kf,kp0+sl_next,j); SBAR(); } }while(0)
  #define STEP(C0,C1,P0,P1,t,GK,GV,GL) do{ SBAR(); \
    const lds_cptr vp_=vp0+sl_prev; \
    VRD(0); SBAR(); float sacc=(P0[0]+P0[1]); \
    GAPA(C0=__builtin_amdgcn_mfma_f32_32x32x16_bf16(kf[0],qr[0],negm,0,0,0), P0[2],P0[3],P0[4],P0[5],     pw0[0]=PKW(P0,0), pw0[1]=PKW(P0,2), pw0); \
    VRD(4); SBAR(); GAPA(C1=__builtin_amdgcn_mfma_f32_32x32x16_bf16(kf[1],qr[0],negm,0,0,0), P0[6],P0[7],P0[8],P0[9],     pw0[2]=PKW(P0,4), pw0[3]=PKW(P0,6), pw0); \
    VRD(1); SBAR(); GAPA(C0=__builtin_amdgcn_mfma_f32_32x32x16_bf16(kf[2],qr[1],C0,0,0,0),   P0[10],P0[11],P0[12],P0[13], pw1[0]=PKW(P0,8), pw1[1]=PKW(P0,10), pw1); \
    VRD(5); SBAR(); GAPA(C1=__builtin_amdgcn_mfma_f32_32x32x16_bf16(kf[3],qr[1],C1,0,0,0),   P0[14],P0[15],P1[0],P1[1],   pw1[2]=PKW(P0,12),pw1[3]=PKW(P0,14), pw1); \
    VRD(2); SBAR(); GAPA(C0=__builtin_amdgcn_mfma_f32_32x32x16_bf16(kf[4],qr[2],C0,0,0,0),   P1[2],P1[3],P1[4],P1[5],     pw2[0]=PKW(P1,0), pw2[1]=PKW(P1,2), pw2); \
    VRD(6); SBAR(); GAPA(C1=__builtin_amdgcn_mfma_f32_32x32x16_bf16(kf[5],qr[2],C1,0,0,0),   P1[6],P1[7],P1[8],P1[9],     pw2[2]=PKW(P1,4), pw2[3]=PKW(P1,6), pw2); \
    VRD(3); SBAR(); GAPA(C0=__builtin_amdgcn_mfma_f32_32x32x16_bf16(kf[6],qr[3],C0,0,0,0),   P1[10],P1[11],P1[12],P1[13], pw3[0]=PKW(P1,8), pw3[1]=PKW(P1,10), pw3); \
    VRD(7); SBAR(); GAPA(C1=__builtin_amdgcn_mfma_f32_32x32x16_bf16(kf[7],qr[3],C1,0,0,0),   P1[14],P1[15],0.f,0.f,       pw3[2]=PKW(P1,12),pw3[3]=PKW(P1,14), pw3); \
    l_reg+=sacc; \
    if(GK){DMA_K((t)+3,sl_cur);} if(GV){DMA_V((t)+1,sl_next);} \
    CMASK(C0,C1,t); \
    _Pragma("unroll") for(int r=0;r<16;++r){C0[r]-=mhat;C1[r]-=mhat;} \
    { float a=MX3(C0[0],C0[1],C1[0]),b=MX3(C0[2],C0[3],C1[1]); a=MX3(a,C1[2],C1[3]); \
      _Pragma("unroll") for(int r=4;r<16;r+=4){a=MX3(a,C0[r],C0[r+1]);b=MX3(b,C0[r+2],C0[r+3]);a=MX3(a,C1[r],C1[r+1]);b=MX3(b,C1[r+2],C1[r+3]);} \
      float rm=__builtin_fmaxf(a,b); { auto rr=__builtin_amdgcn_permlane32_swap(__float_as_uint(rm),__float_as_uint(rm),false,false); rm=__builtin_fmaxf(__uint_as_float(rr[0]),__uint_as_float(rr[1])); } \
      resc=false; \
      if(__builtin_expect(__any(rm>(float)THRL),0)){ const float dl=__builtin_fmaxf(rm,0.f); mhat+=dl; \
        _Pragma("unroll") for(int r=0;r<16;++r){C0[r]-=dl;C1[r]-=dl;} \
        const float f=__builtin_amdgcn_exp2f(-dl); l_reg*=f; if(hi==0)wsf[r32]=f; resc=true; } } \
    SBAR(); \
    GAPB(o[0]=__builtin_amdgcn_mfma_f32_32x32x16_bf16(PAF(0),VFR(0),o[0],0,0,0), C0,0); \
    GAPB(o[1]=__builtin_amdgcn_mfma_f32_32x32x16_bf16(PAF(0),VFR(4),o[1],0,0,0), C0,4); \
    KRD(GL,0); GAPB(o[0]=__builtin_amdgcn_mfma_f32_32x32x16_bf16(PAF(1),VFR(1),o[0],0,0,0), C0,8); \
    KRD(GL,1); GAPB(o[1]=__builtin_amdgcn_mfma_f32_32x32x16_bf16(PAF(1),VFR(5),o[1],0,0,0), C0,12); \
    KRD(GL,2); GAPB(o[0]=__builtin_amdgcn_mfma_f32_32x32x16_bf16(PAF(2),VFR(2),o[0],0,0,0), C1,0); \
    KRD(GL,3); GAPB(o[1]=__builtin_amdgcn_mfma_f32_32x32x16_bf16(PAF(2),VFR(6),o[1],0,0,0), C1,4); \
    GAPB(o[0]=__builtin_amdgcn_mfma_f32_32x32x16_bf16(PAF(3),VFR(3),o[0],0,0,0), C1,8); \
    GAPB(o[1]=__builtin_amdgcn_mfma_f32_32x32x16_bf16(PAF(3),VFR(7),o[1],0,0,0), C1,12); \
    }while(0)
  int t=1;
  #undef CMASK
  #define CMASK(P0,P1,t) do{}while(0)
  for(;t+5<NT;t+=2){
    STEP(pB0,pB1,pA0,pA1,t,true,true,true);     WAIT_BAR(2); RESC(); ROT();
    STEP(pA0,pA1,pB0,pB1,t+1,true,true,true);   WAIT_BAR(2); RESC(); ROT();
  }
  #undef CMASK
  #define CMASK(P0,P1,t) do{ if(CAUSAL){int jb_=(t)-(NT-4); if(jb_>=0)cmask(P0,P1,jb_,qrel,hi);} }while(0)
  #define ENDW(tt) do{ if((tt)+3<NT){WAIT_BAR(2);} else if((tt)+2<NT){WAIT_BAR(1);} else {WAIT_BAR(0);} }while(0)
  for(;t+1<NT;t+=2){
    STEP(pB0,pB1,pA0,pA1,t,(t+3<NT),(t+1<NT),(t+1<NT));       ENDW(t);   RESC(); ROT();
    STEP(pA0,pA1,pB0,pB1,t+1,(t+4<NT),(t+2<NT),(t+2<NT));     ENDW(t+1); RESC(); ROT();
  }
  STEP(pB0,pB1,pA0,pA1,NT-1,false,false,false); RESC();
  { float sacc=pB0[0]+pB0[1]; _Pragma("unroll") for(int r=2;r<16;++r)sacc+=pB0[r]; _Pragma("unroll") for(int r=0;r<16;++r)sacc+=pB1[r]; l_reg+=sacc;
    pw0=(u32x4){PKW(pB0,0),PKW(pB0,2),PKW(pB0,4),PKW(pB0,6)};pw1=(u32x4){PKW(pB0,8),PKW(pB0,10),PKW(pB0,12),PKW(pB0,14)};pw2=(u32x4){PKW(pB1,0),PKW(pB1,2),PKW(pB1,4),PKW(pB1,6)};pw3=(u32x4){PKW(pB1,8),PKW(pB1,10),PKW(pB1,12),PKW(pB1,14)};
    SBAR(); pv(o,vb0+sl_cur,PAF(0),PAF(1),PAF(2),PAF(3)); }
  #undef PKW
  #undef PAF
  #undef VFR
  #undef PIN
  #undef MX3
  #undef GAPA
  #undef GAPB
  #undef EX
  #undef VRD
  #undef KRD
  #undef STEP
  #undef ENDW
  {auto rr=__builtin_amdgcn_permlane32_swap(__float_as_uint(l_reg),__float_as_uint(l_reg),false,false);l_reg=__uint_as_float(rr[0])+__uint_as_float(rr[1]);}
  if(hi==0)wsf[32+r32]=l_reg;asm volatile("s_waitcnt lgkmcnt(0)":::"memory");
  float rli[16];
  #pragma unroll
  for(int r=0;r<16;++r)rli[r]=__builtin_amdgcn_rcpf(wsf[32+crow(r,hi)]);
  bf16*Ow=Ou+(long)(wid*QBLK)*pO;
  { bf16*stg=(bf16*)(shm+LDS_OST)+wid*2048;
    #pragma unroll
    for(int r=0;r<16;++r){const int orow=crow(r,hi);
      #pragma unroll
      for(int d0=0;d0<2;++d0)stg[orow*64+d0*32+r32]=__float2bfloat16(o[d0][r]*rli[r]);}
    asm volatile("s_waitcnt lgkmcnt(0)":::"memory");
    #pragma unroll
    for(int i=0;i<4;++i){const int row=i*8+(lane>>3),ch=lane&7; const u32x4 v=*(const u32x4*)(stg+row*64+ch*8); ATTN_STORE16(Ow+(long)row*pO+ch*8,v);} }
  asm volatile("s_waitcnt lgkmcnt(0)\n\ts_barrier":::"memory");
  #undef DMA_K
  #undef DMA_V
  #undef CMASK
  #undef START
  #undef RESC
  #undef ROT
}
constexpr int ATTN_LDS_BYTES=LDS_BYTES;
#undef SBAR
#undef WAIT_BAR
}
namespace attn2 {
using bf16=__hip_bfloat16;
using bf16x8=__attribute__((ext_vector_type(8)))short;
using s16x4=__attribute__((ext_vector_type(4)))short;
using f32x16=__attribute__((ext_vector_type(16)))float;
using u32x4=__attribute__((ext_vector_type(4)))unsigned;
constexpr int D=64;
constexpr int NW=8,QBLK=32,QB=QBLK*NW,KVBLK=64;
constexpr int ATTN_UNIT_ROWS=QB;
__device__ __forceinline__ int crow(int r,int hi){return (r&3)+8*(r>>2)+4*hi;}
#define SBAR() __builtin_amdgcn_sched_barrier(0)
__device__ __forceinline__ void cmask(f32x16&p0,f32x16&p1,int jb,int qrel,int hi){
  const float NEG=-INFINITY; int kb=64*jb+4*hi;
  #pragma unroll
  for(int r=0;r<16;++r){int kv=kb+(r&3)+8*(r>>2); if(kv>qrel)p0[r]=NEG; if(kv+32>qrel)p1[r]=NEG;}
}

constexpr int NSLOT=3, SLOTB=8192;
constexpr int LDS_K=0, LDS_V=NSLOT*SLOTB, LDS_WS=3*NSLOT*SLOTB, LDS_OST=LDS_WS+NW*64*4, LDS_BYTES=LDS_OST+NW*4096;
constexpr float C2=0.125f*1.4426950408889634f;
__device__ __forceinline__ void glds16(const void*gsrc,unsigned lds_dst){unsigned keep;
  asm volatile("s_mov_b32 %0, m0\n\ts_mov_b32 m0, %2\n\ts_nop 0\n\tglobal_load_lds_dwordx4 %1, off\n\ts_mov_b32 m0, %0":"=&s"(keep):"v"(gsrc),"s"(lds_dst):"memory");}
__device__ __forceinline__ float max3f(float a,float b,float c){float r;asm("v_max3_f32 %0, %1, %2, %3":"=v"(r):"v"(a),"v"(b),"v"(c));return r;}
__device__ __forceinline__ float max2f(float a,float b){float r;asm("v_max_f32_e32 %0, %1, %2":"=v"(r):"v"(a),"v"(b));return r;}
__device__ __forceinline__ float fadd_s(float a,float b){float r;asm("v_add_f32_e32 %0, %1, %2":"=v"(r):"v"(a),"v"(b));return r;}
__device__ __forceinline__ float fsub_s(float a,float b){float r;asm("v_sub_f32_e32 %0, %1, %2":"=v"(r):"v"(a),"v"(b));return r;}
typedef float f32x2_t __attribute__((ext_vector_type(2))); typedef __bf16 bf16x2_t __attribute__((ext_vector_type(2)));
__device__ __forceinline__ unsigned cvtpk_s(float lo,float hi){f32x2_t v={lo,hi};bf16x2_t b=__builtin_convertvector(v,bf16x2_t);return __builtin_bit_cast(unsigned,b);}
#define WAIT_BAR(N) asm volatile("s_waitcnt vmcnt(" #N ") lgkmcnt(0)\n\ts_barrier":::"memory")

__device__ __forceinline__ void qkt(f32x16&p0,f32x16&p1,const char*Kslot,const bf16x8*qr,const f32x16&negm,int r32,int hi){
  const char*kb=Kslot+hi*1024+r32*16;
  #pragma unroll
  for(int d0=0;d0<4;++d0){
    const bf16x8 b0=*reinterpret_cast<const bf16x8*>(kb+d0*2048);
    const bf16x8 b1=*reinterpret_cast<const bf16x8*>(kb+d0*2048+512);
    if(d0==0){p0=__builtin_amdgcn_mfma_f32_32x32x16_bf16(b0,qr[0],negm,0,0,0);p1=__builtin_amdgcn_mfma_f32_32x32x16_bf16(b1,qr[0],negm,0,0,0);}
    else{p0=__builtin_amdgcn_mfma_f32_32x32x16_bf16(b0,qr[d0],p0,0,0,0);p1=__builtin_amdgcn_mfma_f32_32x32x16_bf16(b1,qr[d0],p1,0,0,0);}}
}
typedef __attribute__((address_space(3))) const char* lds_cptr;
typedef short v4i16_t __attribute__((ext_vector_type(4)));
__device__ __forceinline__ void kload8(bf16x8*kf,lds_cptr kp){
  kf[0]=*(const __attribute__((address_space(3))) bf16x8*)(kp);      kf[1]=*(const __attribute__((address_space(3))) bf16x8*)(kp+512);
  kf[2]=*(const __attribute__((address_space(3))) bf16x8*)(kp+2048); kf[3]=*(const __attribute__((address_space(3))) bf16x8*)(kp+2560);
  kf[4]=*(const __attribute__((address_space(3))) bf16x8*)(kp+4096); kf[5]=*(const __attribute__((address_space(3))) bf16x8*)(kp+4608);
  kf[6]=*(const __attribute__((address_space(3))) bf16x8*)(kp+6144); kf[7]=*(const __attribute__((address_space(3))) bf16x8*)(kp+6656);
}
__device__ __forceinline__ void kload2(bf16x8*kf,lds_cptr kp,int j){ kf[2*j]=*(const __attribute__((address_space(3))) bf16x8*)(kp+j*2048); kf[2*j+1]=*(const __attribute__((address_space(3))) bf16x8*)(kp+j*2048+512); }
__device__ __forceinline__ s16x4 vtr(lds_cptr p){ return __builtin_bit_cast(s16x4,__builtin_amdgcn_ds_read_tr16_b64_v4i16((__attribute__((address_space(3))) v4i16_t*)p)); }
__device__ __forceinline__ float rowmax(const f32x16&p0,const f32x16&p1){
  float a=max3f(p0[0],p0[1],p1[0]),b=max3f(p0[2],p0[3],p1[1]);a=max3f(a,p1[2],p1[3]);
  #pragma unroll
  for(int r=4;r<16;r+=4){a=max3f(a,p0[r],p0[r+1]);b=max3f(b,p0[r+2],p0[r+3]);a=max3f(a,p1[r],p1[r+1]);b=max3f(b,p1[r+2],p1[r+3]);}
  const float m=max2f(a,b);
  auto rr=__builtin_amdgcn_permlane32_swap(__float_as_uint(m),__float_as_uint(m),false,false);
  return max2f(__uint_as_float(rr[0]),__uint_as_float(rr[1]));
}
__device__ __forceinline__ void pv(f32x16*o,int vb,bf16x8 pa0,bf16x8 pa1,bf16x8 pa2,bf16x8 pa3){
  #pragma unroll
  for(int d0=0;d0<4;++d0){s16x4 lo[4],hi[4];
    #pragma unroll
    for(int ks=0;ks<4;++ks){
      asm volatile("ds_read_b64_tr_b16 %0,%1 offset:%c2":"=&v"(lo[ks]):"v"(vb),"i"(d0*4096+ks*1024):"memory");
      asm volatile("ds_read_b64_tr_b16 %0,%1 offset:%c2":"=&v"(hi[ks]):"v"(vb),"i"(d0*4096+ks*1024+512):"memory");}
    asm volatile("s_waitcnt lgkmcnt(0)":::"memory");SBAR();
    #define PK(k) (bf16x8){lo[k][0],lo[k][1],lo[k][2],lo[k][3],hi[k][0],hi[k][1],hi[k][2],hi[k][3]}
    o[d0]=__builtin_amdgcn_mfma_f32_32x32x16_bf16(pa0,PK(0),o[d0],0,0,0);
    o[d0]=__builtin_amdgcn_mfma_f32_32x32x16_bf16(pa1,PK(1),o[d0],0,0,0);
    o[d0]=__builtin_amdgcn_mfma_f32_32x32x16_bf16(pa2,PK(2),o[d0],0,0,0);
    o[d0]=__builtin_amdgcn_mfma_f32_32x32x16_bf16(pa3,PK(3),o[d0],0,0,0);
    #undef PK
  }
}

#ifndef ATTN_STORE16
#define ATTN_STORE16(p,v) (*(u32x4*)(p)=(v))
#endif
template<int THRL,bool CAUSAL> __device__ __forceinline__ void attn_unit(const bf16*Qu,const int pQ,const bf16*__restrict__ Kh,const bf16*__restrict__ Vh,const int pKV,bf16*Ou,const int pO,const int NT,char*shm){
  int tid_=threadIdx.x; asm volatile("":"+v"(tid_));
  const int tid=tid_,lane=tid&63,r32=lane&31,hi=lane>>5; const int wid=__builtin_amdgcn_readfirstlane(tid>>6);
  const bf16*Qw=Qu+(long)(wid*QBLK)*pQ;
  const unsigned lds0=(unsigned)(uintptr_t)shm;
  float*wsf=(float*)(shm+LDS_WS)+wid*64;
  const bf16*ksrc=Kh+(long)lane*pKV+wid*8;
  const bf16*vsrc=Vh+(long)(16*(wid&3)+(lane>>2))*pKV+(wid>>2)*32+(lane&3)*8;
  const unsigned kdst=lds0+LDS_K+wid*1024, vdst=lds0+LDS_V+wid*1024;
  #define DMA_K(t,slot) glds16(ksrc+(long)(t)*KVBLK*pKV,(unsigned)__builtin_amdgcn_readfirstlane(kdst+(slot)))
  #define DMA_V(t,slot) do{ glds16(vsrc+(long)(t)*KVBLK*pKV,(unsigned)__builtin_amdgcn_readfirstlane(vdst+2*(slot))); glds16(vsrc+(long)(t)*KVBLK*pKV+64,(unsigned)__builtin_amdgcn_readfirstlane(vdst+2*(slot)+8192)); }while(0)
  const int vb0=(int)(lds0+LDS_V)+((lane>>4)&1)*32+(lane&3)*8+(4*hi+((lane&15)>>2))*64;
  const char*Kbase=shm+LDS_K; bf16x8 kf[8];
  const lds_cptr shm3=(lds_cptr)shm; const lds_cptr kp0=shm3+LDS_K+hi*1024+r32*16; const lds_cptr vp0=shm3+LDS_V+((lane>>4)&1)*32+(lane&3)*8+(4*hi+((lane&15)>>2))*64;
  DMA_K(0,0);DMA_V(0,0);DMA_K(1,SLOTB);
  bf16x8 qr[4];
  #pragma unroll
  for(int d0=0;d0<4;++d0)qr[d0]=*reinterpret_cast<const bf16x8*>(&Qw[(long)r32*pQ+d0*16+hi*8]);
  float mhat=0.f,l_reg=0.f;f32x16 o[4];o[0]=f32x16{};o[1]=f32x16{};o[2]=f32x16{};o[3]=f32x16{};const f32x16 negm=f32x16{};
  const int qrel=wid*QBLK+r32;
  #define CMASK(P0,P1,t) do{ if(CAUSAL){int jb_=(t)-(NT-4); if(jb_>=0)cmask(P0,P1,jb_,qrel,hi);} }while(0)
  bool resc=false;
  #define START(P0,P1) do{ const float rm=rowmax(P0,P1); resc=false; \
    { const float dl=rm; mhat=fadd_s(mhat,dl); \
      _Pragma("unroll") for(int r=0;r<16;++r){P0[r]=fsub_s(P0[r],dl);P1[r]=fsub_s(P1[r],dl);} \
      } \
    _Pragma("unroll") for(int r=0;r<16;++r)P0[r]=__builtin_amdgcn_exp2f(P0[r]); }while(0)
  #define RESC() do{ if(resc){ asm volatile("s_waitcnt lgkmcnt(0)":::"memory"); \
      _Pragma("unroll") for(int d_=0;d_<4;++d_) _Pragma("unroll") for(int r=0;r<16;++r)o[d_][r]*=wsf[crow(r,hi)]; } }while(0)
  f32x16 pA0,pA1,pB0,pB1;
  int sl_prev=0,sl_cur=0,sl_next=SLOTB;
  #define ROT() do{sl_prev=sl_cur;sl_cur=sl_next;sl_next=(sl_next==(NSLOT-1)*SLOTB)?0:sl_next+SLOTB;}while(0)
  DMA_K(2,2*SLOTB);
  WAIT_BAR(4);
  qkt(pA0,pA1,Kbase,qr,negm,r32,hi);asm volatile("s_nop 15\n\ts_nop 7":"+v"(pA0),"+v"(pA1));CMASK(pA0,pA1,0);
  START(pA0,pA1);
  _Pragma("unroll") for(int r=0;r<16;++r)pA1[r]=__builtin_amdgcn_exp2f(pA1[r]);
  WAIT_BAR(0);
  DMA_K(3,0);DMA_V(1,SLOTB);
  ROT();
  kload8(kf,kp0+sl_cur);
  WAIT_BAR(3);
  s16x4 vlo[8],vhi[8]; u32x4 pw0,pw1,pw2,pw3;
  #define PKW(P,B) cvtpk_s(P[B],P[B+1])
  #define PAF(k) __builtin_bit_cast(bf16x8,pw##k)
  #define VFR(i) (bf16x8){vlo[i][0],vlo[i][1],vlo[i][2],vlo[i][3],vhi[i][0],vhi[i][1],vhi[i][2],vhi[i][3]}
  #define PIN(x) asm volatile("":"+v"(x))
  #define MX3(a,b,c) __builtin_fmaxf(__builtin_fmaxf((a),(b)),(c))
  #define GAPA(MF,A0,A1,A2,A3,W0,W1,PW) do{ MF; sacc+=A0; sacc+=A1; sacc+=A2; sacc+=A3; PIN(sacc); W0; W1; PIN(PW); SBAR(); }while(0)
  #define EX(v) __builtin_amdgcn_exp2f(v)
  #define GAPB(MF,X,B) do{ MF; X[B]=EX(X[B]); X[B+1]=EX(X[B+1]); X[B+2]=EX(X[B+2]); X[B+3]=EX(X[B+3]); PIN(X); SBAR(); }while(0)
  #define VRD(i) do{ vlo[i]=vtr(vp_+(((i)>>2)*4096+((i)&3)*1024)); vhi[i]=vtr(vp_+(((i)>>2)*4096+((i)&3)*1024+512)); }while(0)
  #define VRD2(i) do{ vlo[i]=vtr(vp_+((((i)>>2)+2)*4096+((i)&3)*1024)); vhi[i]=vtr(vp_+((((i)>>2)+2)*4096+((i)&3)*1024+512)); }while(0)
  #define GAPB2(MF,X,B) do{ MF; X[B]=EX(X[B]); X[B+1]=EX(X[B+1]); PIN(X); SBAR(); }while(0)
  #define KRD(G,j) do{ if(G){ kload2(kf,kp0+sl_next,j); SBAR(); } }while(0)
  #define STEP(C0,C1,P0,P1,t,GK,GV,GL) do{ SBAR(); \
    const lds_cptr vp_=vp0+2*sl_prev; \
    VRD(0); SBAR(); float sacc=(P0[0]+P0[1]); \
    GAPA(C0=__builtin_amdgcn_mfma_f32_32x32x16_bf16(kf[0],qr[0],negm,0,0,0), P0[2],P0[3],P0[4],P0[5],     pw0[0]=PKW(P0,0), pw0[1]=PKW(P0,2), pw0); \
    VRD(4); SBAR(); GAPA(C1=__builtin_amdgcn_mfma_f32_32x32x16_bf16(kf[1],qr[0],negm,0,0,0), P0[6],P0[7],P0[8],P0[9],     pw0[2]=PKW(P0,4), pw0[3]=PKW(P0,6), pw0); \
    VRD(1); SBAR(); GAPA(C0=__builtin_amdgcn_mfma_f32_32x32x16_bf16(kf[2],qr[1],C0,0,0,0),   P0[10],P0[11],P0[12],P0[13], pw1[0]=PKW(P0,8), pw1[1]=PKW(P0,10), pw1); \
    VRD(5); SBAR(); GAPA(C1=__builtin_amdgcn_mfma_f32_32x32x16_bf16(kf[3],qr[1],C1,0,0,0),   P0[14],P0[15],P1[0],P1[1],   pw1[2]=PKW(P0,12),pw1[3]=PKW(P0,14), pw1); \
    VRD(2); SBAR(); GAPA(C0=__builtin_amdgcn_mfma_f32_32x32x16_bf16(kf[4],qr[2],C0,0,0,0),   P1[2],P1[3],P1[4],P1[5],     pw2[0]=PKW(P1,0), pw2[1]=PKW(P1,2), pw2); \
    VRD(6); SBAR(); GAPA(C1=__builtin_amdgcn_mfma_f32_32x32x16_bf16(kf[5],qr[2],C1,0,0,0),   P1[6],P1[7],P1[8],P1[9],     pw2[2]=PKW(P1,4), pw2[3]=PKW(P1,6), pw2); \
    VRD(3); SBAR(); GAPA(C0=__builtin_amdgcn_mfma_f32_32x32x16_bf16(kf[6],qr[3],C0,0,0,0),   P1[10],P1[11],P1[12],P1[13], pw3[0]=PKW(P1,8), pw3[1]=PKW(P1,10), pw3); \
    VRD(7); SBAR(); GAPA(C1=__builtin_amdgcn_mfma_f32_32x32x16_bf16(kf[7],qr[3],C1,0,0,0),   P1[14],P1[15],0.f,0.f,       pw3[2]=PKW(P1,12),pw3[3]=PKW(P1,14), pw3); \
    l_reg+=sacc; \
    if(GK){DMA_K((t)+3,sl_cur);} if(GV){DMA_V((t)+1,sl_next);} \
    CMASK(C0,C1,t); \
    _Pragma("unroll") for(int r=0;r<16;++r){C0[r]-=mhat;C1[r]-=mhat;} \
    { float a=MX3(C0[0],C0[1],C1[0]),b=MX3(C0[2],C0[3],C1[1]); a=MX3(a,C1[2],C1[3]); \
      _Pragma("unroll") for(int r=4;r<16;r+=4){a=MX3(a,C0[r],C0[r+1]);b=MX3(b,C0[r+2],C0[r+3]);a=MX3(a,C1[r],C1[r+1]);b=MX3(b,C1[r+2],C1[r+3]);} \
      float rm=__builtin_fmaxf(a,b); { auto rr=__builtin_amdgcn_permlane32_swap(__float_as_uint(rm),__float_as_uint(rm),false,false); rm=__builtin_fmaxf(__uint_as_float(rr[0]),__uint_as_float(rr[1])); } \
      resc=false; \
      if(__builtin_expect(__any(rm>(float)THRL),0)){ const float dl=__builtin_fmaxf(rm,0.f); mhat+=dl; \
        _Pragma("unroll") for(int r=0;r<16;++r){C0[r]-=dl;C1[r]-=dl;} \
        const float f=__builtin_amdgcn_exp2f(-dl); l_reg*=f; if(hi==0)wsf[r32]=f; resc=true; } } \
    SBAR(); \
    GAPB2(o[0]=__builtin_amdgcn_mfma_f32_32x32x16_bf16(PAF(0),VFR(0),o[0],0,0,0), C0,0); VRD2(0); SBAR(); \
    GAPB2(o[1]=__builtin_amdgcn_mfma_f32_32x32x16_bf16(PAF(0),VFR(4),o[1],0,0,0), C0,2); VRD2(4); SBAR(); \
    KRD(GL,0); GAPB2(o[0]=__builtin_amdgcn_mfma_f32_32x32x16_bf16(PAF(1),VFR(1),o[0],0,0,0), C0,4); VRD2(1); SBAR(); \
    KRD(GL,1); GAPB2(o[1]=__builtin_amdgcn_mfma_f32_32x32x16_bf16(PAF(1),VFR(5),o[1],0,0,0), C0,6); VRD2(5); SBAR(); \
    KRD(GL,2); GAPB2(o[0]=__builtin_amdgcn_mfma_f32_32x32x16_bf16(PAF(2),VFR(2),o[0],0,0,0), C0,8); VRD2(2); SBAR(); \
    KRD(GL,3); GAPB2(o[1]=__builtin_amdgcn_mfma_f32_32x32x16_bf16(PAF(2),VFR(6),o[1],0,0,0), C0,10); VRD2(6); SBAR(); \
    GAPB2(o[0]=__builtin_amdgcn_mfma_f32_32x32x16_bf16(PAF(3),VFR(3),o[0],0,0,0), C0,12); VRD2(3); SBAR(); \
    GAPB2(o[1]=__builtin_amdgcn_mfma_f32_32x32x16_bf16(PAF(3),VFR(7),o[1],0,0,0), C0,14); VRD2(7); SBAR(); \
    GAPB2(o[2]=__builtin_amdgcn_mfma_f32_32x32x16_bf16(PAF(0),VFR(0),o[2],0,0,0), C1,0); \
    GAPB2(o[3]=__builtin_amdgcn_mfma_f32_32x32x16_bf16(PAF(0),VFR(4),o[3],0,0,0), C1,2); \
    GAPB2(o[2]=__builtin_amdgcn_mfma_f32_32x32x16_bf16(PAF(1),VFR(1),o[2],0,0,0), C1,4); \
    GAPB2(o[3]=__builtin_amdgcn_mfma_f32_32x32x16_bf16(PAF(1),VFR(5),o[3],0,0,0), C1,6); \
    GAPB2(o[2]=__builtin_amdgcn_mfma_f32_32x32x16_bf16(PAF(2),VFR(2),o[2],0,0,0), C1,8); \
    GAPB2(o[3]=__builtin_amdgcn_mfma_f32_32x32x16_bf16(PAF(2),VFR(6),o[3],0,0,0), C1,10); \
    GAPB2(o[2]=__builtin_amdgcn_mfma_f32_32x32x16_bf16(PAF(3),VFR(3),o[2],0,0,0), C1,12); \
    GAPB2(o[3]=__builtin_amdgcn_mfma_f32_32x32x16_bf16(PAF(3),VFR(7),o[3],0,0,0), C1,14); \
    }while(0)
  int t=1;
  #undef CMASK
  #define CMASK(P0,P1,t) do{}while(0)
  for(;t+5<NT;t+=2){
    STEP(pB0,pB1,pA0,pA1,t,true,true,true);     WAIT_BAR(3); RESC(); ROT();
    STEP(pA0,pA1,pB0,pB1,t+1,true,true,true);   WAIT_BAR(3); RESC(); ROT();
  }
  #undef CMASK
  #define CMASK(P0,P1,t) do{ if(CAUSAL){int jb_=(t)-(NT-4); if(jb_>=0)cmask(P0,P1,jb_,qrel,hi);} }while(0)
  #define ENDW(tt) do{ if((tt)+3<NT){WAIT_BAR(3);} else if((tt)+2<NT){WAIT_BAR(2);} else {WAIT_BAR(0);} }while(0)
  for(;t+1<NT;t+=2){
    STEP(pB0,pB1,pA0,pA1,t,(t+3<NT),(t+1<NT),(t+1<NT));       ENDW(t);   RESC(); ROT();
    STEP(pA0,pA1,pB0,pB1,t+1,(t+4<NT),(t+2<NT),(t+2<NT));     ENDW(t+1); RESC(); ROT();
  }
  STEP(pB0,pB1,pA0,pA1,NT-1,false,false,false); RESC();
  { float sacc=pB0[0]+pB0[1]; _Pragma("unroll") for(int r=2;r<16;++r)sacc+=pB0[r]; _Pragma("unroll") for(int r=0;r<16;++r)sacc+=pB1[r]; l_reg+=sacc;
    pw0=(u32x4){PKW(pB0,0),PKW(pB0,2),PKW(pB0,4),PKW(pB0,6)};pw1=(u32x4){PKW(pB0,8),PKW(pB0,10),PKW(pB0,12),PKW(pB0,14)};pw2=(u32x4){PKW(pB1,0),PKW(pB1,2),PKW(pB1,4),PKW(pB1,6)};pw3=(u32x4){PKW(pB1,8),PKW(pB1,10),PKW(pB1,12),PKW(pB1,14)};
    SBAR(); pv(o,vb0+2*sl_cur,PAF(0),PAF(1),PAF(2),PAF(3)); }
  #undef PKW
  #undef PAF
  #undef VFR
  #undef PIN
  #undef MX3
  #undef GAPA
  #undef GAPB
  #undef EX
  #undef VRD
  #undef VRD2
  #undef GAPB2
  #undef KRD
  #undef STEP
  #undef ENDW
  {auto rr=__builtin_amdgcn_permlane32_swap(__float_as_uint(l_reg),__float_as_uint(l_reg),false,false);l_reg=__uint_as_float(rr[0])+__uint_as_float(rr[1]);}
  if(hi==0)wsf[32+r32]=l_reg;asm volatile("s_waitcnt lgkmcnt(0)":::"memory");
  float rli[16];
  #pragma unroll
  for(int r=0;r<16;++r)rli[r]=__builtin_amdgcn_rcpf(wsf[32+crow(r,hi)]);
  bf16*Ow=Ou+(long)(wid*QBLK)*pO;
  { bf16*stg=(bf16*)(shm+LDS_OST)+wid*2048;
    #pragma unroll
    for(int hf=0;hf<2;++hf){
      #pragma unroll
      for(int r=0;r<16;++r){const int orow=crow(r,hi);
        #pragma unroll
        for(int d0=0;d0<2;++d0)stg[orow*64+d0*32+r32]=__float2bfloat16(o[2*hf+d0][r]*rli[r]);}
      asm volatile("s_waitcnt lgkmcnt(0)":::"memory");
      #pragma unroll
      for(int i=0;i<4;++i){const int row=i*8+(lane>>3),ch=lane&7; const u32x4 v=*(const u32x4*)(stg+row*64+ch*8); ATTN_STORE16(Ow+(long)row*pO+hf*64+ch*8,v);}
      asm volatile("s_waitcnt lgkmcnt(0)":::"memory"); } }
  asm volatile("s_waitcnt lgkmcnt(0)\n\ts_barrier":::"memory");
  #undef DMA_K
  #undef DMA_V
  #undef CMASK
  #undef START
  #undef RESC
  #undef ROT
}
constexpr int ATTN_LDS_BYTES=LDS_BYTES;
#undef SBAR
#undef WAIT_BAR
}

constexpr int NWAVES = 8;
#ifndef MK_N_LAUNCHES
#define MK_N_LAUNCHES 1
#endif
constexpr int NPH = 10;
constexpr int BATCH = 32, SEQ = 2048, D = 1024, T = BATCH * SEQ, NMEM = 256, TM = BATCH * NMEM;
constexpr int INCOLS = 5120, PROJW = 2048, GATEW = 3072;
constexpr float RMS_EPS = 1e-6f;
constexpr int NEXP = 16, EH = 512;
constexpr int MAXROWS = 2 * T + NEXP * 256;
constexpr size_t MiB = 1u << 20;
constexpr size_t WS_CTL = 0, CTL_ZERO_BYTES = 1 * MiB;
constexpr size_t WS_WRF = 1 * MiB;
constexpr size_t WS_RINV = 1 * MiB + 128 * 1024;
constexpr size_t WS_WIN = 2 * MiB;
constexpr size_t WS_PC = 13 * MiB;
constexpr size_t WS_WO = 15 * MiB;
constexpr size_t WS_WGU = 17 * MiB;
constexpr size_t WS_WD = 49 * MiB;
constexpr size_t WS_ROUTE = 65 * MiB;
constexpr size_t WS_KV = 68 * MiB;
constexpr size_t WS_XN = 76 * MiB;
constexpr size_t WS_BR = 76 * MiB;
constexpr size_t WS_H2 = 76 * MiB;
constexpr size_t WS_PROJ = 220 * MiB;
constexpr size_t WS_MERGED = 220 * MiB;
constexpr size_t WS_HID = 220 * MiB;
constexpr size_t WS_ATTO = 476 * MiB;
constexpr size_t WS_GATES = 604 * MiB;
constexpr size_t WS_LIST = 476 * MiB;
constexpr size_t WS_RWE = 480 * MiB;
constexpr size_t WS_Y = 604 * MiB;
constexpr size_t WS_END = 988 * MiB;
static_assert(WS_XN + (size_t)(T + TM) * D * 2 <= WS_PROJ && WS_PROJ + (size_t)T * PROJW * 2 <= WS_ATTO && WS_ATTO + (size_t)T * D * 2 <= WS_GATES && WS_GATES + (size_t)T * GATEW * 2 <= WS_END, "ws map");
static_assert(WS_Y + (size_t)MAXROWS * D * 2 <= WS_END && WS_HID + (size_t)MAXROWS * EH * 2 <= WS_ATTO && WS_RWE + (size_t)NEXP * 65536 * 8 <= WS_GATES, "ws map 2");
constexpr int CW_CNT = 64;
constexpr int RING_OFF = 0, RING_BYTES = 131072;
constexpr int LDSX_OFF = RING_BYTES;
constexpr int LDS_BYTES = 147456;

#define GAS __attribute__((address_space(1)))
#define LAS __attribute__((address_space(3)))
typedef unsigned short bf16;
typedef unsigned v4u __attribute__((ext_vector_type(4)));
typedef unsigned v2u __attribute__((ext_vector_type(2)));
typedef float f32x4 __attribute__((ext_vector_type(4)));
#define LDS_WAIT() asm volatile("s_waitcnt lgkmcnt(0)" ::: "memory")
__device__ __forceinline__ unsigned f2bf(float f) { unsigned u = __builtin_bit_cast(unsigned, f); return (u + 0x7fffu + ((u >> 16) & 1u)) >> 16; }
__device__ __forceinline__ unsigned pk2(float lo, float hi) { return f2bf(lo) | (f2bf(hi) << 16); }
typedef float f32x2_t __attribute__((ext_vector_type(2))); typedef __bf16 bf16x2_t __attribute__((ext_vector_type(2)));
typedef short bf16x8_t __attribute__((ext_vector_type(8))); typedef float f32x16_t __attribute__((ext_vector_type(16)));
__device__ __forceinline__ unsigned cvtpk(float lo, float hi) { f32x2_t v = {lo, hi}; bf16x2_t b = __builtin_convertvector(v, bf16x2_t); return __builtin_bit_cast(unsigned, b); }
__device__ __forceinline__ float bflo(unsigned w) { return __uint_as_float(w << 16); }
__device__ __forceinline__ float bfhi(unsigned w) { return __uint_as_float(w & 0xffff0000u); }
__device__ __forceinline__ float wave_sum(float v) {
#pragma unroll
    for (int o = 1; o < 64; o <<= 1) v += __shfl_xor(v, o);
    return v;
}

typedef GAS unsigned gu32;
#define RLX_AGENT __ATOMIC_RELAXED, __HIP_MEMORY_SCOPE_AGENT
constexpr int CW_BAR = 4096;
constexpr int CW_TS = 128;
#define XB_TMO      128
#define XB_XCNT(j)  (256  + 64 * (j))
#define XB_XSUB(j)  (1280 + 64 * (j))
#define XB_XGEN(j)  (2304 + 64 * (j))
#define XB_TOP      3328
#define XB_TOPGEN   3392
#define XCD_BAR_WORDS 3456
#define XB_SPIN_CAP (1u << 18)

__device__ __forceinline__ unsigned xb_ld(unsigned* p)              { return __hip_atomic_load(p, __ATOMIC_RELAXED, __HIP_MEMORY_SCOPE_AGENT); }
__device__ __forceinline__ unsigned xb_add(unsigned* p, unsigned v) { return __hip_atomic_fetch_add(p, v, __ATOMIC_RELAXED, __HIP_MEMORY_SCOPE_AGENT); }
__device__ __forceinline__ unsigned xb_xcc_id() { return (unsigned)__builtin_amdgcn_s_getreg((3 << 11) | 20) & 0xFu; }
#define XB_SPIN(cond, bar) do { unsigned _sp = 0; while (cond) { __builtin_amdgcn_s_sleep(1); \
    if ((++_sp & 255u) == 0u) { if (xb_ld(&(bar)[XB_TMO])) break; if (_sp > XB_SPIN_CAP) { atomicAdd(&(bar)[XB_TMO], 1u); break; } } } } while (0)

struct XcdBarrier {
    unsigned* bar; unsigned x;
    volatile LAS unsigned* st;
};

__device__ __forceinline__ XcdBarrier xcd_barrier_post(unsigned* bar, volatile LAS unsigned* st) {
    XcdBarrier b; b.bar = bar; b.x = xb_xcc_id(); b.st = st;
    if (threadIdx.x == 0) (void)xb_add(&bar[XB_XCNT(b.x)], 1u);
    return b;
}
__device__ __forceinline__ void xcd_barrier_complete(unsigned* bar, unsigned x, unsigned& nloc, unsigned& nx) {
    const unsigned G = gridDim.x * gridDim.y * gridDim.z;
    unsigned sum, cnt, mine, sp = 0u;
    for (;;) {
        sum = 0u; cnt = 0u; mine = 0u;
#pragma unroll
        for (unsigned j = 0; j < 16; ++j) { const unsigned c = xb_ld(&bar[XB_XCNT(j)]); sum += c; cnt += (c > 0u) ? 1u : 0u; mine = (j == x) ? c : mine; }
        if (sum == G) break;
        __builtin_amdgcn_s_sleep(1);
        if ((++sp & 255u) == 0u) { if (xb_ld(&bar[XB_TMO])) break; if (sp > XB_SPIN_CAP) { atomicAdd(&bar[XB_TMO], 1u); break; } }
    }
    nloc = mine > 0u ? mine : 1u; nx = cnt > 0u ? cnt : 1u;
}

__device__ __forceinline__ void xcd_barrier(const XcdBarrier& b) {
    asm volatile("s_waitcnt vmcnt(0)" ::: "memory");
    __syncthreads();
    if (threadIdx.x == 0) {
        unsigned* bar = b.bar;
        __builtin_amdgcn_s_waitcnt(0);
        unsigned nloc = b.st[0], nx = b.st[1];
        if (nloc == 0u) { xcd_barrier_complete(bar, b.x, nloc, nx); b.st[0] = nloc; b.st[1] = nx; }
        const unsigned old = xb_add(&bar[XB_XSUB(b.x)], 1u);
        const unsigned gen = old / nloc;
        if (old + 1u == (gen + 1u) * nloc) {
            __builtin_amdgcn_fence(__ATOMIC_RELEASE, "agent");
            asm volatile("s_waitcnt vmcnt(0)" ::: "memory");
            const unsigned og = xb_add(&bar[XB_TOP], 1u);
            const unsigned tg = og / nx;
            if (og + 1u == (tg + 1u) * nx) xb_add(&bar[XB_TOPGEN], 1u);
            else XB_SPIN(xb_ld(&bar[XB_TOPGEN]) == tg, bar);
            __builtin_amdgcn_fence(__ATOMIC_ACQUIRE, "agent");
            xb_add(&bar[XB_XGEN(b.x)], 1u);
            asm volatile("s_waitcnt vmcnt(0)" ::: "memory");
        } else {
            XB_SPIN(xb_ld(&bar[XB_XGEN(b.x)]) == gen, bar);
            __builtin_amdgcn_fence(__ATOMIC_ACQUIRE, "agent");
            asm volatile("s_waitcnt vmcnt(0)" ::: "memory");
        }
    }
    __syncthreads();
}

struct Frame {
    LAS unsigned char* lds;
    unsigned* ctl;
    int vcu, G;
};

__device__ __forceinline__ void p0_tile(const float* W, int N, int k0, int n0, bf16* WT, int Kd, int drow0, LAS float* scr, int lane, const float* gk = nullptr) {
    f32x4 w[8];
#pragma unroll
    for (int i = 0; i < 8; ++i) w[i] = *(const GAS f32x4*)(W + (size_t)(k0 + i * 8 + (lane >> 3)) * N + n0 + (lane & 7) * 4);
    if (gk) {
#pragma unroll
        for (int i = 0; i < 8; ++i) w[i] = w[i] * gk[k0 + i * 8 + (lane >> 3)]; }
#pragma unroll
    for (int i = 0; i < 8; ++i) { LAS float* d = scr + (i * 8 + (lane >> 3)) * 33 + (lane & 7) * 4; d[0] = w[i].x; d[1] = w[i].y; d[2] = w[i].z; d[3] = w[i].w; }
    LDS_WAIT(); asm volatile("" ::: "memory");
    const int c = lane & 7;
#pragma unroll
    for (int j = 0; j < 4; ++j) { const int n = (lane >> 3) + 8 * j; const LAS float* s = scr + (8 * c) * 33 + n;
        v4u o; o.x = pk2(s[0 * 33], s[1 * 33]); o.y = pk2(s[2 * 33], s[3 * 33]); o.z = pk2(s[4 * 33], s[5 * 33]); o.w = pk2(s[6 * 33], s[7 * 33]);
        *(GAS v4u*)(WT + (size_t)(drow0 + n) * Kd + k0 + 8 * c) = o; }
    LDS_WAIT(); asm volatile("" ::: "memory");
}
__device__ __forceinline__ void p0_plain(const float* W, int K, int N, bf16* WT, int row_off, int item, LAS float* scr, int lane) {
    const int nblk = N / 32, kb = item / nblk, nb = item % nblk;
    p0_tile(W, N, 64 * kb, 32 * nb, WT, K, row_off + 32 * nb, scr, lane);
}
__device__ __forceinline__ void rms_row_to_bf16(const float* xrow, const float* g, bf16* orow, int lane) {
    const GAS f32x4* xr = (const GAS f32x4*)xrow + lane; const GAS f32x4* gr = (const GAS f32x4*)g + lane;
    f32x4 v[4]; float s = 0.f;
#pragma unroll
    for (int j = 0; j < 4; ++j) { v[j] = xr[64 * j]; s += (v[j].x * v[j].x + v[j].y * v[j].y) + (v[j].z * v[j].z + v[j].w * v[j].w); }
    const float r = 1.f / sqrtf(wave_sum(s) * (1.f / D) + RMS_EPS);
    GAS unsigned long long* o8 = (GAS unsigned long long*)orow + lane;
#pragma unroll
    for (int j = 0; j < 4; ++j) { const f32x4 gg = gr[64 * j]; const f32x4 h = v[j] * r * gg;
        o8[64 * j] = (unsigned long long)pk2(h.x, h.y) | ((unsigned long long)pk2(h.z, h.w) << 32); }
}

__device__ __forceinline__ void rms_rows_stream(const float* src1, const float* g1, const float* src2, const float* g2, int nT, int nAll, bf16* dst, int m0, int mstep, int lane) {
    f32x4 cur[4][4], nxt[4][4];
    if (m0 >= nAll) return;
    { const GAS f32x4* xr = (const GAS f32x4*)((m0 < nT ? src1 + (size_t)m0 * D : src2 + (size_t)(m0 - nT) * D)) + lane;
#pragma unroll
      for (int q = 0; q < 4; ++q)
#pragma unroll
          for (int j = 0; j < 4; ++j) cur[q][j] = xr[q * 256 + 64 * j]; }
    for (int m = m0; m < nAll; m += mstep) {
        const int mn = m + mstep; const bool has = mn < nAll; const int ml = has ? mn : m;
        { const GAS f32x4* xr = (const GAS f32x4*)((ml < nT ? src1 + (size_t)ml * D : src2 + (size_t)(ml - nT) * D)) + lane;
#pragma unroll
          for (int q = 0; q < 4; ++q)
#pragma unroll
              for (int j = 0; j < 4; ++j) nxt[q][j] = xr[q * 256 + 64 * j]; }
        float s[4];
#pragma unroll
        for (int q = 0; q < 4; ++q) { s[q] = 0.f;
#pragma unroll
            for (int j = 0; j < 4; ++j) s[q] += (cur[q][j].x * cur[q][j].x + cur[q][j].y * cur[q][j].y) + (cur[q][j].z * cur[q][j].z + cur[q][j].w * cur[q][j].w); }
#pragma unroll
        for (int o = 1; o < 64; o <<= 1) {
#pragma unroll
            for (int q = 0; q < 4; ++q) s[q] += __shfl_xor(s[q], o); }
        const GAS f32x4* gr = (const GAS f32x4*)(m < nT ? g1 : g2) + lane;
        f32x4 gg[4];
#pragma unroll
        for (int j = 0; j < 4; ++j) gg[j] = gr[64 * j];
#pragma unroll
        for (int q = 0; q < 4; ++q) { const float r = 1.f / sqrtf(s[q] * (1.f / D) + RMS_EPS);
            GAS unsigned long long* o8 = (GAS unsigned long long*)(dst + (size_t)(m + q) * D) + lane;
#pragma unroll
            for (int j = 0; j < 4; ++j) { const f32x4 h = cur[q][j] * r * gg[j]; o8[64 * j] = (unsigned long long)pk2(h.x, h.y) | ((unsigned long long)pk2(h.z, h.w) << 32); } }
#pragma unroll
        for (int q = 0; q < 4; ++q)
#pragma unroll
            for (int j = 0; j < 4; ++j) cur[q][j] = nxt[q][j];
    }
}

__device__ __forceinline__ void build_tile_tables(Frame& F, const int tid) {
    LAS int* TB = (LAS int*)(F.lds + LDSX_OFF); LAS unsigned char* t2e = F.lds + LDSX_OFF + 128;
    __syncthreads();
    if (tid == 0) { int acc = 0;
        for (int e = 0; e < NEXP; ++e) { const int n = (int)__hip_atomic_load(F.ctl + CW_CNT + e, __ATOMIC_RELAXED, __HIP_MEMORY_SCOPE_AGENT); TB[e] = acc; acc += (n + 255) >> 8; }
        TB[NEXP] = acc; }
    __syncthreads();
    for (int t = tid; t < 1024; t += NWAVES * 64) { int e = 0;
#pragma unroll
        for (int k = 1; k < NEXP; ++k) e += (t >= TB[k]) ? 1 : 0;
        t2e[t] = (unsigned char)e; }
    __syncthreads();
}

struct Args { const float* in[26]; float* out; unsigned char* ws; int ph_lo, ph_hi; };

__global__ void __launch_bounds__(NWAVES * 64, 2) hybrid_fwd(Args args) {
    extern __shared__ __attribute__((aligned(16))) unsigned char lds[];
    __builtin_assume(__builtin_amdgcn_workitem_id_y() == 0); __builtin_assume(__builtin_amdgcn_workitem_id_z() == 0);
    Frame F;
    F.lds = (LAS unsigned char*)lds;
    F.G = gridDim.x; { const int bx = blockIdx.x; F.vcu = (F.G % 8 == 0) ? (bx % 8) * (F.G / 8) + bx / 8 : bx; }
    F.ctl = (unsigned*)(args.ws + WS_CTL);
#define x_in (args.in[0])
#define mem_in (args.in[1])
#define norm_mix_g (args.in[2])
#define w_in (args.in[3])
#define pool_w (args.in[4])
#define pool_scale (args.in[5])
#define lam_q1 (args.in[6])
#define lam_k1 (args.in[7])
#define lam_q2 (args.in[8])
#define lam_k2 (args.in[9])
#define subln_g (args.in[10])
#define norm_mem_g (args.in[11])
#define w_mem_kv (args.in[12])
#define p_pool (args.in[13])
#define p_diff (args.in[14])
#define p_mem (args.in[15])
#define w_o (args.in[16])
#define norm_ffn_g (args.in[17])
#define w_rg (args.in[18])
#define b_rg (args.in[19])
#define w_re (args.in[20])
#define b_re (args.in[21])
#define w_eg (args.in[22])
#define w_eu (args.in[23])
#define w_ed (args.in[24])
#define final_g (args.in[25])
#define Win_t ((bf16*)(args.ws + WS_WIN))
#define Pc_t ((bf16*)(args.ws + WS_PC))
#define Wo_t ((bf16*)(args.ws + WS_WO))
#define Wgu_t ((bf16*)(args.ws + WS_WGU))
#define Wd_t ((bf16*)(args.ws + WS_WD))
#define KV ((bf16*)(args.ws + WS_KV))
#define XN ((bf16*)(args.ws + WS_XN))
#define BR ((bf16*)(args.ws + WS_BR))
#define H2 ((bf16*)(args.ws + WS_H2))
#define PROJ ((bf16*)(args.ws + WS_PROJ))
#define MERGED ((bf16*)(args.ws + WS_MERGED))
#define HID ((bf16*)(args.ws + WS_HID))
#define ATTO ((bf16*)(args.ws + WS_ATTO))
#define GATES ((bf16*)(args.ws + WS_GATES))
#define Y ((bf16*)(args.ws + WS_Y))
#define ROUTE ((v4u*)(args.ws + WS_ROUTE))
#define RWE ((float*)(args.ws + WS_RWE))
#define LIST ((int*)(args.ws + WS_LIST))
#define WRF ((bf16*)(args.ws + WS_WRF))
#define RINV ((float*)(args.ws + WS_RINV))
#define X1 (args.out)
    const int NGW = F.G * NWAVES;
#define PHASE_IDS int tid = threadIdx.x; asm volatile("" : "+v"(tid)); const int lane = tid & 63, wave = __builtin_amdgcn_readfirstlane(tid >> 6), gw = F.vcu * NWAVES + wave; (void)lane; (void)gw;
    const int lo = args.ph_lo, hi = args.ph_hi;
    cg::grid_group grid = cg::this_grid();
#ifndef PH_MASK
#define PH_MASK 0x3ff
#endif
#define IN(k) (((PH_MASK >> (k)) & 1) && lo <= (k) && (k) < hi)
#ifndef PROBE_A
#define PROBE_A -1
#endif
#ifndef PROBE_B
#define PROBE_B -1
#endif
#ifndef PROBE_A2
#define PROBE_A2 (PROBE_A + 1)
#endif
#ifndef PROBE_B2
#define PROBE_B2 (PROBE_B + 1)
#endif
#define STAMP(k) do { if ((PROBE_A >= 0 || PROBE_B >= 0) && blockIdx.x == 0 && threadIdx.x == 0) ((unsigned long long*)(F.ctl + CW_TS))[k] = __builtin_amdgcn_s_memrealtime(); } while (0)
#define SEAM(k) do { if (IN(k) && IN((k) + 1)) { if ((k) == 0) grid.sync(); else { XcdBarrier b_; b_.bar = (unsigned*)(args.ws + WS_CTL) + CW_BAR; b_.x = xb_xcc_id(); b_.st = (volatile LAS unsigned*)(F.lds + LDSX_OFF + 2048); xcd_barrier(b_); } } STAMP((k) + 1); } while (0)
    if (threadIdx.x < 2) ((LAS unsigned*)(F.lds + LDSX_OFF + 2048))[threadIdx.x] = 0u;
    __syncthreads();
    if (lo < hi - 1) (void)xcd_barrier_post((unsigned*)(args.ws + WS_CTL) + CW_BAR, (volatile LAS unsigned*)(F.lds + LDSX_OFF + 2048));
    STAMP(0);

    if (IN(0)) {
        PHASE_IDS
        LAS float* scr = (LAS float*)(F.lds + RING_OFF + wave * 16384);
        constexpr int I_IN = 16 * 160, I_KV = 16 * 16, I_PD = 8 * 32, I_PM = 4 * 32, I_WO = 16 * 32, I_EG = 16 * 256, I_EU = 16 * 256, I_ED = 16 * 256;
        constexpr int NITEMS = I_IN + I_KV + I_PD + I_PM + I_WO + I_EG + I_EU + I_ED;
        for (int it = gw; it < NITEMS; it += NGW) {
            int r = it;
            if (r < I_IN) { p0_plain(w_in, D, INCOLS, Win_t, 0, r, scr, lane); continue; } r -= I_IN;
            if (r < I_KV) { p0_plain(w_mem_kv, D, 512, Win_t, INCOLS, r, scr, lane); continue; } r -= I_KV;
            if (r < I_PD) { const int kb = r >> 5, nb = r & 31; p0_tile(p_diff, D, 64 * kb, 32 * nb, Pc_t + 256, D, 32 * nb, scr, lane); continue; } r -= I_PD;
            if (r < I_PM) { const int kb = r >> 5, nb = r & 31; p0_tile(p_mem, D, 64 * kb, 32 * nb, Pc_t + 768, D, 32 * nb, scr, lane); continue; } r -= I_PM;
            if (r < I_WO) { p0_plain(w_o, D, D, Wo_t, 0, r, scr, lane); continue; } r -= I_WO;
            if (r < I_EG + I_EU) { const bool up = r >= I_EG; if (up) r -= I_EG;
                const int e = r >> 8, rr = r & 255, kb = rr >> 4, nb = rr & 15, n0 = 32 * nb;
                p0_tile((up ? w_eu : w_eg) + (size_t)e * D * EH, EH, 64 * kb, n0, Wgu_t + (size_t)e * D * D, D, (n0 >> 7) * 256 + (n0 & 127) + (up ? 128 : 0), scr, lane, norm_ffn_g); continue; }
            r -= I_EG + I_EU;
            { const int e = r >> 8, rr = r & 255, kb = rr >> 5, nb = rr & 31;
              p0_tile(w_ed + (size_t)e * EH * D, D, 64 * kb, 32 * nb, Wd_t + (size_t)e * D * EH, EH, 32 * nb, scr, lane); }
        }
        STAMP(12);
        for (int idx = (F.vcu * NWAVES * 64 + tid); idx < 5120; idx += F.G * NWAVES * 64) {
            const int q = idx % 20, h = (idx / 20) & 1, hl = (idx / 40) & 1, st = idx / 80, k0 = 32 * (st >> 1) + 16 * h + 8 * (st & 1);
            float v[8];
#pragma unroll
            for (int j = 0; j < 8; ++j) { const int k = k0 + j; const float w = norm_ffn_g[k] * (q < 4 ? w_rg[k * 4 + q] : w_re[k * 16 + (q - 4)]); const float hi = bflo(f2bf(w) ); v[j] = hl ? (w - hi) : w; }
            v4u o; o.x = pk2(v[0], v[1]); o.y = pk2(v[2], v[3]); o.z = pk2(v[4], v[5]); o.w = pk2(v[6], v[7]);
            *((GAS v4u*)WRF + idx) = o;
        }
        for (int idx = (F.vcu * NWAVES * 64 + tid); idx < 256 * 1024; idx += F.G * NWAVES * 64) {
            const int kc = idx >> 10, n = idx & 1023, g = kc >> 6; float a = 0.f;
#pragma unroll 16
            for (int d = 0; d < 64; ++d) a += pool_w[kc * 64 + d] * pool_scale[g * 64 + d] * p_pool[(size_t)(g * 64 + d) * D + n];
            Pc_t[(size_t)n * D + kc] = (bf16)f2bf(a);
        }
        STAMP(13);
        rms_rows_stream(x_in, norm_mix_g, mem_in, norm_mem_g, T, T + TM, XN, gw * 4, NGW * 4, lane);
    }
    SEAM(0);

    if (IN(1)) {
        pg8::Gemm g{XN, Win_t, T, INCOLS, D};
        pg8::ProjOrder S; S.so.init(T, INCOLS, F.G, (int)blockIdx.x);
        pg8::EpiProj E{PROJ, GATES, KV, attn_body::C2};
        pg8::gemm_phase<pg8::EpiProj, pg8::ProjOrder, true, true>(F.lds + RING_OFF, g, S, E);
    }
    SEAM(1);

    if (IN(2)) {
        PHASE_IDS
        typedef attn_body::bf16 abf;
        struct DiffOrder { int vcu, G;
            __device__ __forceinline__ bool next(int i, int& bhm, int& qb) const { bhm = vcu + (i >> 3) * G; if (bhm >= BATCH * 8) return false; const int k = i & 7; qb = (k & 1) ? (k >> 1) : 7 - (k >> 1); return true; } };
        struct MemOrder { int vcu, G;
            __device__ __forceinline__ bool next(int i, int& mu, int& qb) const { mu = vcu + (i >> 2) * G; if (mu >= BATCH * 8) return false; qb = (mu & 1) * 4 + (i & 3); return true; } };
        { const DiffOrder S{F.vcu, F.G}; int bhm, qb;
          for (int i = 0; S.next(i, bhm, qb); ++i) {
            const int b = bhm >> 3, h = (bhm >> 1) & 3, m = bhm & 1; const size_t rb = (size_t)b * SEQ;
            const attn2::bf16* Qu = (const attn2::bf16*)PROJ + (rb + qb * 256) * PROJW + 256 + h * 128 + m * 64;
            const attn2::bf16* Kh = (const attn2::bf16*)PROJ + rb * PROJW + 768 + h * 128 + m * 64;
            const attn2::bf16* Vh = (const attn2::bf16*)PROJ + rb * PROJW + 1280 + h * 128;
            attn2::bf16* Ou = (attn2::bf16*)ATTO + (rb + qb * 256) * D + m * 512 + h * 128;
            asm volatile("" : "+s"(Qu), "+s"(Kh), "+s"(Vh), "+s"(Ou));
            attn2::attn_unit<8, true>(Qu, PROJW, Kh, Vh, PROJW, Ou, D, 4 * (qb + 1), (char*)lds + RING_OFF); } }
        { const MemOrder S{F.vcu, F.G}; int mu, qb;
          for (int i = 0; S.next(i, mu, qb); ++i) {
            const int b = mu >> 3, mh = (mu >> 1) & 3;
            const abf* Qu = (const abf*)PROJ + ((size_t)b * SEQ + qb * 256) * PROJW + 1792 + mh * 64;
            const abf* Kh = (const abf*)KV + (size_t)b * NMEM * 512 + mh * 64;
            const abf* Vh = (const abf*)KV + (size_t)b * NMEM * 512 + 256 + mh * 64;
            abf* Ou = (abf*)BR + ((size_t)b * SEQ + qb * 256) * D + 768 + mh * 64;
            asm volatile("" : "+s"(Qu), "+s"(Kh), "+s"(Vh), "+s"(Ou));
            attn_body::attn_unit<8, false>(Qu, PROJW, Kh, Vh, 512, Ou, D, 4, (char*)lds + RING_OFF); } }
    }
    SEAM(2);

    if (IN(3)) {
        PHASE_IDS
        float lam;
        { const float s1 = wave_sum(lam_q1[lane] * lam_k1[lane]), s2 = wave_sum(lam_q2[lane] * lam_k2[lane]); lam = __expf(s1) - __expf(s2) + 0.2f; }
        const int gi = lane >> 4, w = 2 << gi;
        float sg[8];
#pragma unroll
        for (int i = 0; i < 8; ++i) sg[i] = subln_g[((8 * lane) & 127) + i] * 0.8f;
        for (int t = gw; t < T; t += NGW) {
            const int s = t & (SEQ - 1);
            const GAS v2u* up = (const GAS v2u*)(PROJ + (size_t)t * PROJW) + lane;
            const v2u ut = up[0];
            float a0 = 0.f, a1 = 0.f, a2 = 0.f, a3 = 0.f;
            const int nw = (w < s + 1) ? w : s + 1;
            v2u wq[16];
#pragma unroll
            for (int j = 0; j < 16; ++j) { wq[j] = (v2u){0u, 0u}; if (j < nw) wq[j] = *(const GAS v2u*)((const GAS bf16*)up - (size_t)j * PROJW); }
#pragma unroll
            for (int j = 0; j < 16; ++j) { a0 += bflo(wq[j].x); a1 += bfhi(wq[j].x); a2 += bflo(wq[j].y); a3 += bfhi(wq[j].y); }
            const float inv = 1.f / (float)nw;
            v2u po; po.x = pk2(a0 * inv - bflo(ut.x), a1 * inv - bfhi(ut.x)); po.y = pk2(a2 * inv - bflo(ut.y), a3 * inv - bfhi(ut.y));
            *((GAS v2u*)(BR + (size_t)t * D) + lane) = po;
            const v4u o0 = *((const GAS v4u*)(ATTO + (size_t)t * D) + lane), o1 = *((const GAS v4u*)(ATTO + (size_t)t * D + 512) + lane);
            float xv[8];
            xv[0] = bflo(o0.x) - lam * bflo(o1.x); xv[1] = bfhi(o0.x) - lam * bfhi(o1.x); xv[2] = bflo(o0.y) - lam * bflo(o1.y); xv[3] = bfhi(o0.y) - lam * bfhi(o1.y);
            xv[4] = bflo(o0.z) - lam * bflo(o1.z); xv[5] = bfhi(o0.z) - lam * bfhi(o1.z); xv[6] = bflo(o0.w) - lam * bflo(o1.w); xv[7] = bfhi(o0.w) - lam * bfhi(o1.w);
            float ss = 0.f;
#pragma unroll
            for (int i = 0; i < 8; ++i) ss += xv[i] * xv[i];
            ss += __shfl_xor(ss, 1); ss += __shfl_xor(ss, 2); ss += __shfl_xor(ss, 4); ss += __shfl_xor(ss, 8);
            const float r = 1.f / sqrtf(ss * (1.f / 128.f) + RMS_EPS);
            v4u od; od.x = pk2(xv[0] * r * sg[0], xv[1] * r * sg[1]); od.y = pk2(xv[2] * r * sg[2], xv[3] * r * sg[3]); od.z = pk2(xv[4] * r * sg[4], xv[5] * r * sg[5]); od.w = pk2(xv[6] * r * sg[6], xv[7] * r * sg[7]);
            *((GAS v4u*)(BR + (size_t)t * D + 256) + lane) = od;
        }
    }
    SEAM(3);

    if (IN(4)) {
        pg8::StaticOrder S; S.init(T, D, F.G, (int)blockIdx.x);
        pg8::Gemm g{BR, Pc_t, T, D, D}; pg8::EpiMerge E{GATES, MERGED}; pg8::MidRescale MH{GATES};
        pg8::gemm_phase<pg8::EpiMerge, pg8::StaticOrder, true, true, pg8::MidRescale>(F.lds + RING_OFF, g, S, E, MH);
    }
    SEAM(4);

    if (IN(5)) {
        pg8::Gemm g{MERGED, Wo_t, T, D, D}; pg8::StaticOrder S; S.init(T, D, F.G, (int)blockIdx.x);
        pg8::EpiWo E{x_in, X1};
        pg8::gemm_phase<pg8::EpiWo, pg8::StaticOrder, true, true>(F.lds + RING_OFF, g, S, E);
    }
    SEAM(5);

    if (IN(6)) {
        PHASE_IDS
        LAS v4u* WL = (LAS v4u*)(F.lds + RING_OFF);
        LAS float* SC = (LAS float*)(F.lds + RING_OFF + 81920) + wave * 1024;
        LAS v4u* REC = (LAS v4u*)(F.lds + RING_OFF + 81920 + 32768);
        LAS unsigned* LCNT = (LAS unsigned*)(F.lds + RING_OFF + 81920 + 32768 + 4096);
        LAS unsigned* LBASE = LCNT + 16; LAS float* RIL = (LAS float*)(LCNT + 32);
        for (int idx = tid; idx < 5120; idx += NWAVES * 64) WL[idx] = *((const GAS v4u*)WRF + idx);
        float bg[4], be[16];
#pragma unroll
        for (int i = 0; i < 4; ++i) bg[i] = b_rg[i];
#pragma unroll
        for (int i = 0; i < 16; ++i) be[i] = b_re[i];
        const int r32 = lane & 31, hh = lane >> 5;
        for (int rb0 = F.vcu * 256; rb0 < T; rb0 += F.G * 256) {
            if (tid < 16) LCNT[tid] = 0u;
            __syncthreads();
            const int li = wave * 32 + r32, row = rb0 + li;
            const GAS f32x4* xp = (const GAS f32x4*)(X1 + (size_t)row * D + 16 * hh);
            GAS v4u* hp = (GAS v4u*)(H2 + (size_t)row * D + 16 * hh);
            const LAS v4u* wl = WL + hh * 20 + r32;
            f32x16_t acc = {}; float ss = 0.f;
            f32x4 cur[8];
#pragma unroll
            for (int i = 0; i < 8; ++i) cur[i] = xp[(i >> 2) * 8 + (i & 3)];
#pragma unroll 1
            for (int sp2 = 0; sp2 < 16; ++sp2) {
                f32x4 nxt[8];
                const int spn = (sp2 + 1 < 16) ? sp2 + 1 : sp2;
#pragma unroll
                for (int i = 0; i < 8; ++i) nxt[i] = xp[(2 * spn + (i >> 2)) * 8 + (i & 3)];
#pragma unroll
                for (int u = 0; u < 2; ++u) { const int sp = 2 * sp2 + u;
                    v4u ahi[2], alo[2];
#pragma unroll
                    for (int e = 0; e < 2; ++e) { const f32x4 a = cur[4 * u + 2 * e], b = cur[4 * u + 2 * e + 1];
                        ss += (a.x * a.x + a.y * a.y) + (a.z * a.z + a.w * a.w) + (b.x * b.x + b.y * b.y) + (b.z * b.z + b.w * b.w);
                        v4u h; h.x = cvtpk(a.x, a.y); h.y = cvtpk(a.z, a.w); h.z = cvtpk(b.x, b.y); h.w = cvtpk(b.z, b.w); ahi[e] = h;
                        v4u l; l.x = cvtpk(a.x - bflo(h.x), a.y - bfhi(h.x)); l.y = cvtpk(a.z - bflo(h.y), a.w - bfhi(h.y)); l.z = cvtpk(b.x - bflo(h.z), b.y - bfhi(h.z)); l.w = cvtpk(b.z - bflo(h.w), b.w - bfhi(h.w)); alo[e] = l; }
                    hp[sp * 4] = ahi[0]; hp[sp * 4 + 1] = ahi[1];
#pragma unroll
                    for (int e = 0; e < 2; ++e) { const int st = 2 * sp + e;
                        v4u bh = {0u, 0u, 0u, 0u}, bl = {0u, 0u, 0u, 0u};
                        if (r32 < 20) { bh = wl[(st * 4) * 20]; bl = wl[(st * 4 + 2) * 20]; }
                        acc = __builtin_amdgcn_mfma_f32_32x32x16_bf16(__builtin_bit_cast(bf16x8_t, ahi[e]), __builtin_bit_cast(bf16x8_t, bh), acc, 0, 0, 0);
                        acc = __builtin_amdgcn_mfma_f32_32x32x16_bf16(__builtin_bit_cast(bf16x8_t, alo[e]), __builtin_bit_cast(bf16x8_t, bh), acc, 0, 0, 0);
                        acc = __builtin_amdgcn_mfma_f32_32x32x16_bf16(__builtin_bit_cast(bf16x8_t, ahi[e]), __builtin_bit_cast(bf16x8_t, bl), acc, 0, 0, 0); } }
#pragma unroll
                for (int i = 0; i < 8; ++i) cur[i] = nxt[i];
            }
            ss += __shfl_xor(ss, 32);
            const float rinv = 1.f / sqrtf(ss * (1.f / D) + RMS_EPS);
#pragma unroll
            for (int r = 0; r < 16; ++r) SC[((r & 3) + 8 * (r >> 2) + 4 * hh) * 32 + r32] = acc[r];
            LDS_WAIT();
            if (lane < 32) {
                float lg[20];
#pragma unroll
                for (int q4 = 0; q4 < 5; ++q4) { const f32x4 t4 = *(const LAS f32x4*)(SC + lane * 32 + 4 * q4); lg[4 * q4] = t4.x * rinv; lg[4 * q4 + 1] = t4.y * rinv; lg[4 * q4 + 2] = t4.z * rinv; lg[4 * q4 + 3] = t4.w * rinv; }
                float gl[4];
#pragma unroll
                for (int i = 0; i < 4; ++i) gl[i] = lg[i] + bg[i];
                int gidx = 0; float gmax = gl[0];
#pragma unroll
                for (int i = 1; i < 4; ++i) if (gl[i] > gmax) { gmax = gl[i]; gidx = i; }
                float gsum = 0.f;
#pragma unroll
                for (int i = 0; i < 4; ++i) gsum += __expf(gl[i] - gmax);
                const float gp = 1.f / gsum;
                float el[4];
#pragma unroll
                for (int j = 0; j < 4; ++j) { const float l0 = lg[4 + j] + be[j], l1 = lg[8 + j] + be[4 + j], l2 = lg[12 + j] + be[8 + j], l3 = lg[16 + j] + be[12 + j];
                    el[j] = gidx == 0 ? l0 : gidx == 1 ? l1 : gidx == 2 ? l2 : l3; }
                int i0 = 0; float m0 = el[0];
#pragma unroll
                for (int j = 1; j < 4; ++j) if (el[j] > m0) { m0 = el[j]; i0 = j; }
                int i1 = -1; float m1 = -3.0e38f;
#pragma unroll
                for (int j = 0; j < 4; ++j) if (j != i0 && el[j] > m1) { m1 = el[j]; i1 = j; }
                if (i1 < 0) { i1 = (i0 + 1) & 3; m1 = m0; }
                const float p1 = __expf(m1 - m0);
                const float w0 = gp / (1.f + p1), w1 = gp * p1 / (1.f + p1);
                const unsigned e0 = (unsigned)(gidx * 4 + i0), e1 = (unsigned)(gidx * 4 + i1);
                const unsigned s0 = __hip_atomic_fetch_add(LCNT + e0, 1u, __ATOMIC_RELAXED, __HIP_MEMORY_SCOPE_WORKGROUP), s1 = __hip_atomic_fetch_add(LCNT + e1, 1u, __ATOMIC_RELAXED, __HIP_MEMORY_SCOPE_WORKGROUP);
                v4u rc; rc.x = (e0 << 20) | s0; rc.y = (e1 << 20) | s1; rc.z = __float_as_uint(w0); rc.w = __float_as_uint(w1); REC[li] = rc;
                RINV[row] = rinv; RIL[li] = rinv;
            }
            __syncthreads();
            if (tid < 16) LBASE[tid] = __hip_atomic_fetch_add(F.ctl + CW_CNT + tid, LCNT[tid], __ATOMIC_RELAXED, __HIP_MEMORY_SCOPE_AGENT);
            __syncthreads();
            if (tid < 256) { v4u rc = REC[tid]; rc.x += LBASE[rc.x >> 20]; rc.y += LBASE[rc.y >> 20]; *((GAS v4u*)ROUTE + rb0 + tid) = rc;
                const unsigned i0 = ((rc.x >> 20) << 16) + (rc.x & 0xFFFFFu), i1 = ((rc.y >> 20) << 16) + (rc.y & 0xFFFFFu); const float ri = RIL[tid];
                LIST[i0] = rb0 + tid; LIST[i1] = rb0 + tid; RWE[2 * i0] = ri; RWE[2 * i0 + 1] = __uint_as_float(rc.z); RWE[2 * i1] = ri; RWE[2 * i1 + 1] = __uint_as_float(rc.w); }
            __syncthreads();
        }
    }
    SEAM(6);

    if (IN(7)) {
        PHASE_IDS
        build_tile_tables(F, tid);
        const LAS int* TB = (const LAS int*)(F.lds + LDSX_OFF); const LAS unsigned char* t2e = (const LAS unsigned char*)(F.lds + LDSX_OFF + 128);
        LAS int* TOKL = (LAS int*)(F.lds + LDSX_OFF + 4096);
        const int nunits = TB[NEXP] * 4;
        for (int i = 0; i < 11; ++i) { const int L = i * F.G + F.vcu; if (L >= nunits) break;
            const int pm = L >> 2, e = t2e[pm], lt = pm - TB[e];
            if (tid < 256) { unsigned tok = (unsigned)LIST[(e << 16) + lt * 256 + tid]; tok = tok < (unsigned)T ? tok : (unsigned)(T - 1); TOKL[i * 256 + tid] = (int)tok; } }
        __syncthreads();
        pg8::Gemm g{H2, Wgu_t, T, NEXP * D, D};
        pg8::MoeOrder S{t2e, nunits, F.G, F.vcu};
        pg8::EpiGateUp E{HID, RWE, TB};
        pg8::gemm_phase<pg8::EpiGateUp, pg8::MoeOrder, true, true, pg8::NoMid, true>(F.lds + RING_OFF, g, S, E, pg8::NoMid(), TOKL);
    }
    SEAM(7);

    if (IN(8)) {
        PHASE_IDS
        build_tile_tables(F, tid);
        const LAS int* TB = (const LAS int*)(F.lds + LDSX_OFF);
        pg8::Gemm g{HID, Wd_t, MAXROWS, NEXP * D, EH};
        pg8::MoeOrder S{(const LAS unsigned char*)(F.lds + LDSX_OFF + 128), TB[NEXP] * 4, F.G, F.vcu};
        pg8::EpiDown E{Y};
        pg8::gemm_phase<pg8::EpiDown, pg8::MoeOrder, true, true>(F.lds + RING_OFF, g, S, E);
    }
    SEAM(8);

    if (IN(9)) {
        PHASE_IDS
        build_tile_tables(F, tid);
        const LAS int* TB = (const LAS int*)(F.lds + LDSX_OFF);
        for (int t = gw; t < T; t += NGW) {
            const v4u rc = *((const GAS v4u*)ROUTE + t);
            const size_t r0 = (size_t)TB[rc.x >> 20] * 256 + (rc.x & 0xFFFFFu), r1 = (size_t)TB[rc.y >> 20] * 256 + (rc.y & 0xFFFFFu);
            GAS f32x4* xr = (GAS f32x4*)(X1 + (size_t)t * D) + lane; const GAS f32x4* gr = (const GAS f32x4*)final_g + lane;
            const GAS v2u* y0 = (const GAS v2u*)(Y + r0 * D) + lane; const GAS v2u* y1 = (const GAS v2u*)(Y + r1 * D) + lane;
            f32x4 v[4]; float s = 0.f;
#pragma unroll
            for (int j = 0; j < 4; ++j) { v[j] = xr[64 * j]; const v2u a = y0[64 * j], b = y1[64 * j];
                v[j].x += bflo(a.x) + bflo(b.x); v[j].y += bfhi(a.x) + bfhi(b.x); v[j].z += bflo(a.y) + bflo(b.y); v[j].w += bfhi(a.y) + bfhi(b.y);
                s += (v[j].x * v[j].x + v[j].y * v[j].y) + (v[j].z * v[j].z + v[j].w * v[j].w); }
            const float r = 1.f / sqrtf(wave_sum(s) * (1.f / D) + RMS_EPS);
#pragma unroll
            for (int j = 0; j < 4; ++j) { f32x4 o = v[j] * r * gr[64 * j];
                if (PROBE_B >= 0 && blockIdx.x == 0 && (t / NGW) < 8) {
                    const unsigned long long* ts = (const unsigned long long*)(F.ctl + CW_TS); const float amp = sqrtf((float)((ts[PROBE_B2] - ts[PROBE_B]) / 100) * 1e-3f);
                    o.x += amp; o.y += amp; o.z += amp; o.w += amp; }
                xr[64 * j] = o; }
        }
        STAMP(10);
        if (PROBE_A >= 0 && blockIdx.x == 0 && threadIdx.x == 0) {
            const unsigned long long* ts = (const unsigned long long*)(F.ctl + CW_TS);
            X1[0] += 4.f + (float)((ts[PROBE_A2] - ts[PROBE_A]) / 100) * 0.01f; }
    }
#undef IN
#undef SEAM
#undef STAMP
#undef PHASE_IDS
#undef x_in
#undef mem_in
#undef norm_mix_g
#undef w_in
#undef pool_w
#undef pool_scale
#undef lam_q1
#undef lam_k1
#undef lam_q2
#undef lam_k2
#undef subln_g
#undef norm_mem_g
#undef w_mem_kv
#undef p_pool
#undef p_diff
#undef p_mem
#undef w_o
#undef norm_ffn_g
#undef w_rg
#undef b_rg
#undef w_re
#undef b_re
#undef w_eg
#undef w_eu
#undef w_ed
#undef final_g
#undef Win_t
#undef Pc_t
#undef Wo_t
#undef Wgu_t
#undef Wd_t
#undef KV
#undef XN
#undef BR
#undef H2
#undef PROJ
#undef MERGED
#undef HID
#undef ATTO
#undef GATES
#undef Y
#undef ROUTE
#undef RWE
#undef LIST
#undef WRF
#undef RINV
#undef X1
}

extern "C" void kernel_launch(void* const* d_in, const int* in_sizes, int n_in, void* d_out, int out_size, void* d_ws, size_t ws_size, hipStream_t stream) {
    static int grid = 0;
    if (grid == 0) {
        if (n_in != 26 || in_sizes[0] != T * D || out_size != T * D || ws_size < WS_END) { fprintf(stderr, "kernel_launch: unexpected problem: n_in %d in0 %d out %d ws %zu (need %zu)\n", n_in, n_in > 0 ? in_sizes[0] : -1, out_size, ws_size, (size_t)WS_END); grid = -1; return; }
        int dev = 0, cus = 0, per_cu = 0;
        if (hipGetDevice(&dev) != hipSuccess || hipDeviceGetAttribute(&cus, hipDeviceAttributeMultiprocessorCount, dev) != hipSuccess) { fprintf(stderr, "kernel_launch: device query failed\n"); grid = -1; return; }
        if (hipFuncSetAttribute((const void*)hybrid_fwd, hipFuncAttributeMaxDynamicSharedMemorySize, LDS_BYTES) != hipSuccess) { fprintf(stderr, "kernel_launch: hipFuncSetAttribute failed\n"); grid = -1; return; }
        if (hipOccupancyMaxActiveBlocksPerMultiprocessor(&per_cu, (const void*)hybrid_fwd, NWAVES * 64, LDS_BYTES) != hipSuccess || per_cu < 1) { fprintf(stderr, "kernel_launch: occupancy query says %d blocks per CU\n", per_cu); grid = -1; return; }
        (void)hipGetLastError();
        grid = cus;
        if (grid > 256) grid = 256;
    }
    if (grid < 0) return;
    if (hipMemsetAsync((char*)d_ws + WS_CTL, 0, CTL_ZERO_BYTES, stream) != hipSuccess) { fprintf(stderr, "kernel_launch: memset failed\n"); return; }
    Args a{};
    for (int i = 0; i < 26; ++i) a.in[i] = (const float*)d_in[i];
    a.out = (float*)d_out; a.ws = (unsigned char*)d_ws;
#if MK_N_LAUNCHES == 1
    a.ph_lo = 0; a.ph_hi = NPH;
    void* kargs[] = {&a};
    hipError_t e = hipLaunchCooperativeKernel((const void*)hybrid_fwd, dim3(grid), dim3(NWAVES * 64), kargs, LDS_BYTES, stream);
    if (e != hipSuccess) fprintf(stderr, "kernel_launch: cooperative launch failed: %s (grid %d)\n", hipGetErrorString(e), grid);
#else
    for (int p = 0; p < NPH; ++p) { a.ph_lo = p; a.ph_hi = p + 1;
        hipLaunchKernelGGL(hybrid_fwd, dim3(grid), dim3(NWAVES * 64), LDS_BYTES, stream, a);
        const hipError_t le = hipPeekAtLastError(); if (le != hipSuccess) { fprintf(stderr, "kernel_launch: launch %d failed: %s\n", p, hipGetErrorName(le)); break; } }
#endif
}
```

```cpp
#include <hip/hip_runtime.h>
#include <hip/hip_cooperative_groups.h>
#include <cstdio>
#include <cstdint>
namespace cg = cooperative_groups;
namespace pg8 {
#define PG8_LAS __attribute__((address_space(3)))
typedef unsigned short bf16_t;
typedef short bf16x8 __attribute__((ext_vector_type(8)));
typedef float f32x4 __attribute__((ext_vector_type(4)));
typedef unsigned u32x4 __attribute__((ext_vector_type(4)));
constexpr int BM = 256, BK = 64, HALF = 128, HTB = HALF * BK * 2  , STAGE_BYTES = 8 * HTB, NXCD = 8, WGM = 8;

__host__ __device__ __forceinline__ int lds_byte(int r, int c) { const int st = (r >> 4) * 2 + (c >> 5), rr = r & 15, cc = c & 31, ob = rr * 64 + cc * 2; return st * 1024 + (ob ^ (((ob >> 9) & 1) << 5)); }
__host__ __device__ __forceinline__ void stage_rc(int b, int& R, int& C) { const int st = b / 1024, sb = b % 1024, swz = sb ^ (((sb >> 9) & 1) << 5); R = (st >> 1) * 16 + swz / 64; C = (st & 1) * 32 + (swz % 64) / 2; }
__host__ __device__ __forceinline__ int perm32(int rho) { const int n = rho >> 4, i = rho & 15; return 8 * (i >> 2) + 4 * n + (i & 3); }

struct Unit { int pm, pn; };
struct Gemm { const bf16_t* A; const bf16_t* Bt; int M, N, K; };

struct StaticOrder {
    int nM, nN, nwg, G, c;
    __host__ __device__ void init(int M, int N, int G_, int c_) { nM = M / BM; nN = N / BM; nwg = nM * nN; G = G_; c = c_; }
    __host__ __device__ bool next(int i, Unit& u) const {
        const long L = (long)i * G + c; if (L >= nwg) return false;
        int wgid = (int)L; { const int q = nwg / NXCD, r = nwg % NXCD, xcd = wgid % NXCD, off = wgid / NXCD; wgid = (xcd < r ? xcd * (q + 1) : r * (q + 1) + (xcd - r) * q) + off; }
        const int nig = WGM * nN, gid = wgid / nig, fm = gid * WGM, gsz = (nM - fm) < WGM ? (nM - fm) : WGM;
        u.pm = fm + ((wgid % nig) % gsz); u.pn = (wgid % nig) / gsz; return true;
    }
    __device__ __forceinline__ void a_ready(const Unit&) const {}
    __device__ __forceinline__ void done(const Unit&) const {}
};

__device__ __forceinline__ unsigned cvt_pk_bf16(float lo, float hi) { unsigned r; asm volatile("v_cvt_pk_bf16_f32 %0, %1, %2" : "=v"(r) : "v"(lo), "v"(hi)); return r; }
typedef unsigned u32x2 __attribute__((ext_vector_type(2)));
__device__ __forceinline__ float bf_lo(unsigned w) { return __uint_as_float(w << 16); }
__device__ __forceinline__ float bf_hi(unsigned w) { return __uint_as_float(w & 0xffff0000u); }
__device__ __forceinline__ float sigmoid_f(float x) { return __builtin_amdgcn_rcpf(1.0f + __builtin_amdgcn_exp2f(-1.4426950408889634f * x)); }
__device__ __forceinline__ u32x4 pack8(const f32x4 a, const f32x4 b) { u32x4 w; w.x = cvt_pk_bf16(a[0], a[1]); w.y = cvt_pk_bf16(a[2], a[3]); w.z = cvt_pk_bf16(b[0], b[1]); w.w = cvt_pk_bf16(b[2], b[3]); return w; }

struct ProjOrder {
    StaticOrder so;
    __device__ __forceinline__ bool next(int i, Unit& u) const {
        const long L = (long)i * so.G + so.c;
        if (L < so.nwg) return so.next(i, u);
        const int x = (int)(L - so.nwg); if (x >= 64) return false;
        u.pm = 256 + (x >> 1); u.pn = 20 + (x & 1); return true;
    }
    __device__ __forceinline__ void a_ready(const Unit&) const {}
    __device__ __forceinline__ void done(const Unit&) const {}
};
struct MoeOrder {
    const PG8_LAS unsigned char* t2e; int nunits, G, c;
    __device__ __forceinline__ bool next(int i, Unit& u) const {
        const int L = i * G + c; if (L >= nunits) return false;
        const int pm = L >> 2; u.pm = pm; u.pn = (int)t2e[pm] * 4 + (L & 3); return true;
    }
    __device__ __forceinline__ void a_ready(const Unit&) const {}
    __device__ __forceinline__ void done(const Unit&) const {}
};

struct EpiProj {
    static constexpr bool PERM = true, AFTER_DRAIN = false;
    bf16_t* PROJ; bf16_t* GATES; bf16_t* KV; float qscale;
    __device__ __forceinline__ void operator()(const f32x4 (&acc)[2][2][4][2], const Unit& u, int wr, int wc, int fr, int fq) const {
        bf16_t* base; int ldc, colt, mode = 0; float sc = 1.f; int rowt = u.pm * BM;
        if (u.pm >= 256) { base = KV; ldc = 512; colt = (u.pn - 20) * BM; rowt -= 65536; }
        else if (u.pn < 8) { base = PROJ; ldc = 2048; colt = u.pn * BM; if (u.pn == 1 || u.pn == 2 || u.pn == 7) sc = qscale; }
        else { base = GATES; ldc = 3072; colt = (u.pn - 8) * BM; mode = 1; }
        const int row0 = rowt + wr * 64 + fr, col0 = colt + wc * 32 + 8 * fq;
#pragma unroll
        for (int ai = 0; ai < 2; ++ai)
#pragma unroll
            for (int m = 0; m < 4; ++m) { bf16_t* rowp = base + (size_t)(row0 + ai * HALF + m * 16) * ldc + col0;
#pragma unroll
                for (int bj = 0; bj < 2; ++bj) { f32x4 v0 = acc[ai][bj][m][0], v1 = acc[ai][bj][m][1];
                    if (mode) {
#pragma unroll
                        for (int i = 0; i < 4; ++i) { v0[i] = sigmoid_f(v0[i]); v1[i] = sigmoid_f(v1[i]); } }
                    else { v0 = v0 * sc; v1 = v1 * sc; }
                    *(u32x4*)(rowp + bj * HALF) = pack8(v0, v1); } }
    }
};
__device__ __forceinline__ float gclamp(float g) { return __builtin_fmaxf(g, 1e-18f); }
struct MidRescale {
    static constexpr bool ON = true; static constexpr int T0 = 4, T1 = 12;
    const bf16_t* GATES;
    __device__ __forceinline__ void operator()(f32x4 (&acc)[2][2][4][2], const Unit& u, int t, int wr, int wc, int fr, int fq) const {
        int fr_ = fr; asm volatile("" : "+v"(fr_));
        const int row0 = u.pm * BM + wr * 64 + fr_, col0 = u.pn * BM + wc * 32 + 8 * fq; const int gprev = (t == T0) ? 0 : 1024;
        const unsigned off0 = ((unsigned)row0 * 3072u + (unsigned)(gprev + col0)) * 2u;
#pragma unroll
        for (int ai = 0; ai < 2; ++ai) {
            u32x4 ga[4][2], gb[4][2];
#pragma unroll
            for (int m = 0; m < 4; ++m) { const char* gp = (const char*)GATES + (off0 + (unsigned)((ai * HALF + m * 16) * 3072 * 2));
#pragma unroll
                for (int bj = 0; bj < 2; ++bj) { ga[m][bj] = *(const u32x4*)(gp + bj * HALF * 2); gb[m][bj] = *(const u32x4*)(gp + 2048 + bj * HALF * 2); } }
#pragma unroll
            for (int m = 0; m < 4; ++m)
#pragma unroll
                for (int bj = 0; bj < 2; ++bj) { const u32x4 a = ga[m][bj], b = gb[m][bj];
                    f32x4 r0, r1;
                    r0[0] = bf_lo(a.x) * __builtin_amdgcn_rcpf(gclamp(bf_lo(b.x))); r0[1] = bf_hi(a.x) * __builtin_amdgcn_rcpf(gclamp(bf_hi(b.x)));
                    r0[2] = bf_lo(a.y) * __builtin_amdgcn_rcpf(gclamp(bf_lo(b.y))); r0[3] = bf_hi(a.y) * __builtin_amdgcn_rcpf(gclamp(bf_hi(b.y)));
                    r1[0] = bf_lo(a.z) * __builtin_amdgcn_rcpf(gclamp(bf_lo(b.z))); r1[1] = bf_hi(a.z) * __builtin_amdgcn_rcpf(gclamp(bf_hi(b.z)));
                    r1[2] = bf_lo(a.w) * __builtin_amdgcn_rcpf(gclamp(bf_lo(b.w))); r1[3] = bf_hi(a.w) * __builtin_amdgcn_rcpf(gclamp(bf_hi(b.w)));
                    acc[ai][bj][m][0] = acc[ai][bj][m][0] * r0; acc[ai][bj][m][1] = acc[ai][bj][m][1] * r1; }
            asm volatile("" ::: "memory"); }
    }
};
struct EpiMerge {
    static constexpr bool PERM = true, AFTER_DRAIN = false;
    const bf16_t* GATES; bf16_t* MERGED;
    __device__ __forceinline__ void operator()(const f32x4 (&acc)[2][2][4][2], const Unit& u, int wr, int wc, int fr, int fq) const {
        const int row0 = u.pm * BM + wr * 64 + fr, col0 = u.pn * BM + wc * 32 + 8 * fq;
        const unsigned off0 = ((unsigned)row0 * 3072u + (unsigned)(2048 + col0)) * 2u;
        u32x4 gg[2][4][2];
#pragma unroll
        for (int ai = 0; ai < 2; ++ai)
#pragma unroll
            for (int m = 0; m < 4; ++m)
#pragma unroll
                for (int bj = 0; bj < 2; ++bj) gg[ai][m][bj] = *(const u32x4*)((const char*)GATES + (off0 + (unsigned)((ai * HALF + m * 16) * 3072 * 2)) + bj * HALF * 2);
#pragma unroll
        for (int ai = 0; ai < 2; ++ai)
#pragma unroll
            for (int m = 0; m < 4; ++m) { const size_t r = (size_t)(row0 + ai * HALF + m * 16);
#pragma unroll
                for (int bj = 0; bj < 2; ++bj) { const int c = col0 + bj * HALF; const u32x4 g = gg[ai][m][bj];
                    f32x4 v0 = acc[ai][bj][m][0], v1 = acc[ai][bj][m][1];
                    v0[0] *= gclamp(bf_lo(g.x)); v0[1] *= gclamp(bf_hi(g.x)); v0[2] *= gclamp(bf_lo(g.y)); v0[3] *= gclamp(bf_hi(g.y));
                    v1[0] *= gclamp(bf_lo(g.z)); v1[1] *= gclamp(bf_hi(g.z)); v1[2] *= gclamp(bf_lo(g.w)); v1[3] *= gclamp(bf_hi(g.w));
                    *(u32x4*)(MERGED + r * 1024 + c) = pack8(v0, v1); } }
    }
};
struct EpiWo {
    static constexpr bool PERM = false, AFTER_DRAIN = false;
    const float* X; float* X1;
    __device__ __forceinline__ void operator()(const f32x4 (&acc)[2][2][4][2], const Unit& u, int wr, int wc, int fr, int fq) const {
        const int row0 = u.pm * BM + wr * 64 + fr, col0 = u.pn * BM + wc * 32 + 4 * fq;
#pragma unroll
        for (int ai = 0; ai < 2; ++ai)
#pragma unroll
            for (int m = 0; m < 4; ++m) { const size_t off = (size_t)(row0 + ai * HALF + m * 16) * 1024 + col0;
#pragma unroll
                for (int bj = 0; bj < 2; ++bj)
#pragma unroll
                    for (int n = 0; n < 2; ++n) { const size_t o = off + bj * HALF + n * 16; *(f32x4*)(X1 + o) = *(const f32x4*)(X + o) + acc[ai][bj][m][n]; } }
    }
};
struct EpiGateUp {
    static constexpr bool PERM = true, AFTER_DRAIN = false;
    bf16_t* HID; const float* RWE; const PG8_LAS int* TB;
    __device__ __forceinline__ void operator()(const f32x4 (&acc)[2][2][4][2], const Unit& u, int wr, int wc, int fr, int fq) const {
        const int row0 = u.pm * BM + wr * 64 + fr, colh = (u.pn & 3) * 128 + wc * 32 + 8 * fq;
#pragma unroll
        for (int ai = 0; ai < 2; ++ai)
#pragma unroll
            for (int m = 0; m < 4; ++m) { const size_t r = (size_t)(row0 + ai * HALF + m * 16); const size_t es = (size_t)((u.pn >> 2) << 16) + (r - (size_t)TB[u.pn >> 2] * 256); const float ri = RWE[2 * es], w = RWE[2 * es + 1];
                f32x4 h0, h1;
#pragma unroll
                for (int i = 0; i < 4; ++i) { const float g0 = acc[ai][0][m][0][i] * ri, g1 = acc[ai][0][m][1][i] * ri; const float wr_ = w * ri;
                    h0[i] = g0 * sigmoid_f(g0) * acc[ai][1][m][0][i] * wr_; h1[i] = g1 * sigmoid_f(g1) * acc[ai][1][m][1][i] * wr_; }
                *(u32x4*)(HID + r * 512 + colh) = pack8(h0, h1); }
    }
};
struct EpiDown {
    static constexpr bool PERM = true, AFTER_DRAIN = false;
    bf16_t* Y;
    __device__ __forceinline__ void operator()(const f32x4 (&acc)[2][2][4][2], const Unit& u, int wr, int wc, int fr, int fq) const {
        const int row0 = u.pm * BM + wr * 64 + fr, col0 = (u.pn & 3) * BM + wc * 32 + 8 * fq;
#pragma unroll
        for (int ai = 0; ai < 2; ++ai)
#pragma unroll
            for (int m = 0; m < 4; ++m) { bf16_t* rowp = Y + (size_t)(row0 + ai * HALF + m * 16) * 1024 + col0;
#pragma unroll
                for (int bj = 0; bj < 2; ++bj) *(u32x4*)(rowp + bj * HALF) = pack8(acc[ai][bj][m][0], acc[ai][bj][m][1]); }
    }
};

struct NoMid { static constexpr bool ON = false; static constexpr int T0 = -1, T1 = -1; __device__ __forceinline__ void operator()(f32x4 (&)[2][2][4][2], const Unit&, int, int, int, int, int) const {} };
template <class Epi, class Sched, bool ALIGN_EPI = false, bool SP2 = false, class Mid = NoMid, bool GATHER = false>
__device__ __forceinline__ void gemm_phase(PG8_LAS unsigned char* lds, const Gemm g, const Sched& S, const Epi& E, const Mid& MH = Mid(), const PG8_LAS int* tokl = nullptr) {
    int tid_ = threadIdx.x; asm volatile("" : "+v"(tid_));
    const int tid = tid_, wid = __builtin_amdgcn_readfirstlane(tid >> 6), lane = tid & 63, wr = wid >> 2, wc = wid & 3, fr = lane & 15, fq = lane >> 4;
    static_assert(!GATHER || SP2, "GATHER is written for the SP2 loop");
    const int K = g.K, nt = K / BK;
    unsigned voffA[2], voffB[2];
#pragma unroll
    for (int i = 0; i < 2; ++i) { int R, C; stage_rc(tid * 16 + i * 8192, R, C); const int Rb = Epi::PERM ? ((R & ~31) + perm32(R & 31)) : R;
        voffA[i] = (unsigned)(R * K + C) * 2u; voffB[i] = (unsigned)(Rb * K + C) * 2u; }
    const size_t kstep = (size_t)(BK * 2);
    const size_t hstep = (size_t)HALF * K * 2;
    const size_t tstep = 2 * hstep;
    const unsigned ldsw = (unsigned)wid * 1024u;
    const int aoff = lds_byte(wr * 64 + fr, fq * 8), boff = lds_byte(wc * 32 + fr, fq * 8);
    unsigned vGc[2][2], vGn[2][2]; int gR[2], gC[2];
    if constexpr (GATHER) {
#pragma unroll
        for (int i = 0; i < 2; ++i) { stage_rc(tid * 16 + i * 8192, gR[i], gC[i]); }
    }
#define PG8_GOFFS(dst, u_) do { if constexpr (GATHER) { _Pragma("unroll") for (int hh_ = 0; hh_ < 2; ++hh_) _Pragma("unroll") for (int i_ = 0; i_ < 2; ++i_) \
        dst[hh_][i_] = ((unsigned)tokl[(u_) * 256 + hh_ * HALF + gR[i_]] * (unsigned)K + (unsigned)gC[i_]) * 2u; } } while (0)
#define PG8_STGA(bufoff, base, hh, nx) do { if constexpr (GATHER) { _Pragma("unroll") for (int _i = 0; _i < 2; ++_i) \
        __builtin_amdgcn_global_load_lds((const unsigned*)((const char*)(base) + ((nx) ? vGn[hh][_i] : vGc[hh][_i])), (PG8_LAS unsigned*)(lds + (bufoff) + ldsw + _i * 8192), 16, 0, 0); } \
      else { PG8_STAGE(bufoff, (base) + (hh) * hstep, voffA); } } while (0)
#define PG8_SA(b, h) (((b) * 2 + (h)) * HTB)
#define PG8_SB(b, h) ((4 + (b) * 2 + (h)) * HTB)
#define PG8_STAGE(bufoff, gbase, voff) do { _Pragma("unroll") for (int _i = 0; _i < 2; ++_i) \
        __builtin_amdgcn_global_load_lds((const unsigned*)((const char*)(gbase) + (voff)[_i]), (PG8_LAS unsigned*)(lds + (bufoff) + ldsw + _i * 8192), 16, 0, 0); } while (0)
#define PG8_LDA(dst, b, h) do { _Pragma("unroll") for (int m = 0; m < 4; ++m) _Pragma("unroll") for (int k = 0; k < 2; ++k) dst[m][k] = *(const PG8_LAS bf16x8*)(lds + PG8_SA(b, h) + aoff + m * 2048 + k * 1024); } while (0)
#define PG8_LDB(dst, b, h) do { _Pragma("unroll") for (int n = 0; n < 2; ++n) _Pragma("unroll") for (int k = 0; k < 2; ++k) dst[n][k] = *(const PG8_LAS bf16x8*)(lds + PG8_SB(b, h) + boff + n * 2048 + k * 1024); } while (0)
#define PG8_MMA(ai, bj, At, Bt) do { __builtin_amdgcn_s_setprio(1); _Pragma("unroll") for (int m = 0; m < 4; ++m) _Pragma("unroll") for (int n = 0; n < 2; ++n) _Pragma("unroll") for (int k = 0; k < 2; ++k) \
        acc[ai][bj][m][n] = __builtin_amdgcn_mfma_f32_16x16x32_bf16(Bt[n][k], At[m][k], acc[ai][bj][m][n], 0, 0, 0); __builtin_amdgcn_s_setprio(0); } while (0)
#define PG8_WAIT_V(n) asm volatile("s_waitcnt vmcnt(" #n ")" ::: "memory")
#define PG8_WAIT_L(n) asm volatile("s_waitcnt lgkmcnt(" #n ")" ::: "memory")
#define PG8_BAR __builtin_amdgcn_s_barrier()
#define PG8_SCHED __builtin_amdgcn_sched_barrier(0)
    Unit cur, nxt; int ui = 0;
    if (!S.next(0, cur)) return;
    f32x4 acc[2][2][4][2];
#pragma unroll
    for (int a = 0; a < 2; ++a)
#pragma unroll
        for (int b = 0; b < 2; ++b)
#pragma unroll
            for (int m = 0; m < 4; ++m)
#pragma unroll
                for (int n = 0; n < 2; ++n) acc[a][b][m][n] = (f32x4){0.f, 0.f, 0.f, 0.f};
    bf16x8 At[4][2], B0[2][2], B1[2][2];
    const char* cA = (const char*)g.A + (GATHER ? (size_t)0 : (size_t)cur.pm * tstep); const char* cB = (const char*)g.Bt + (size_t)cur.pn * tstep;
    PG8_GOFFS(vGc, 0); PG8_GOFFS(vGn, 0);
    S.a_ready(cur);
    if constexpr (SP2) {
        PG8_STAGE(PG8_SB(0, 0), cB, voffB); PG8_STAGE(PG8_SB(0, 1), cB + hstep, voffB); PG8_STGA(PG8_SA(0, 0), cA, 0, false); PG8_STGA(PG8_SA(0, 1), cA, 1, false);
        if (wr == 1) PG8_BAR;
        PG8_WAIT_V(2); PG8_BAR;
        PG8_STAGE(PG8_SB(1, 0), cB + kstep, voffB); PG8_STGA(PG8_SA(1, 0), cA + kstep, 0, false); PG8_STAGE(PG8_SB(1, 1), cB + hstep + kstep, voffB);
        PG8_WAIT_V(6); PG8_BAR;
    } else {
        PG8_STAGE(PG8_SB(0, 0), cB, voffB); PG8_STAGE(PG8_SA(0, 0), cA, voffA); PG8_STAGE(PG8_SB(0, 1), cB + hstep, voffB); PG8_STAGE(PG8_SA(0, 1), cA + hstep, voffA);
        if (wr == 1) PG8_BAR;
        PG8_WAIT_V(4); PG8_BAR;
        PG8_STAGE(PG8_SB(1, 0), cB + kstep, voffB); PG8_STAGE(PG8_SA(1, 0), cA + kstep, voffA); PG8_STAGE(PG8_SB(1, 1), cB + hstep + kstep, voffB);
        PG8_WAIT_V(6); PG8_BAR;
    }
    for (;;) {
        const bool has_next = S.next(ui + 1, nxt);
        if (has_next) PG8_GOFFS(vGn, ui + 1);
        const char* nA = (has_next && !GATHER) ? (const char*)g.A + (size_t)nxt.pm * tstep : cA; const char* nB = has_next ? (const char*)g.Bt + (size_t)nxt.pn * tstep : cB;
        for (int t = 0; t < nt; t += 2) {
            if constexpr (Mid::ON) { if (t == Mid::T0 || t == Mid::T1) MH(acc, cur, t, wr, wc, fr, fq); }
            const bool last = (t == nt - 2);
            const char* a1 = cA + (size_t)(t + 1) * kstep;
            const char* a2 = last ? nA : cA + (size_t)(t + 2) * kstep; const char* b2 = last ? nB : cB + (size_t)(t + 2) * kstep;
            const char* a3 = a2 + kstep; const char* b3 = b2 + kstep;
            if (last && has_next) S.a_ready(nxt);
            if constexpr (SP2) {
            PG8_LDB(B0, 0, 0); PG8_LDB(B1, 0, 1); PG8_SCHED; PG8_LDA(At, 0, 0); PG8_STGA(PG8_SA(1, 1), a1, 1, false);
            PG8_WAIT_V(8); PG8_WAIT_L(0); PG8_BAR; PG8_MMA(0, 0, At, B0); PG8_MMA(0, 1, At, B1); PG8_BAR; PG8_SCHED;
            PG8_LDA(At, 0, 1); PG8_STAGE(PG8_SB(0, 0), b2, voffB); PG8_STAGE(PG8_SB(0, 1), b2 + hstep, voffB); PG8_STGA(PG8_SA(0, 0), a2, 0, last && has_next);
            PG8_WAIT_V(8); PG8_WAIT_L(0); PG8_BAR; PG8_MMA(1, 0, At, B0); PG8_MMA(1, 1, At, B1); PG8_BAR; PG8_SCHED;
            PG8_LDB(B0, 1, 0); PG8_LDB(B1, 1, 1); PG8_SCHED; PG8_LDA(At, 1, 0); PG8_STGA(PG8_SA(0, 1), a2, 1, last && has_next);
            PG8_WAIT_V(8); PG8_WAIT_L(0); PG8_BAR; PG8_MMA(0, 0, At, B0); PG8_MMA(0, 1, At, B1); PG8_BAR; PG8_SCHED;
            PG8_LDA(At, 1, 1); PG8_STAGE(PG8_SB(1, 0), b3, voffB); PG8_STAGE(PG8_SB(1, 1), b3 + hstep, voffB); PG8_STGA(PG8_SA(1, 0), a3, 0, last && has_next);
            PG8_WAIT_V(8); PG8_WAIT_L(0); PG8_BAR; PG8_MMA(1, 0, At, B0); PG8_MMA(1, 1, At, B1); PG8_BAR; PG8_SCHED;
            } else {
            PG8_LDB(B0, 0, 0); PG8_SCHED; PG8_LDA(At, 0, 0); PG8_STAGE(PG8_SA(1, 1), a1 + hstep, voffA);
            PG8_WAIT_L(8); PG8_BAR; PG8_WAIT_L(0); PG8_MMA(0, 0, At, B0); PG8_BAR; PG8_SCHED;
            PG8_LDB(B1, 0, 1); PG8_STAGE(PG8_SB(0, 0), b2, voffB);
            PG8_BAR; PG8_WAIT_L(0); PG8_MMA(0, 1, At, B1); PG8_BAR;
            PG8_LDA(At, 0, 1); PG8_STAGE(PG8_SA(0, 0), a2, voffA);
            PG8_BAR; PG8_WAIT_L(0); PG8_MMA(1, 0, At, B0); PG8_BAR; PG8_SCHED;
            PG8_STAGE(PG8_SB(0, 1), b2 + hstep, voffB);
            PG8_WAIT_V(6); PG8_BAR; PG8_MMA(1, 1, At, B1); PG8_BAR;
            PG8_LDB(B0, 1, 0); PG8_SCHED; PG8_LDA(At, 1, 0); PG8_STAGE(PG8_SA(0, 1), a2 + hstep, voffA);
            PG8_WAIT_L(8); PG8_BAR; PG8_WAIT_L(0); PG8_MMA(0, 0, At, B0); PG8_BAR; PG8_SCHED;
            PG8_LDB(B1, 1, 1); PG8_STAGE(PG8_SB(1, 0), b3, voffB);
            PG8_BAR; PG8_WAIT_L(0); PG8_MMA(0, 1, At, B1); PG8_BAR;
            PG8_LDA(At, 1, 1); PG8_STAGE(PG8_SA(1, 0), a3, voffA);
            PG8_BAR; PG8_WAIT_L(0); PG8_MMA(1, 0, At, B0); PG8_BAR; PG8_SCHED;
            PG8_STAGE(PG8_SB(1, 1), b3 + hstep, voffB);
            PG8_WAIT_V(6); PG8_BAR; PG8_MMA(1, 1, At, B1); PG8_BAR;
            }
        }
        if constexpr (ALIGN_EPI) { if (wr == 0) PG8_BAR; }
        if constexpr (!Epi::AFTER_DRAIN) { E(acc, cur, wr, wc, fr, fq); S.done(cur); }
        if (!has_next) break;
#pragma unroll
        for (int a = 0; a < 2; ++a)
#pragma unroll
            for (int b = 0; b < 2; ++b)
#pragma unroll
                for (int m = 0; m < 4; ++m)
#pragma unroll
                    for (int n = 0; n < 2; ++n) acc[a][b][m][n] = (f32x4){0.f, 0.f, 0.f, 0.f};
        cur = nxt; cA = nA; cB = nB; ++ui;
        if constexpr (GATHER) { _Pragma("unroll") for (int hh_ = 0; hh_ < 2; ++hh_) _Pragma("unroll") for (int i_ = 0; i_ < 2; ++i_) vGc[hh_][i_] = vGn[hh_][i_]; }
        if constexpr (ALIGN_EPI) { if (wr == 1) PG8_BAR; }
    }
    PG8_WAIT_V(0);
    if constexpr (!ALIGN_EPI) { if (wr == 0) PG8_BAR; }
    PG8_BAR;
    if constexpr (Epi::AFTER_DRAIN) { E.fused(acc, cur, wr, wc, fr, fq, lds, wid, lane); S.done(cur); }
#undef PG8_SA
#undef PG8_SB
#undef PG8_STAGE
#undef PG8_STGA
#undef PG8_GOFFS
#undef PG8_LDA
#undef PG8_LDB
#undef PG8_MMA
#undef PG8_WAIT_V
#undef PG8_WAIT_L
#undef PG8_BAR
#undef PG8_SCHED
}
}
#include <hip/hip_bf16.h>
#include <cmath>
namespace attn_body {
using bf16=__hip_bfloat16;
using bf16x8=__attribute__((ext_vector_type(8)))short;
using s16x4=__attribute__((ext_vector_type(4)))short;
using f32x16=__attribute__((ext_vector_type(16)))float;
using u32x4=__attribute__((ext_vector_type(4)))unsigned;
constexpr int D=64;
constexpr int NW=8,QBLK=32,QB=QBLK*NW,KVBLK=64;
constexpr int ATTN_UNIT_ROWS=QB;
__device__ __forceinline__ int crow(int r,int hi){return (r&3)+8*(r>>2)+4*hi;}
#define SBAR() __builtin_amdgcn_sched_barrier(0)
__device__ __forceinline__ void cmask(f32x16&p0,f32x16&p1,int jb,int qrel,int hi){
  const float NEG=-INFINITY; int kb=64*jb+4*hi;
  #pragma unroll
  for(int r=0;r<16;++r){int kv=kb+(r&3)+8*(r>>2); if(kv>qrel)p0[r]=NEG; if(kv+32>qrel)p1[r]=NEG;}
}

constexpr int NSLOT=3, SLOTB=8192;
constexpr int LDS_K=0, LDS_V=NSLOT*SLOTB, LDS_WS=2*NSLOT*SLOTB, LDS_OST=LDS_WS+NW*64*4, LDS_BYTES=LDS_OST+NW*4096;
constexpr float C2=0.125f*1.4426950408889634f;
__device__ __forceinline__ void glds16(const void*gsrc,unsigned lds_dst){unsigned keep;
  asm volatile("s_mov_b32 %0, m0\n\ts_mov_b32 m0, %2\n\ts_nop 0\n\tglobal_load_lds_dwordx4 %1, off\n\ts_mov_b32 m0, %0":"=&s"(keep):"v"(gsrc),"s"(lds_dst):"memory");}
__device__ __forceinline__ float max3f(float a,float b,float c){float r;asm("v_max3_f32 %0, %1, %2, %3":"=v"(r):"v"(a),"v"(b),"v"(c));return r;}
__device__ __forceinline__ float max2f(float a,float b){float r;asm("v_max_f32_e32 %0, %1, %2":"=v"(r):"v"(a),"v"(b));return r;}
__device__ __forceinline__ float fadd_s(float a,float b){float r;asm("v_add_f32_e32 %0, %1, %2":"=v"(r):"v"(a),"v"(b));return r;}
__device__ __forceinline__ float fsub_s(float a,float b){float r;asm("v_sub_f32_e32 %0, %1, %2":"=v"(r):"v"(a),"v"(b));return r;}
typedef float f32x2_t __attribute__((ext_vector_type(2))); typedef __bf16 bf16x2_t __attribute__((ext_vector_type(2)));
__device__ __forceinline__ unsigned cvtpk_s(float lo,float hi){f32x2_t v={lo,hi};bf16x2_t b=__builtin_convertvector(v,bf16x2_t);return __builtin_bit_cast(unsigned,b);}
#define WAIT_BAR(N) asm volatile("s_waitcnt vmcnt(" #N ") lgkmcnt(0)\n\ts_barrier":::"memory")

__device__ __forceinline__ void qkt(f32x16&p0,f32x16&p1,const char*Kslot,const bf16x8*qr,const f32x16&negm,int r32,int hi){
  const char*kb=Kslot+hi*1024+r32*16;
  #pragma unroll
  for(int d0=0;d0<4;++d0){
    const bf16x8 b0=*reinterpret_cast<const bf16x8*>(kb+d0*2048);
    const bf16x8 b1=*reinterpret_cast<const bf16x8*>(kb+d0*2048+512);
    if(d0==0){p0=__builtin_amdgcn_mfma_f32_32x32x16_bf16(b0,qr[0],negm,0,0,0);p1=__builtin_amdgcn_mfma_f32_32x32x16_bf16(b1,qr[0],negm,0,0,0);}
    else{p0=__builtin_amdgcn_mfma_f32_32x32x16_bf16(b0,qr[d0],p0,0,0,0);p1=__builtin_amdgcn_mfma_f32_32x32x16_bf16(b1,qr[d0],p1,0,0,0);}}
}
typedef __attribute__((address_space(3))) const char* lds_cptr;
typedef short v4i16_t __attribute__((ext_vector_type(4)));
__device__ __forceinline__ void kload8(bf16x8*kf,lds_cptr kp){
  kf[0]=*(const __attribute__((address_space(3))) bf16x8*)(kp);      kf[1]=*(const __attribute__((address_space(3))) bf16x8*)(kp+512);
  kf[2]=*(const __attribute__((address_space(3))) bf16x8*)(kp+2048); kf[3]=*(const __attribute__((address_space(3))) bf16x8*)(kp+2560);
  kf[4]=*(const __attribute__((address_space(3))) bf16x8*)(kp+4096); kf[5]=*(const __attribute__((address_space(3))) bf16x8*)(kp+4608);
  kf[6]=*(const __attribute__((address_space(3))) bf16x8*)(kp+6144); kf[7]=*(const __attribute__((address_space(3))) bf16x8*)(kp+6656);
}
__device__ __forceinline__ void kload2(bf16x8*kf,lds_cptr kp,int j){ kf[2*j]=*(const __attribute__((address_space(3))) bf16x8*)(kp+j*2048); kf[2*j+1]=*(const __attribute__((address_space(3))) bf16x8*)(kp+j*2048+512); }
__device__ __forceinline__ s16x4 vtr(lds_cptr p){ return __builtin_bit_cast(s16x4,__builtin_amdgcn_ds_read_tr16_b64_v4i16((__attribute__((address_space(3))) v4i16_t*)p)); }
__device__ __forceinline__ float rowmax(const f32x16&p0,const f32x16&p1){
  float a=max3f(p0[0],p0[1],p1[0]),b=max3f(p0[2],p0[3],p1[1]);a=max3f(a,p1[2],p1[3]);
  #pragma unroll
  for(int r=4;r<16;r+=4){a=max3f(a,p0[r],p0[r+1]);b=max3f(b,p0[r+2],p0[r+3]);a=max3f(a,p1[r],p1[r+1]);b=max3f(b,p1[r+2],p1[r+3]);}
  const float m=max2f(a,b);
  auto rr=__builtin_amdgcn_permlane32_swap(__float_as_uint(m),__float_as_uint(m),false,false);
  return max2f(__uint_as_float(rr[0]),__uint_as_float(rr[1]));
}
__device__ __forceinline__ void pv(f32x16*o,int vb,bf16x8 pa0,bf16x8 pa1,bf16x8 pa2,bf16x8 pa3){
  #pragma unroll
  for(int d0=0;d0<2;++d0){s16x4 lo[4],hi[4];
    #pragma unroll
    for(int ks=0;ks<4;++ks){
      asm volatile("ds_read_b64_tr_b16 %0,%1 offset:%c2":"=&v"(lo[ks]):"v"(vb),"i"(d0*4096+ks*1024):"memory");
      asm volatile("ds_read_b64_tr_b16 %0,%1 offset:%c2":"=&v"(hi[ks]):"v"(vb),"i"(d0*4096+ks*1024+512):"memory");}
    asm volatile("s_waitcnt lgkmcnt(0)":::"memory");SBAR();
    #define PK(k) (bf16x8){lo[k][0],lo[k][1],lo[k][2],lo[k][3],hi[k][0],hi[k][1],hi[k][2],hi[k][3]}
    o[d0]=__builtin_amdgcn_mfma_f32_32x32x16_bf16(pa0,PK(0),o[d0],0,0,0);
    o[d0]=__builtin_amdgcn_mfma_f32_32x32x16_bf16(pa1,PK(1),o[d0],0,0,0);
    o[d0]=__builtin_amdgcn_mfma_f32_32x32x16_bf16(pa2,PK(2),o[d0],0,0,0);
    o[d0]=__builtin_amdgcn_mfma_f32_32x32x16_bf16(pa3,PK(3),o[d0],0,0,0);
    #undef PK
  }
}

#ifndef ATTN_STORE16
#define ATTN_STORE16(p,v) (*(u32x4*)(p)=(v))
#endif
template<int THRL,bool CAUSAL> __device__ __forceinline__ void attn_unit(const bf16*Qu,const int pQ,const bf16*__restrict__ Kh,const bf16*__restrict__ Vh,const int pKV,bf16*Ou,const int pO,const int NT,char*shm){
  int tid_=threadIdx.x; asm volatile("":"+v"(tid_));
  const int tid=tid_,lane=tid&63,r32=lane&31,hi=lane>>5; const int wid=__builtin_amdgcn_readfirstlane(tid>>6);
  const bf16*Qw=Qu+(long)(wid*QBLK)*pQ;
  const unsigned lds0=(unsigned)(uintptr_t)shm;
  float*wsf=(float*)(shm+LDS_WS)+wid*64;
  const bf16*ksrc=Kh+(long)lane*pKV+wid*8;
  const bf16*vsrc=Vh+(long)(16*(wid&3)+(lane>>2))*pKV+(wid>>2)*32+(lane&3)*8;
  const unsigned kdst=lds0+LDS_K+wid*1024, vdst=lds0+LDS_V+wid*1024;
  #define DMA_K(t,slot) glds16(ksrc+(long)(t)*KVBLK*pKV,(unsigned)__builtin_amdgcn_readfirstlane(kdst+(slot)))
  #define DMA_V(t,slot) glds16(vsrc+(long)(t)*KVBLK*pKV,(unsigned)__builtin_amdgcn_readfirstlane(vdst+(slot)))
  const int vb0=(int)(lds0+LDS_V)+((lane>>4)&1)*32+(lane&3)*8+(4*hi+((lane&15)>>2))*64;
  const char*Kbase=shm+LDS_K; bf16x8 kf[8];
  const lds_cptr shm3=(lds_cptr)shm; const lds_cptr kp0=shm3+LDS_K+hi*1024+r32*16; const lds_cptr vp0=shm3+LDS_V+((lane>>4)&1)*32+(lane&3)*8+(4*hi+((lane&15)>>2))*64;
  DMA_K(0,0);DMA_V(0,0);DMA_K(1,SLOTB);
  bf16x8 qr[4];
  #pragma unroll
  for(int d0=0;d0<4;++d0)qr[d0]=*reinterpret_cast<const bf16x8*>(&Qw[(long)r32*pQ+d0*16+hi*8]);
  float mhat=0.f,l_reg=0.f;f32x16 o[2];o[0]=f32x16{};o[1]=f32x16{};const f32x16 negm=f32x16{};
  const int qrel=wid*QBLK+r32;
  #define CMASK(P0,P1,t) do{ if(CAUSAL){int jb_=(t)-(NT-4); if(jb_>=0)cmask(P0,P1,jb_,qrel,hi);} }while(0)
  bool resc=false;
  #define START(P0,P1) do{ const float rm=rowmax(P0,P1); resc=false; \
    { const float dl=rm; mhat=fadd_s(mhat,dl); \
      _Pragma("unroll") for(int r=0;r<16;++r){P0[r]=fsub_s(P0[r],dl);P1[r]=fsub_s(P1[r],dl);} \
      } \
    _Pragma("unroll") for(int r=0;r<16;++r)P0[r]=__builtin_amdgcn_exp2f(P0[r]); }while(0)
  #define RESC() do{ if(resc){ asm volatile("s_waitcnt lgkmcnt(0)":::"memory"); \
      _Pragma("unroll") for(int d_=0;d_<2;++d_) _Pragma("unroll") for(int r=0;r<16;++r)o[d_][r]*=wsf[crow(r,hi)]; } }while(0)
  f32x16 pA0,pA1,pB0,pB1;
  int sl_prev=0,sl_cur=0,sl_next=SLOTB;
  #define ROT() do{sl_prev=sl_cur;sl_cur=sl_next;sl_next=(sl_next==(NSLOT-1)*SLOTB)?0:sl_next+SLOTB;}while(0)
  DMA_K(2,2*SLOTB);
  WAIT_BAR(3);
  qkt(pA0,pA1,Kbase,qr,negm,r32,hi);asm volatile("s_nop 15\n\ts_nop 7":"+v"(pA0),"+v"(pA1));CMASK(pA0,pA1,0);
  START(pA0,pA1);
  _Pragma("unroll") for(int r=0;r<16;++r)pA1[r]=__builtin_amdgcn_exp2f(pA1[r]);
  WAIT_BAR(0);
  DMA_K(3,0);DMA_V(1,SLOTB);
  ROT();
  kload8(kf,kp0+sl_cur);
  WAIT_BAR(2);
  s16x4 vlo[8],vhi[8]; u32x4 pw0,pw1,pw2,pw3;
  #define PKW(P,B) cvtpk_s(P[B],P[B+1])
  #define PAF(k) __builtin_bit_cast(bf16x8,pw##k)
  #define VFR(i) (bf16x8){vlo[i][0],vlo[i][1],vlo[i][2],vlo[i][3],vhi[i][0],vhi[i][1],vhi[i][2],vhi[i][3]}
  #define PIN(x) asm volatile("":"+v"(x))
  #define MX3(a,b,c) __builtin_fmaxf(__builtin_fmaxf((a),(b)),(c))
  #define GAPA(MF,A0,A1,A2,A3,W0,W1,PW) do{ MF; sacc+=A0; sacc+=A1; sacc+=A2; sacc+=A3; PIN(sacc); W0; W1; PIN(PW); SBAR(); }while(0)
  #define EX(v) __builtin_amdgcn_exp2f(v)
  #define GAPB(MF,X,B) do{ MF; X[B]=EX(X[B]); X[B+1]=EX(X[B+1]); X[B+2]=EX(X[B+2]); X[B+3]=EX(X[B+3]); PIN(X); SBAR(); }while(0)
  #define VRD(i) do{ vlo[i]=vtr(vp_+(((i)>>2)*4096+((i)&3)*1024)); vhi[i]=vtr(vp_+(((i)>>2)*4096+((i)&3)*1024+512)); }while(0)
  #define KRD(G,j) do{ if(G){ kload2(kf,kp0+sl_next,j); SBAR(); } }while(0)
  #define STEP(C0,C1,P0,P1,t,GK,GV,GL) do{ SBAR(); \
    const lds_cptr vp_=vp0+sl_prev; \
    VRD(0); SBAR(); float sacc=(P0[0]+P0[1]); \
    GAPA(C0=__builtin_amdgcn_mfma_f32_32x32x16_bf16(kf[0],qr[0],negm,0,0,0), P0[2],P0[3],P0[4],P0[5],     pw0[0]=PKW(P0,0), pw0[1]=PKW(P0,2), pw0); \
    VRD(4); SBAR(); GAPA(C1=__builtin_amdgcn_mfma_f32_32x32x16_bf16(kf[1],qr[0],negm,0,0,0), P0[6],P0[7],P0[8],P0[9],     pw0[2]=PKW(P0,4), pw0[3]=PKW(P0,6), pw0); \
    VRD(1); SBAR(); GAPA(C0=__builtin_amdgcn_mfma_f32_32x32x16_bf16(kf[2],qr[1],C0,0,0,0),   P0[10],P0[11],P0[12],P0[13], pw1[0]=PKW(P0,8), pw1[1]=PKW(P0,10), pw1); \
    VRD(5); SBAR(); GAPA(C1=__builtin_amdgcn_mfma_f32_32x32x16_bf16(kf[3],qr[1],C1,0,0,0),   P0[14],P0[15],P1[0],P1[1],   pw1[2]=PKW(P0,12),pw1[3]=PKW(P0,14), pw1); \
    VRD(2); SBAR(); GAPA(C0=__builtin_amdgcn_mfma_f32_32x32x16_bf16(kf[4],qr[2],C0,0,0,0),   P1[2],P1[3],P1[4],P1[5],     pw2[0]=PKW(P1,0), pw2[1]=PKW(P1,2), pw2); \
    VRD(6); SBAR(); GAPA(C1=__builtin_amdgcn_mfma_f32_32x32x16_bf16(kf[5],qr[2],C1,0,0,0),   P1[6],P1[7],P1[8],P1[9],     pw2[2]=PKW(P1,4), pw2[3]=PKW(P1,6), pw2); \
    VRD(3); SBAR(); GAPA(C0=__builtin_amdgcn_mfma_f32_32x32x16_bf16(kf[6],qr[3],C0,0,0,0),   P1[10],P1[11],P1[12],P1[13], pw3[0]=PKW(P1,8), pw3[1]=PKW(P1,10), pw3); \
    VRD(7); SBAR(); GAPA(C1=__builtin_amdgcn_mfma_f32_32x32x16_bf16(kf[7],qr[3],C1,0,0,0),   P1[14],P1[15],0.f,0.f,       pw3[2]=PKW(P1,12),pw3[3]=PKW(P1,14), pw3); \
    l_reg+=sacc; \
    if(GK){DMA_K((t)+3,sl_cur);} if(GV){DMA_V((t)+1,sl_next);} \
    CMASK(C0,C1,t); \
    _Pragma("unroll") for(int r=0;r<16;++r){C0[r]-=mhat;C1[r]-=mhat;} \
    { float a=MX3(C0[0],C0[1],C1[0]),b=MX3(C0[2],C0[3],C1[1]); a=MX3(a,C1[2],C1[3]); \
      _Pragma("unroll") for(int r=4;r<16;r+=4){a=MX3(a,C0[r],C0[r+1]);b=MX3(b,C0[r+2],C0[r+3]);a=MX3(a,C1[r],C1[r+1]);b=MX3(b,C1[r+2],C1[r+3]);} \
      float rm=__builtin_fmaxf(a,b); { auto rr=__builtin_amdgcn_permlane32_swap(__float_as_uint(rm),__float_as_uint(rm),false,false); rm=__builtin_fmaxf(__uint_as_float(rr[0]),__uint_as_float(rr[1])); } \
      resc=false; \
      if(__builtin_expect(__any(rm>(float)THRL),0)){ const float dl=__builtin_fmaxf(rm,0.f); mhat+=dl; \
        _Pragma("unroll") for(int r=0;r<16;++r){C0[r]-=dl;C1[r]-=dl;} \
        const float f=__builtin_amdgcn_exp2f(-dl); l_reg*=f; if(hi==0)wsf[r32]=f; resc=true; } } \
    SBAR(); \
    GAPB(o[0]=__builtin_amdgcn_mfma_f32_32x32x16_bf16(PAF(0),VFR(0),o[0],0,0,0), C0,0); \
    GAPB(o[1]=__builtin_amdgcn_mfma_f32_32x32x16_bf16(PAF(0),VFR(4),o[1],0,0,0), C0,4); \
    KRD(GL,0); GAPB(o[0]=__builtin_amdgcn_mfma_f32_32x32x16_bf16(PAF(1),VFR(1),o[0],0,0,0), C0,8); \
    KRD(GL,1); GAPB(o[1]=__builtin_amdgcn_mfma_f32_32x32x16_bf16(PAF(1),VFR(5),o[1],0,0,0), C0,12); \
    KRD(GL,2); GAPB(o[0]=__builtin_amdgcn_mfma_f32_32x32x16_bf16(PAF(2),VFR(2),o[0],0,0,0), C1,0); \
    KRD(GL,3); GAPB(o[1]=__builtin_amdgcn_mfma_f32_32x32x16_bf16(PAF(2),VFR(6),o[1],0,0,0), C1,4); \
    GAPB(o[0]=__builtin_amdgcn_mfma_f32_32x32x16_bf16(PAF(3),VFR(3),o[0],0,0,0), C1,8); \
    GAPB(o[1]=__builtin_amdgcn_mfma_f32_32x32x16_bf16(PAF(3),VFR(7),o[1],0,0,0), C1,12); \
    }while(0)
  int t=1;
  #undef CMASK
  #define CMASK(P0,P1,t) do{}while(0)
  for(;t+5<NT;t+=2){
    STEP(pB0,pB1,pA0,pA1,t,true,true,true);     WAIT_BAR(2); RESC(); ROT();
    STEP(pA0,pA1,pB0,pB1,t+1,true,true,true);   WAIT_BAR(2); RESC(); ROT();
  }
  #undef CMASK
  #define CMASK(P0,P1,t) do{ if(CAUSAL){int jb_=(t)-(NT-4); if(jb_>=0)cmask(P0,P1,jb_,qrel,hi);} }while(0)
  #define ENDW(tt) do{ if((tt)+3<NT){WAIT_BAR(2);} else if((tt)+2<NT){WAIT_BAR(1);} else {WAIT_BAR(0);} }while(0)
  for(;t+1<NT;t+=2){
    STEP(pB0,pB1,pA0,pA1,t,(t+3<NT),(t+1<NT),(t+1<NT));       ENDW(t);   RESC(); ROT();
    STEP(pA0,pA1,pB0,pB1,t+1,(t+4<NT),(t+2<NT),(t+2<NT));     ENDW(t+1); RESC(); ROT();
  }
  STEP(pB0,pB1,pA0,pA1,NT-1,false,false,false); RESC();
  { float sacc=pB0[0]+pB0[1]; _Pragma("unroll") for(int r=2;r<16;++r)sacc+=pB0[r]; _Pragma("unroll") for(int r=0;r<16;++r)sacc+=pB1[r]; l_reg+=sacc;
    pw0=(u32x4){PKW(pB0,0),PKW(pB0,2),PKW(pB0,4),PKW(pB0,6)};pw1=(u32x4){PKW(pB0,8),PKW(pB0,10),PKW(pB0,12),PKW(pB0,14)};pw2=(u32x4){PKW(pB1,0),PKW(pB1,2),PKW(pB1,4),PKW(pB1,6)};pw3=(u32x4){PKW(pB1,8),PKW(pB1,10),PKW(pB1,12),PKW(pB1,14)};
    SBAR(); pv(o,vb0+sl_cur,PAF(0),PAF(1),PAF(2),PAF(3)); }
  #undef PKW
  #undef PAF
  #undef VFR
  #undef PIN
  #undef MX3
  #undef GAPA
  #undef GAPB
  #undef EX
  #undef VRD
  #undef KRD
  #undef STEP
  #undef ENDW
  {auto rr=__builtin_amdgcn_permlane32_swap(__float_as_uint(l_reg),__float_as_uint(l_reg),false,false);l_reg=__uint_as_float(rr[0])+__uint_as_float(rr[1]);}
  if(hi==0)wsf[32+r32]=l_reg;asm volatile("s_waitcnt lgkmcnt(0)":::"memory");
  float rli[16];
  #pragma unroll
  for(int r=0;r<16;++r)rli[r]=__builtin_amdgcn_rcpf(wsf[32+crow(r,hi)]);
  bf16*Ow=Ou+(long)(wid*QBLK)*pO;
  { bf16*stg=(bf16*)(shm+LDS_OST)+wid*2048;
    #pragma unroll
    for(int r=0;r<16;++r){const int orow=crow(r,hi);
      #pragma unroll
      for(int d0=0;d0<2;++d0)stg[orow*64+d0*32+r32]=__float2bfloat16(o[d0][r]*rli[r]);}
    asm volatile("s_waitcnt lgkmcnt(0)":::"memory");
    #pragma unroll
    for(int i=0;i<4;++i){const int row=i*8+(lane>>3),ch=lane&7; const u32x4 v=*(const u32x4*)(stg+row*64+ch*8); ATTN_STORE16(Ow+(long)row*pO+ch*8,v);} }
  asm volatile("s_waitcnt lgkmcnt(0)\n\ts_barrier":::"memory");
  #undef DMA_K
  #undef DMA_V
  #undef CMASK
  #undef START
  #undef RESC
  #undef ROT
}
__device__ __forceinline__ void mem_attn(const bf16*Q0,const int pQ,const bf16*__restrict__ Kh,const bf16*__restrict__ Vh,const int pKV,bf16*O0,const int pO,const int nqb,char*shm){
  int tid_=threadIdx.x; asm volatile("":"+v"(tid_));
  const int tid=tid_,lane=tid&63,r32=lane&31,hi=lane>>5; const int wid=__builtin_amdgcn_readfirstlane(tid>>6);
  constexpr int MK=0,MV=32768,MWS=65536,MOST=65536+2048;
  const unsigned lds0=(unsigned)(uintptr_t)shm;
  const bf16*ksrc=Kh+(long)lane*pKV+wid*8;
  const bf16*vsrc=Vh+(long)(16*(wid&3)+(lane>>2))*pKV+(wid>>2)*32+(lane&3)*8;
  #pragma unroll
  for(int t=0;t<4;++t){ glds16(ksrc+(long)t*KVBLK*pKV,(unsigned)__builtin_amdgcn_readfirstlane(lds0+MK+t*8192+wid*1024)); glds16(vsrc+(long)t*KVBLK*pKV,(unsigned)__builtin_amdgcn_readfirstlane(lds0+MV+t*8192+wid*1024)); }
  WAIT_BAR(0);
  const int vb0=(int)(lds0+MV)+((lane>>4)&1)*32+(lane&3)*8+(4*hi+((lane&15)>>2))*64;
  float*wsf=(float*)(shm+MWS)+wid*64;
  const f32x16 zero=f32x16{};
  for(int qb=0;qb<nqb;++qb){
    const bf16*Qw=Q0+(long)(qb*QB+wid*QBLK)*pQ;
    bf16x8 qr[4];
    #pragma unroll
    for(int d0=0;d0<4;++d0)qr[d0]=*reinterpret_cast<const bf16x8*>(&Qw[(long)r32*pQ+d0*16+hi*8]);
    f32x16 p[4][2];
    #pragma unroll
    for(int t=0;t<4;++t)qkt(p[t][0],p[t][1],shm+MK+t*8192,qr,zero,r32,hi);
    float m=p[0][0][0];
    #pragma unroll
    for(int t=0;t<4;++t)
      #pragma unroll
      for(int j=0;j<2;++j)
        #pragma unroll
        for(int r=0;r<16;++r)m=__builtin_fmaxf(m,p[t][j][r]);
    { auto rr=__builtin_amdgcn_permlane32_swap(__float_as_uint(m),__float_as_uint(m),false,false); m=__builtin_fmaxf(__uint_as_float(rr[0]),__uint_as_float(rr[1])); }
    float l=0.f;
    #pragma unroll
    for(int t=0;t<4;++t)
      #pragma unroll
      for(int j=0;j<2;++j)
        #pragma unroll
        for(int r=0;r<16;++r){ const float e=__builtin_amdgcn_exp2f(p[t][j][r]-m); p[t][j][r]=e; l+=e; }
    { auto rr=__builtin_amdgcn_permlane32_swap(__float_as_uint(l),__float_as_uint(l),false,false); l=__uint_as_float(rr[0])+__uint_as_float(rr[1]); }
    f32x16 o[2]; o[0]=f32x16{}; o[1]=f32x16{};
    #pragma unroll
    for(int t=0;t<4;++t){
      const u32x4 w0={cvtpk_s(p[t][0][0],p[t][0][1]),cvtpk_s(p[t][0][2],p[t][0][3]),cvtpk_s(p[t][0][4],p[t][0][5]),cvtpk_s(p[t][0][6],p[t][0][7])};
      const u32x4 w1={cvtpk_s(p[t][0][8],p[t][0][9]),cvtpk_s(p[t][0][10],p[t][0][11]),cvtpk_s(p[t][0][12],p[t][0][13]),cvtpk_s(p[t][0][14],p[t][0][15])};
      const u32x4 w2={cvtpk_s(p[t][1][0],p[t][1][1]),cvtpk_s(p[t][1][2],p[t][1][3]),cvtpk_s(p[t][1][4],p[t][1][5]),cvtpk_s(p[t][1][6],p[t][1][7])};
      const u32x4 w3={cvtpk_s(p[t][1][8],p[t][1][9]),cvtpk_s(p[t][1][10],p[t][1][11]),cvtpk_s(p[t][1][12],p[t][1][13]),cvtpk_s(p[t][1][14],p[t][1][15])};
      pv(o,vb0+t*8192,__builtin_bit_cast(bf16x8,w0),__builtin_bit_cast(bf16x8,w1),__builtin_bit_cast(bf16x8,w2),__builtin_bit_cast(bf16x8,w3)); }
    if(hi==0)wsf[32+r32]=l; asm volatile("s_waitcnt lgkmcnt(0)":::"memory");
    float rli[16];
    #pragma unroll
    for(int r=0;r<16;++r)rli[r]=__builtin_amdgcn_rcpf(wsf[32+crow(r,hi)]);
    bf16*Ow=O0+(long)(qb*QB+wid*QBLK)*pO;
    { bf16*stg=(bf16*)(shm+MOST)+wid*2048;
      #pragma unroll
      for(int r=0;r<16;++r){const int orow=crow(r,hi);
        #pragma unroll
        for(int d0=0;d0<2;++d0)stg[orow*64+d0*32+r32]=__float2bfloat16(o[d0][r]*rli[r]);}
      asm volatile("s_waitcnt lgkmcnt(0)":::"memory");
      #pragma unroll
      for(int i=0;i<4;++i){const int row=i*8+(lane>>3),ch=lane&7; const u32x4 v=*(const u32x4*)(stg+row*64+ch*8); ATTN_STORE16(Ow+(long)row*pO+ch*8,v);}
      asm volatile("s_waitcnt lgkmcnt(0)":::"memory"); }
  }
  asm volatile("s_waitcnt lgkmcnt(0)\n\ts_barrier":::"memory");
}
constexpr int ATTN_LDS_BYTES=LDS_BYTES;
#undef SBAR
#undef WAIT_BAR
}
namespace attn2 {
using bf16=__hip_bfloat16;
using bf16x8=__attribute__((ext_vector_type(8)))short;
using s16x4=__attribute__((ext_vector_type(4)))short;
using f32x16=__attribute__((ext_vector_type(16)))float;
using u32x4=__attribute__((ext_vector_type(4)))unsigned;
constexpr int D=64;
constexpr int NW=8,QBLK=32,QB=QBLK*NW,KVBLK=64;
constexpr int ATTN_UNIT_ROWS=QB;
__device__ __forceinline__ int crow(int r,int hi){return (r&3)+8*(r>>2)+4*hi;}
#define SBAR() __builtin_amdgcn_sched_barrier(0)
__device__ __forceinline__ void cmask(f32x16&p0,f32x16&p1,int jb,int qrel,int hi){
  const float NEG=-INFINITY; int kb=64*jb+4*hi;
  #pragma unroll
  for(int r=0;r<16;++r){int kv=kb+(r&3)+8*(r>>2); if(kv>qrel)p0[r]=NEG; if(kv+32>qrel)p1[r]=NEG;}
}

constexpr int NSLOT=3, SLOTB=8192;
constexpr int LDS_K=0, LDS_V=NSLOT*SLOTB, LDS_WS=3*NSLOT*SLOTB, LDS_OST=LDS_WS+NW*64*4, LDS_BYTES=LDS_OST+NW*4096;
constexpr float C2=0.125f*1.4426950408889634f;
__device__ __forceinline__ void glds16(const void*gsrc,unsigned lds_dst){unsigned keep;
  asm volatile("s_mov_b32 %0, m0\n\ts_mov_b32 m0, %2\n\ts_nop 0\n\tglobal_load_lds_dwordx4 %1, off\n\ts_mov_b32 m0, %0":"=&s"(keep):"v"(gsrc),"s"(lds_dst):"memory");}
__device__ __forceinline__ float max3f(float a,float b,float c){float r;asm("v_max3_f32 %0, %1, %2, %3":"=v"(r):"v"(a),"v"(b),"v"(c));return r;}
__device__ __forceinline__ float max2f(float a,float b){float r;asm("v_max_f32_e32 %0, %1, %2":"=v"(r):"v"(a),"v"(b));return r;}
__device__ __forceinline__ float fadd_s(float a,float b){float r;asm("v_add_f32_e32 %0, %1, %2":"=v"(r):"v"(a),"v"(b));return r;}
__device__ __forceinline__ float fsub_s(float a,float b){float r;asm("v_sub_f32_e32 %0, %1, %2":"=v"(r):"v"(a),"v"(b));return r;}
typedef float f32x2_t __attribute__((ext_vector_type(2))); typedef __bf16 bf16x2_t __attribute__((ext_vector_type(2)));
__device__ __forceinline__ unsigned cvtpk_s(float lo,float hi){f32x2_t v={lo,hi};bf16x2_t b=__builtin_convertvector(v,bf16x2_t);return __builtin_bit_cast(unsigned,b);}
#define WAIT_BAR(N) asm volatile("s_waitcnt vmcnt(" #N ") lgkmcnt(0)\n\ts_barrier":::"memory")

__device__ __forceinline__ void qkt(f32x16&p0,f32x16&p1,const char*Kslot,const bf16x8*qr,const f32x16&negm,int r32,int hi){
  const char*kb=Kslot+hi*1024+r32*16;
  #pragma unroll
  for(int d0=0;d0<4;++d0){
    const bf16x8 b0=*reinterpret_cast<const bf16x8*>(kb+d0*2048);
    const bf16x8 b1=*reinterpret_cast<const bf16x8*>(kb+d0*2048+512);
    if(d0==0){p0=__builtin_amdgcn_mfma_f32_32x32x16_bf16(b0,qr[0],negm,0,0,0);p1=__builtin_amdgcn_mfma_f32_32x32x16_bf16(b1,qr[0],negm,0,0,0);}
    else{p0=__builtin_amdgcn_mfma_f32_32x32x16_bf16(b0,qr[d0],p0,0,0,0);p1=__builtin_amdgcn_mfma_f32_32x32x16_bf16(b1,qr[d0],p1,0,0,0);}}
}
typedef __attribute__((address_space(3))) const char* lds_cptr;
typedef short v4i16_t __attribute__((ext_vector_type(4)));
__device__ __forceinline__ void kload8(bf16x8*kf,lds_cptr kp){
  kf[0]=*(const __attribute__((address_space(3))) bf16x8*)(kp);      kf[1]=*(const __attribute__((address_space(3))) bf16x8*)(kp+512);
  kf[2]=*(const __attribute__((address_space(3))) bf16x8*)(kp+2048); kf[3]=*(const __attribute__((address_space(3))) bf16x8*)(kp+2560);
  kf[4]=*(const __attribute__((address_space(3))) bf16x8*)(kp+4096); kf[5]=*(const __attribute__((address_space(3))) bf16x8*)(kp+4608);
  kf[6]=*(const __attribute__((address_space(3))) bf16x8*)(kp+6144); kf[7]=*(const __attribute__((address_space(3))) bf16x8*)(kp+6656);
}
__device__ __forceinline__ void kload2(bf16x8*kf,lds_cptr kp,int j){ kf[2*j]=*(const __attribute__((address_space(3))) bf16x8*)(kp+j*2048); kf[2*j+1]=*(const __attribute__((address_space(3))) bf16x8*)(kp+j*2048+512); }
__device__ __forceinline__ s16x4 vtr(lds_cptr p){ return __builtin_bit_cast(s16x4,__builtin_amdgcn_ds_read_tr16_b64_v4i16((__attribute__((address_space(3))) v4i16_t*)p)); }
__device__ __forceinline__ float rowmax(const f32x16&p0,const f32x16&p1){
  float a=max3f(p0[0],p0[1],p1[0]),b=max3f(p0[2],p0[3],p1[1]);a=max3f(a,p1[2],p1[3]);
  #pragma unroll
  for(int r=4;r<16;r+=4){a=max3f(a,p0[r],p0[r+1]);b=max3f(b,p0[r+2],p0[r+3]);a=max3f(a,p1[r],p1[r+1]);b=max3f(b,p1[r+2],p1[r+3]);}
  const float m=max2f(a,b);
  auto rr=__builtin_amdgcn_permlane32_swap(__float_as_uint(m),__float_as_uint(m),false,false);
  return max2f(__uint_as_float(rr[0]),__uint_as_float(rr[1]));
}
__device__ __forceinline__ void pv(f32x16*o,int vb,bf16x8 pa0,bf16x8 pa1,bf16x8 pa2,bf16x8 pa3){
  #pragma unroll
  for(int d0=0;d0<4;++d0){s16x4 lo[4],hi[4];
    #pragma unroll
    for(int ks=0;ks<4;++ks){
      asm volatile("ds_read_b64_tr_b16 %0,%1 offset:%c2":"=&v"(lo[ks]):"v"(vb),"i"(d0*4096+ks*1024):"memory");
      asm volatile("ds_read_b64_tr_b16 %0,%1 offset:%c2":"=&v"(hi[ks]):"v"(vb),"i"(d0*4096+ks*1024+512):"memory");}
    asm volatile("s_waitcnt lgkmcnt(0)":::"memory");SBAR();
    #define PK(k) (bf16x8){lo[k][0],lo[k][1],lo[k][2],lo[k][3],hi[k][0],hi[k][1],hi[k][2],hi[k][3]}
    o[d0]=__builtin_amdgcn_mfma_f32_32x32x16_bf16(pa0,PK(0),o[d0],0,0,0);
    o[d0]=__builtin_amdgcn_mfma_f32_32x32x16_bf16(pa1,PK(1),o[d0],0,0,0);
    o[d0]=__builtin_amdgcn_mfma_f32_32x32x16_bf16(pa2,PK(2),o[d0],0,0,0);
    o[d0]=__builtin_amdgcn_mfma_f32_32x32x16_bf16(pa3,PK(3),o[d0],0,0,0);
    #undef PK
  }
}

#ifndef ATTN_STORE16
#define ATTN_STORE16(p,v) (*(u32x4*)(p)=(v))
#endif
template<int THRL,bool CAUSAL> __device__ __forceinline__ void attn_unit(const bf16*Qu,const int pQ,const bf16*__restrict__ Kh,const bf16*__restrict__ Vh,const int pKV,bf16*Ou,const int pO,const int NT,char*shm){
  int tid_=threadIdx.x; asm volatile("":"+v"(tid_));
  const int tid=tid_,lane=tid&63,r32=lane&31,hi=lane>>5; const int wid=__builtin_amdgcn_readfirstlane(tid>>6);
  const bf16*Qw=Qu+(long)(wid*QBLK)*pQ;
  const unsigned lds0=(unsigned)(uintptr_t)shm;
  float*wsf=(float*)(shm+LDS_WS)+wid*64;
  const bf16*ksrc=Kh+(long)lane*pKV+wid*8;
  const bf16*vsrc=Vh+(long)(16*(wid&3)+(lane>>2))*pKV+(wid>>2)*32+(lane&3)*8;
  const unsigned kdst=lds0+LDS_K+wid*1024, vdst=lds0+LDS_V+wid*1024;
  #define DMA_K(t,slot) glds16(ksrc+(long)(t)*KVBLK*pKV,(unsigned)__builtin_amdgcn_readfirstlane(kdst+(slot)))
  #define DMA_V(t,slot) do{ glds16(vsrc+(long)(t)*KVBLK*pKV,(unsigned)__builtin_amdgcn_readfirstlane(vdst+2*(slot))); glds16(vsrc+(long)(t)*KVBLK*pKV+64,(unsigned)__builtin_amdgcn_readfirstlane(vdst+2*(slot)+8192)); }while(0)
  const int vb0=(int)(lds0+LDS_V)+((lane>>4)&1)*32+(lane&3)*8+(4*hi+((lane&15)>>2))*64;
  const char*Kbase=shm+LDS_K; bf16x8 kf[8];
  const lds_cptr shm3=(lds_cptr)shm; const lds_cptr kp0=shm3+LDS_K+hi*1024+r32*16; const lds_cptr vp0=shm3+LDS_V+((lane>>4)&1)*32+(lane&3)*8+(4*hi+((lane&15)>>2))*64;
  DMA_K(0,0);DMA_V(0,0);DMA_K(1,SLOTB);
  bf16x8 qr[4];
  #pragma unroll
  for(int d0=0;d0<4;++d0)qr[d0]=*reinterpret_cast<const bf16x8*>(&Qw[(long)r32*pQ+d0*16+hi*8]);
  float mhat=0.f,l_reg=0.f;f32x16 o[4];o[0]=f32x16{};o[1]=f32x16{};o[2]=f32x16{};o[3]=f32x16{};const f32x16 negm=f32x16{};
  const int qrel=wid*QBLK+r32;
  #define CMASK(P0,P1,t) do{ if(CAUSAL){int jb_=(t)-(NT-4); if(jb_>=0)cmask(P0,P1,jb_,qrel,hi);} }while(0)
  bool resc=false;
  #define START(P0,P1) do{ const float rm=rowmax(P0,P1); resc=false; \
    { const float dl=rm; mhat=fadd_s(mhat,dl); \
      _Pragma("unroll") for(int r=0;r<16;++r){P0[r]=fsub_s(P0[r],dl);P1[r]=fsub_s(P1[r],dl);} \
      } \
    _Pragma("unroll") for(int r=0;r<16;++r)P0[r]=__builtin_amdgcn_exp2f(P0[r]); }while(0)
  #define RESC() do{ if(resc){ asm volatile("s_waitcnt lgkmcnt(0)":::"memory"); \
      _Pragma("unroll") for(int d_=0;d_<4;++d_) _Pragma("unroll") for(int r=0;r<16;++r)o[d_][r]*=wsf[crow(r,hi)]; } }while(0)
  f32x16 pA0,pA1,pB0,pB1;
  int sl_prev=0,sl_cur=0,sl_next=SLOTB;
  #define ROT() do{sl_prev=sl_cur;sl_cur=sl_next;sl_next=(sl_next==(NSLOT-1)*SLOTB)?0:sl_next+SLOTB;}while(0)
  DMA_K(2,2*SLOTB);
  WAIT_BAR(4);
  qkt(pA0,pA1,Kbase,qr,negm,r32,hi);asm volatile("s_nop 15\n\ts_nop 7":"+v"(pA0),"+v"(pA1));CMASK(pA0,pA1,0);
  START(pA0,pA1);
  _Pragma("unroll") for(int r=0;r<16;++r)pA1[r]=__builtin_amdgcn_exp2f(pA1[r]);
  WAIT_BAR(0);
  DMA_K(3,0);DMA_V(1,SLOTB);
  ROT();
  kload8(kf,kp0+sl_cur);
  WAIT_BAR(3);
  s16x4 vlo[8],vhi[8]; u32x4 pw0,pw1,pw2,pw3;
  #define PKW(P,B) cvtpk_s(P[B],P[B+1])
  #define PAF(k) __builtin_bit_cast(bf16x8,pw##k)
  #define VFR(i) (bf16x8){vlo[i][0],vlo[i][1],vlo[i][2],vlo[i][3],vhi[i][0],vhi[i][1],vhi[i][2],vhi[i][3]}
  #define PIN(x) asm volatile("":"+v"(x))
  #define MX3(a,b,c) __builtin_fmaxf(__builtin_fmaxf((a),(b)),(c))
  #define GAPA(MF,A0,A1,A2,A3,W0,W1,PW) do{ MF; sacc+=A0; sacc+=A1; sacc+=A2; sacc+=A3; PIN(sacc); W0; W1; PIN(PW); SBAR(); }while(0)
  #define EX(v) __builtin_amdgcn_exp2f(v)
  #define GAPB(MF,X,B) do{ MF; X[B]=EX(X[B]); X[B+1]=EX(X[B+1]); X[B+2]=EX(X[B+2]); X[B+3]=EX(X[B+3]); PIN(X); SBAR(); }while(0)
  #define VRD(i) do{ vlo[i]=vtr(vp_+(((i)>>2)*4096+((i)&3)*1024)); vhi[i]=vtr(vp_+(((i)>>2)*4096+((i)&3)*1024+512)); }while(0)
  #define VRD2(i) do{ vlo[i]=vtr(vp_+((((i)>>2)+2)*4096+((i)&3)*1024)); vhi[i]=vtr(vp_+((((i)>>2)+2)*4096+((i)&3)*1024+512)); }while(0)
  #define GAPB2(MF,X,B) do{ MF; X[B]=EX(X[B]); X[B+1]=EX(X[B+1]); PIN(X); SBAR(); }while(0)
  #define KRD(G,j) do{ if(G){ kload2(kf,kp0+sl_next,j); SBAR(); } }while(0)
  #define STEP(C0,C1,P0,P1,t,GK,GV,GL) do{ SBAR(); \
    const lds_cptr vp_=vp0+2*sl_prev; \
    VRD(0); SBAR(); float sacc=(P0[0]+P0[1]); \
    GAPA(C0=__builtin_amdgcn_mfma_f32_32x32x16_bf16(kf[0],qr[0],negm,0,0,0), P0[2],P0[3],P0[4],P0[5],     pw0[0]=PKW(P0,0), pw0[1]=PKW(P0,2), pw0); \
    VRD(4); SBAR(); GAPA(C1=__builtin_amdgcn_mfma_f32_32x32x16_bf16(kf[1],qr[0],negm,0,0,0), P0[6],P0[7],P0[8],P0[9],     pw0[2]=PKW(P0,4), pw0[3]=PKW(P0,6), pw0); \
    VRD(1); SBAR(); GAPA(C0=__builtin_amdgcn_mfma_f32_32x32x16_bf16(kf[2],qr[1],C0,0,0,0),   P0[10],P0[11],P0[12],P0[13], pw1[0]=PKW(P0,8), pw1[1]=PKW(P0,10), pw1); \
    VRD(5); SBAR(); GAPA(C1=__builtin_amdgcn_mfma_f32_32x32x16_bf16(kf[3],qr[1],C1,0,0,0),   P0[14],P0[15],P1[0],P1[1],   pw1[2]=PKW(P0,12),pw1[3]=PKW(P0,14), pw1); \
    VRD(2); SBAR(); GAPA(C0=__builtin_amdgcn_mfma_f32_32x32x16_bf16(kf[4],qr[2],C0,0,0,0),   P1[2],P1[3],P1[4],P1[5],     pw2[0]=PKW(P1,0), pw2[1]=PKW(P1,2), pw2); \
    VRD(6); SBAR(); GAPA(C1=__builtin_amdgcn_mfma_f32_32x32x16_bf16(kf[5],qr[2],C1,0,0,0),   P1[6],P1[7],P1[8],P1[9],     pw2[2]=PKW(P1,4), pw2[3]=PKW(P1,6), pw2); \
    VRD(3); SBAR(); GAPA(C0=__builtin_amdgcn_mfma_f32_32x32x16_bf16(kf[6],qr[3],C0,0,0,0),   P1[10],P1[11],P1[12],P1[13], pw3[0]=PKW(P1,8), pw3[1]=PKW(P1,10), pw3); \
    VRD(7); SBAR(); GAPA(C1=__builtin_amdgcn_mfma_f32_32x32x16_bf16(kf[7],qr[3],C1,0,0,0),   P1[14],P1[15],0.f,0.f,       pw3[2]=PKW(P1,12),pw3[3]=PKW(P1,14), pw3); \
    l_reg+=sacc; \
    if(GK){DMA_K((t)+3,sl_cur);} if(GV){DMA_V((t)+1,sl_next);} \
    CMASK(C0,C1,t); \
    _Pragma("unroll") for(int r=0;r<16;++r){C0[r]-=mhat;C1[r]-=mhat;} \
    { float a=MX3(C0[0],C0[1],C1[0]),b=MX3(C0[2],C0[3],C1[1]); a=MX3(a,C1[2],C1[3]); \
      _Pragma("unroll") for(int r=4;r<16;r+=4){a=MX3(a,C0[r],C0[r+1]);b=MX3(b,C0[r+2],C0[r+3]);a=MX3(a,C1[r],C1[r+1]);b=MX3(b,C1[r+2],C1[r+3]);} \
      float rm=__builtin_fmaxf(a,b); { auto rr=__builtin_amdgcn_permlane32_swap(__float_as_uint(rm),__float_as_uint(rm),false,false); rm=__builtin_fmaxf(__uint_as_float(rr[0]),__uint_as_float(rr[1])); } \
      resc=false; \
      if(__builtin_expect(__any(rm>(float)THRL),0)){ const float dl=__builtin_fmaxf(rm,0.f); mhat+=dl; \
        _Pragma("unroll") for(int r=0;r<16;++r){C0[r]-=dl;C1[r]-=dl;} \
        const float f=__builtin_amdgcn_exp2f(-dl); l_reg*=f; if(hi==0)wsf[r32]=f; resc=true; } } \
    SBAR(); \
    GAPB2(o[0]=__builtin_amdgcn_mfma_f32_32x32x16_bf16(PAF(0),VFR(0),o[0],0,0,0), C0,0); VRD2(0); SBAR(); \
    GAPB2(o[1]=__builtin_amdgcn_mfma_f32_32x32x16_bf16(PAF(0),VFR(4),o[1],0,0,0), C0,2); VRD2(4); SBAR(); \
    KRD(GL,0); GAPB2(o[0]=__builtin_amdgcn_mfma_f32_32x32x16_bf16(PAF(1),VFR(1),o[0],0,0,0), C0,4); VRD2(1); SBAR(); \
    KRD(GL,1); GAPB2(o[1]=__builtin_amdgcn_mfma_f32_32x32x16_bf16(PAF(1),VFR(5),o[1],0,0,0), C0,6); VRD2(5); SBAR(); \
    KRD(GL,2); GAPB2(o[0]=__builtin_amdgcn_mfma_f32_32x32x16_bf16(PAF(2),VFR(2),o[0],0,0,0), C0,8); VRD2(2); SBAR(); \
    KRD(GL,3); GAPB2(o[1]=__builtin_amdgcn_mfma_f32_32x32x16_bf16(PAF(2),VFR(6),o[1],0,0,0), C0,10); VRD2(6); SBAR(); \
    GAPB2(o[0]=__builtin_amdgcn_mfma_f32_32x32x16_bf16(PAF(3),VFR(3),o[0],0,0,0), C0,12); VRD2(3); SBAR(); \
    GAPB2(o[1]=__builtin_amdgcn_mfma_f32_32x32x16_bf16(PAF(3),VFR(7),o[1],0,0,0), C0,14); VRD2(7); SBAR(); \
    GAPB2(o[2]=__builtin_amdgcn_mfma_f32_32x32x16_bf16(PAF(0),VFR(0),o[2],0,0,0), C1,0); \
    GAPB2(o[3]=__builtin_amdgcn_mfma_f32_32x32x16_bf16(PAF(0),VFR(4),o[3],0,0,0), C1,2); \
    GAPB2(o[2]=__builtin_amdgcn_mfma_f32_32x32x16_bf16(PAF(1),VFR(1),o[2],0,0,0), C1,4); \
    GAPB2(o[3]=__builtin_amdgcn_mfma_f32_32x32x16_bf16(PAF(1),VFR(5),o[3],0,0,0), C1,6); \
    GAPB2(o[2]=__builtin_amdgcn_mfma_f32_32x32x16_bf16(PAF(2),VFR(2),o[2],0,0,0), C1,8); \
    GAPB2(o[3]=__builtin_amdgcn_mfma_f32_32x32x16_bf16(PAF(2),VFR(6),o[3],0,0,0), C1,10); \
    GAPB2(o[2]=__builtin_amdgcn_mfma_f32_32x32x16_bf16(PAF(3),VFR(3),o[2],0,0,0), C1,12); \
    GAPB2(o[3]=__builtin_amdgcn_mfma_f32_32x32x16_bf16(PAF(3),VFR(7),o[3],0,0,0), C1,14); \
    }while(0)
  int t=1;
  #undef CMASK
  #define CMASK(P0,P1,t) do{}while(0)
  for(;t+5<NT;t+=2){
    STEP(pB0,pB1,pA0,pA1,t,true,true,true);     WAIT_BAR(3); RESC(); ROT();
    STEP(pA0,pA1,pB0,pB1,t+1,true,true,true);   WAIT_BAR(3); RESC(); ROT();
  }
  #undef CMASK
  #define CMASK(P0,P1,t) do{ if(CAUSAL){int jb_=(t)-(NT-4); if(jb_>=0)cmask(P0,P1,jb_,qrel,hi);} }while(0)
  #define ENDW(tt) do{ if((tt)+3<NT){WAIT_BAR(3);} else if((tt)+2<NT){WAIT_BAR(2);} else {WAIT_BAR(0);} }while(0)
  for(;t+1<NT;t+=2){
    STEP(pB0,pB1,pA0,pA1,t,(t+3<NT),(t+1<NT),(t+1<NT));       ENDW(t);   RESC(); ROT();
    STEP(pA0,pA1,pB0,pB1,t+1,(t+4<NT),(t+2<NT),(t+2<NT));     ENDW(t+1); RESC(); ROT();
  }
  STEP(pB0,pB1,pA0,pA1,NT-1,false,false,false); RESC();
  { float sacc=pB0[0]+pB0[1]; _Pragma("unroll") for(int r=2;r<16;++r)sacc+=pB0[r]; _Pragma("unroll") for(int r=0;r<16;++r)sacc+=pB1[r]; l_reg+=sacc;
    pw0=(u32x4){PKW(pB0,0),PKW(pB0,2),PKW(pB0,4),PKW(pB0,6)};pw1=(u32x4){PKW(pB0,8),PKW(pB0,10),PKW(pB0,12),PKW(pB0,14)};pw2=(u32x4){PKW(pB1,0),PKW(pB1,2),PKW(pB1,4),PKW(pB1,6)};pw3=(u32x4){PKW(pB1,8),PKW(pB1,10),PKW(pB1,12),PKW(pB1,14)};
    SBAR(); pv(o,vb0+2*sl_cur,PAF(0),PAF(1),PAF(2),PAF(3)); }
  #undef PKW
  #undef PAF
  #undef VFR
  #undef PIN
  #undef MX3
  #undef GAPA
  #undef GAPB
  #undef EX
  #undef VRD
  #undef VRD2
  #undef GAPB2
  #undef KRD
  #undef STEP
  #undef ENDW
  {auto rr=__builtin_amdgcn_permlane32_swap(__float_as_uint(l_reg),__float_as_uint(l_reg),false,false);l_reg=__uint_as_float(rr[0])+__uint_as_float(rr[1]);}
  if(hi==0)wsf[32+r32]=l_reg;asm volatile("s_waitcnt lgkmcnt(0)":::"memory");
  float rli[16];
  #pragma unroll
  for(int r=0;r<16;++r)rli[r]=__builtin_amdgcn_rcpf(wsf[32+crow(r,hi)]);
  bf16*Ow=Ou+(long)(wid*QBLK)*pO;
  { bf16*stg=(bf16*)(shm+LDS_OST)+wid*2048;
    #pragma unroll
    for(int hf=0;hf<2;++hf){
      #pragma unroll
      for(int r=0;r<16;++r){const int orow=crow(r,hi);
        #pragma unroll
        for(int d0=0;d0<2;++d0)stg[orow*64+d0*32+r32]=__float2bfloat16(o[2*hf+d0][r]*rli[r]);}
      asm volatile("s_waitcnt lgkmcnt(0)":::"memory");
      #pragma unroll
      for(int i=0;i<4;++i){const int row=i*8+(lane>>3),ch=lane&7; const u32x4 v=*(const u32x4*)(stg+row*64+ch*8); ATTN_STORE16(Ow+(long)row*pO+hf*64+ch*8,v);}
      asm volatile("s_waitcnt lgkmcnt(0)":::"memory"); } }
  asm volatile("s_waitcnt lgkmcnt(0)\n\ts_barrier":::"memory");
  #undef DMA_K
  #undef DMA_V
  #undef CMASK
  #undef START
  #undef RESC
  #undef ROT
}
constexpr int ATTN_LDS_BYTES=LDS_BYTES;
#undef SBAR
#undef WAIT_BAR
}

constexpr int NWAVES = 8;
#ifndef MK_N_LAUNCHES
#define MK_N_LAUNCHES 1
#endif
constexpr int NPH = 10;
constexpr int BATCH = 32, SEQ = 2048, D = 1024, T = BATCH * SEQ, NMEM = 256, TM = BATCH * NMEM;
constexpr int INCOLS = 5120, PROJW = 2048, GATEW = 3072;
constexpr float RMS_EPS = 1e-6f;
constexpr int NEXP = 16, EH = 512;
constexpr int MAXROWS = 2 * T + NEXP * 256;
constexpr size_t MiB = 1u << 20;
constexpr size_t WS_CTL = 0, CTL_ZERO_BYTES = 64 * 1024;
constexpr size_t WS_WRF = 1 * MiB;
constexpr size_t WS_RINV = 1 * MiB + 128 * 1024;
constexpr size_t WS_WIN = 2 * MiB;
constexpr size_t WS_PC = 13 * MiB;
constexpr size_t WS_WO = 15 * MiB;
constexpr size_t WS_WGU = 17 * MiB;
constexpr size_t WS_WD = 49 * MiB;
constexpr size_t WS_ROUTE = 65 * MiB;
constexpr size_t WS_KV = 68 * MiB;
constexpr size_t WS_XN = 76 * MiB;
constexpr size_t WS_BR = 76 * MiB;
constexpr size_t WS_H2 = 76 * MiB;
constexpr size_t WS_PROJ = 220 * MiB;
constexpr size_t WS_MERGED = 220 * MiB;
constexpr size_t WS_HID = 220 * MiB;
constexpr size_t WS_ATTO = 476 * MiB;
constexpr size_t WS_GATES = 604 * MiB;
constexpr size_t WS_LIST = 476 * MiB;
constexpr size_t WS_RWE = 480 * MiB;
constexpr size_t WS_Y = 604 * MiB;
constexpr size_t WS_END = 988 * MiB;
static_assert(WS_XN + (size_t)(T + TM) * D * 2 <= WS_PROJ && WS_PROJ + (size_t)T * PROJW * 2 <= WS_ATTO && WS_ATTO + (size_t)T * D * 2 <= WS_GATES && WS_GATES + (size_t)T * GATEW * 2 <= WS_END, "ws map");
static_assert(WS_Y + (size_t)MAXROWS * D * 2 <= WS_END && WS_HID + (size_t)MAXROWS * EH * 2 <= WS_ATTO && WS_RWE + (size_t)NEXP * 65536 * 8 <= WS_GATES, "ws map 2");
constexpr int CW_CNT = 64;
constexpr int RING_OFF = 0, RING_BYTES = 131072;
constexpr int LDSX_OFF = RING_BYTES;
constexpr int LDS_BYTES = 147456;

#define GAS __attribute__((address_space(1)))
#define LAS __attribute__((address_space(3)))
typedef unsigned short bf16;
typedef unsigned v4u __attribute__((ext_vector_type(4)));
typedef unsigned v2u __attribute__((ext_vector_type(2)));
typedef float f32x4 __attribute__((ext_vector_type(4)));
#define LDS_WAIT() asm volatile("s_waitcnt lgkmcnt(0)" ::: "memory")
__device__ __forceinline__ unsigned f2bf(float f) { unsigned u = __builtin_bit_cast(unsigned, f); return (u + 0x7fffu + ((u >> 16) & 1u)) >> 16; }
__device__ __forceinline__ unsigned pk2(float lo, float hi) { return f2bf(lo) | (f2bf(hi) << 16); }
typedef float f32x2_t __attribute__((ext_vector_type(2))); typedef __bf16 bf16x2_t __attribute__((ext_vector_type(2)));
typedef short bf16x8_t __attribute__((ext_vector_type(8))); typedef float f32x16_t __attribute__((ext_vector_type(16)));
__device__ __forceinline__ unsigned cvtpk(float lo, float hi) { f32x2_t v = {lo, hi}; bf16x2_t b = __builtin_convertvector(v, bf16x2_t); return __builtin_bit_cast(unsigned, b); }
__device__ __forceinline__ float bflo(unsigned w) { return __uint_as_float(w << 16); }
__device__ __forceinline__ float bfhi(unsigned w) { return __uint_as_float(w & 0xffff0000u); }
__device__ __forceinline__ float wave_sum(float v) {
#pragma unroll
    for (int o = 1; o < 64; o <<= 1) v += __shfl_xor(v, o);
    return v;
}

typedef GAS unsigned gu32;
#define RLX_AGENT __ATOMIC_RELAXED, __HIP_MEMORY_SCOPE_AGENT
constexpr int CW_BAR = 4096;
constexpr int CW_TS = 128;
#define XB_TMO      128
#define XB_XCNT(j)  (256  + 64 * (j))
#define XB_XSUB(j)  (1280 + 64 * (j))
#define XB_XGEN(j)  (2304 + 64 * (j))
#define XB_TOP      3328
#define XB_TOPGEN   3392
#define XCD_BAR_WORDS 3456
#define XB_SPIN_CAP (1u << 18)

__device__ __forceinline__ unsigned xb_ld(unsigned* p)              { return __hip_atomic_load(p, __ATOMIC_RELAXED, __HIP_MEMORY_SCOPE_AGENT); }
__device__ __forceinline__ unsigned xb_add(unsigned* p, unsigned v) { return __hip_atomic_fetch_add(p, v, __ATOMIC_RELAXED, __HIP_MEMORY_SCOPE_AGENT); }
__device__ __forceinline__ unsigned xb_xcc_id() { return (unsigned)__builtin_amdgcn_s_getreg((3 << 11) | 20) & 0xFu; }
#define XB_SPIN(cond, bar) do { unsigned _sp = 0; while (cond) { __builtin_amdgcn_s_sleep(1); \
    if ((++_sp & 255u) == 0u) { if (xb_ld(&(bar)[XB_TMO])) break; if (_sp > XB_SPIN_CAP) { atomicAdd(&(bar)[XB_TMO], 1u); break; } } } } while (0)

struct XcdBarrier {
    unsigned* bar; unsigned x;
    volatile LAS unsigned* st;
};

__device__ __forceinline__ XcdBarrier xcd_barrier_post(unsigned* bar, volatile LAS unsigned* st) {
    XcdBarrier b; b.bar = bar; b.x = xb_xcc_id(); b.st = st;
    if (threadIdx.x == 0) (void)xb_add(&bar[XB_XCNT(b.x)], 1u);
    return b;
}
__device__ __forceinline__ void xcd_barrier_complete(unsigned* bar, unsigned x, unsigned& nloc, unsigned& nx) {
    const unsigned G = gridDim.x * gridDim.y * gridDim.z;
    unsigned sum, cnt, mine, sp = 0u;
    for (;;) {
        sum = 0u; cnt = 0u; mine = 0u;
#pragma unroll
        for (unsigned j = 0; j < 16; ++j) { const unsigned c = xb_ld(&bar[XB_XCNT(j)]); sum += c; cnt += (c > 0u) ? 1u : 0u; mine = (j == x) ? c : mine; }
        if (sum == G) break;
        __builtin_amdgcn_s_sleep(1);
        if ((++sp & 255u) == 0u) { if (xb_ld(&bar[XB_TMO])) break; if (sp > XB_SPIN_CAP) { atomicAdd(&bar[XB_TMO], 1u); break; } }
    }
    nloc = mine > 0u ? mine : 1u; nx = cnt > 0u ? cnt : 1u;
}

__device__ __forceinline__ void xcd_barrier(const XcdBarrier& b) {
    asm volatile("s_waitcnt vmcnt(0)" ::: "memory");
    __syncthreads();
    if (threadIdx.x == 0) {
        unsigned* bar = b.bar;
        __builtin_amdgcn_s_waitcnt(0);
        unsigned nloc = b.st[0], nx = b.st[1];
        if (nloc == 0u) { xcd_barrier_complete(bar, b.x, nloc, nx); b.st[0] = nloc; b.st[1] = nx; }
        const unsigned old = xb_add(&bar[XB_XSUB(b.x)], 1u);
        const unsigned gen = old / nloc;
        if (old + 1u == (gen + 1u) * nloc) {
            __builtin_amdgcn_fence(__ATOMIC_RELEASE, "agent");
            asm volatile("s_waitcnt vmcnt(0)" ::: "memory");
            const unsigned og = xb_add(&bar[XB_TOP], 1u);
            const unsigned tg = og / nx;
            if (og + 1u == (tg + 1u) * nx) xb_add(&bar[XB_TOPGEN], 1u);
            else XB_SPIN(xb_ld(&bar[XB_TOPGEN]) == tg, bar);
            __builtin_amdgcn_fence(__ATOMIC_ACQUIRE, "agent");
            xb_add(&bar[XB_XGEN(b.x)], 1u);
            asm volatile("s_waitcnt vmcnt(0)" ::: "memory");
        } else {
            XB_SPIN(xb_ld(&bar[XB_XGEN(b.x)]) == gen, bar);
            __builtin_amdgcn_fence(__ATOMIC_ACQUIRE, "agent");
            asm volatile("s_waitcnt vmcnt(0)" ::: "memory");
        }
    }
    __syncthreads();
}

struct Frame {
    LAS unsigned char* lds;
    unsigned* ctl;
    int vcu, G;
};

__device__ __forceinline__ void p0_tile(const float* W, int N, int k0, int n0, bf16* WT, int Kd, int drow0, LAS float* scr, int lane, const float* gk = nullptr) {
    f32x4 w[8];
#pragma unroll
    for (int i = 0; i < 8; ++i) w[i] = *(const GAS f32x4*)(W + (size_t)(k0 + i * 8 + (lane >> 3)) * N + n0 + (lane & 7) * 4);
    if (gk) {
#pragma unroll
        for (int i = 0; i < 8; ++i) w[i] = w[i] * gk[k0 + i * 8 + (lane >> 3)]; }
#pragma unroll
    for (int i = 0; i < 8; ++i) { LAS float* d = scr + (i * 8 + (lane >> 3)) * 33 + (lane & 7) * 4; d[0] = w[i].x; d[1] = w[i].y; d[2] = w[i].z; d[3] = w[i].w; }
    LDS_WAIT(); asm volatile("" ::: "memory");
    const int c = lane & 7;
#pragma unroll
    for (int j = 0; j < 4; ++j) { const int n = (lane >> 3) + 8 * j; const LAS float* s = scr + (8 * c) * 33 + n;
        v4u o; o.x = pk2(s[0 * 33], s[1 * 33]); o.y = pk2(s[2 * 33], s[3 * 33]); o.z = pk2(s[4 * 33], s[5 * 33]); o.w = pk2(s[6 * 33], s[7 * 33]);
        *(GAS v4u*)(WT + (size_t)(drow0 + n) * Kd + k0 + 8 * c) = o; }
    LDS_WAIT(); asm volatile("" ::: "memory");
}
__device__ __forceinline__ void p0_plain(const float* W, int K, int N, bf16* WT, int row_off, int item, LAS float* scr, int lane) {
    const int nblk = N / 32, kb = item / nblk, nb = item % nblk;
    p0_tile(W, N, 64 * kb, 32 * nb, WT, K, row_off + 32 * nb, scr, lane);
}
__device__ __forceinline__ void rms_row_to_bf16(const float* xrow, const float* g, bf16* orow, int lane) {
    const GAS f32x4* xr = (const GAS f32x4*)xrow + lane; const GAS f32x4* gr = (const GAS f32x4*)g + lane;
    f32x4 v[4]; float s = 0.f;
#pragma unroll
    for (int j = 0; j < 4; ++j) { v[j] = xr[64 * j]; s += (v[j].x * v[j].x + v[j].y * v[j].y) + (v[j].z * v[j].z + v[j].w * v[j].w); }
    const float r = 1.f / sqrtf(wave_sum(s) * (1.f / D) + RMS_EPS);
    GAS unsigned long long* o8 = (GAS unsigned long long*)orow + lane;
#pragma unroll
    for (int j = 0; j < 4; ++j) { const f32x4 gg = gr[64 * j]; const f32x4 h = v[j] * r * gg;
        o8[64 * j] = (unsigned long long)pk2(h.x, h.y) | ((unsigned long long)pk2(h.z, h.w) << 32); }
}

__device__ __forceinline__ void rms_rows_stream(const float* src1, const float* g1, const float* src2, const float* g2, int nT, int nAll, bf16* dst, int m0, int mstep, int lane) {
    f32x4 cur[4][4], nxt[4][4];
    if (m0 >= nAll) return;
    { const GAS f32x4* xr = (const GAS f32x4*)((m0 < nT ? src1 + (size_t)m0 * D : src2 + (size_t)(m0 - nT) * D)) + lane;
#pragma unroll
      for (int q = 0; q < 4; ++q)
#pragma unroll
          for (int j = 0; j < 4; ++j) cur[q][j] = xr[q * 256 + 64 * j]; }
    for (int m = m0; m < nAll; m += mstep) {
        const int mn = m + mstep; const bool has = mn < nAll; const int ml = has ? mn : m;
        { const GAS f32x4* xr = (const GAS f32x4*)((ml < nT ? src1 + (size_t)ml * D : src2 + (size_t)(ml - nT) * D)) + lane;
#pragma unroll
          for (int q = 0; q < 4; ++q)
#pragma unroll
              for (int j = 0; j < 4; ++j) nxt[q][j] = xr[q * 256 + 64 * j]; }
        float s[4];
#pragma unroll
        for (int q = 0; q < 4; ++q) { s[q] = 0.f;
#pragma unroll
            for (int j = 0; j < 4; ++j) s[q] += (cur[q][j].x * cur[q][j].x + cur[q][j].y * cur[q][j].y) + (cur[q][j].z * cur[q][j].z + cur[q][j].w * cur[q][j].w); }
#pragma unroll
        for (int o = 1; o < 64; o <<= 1) {
#pragma unroll
            for (int q = 0; q < 4; ++q) s[q] += __shfl_xor(s[q], o); }
        const GAS f32x4* gr = (const GAS f32x4*)(m < nT ? g1 : g2) + lane;
        f32x4 gg[4];
#pragma unroll
        for (int j = 0; j < 4; ++j) gg[j] = gr[64 * j];
#pragma unroll
        for (int q = 0; q < 4; ++q) { const float r = 1.f / sqrtf(s[q] * (1.f / D) + RMS_EPS);
            GAS unsigned long long* o8 = (GAS unsigned long long*)(dst + (size_t)(m + q) * D) + lane;
#pragma unroll
            for (int j = 0; j < 4; ++j) { const f32x4 h = cur[q][j] * r * gg[j]; o8[64 * j] = (unsigned long long)pk2(h.x, h.y) | ((unsigned long long)pk2(h.z, h.w) << 32); } }
#pragma unroll
        for (int q = 0; q < 4; ++q)
#pragma unroll
            for (int j = 0; j < 4; ++j) cur[q][j] = nxt[q][j];
    }
}

__device__ __forceinline__ void build_tile_tables(Frame& F, const int tid) {
    LAS int* TB = (LAS int*)(F.lds + LDSX_OFF); LAS unsigned char* t2e = F.lds + LDSX_OFF + 128;
    __syncthreads();
    if (tid == 0) { int acc = 0;
        for (int e = 0; e < NEXP; ++e) { const int n = (int)__hip_atomic_load(F.ctl + CW_CNT + e, __ATOMIC_RELAXED, __HIP_MEMORY_SCOPE_AGENT); TB[e] = acc; acc += (n + 255) >> 8; }
        TB[NEXP] = acc; }
    __syncthreads();
    for (int t = tid; t < 1024; t += NWAVES * 64) { int e = 0;
#pragma unroll
        for (int k = 1; k < NEXP; ++k) e += (t >= TB[k]) ? 1 : 0;
        t2e[t] = (unsigned char)e; }
    __syncthreads();
}

struct Args { const float* in[26]; float* out; unsigned char* ws; int ph_lo, ph_hi; };

__global__ void __launch_bounds__(NWAVES * 64, 2) hybrid_fwd(Args args) {
    extern __shared__ __attribute__((aligned(16))) unsigned char lds[];
    __builtin_assume(__builtin_amdgcn_workitem_id_y() == 0); __builtin_assume(__builtin_amdgcn_workitem_id_z() == 0);
    Frame F;
    F.lds = (LAS unsigned char*)lds;
    F.G = gridDim.x; { const int bx = blockIdx.x; F.vcu = (F.G % 8 == 0) ? (bx % 8) * (F.G / 8) + bx / 8 : bx; }
    F.ctl = (unsigned*)(args.ws + WS_CTL);
#define x_in (args.in[0])
#define mem_in (args.in[1])
#define norm_mix_g (args.in[2])
#define w_in (args.in[3])
#define pool_w (args.in[4])
#define pool_scale (args.in[5])
#define lam_q1 (args.in[6])
#define lam_k1 (args.in[7])
#define lam_q2 (args.in[8])
#define lam_k2 (args.in[9])
#define subln_g (args.in[10])
#define norm_mem_g (args.in[11])
#define w_mem_kv (args.in[12])
#define p_pool (args.in[13])
#define p_diff (args.in[14])
#define p_mem (args.in[15])
#define w_o (args.in[16])
#define norm_ffn_g (args.in[17])
#define w_rg (args.in[18])
#define b_rg (args.in[19])
#define w_re (args.in[20])
#define b_re (args.in[21])
#define w_eg (args.in[22])
#define w_eu (args.in[23])
#define w_ed (args.in[24])
#define final_g (args.in[25])
#define Win_t ((bf16*)(args.ws + WS_WIN))
#define Pc_t ((bf16*)(args.ws + WS_PC))
#define Wo_t ((bf16*)(args.ws + WS_WO))
#define Wgu_t ((bf16*)(args.ws + WS_WGU))
#define Wd_t ((bf16*)(args.ws + WS_WD))
#define KV ((bf16*)(args.ws + WS_KV))
#define XN ((bf16*)(args.ws + WS_XN))
#define BR ((bf16*)(args.ws + WS_BR))
#define H2 ((bf16*)(args.ws + WS_H2))
#define PROJ ((bf16*)(args.ws + WS_PROJ))
#define MERGED ((bf16*)(args.ws + WS_MERGED))
#define HID ((bf16*)(args.ws + WS_HID))
#define ATTO ((bf16*)(args.ws + WS_ATTO))
#define GATES ((bf16*)(args.ws + WS_GATES))
#define Y ((bf16*)(args.ws + WS_Y))
#define ROUTE ((v4u*)(args.ws + WS_ROUTE))
#define RWE ((float*)(args.ws + WS_RWE))
#define LIST ((int*)(args.ws + WS_LIST))
#define WRF ((bf16*)(args.ws + WS_WRF))
#define RINV ((float*)(args.ws + WS_RINV))
#define X1 (args.out)
    const int NGW = F.G * NWAVES;
#define PHASE_IDS int tid = threadIdx.x; asm volatile("" : "+v"(tid)); const int lane = tid & 63, wave = __builtin_amdgcn_readfirstlane(tid >> 6), gw = F.vcu * NWAVES + wave; (void)lane; (void)gw;
    const int lo = args.ph_lo, hi = args.ph_hi;
    cg::grid_group grid = cg::this_grid();
#ifndef PH_MASK
#define PH_MASK 0x3ff
#endif
#define IN(k) (((PH_MASK >> (k)) & 1) && lo <= (k) && (k) < hi)
#ifndef PROBE_A
#define PROBE_A -1
#endif
#ifndef PROBE_B
#define PROBE_B -1
#endif
#ifndef PROBE_A2
#define PROBE_A2 (PROBE_A + 1)
#endif
#ifndef PROBE_B2
#define PROBE_B2 (PROBE_B + 1)
#endif
#define STAMP(k) do { if ((PROBE_A >= 0 || PROBE_B >= 0) && blockIdx.x == 0 && threadIdx.x == 0) ((unsigned long long*)(F.ctl + CW_TS))[k] = __builtin_amdgcn_s_memrealtime(); } while (0)
#define SEAM(k) do { if (IN(k) && IN((k) + 1)) { if (hi > NPH) grid.sync(); else { XcdBarrier b_; b_.bar = (unsigned*)(args.ws + WS_CTL) + CW_BAR; b_.x = xb_xcc_id(); b_.st = (volatile LAS unsigned*)(F.lds + LDSX_OFF + 2048); xcd_barrier(b_); } } STAMP((k) + 1); } while (0)
    if (threadIdx.x < 2) ((LAS unsigned*)(F.lds + LDSX_OFF + 2048))[threadIdx.x] = 0u;
    __syncthreads();
    if (lo < hi - 1) (void)xcd_barrier_post((unsigned*)(args.ws + WS_CTL) + CW_BAR, (volatile LAS unsigned*)(F.lds + LDSX_OFF + 2048));
    STAMP(0);

    if (IN(0)) {
        PHASE_IDS
        LAS float* scr = (LAS float*)(F.lds + RING_OFF + wave * 16384);
        constexpr int I_IN = 16 * 160, I_KV = 16 * 16, I_PD = 8 * 32, I_PM = 4 * 32, I_WO = 16 * 32, I_EG = 16 * 256, I_EU = 16 * 256, I_ED = 16 * 256;
        constexpr int NITEMS = I_IN + I_KV + I_PD + I_PM + I_WO + I_EG + I_EU + I_ED;
        for (int it = gw; it < NITEMS; it += NGW) {
            int r = it;
            if (r < I_IN) { p0_plain(w_in, D, INCOLS, Win_t, 0, r, scr, lane); continue; } r -= I_IN;
            if (r < I_KV) { p0_plain(w_mem_kv, D, 512, Win_t, INCOLS, r, scr, lane); continue; } r -= I_KV;
            if (r < I_PD) { const int kb = r >> 5, nb = r & 31; p0_tile(p_diff, D, 64 * kb, 32 * nb, Pc_t + 256, D, 32 * nb, scr, lane); continue; } r -= I_PD;
            if (r < I_PM) { const int kb = r >> 5, nb = r & 31; p0_tile(p_mem, D, 64 * kb, 32 * nb, Pc_t + 768, D, 32 * nb, scr, lane); continue; } r -= I_PM;
            if (r < I_WO) { p0_plain(w_o, D, D, Wo_t, 0, r, scr, lane); continue; } r -= I_WO;
            if (r < I_EG + I_EU) { const bool up = r >= I_EG; if (up) r -= I_EG;
                const int e = r >> 8, rr = r & 255, kb = rr >> 4, nb = rr & 15, n0 = 32 * nb;
                p0_tile((up ? w_eu : w_eg) + (size_t)e * D * EH, EH, 64 * kb, n0, Wgu_t + (size_t)e * D * D, D, (n0 >> 7) * 256 + (n0 & 127) + (up ? 128 : 0), scr, lane, norm_ffn_g); continue; }
            r -= I_EG + I_EU;
            { const int e = r >> 8, rr = r & 255, kb = rr >> 5, nb = rr & 31;
              p0_tile(w_ed + (size_t)e * EH * D, D, 64 * kb, 32 * nb, Wd_t + (size_t)e * D * EH, EH, 32 * nb, scr, lane); }
        }
        STAMP(12);
        for (int idx = (F.vcu * NWAVES * 64 + tid); idx < 5120; idx += F.G * NWAVES * 64) {
            const int q = idx % 20, h = (idx / 20) & 1, hl = (idx / 40) & 1, st = idx / 80, k0 = 32 * (st >> 1) + 16 * h + 8 * (st & 1);
            float v[8];
#pragma unroll
            for (int j = 0; j < 8; ++j) { const int k = k0 + j; const float w = norm_ffn_g[k] * (q < 4 ? w_rg[k * 4 + q] : w_re[k * 16 + (q - 4)]); const float hi = bflo(f2bf(w) ); v[j] = hl ? (w - hi) : w; }
            v4u o; o.x = pk2(v[0], v[1]); o.y = pk2(v[2], v[3]); o.z = pk2(v[4], v[5]); o.w = pk2(v[6], v[7]);
            *((GAS v4u*)WRF + idx) = o;
        }
        for (int idx = (F.vcu * NWAVES * 64 + tid); idx < 256 * 1024; idx += F.G * NWAVES * 64) {
            const int kc = idx >> 10, n = idx & 1023, g = kc >> 6; float a = 0.f;
#pragma unroll 16
            for (int d = 0; d < 64; ++d) a += pool_w[kc * 64 + d] * pool_scale[g * 64 + d] * p_pool[(size_t)(g * 64 + d) * D + n];
            Pc_t[(size_t)n * D + kc] = (bf16)f2bf(a);
        }
        STAMP(13);
        rms_rows_stream(x_in, norm_mix_g, mem_in, norm_mem_g, T, T + TM, XN, gw * 4, NGW * 4, lane);
    }
    SEAM(0);

    if (IN(1)) {
        pg8::Gemm g{XN, Win_t, T, INCOLS, D};
        pg8::ProjOrder S; S.so.init(T, INCOLS, F.G, (int)blockIdx.x);
        pg8::EpiProj E{PROJ, GATES, KV, attn_body::C2};
        pg8::gemm_phase<pg8::EpiProj, pg8::ProjOrder, true, true>(F.lds + RING_OFF, g, S, E);
    }
    SEAM(1);

    if (IN(2)) {
        PHASE_IDS
        typedef attn_body::bf16 abf;
        struct DiffOrder { int vcu, G;
            __device__ __forceinline__ bool next(int i, int& bhm, int& qb) const { bhm = vcu + (i >> 3) * G; if (bhm >= BATCH * 8) return false; const int k = i & 7; qb = (k & 1) ? (k >> 1) : 7 - (k >> 1); return true; } };
        { const DiffOrder S{F.vcu, F.G}; int bhm, qb;
          for (int i = 0; S.next(i, bhm, qb); ++i) {
            const int b = bhm >> 3, h = (bhm >> 1) & 3, m = bhm & 1; const size_t rb = (size_t)b * SEQ;
            const attn2::bf16* Qu = (const attn2::bf16*)PROJ + (rb + qb * 256) * PROJW + 256 + h * 128 + m * 64;
            const attn2::bf16* Kh = (const attn2::bf16*)PROJ + rb * PROJW + 768 + h * 128 + m * 64;
            const attn2::bf16* Vh = (const attn2::bf16*)PROJ + rb * PROJW + 1280 + h * 128;
            attn2::bf16* Ou = (attn2::bf16*)ATTO + (rb + qb * 256) * D + m * 512 + h * 128;
            asm volatile("" : "+s"(Qu), "+s"(Kh), "+s"(Vh), "+s"(Ou));
            attn2::attn_unit<8, true>(Qu, PROJW, Kh, Vh, PROJW, Ou, D, 4 * (qb + 1), (char*)lds + RING_OFF); } }
        for (int mu = F.vcu; mu < BATCH * 8; mu += F.G) {
            const int b = mu >> 3, mh = (mu >> 1) & 3, half = mu & 1;
            const abf* Q0 = (const abf*)PROJ + ((size_t)b * SEQ + half * 1024) * PROJW + 1792 + mh * 64;
            const abf* Kh = (const abf*)KV + (size_t)b * NMEM * 512 + mh * 64;
            const abf* Vh = (const abf*)KV + (size_t)b * NMEM * 512 + 256 + mh * 64;
            abf* O0 = (abf*)BR + ((size_t)b * SEQ + half * 1024) * D + 768 + mh * 64;
            asm volatile("" : "+s"(Q0), "+s"(Kh), "+s"(Vh), "+s"(O0));
            attn_body::mem_attn(Q0, PROJW, Kh, Vh, 512, O0, D, 4, (char*)lds + RING_OFF); }
    }
    SEAM(2);

    if (IN(3)) {
        PHASE_IDS
        float lam;
        { const float s1 = wave_sum(lam_q1[lane] * lam_k1[lane]), s2 = wave_sum(lam_q2[lane] * lam_k2[lane]); lam = __expf(s1) - __expf(s2) + 0.2f; }
        const int gi = lane >> 4, w = 2 << gi;
        float sg[8];
#pragma unroll
        for (int i = 0; i < 8; ++i) sg[i] = subln_g[((8 * lane) & 127) + i] * 0.8f;
        for (int t = gw; t < T; t += NGW) {
            const int s = t & (SEQ - 1);
            const GAS v2u* up = (const GAS v2u*)(PROJ + (size_t)t * PROJW) + lane;
            const v2u ut = up[0];
            float a0 = 0.f, a1 = 0.f, a2 = 0.f, a3 = 0.f;
            const int nw = (w < s + 1) ? w : s + 1;
            v2u wq[16];
#pragma unroll
            for (int j = 0; j < 16; ++j) { wq[j] = (v2u){0u, 0u}; if (j < nw) wq[j] = *(const GAS v2u*)((const GAS bf16*)up - (size_t)j * PROJW); }
#pragma unroll
            for (int j = 0; j < 16; ++j) { a0 += bflo(wq[j].x); a1 += bfhi(wq[j].x); a2 += bflo(wq[j].y); a3 += bfhi(wq[j].y); }
            const float inv = 1.f / (float)nw;
            v2u po; po.x = pk2(a0 * inv - bflo(ut.x), a1 * inv - bfhi(ut.x)); po.y = pk2(a2 * inv - bflo(ut.y), a3 * inv - bfhi(ut.y));
            *((GAS v2u*)(BR + (size_t)t * D) + lane) = po;
            const v4u o0 = *((const GAS v4u*)(ATTO + (size_t)t * D) + lane), o1 = *((const GAS v4u*)(ATTO + (size_t)t * D + 512) + lane);
            float xv[8];
            xv[0] = bflo(o0.x) - lam * bflo(o1.x); xv[1] = bfhi(o0.x) - lam * bfhi(o1.x); xv[2] = bflo(o0.y) - lam * bflo(o1.y); xv[3] = bfhi(o0.y) - lam * bfhi(o1.y);
            xv[4] = bflo(o0.z) - lam * bflo(o1.z); xv[5] = bfhi(o0.z) - lam * bfhi(o1.z); xv[6] = bflo(o0.w) - lam * bflo(o1.w); xv[7] = bfhi(o0.w) - lam * bfhi(o1.w);
            float ss = 0.f;
#pragma unroll
            for (int i = 0; i < 8; ++i) ss += xv[i] * xv[i];
            ss += __shfl_xor(ss, 1); ss += __shfl_xor(ss, 2); ss += __shfl_xor(ss, 4); ss += __shfl_xor(ss, 8);
            const float r = 1.f / sqrtf(ss * (1.f / 128.f) + RMS_EPS);
            v4u od; od.x = pk2(xv[0] * r * sg[0], xv[1] * r * sg[1]); od.y = pk2(xv[2] * r * sg[2], xv[3] * r * sg[3]); od.z = pk2(xv[4] * r * sg[4], xv[5] * r * sg[5]); od.w = pk2(xv[6] * r * sg[6], xv[7] * r * sg[7]);
            *((GAS v4u*)(BR + (size_t)t * D + 256) + lane) = od;
        }
    }
    SEAM(3);

    if (IN(4)) {
        pg8::StaticOrder S; S.init(T, D, F.G, (int)blockIdx.x);
        pg8::Gemm g{BR, Pc_t, T, D, D}; pg8::EpiMerge E{GATES, MERGED}; pg8::MidRescale MH{GATES};
        pg8::gemm_phase<pg8::EpiMerge, pg8::StaticOrder, true, true, pg8::MidRescale>(F.lds + RING_OFF, g, S, E, MH);
    }
    SEAM(4);

    if (IN(5)) {
        pg8::Gemm g{MERGED, Wo_t, T, D, D}; pg8::StaticOrder S; S.init(T, D, F.G, (int)blockIdx.x);
        pg8::EpiWo E{x_in, X1};
        pg8::gemm_phase<pg8::EpiWo, pg8::StaticOrder, true, true>(F.lds + RING_OFF, g, S, E);
    }
    SEAM(5);

    if (IN(6)) {
        PHASE_IDS
        LAS v4u* WL = (LAS v4u*)(F.lds + RING_OFF);
        LAS float* SC = (LAS float*)(F.lds + RING_OFF + 81920) + wave * 1024;
        LAS v4u* REC = (LAS v4u*)(F.lds + RING_OFF + 81920 + 32768);
        LAS unsigned* LCNT = (LAS unsigned*)(F.lds + RING_OFF + 81920 + 32768 + 4096);
        LAS unsigned* LBASE = LCNT + 16; LAS float* RIL = (LAS float*)(LCNT + 32);
        for (int idx = tid; idx < 5120; idx += NWAVES * 64) WL[idx] = *((const GAS v4u*)WRF + idx);
        float bg[4], be[16];
#pragma unroll
        for (int i = 0; i < 4; ++i) bg[i] = b_rg[i];
#pragma unroll
        for (int i = 0; i < 16; ++i) be[i] = b_re[i];
        const int r32 = lane & 31, hh = lane >> 5;
        for (int rb0 = F.vcu * 256; rb0 < T; rb0 += F.G * 256) {
            if (tid < 16) LCNT[tid] = 0u;
            __syncthreads();
            const int li = wave * 32 + r32, row = rb0 + li;
            const GAS f32x4* xp = (const GAS f32x4*)(X1 + (size_t)row * D + 16 * hh);
            GAS v4u* hp = (GAS v4u*)(H2 + (size_t)row * D + 16 * hh);
            const LAS v4u* wl = WL + hh * 20 + r32;
            f32x16_t acc = {}; float ss = 0.f;
            f32x4 cur[8];
#pragma unroll
            for (int i = 0; i < 8; ++i) cur[i] = xp[(i >> 2) * 8 + (i & 3)];
#pragma unroll 1
            for (int sp2 = 0; sp2 < 16; ++sp2) {
                f32x4 nxt[8];
                const int spn = (sp2 + 1 < 16) ? sp2 + 1 : sp2;
#pragma unroll
                for (int i = 0; i < 8; ++i) nxt[i] = xp[(2 * spn + (i >> 2)) * 8 + (i & 3)];
#pragma unroll
                for (int u = 0; u < 2; ++u) { const int sp = 2 * sp2 + u;
                    v4u ahi[2], alo[2];
#pragma unroll
                    for (int e = 0; e < 2; ++e) { const f32x4 a = cur[4 * u + 2 * e], b = cur[4 * u + 2 * e + 1];
                        ss += (a.x * a.x + a.y * a.y) + (a.z * a.z + a.w * a.w) + (b.x * b.x + b.y * b.y) + (b.z * b.z + b.w * b.w);
                        v4u h; h.x = cvtpk(a.x, a.y); h.y = cvtpk(a.z, a.w); h.z = cvtpk(b.x, b.y); h.w = cvtpk(b.z, b.w); ahi[e] = h;
                        v4u l; l.x = cvtpk(a.x - bflo(h.x), a.y - bfhi(h.x)); l.y = cvtpk(a.z - bflo(h.y), a.w - bfhi(h.y)); l.z = cvtpk(b.x - bflo(h.z), b.y - bfhi(h.z)); l.w = cvtpk(b.z - bflo(h.w), b.w - bfhi(h.w)); alo[e] = l; }
                    hp[sp * 4] = ahi[0]; hp[sp * 4 + 1] = ahi[1];
#pragma unroll
                    for (int e = 0; e < 2; ++e) { const int st = 2 * sp + e;
                        v4u bh = {0u, 0u, 0u, 0u}, bl = {0u, 0u, 0u, 0u};
                        if (r32 < 20) { bh = wl[(st * 4) * 20]; bl = wl[(st * 4 + 2) * 20]; }
                        acc = __builtin_amdgcn_mfma_f32_32x32x16_bf16(__builtin_bit_cast(bf16x8_t, ahi[e]), __builtin_bit_cast(bf16x8_t, bh), acc, 0, 0, 0);
                        acc = __builtin_amdgcn_mfma_f32_32x32x16_bf16(__builtin_bit_cast(bf16x8_t, alo[e]), __builtin_bit_cast(bf16x8_t, bh), acc, 0, 0, 0);
                        acc = __builtin_amdgcn_mfma_f32_32x32x16_bf16(__builtin_bit_cast(bf16x8_t, ahi[e]), __builtin_bit_cast(bf16x8_t, bl), acc, 0, 0, 0); } }
#pragma unroll
                for (int i = 0; i < 8; ++i) cur[i] = nxt[i];
            }
            ss += __shfl_xor(ss, 32);
            const float rinv = 1.f / sqrtf(ss * (1.f / D) + RMS_EPS);
#pragma unroll
            for (int r = 0; r < 16; ++r) SC[((r & 3) + 8 * (r >> 2) + 4 * hh) * 32 + r32] = acc[r];
            LDS_WAIT();
            if (lane < 32) {
                float lg[20];
#pragma unroll
                for (int q4 = 0; q4 < 5; ++q4) { const f32x4 t4 = *(const LAS f32x4*)(SC + lane * 32 + 4 * q4); lg[4 * q4] = t4.x * rinv; lg[4 * q4 + 1] = t4.y * rinv; lg[4 * q4 + 2] = t4.z * rinv; lg[4 * q4 + 3] = t4.w * rinv; }
                float gl[4];
#pragma unroll
                for (int i = 0; i < 4; ++i) gl[i] = lg[i] + bg[i];
                int gidx = 0; float gmax = gl[0];
#pragma unroll
                for (int i = 1; i < 4; ++i) if (gl[i] > gmax) { gmax = gl[i]; gidx = i; }
                float gsum = 0.f;
#pragma unroll
                for (int i = 0; i < 4; ++i) gsum += __expf(gl[i] - gmax);
                const float gp = 1.f / gsum;
                float el[4];
#pragma unroll
                for (int j = 0; j < 4; ++j) { const float l0 = lg[4 + j] + be[j], l1 = lg[8 + j] + be[4 + j], l2 = lg[12 + j] + be[8 + j], l3 = lg[16 + j] + be[12 + j];
                    el[j] = gidx == 0 ? l0 : gidx == 1 ? l1 : gidx == 2 ? l2 : l3; }
                int i0 = 0; float m0 = el[0];
#pragma unroll
                for (int j = 1; j < 4; ++j) if (el[j] > m0) { m0 = el[j]; i0 = j; }
                int i1 = -1; float m1 = -3.0e38f;
#pragma unroll
                for (int j = 0; j < 4; ++j) if (j != i0 && el[j] > m1) { m1 = el[j]; i1 = j; }
                if (i1 < 0) { i1 = (i0 + 1) & 3; m1 = m0; }
                const float p1 = __expf(m1 - m0);
                const float w0 = gp / (1.f + p1), w1 = gp * p1 / (1.f + p1);
                const unsigned e0 = (unsigned)(gidx * 4 + i0), e1 = (unsigned)(gidx * 4 + i1);
                const unsigned s0 = __hip_atomic_fetch_add(LCNT + e0, 1u, __ATOMIC_RELAXED, __HIP_MEMORY_SCOPE_WORKGROUP), s1 = __hip_atomic_fetch_add(LCNT + e1, 1u, __ATOMIC_RELAXED, __HIP_MEMORY_SCOPE_WORKGROUP);
                v4u rc; rc.x = (e0 << 20) | s0; rc.y = (e1 << 20) | s1; rc.z = __float_as_uint(w0); rc.w = __float_as_uint(w1); REC[li] = rc;
                RINV[row] = rinv; RIL[li] = rinv;
            }
            __syncthreads();
            if (tid < 16) LBASE[tid] = __hip_atomic_fetch_add(F.ctl + CW_CNT + tid, LCNT[tid], __ATOMIC_RELAXED, __HIP_MEMORY_SCOPE_AGENT);
            __syncthreads();
            if (tid < 256) { v4u rc = REC[tid]; rc.x += LBASE[rc.x >> 20]; rc.y += LBASE[rc.y >> 20]; *((GAS v4u*)ROUTE + rb0 + tid) = rc;
                const unsigned i0 = ((rc.x >> 20) << 16) + (rc.x & 0xFFFFFu), i1 = ((rc.y >> 20) << 16) + (rc.y & 0xFFFFFu); const float ri = RIL[tid];
                LIST[i0] = rb0 + tid; LIST[i1] = rb0 + tid; RWE[2 * i0] = ri; RWE[2 * i0 + 1] = __uint_as_float(rc.z); RWE[2 * i1] = ri; RWE[2 * i1 + 1] = __uint_as_float(rc.w); }
            __syncthreads();
        }
    }
    SEAM(6);

    if (IN(7)) {
        PHASE_IDS
        build_tile_tables(F, tid);
        const LAS int* TB = (const LAS int*)(F.lds + LDSX_OFF); const LAS unsigned char* t2e = (const LAS unsigned char*)(F.lds + LDSX_OFF + 128);
        LAS int* TOKL = (LAS int*)(F.lds + LDSX_OFF + 4096);
        const int nunits = TB[NEXP] * 4;
        for (int i = 0; i < 11; ++i) { const int L = i * F.G + F.vcu; if (L >= nunits) break;
            const int pm = L >> 2, e = t2e[pm], lt = pm - TB[e];
            if (tid < 256) { unsigned tok = (unsigned)LIST[(e << 16) + lt * 256 + tid]; tok = tok < (unsigned)T ? tok : (unsigned)(T - 1); TOKL[i * 256 + tid] = (int)tok; } }
        __syncthreads();
        pg8::Gemm g{H2, Wgu_t, T, NEXP * D, D};
        pg8::MoeOrder S{t2e, nunits, F.G, F.vcu};
        pg8::EpiGateUp E{HID, RWE, TB};
        pg8::gemm_phase<pg8::EpiGateUp, pg8::MoeOrder, true, true, pg8::NoMid, true>(F.lds + RING_OFF, g, S, E, pg8::NoMid(), TOKL);
    }
    SEAM(7);

    if (IN(8)) {
        PHASE_IDS
        build_tile_tables(F, tid);
        const LAS int* TB = (const LAS int*)(F.lds + LDSX_OFF);
        pg8::Gemm g{HID, Wd_t, MAXROWS, NEXP * D, EH};
        pg8::MoeOrder S{(const LAS unsigned char*)(F.lds + LDSX_OFF + 128), TB[NEXP] * 4, F.G, F.vcu};
        pg8::EpiDown E{Y};
        pg8::gemm_phase<pg8::EpiDown, pg8::MoeOrder, true, true>(F.lds + RING_OFF, g, S, E);
    }
    SEAM(8);

    if (IN(9)) {
        PHASE_IDS
        build_tile_tables(F, tid);
        const LAS int* TB = (const LAS int*)(F.lds + LDSX_OFF);
        for (int t = gw; t < T; t += NGW) {
            const v4u rc = *((const GAS v4u*)ROUTE + t);
            const size_t r0 = (size_t)TB[rc.x >> 20] * 256 + (rc.x & 0xFFFFFu), r1 = (size_t)TB[rc.y >> 20] * 256 + (rc.y & 0xFFFFFu);
            GAS f32x4* xr = (GAS f32x4*)(X1 + (size_t)t * D) + lane; const GAS f32x4* gr = (const GAS f32x4*)final_g + lane;
            const GAS v2u* y0 = (const GAS v2u*)(Y + r0 * D) + lane; const GAS v2u* y1 = (const GAS v2u*)(Y + r1 * D) + lane;
            f32x4 v[4]; float s = 0.f;
#pragma unroll
            for (int j = 0; j < 4; ++j) { v[j] = xr[64 * j]; const v2u a = y0[64 * j], b = y1[64 * j];
                v[j].x += bflo(a.x) + bflo(b.x); v[j].y += bfhi(a.x) + bfhi(b.x); v[j].z += bflo(a.y) + bflo(b.y); v[j].w += bfhi(a.y) + bfhi(b.y);
                s += (v[j].x * v[j].x + v[j].y * v[j].y) + (v[j].z * v[j].z + v[j].w * v[j].w); }
            const float r = 1.f / sqrtf(wave_sum(s) * (1.f / D) + RMS_EPS);
#pragma unroll
            for (int j = 0; j < 4; ++j) { f32x4 o = v[j] * r * gr[64 * j];
                if (PROBE_B >= 0 && blockIdx.x == 0 && (t / NGW) < 8) {
                    const unsigned long long* ts = (const unsigned long long*)(F.ctl + CW_TS); const float amp = sqrtf((float)((ts[PROBE_B2] - ts[PROBE_B]) / 100) * 1e-3f);
                    o.x += amp; o.y += amp; o.z += amp; o.w += amp; }
                xr[64 * j] = o; }
        }
        STAMP(10);
        if (PROBE_A >= 0 && blockIdx.x == 0 && threadIdx.x == 0) {
            const unsigned long long* ts = (const unsigned long long*)(F.ctl + CW_TS);
            X1[0] += 4.f + (float)((ts[PROBE_A2] - ts[PROBE_A]) / 100) * 0.01f; }
    }
#undef IN
#undef SEAM
#undef STAMP
#undef PHASE_IDS
#undef x_in
#undef mem_in
#undef norm_mix_g
#undef w_in
#undef pool_w
#undef pool_scale
#undef lam_q1
#undef lam_k1
#undef lam_q2
#undef lam_k2
#undef subln_g
#undef norm_mem_g
#undef w_mem_kv
#undef p_pool
#undef p_diff
#undef p_mem
#undef w_o
#undef norm_ffn_g
#undef w_rg
#undef b_rg
#undef w_re
#undef b_re
#undef w_eg
#undef w_eu
#undef w_ed
#undef final_g
#undef Win_t
#undef Pc_t
#undef Wo_t
#undef Wgu_t
#undef Wd_t
#undef KV
#undef XN
#undef BR
#undef H2
#undef PROJ
#undef MERGED
#undef HID
#undef ATTO
#undef GATES
#undef Y
#undef ROUTE
#undef RWE
#undef LIST
#undef WRF
#undef RINV
#undef X1
}

extern "C" void kernel_launch(void* const* d_in, const int* in_sizes, int n_in, void* d_out, int out_size, void* d_ws, size_t ws_size, hipStream_t stream) {
    static int grid = 0;
    if (grid == 0) {
        if (n_in != 26 || in_sizes[0] != T * D || out_size != T * D || ws_size < WS_END) { fprintf(stderr, "kernel_launch: unexpected problem: n_in %d in0 %d out %d ws %zu (need %zu)\n", n_in, n_in > 0 ? in_sizes[0] : -1, out_size, ws_size, (size_t)WS_END); grid = -1; return; }
        int dev = 0, cus = 0, per_cu = 0;
        if (hipGetDevice(&dev) != hipSuccess || hipDeviceGetAttribute(&cus, hipDeviceAttributeMultiprocessorCount, dev) != hipSuccess) { fprintf(stderr, "kernel_launch: device query failed\n"); grid = -1; return; }
        if (hipFuncSetAttribute((const void*)hybrid_fwd, hipFuncAttributeMaxDynamicSharedMemorySize, LDS_BYTES) != hipSuccess) { fprintf(stderr, "kernel_launch: hipFuncSetAttribute failed\n"); grid = -1; return; }
        if (hipOccupancyMaxActiveBlocksPerMultiprocessor(&per_cu, (const void*)hybrid_fwd, NWAVES * 64, LDS_BYTES) != hipSuccess || per_cu < 1) { fprintf(stderr, "kernel_launch: occupancy query says %d blocks per CU\n", per_cu); grid = -1; return; }
        (void)hipGetLastError();
        grid = cus;
        if (grid > 256) grid = 256;
    }
    if (grid < 0) return;
    if (hipMemsetAsync((char*)d_ws + WS_CTL, 0, CTL_ZERO_BYTES, stream) != hipSuccess) { fprintf(stderr, "kernel_launch: memset failed\n"); return; }
    Args a{};
    for (int i = 0; i < 26; ++i) a.in[i] = (const float*)d_in[i];
    a.out = (float*)d_out; a.ws = (unsigned char*)d_ws;
#if MK_N_LAUNCHES == 1
    a.ph_lo = 0; a.ph_hi = NPH;
    void* kargs[] = {&a};
    hipError_t e = hipLaunchCooperativeKernel((const void*)hybrid_fwd, dim3(grid), dim3(NWAVES * 64), kargs, LDS_BYTES, stream);
    if (e != hipSuccess) fprintf(stderr, "kernel_launch: cooperative launch failed: %s (grid %d)\n", hipGetErrorString(e), grid);
#else
    for (int p = 0; p < NPH; ++p) { a.ph_lo = p; a.ph_hi = p + 1;
        hipLaunchKernelGGL(hybrid_fwd, dim3(grid), dim3(NWAVES * 64), LDS_BYTES, stream, a);
        const hipError_t le = hipPeekAtLastError(); if (le != hipSuccess) { fprintf(stderr, "kernel_launch: launch %d failed: %s\n", p, hipGetErrorName(le)); break; } }
#endif
}
```

```cpp
#include <hip/hip_runtime.h>
#include <hip/hip_cooperative_groups.h>
#include <cstdio>
#include <cstdint>
namespace cg = cooperative_groups;
namespace pg8 {
#define PG8_LAS __attribute__((address_space(3)))
typedef unsigned short bf16_t;
typedef short bf16x8 __attribute__((ext_vector_type(8)));
typedef float f32x4 __attribute__((ext_vector_type(4)));
typedef unsigned u32x4 __attribute__((ext_vector_type(4)));
constexpr int BM = 256, BK = 64, HALF = 128, HTB = HALF * BK * 2  , STAGE_BYTES = 8 * HTB, NXCD = 8, WGM = 8;

__host__ __device__ __forceinline__ int lds_byte(int r, int c) { const int st = (r >> 4) * 2 + (c >> 5), rr = r & 15, cc = c & 31, ob = rr * 64 + cc * 2; return st * 1024 + (ob ^ (((ob >> 9) & 1) << 5)); }
__host__ __device__ __forceinline__ void stage_rc(int b, int& R, int& C) { const int st = b / 1024, sb = b % 1024, swz = sb ^ (((sb >> 9) & 1) << 5); R = (st >> 1) * 16 + swz / 64; C = (st & 1) * 32 + (swz % 64) / 2; }
__host__ __device__ __forceinline__ int perm32(int rho) { const int n = rho >> 4, i = rho & 15; return 8 * (i >> 2) + 4 * n + (i & 3); }

struct Unit { int pm, pn; };
struct Gemm { const bf16_t* A; const bf16_t* Bt; int M, N, K; };

struct StaticOrder {
    int nM, nN, nwg, G, c;
    __host__ __device__ void init(int M, int N, int G_, int c_) { nM = M / BM; nN = N / BM; nwg = nM * nN; G = G_; c = c_; }
    __host__ __device__ bool next(int i, Unit& u) const {
        const long L = (long)i * G + c; if (L >= nwg) return false;
        int wgid = (int)L; { const int q = nwg / NXCD, r = nwg % NXCD, xcd = wgid % NXCD, off = wgid / NXCD; wgid = (xcd < r ? xcd * (q + 1) : r * (q + 1) + (xcd - r) * q) + off; }
        const int nig = WGM * nN, gid = wgid / nig, fm = gid * WGM, gsz = (nM - fm) < WGM ? (nM - fm) : WGM;
        u.pm = fm + ((wgid % nig) % gsz); u.pn = (wgid % nig) / gsz; return true;
    }
    __device__ __forceinline__ void a_ready(const Unit&) const {}
    __device__ __forceinline__ void done(const Unit&) const {}
};

__device__ __forceinline__ unsigned cvt_pk_bf16(float lo, float hi) { unsigned r; asm volatile("v_cvt_pk_bf16_f32 %0, %1, %2" : "=v"(r) : "v"(lo), "v"(hi)); return r; }
typedef unsigned u32x2 __attribute__((ext_vector_type(2)));
__device__ __forceinline__ float bf_lo(unsigned w) { return __uint_as_float(w << 16); }
__device__ __forceinline__ float bf_hi(unsigned w) { return __uint_as_float(w & 0xffff0000u); }
__device__ __forceinline__ float sigmoid_f(float x) { return __builtin_amdgcn_rcpf(1.0f + __builtin_amdgcn_exp2f(-1.4426950408889634f * x)); }
__device__ __forceinline__ u32x4 pack8(const f32x4 a, const f32x4 b) { u32x4 w; w.x = cvt_pk_bf16(a[0], a[1]); w.y = cvt_pk_bf16(a[2], a[3]); w.z = cvt_pk_bf16(b[0], b[1]); w.w = cvt_pk_bf16(b[2], b[3]); return w; }

struct ProjOrder {
    StaticOrder so;
    __device__ __forceinline__ bool next(int i, Unit& u) const {
        const long L = (long)i * so.G + so.c;
        if (L < so.nwg) return so.next(i, u);
        const int x = (int)(L - so.nwg); if (x >= 64) return false;
        u.pm = 256 + (x >> 1); u.pn = 20 + (x & 1); return true;
    }
    __device__ __forceinline__ void a_ready(const Unit&) const {}
    __device__ __forceinline__ void done(const Unit&) const {}
};
struct MoeOrder {
    const PG8_LAS unsigned char* t2e; int nunits, G, c;
    __device__ __forceinline__ bool next(int i, Unit& u) const {
        const int L = i * G + c; if (L >= nunits) return false;
        const int pm = L >> 2; u.pm = pm; u.pn = (int)t2e[pm] * 4 + (L & 3); return true;
    }
    __device__ __forceinline__ void a_ready(const Unit&) const {}
    __device__ __forceinline__ void done(const Unit&) const {}
};

struct EpiProj {
    static constexpr bool PERM = true, AFTER_DRAIN = false;
    bf16_t* PROJ; bf16_t* GATES; bf16_t* KV; float qscale;
    __device__ __forceinline__ void operator()(const f32x4 (&acc)[2][2][4][2], const Unit& u, int wr, int wc, int fr, int fq) const {
        bf16_t* base; int ldc, colt, mode = 0; float sc = 1.f; int rowt = u.pm * BM;
        if (u.pm >= 256) { base = KV; ldc = 512; colt = (u.pn - 20) * BM; rowt -= 65536; }
        else if (u.pn < 8) { base = PROJ; ldc = 2048; colt = u.pn * BM; if (u.pn == 1 || u.pn == 2 || u.pn == 7) sc = qscale; }
        else { base = GATES; ldc = 3072; colt = (u.pn - 8) * BM; mode = 1; }
        const int row0 = rowt + wr * 64 + fr, col0 = colt + wc * 32 + 8 * fq;
#pragma unroll
        for (int ai = 0; ai < 2; ++ai)
#pragma unroll
            for (int m = 0; m < 4; ++m) { bf16_t* rowp = base + (size_t)(row0 + ai * HALF + m * 16) * ldc + col0;
#pragma unroll
                for (int bj = 0; bj < 2; ++bj) { f32x4 v0 = acc[ai][bj][m][0], v1 = acc[ai][bj][m][1];
                    if (mode) {
#pragma unroll
                        for (int i = 0; i < 4; ++i) { v0[i] = sigmoid_f(v0[i]); v1[i] = sigmoid_f(v1[i]); } }
                    else { v0 = v0 * sc; v1 = v1 * sc; }
                    *(u32x4*)(rowp + bj * HALF) = pack8(v0, v1); } }
    }
};
__device__ __forceinline__ float gclamp(float g) { return __builtin_fmaxf(g, 1e-18f); }
struct MidRescale {
    static constexpr bool ON = true; static constexpr int T0 = 4, T1 = 12;
    const bf16_t* GATES;
    __device__ __forceinline__ void operator()(f32x4 (&acc)[2][2][4][2], const Unit& u, int t, int wr, int wc, int fr, int fq) const {
        int fr_ = fr; asm volatile("" : "+v"(fr_));
        const int row0 = u.pm * BM + wr * 64 + fr_, col0 = u.pn * BM + wc * 32 + 8 * fq; const int gprev = (t == T0) ? 0 : 1024;
        const unsigned off0 = ((unsigned)row0 * 3072u + (unsigned)(gprev + col0)) * 2u;
#pragma unroll
        for (int ai = 0; ai < 2; ++ai) {
            u32x4 ga[4][2], gb[4][2];
#pragma unroll
            for (int m = 0; m < 4; ++m) { const char* gp = (const char*)GATES + (off0 + (unsigned)((ai * HALF + m * 16) * 3072 * 2));
#pragma unroll
                for (int bj = 0; bj < 2; ++bj) { ga[m][bj] = *(const u32x4*)(gp + bj * HALF * 2); gb[m][bj] = *(const u32x4*)(gp + 2048 + bj * HALF * 2); } }
#pragma unroll
            for (int m = 0; m < 4; ++m)
#pragma unroll
                for (int bj = 0; bj < 2; ++bj) { const u32x4 a = ga[m][bj], b = gb[m][bj];
                    f32x4 r0, r1;
                    r0[0] = bf_lo(a.x) * __builtin_amdgcn_rcpf(gclamp(bf_lo(b.x))); r0[1] = bf_hi(a.x) * __builtin_amdgcn_rcpf(gclamp(bf_hi(b.x)));
                    r0[2] = bf_lo(a.y) * __builtin_amdgcn_rcpf(gclamp(bf_lo(b.y))); r0[3] = bf_hi(a.y) * __builtin_amdgcn_rcpf(gclamp(bf_hi(b.y)));
                    r1[0] = bf_lo(a.z) * __builtin_amdgcn_rcpf(gclamp(bf_lo(b.z))); r1[1] = bf_hi(a.z) * __builtin_amdgcn_rcpf(gclamp(bf_hi(b.z)));
                    r1[2] = bf_lo(a.w) * __builtin_amdgcn_rcpf(gclamp(bf_lo(b.w))); r1[3] = bf_hi(a.w) * __builtin_amdgcn_rcpf(gclamp(bf_hi(b.w)));
                    acc[ai][bj][m][0] = acc[ai][bj][m][0] * r0; acc[ai][bj][m][1] = acc[ai][bj][m][1] * r1; }
            asm volatile("" ::: "memory"); }
    }
};
struct EpiMerge {
    static constexpr bool PERM = true, AFTER_DRAIN = false;
    const bf16_t* GATES; bf16_t* MERGED;
    __device__ __forceinline__ void operator()(const f32x4 (&acc)[2][2][4][2], const Unit& u, int wr, int wc, int fr, int fq) const {
        const int row0 = u.pm * BM + wr * 64 + fr, col0 = u.pn * BM + wc * 32 + 8 * fq;
        const unsigned off0 = ((unsigned)row0 * 3072u + (unsigned)(2048 + col0)) * 2u;
        u32x4 gg[2][4][2];
#pragma unroll
        for (int ai = 0; ai < 2; ++ai)
#pragma unroll
            for (int m = 0; m < 4; ++m)
#pragma unroll
                for (int bj = 0; bj < 2; ++bj) gg[ai][m][bj] = *(const u32x4*)((const char*)GATES + (off0 + (unsigned)((ai * HALF + m * 16) * 3072 * 2)) + bj * HALF * 2);
#pragma unroll
        for (int ai = 0; ai < 2; ++ai)
#pragma unroll
            for (int m = 0; m < 4; ++m) { const size_t r = (size_t)(row0 + ai * HALF + m * 16);
#pragma unroll
                for (int bj = 0; bj < 2; ++bj) { const int c = col0 + bj * HALF; const u32x4 g = gg[ai][m][bj];
                    f32x4 v0 = acc[ai][bj][m][0], v1 = acc[ai][bj][m][1];
                    v0[0] *= gclamp(bf_lo(g.x)); v0[1] *= gclamp(bf_hi(g.x)); v0[2] *= gclamp(bf_lo(g.y)); v0[3] *= gclamp(bf_hi(g.y));
                    v1[0] *= gclamp(bf_lo(g.z)); v1[1] *= gclamp(bf_hi(g.z)); v1[2] *= gclamp(bf_lo(g.w)); v1[3] *= gclamp(bf_hi(g.w));
                    *(u32x4*)(MERGED + r * 1024 + c) = pack8(v0, v1); } }
    }
};
struct EpiMix {
    static constexpr bool PERM = true, AFTER_DRAIN = false;
    bf16_t* MIX;
    __device__ __forceinline__ void operator()(const f32x4 (&acc)[2][2][4][2], const Unit& u, int wr, int wc, int fr, int fq) const {
        const int row0 = u.pm * BM + wr * 64 + fr, col0 = u.pn * BM + wc * 32 + 8 * fq;
#pragma unroll
        for (int ai = 0; ai < 2; ++ai)
#pragma unroll
            for (int m = 0; m < 4; ++m) { bf16_t* rowp = MIX + (size_t)(row0 + ai * HALF + m * 16) * 1024 + col0;
#pragma unroll
                for (int bj = 0; bj < 2; ++bj) *(u32x4*)(rowp + bj * HALF) = pack8(acc[ai][bj][m][0], acc[ai][bj][m][1]); }
    }
};
struct EpiWo {
    static constexpr bool PERM = false, AFTER_DRAIN = false;
    const float* X; float* X1;
    __device__ __forceinline__ void operator()(const f32x4 (&acc)[2][2][4][2], const Unit& u, int wr, int wc, int fr, int fq) const {
        const int row0 = u.pm * BM + wr * 64 + fr, col0 = u.pn * BM + wc * 32 + 4 * fq;
#pragma unroll
        for (int ai = 0; ai < 2; ++ai)
#pragma unroll
            for (int m = 0; m < 4; ++m) { const size_t off = (size_t)(row0 + ai * HALF + m * 16) * 1024 + col0;
#pragma unroll
                for (int bj = 0; bj < 2; ++bj)
#pragma unroll
                    for (int n = 0; n < 2; ++n) { const size_t o = off + bj * HALF + n * 16; *(f32x4*)(X1 + o) = *(const f32x4*)(X + o) + acc[ai][bj][m][n]; } }
    }
};
struct EpiGateUp {
    static constexpr bool PERM = true, AFTER_DRAIN = false;
    bf16_t* HID; const float* RWE; const PG8_LAS int* TB;
    __device__ __forceinline__ void operator()(const f32x4 (&acc)[2][2][4][2], const Unit& u, int wr, int wc, int fr, int fq) const {
        const int row0 = u.pm * BM + wr * 64 + fr, colh = (u.pn & 3) * 128 + wc * 32 + 8 * fq;
#pragma unroll
        for (int ai = 0; ai < 2; ++ai)
#pragma unroll
            for (int m = 0; m < 4; ++m) { const size_t r = (size_t)(row0 + ai * HALF + m * 16); const size_t es = (size_t)((u.pn >> 2) << 16) + (r - (size_t)TB[u.pn >> 2] * 256); const float ri = RWE[2 * es], w = RWE[2 * es + 1];
                f32x4 h0, h1;
#pragma unroll
                for (int i = 0; i < 4; ++i) { const float g0 = acc[ai][0][m][0][i] * ri, g1 = acc[ai][0][m][1][i] * ri; const float wr_ = w * ri;
                    h0[i] = g0 * sigmoid_f(g0) * acc[ai][1][m][0][i] * wr_; h1[i] = g1 * sigmoid_f(g1) * acc[ai][1][m][1][i] * wr_; }
                *(u32x4*)(HID + r * 512 + colh) = pack8(h0, h1); }
    }
};
struct EpiDown {
    static constexpr bool PERM = true, AFTER_DRAIN = false;
    bf16_t* Y;
    __device__ __forceinline__ void operator()(const f32x4 (&acc)[2][2][4][2], const Unit& u, int wr, int wc, int fr, int fq) const {
        const int row0 = u.pm * BM + wr * 64 + fr, col0 = (u.pn & 3) * BM + wc * 32 + 8 * fq;
#pragma unroll
        for (int ai = 0; ai < 2; ++ai)
#pragma unroll
            for (int m = 0; m < 4; ++m) { bf16_t* rowp = Y + (size_t)(row0 + ai * HALF + m * 16) * 1024 + col0;
#pragma unroll
                for (int bj = 0; bj < 2; ++bj) *(u32x4*)(rowp + bj * HALF) = pack8(acc[ai][bj][m][0], acc[ai][bj][m][1]); }
    }
};

struct NoMid { static constexpr bool ON = false; static constexpr int T0 = -1, T1 = -1; __device__ __forceinline__ void operator()(f32x4 (&)[2][2][4][2], const Unit&, int, int, int, int, int) const {} };
template <class Epi, class Sched, bool ALIGN_EPI = false, bool SP2 = false, class Mid = NoMid, bool GATHER = false>
__device__ __forceinline__ void gemm_phase(PG8_LAS unsigned char* lds, const Gemm g, const Sched& S, const Epi& E, const Mid& MH = Mid(), const PG8_LAS int* tokl = nullptr) {
    int tid_ = threadIdx.x; asm volatile("" : "+v"(tid_));
    const int tid = tid_, wid = __builtin_amdgcn_readfirstlane(tid >> 6), lane = tid & 63, wr = wid >> 2, wc = wid & 3, fr = lane & 15, fq = lane >> 4;
    static_assert(!GATHER || SP2, "GATHER is written for the SP2 loop");
    const int K = g.K, nt = K / BK;
    unsigned voffA[2], voffB[2];
#pragma unroll
    for (int i = 0; i < 2; ++i) { int R, C; stage_rc(tid * 16 + i * 8192, R, C); const int Rb = Epi::PERM ? ((R & ~31) + perm32(R & 31)) : R;
        voffA[i] = (unsigned)(R * K + C) * 2u; voffB[i] = (unsigned)(Rb * K + C) * 2u; }
    const size_t kstep = (size_t)(BK * 2);
    const size_t hstep = (size_t)HALF * K * 2;
    const size_t tstep = 2 * hstep;
    const unsigned ldsw = (unsigned)wid * 1024u;
    const int aoff = lds_byte(wr * 64 + fr, fq * 8), boff = lds_byte(wc * 32 + fr, fq * 8);
    unsigned vGc[2][2], vGn[2][2]; int gR[2], gC[2];
    if constexpr (GATHER) {
#pragma unroll
        for (int i = 0; i < 2; ++i) { stage_rc(tid * 16 + i * 8192, gR[i], gC[i]); }
    }
#define PG8_GOFFS(dst, u_) do { if constexpr (GATHER) { _Pragma("unroll") for (int hh_ = 0; hh_ < 2; ++hh_) _Pragma("unroll") for (int i_ = 0; i_ < 2; ++i_) \
        dst[hh_][i_] = ((unsigned)tokl[(u_) * 256 + hh_ * HALF + gR[i_]] * (unsigned)K + (unsigned)gC[i_]) * 2u; } } while (0)
#define PG8_STGA(bufoff, base, hh, nx) do { if constexpr (GATHER) { _Pragma("unroll") for (int _i = 0; _i < 2; ++_i) \
        __builtin_amdgcn_global_load_lds((const unsigned*)((const char*)(base) + ((nx) ? vGn[hh][_i] : vGc[hh][_i])), (PG8_LAS unsigned*)(lds + (bufoff) + ldsw + _i * 8192), 16, 0, 0); } \
      else { PG8_STAGE(bufoff, (base) + (hh) * hstep, voffA); } } while (0)
#define PG8_SA(b, h) (((b) * 2 + (h)) * HTB)
#define PG8_SB(b, h) ((4 + (b) * 2 + (h)) * HTB)
#define PG8_STAGE(bufoff, gbase, voff) do { _Pragma("unroll") for (int _i = 0; _i < 2; ++_i) \
        __builtin_amdgcn_global_load_lds((const unsigned*)((const char*)(gbase) + (voff)[_i]), (PG8_LAS unsigned*)(lds + (bufoff) + ldsw + _i * 8192), 16, 0, 0); } while (0)
#define PG8_LDA(dst, b, h) do { _Pragma("unroll") for (int m = 0; m < 4; ++m) _Pragma("unroll") for (int k = 0; k < 2; ++k) dst[m][k] = *(const PG8_LAS bf16x8*)(lds + PG8_SA(b, h) + aoff + m * 2048 + k * 1024); } while (0)
#define PG8_LDB(dst, b, h) do { _Pragma("unroll") for (int n = 0; n < 2; ++n) _Pragma("unroll") for (int k = 0; k < 2; ++k) dst[n][k] = *(const PG8_LAS bf16x8*)(lds + PG8_SB(b, h) + boff + n * 2048 + k * 1024); } while (0)
#define PG8_MMA(ai, bj, At, Bt) do { __builtin_amdgcn_s_setprio(1); _Pragma("unroll") for (int m = 0; m < 4; ++m) _Pragma("unroll") for (int n = 0; n < 2; ++n) _Pragma("unroll") for (int k = 0; k < 2; ++k) \
        acc[ai][bj][m][n] = __builtin_amdgcn_mfma_f32_16x16x32_bf16(Bt[n][k], At[m][k], acc[ai][bj][m][n], 0, 0, 0); __builtin_amdgcn_s_setprio(0); } while (0)
#define PG8_WAIT_V(n) asm volatile("s_waitcnt vmcnt(" #n ")" ::: "memory")
#define PG8_WAIT_L(n) asm volatile("s_waitcnt lgkmcnt(" #n ")" ::: "memory")
#define PG8_BAR __builtin_amdgcn_s_barrier()
#define PG8_SCHED __builtin_amdgcn_sched_barrier(0)
    Unit cur, nxt; int ui = 0;
    if (!S.next(0, cur)) return;
    f32x4 acc[2][2][4][2];
#pragma unroll
    for (int a = 0; a < 2; ++a)
#pragma unroll
        for (int b = 0; b < 2; ++b)
#pragma unroll
            for (int m = 0; m < 4; ++m)
#pragma unroll
                for (int n = 0; n < 2; ++n) acc[a][b][m][n] = (f32x4){0.f, 0.f, 0.f, 0.f};
    bf16x8 At[4][2], B0[2][2], B1[2][2];
    const char* cA = (const char*)g.A + (GATHER ? (size_t)0 : (size_t)cur.pm * tstep); const char* cB = (const char*)g.Bt + (size_t)cur.pn * tstep;
    PG8_GOFFS(vGc, 0); PG8_GOFFS(vGn, 0);
    S.a_ready(cur);
    if constexpr (SP2) {
        PG8_STAGE(PG8_SB(0, 0), cB, voffB); PG8_STAGE(PG8_SB(0, 1), cB + hstep, voffB); PG8_STGA(PG8_SA(0, 0), cA, 0, false); PG8_STGA(PG8_SA(0, 1), cA, 1, false);
        if (wr == 1) PG8_BAR;
        PG8_WAIT_V(2); PG8_BAR;
        PG8_STAGE(PG8_SB(1, 0), cB + kstep, voffB); PG8_STGA(PG8_SA(1, 0), cA + kstep, 0, false); PG8_STAGE(PG8_SB(1, 1), cB + hstep + kstep, voffB);
        PG8_WAIT_V(6); PG8_BAR;
    } else {
        PG8_STAGE(PG8_SB(0, 0), cB, voffB); PG8_STAGE(PG8_SA(0, 0), cA, voffA); PG8_STAGE(PG8_SB(0, 1), cB + hstep, voffB); PG8_STAGE(PG8_SA(0, 1), cA + hstep, voffA);
        if (wr == 1) PG8_BAR;
        PG8_WAIT_V(4); PG8_BAR;
        PG8_STAGE(PG8_SB(1, 0), cB + kstep, voffB); PG8_STAGE(PG8_SA(1, 0), cA + kstep, voffA); PG8_STAGE(PG8_SB(1, 1), cB + hstep + kstep, voffB);
        PG8_WAIT_V(6); PG8_BAR;
    }
    for (;;) {
        const bool has_next = S.next(ui + 1, nxt);
        if (has_next) PG8_GOFFS(vGn, ui + 1);
        const char* nA = (has_next && !GATHER) ? (const char*)g.A + (size_t)nxt.pm * tstep : cA; const char* nB = has_next ? (const char*)g.Bt + (size_t)nxt.pn * tstep : cB;
        for (int t = 0; t < nt; t += 2) {
            if constexpr (Mid::ON) { if (t == Mid::T0 || t == Mid::T1) MH(acc, cur, t, wr, wc, fr, fq); }
            const bool last = (t == nt - 2);
            const char* a1 = cA + (size_t)(t + 1) * kstep;
            const char* a2 = last ? nA : cA + (size_t)(t + 2) * kstep; const char* b2 = last ? nB : cB + (size_t)(t + 2) * kstep;
            const char* a3 = a2 + kstep; const char* b3 = b2 + kstep;
            if (last && has_next) S.a_ready(nxt);
            if constexpr (SP2) {
            PG8_LDB(B0, 0, 0); PG8_LDB(B1, 0, 1); PG8_SCHED; PG8_LDA(At, 0, 0); PG8_STGA(PG8_SA(1, 1), a1, 1, false);
            PG8_WAIT_V(8); PG8_WAIT_L(0); PG8_BAR; PG8_MMA(0, 0, At, B0); PG8_MMA(0, 1, At, B1); PG8_BAR; PG8_SCHED;
            PG8_LDA(At, 0, 1); PG8_STAGE(PG8_SB(0, 0), b2, voffB); PG8_STAGE(PG8_SB(0, 1), b2 + hstep, voffB); PG8_STGA(PG8_SA(0, 0), a2, 0, last && has_next);
            PG8_WAIT_V(8); PG8_WAIT_L(0); PG8_BAR; PG8_MMA(1, 0, At, B0); PG8_MMA(1, 1, At, B1); PG8_BAR; PG8_SCHED;
            PG8_LDB(B0, 1, 0); PG8_LDB(B1, 1, 1); PG8_SCHED; PG8_LDA(At, 1, 0); PG8_STGA(PG8_SA(0, 1), a2, 1, last && has_next);
            PG8_WAIT_V(8); PG8_WAIT_L(0); PG8_BAR; PG8_MMA(0, 0, At, B0); PG8_MMA(0, 1, At, B1); PG8_BAR; PG8_SCHED;
            PG8_LDA(At, 1, 1); PG8_STAGE(PG8_SB(1, 0), b3, voffB); PG8_STAGE(PG8_SB(1, 1), b3 + hstep, voffB); PG8_STGA(PG8_SA(1, 0), a3, 0, last && has_next);
            PG8_WAIT_V(8); PG8_WAIT_L(0); PG8_BAR; PG8_MMA(1, 0, At, B0); PG8_MMA(1, 1, At, B1); PG8_BAR; PG8_SCHED;
            } else {
            PG8_LDB(B0, 0, 0); PG8_SCHED; PG8_LDA(At, 0, 0); PG8_STAGE(PG8_SA(1, 1), a1 + hstep, voffA);
            PG8_WAIT_L(8); PG8_BAR; PG8_WAIT_L(0); PG8_MMA(0, 0, At, B0); PG8_BAR; PG8_SCHED;
            PG8_LDB(B1, 0, 1); PG8_STAGE(PG8_SB(0, 0), b2, voffB);
            PG8_BAR; PG8_WAIT_L(0); PG8_MMA(0, 1, At, B1); PG8_BAR;
            PG8_LDA(At, 0, 1); PG8_STAGE(PG8_SA(0, 0), a2, voffA);
            PG8_BAR; PG8_WAIT_L(0); PG8_MMA(1, 0, At, B0); PG8_BAR; PG8_SCHED;
            PG8_STAGE(PG8_SB(0, 1), b2 + hstep, voffB);
            PG8_WAIT_V(6); PG8_BAR; PG8_MMA(1, 1, At, B1); PG8_BAR;
            PG8_LDB(B0, 1, 0); PG8_SCHED; PG8_LDA(At, 1, 0); PG8_STAGE(PG8_SA(0, 1), a2 + hstep, voffA);
            PG8_WAIT_L(8); PG8_BAR; PG8_WAIT_L(0); PG8_MMA(0, 0, At, B0); PG8_BAR; PG8_SCHED;
            PG8_LDB(B1, 1, 1); PG8_STAGE(PG8_SB(1, 0), b3, voffB);
            PG8_BAR; PG8_WAIT_L(0); PG8_MMA(0, 1, At, B1); PG8_BAR;
            PG8_LDA(At, 1, 1); PG8_STAGE(PG8_SA(1, 0), a3, voffA);
            PG8_BAR; PG8_WAIT_L(0); PG8_MMA(1, 0, At, B0); PG8_BAR; PG8_SCHED;
            PG8_STAGE(PG8_SB(1, 1), b3 + hstep, voffB);
            PG8_WAIT_V(6); PG8_BAR; PG8_MMA(1, 1, At, B1); PG8_BAR;
            }
        }
        if constexpr (ALIGN_EPI) { if (wr == 0) PG8_BAR; }
        if constexpr (!Epi::AFTER_DRAIN) { E(acc, cur, wr, wc, fr, fq); S.done(cur); }
        if (!has_next) break;
#pragma unroll
        for (int a = 0; a < 2; ++a)
#pragma unroll
            for (int b = 0; b < 2; ++b)
#pragma unroll
                for (int m = 0; m < 4; ++m)
#pragma unroll
                    for (int n = 0; n < 2; ++n) acc[a][b][m][n] = (f32x4){0.f, 0.f, 0.f, 0.f};
        cur = nxt; cA = nA; cB = nB; ++ui;
        if constexpr (GATHER) { _Pragma("unroll") for (int hh_ = 0; hh_ < 2; ++hh_) _Pragma("unroll") for (int i_ = 0; i_ < 2; ++i_) vGc[hh_][i_] = vGn[hh_][i_]; }
        if constexpr (ALIGN_EPI) { if (wr == 1) PG8_BAR; }
    }
    PG8_WAIT_V(0);
    if constexpr (!ALIGN_EPI) { if (wr == 0) PG8_BAR; }
    PG8_BAR;
    if constexpr (Epi::AFTER_DRAIN) { E.fused(acc, cur, wr, wc, fr, fq, lds, wid, lane); S.done(cur); }
#undef PG8_SA
#undef PG8_SB
#undef PG8_STAGE
#undef PG8_STGA
#undef PG8_GOFFS
#undef PG8_LDA
#undef PG8_LDB
#undef PG8_MMA
#undef PG8_WAIT_V
#undef PG8_WAIT_L
#undef PG8_BAR
#undef PG8_SCHED
}
}
#include <hip/hip_bf16.h>
#include <cmath>
namespace attn_body {
using bf16=__hip_bfloat16;
using bf16x8=__attribute__((ext_vector_type(8)))short;
using s16x4=__attribute__((ext_vector_type(4)))short;
using f32x16=__attribute__((ext_vector_type(16)))float;
using u32x4=__attribute__((ext_vector_type(4)))unsigned;
constexpr int D=64;
constexpr int NW=8,QBLK=32,QB=QBLK*NW,KVBLK=64;
constexpr int ATTN_UNIT_ROWS=QB;
__device__ __forceinline__ int crow(int r,int hi){return (r&3)+8*(r>>2)+4*hi;}
#define SBAR() __builtin_amdgcn_sched_barrier(0)
__device__ __forceinline__ void cmask(f32x16&p0,f32x16&p1,int jb,int qrel,int hi){
  const float NEG=-INFINITY; int kb=64*jb+4*hi;
  #pragma unroll
  for(int r=0;r<16;++r){int kv=kb+(r&3)+8*(r>>2); if(kv>qrel)p0[r]=NEG; if(kv+32>qrel)p1[r]=NEG;}
}

constexpr int NSLOT=3, SLOTB=8192;
constexpr int LDS_K=0, LDS_V=NSLOT*SLOTB, LDS_WS=2*NSLOT*SLOTB, LDS_OST=LDS_WS+NW*64*4, LDS_BYTES=LDS_OST+NW*4096;
constexpr float C2=0.125f*1.4426950408889634f;
__device__ __forceinline__ void glds16(const void*gsrc,unsigned lds_dst){unsigned keep;
  asm volatile("s_mov_b32 %0, m0\n\ts_mov_b32 m0, %2\n\ts_nop 0\n\tglobal_load_lds_dwordx4 %1, off\n\ts_mov_b32 m0, %0":"=&s"(keep):"v"(gsrc),"s"(lds_dst):"memory");}
__device__ __forceinline__ float max3f(float a,float b,float c){float r;asm("v_max3_f32 %0, %1, %2, %3":"=v"(r):"v"(a),"v"(b),"v"(c));return r;}
__device__ __forceinline__ float max2f(float a,float b){float r;asm("v_max_f32_e32 %0, %1, %2":"=v"(r):"v"(a),"v"(b));return r;}
__device__ __forceinline__ float fadd_s(float a,float b){float r;asm("v_add_f32_e32 %0, %1, %2":"=v"(r):"v"(a),"v"(b));return r;}
__device__ __forceinline__ float fsub_s(float a,float b){float r;asm("v_sub_f32_e32 %0, %1, %2":"=v"(r):"v"(a),"v"(b));return r;}
typedef float f32x2_t __attribute__((ext_vector_type(2))); typedef __bf16 bf16x2_t __attribute__((ext_vector_type(2)));
__device__ __forceinline__ unsigned cvtpk_s(float lo,float hi){f32x2_t v={lo,hi};bf16x2_t b=__builtin_convertvector(v,bf16x2_t);return __builtin_bit_cast(unsigned,b);}
#define WAIT_BAR(N) asm volatile("s_waitcnt vmcnt(" #N ") lgkmcnt(0)\n\ts_barrier":::"memory")

__device__ __forceinline__ void qkt(f32x16&p0,f32x16&p1,const char*Kslot,const bf16x8*qr,const f32x16&negm,int r32,int hi){
  const char*kb=Kslot+hi*1024+r32*16;
  #pragma unroll
  for(int d0=0;d0<4;++d0){
    const bf16x8 b0=*reinterpret_cast<const bf16x8*>(kb+d0*2048);
    const bf16x8 b1=*reinterpret_cast<const bf16x8*>(kb+d0*2048+512);
    if(d0==0){p0=__builtin_amdgcn_mfma_f32_32x32x16_bf16(b0,qr[0],negm,0,0,0);p1=__builtin_amdgcn_mfma_f32_32x32x16_bf16(b1,qr[0],negm,0,0,0);}
    else{p0=__builtin_amdgcn_mfma_f32_32x32x16_bf16(b0,qr[d0],p0,0,0,0);p1=__builtin_amdgcn_mfma_f32_32x32x16_bf16(b1,qr[d0],p1,0,0,0);}}
}
typedef __attribute__((address_space(3))) const char* lds_cptr;
typedef short v4i16_t __attribute__((ext_vector_type(4)));
__device__ __forceinline__ void kload8(bf16x8*kf,lds_cptr kp){
  kf[0]=*(const __attribute__((address_space(3))) bf16x8*)(kp);      kf[1]=*(const __attribute__((address_space(3))) bf16x8*)(kp+512);
  kf[2]=*(const __attribute__((address_space(3))) bf16x8*)(kp+2048); kf[3]=*(const __attribute__((address_space(3))) bf16x8*)(kp+2560);
  kf[4]=*(const __attribute__((address_space(3))) bf16x8*)(kp+4096); kf[5]=*(const __attribute__((address_space(3))) bf16x8*)(kp+4608);
  kf[6]=*(const __attribute__((address_space(3))) bf16x8*)(kp+6144); kf[7]=*(const __attribute__((address_space(3))) bf16x8*)(kp+6656);
}
__device__ __forceinline__ void kload2(bf16x8*kf,lds_cptr kp,int j){ kf[2*j]=*(const __attribute__((address_space(3))) bf16x8*)(kp+j*2048); kf[2*j+1]=*(const __attribute__((address_space(3))) bf16x8*)(kp+j*2048+512); }
__device__ __forceinline__ s16x4 vtr(lds_cptr p){ return __builtin_bit_cast(s16x4,__builtin_amdgcn_ds_read_tr16_b64_v4i16((__attribute__((address_space(3))) v4i16_t*)p)); }
__device__ __forceinline__ float rowmax(const f32x16&p0,const f32x16&p1){
  float a=max3f(p0[0],p0[1],p1[0]),b=max3f(p0[2],p0[3],p1[1]);a=max3f(a,p1[2],p1[3]);
  #pragma unroll
  for(int r=4;r<16;r+=4){a=max3f(a,p0[r],p0[r+1]);b=max3f(b,p0[r+2],p0[r+3]);a=max3f(a,p1[r],p1[r+1]);b=max3f(b,p1[r+2],p1[r+3]);}
  const float m=max2f(a,b);
  auto rr=__builtin_amdgcn_permlane32_swap(__float_as_uint(m),__float_as_uint(m),false,false);
  return max2f(__uint_as_float(rr[0]),__uint_as_float(rr[1]));
}
__device__ __forceinline__ void pv(f32x16*o,int vb,bf16x8 pa0,bf16x8 pa1,bf16x8 pa2,bf16x8 pa3){
  #pragma unroll
  for(int d0=0;d0<2;++d0){s16x4 lo[4],hi[4];
    #pragma unroll
    for(int ks=0;ks<4;++ks){
      asm volatile("ds_read_b64_tr_b16 %0,%1 offset:%c2":"=&v"(lo[ks]):"v"(vb),"i"(d0*4096+ks*1024):"memory");
      asm volatile("ds_read_b64_tr_b16 %0,%1 offset:%c2":"=&v"(hi[ks]):"v"(vb),"i"(d0*4096+ks*1024+512):"memory");}
    asm volatile("s_waitcnt lgkmcnt(0)":::"memory");SBAR();
    #define PK(k) (bf16x8){lo[k][0],lo[k][1],lo[k][2],lo[k][3],hi[k][0],hi[k][1],hi[k][2],hi[k][3]}
    o[d0]=__builtin_amdgcn_mfma_f32_32x32x16_bf16(pa0,PK(0),o[d0],0,0,0);
    o[d0]=__builtin_amdgcn_mfma_f32_32x32x16_bf16(pa1,PK(1),o[d0],0,0,0);
    o[d0]=__builtin_amdgcn_mfma_f32_32x32x16_bf16(pa2,PK(2),o[d0],0,0,0);
    o[d0]=__builtin_amdgcn_mfma_f32_32x32x16_bf16(pa3,PK(3),o[d0],0,0,0);
    #undef PK
  }
}

#ifndef ATTN_STORE16
#define ATTN_STORE16(p,v) (*(u32x4*)(p)=(v))
#endif
template<int THRL,bool CAUSAL> __device__ __forceinline__ void attn_unit(const bf16*Qu,const int pQ,const bf16*__restrict__ Kh,const bf16*__restrict__ Vh,const int pKV,bf16*Ou,const int pO,const int NT,char*shm){
  int tid_=threadIdx.x; asm volatile("":"+v"(tid_));
  const int tid=tid_,lane=tid&63,r32=lane&31,hi=lane>>5; const int wid=__builtin_amdgcn_readfirstlane(tid>>6);
  const bf16*Qw=Qu+(long)(wid*QBLK)*pQ;
  const unsigned lds0=(unsigned)(uintptr_t)shm;
  float*wsf=(float*)(shm+LDS_WS)+wid*64;
  const bf16*ksrc=Kh+(long)lane*pKV+wid*8;
  const bf16*vsrc=Vh+(long)(16*(wid&3)+(lane>>2))*pKV+(wid>>2)*32+(lane&3)*8;
  const unsigned kdst=lds0+LDS_K+wid*1024, vdst=lds0+LDS_V+wid*1024;
  #define DMA_K(t,slot) glds16(ksrc+(long)(t)*KVBLK*pKV,(unsigned)__builtin_amdgcn_readfirstlane(kdst+(slot)))
  #define DMA_V(t,slot) glds16(vsrc+(long)(t)*KVBLK*pKV,(unsigned)__builtin_amdgcn_readfirstlane(vdst+(slot)))
  const int vb0=(int)(lds0+LDS_V)+((lane>>4)&1)*32+(lane&3)*8+(4*hi+((lane&15)>>2))*64;
  const char*Kbase=shm+LDS_K; bf16x8 kf[8];
  const lds_cptr shm3=(lds_cptr)shm; const lds_cptr kp0=shm3+LDS_K+hi*1024+r32*16; const lds_cptr vp0=shm3+LDS_V+((lane>>4)&1)*32+(lane&3)*8+(4*hi+((lane&15)>>2))*64;
  DMA_K(0,0);DMA_V(0,0);DMA_K(1,SLOTB);
  bf16x8 qr[4];
  #pragma unroll
  for(int d0=0;d0<4;++d0)qr[d0]=*reinterpret_cast<const bf16x8*>(&Qw[(long)r32*pQ+d0*16+hi*8]);
  float mhat=0.f,l_reg=0.f;f32x16 o[2];o[0]=f32x16{};o[1]=f32x16{};const f32x16 negm=f32x16{};
  const int qrel=wid*QBLK+r32;
  #define CMASK(P0,P1,t) do{ if(CAUSAL){int jb_=(t)-(NT-4); if(jb_>=0)cmask(P0,P1,jb_,qrel,hi);} }while(0)
  bool resc=false;
  #define START(P0,P1) do{ const float rm=rowmax(P0,P1); resc=false; \
    { const float dl=rm; mhat=fadd_s(mhat,dl); \
      _Pragma("unroll") for(int r=0;r<16;++r){P0[r]=fsub_s(P0[r],dl);P1[r]=fsub_s(P1[r],dl);} \
      } \
    _Pragma("unroll") for(int r=0;r<16;++r)P0[r]=__builtin_amdgcn_exp2f(P0[r]); }while(0)
  #define RESC() do{ if(resc){ asm volatile("s_waitcnt lgkmcnt(0)":::"memory"); \
      _Pragma("unroll") for(int d_=0;d_<2;++d_) _Pragma("unroll") for(int r=0;r<16;++r)o[d_][r]*=wsf[crow(r,hi)]; } }while(0)
  f32x16 pA0,pA1,pB0,pB1;
  int sl_prev=0,sl_cur=0,sl_next=SLOTB;
  #define ROT() do{sl_prev=sl_cur;sl_cur=sl_next;sl_next=(sl_next==(NSLOT-1)*SLOTB)?0:sl_next+SLOTB;}while(0)
  DMA_K(2,2*SLOTB);
  WAIT_BAR(3);
  qkt(pA0,pA1,Kbase,qr,negm,r32,hi);asm volatile("s_nop 15\n\ts_nop 7":"+v"(pA0),"+v"(pA1));CMASK(pA0,pA1,0);
  START(pA0,pA1);
  _Pragma("unroll") for(int r=0;r<16;++r)pA1[r]=__builtin_amdgcn_exp2f(pA1[r]);
  WAIT_BAR(0);
  DMA_K(3,0);DMA_V(1,SLOTB);
  ROT();
  kload8(kf,kp0+sl_cur);
  WAIT_BAR(2);
  s16x4 vlo[8],vhi[8]; u32x4 pw0,pw1,pw2,pw3;
  #define PKW(P,B) cvtpk_s(P[B],P[B+1])
  #define PAF(k) __builtin_bit_cast(bf16x8,pw##k)
  #define VFR(i) (bf16x8){vlo[i][0],vlo[i][1],vlo[i][2],vlo[i][3],vhi[i][0],vhi[i][1],vhi[i][2],vhi[i][3]}
  #define PIN(x) asm volatile("":"+v"(x))
  #define MX3(a,b,c) __builtin_fmaxf(__builtin_fmaxf((a),(b)),(c))
  #define GAPA(MF,A0,A1,A2,A3,W0,W1,PW) do{ MF; sacc+=A0; sacc+=A1; sacc+=A2; sacc+=A3; PIN(sacc); W0; W1; PIN(PW); SBAR(); }while(0)
  #define EX(v) __builtin_amdgcn_exp2f(v)
  #define GAPB(MF,X,B) do{ MF; X[B]=EX(X[B]); X[B+1]=EX(X[B+1]); X[B+2]=EX(X[B+2]); X[B+3]=EX(X[B+3]); PIN(X); SBAR(); }while(0)
  #define VRD(i) do{ vlo[i]=vtr(vp_+(((i)>>2)*4096+((i)&3)*1024)); vhi[i]=vtr(vp_+(((i)>>2)*4096+((i)&3)*1024+512)); }while(0)
  #define KRD(G,j) do{ if(G){ kload2(kf,kp0+sl_next,j); SBAR(); } }while(0)
  #define STEP(C0,C1,P0,P1,t,GK,GV,GL) do{ SBAR(); \
    const lds_cptr vp_=vp0+sl_prev; \
    VRD(0); SBAR(); float sacc=(P0[0]+P0[1]); \
    GAPA(C0=__builtin_amdgcn_mfma_f32_32x32x16_bf16(kf[0],qr[0],negm,0,0,0), P0[2],P0[3],P0[4],P0[5],     pw0[0]=PKW(P0,0), pw0[1]=PKW(P0,2), pw0); \
    VRD(4); SBAR(); GAPA(C1=__builtin_amdgcn_mfma_f32_32x32x16_bf16(kf[1],qr[0],negm,0,0,0), P0[6],P0[7],P0[8],P0[9],     pw0[2]=PKW(P0,4), pw0[3]=PKW(P0,6), pw0); \
    VRD(1); SBAR(); GAPA(C0=__builtin_amdgcn_mfma_f32_32x32x16_bf16(kf[2],qr[1],C0,0,0,0),   P0[10],P0[11],P0[12],P0[13], pw1[0]=PKW(P0,8), pw1[1]=PKW(P0,10), pw1); \
    VRD(5); SBAR(); GAPA(C1=__builtin_amdgcn_mfma_f32_32x32x16_bf16(kf[3],qr[1],C1,0,0,0),   P0[14],P0[15],P1[0],P1[1],   pw1[2]=PKW(P0,12),pw1[3]=PKW(P0,14), pw1); \
    VRD(2); SBAR(); GAPA(C0=__builtin_amdgcn_mfma_f32_32x32x16_bf16(kf[4],qr[2],C0,0,0,0),   P1[2],P1[3],P1[4],P1[5],     pw2[0]=PKW(P1,0), pw2[1]=PKW(P1,2), pw2); \
    VRD(6); SBAR(); GAPA(C1=__builtin_amdgcn_mfma_f32_32x32x16_bf16(kf[5],qr[2],C1,0,0,0),   P1[6],P1[7],P1[8],P1[9],     pw2[2]=PKW(P1,4), pw2[3]=PKW(P1,6), pw2); \
    VRD(3); SBAR(); GAPA(C0=__builtin_amdgcn_mfma_f32_32x32x16_bf16(kf[6],qr[3],C0,0,0,0),   P1[10],P1[11],P1[12],P1[13], pw3[0]=PKW(P1,8), pw3[1]=PKW(P1,10), pw3); \
    VRD(7); SBAR(); GAPA(C1=__builtin_amdgcn_mfma_f32_32x32x16_bf16(kf[7],qr[3],C1,0,0,0),   P1[14],P1[15],0.f,0.f,       pw3[2]=PKW(P1,12),pw3[3]=PKW(P1,14), pw3); \
    l_reg+=sacc; \
    if(GK){DMA_K((t)+3,sl_cur);} if(GV){DMA_V((t)+1,sl_next);} \
    CMASK(C0,C1,t); \
    _Pragma("unroll") for(int r=0;r<16;++r){C0[r]-=mhat;C1[r]-=mhat;} \
    { float a=MX3(C0[0],C0[1],C1[0]),b=MX3(C0[2],C0[3],C1[1]); a=MX3(a,C1[2],C1[3]); \
      _Pragma("unroll") for(int r=4;r<16;r+=4){a=MX3(a,C0[r],C0[r+1]);b=MX3(b,C0[r+2],C0[r+3]);a=MX3(a,C1[r],C1[r+1]);b=MX3(b,C1[r+2],C1[r+3]);} \
      float rm=__builtin_fmaxf(a,b); { auto rr=__builtin_amdgcn_permlane32_swap(__float_as_uint(rm),__float_as_uint(rm),false,false); rm=__builtin_fmaxf(__uint_as_float(rr[0]),__uint_as_float(rr[1])); } \
      resc=false; \
      if(__builtin_expect(__any(rm>(float)THRL),0)){ const float dl=__builtin_fmaxf(rm,0.f); mhat+=dl; \
        _Pragma("unroll") for(int r=0;r<16;++r){C0[r]-=dl;C1[r]-=dl;} \
        const float f=__builtin_amdgcn_exp2f(-dl); l_reg*=f; if(hi==0)wsf[r32]=f; resc=true; } } \
    SBAR(); \
    GAPB(o[0]=__builtin_amdgcn_mfma_f32_32x32x16_bf16(PAF(0),VFR(0),o[0],0,0,0), C0,0); \
    GAPB(o[1]=__builtin_amdgcn_mfma_f32_32x32x16_bf16(PAF(0),VFR(4),o[1],0,0,0), C0,4); \
    KRD(GL,0); GAPB(o[0]=__builtin_amdgcn_mfma_f32_32x32x16_bf16(PAF(1),VFR(1),o[0],0,0,0), C0,8); \
    KRD(GL,1); GAPB(o[1]=__builtin_amdgcn_mfma_f32_32x32x16_bf16(PAF(1),VFR(5),o[1],0,0,0), C0,12); \
    KRD(GL,2); GAPB(o[0]=__builtin_amdgcn_mfma_f32_32x32x16_bf16(PAF(2),VFR(2),o[0],0,0,0), C1,0); \
    KRD(GL,3); GAPB(o[1]=__builtin_amdgcn_mfma_f32_32x32x16_bf16(PAF(2),VFR(6),o[1],0,0,0), C1,4); \
    GAPB(o[0]=__builtin_amdgcn_mfma_f32_32x32x16_bf16(PAF(3),VFR(3),o[0],0,0,0), C1,8); \
    GAPB(o[1]=__builtin_amdgcn_mfma_f32_32x32x16_bf16(PAF(3),VFR(7),o[1],0,0,0), C1,12); \
    }while(0)
  int t=1;
  #undef CMASK
  #define CMASK(P0,P1,t) do{}while(0)
  for(;t+5<NT;t+=2){
    STEP(pB0,pB1,pA0,pA1,t,true,true,true);     WAIT_BAR(2); RESC(); ROT();
    STEP(pA0,pA1,pB0,pB1,t+1,true,true,true);   WAIT_BAR(2); RESC(); ROT();
  }
  #undef CMASK
  #define CMASK(P0,P1,t) do{ if(CAUSAL){int jb_=(t)-(NT-4); if(jb_>=0)cmask(P0,P1,jb_,qrel,hi);} }while(0)
  #define ENDW(tt) do{ if((tt)+3<NT){WAIT_BAR(2);} else if((tt)+2<NT){WAIT_BAR(1);} else {WAIT_BAR(0);} }while(0)
  for(;t+1<NT;t+=2){
    STEP(pB0,pB1,pA0,pA1,t,(t+3<NT),(t+1<NT),(t+1<NT));       ENDW(t);   RESC(); ROT();
    STEP(pA0,pA1,pB0,pB1,t+1,(t+4<NT),(t+2<NT),(t+2<NT));     ENDW(t+1); RESC(); ROT();
  }
  STEP(pB0,pB1,pA0,pA1,NT-1,false,false,false); RESC();
  { float sacc=pB0[0]+pB0[1]; _Pragma("unroll") for(int r=2;r<16;++r)sacc+=pB0[r]; _Pragma("unroll") for(int r=0;r<16;++r)sacc+=pB1[r]; l_reg+=sacc;
    pw0=(u32x4){PKW(pB0,0),PKW(pB0,2),PKW(pB0,4),PKW(pB0,6)};pw1=(u32x4){PKW(pB0,8),PKW(pB0,10),PKW(pB0,12),PKW(pB0,14)};pw2=(u32x4){PKW(pB1,0),PKW(pB1,2),PKW(pB1,4),PKW(pB1,6)};pw3=(u32x4){PKW(pB1,8),PKW(pB1,10),PKW(pB1,12),PKW(pB1,14)};
    SBAR(); pv(o,vb0+sl_cur,PAF(0),PAF(1),PAF(2),PAF(3)); }
  #undef PKW
  #undef PAF
  #undef VFR
  #undef PIN
  #undef MX3
  #undef GAPA
  #undef GAPB
  #undef EX
  #undef VRD
  #undef KRD
  #undef STEP
  #undef ENDW
  {auto rr=__builtin_amdgcn_permlane32_swap(__float_as_uint(l_reg),__float_as_uint(l_reg),false,false);l_reg=__uint_as_float(rr[0])+__uint_as_float(rr[1]);}
  if(hi==0)wsf[32+r32]=l_reg;asm volatile("s_waitcnt lgkmcnt(0)":::"memory");
  float rli[16];
  #pragma unroll
  for(int r=0;r<16;++r)rli[r]=__builtin_amdgcn_rcpf(wsf[32+crow(r,hi)]);
  bf16*Ow=Ou+(long)(wid*QBLK)*pO;
  { bf16*stg=(bf16*)(shm+LDS_OST)+wid*2048;
    #pragma unroll
    for(int r=0;r<16;++r){const int orow=crow(r,hi);
      #pragma unroll
      for(int d0=0;d0<2;++d0)stg[orow*64+d0*32+r32]=__float2bfloat16(o[d0][r]*rli[r]);}
    asm volatile("s_waitcnt lgkmcnt(0)":::"memory");
    #pragma unroll
    for(int i=0;i<4;++i){const int row=i*8+(lane>>3),ch=lane&7; const u32x4 v=*(const u32x4*)(stg+row*64+ch*8); ATTN_STORE16(Ow+(long)row*pO+ch*8,v);} }
  asm volatile("s_waitcnt lgkmcnt(0)\n\ts_barrier":::"memory");
  #undef DMA_K
  #undef DMA_V
  #undef CMASK
  #undef START
  #undef RESC
  #undef ROT
}
__device__ __forceinline__ void mem_attn(const bf16*Q0,const int pQ,const bf16*__restrict__ Kh,const bf16*__restrict__ Vh,const int pKV,bf16*O0,const int pO,const int nqb,char*shm){
  int tid_=threadIdx.x; asm volatile("":"+v"(tid_));
  const int tid=tid_,lane=tid&63,r32=lane&31,hi=lane>>5; const int wid=__builtin_amdgcn_readfirstlane(tid>>6);
  constexpr int MK=0,MV=32768,MWS=65536,MOST=65536+2048;
  const unsigned lds0=(unsigned)(uintptr_t)shm;
  const bf16*ksrc=Kh+(long)lane*pKV+wid*8;
  const bf16*vsrc=Vh+(long)(16*(wid&3)+(lane>>2))*pKV+(wid>>2)*32+(lane&3)*8;
  #pragma unroll
  for(int t=0;t<4;++t){ glds16(ksrc+(long)t*KVBLK*pKV,(unsigned)__builtin_amdgcn_readfirstlane(lds0+MK+t*8192+wid*1024)); glds16(vsrc+(long)t*KVBLK*pKV,(unsigned)__builtin_amdgcn_readfirstlane(lds0+MV+t*8192+wid*1024)); }
  WAIT_BAR(0);
  const int vb0=(int)(lds0+MV)+((lane>>4)&1)*32+(lane&3)*8+(4*hi+((lane&15)>>2))*64;
  float*wsf=(float*)(shm+MWS)+wid*64;
  const f32x16 zero=f32x16{};
  for(int qb=0;qb<nqb;++qb){
    const bf16*Qw=Q0+(long)(qb*QB+wid*QBLK)*pQ;
    bf16x8 qr[4];
    #pragma unroll
    for(int d0=0;d0<4;++d0)qr[d0]=*reinterpret_cast<const bf16x8*>(&Qw[(long)r32*pQ+d0*16+hi*8]);
    f32x16 p[4][2];
    #pragma unroll
    for(int t=0;t<4;++t)qkt(p[t][0],p[t][1],shm+MK+t*8192,qr,zero,r32,hi);
    float m=p[0][0][0];
    #pragma unroll
    for(int t=0;t<4;++t)
      #pragma unroll
      for(int j=0;j<2;++j)
        #pragma unroll
        for(int r=0;r<16;++r)m=__builtin_fmaxf(m,p[t][j][r]);
    { auto rr=__builtin_amdgcn_permlane32_swap(__float_as_uint(m),__float_as_uint(m),false,false); m=__builtin_fmaxf(__uint_as_float(rr[0]),__uint_as_float(rr[1])); }
    float l=0.f;
    #pragma unroll
    for(int t=0;t<4;++t)
      #pragma unroll
      for(int j=0;j<2;++j)
        #pragma unroll
        for(int r=0;r<16;++r){ const float e=__builtin_amdgcn_exp2f(p[t][j][r]-m); p[t][j][r]=e; l+=e; }
    { auto rr=__builtin_amdgcn_permlane32_swap(__float_as_uint(l),__float_as_uint(l),false,false); l=__uint_as_float(rr[0])+__uint_as_float(rr[1]); }
    f32x16 o[2]; o[0]=f32x16{}; o[1]=f32x16{};
    #pragma unroll
    for(int t=0;t<4;++t){
      const u32x4 w0={cvtpk_s(p[t][0][0],p[t][0][1]),cvtpk_s(p[t][0][2],p[t][0][3]),cvtpk_s(p[t][0][4],p[t][0][5]),cvtpk_s(p[t][0][6],p[t][0][7])};
      const u32x4 w1={cvtpk_s(p[t][0][8],p[t][0][9]),cvtpk_s(p[t][0][10],p[t][0][11]),cvtpk_s(p[t][0][12],p[t][0][13]),cvtpk_s(p[t][0][14],p[t][0][15])};
      const u32x4 w2={cvtpk_s(p[t][1][0],p[t][1][1]),cvtpk_s(p[t][1][2],p[t][1][3]),cvtpk_s(p[t][1][4],p[t][1][5]),cvtpk_s(p[t][1][6],p[t][1][7])};
      const u32x4 w3={cvtpk_s(p[t][1][8],p[t][1][9]),cvtpk_s(p[t][1][10],p[t][1][11]),cvtpk_s(p[t][1][12],p[t][1][13]),cvtpk_s(p[t][1][14],p[t][1][15])};
      pv(o,vb0+t*8192,__builtin_bit_cast(bf16x8,w0),__builtin_bit_cast(bf16x8,w1),__builtin_bit_cast(bf16x8,w2),__builtin_bit_cast(bf16x8,w3)); }
    if(hi==0)wsf[32+r32]=l; asm volatile("s_waitcnt lgkmcnt(0)":::"memory");
    float rli[16];
    #pragma unroll
    for(int r=0;r<16;++r)rli[r]=__builtin_amdgcn_rcpf(wsf[32+crow(r,hi)]);
    bf16*Ow=O0+(long)(qb*QB+wid*QBLK)*pO;
    { bf16*stg=(bf16*)(shm+MOST)+wid*2048;
      #pragma unroll
      for(int r=0;r<16;++r){const int orow=crow(r,hi);
        #pragma unroll
        for(int d0=0;d0<2;++d0)stg[orow*64+d0*32+r32]=__float2bfloat16(o[d0][r]*rli[r]);}
      asm volatile("s_waitcnt lgkmcnt(0)":::"memory");
      #pragma unroll
      for(int i=0;i<4;++i){const int row=i*8+(lane>>3),ch=lane&7; const u32x4 v=*(const u32x4*)(stg+row*64+ch*8); ATTN_STORE16(Ow+(long)row*pO+ch*8,v);}
      asm volatile("s_waitcnt lgkmcnt(0)":::"memory"); }
  }
  asm volatile("s_waitcnt lgkmcnt(0)\n\ts_barrier":::"memory");
}
constexpr int ATTN_LDS_BYTES=LDS_BYTES;
#undef SBAR
#undef WAIT_BAR
}
namespace attn2 {
using bf16=__hip_bfloat16;
using bf16x8=__attribute__((ext_vector_type(8)))short;
using s16x4=__attribute__((ext_vector_type(4)))short;
using f32x16=__attribute__((ext_vector_type(16)))float;
using u32x4=__attribute__((ext_vector_type(4)))unsigned;
constexpr int D=64;
constexpr int NW=8,QBLK=32,QB=QBLK*NW,KVBLK=64;
constexpr int ATTN_UNIT_ROWS=QB;
__device__ __forceinline__ int crow(int r,int hi){return (r&3)+8*(r>>2)+4*hi;}
#define SBAR() __builtin_amdgcn_sched_barrier(0)
__device__ __forceinline__ void cmask(f32x16&p0,f32x16&p1,int jb,int qrel,int hi){
  const float NEG=-INFINITY; int kb=64*jb+4*hi;
  #pragma unroll
  for(int r=0;r<16;++r){int kv=kb+(r&3)+8*(r>>2); if(kv>qrel)p0[r]=NEG; if(kv+32>qrel)p1[r]=NEG;}
}

constexpr int NSLOT=3, SLOTB=8192;
constexpr int LDS_K=0, LDS_V=NSLOT*SLOTB, LDS_WS=3*NSLOT*SLOTB, LDS_OST=LDS_WS+NW*64*4, LDS_BYTES=LDS_OST+NW*4096;
constexpr float C2=0.125f*1.4426950408889634f;
__device__ __forceinline__ void glds16(const void*gsrc,unsigned lds_dst){unsigned keep;
  asm volatile("s_mov_b32 %0, m0\n\ts_mov_b32 m0, %2\n\ts_nop 0\n\tglobal_load_lds_dwordx4 %1, off\n\ts_mov_b32 m0, %0":"=&s"(keep):"v"(gsrc),"s"(lds_dst):"memory");}
__device__ __forceinline__ float max3f(float a,float b,float c){float r;asm("v_max3_f32 %0, %1, %2, %3":"=v"(r):"v"(a),"v"(b),"v"(c));return r;}
__device__ __forceinline__ float max2f(float a,float b){float r;asm("v_max_f32_e32 %0, %1, %2":"=v"(r):"v"(a),"v"(b));return r;}
__device__ __forceinline__ float fadd_s(float a,float b){float r;asm("v_add_f32_e32 %0, %1, %2":"=v"(r):"v"(a),"v"(b));return r;}
__device__ __forceinline__ float fsub_s(float a,float b){float r;asm("v_sub_f32_e32 %0, %1, %2":"=v"(r):"v"(a),"v"(b));return r;}
typedef float f32x2_t __attribute__((ext_vector_type(2))); typedef __bf16 bf16x2_t __attribute__((ext_vector_type(2)));
__device__ __forceinline__ unsigned cvtpk_s(float lo,float hi){f32x2_t v={lo,hi};bf16x2_t b=__builtin_convertvector(v,bf16x2_t);return __builtin_bit_cast(unsigned,b);}
#define WAIT_BAR(N) asm volatile("s_waitcnt vmcnt(" #N ") lgkmcnt(0)\n\ts_barrier":::"memory")

__device__ __forceinline__ void qkt(f32x16&p0,f32x16&p1,const char*Kslot,const bf16x8*qr,const f32x16&negm,int r32,int hi){
  const char*kb=Kslot+hi*1024+r32*16;
  #pragma unroll
  for(int d0=0;d0<4;++d0){
    const bf16x8 b0=*reinterpret_cast<const bf16x8*>(kb+d0*2048);
    const bf16x8 b1=*reinterpret_cast<const bf16x8*>(kb+d0*2048+512);
    if(d0==0){p0=__builtin_amdgcn_mfma_f32_32x32x16_bf16(b0,qr[0],negm,0,0,0);p1=__builtin_amdgcn_mfma_f32_32x32x16_bf16(b1,qr[0],negm,0,0,0);}
    else{p0=__builtin_amdgcn_mfma_f32_32x32x16_bf16(b0,qr[d0],p0,0,0,0);p1=__builtin_amdgcn_mfma_f32_32x32x16_bf16(b1,qr[d0],p1,0,0,0);}}
}
typedef __attribute__((address_space(3))) const char* lds_cptr;
typedef short v4i16_t __attribute__((ext_vector_type(4)));
__device__ __forceinline__ void kload8(bf16x8*kf,lds_cptr kp){
  kf[0]=*(const __attribute__((address_space(3))) bf16x8*)(kp);      kf[1]=*(const __attribute__((address_space(3))) bf16x8*)(kp+512);
  kf[2]=*(const __attribute__((address_space(3))) bf16x8*)(kp+2048); kf[3]=*(const __attribute__((address_space(3))) bf16x8*)(kp+2560);
  kf[4]=*(const __attribute__((address_space(3))) bf16x8*)(kp+4096); kf[5]=*(const __attribute__((address_space(3))) bf16x8*)(kp+4608);
  kf[6]=*(const __attribute__((address_space(3))) bf16x8*)(kp+6144); kf[7]=*(const __attribute__((address_space(3))) bf16x8*)(kp+6656);
}
__device__ __forceinline__ void kload2(bf16x8*kf,lds_cptr kp,int j){ kf[2*j]=*(const __attribute__((address_space(3))) bf16x8*)(kp+j*2048); kf[2*j+1]=*(const __attribute__((address_space(3))) bf16x8*)(kp+j*2048+512); }
__device__ __forceinline__ s16x4 vtr(lds_cptr p){ return __builtin_bit_cast(s16x4,__builtin_amdgcn_ds_read_tr16_b64_v4i16((__attribute__((address_space(3))) v4i16_t*)p)); }
__device__ __forceinline__ float rowmax(const f32x16&p0,const f32x16&p1){
  float a=max3f(p0[0],p0[1],p1[0]),b=max3f(p0[2],p0[3],p1[1]);a=max3f(a,p1[2],p1[3]);
  #pragma unroll
  for(int r=4;r<16;r+=4){a=max3f(a,p0[r],p0[r+1]);b=max3f(b,p0[r+2],p0[r+3]);a=max3f(a,p1[r],p1[r+1]);b=max3f(b,p1[r+2],p1[r+3]);}
  const float m=max2f(a,b);
  auto rr=__builtin_amdgcn_permlane32_swap(__float_as_uint(m),__float_as_uint(m),false,false);
  return max2f(__uint_as_float(rr[0]),__uint_as_float(rr[1]));
}
__device__ __forceinline__ void pv(f32x16*o,int vb,bf16x8 pa0,bf16x8 pa1,bf16x8 pa2,bf16x8 pa3){
  #pragma unroll
  for(int d0=0;d0<4;++d0){s16x4 lo[4],hi[4];
    #pragma unroll
    for(int ks=0;ks<4;++ks){
      asm volatile("ds_read_b64_tr_b16 %0,%1 offset:%c2":"=&v"(lo[ks]):"v"(vb),"i"(d0*4096+ks*1024):"memory");
      asm volatile("ds_read_b64_tr_b16 %0,%1 offset:%c2":"=&v"(hi[ks]):"v"(vb),"i"(d0*4096+ks*1024+512):"memory");}
    asm volatile("s_waitcnt lgkmcnt(0)":::"memory");SBAR();
    #define PK(k) (bf16x8){lo[k][0],lo[k][1],lo[k][2],lo[k][3],hi[k][0],hi[k][1],hi[k][2],hi[k][3]}
    o[d0]=__builtin_amdgcn_mfma_f32_32x32x16_bf16(pa0,PK(0),o[d0],0,0,0);
    o[d0]=__builtin_amdgcn_mfma_f32_32x32x16_bf16(pa1,PK(1),o[d0],0,0,0);
    o[d0]=__builtin_amdgcn_mfma_f32_32x32x16_bf16(pa2,PK(2),o[d0],0,0,0);
    o[d0]=__builtin_amdgcn_mfma_f32_32x32x16_bf16(pa3,PK(3),o[d0],0,0,0);
    #undef PK
  }
}

#ifndef ATTN_STORE16
#define ATTN_STORE16(p,v) (*(u32x4*)(p)=(v))
#endif
template<int THRL,bool CAUSAL> __device__ __forceinline__ void attn_unit(const bf16*Qu,const int pQ,const bf16*__restrict__ Kh,const bf16*__restrict__ Vh,const int pKV,bf16*Ou,const int pO,const int NT,char*shm){
  int tid_=threadIdx.x; asm volatile("":"+v"(tid_));
  const int tid=tid_,lane=tid&63,r32=lane&31,hi=lane>>5; const int wid=__builtin_amdgcn_readfirstlane(tid>>6);
  const bf16*Qw=Qu+(long)(wid*QBLK)*pQ;
  const unsigned lds0=(unsigned)(uintptr_t)shm;
  float*wsf=(float*)(shm+LDS_WS)+wid*64;
  const bf16*ksrc=Kh+(long)lane*pKV+wid*8;
  const bf16*vsrc=Vh+(long)(16*(wid&3)+(lane>>2))*pKV+(wid>>2)*32+(lane&3)*8;
  const unsigned kdst=lds0+LDS_K+wid*1024, vdst=lds0+LDS_V+wid*1024;
  #define DMA_K(t,slot) glds16(ksrc+(long)(t)*KVBLK*pKV,(unsigned)__builtin_amdgcn_readfirstlane(kdst+(slot)))
  #define DMA_V(t,slot) do{ glds16(vsrc+(long)(t)*KVBLK*pKV,(unsigned)__builtin_amdgcn_readfirstlane(vdst+2*(slot))); glds16(vsrc+(long)(t)*KVBLK*pKV+64,(unsigned)__builtin_amdgcn_readfirstlane(vdst+2*(slot)+8192)); }while(0)
  const int vb0=(int)(lds0+LDS_V)+((lane>>4)&1)*32+(lane&3)*8+(4*hi+((lane&15)>>2))*64;
  const char*Kbase=shm+LDS_K; bf16x8 kf[8];
  const lds_cptr shm3=(lds_cptr)shm; const lds_cptr kp0=shm3+LDS_K+hi*1024+r32*16; const lds_cptr vp0=shm3+LDS_V+((lane>>4)&1)*32+(lane&3)*8+(4*hi+((lane&15)>>2))*64;
  DMA_K(0,0);DMA_V(0,0);DMA_K(1,SLOTB);
  bf16x8 qr[4];
  #pragma unroll
  for(int d0=0;d0<4;++d0)qr[d0]=*reinterpret_cast<const bf16x8*>(&Qw[(long)r32*pQ+d0*16+hi*8]);
  float mhat=0.f,l_reg=0.f;f32x16 o[4];o[0]=f32x16{};o[1]=f32x16{};o[2]=f32x16{};o[3]=f32x16{};const f32x16 negm=f32x16{};
  const int qrel=wid*QBLK+r32;
  #define CMASK(P0,P1,t) do{ if(CAUSAL){int jb_=(t)-(NT-4); if(jb_>=0)cmask(P0,P1,jb_,qrel,hi);} }while(0)
  bool resc=false;
  #define START(P0,P1) do{ const float rm=rowmax(P0,P1); resc=false; \
    { const float dl=rm; mhat=fadd_s(mhat,dl); \
      _Pragma("unroll") for(int r=0;r<16;++r){P0[r]=fsub_s(P0[r],dl);P1[r]=fsub_s(P1[r],dl);} \
      } \
    _Pragma("unroll") for(int r=0;r<16;++r)P0[r]=__builtin_amdgcn_exp2f(P0[r]); }while(0)
  #define RESC() do{ if(resc){ asm volatile("s_waitcnt lgkmcnt(0)":::"memory"); \
      _Pragma("unroll") for(int d_=0;d_<4;++d_) _Pragma("unroll") for(int r=0;r<16;++r)o[d_][r]*=wsf[crow(r,hi)]; } }while(0)
  f32x16 pA0,pA1,pB0,pB1;
  int sl_prev=0,sl_cur=0,sl_next=SLOTB;
  #define ROT() do{sl_prev=sl_cur;sl_cur=sl_next;sl_next=(sl_next==(NSLOT-1)*SLOTB)?0:sl_next+SLOTB;}while(0)
  DMA_K(2,2*SLOTB);
  WAIT_BAR(4);
  qkt(pA0,pA1,Kbase,qr,negm,r32,hi);asm volatile("s_nop 15\n\ts_nop 7":"+v"(pA0),"+v"(pA1));CMASK(pA0,pA1,0);
  START(pA0,pA1);
  _Pragma("unroll") for(int r=0;r<16;++r)pA1[r]=__builtin_amdgcn_exp2f(pA1[r]);
  WAIT_BAR(0);
  DMA_K(3,0);DMA_V(1,SLOTB);
  ROT();
  kload8(kf,kp0+sl_cur);
  WAIT_BAR(3);
  s16x4 vlo[8],vhi[8]; u32x4 pw0,pw1,pw2,pw3;
  #define PKW(P,B) cvtpk_s(P[B],P[B+1])
  #define PAF(k) __builtin_bit_cast(bf16x8,pw##k)
  #define VFR(i) (bf16x8){vlo[i][0],vlo[i][1],vlo[i][2],vlo[i][3],vhi[i][0],vhi[i][1],vhi[i][2],vhi[i][3]}
  #define PIN(x) asm volatile("":"+v"(x))
  #define MX3(a,b,c) __builtin_fmaxf(__builtin_fmaxf((a),(b)),(c))
  #define GAPA(MF,A0,A1,A2,A3,W0,W1,PW) do{ MF; sacc+=A0; sacc+=A1; sacc+=A2; sacc+=A3; PIN(sacc); W0; W1; PIN(PW); SBAR(); }while(0)
  #define EX(v) __builtin_amdgcn_exp2f(v)
  #define GAPB(MF,X,B) do{ MF; X[B]=EX(X[B]); X[B+1]=EX(X[B+1]); X[B+2]=EX(X[B+2]); X[B+3]=EX(X[B+3]); PIN(X); SBAR(); }while(0)
  #define VRD(i) do{ vlo[i]=vtr(vp_+(((i)>>2)*4096+((i)&3)*1024)); vhi[i]=vtr(vp_+(((i)>>2)*4096+((i)&3)*1024+512)); }while(0)
  #define VRD2(i) do{ vlo[i]=vtr(vp_+((((i)>>2)+2)*4096+((i)&3)*1024)); vhi[i]=vtr(vp_+((((i)>>2)+2)*4096+((i)&3)*1024+512)); }while(0)
  #define GAPB2(MF,X,B) do{ MF; X[B]=EX(X[B]); X[B+1]=EX(X[B+1]); PIN(X); SBAR(); }while(0)
  #define KRD(G,j) do{ if(G){ kload2(kf,kp0+sl_next,j); SBAR(); } }while(0)
  #define STEP(C0,C1,P0,P1,t,GK,GV,GL) do{ SBAR(); \
    const lds_cptr vp_=vp0+2*sl_prev; \
    VRD(0); SBAR(); float sacc=(P0[0]+P0[1]); \
    GAPA(C0=__builtin_amdgcn_mfma_f32_32x32x16_bf16(kf[0],qr[0],negm,0,0,0), P0[2],P0[3],P0[4],P0[5],     pw0[0]=PKW(P0,0), pw0[1]=PKW(P0,2), pw0); \
    VRD(4); SBAR(); GAPA(C1=__builtin_amdgcn_mfma_f32_32x32x16_bf16(kf[1],qr[0],negm,0,0,0), P0[6],P0[7],P0[8],P0[9],     pw0[2]=PKW(P0,4), pw0[3]=PKW(P0,6), pw0); \
    VRD(1); SBAR(); GAPA(C0=__builtin_amdgcn_mfma_f32_32x32x16_bf16(kf[2],qr[1],C0,0,0,0),   P0[10],P0[11],P0[12],P0[13], pw1[0]=PKW(P0,8), pw1[1]=PKW(P0,10), pw1); \
    VRD(5); SBAR(); GAPA(C1=__builtin_amdgcn_mfma_f32_32x32x16_bf16(kf[3],qr[1],C1,0,0,0),   P0[14],P0[15],P1[0],P1[1],   pw1[2]=PKW(P0,12),pw1[3]=PKW(P0,14), pw1); \
    VRD(2); SBAR(); GAPA(C0=__builtin_amdgcn_mfma_f32_32x32x16_bf16(kf[4],qr[2],C0,0,0,0),   P1[2],P1[3],P1[4],P1[5],     pw2[0]=PKW(P1,0), pw2[1]=PKW(P1,2), pw2); \
    VRD(6); SBAR(); GAPA(C1=__builtin_amdgcn_mfma_f32_32x32x16_bf16(kf[5],qr[2],C1,0,0,0),   P1[6],P1[7],P1[8],P1[9],     pw2[2]=PKW(P1,4), pw2[3]=PKW(P1,6), pw2); \
    VRD(3); SBAR(); GAPA(C0=__builtin_amdgcn_mfma_f32_32x32x16_bf16(kf[6],qr[3],C0,0,0,0),   P1[10],P1[11],P1[12],P1[13], pw3[0]=PKW(P1,8), pw3[1]=PKW(P1,10), pw3); \
    VRD(7); SBAR(); GAPA(C1=__builtin_amdgcn_mfma_f32_32x32x16_bf16(kf[7],qr[3],C1,0,0,0),   P1[14],P1[15],0.f,0.f,       pw3[2]=PKW(P1,12),pw3[3]=PKW(P1,14), pw3); \
    l_reg+=sacc; \
    if(GK){DMA_K((t)+3,sl_cur);} if(GV){DMA_V((t)+1,sl_next);} \
    CMASK(C0,C1,t); \
    _Pragma("unroll") for(int r=0;r<16;++r){C0[r]-=mhat;C1[r]-=mhat;} \
    { float a=MX3(C0[0],C0[1],C1[0]),b=MX3(C0[2],C0[3],C1[1]); a=MX3(a,C1[2],C1[3]); \
      _Pragma("unroll") for(int r=4;r<16;r+=4){a=MX3(a,C0[r],C0[r+1]);b=MX3(b,C0[r+2],C0[r+3]);a=MX3(a,C1[r],C1[r+1]);b=MX3(b,C1[r+2],C1[r+3]);} \
      float rm=__builtin_fmaxf(a,b); { auto rr=__builtin_amdgcn_permlane32_swap(__float_as_uint(rm),__float_as_uint(rm),false,false); rm=__builtin_fmaxf(__uint_as_float(rr[0]),__uint_as_float(rr[1])); } \
      resc=false; \
      if(__builtin_expect(__any(rm>(float)THRL),0)){ const float dl=__builtin_fmaxf(rm,0.f); mhat+=dl; \
        _Pragma("unroll") for(int r=0;r<16;++r){C0[r]-=dl;C1[r]-=dl;} \
        const float f=__builtin_amdgcn_exp2f(-dl); l_reg*=f; if(hi==0)wsf[r32]=f; resc=true; } } \
    SBAR(); \
    GAPB2(o[0]=__builtin_amdgcn_mfma_f32_32x32x16_bf16(PAF(0),VFR(0),o[0],0,0,0), C0,0); VRD2(0); SBAR(); \
    GAPB2(o[1]=__builtin_amdgcn_mfma_f32_32x32x16_bf16(PAF(0),VFR(4),o[1],0,0,0), C0,2); VRD2(4); SBAR(); \
    KRD(GL,0); GAPB2(o[0]=__builtin_amdgcn_mfma_f32_32x32x16_bf16(PAF(1),VFR(1),o[0],0,0,0), C0,4); VRD2(1); SBAR(); \
    KRD(GL,1); GAPB2(o[1]=__builtin_amdgcn_mfma_f32_32x32x16_bf16(PAF(1),VFR(5),o[1],0,0,0), C0,6); VRD2(5); SBAR(); \
    KRD(GL,2); GAPB2(o[0]=__builtin_amdgcn_mfma_f32_32x32x16_bf16(PAF(2),VFR(2),o[0],0,0,0), C0,8); VRD2(2); SBAR(); \
    KRD(GL,3); GAPB2(o[1]=__builtin_amdgcn_mfma_f32_32x32x16_bf16(PAF(2),VFR(6),o[1],0,0,0), C0,10); VRD2(6); SBAR(); \
    GAPB2(o[0]=__builtin_amdgcn_mfma_f32_32x32x16_bf16(PAF(3),VFR(3),o[0],0,0,0), C0,12); VRD2(3); SBAR(); \
    GAPB2(o[1]=__builtin_amdgcn_mfma_f32_32x32x16_bf16(PAF(3),VFR(7),o[1],0,0,0), C0,14); VRD2(7); SBAR(); \
    GAPB2(o[2]=__builtin_amdgcn_mfma_f32_32x32x16_bf16(PAF(0),VFR(0),o[2],0,0,0), C1,0); \
    GAPB2(o[3]=__builtin_amdgcn_mfma_f32_32x32x16_bf16(PAF(0),VFR(4),o[3],0,0,0), C1,2); \
    GAPB2(o[2]=__builtin_amdgcn_mfma_f32_32x32x16_bf16(PAF(1),VFR(1),o[2],0,0,0), C1,4); \
    GAPB2(o[3]=__builtin_amdgcn_mfma_f32_32x32x16_bf16(PAF(1),VFR(5),o[3],0,0,0), C1,6); \
    GAPB2(o[2]=__builtin_amdgcn_mfma_f32_32x32x16_bf16(PAF(2),VFR(2),o[2],0,0,0), C1,8); \
    GAPB2(o[3]=__builtin_amdgcn_mfma_f32_32x32x16_bf16(PAF(2),VFR(6),o[3],0,0,0), C1,10); \
    GAPB2(o[2]=__builtin_amdgcn_mfma_f32_32x32x16_bf16(PAF(3),VFR(3),o[2],0,0,0), C1,12); \
    GAPB2(o[3]=__builtin_amdgcn_mfma_f32_32x32x16_bf16(PAF(3),VFR(7),o[3],0,0,0), C1,14); \
    }while(0)
  int t=1;
  #undef CMASK
  #define CMASK(P0,P1,t) do{}while(0)
  for(;t+5<NT;t+=2){
    STEP(pB0,pB1,pA0,pA1,t,true,true,true);     WAIT_BAR(3); RESC(); ROT();
    STEP(pA0,pA1,pB0,pB1,t+1,true,true,true);   WAIT_BAR(3); RESC(); ROT();
  }
  #undef CMASK
  #define CMASK(P0,P1,t) do{ if(CAUSAL){int jb_=(t)-(NT-4); if(jb_>=0)cmask(P0,P1,jb_,qrel,hi);} }while(0)
  #define ENDW(tt) do{ if((tt)+3<NT){WAIT_BAR(3);} else if((tt)+2<NT){WAIT_BAR(2);} else {WAIT_BAR(0);} }while(0)
  for(;t+1<NT;t+=2){
    STEP(pB0,pB1,pA0,pA1,t,(t+3<NT),(t+1<NT),(t+1<NT));       ENDW(t);   RESC(); ROT();
    STEP(pA0,pA1,pB0,pB1,t+1,(t+4<NT),(t+2<NT),(t+2<NT));     ENDW(t+1); RESC(); ROT();
  }
  STEP(pB0,pB1,pA0,pA1,NT-1,false,false,false); RESC();
  { float sacc=pB0[0]+pB0[1]; _Pragma("unroll") for(int r=2;r<16;++r)sacc+=pB0[r]; _Pragma("unroll") for(int r=0;r<16;++r)sacc+=pB1[r]; l_reg+=sacc;
    pw0=(u32x4){PKW(pB0,0),PKW(pB0,2),PKW(pB0,4),PKW(pB0,6)};pw1=(u32x4){PKW(pB0,8),PKW(pB0,10),PKW(pB0,12),PKW(pB0,14)};pw2=(u32x4){PKW(pB1,0),PKW(pB1,2),PKW(pB1,4),PKW(pB1,6)};pw3=(u32x4){PKW(pB1,8),PKW(pB1,10),PKW(pB1,12),PKW(pB1,14)};
    SBAR(); pv(o,vb0+2*sl_cur,PAF(0),PAF(1),PAF(2),PAF(3)); }
  #undef PKW
  #undef PAF
  #undef VFR
  #undef PIN
  #undef MX3
  #undef GAPA
  #undef GAPB
  #undef EX
  #undef VRD
  #undef VRD2
  #undef GAPB2
  #undef KRD
  #undef STEP
  #undef ENDW
  {auto rr=__builtin_amdgcn_permlane32_swap(__float_as_uint(l_reg),__float_as_uint(l_reg),false,false);l_reg=__uint_as_float(rr[0])+__uint_as_float(rr[1]);}
  if(hi==0)wsf[32+r32]=l_reg;asm volatile("s_waitcnt lgkmcnt(0)":::"memory");
  float rli[16];
  #pragma unroll
  for(int r=0;r<16;++r)rli[r]=__builtin_amdgcn_rcpf(wsf[32+crow(r,hi)]);
  bf16*Ow=Ou+(long)(wid*QBLK)*pO;
  { bf16*stg=(bf16*)(shm+LDS_OST)+wid*2048;
    #pragma unroll
    for(int hf=0;hf<2;++hf){
      #pragma unroll
      for(int r=0;r<16;++r){const int orow=crow(r,hi);
        #pragma unroll
        for(int d0=0;d0<2;++d0)stg[orow*64+d0*32+r32]=__float2bfloat16(o[2*hf+d0][r]*rli[r]);}
      asm volatile("s_waitcnt lgkmcnt(0)":::"memory");
      #pragma unroll
      for(int i=0;i<4;++i){const int row=i*8+(lane>>3),ch=lane&7; const u32x4 v=*(const u32x4*)(stg+row*64+ch*8); ATTN_STORE16(Ow+(long)row*pO+hf*64+ch*8,v);}
      asm volatile("s_waitcnt lgkmcnt(0)":::"memory"); } }
  asm volatile("s_waitcnt lgkmcnt(0)\n\ts_barrier":::"memory");
  #undef DMA_K
  #undef DMA_V
  #undef CMASK
  #undef START
  #undef RESC
  #undef ROT
}
constexpr int ATTN_LDS_BYTES=LDS_BYTES;
#undef SBAR
#undef WAIT_BAR
}

constexpr int NWAVES = 8;
#ifndef MK_N_LAUNCHES
#define MK_N_LAUNCHES 1
#endif
constexpr int NPH = 10;
constexpr int BATCH = 32, SEQ = 2048, D = 1024, T = BATCH * SEQ, NMEM = 256, TM = BATCH * NMEM;
constexpr int INCOLS = 5120, PROJW = 2048, GATEW = 3072;
constexpr float RMS_EPS = 1e-6f;
constexpr int NEXP = 16, EH = 512;
constexpr int MAXROWS = 2 * T + NEXP * 256;
constexpr size_t MiB = 1u << 20;
constexpr size_t WS_CTL = 0, CTL_ZERO_BYTES = 64 * 1024;
constexpr size_t WS_WRF = 1 * MiB;
constexpr size_t WS_RINV = 1 * MiB + 128 * 1024;
constexpr size_t WS_WIN = 2 * MiB;
constexpr size_t WS_PC = 13 * MiB;
constexpr size_t WS_WO = 15 * MiB;
constexpr size_t WS_WGU = 17 * MiB;
constexpr size_t WS_WD = 49 * MiB;
constexpr size_t WS_ROUTE = 65 * MiB;
constexpr size_t WS_KV = 68 * MiB;
constexpr size_t WS_XN = 76 * MiB;
constexpr size_t WS_BR = 76 * MiB;
constexpr size_t WS_H2 = 76 * MiB;
constexpr size_t WS_PROJ = 220 * MiB;
constexpr size_t WS_MERGED = 220 * MiB;
constexpr size_t WS_MIX = 348 * MiB;
constexpr size_t WS_HID = 220 * MiB;
constexpr size_t WS_ATTO = 476 * MiB;
constexpr size_t WS_GATES = 604 * MiB;
constexpr size_t WS_LIST = 476 * MiB;
constexpr size_t WS_RWE = 480 * MiB;
constexpr size_t WS_Y = 604 * MiB;
constexpr size_t WS_END = 988 * MiB;
static_assert(WS_XN + (size_t)(T + TM) * D * 2 <= WS_PROJ && WS_PROJ + (size_t)T * PROJW * 2 <= WS_ATTO && WS_ATTO + (size_t)T * D * 2 <= WS_GATES && WS_GATES + (size_t)T * GATEW * 2 <= WS_END, "ws map");
static_assert(WS_Y + (size_t)MAXROWS * D * 2 <= WS_END && WS_HID + (size_t)MAXROWS * EH * 2 <= WS_ATTO && WS_RWE + (size_t)NEXP * 65536 * 8 <= WS_GATES, "ws map 2");
constexpr int CW_CNT = 64;
constexpr int RING_OFF = 0, RING_BYTES = 131072;
constexpr int LDSX_OFF = RING_BYTES;
constexpr int LDS_BYTES = 147456;

#define GAS __attribute__((address_space(1)))
#define LAS __attribute__((address_space(3)))
typedef unsigned short bf16;
typedef unsigned v4u __attribute__((ext_vector_type(4)));
typedef unsigned v2u __attribute__((ext_vector_type(2)));
typedef float f32x4 __attribute__((ext_vector_type(4)));
#define LDS_WAIT() asm volatile("s_waitcnt lgkmcnt(0)" ::: "memory")
__device__ __forceinline__ unsigned f2bf(float f) { unsigned u = __builtin_bit_cast(unsigned, f); return (u + 0x7fffu + ((u >> 16) & 1u)) >> 16; }
__device__ __forceinline__ unsigned pk2(float lo, float hi) { return f2bf(lo) | (f2bf(hi) << 16); }
typedef float f32x2_t __attribute__((ext_vector_type(2))); typedef __bf16 bf16x2_t __attribute__((ext_vector_type(2)));
typedef short bf16x8_t __attribute__((ext_vector_type(8))); typedef float f32x16_t __attribute__((ext_vector_type(16)));
__device__ __forceinline__ unsigned cvtpk(float lo, float hi) { f32x2_t v = {lo, hi}; bf16x2_t b = __builtin_convertvector(v, bf16x2_t); return __builtin_bit_cast(unsigned, b); }
__device__ __forceinline__ float bflo(unsigned w) { return __uint_as_float(w << 16); }
__device__ __forceinline__ float bfhi(unsigned w) { return __uint_as_float(w & 0xffff0000u); }
__device__ __forceinline__ float wave_sum(float v) {
#pragma unroll
    for (int o = 1; o < 64; o <<= 1) v += __shfl_xor(v, o);
    return v;
}

typedef GAS unsigned gu32;
#define RLX_AGENT __ATOMIC_RELAXED, __HIP_MEMORY_SCOPE_AGENT
constexpr int CW_BAR = 4096;
constexpr int CW_TS = 128;
#define XB_TMO      128
#define XB_XCNT(j)  (256  + 64 * (j))
#define XB_XSUB(j)  (1280 + 64 * (j))
#define XB_XGEN(j)  (2304 + 64 * (j))
#define XB_TOP      3328
#define XB_TOPGEN   3392
#define XCD_BAR_WORDS 3456
#define XB_SPIN_CAP (1u << 18)

__device__ __forceinline__ unsigned xb_ld(unsigned* p)              { return __hip_atomic_load(p, __ATOMIC_RELAXED, __HIP_MEMORY_SCOPE_AGENT); }
__device__ __forceinline__ unsigned xb_add(unsigned* p, unsigned v) { return __hip_atomic_fetch_add(p, v, __ATOMIC_RELAXED, __HIP_MEMORY_SCOPE_AGENT); }
__device__ __forceinline__ unsigned xb_xcc_id() { return (unsigned)__builtin_amdgcn_s_getreg((3 << 11) | 20) & 0xFu; }
#define XB_SPIN(cond, bar) do { unsigned _sp = 0; while (cond) { __builtin_amdgcn_s_sleep(1); \
    if ((++_sp & 255u) == 0u) { if (xb_ld(&(bar)[XB_TMO])) break; if (_sp > XB_SPIN_CAP) { atomicAdd(&(bar)[XB_TMO], 1u); break; } } } } while (0)

struct XcdBarrier {
    unsigned* bar; unsigned x;
    volatile LAS unsigned* st;
};

__device__ __forceinline__ XcdBarrier xcd_barrier_post(unsigned* bar, volatile LAS unsigned* st) {
    XcdBarrier b; b.bar = bar; b.x = xb_xcc_id(); b.st = st;
    if (threadIdx.x == 0) (void)xb_add(&bar[XB_XCNT(b.x)], 1u);
    return b;
}
__device__ __forceinline__ void xcd_barrier_complete(unsigned* bar, unsigned x, unsigned& nloc, unsigned& nx) {
    const unsigned G = gridDim.x * gridDim.y * gridDim.z;
    unsigned sum, cnt, mine, sp = 0u;
    for (;;) {
        sum = 0u; cnt = 0u; mine = 0u;
#pragma unroll
        for (unsigned j = 0; j < 16; ++j) { const unsigned c = xb_ld(&bar[XB_XCNT(j)]); sum += c; cnt += (c > 0u) ? 1u : 0u; mine = (j == x) ? c : mine; }
        if (sum == G) break;
        __builtin_amdgcn_s_sleep(1);
        if ((++sp & 255u) == 0u) { if (xb_ld(&bar[XB_TMO])) break; if (sp > XB_SPIN_CAP) { atomicAdd(&bar[XB_TMO], 1u); break; } }
    }
    nloc = mine > 0u ? mine : 1u; nx = cnt > 0u ? cnt : 1u;
}

__device__ __forceinline__ void xcd_barrier(const XcdBarrier& b) {
    asm volatile("s_waitcnt vmcnt(0)" ::: "memory");
    __syncthreads();
    if (threadIdx.x == 0) {
        unsigned* bar = b.bar;
        __builtin_amdgcn_s_waitcnt(0);
        unsigned nloc = b.st[0], nx = b.st[1];
        if (nloc == 0u) { xcd_barrier_complete(bar, b.x, nloc, nx); b.st[0] = nloc; b.st[1] = nx; }
        const unsigned old = xb_add(&bar[XB_XSUB(b.x)], 1u);
        const unsigned gen = old / nloc;
        if (old + 1u == (gen + 1u) * nloc) {
            __builtin_amdgcn_fence(__ATOMIC_RELEASE, "agent");
            asm volatile("s_waitcnt vmcnt(0)" ::: "memory");
            const unsigned og = xb_add(&bar[XB_TOP], 1u);
            const unsigned tg = og / nx;
            if (og + 1u == (tg + 1u) * nx) xb_add(&bar[XB_TOPGEN], 1u);
            else XB_SPIN(xb_ld(&bar[XB_TOPGEN]) == tg, bar);
            __builtin_amdgcn_fence(__ATOMIC_ACQUIRE, "agent");
            xb_add(&bar[XB_XGEN(b.x)], 1u);
            asm volatile("s_waitcnt vmcnt(0)" ::: "memory");
        } else {
            XB_SPIN(xb_ld(&bar[XB_XGEN(b.x)]) == gen, bar);
            __builtin_amdgcn_fence(__ATOMIC_ACQUIRE, "agent");
            asm volatile("s_waitcnt vmcnt(0)" ::: "memory");
        }
    }
    __syncthreads();
}

struct Frame {
    LAS unsigned char* lds;
    unsigned* ctl;
    int vcu, G;
};

__device__ __forceinline__ void p0_tile(const float* W, int N, int k0, int n0, bf16* WT, int Kd, int drow0, LAS float* scr, int lane, const float* gk = nullptr) {
    f32x4 w[8];
#pragma unroll
    for (int i = 0; i < 8; ++i) w[i] = *(const GAS f32x4*)(W + (size_t)(k0 + i * 8 + (lane >> 3)) * N + n0 + (lane & 7) * 4);
    if (gk) {
#pragma unroll
        for (int i = 0; i < 8; ++i) w[i] = w[i] * gk[k0 + i * 8 + (lane >> 3)]; }
#pragma unroll
    for (int i = 0; i < 8; ++i) { LAS float* d = scr + (i * 8 + (lane >> 3)) * 33 + (lane & 7) * 4; d[0] = w[i].x; d[1] = w[i].y; d[2] = w[i].z; d[3] = w[i].w; }
    LDS_WAIT(); asm volatile("" ::: "memory");
    const int c = lane & 7;
#pragma unroll
    for (int j = 0; j < 4; ++j) { const int n = (lane >> 3) + 8 * j; const LAS float* s = scr + (8 * c) * 33 + n;
        v4u o; o.x = pk2(s[0 * 33], s[1 * 33]); o.y = pk2(s[2 * 33], s[3 * 33]); o.z = pk2(s[4 * 33], s[5 * 33]); o.w = pk2(s[6 * 33], s[7 * 33]);
        *(GAS v4u*)(WT + (size_t)(drow0 + n) * Kd + k0 + 8 * c) = o; }
    LDS_WAIT(); asm volatile("" ::: "memory");
}
__device__ __forceinline__ void p0_plain(const float* W, int K, int N, bf16* WT, int row_off, int item, LAS float* scr, int lane) {
    const int nblk = N / 32, kb = item / nblk, nb = item % nblk;
    p0_tile(W, N, 64 * kb, 32 * nb, WT, K, row_off + 32 * nb, scr, lane);
}
__device__ __forceinline__ void rms_row_to_bf16(const float* xrow, const float* g, bf16* orow, int lane) {
    const GAS f32x4* xr = (const GAS f32x4*)xrow + lane; const GAS f32x4* gr = (const GAS f32x4*)g + lane;
    f32x4 v[4]; float s = 0.f;
#pragma unroll
    for (int j = 0; j < 4; ++j) { v[j] = xr[64 * j]; s += (v[j].x * v[j].x + v[j].y * v[j].y) + (v[j].z * v[j].z + v[j].w * v[j].w); }
    const float r = 1.f / sqrtf(wave_sum(s) * (1.f / D) + RMS_EPS);
    GAS unsigned long long* o8 = (GAS unsigned long long*)orow + lane;
#pragma unroll
    for (int j = 0; j < 4; ++j) { const f32x4 gg = gr[64 * j]; const f32x4 h = v[j] * r * gg;
        o8[64 * j] = (unsigned long long)pk2(h.x, h.y) | ((unsigned long long)pk2(h.z, h.w) << 32); }
}

__device__ __forceinline__ void rms_rows_stream(const float* src1, const float* g1, const float* src2, const float* g2, int nT, int nAll, bf16* dst, int m0, int mstep, int lane) {
    f32x4 cur[4][4], nxt[4][4];
    if (m0 >= nAll) return;
    { const GAS f32x4* xr = (const GAS f32x4*)((m0 < nT ? src1 + (size_t)m0 * D : src2 + (size_t)(m0 - nT) * D)) + lane;
#pragma unroll
      for (int q = 0; q < 4; ++q)
#pragma unroll
          for (int j = 0; j < 4; ++j) cur[q][j] = xr[q * 256 + 64 * j]; }
    for (int m = m0; m < nAll; m += mstep) {
        const int mn = m + mstep; const bool has = mn < nAll; const int ml = has ? mn : m;
        { const GAS f32x4* xr = (const GAS f32x4*)((ml < nT ? src1 + (size_t)ml * D : src2 + (size_t)(ml - nT) * D)) + lane;
#pragma unroll
          for (int q = 0; q < 4; ++q)
#pragma unroll
              for (int j = 0; j < 4; ++j) nxt[q][j] = xr[q * 256 + 64 * j]; }
        float s[4];
#pragma unroll
        for (int q = 0; q < 4; ++q) { s[q] = 0.f;
#pragma unroll
            for (int j = 0; j < 4; ++j) s[q] += (cur[q][j].x * cur[q][j].x + cur[q][j].y * cur[q][j].y) + (cur[q][j].z * cur[q][j].z + cur[q][j].w * cur[q][j].w); }
#pragma unroll
        for (int o = 1; o < 64; o <<= 1) {
#pragma unroll
            for (int q = 0; q < 4; ++q) s[q] += __shfl_xor(s[q], o); }
        const GAS f32x4* gr = (const GAS f32x4*)(m < nT ? g1 : g2) + lane;
        f32x4 gg[4];
#pragma unroll
        for (int j = 0; j < 4; ++j) gg[j] = gr[64 * j];
#pragma unroll
        for (int q = 0; q < 4; ++q) { const float r = 1.f / sqrtf(s[q] * (1.f / D) + RMS_EPS);
            GAS unsigned long long* o8 = (GAS unsigned long long*)(dst + (size_t)(m + q) * D) + lane;
#pragma unroll
            for (int j = 0; j < 4; ++j) { const f32x4 h = cur[q][j] * r * gg[j]; o8[64 * j] = (unsigned long long)pk2(h.x, h.y) | ((unsigned long long)pk2(h.z, h.w) << 32); } }
#pragma unroll
        for (int q = 0; q < 4; ++q)
#pragma unroll
            for (int j = 0; j < 4; ++j) cur[q][j] = nxt[q][j];
    }
}

__device__ __forceinline__ void build_tile_tables(Frame& F, const int tid) {
    LAS int* TB = (LAS int*)(F.lds + LDSX_OFF); LAS unsigned char* t2e = F.lds + LDSX_OFF + 128;
    __syncthreads();
    if (tid == 0) { int acc = 0;
        for (int e = 0; e < NEXP; ++e) { const int n = (int)__hip_atomic_load(F.ctl + CW_CNT + e, __ATOMIC_RELAXED, __HIP_MEMORY_SCOPE_AGENT); TB[e] = acc; acc += (n + 255) >> 8; }
        TB[NEXP] = acc; }
    __syncthreads();
    for (int t = tid; t < 1024; t += NWAVES * 64) { int e = 0;
#pragma unroll
        for (int k = 1; k < NEXP; ++k) e += (t >= TB[k]) ? 1 : 0;
        t2e[t] = (unsigned char)e; }
    __syncthreads();
}

struct Args { const float* in[26]; float* out; unsigned char* ws; int ph_lo, ph_hi; };

__global__ void __launch_bounds__(NWAVES * 64, 2) hybrid_fwd(Args args) {
    extern __shared__ __attribute__((aligned(16))) unsigned char lds[];
    __builtin_assume(__builtin_amdgcn_workitem_id_y() == 0); __builtin_assume(__builtin_amdgcn_workitem_id_z() == 0);
    Frame F;
    F.lds = (LAS unsigned char*)lds;
    F.G = gridDim.x; { const int bx = blockIdx.x; F.vcu = (F.G % 8 == 0) ? (bx % 8) * (F.G / 8) + bx / 8 : bx; }
    F.ctl = (unsigned*)(args.ws + WS_CTL);
#define x_in (args.in[0])
#define mem_in (args.in[1])
#define norm_mix_g (args.in[2])
#define w_in (args.in[3])
#define pool_w (args.in[4])
#define pool_scale (args.in[5])
#define lam_q1 (args.in[6])
#define lam_k1 (args.in[7])
#define lam_q2 (args.in[8])
#define lam_k2 (args.in[9])
#define subln_g (args.in[10])
#define norm_mem_g (args.in[11])
#define w_mem_kv (args.in[12])
#define p_pool (args.in[13])
#define p_diff (args.in[14])
#define p_mem (args.in[15])
#define w_o (args.in[16])
#define norm_ffn_g (args.in[17])
#define w_rg (args.in[18])
#define b_rg (args.in[19])
#define w_re (args.in[20])
#define b_re (args.in[21])
#define w_eg (args.in[22])
#define w_eu (args.in[23])
#define w_ed (args.in[24])
#define final_g (args.in[25])
#define Win_t ((bf16*)(args.ws + WS_WIN))
#define Pc_t ((bf16*)(args.ws + WS_PC))
#define Wo_t ((bf16*)(args.ws + WS_WO))
#define Wgu_t ((bf16*)(args.ws + WS_WGU))
#define Wd_t ((bf16*)(args.ws + WS_WD))
#define KV ((bf16*)(args.ws + WS_KV))
#define XN ((bf16*)(args.ws + WS_XN))
#define BR ((bf16*)(args.ws + WS_BR))
#define H2 ((bf16*)(args.ws + WS_H2))
#define PROJ ((bf16*)(args.ws + WS_PROJ))
#define MERGED ((bf16*)(args.ws + WS_MERGED))
#define MIX ((bf16*)(args.ws + WS_MIX))
#define HID ((bf16*)(args.ws + WS_HID))
#define ATTO ((bf16*)(args.ws + WS_ATTO))
#define GATES ((bf16*)(args.ws + WS_GATES))
#define Y ((bf16*)(args.ws + WS_Y))
#define ROUTE ((v4u*)(args.ws + WS_ROUTE))
#define RWE ((float*)(args.ws + WS_RWE))
#define LIST ((int*)(args.ws + WS_LIST))
#define WRF ((bf16*)(args.ws + WS_WRF))
#define RINV ((float*)(args.ws + WS_RINV))
#define X1 (args.out)
    const int NGW = F.G * NWAVES;
#define PHASE_IDS int tid = threadIdx.x; asm volatile("" : "+v"(tid)); const int lane = tid & 63, wave = __builtin_amdgcn_readfirstlane(tid >> 6), gw = F.vcu * NWAVES + wave; (void)lane; (void)gw;
    const int lo = args.ph_lo, hi = args.ph_hi;
    cg::grid_group grid = cg::this_grid();
#ifndef PH_MASK
#define PH_MASK 0x3ff
#endif
#define IN(k) (((PH_MASK >> (k)) & 1) && lo <= (k) && (k) < hi)
#ifndef PROBE_A
#define PROBE_A -1
#endif
#ifndef PROBE_B
#define PROBE_B -1
#endif
#ifndef PROBE_A2
#define PROBE_A2 (PROBE_A + 1)
#endif
#ifndef PROBE_B2
#define PROBE_B2 (PROBE_B + 1)
#endif
#define STAMP(k) do { if ((PROBE_A >= 0 || PROBE_B >= 0) && blockIdx.x == 0 && threadIdx.x == 0) ((unsigned long long*)(F.ctl + CW_TS))[k] = __builtin_amdgcn_s_memrealtime(); } while (0)
#define SEAM(k) do { if (IN(k) && IN((k) + 1)) { if (hi > NPH) grid.sync(); else { XcdBarrier b_; b_.bar = (unsigned*)(args.ws + WS_CTL) + CW_BAR; b_.x = xb_xcc_id(); b_.st = (volatile LAS unsigned*)(F.lds + LDSX_OFF + 2048); xcd_barrier(b_); } } STAMP((k) + 1); } while (0)
    if (threadIdx.x < 2) ((LAS unsigned*)(F.lds + LDSX_OFF + 2048))[threadIdx.x] = 0u;
    __syncthreads();
    if (lo < hi - 1) (void)xcd_barrier_post((unsigned*)(args.ws + WS_CTL) + CW_BAR, (volatile LAS unsigned*)(F.lds + LDSX_OFF + 2048));
    STAMP(0);

    if (IN(0)) {
        PHASE_IDS
        LAS float* scr = (LAS float*)(F.lds + RING_OFF + wave * 16384);
        constexpr int I_IN = 16 * 160, I_KV = 16 * 16, I_PD = 8 * 32, I_PM = 4 * 32, I_WO = 16 * 32, I_EG = 16 * 256, I_EU = 16 * 256, I_ED = 16 * 256;
        constexpr int NITEMS = I_IN + I_KV + I_PD + I_PM + I_WO + I_EG + I_EU + I_ED;
        for (int it = gw; it < NITEMS; it += NGW) {
            int r = it;
            if (r < I_IN) { p0_plain(w_in, D, INCOLS, Win_t, 0, r, scr, lane); continue; } r -= I_IN;
            if (r < I_KV) { p0_plain(w_mem_kv, D, 512, Win_t, INCOLS, r, scr, lane); continue; } r -= I_KV;
            if (r < I_PD) { const int kb = r >> 5, nb = r & 31; p0_tile(p_diff, D, 64 * kb, 32 * nb, Pc_t + 256, D, 32 * nb, scr, lane); continue; } r -= I_PD;
            if (r < I_PM) { const int kb = r >> 5, nb = r & 31; p0_tile(p_mem, D, 64 * kb, 32 * nb, Pc_t + 768, D, 32 * nb, scr, lane); continue; } r -= I_PM;
            if (r < I_WO) { p0_plain(w_o, D, D, Wo_t, 0, r, scr, lane); continue; } r -= I_WO;
            if (r < I_EG + I_EU) { const bool up = r >= I_EG; if (up) r -= I_EG;
                const int e = r >> 8, rr = r & 255, kb = rr >> 4, nb = rr & 15, n0 = 32 * nb;
                p0_tile((up ? w_eu : w_eg) + (size_t)e * D * EH, EH, 64 * kb, n0, Wgu_t + (size_t)e * D * D, D, (n0 >> 7) * 256 + (n0 & 127) + (up ? 128 : 0), scr, lane, norm_ffn_g); continue; }
            r -= I_EG + I_EU;
            { const int e = r >> 8, rr = r & 255, kb = rr >> 5, nb = rr & 31;
              p0_tile(w_ed + (size_t)e * EH * D, D, 64 * kb, 32 * nb, Wd_t + (size_t)e * D * EH, EH, 32 * nb, scr, lane); }
        }
        STAMP(12);
        for (int idx = (F.vcu * NWAVES * 64 + tid); idx < 5120; idx += F.G * NWAVES * 64) {
            const int q = idx % 20, h = (idx / 20) & 1, hl = (idx / 40) & 1, st = idx / 80, k0 = 32 * (st >> 1) + 16 * h + 8 * (st & 1);
            float v[8];
#pragma unroll
            for (int j = 0; j < 8; ++j) { const int k = k0 + j; const float w = norm_ffn_g[k] * (q < 4 ? w_rg[k * 4 + q] : w_re[k * 16 + (q - 4)]); const float hi = bflo(f2bf(w) ); v[j] = hl ? (w - hi) : w; }
            v4u o; o.x = pk2(v[0], v[1]); o.y = pk2(v[2], v[3]); o.z = pk2(v[4], v[5]); o.w = pk2(v[6], v[7]);
            *((GAS v4u*)WRF + idx) = o;
        }
        for (int idx = (F.vcu * NWAVES * 64 + tid); idx < 256 * 1024; idx += F.G * NWAVES * 64) {
            const int kc = idx >> 10, n = idx & 1023, g = kc >> 6; float a = 0.f;
#pragma unroll 16
            for (int d = 0; d < 64; ++d) a += pool_w[kc * 64 + d] * pool_scale[g * 64 + d] * p_pool[(size_t)(g * 64 + d) * D + n];
            Pc_t[(size_t)n * D + kc] = (bf16)f2bf(a);
        }
        STAMP(13);
        rms_rows_stream(x_in, norm_mix_g, mem_in, norm_mem_g, T, T + TM, XN, gw * 4, NGW * 4, lane);
    }
    SEAM(0);

    if (IN(1)) {
        pg8::Gemm g{XN, Win_t, T, INCOLS, D};
        pg8::ProjOrder S; S.so.init(T, INCOLS, F.G, (int)blockIdx.x);
        pg8::EpiProj E{PROJ, GATES, KV, attn_body::C2};
        pg8::gemm_phase<pg8::EpiProj, pg8::ProjOrder, true, true>(F.lds + RING_OFF, g, S, E);
    }
    SEAM(1);

    if (IN(2)) {
        PHASE_IDS
        typedef attn_body::bf16 abf;
        struct DiffOrder { int vcu, G;
            __device__ __forceinline__ bool next(int i, int& bhm, int& qb) const { bhm = vcu + (i >> 3) * G; if (bhm >= BATCH * 8) return false; const int k = i & 7; qb = (k & 1) ? (k >> 1) : 7 - (k >> 1); return true; } };
        { const DiffOrder S{F.vcu, F.G}; int bhm, qb;
          for (int i = 0; S.next(i, bhm, qb); ++i) {
            const int b = bhm >> 3, h = (bhm >> 1) & 3, m = bhm & 1; const size_t rb = (size_t)b * SEQ;
            const attn2::bf16* Qu = (const attn2::bf16*)PROJ + (rb + qb * 256) * PROJW + 256 + h * 128 + m * 64;
            const attn2::bf16* Kh = (const attn2::bf16*)PROJ + rb * PROJW + 768 + h * 128 + m * 64;
            const attn2::bf16* Vh = (const attn2::bf16*)PROJ + rb * PROJW + 1280 + h * 128;
            attn2::bf16* Ou = (attn2::bf16*)ATTO + (rb + qb * 256) * D + m * 512 + h * 128;
            asm volatile("" : "+s"(Qu), "+s"(Kh), "+s"(Vh), "+s"(Ou));
            attn2::attn_unit<8, true>(Qu, PROJW, Kh, Vh, PROJW, Ou, D, 4 * (qb + 1), (char*)lds + RING_OFF); } }
        for (int mu = F.vcu; mu < BATCH * 8; mu += F.G) {
            const int b = mu >> 3, mh = (mu >> 1) & 3, half = mu & 1;
            const abf* Q0 = (const abf*)PROJ + ((size_t)b * SEQ + half * 1024) * PROJW + 1792 + mh * 64;
            const abf* Kh = (const abf*)KV + (size_t)b * NMEM * 512 + mh * 64;
            const abf* Vh = (const abf*)KV + (size_t)b * NMEM * 512 + 256 + mh * 64;
            abf* O0 = (abf*)BR + ((size_t)b * SEQ + half * 1024) * D + 768 + mh * 64;
            asm volatile("" : "+s"(Q0), "+s"(Kh), "+s"(Vh), "+s"(O0));
            attn_body::mem_attn(Q0, PROJW, Kh, Vh, 512, O0, D, 4, (char*)lds + RING_OFF); }
    }
    SEAM(2);

    if (IN(3)) {
        PHASE_IDS
        float lam;
        { const float s1 = wave_sum(lam_q1[lane] * lam_k1[lane]), s2 = wave_sum(lam_q2[lane] * lam_k2[lane]); lam = __expf(s1) - __expf(s2) + 0.2f; }
        const int gi = lane >> 4, w = 2 << gi;
        float sg[8];
#pragma unroll
        for (int i = 0; i < 8; ++i) sg[i] = subln_g[((8 * lane) & 127) + i] * 0.8f;
        for (int t = gw; t < T; t += NGW) {
            const int s = t & (SEQ - 1);
            const GAS v2u* up = (const GAS v2u*)(PROJ + (size_t)t * PROJW) + lane;
            const v2u ut = up[0];
            float a0 = 0.f, a1 = 0.f, a2 = 0.f, a3 = 0.f;
            const int nw = (w < s + 1) ? w : s + 1;
            v2u wq[16];
#pragma unroll
            for (int j = 0; j < 16; ++j) { wq[j] = (v2u){0u, 0u}; if (j < nw) wq[j] = *(const GAS v2u*)((const GAS bf16*)up - (size_t)j * PROJW); }
#pragma unroll
            for (int j = 0; j < 16; ++j) { a0 += bflo(wq[j].x); a1 += bfhi(wq[j].x); a2 += bflo(wq[j].y); a3 += bfhi(wq[j].y); }
            const float inv = 1.f / (float)nw;
            v2u po; po.x = pk2(a0 * inv - bflo(ut.x), a1 * inv - bfhi(ut.x)); po.y = pk2(a2 * inv - bflo(ut.y), a3 * inv - bfhi(ut.y));
            *((GAS v2u*)(BR + (size_t)t * D) + lane) = po;
            const v4u o0 = *((const GAS v4u*)(ATTO + (size_t)t * D) + lane), o1 = *((const GAS v4u*)(ATTO + (size_t)t * D + 512) + lane);
            float xv[8];
            xv[0] = bflo(o0.x) - lam * bflo(o1.x); xv[1] = bfhi(o0.x) - lam * bfhi(o1.x); xv[2] = bflo(o0.y) - lam * bflo(o1.y); xv[3] = bfhi(o0.y) - lam * bfhi(o1.y);
            xv[4] = bflo(o0.z) - lam * bflo(o1.z); xv[5] = bfhi(o0.z) - lam * bfhi(o1.z); xv[6] = bflo(o0.w) - lam * bflo(o1.w); xv[7] = bfhi(o0.w) - lam * bfhi(o1.w);
            float ss = 0.f;
#pragma unroll
            for (int i = 0; i < 8; ++i) ss += xv[i] * xv[i];
            ss += __shfl_xor(ss, 1); ss += __shfl_xor(ss, 2); ss += __shfl_xor(ss, 4); ss += __shfl_xor(ss, 8);
            const float r = 1.f / sqrtf(ss * (1.f / 128.f) + RMS_EPS);
            v4u od; od.x = pk2(xv[0] * r * sg[0], xv[1] * r * sg[1]); od.y = pk2(xv[2] * r * sg[2], xv[3] * r * sg[3]); od.z = pk2(xv[4] * r * sg[4], xv[5] * r * sg[5]); od.w = pk2(xv[6] * r * sg[6], xv[7] * r * sg[7]);
            *((GAS v4u*)(BR + (size_t)t * D + 256) + lane) = od;
        }
    }
    SEAM(3);

    if (IN(4)) {
        pg8::StaticOrder S; S.init(T, D, F.G, (int)blockIdx.x);
        pg8::Gemm g{BR, Pc_t, T, D, D}; pg8::EpiMerge E{GATES, MERGED}; pg8::MidRescale MH{GATES};
        pg8::gemm_phase<pg8::EpiMerge, pg8::StaticOrder, true, true, pg8::MidRescale>(F.lds + RING_OFF, g, S, E, MH);
    }
    SEAM(4);

    if (IN(5)) {
        pg8::Gemm g{MERGED, Wo_t, T, D, D}; pg8::StaticOrder S; S.init(T, D, F.G, (int)blockIdx.x);
        pg8::EpiMix E{MIX};
        pg8::gemm_phase<pg8::EpiMix, pg8::StaticOrder, true, true>(F.lds + RING_OFF, g, S, E);
    }
    SEAM(5);

    if (IN(6)) {
        PHASE_IDS
        LAS v4u* WL = (LAS v4u*)(F.lds + RING_OFF);
        LAS float* SC = (LAS float*)(F.lds + RING_OFF + 81920) + wave * 1024;
        LAS v4u* REC = (LAS v4u*)(F.lds + RING_OFF + 81920 + 32768);
        LAS unsigned* LCNT = (LAS unsigned*)(F.lds + RING_OFF + 81920 + 32768 + 4096);
        LAS unsigned* LBASE = LCNT + 16; LAS float* RIL = (LAS float*)(LCNT + 32);
        for (int idx = tid; idx < 5120; idx += NWAVES * 64) WL[idx] = *((const GAS v4u*)WRF + idx);
        float bg[4], be[16];
#pragma unroll
        for (int i = 0; i < 4; ++i) bg[i] = b_rg[i];
#pragma unroll
        for (int i = 0; i < 16; ++i) be[i] = b_re[i];
        const int r32 = lane & 31, hh = lane >> 5;
        for (int rb0 = F.vcu * 256; rb0 < T; rb0 += F.G * 256) {
            if (tid < 16) LCNT[tid] = 0u;
            __syncthreads();
            const int li = wave * 32 + r32, row = rb0 + li;
            const GAS f32x4* xp = (const GAS f32x4*)(x_in + (size_t)row * D + 16 * hh);
            const GAS v4u* mp = (const GAS v4u*)(MIX + (size_t)row * D + 16 * hh);
            GAS v4u* hp = (GAS v4u*)(H2 + (size_t)row * D + 16 * hh);
            const LAS v4u* wl = WL + hh * 20 + r32;
            f32x16_t acc = {}; float ss = 0.f;
            f32x4 cur[8]; v4u curm[4];
#pragma unroll
            for (int i = 0; i < 8; ++i) cur[i] = xp[(i >> 2) * 8 + (i & 3)];
#pragma unroll
            for (int i = 0; i < 4; ++i) curm[i] = mp[(i >> 1) * 4 + (i & 1)];
#pragma unroll 1
            for (int sp2 = 0; sp2 < 16; ++sp2) {
                f32x4 nxt[8]; v4u nxtm[4];
                const int spn = (sp2 + 1 < 16) ? sp2 + 1 : sp2;
#pragma unroll
                for (int i = 0; i < 8; ++i) nxt[i] = xp[(2 * spn + (i >> 2)) * 8 + (i & 3)];
#pragma unroll
                for (int i = 0; i < 4; ++i) nxtm[i] = mp[(2 * spn + (i >> 1)) * 4 + (i & 1)];
#pragma unroll
                for (int i = 0; i < 4; ++i) { const v4u mm = curm[i];
                    cur[2 * i].x += bflo(mm.x); cur[2 * i].y += bfhi(mm.x); cur[2 * i].z += bflo(mm.y); cur[2 * i].w += bfhi(mm.y);
                    cur[2 * i + 1].x += bflo(mm.z); cur[2 * i + 1].y += bfhi(mm.z); cur[2 * i + 1].z += bflo(mm.w); cur[2 * i + 1].w += bfhi(mm.w); }
#pragma unroll
                for (int u = 0; u < 2; ++u) { const int sp = 2 * sp2 + u;
                    v4u ahi[2], alo[2];
#pragma unroll
                    for (int e = 0; e < 2; ++e) { const f32x4 a = cur[4 * u + 2 * e], b = cur[4 * u + 2 * e + 1];
                        ss += (a.x * a.x + a.y * a.y) + (a.z * a.z + a.w * a.w) + (b.x * b.x + b.y * b.y) + (b.z * b.z + b.w * b.w);
                        v4u h; h.x = cvtpk(a.x, a.y); h.y = cvtpk(a.z, a.w); h.z = cvtpk(b.x, b.y); h.w = cvtpk(b.z, b.w); ahi[e] = h;
                        v4u l; l.x = cvtpk(a.x - bflo(h.x), a.y - bfhi(h.x)); l.y = cvtpk(a.z - bflo(h.y), a.w - bfhi(h.y)); l.z = cvtpk(b.x - bflo(h.z), b.y - bfhi(h.z)); l.w = cvtpk(b.z - bflo(h.w), b.w - bfhi(h.w)); alo[e] = l; }
                    hp[sp * 4] = ahi[0]; hp[sp * 4 + 1] = ahi[1];
#pragma unroll
                    for (int e = 0; e < 2; ++e) { const int st = 2 * sp + e;
                        v4u bh = {0u, 0u, 0u, 0u}, bl = {0u, 0u, 0u, 0u};
                        if (r32 < 20) { bh = wl[(st * 4) * 20]; bl = wl[(st * 4 + 2) * 20]; }
                        acc = __builtin_amdgcn_mfma_f32_32x32x16_bf16(__builtin_bit_cast(bf16x8_t, ahi[e]), __builtin_bit_cast(bf16x8_t, bh), acc, 0, 0, 0);
                        acc = __builtin_amdgcn_mfma_f32_32x32x16_bf16(__builtin_bit_cast(bf16x8_t, alo[e]), __builtin_bit_cast(bf16x8_t, bh), acc, 0, 0, 0);
                        acc = __builtin_amdgcn_mfma_f32_32x32x16_bf16(__builtin_bit_cast(bf16x8_t, ahi[e]), __builtin_bit_cast(bf16x8_t, bl), acc, 0, 0, 0); } }
#pragma unroll
                for (int i = 0; i < 8; ++i) cur[i] = nxt[i];
#pragma unroll
                for (int i = 0; i < 4; ++i) curm[i] = nxtm[i];
            }
            ss += __shfl_xor(ss, 32);
            const float rinv = 1.f / sqrtf(ss * (1.f / D) + RMS_EPS);
#pragma unroll
            for (int r = 0; r < 16; ++r) SC[((r & 3) + 8 * (r >> 2) + 4 * hh) * 32 + r32] = acc[r];
            LDS_WAIT();
            if (lane < 32) {
                float lg[20];
#pragma unroll
                for (int q4 = 0; q4 < 5; ++q4) { const f32x4 t4 = *(const LAS f32x4*)(SC + lane * 32 + 4 * q4); lg[4 * q4] = t4.x * rinv; lg[4 * q4 + 1] = t4.y * rinv; lg[4 * q4 + 2] = t4.z * rinv; lg[4 * q4 + 3] = t4.w * rinv; }
                float gl[4];
#pragma unroll
                for (int i = 0; i < 4; ++i) gl[i] = lg[i] + bg[i];
                int gidx = 0; float gmax = gl[0];
#pragma unroll
                for (int i = 1; i < 4; ++i) if (gl[i] > gmax) { gmax = gl[i]; gidx = i; }
                float gsum = 0.f;
#pragma unroll
                for (int i = 0; i < 4; ++i) gsum += __expf(gl[i] - gmax);
                const float gp = 1.f / gsum;
                float el[4];
#pragma unroll
                for (int j = 0; j < 4; ++j) { const float l0 = lg[4 + j] + be[j], l1 = lg[8 + j] + be[4 + j], l2 = lg[12 + j] + be[8 + j], l3 = lg[16 + j] + be[12 + j];
                    el[j] = gidx == 0 ? l0 : gidx == 1 ? l1 : gidx == 2 ? l2 : l3; }
                int i0 = 0; float m0 = el[0];
#pragma unroll
                for (int j = 1; j < 4; ++j) if (el[j] > m0) { m0 = el[j]; i0 = j; }
                int i1 = -1; float m1 = -3.0e38f;
#pragma unroll
                for (int j = 0; j < 4; ++j) if (j != i0 && el[j] > m1) { m1 = el[j]; i1 = j; }
                if (i1 < 0) { i1 = (i0 + 1) & 3; m1 = m0; }
                const float p1 = __expf(m1 - m0);
                const float w0 = gp / (1.f + p1), w1 = gp * p1 / (1.f + p1);
                const unsigned e0 = (unsigned)(gidx * 4 + i0), e1 = (unsigned)(gidx * 4 + i1);
                const unsigned s0 = __hip_atomic_fetch_add(LCNT + e0, 1u, __ATOMIC_RELAXED, __HIP_MEMORY_SCOPE_WORKGROUP), s1 = __hip_atomic_fetch_add(LCNT + e1, 1u, __ATOMIC_RELAXED, __HIP_MEMORY_SCOPE_WORKGROUP);
                v4u rc; rc.x = (e0 << 20) | s0; rc.y = (e1 << 20) | s1; rc.z = __float_as_uint(w0); rc.w = __float_as_uint(w1); REC[li] = rc;
                RINV[row] = rinv; RIL[li] = rinv;
            }
            __syncthreads();
            if (tid < 16) LBASE[tid] = __hip_atomic_fetch_add(F.ctl + CW_CNT + tid, LCNT[tid], __ATOMIC_RELAXED, __HIP_MEMORY_SCOPE_AGENT);
            __syncthreads();
            if (tid < 256) { v4u rc = REC[tid]; rc.x += LBASE[rc.x >> 20]; rc.y += LBASE[rc.y >> 20]; *((GAS v4u*)ROUTE + rb0 + tid) = rc;
                const unsigned i0 = ((rc.x >> 20) << 16) + (rc.x & 0xFFFFFu), i1 = ((rc.y >> 20) << 16) + (rc.y & 0xFFFFFu); const float ri = RIL[tid];
                LIST[i0] = rb0 + tid; LIST[i1] = rb0 + tid; RWE[2 * i0] = ri; RWE[2 * i0 + 1] = __uint_as_float(rc.z); RWE[2 * i1] = ri; RWE[2 * i1 + 1] = __uint_as_float(rc.w); }
            __syncthreads();
        }
    }
    SEAM(6);

    if (IN(7)) {
        PHASE_IDS
        build_tile_tables(F, tid);
        const LAS int* TB = (const LAS int*)(F.lds + LDSX_OFF); const LAS unsigned char* t2e = (const LAS unsigned char*)(F.lds + LDSX_OFF + 128);
        LAS int* TOKL = (LAS int*)(F.lds + LDSX_OFF + 4096);
        const int nunits = TB[NEXP] * 4;
        for (int i = 0; i < 11; ++i) { const int L = i * F.G + F.vcu; if (L >= nunits) break;
            const int pm = L >> 2, e = t2e[pm], lt = pm - TB[e];
            if (tid < 256) { unsigned tok = (unsigned)LIST[(e << 16) + lt * 256 + tid]; tok = tok < (unsigned)T ? tok : (unsigned)(T - 1); TOKL[i * 256 + tid] = (int)tok; } }
        __syncthreads();
        pg8::Gemm g{H2, Wgu_t, T, NEXP * D, D};
        pg8::MoeOrder S{t2e, nunits, F.G, F.vcu};
        pg8::EpiGateUp E{HID, RWE, TB};
        pg8::gemm_phase<pg8::EpiGateUp, pg8::MoeOrder, true, true, pg8::NoMid, true>(F.lds + RING_OFF, g, S, E, pg8::NoMid(), TOKL);
    }
    SEAM(7);

    if (IN(8)) {
        PHASE_IDS
        build_tile_tables(F, tid);
        const LAS int* TB = (const LAS int*)(F.lds + LDSX_OFF);
        pg8::Gemm g{HID, Wd_t, MAXROWS, NEXP * D, EH};
        pg8::MoeOrder S{(const LAS unsigned char*)(F.lds + LDSX_OFF + 128), TB[NEXP] * 4, F.G, F.vcu};
        pg8::EpiDown E{Y};
        pg8::gemm_phase<pg8::EpiDown, pg8::MoeOrder, true, true>(F.lds + RING_OFF, g, S, E);
    }
    SEAM(8);

    if (IN(9)) {
        PHASE_IDS
        build_tile_tables(F, tid);
        const LAS int* TB = (const LAS int*)(F.lds + LDSX_OFF);
        for (int t = gw; t < T; t += NGW) {
            const v4u rc = *((const GAS v4u*)ROUTE + t);
            const size_t r0 = (size_t)TB[rc.x >> 20] * 256 + (rc.x & 0xFFFFFu), r1 = (size_t)TB[rc.y >> 20] * 256 + (rc.y & 0xFFFFFu);
            GAS f32x4* xr = (GAS f32x4*)(X1 + (size_t)t * D) + lane; const GAS f32x4* gr = (const GAS f32x4*)final_g + lane; const GAS v2u* hr = (const GAS v2u*)(H2 + (size_t)t * D) + lane;
            const GAS v2u* y0 = (const GAS v2u*)(Y + r0 * D) + lane; const GAS v2u* y1 = (const GAS v2u*)(Y + r1 * D) + lane;
            f32x4 v[4]; float s = 0.f;
#pragma unroll
            for (int j = 0; j < 4; ++j) { const v2u hx = hr[64 * j]; v[j] = (f32x4){bflo(hx.x), bfhi(hx.x), bflo(hx.y), bfhi(hx.y)}; const v2u a = y0[64 * j], b = y1[64 * j];
                v[j].x += bflo(a.x) + bflo(b.x); v[j].y += bfhi(a.x) + bfhi(b.x); v[j].z += bflo(a.y) + bflo(b.y); v[j].w += bfhi(a.y) + bfhi(b.y);
                s += (v[j].x * v[j].x + v[j].y * v[j].y) + (v[j].z * v[j].z + v[j].w * v[j].w); }
            const float r = 1.f / sqrtf(wave_sum(s) * (1.f / D) + RMS_EPS);
#pragma unroll
            for (int j = 0; j < 4; ++j) { f32x4 o = v[j] * r * gr[64 * j];
                if (PROBE_B >= 0 && blockIdx.x == 0 && (t / NGW) < 8) {
                    const unsigned long long* ts = (const unsigned long long*)(F.ctl + CW_TS); const float amp = sqrtf((float)((ts[PROBE_B2] - ts[PROBE_B]) / 100) * 1e-3f);
                    o.x += amp; o.y += amp; o.z += amp; o.w += amp; }
                xr[64 * j] = o; }
        }
        STAMP(10);
        if (PROBE_A >= 0 && blockIdx.x == 0 && threadIdx.x == 0) {
            const unsigned long long* ts = (const unsigned long long*)(F.ctl + CW_TS);
            X1[0] += 4.f + (float)((ts[PROBE_A2] - ts[PROBE_A]) / 100) * 0.01f; }
    }
#undef IN
#undef SEAM
#undef STAMP
#undef PHASE_IDS
#undef x_in
#undef mem_in
#undef norm_mix_g
#undef w_in
#undef pool_w
#undef pool_scale
#undef lam_q1
#undef lam_k1
#undef lam_q2
#undef lam_k2
#undef subln_g
#undef norm_mem_g
#undef w_mem_kv
#undef p_pool
#undef p_diff
#undef p_mem
#undef w_o
#undef norm_ffn_g
#undef w_rg
#undef b_rg
#undef w_re
#undef b_re
#undef w_eg
#undef w_eu
#undef w_ed
#undef final_g
#undef Win_t
#undef Pc_t
#undef Wo_t
#undef Wgu_t
#undef Wd_t
#undef KV
#undef XN
#undef BR
#undef H2
#undef PROJ
#undef MERGED
#undef MIX
#undef HID
#undef ATTO
#undef GATES
#undef Y
#undef ROUTE
#undef RWE
#undef LIST
#undef WRF
#undef RINV
#undef X1
}

extern "C" void kernel_launch(void* const* d_in, const int* in_sizes, int n_in, void* d_out, int out_size, void* d_ws, size_t ws_size, hipStream_t stream) {
    static int grid = 0;
    if (grid == 0) {
        if (n_in != 26 || in_sizes[0] != T * D || out_size != T * D || ws_size < WS_END) { fprintf(stderr, "kernel_launch: unexpected problem: n_in %d in0 %d out %d ws %zu (need %zu)\n", n_in, n_in > 0 ? in_sizes[0] : -1, out_size, ws_size, (size_t)WS_END); grid = -1; return; }
        int dev = 0, cus = 0, per_cu = 0;
        if (hipGetDevice(&dev) != hipSuccess || hipDeviceGetAttribute(&cus, hipDeviceAttributeMultiprocessorCount, dev) != hipSuccess) { fprintf(stderr, "kernel_launch: device query failed\n"); grid = -1; return; }
        if (hipFuncSetAttribute((const void*)hybrid_fwd, hipFuncAttributeMaxDynamicSharedMemorySize, LDS_BYTES) != hipSuccess) { fprintf(stderr, "kernel_launch: hipFuncSetAttribute failed\n"); grid = -1; return; }
        if (hipOccupancyMaxActiveBlocksPerMultiprocessor(&per_cu, (const void*)hybrid_fwd, NWAVES * 64, LDS_BYTES) != hipSuccess || per_cu < 1) { fprintf(stderr, "kernel_launch: occupancy query says %d blocks per CU\n", per_cu); grid = -1; return; }
        (void)hipGetLastError();
        grid = cus;
        if (grid > 256) grid = 256;
    }
    if (grid < 0) return;
    if (hipMemsetAsync((char*)d_ws + WS_CTL, 0, CTL_ZERO_BYTES, stream) != hipSuccess) { fprintf(stderr, "kernel_launch: memset failed\n"); return; }
    Args a{};
    for (int i = 0; i < 26; ++i) a.in[i] = (const float*)d_in[i];
    a.out = (float*)d_out; a.ws = (unsigned char*)d_ws;
#if MK_N_LAUNCHES == 1
    a.ph_lo = 0; a.ph_hi = NPH;
    void* kargs[] = {&a};
    hipError_t e = hipLaunchCooperativeKernel((const void*)hybrid_fwd, dim3(grid), dim3(NWAVES * 64), kargs, LDS_BYTES, stream);
    if (e != hipSuccess) fprintf(stderr, "kernel_launch: cooperative launch failed: %s (grid %d)\n", hipGetErrorString(e), grid);
#else
    for (int p = 0; p < NPH; ++p) { a.ph_lo = p; a.ph_hi = p + 1;
        hipLaunchKernelGGL(hybrid_fwd, dim3(grid), dim3(NWAVES * 64), LDS_BYTES, stream, a);
        const hipError_t le = hipPeekAtLastError(); if (le != hipSuccess) { fprintf(stderr, "kernel_launch: launch %d failed: %s\n", p, hipGetErrorName(le)); break; } }
#endif
}
```

```cpp
#include <hip/hip_runtime.h>
#include <hip/hip_cooperative_groups.h>
#include <cstdio>
#include <cstdint>
namespace cg = cooperative_groups;
namespace pg8 {
#define PG8_LAS __attribute__((address_space(3)))
typedef unsigned short bf16_t;
typedef short bf16x8 __attribute__((ext_vector_type(8)));
typedef float f32x4 __attribute__((ext_vector_type(4)));
typedef unsigned u32x4 __attribute__((ext_vector_type(4)));
constexpr int BM = 256, BK = 64, HALF = 128, HTB = HALF * BK * 2  , STAGE_BYTES = 8 * HTB, NXCD = 8, WGM = 8;

__host__ __device__ __forceinline__ int lds_byte(int r, int c) { const int st = (r >> 4) * 2 + (c >> 5), rr = r & 15, cc = c & 31, ob = rr * 64 + cc * 2; return st * 1024 + (ob ^ (((ob >> 9) & 1) << 5)); }
__host__ __device__ __forceinline__ void stage_rc(int b, int& R, int& C) { const int st = b / 1024, sb = b % 1024, swz = sb ^ (((sb >> 9) & 1) << 5); R = (st >> 1) * 16 + swz / 64; C = (st & 1) * 32 + (swz % 64) / 2; }
__host__ __device__ __forceinline__ int perm32(int rho) { const int n = rho >> 4, i = rho & 15; return 8 * (i >> 2) + 4 * n + (i & 3); }

struct Unit { int pm, pn; };
struct Gemm { const bf16_t* A; const bf16_t* Bt; int M, N, K; };

struct StaticOrder {
    int nM, nN, nwg, G, c;
    __host__ __device__ void init(int M, int N, int G_, int c_) { nM = M / BM; nN = N / BM; nwg = nM * nN; G = G_; c = c_; }
    __host__ __device__ bool next(int i, Unit& u) const {
        const long L = (long)i * G + c; if (L >= nwg) return false;
        int wgid = (int)L; { const int q = nwg / NXCD, r = nwg % NXCD, xcd = wgid % NXCD, off = wgid / NXCD; wgid = (xcd < r ? xcd * (q + 1) : r * (q + 1) + (xcd - r) * q) + off; }
        const int nig = WGM * nN, gid = wgid / nig, fm = gid * WGM, gsz = (nM - fm) < WGM ? (nM - fm) : WGM;
        u.pm = fm + ((wgid % nig) % gsz); u.pn = (wgid % nig) / gsz; return true;
    }
    __device__ __forceinline__ void a_ready(const Unit&) const {}
    __device__ __forceinline__ void done(const Unit&) const {}
};

__device__ __forceinline__ unsigned cvt_pk_bf16(float lo, float hi) { unsigned r; asm volatile("v_cvt_pk_bf16_f32 %0, %1, %2" : "=v"(r) : "v"(lo), "v"(hi)); return r; }
typedef unsigned u32x2 __attribute__((ext_vector_type(2)));
__device__ __forceinline__ float bf_lo(unsigned w) { return __uint_as_float(w << 16); }
__device__ __forceinline__ float bf_hi(unsigned w) { return __uint_as_float(w & 0xffff0000u); }
__device__ __forceinline__ float sigmoid_f(float x) { return __builtin_amdgcn_rcpf(1.0f + __builtin_amdgcn_exp2f(-1.4426950408889634f * x)); }
__device__ __forceinline__ u32x4 pack8(const f32x4 a, const f32x4 b) { u32x4 w; w.x = cvt_pk_bf16(a[0], a[1]); w.y = cvt_pk_bf16(a[2], a[3]); w.z = cvt_pk_bf16(b[0], b[1]); w.w = cvt_pk_bf16(b[2], b[3]); return w; }

struct ProjOrder {
    StaticOrder so;
    __device__ __forceinline__ bool next(int i, Unit& u) const {
        const long L = (long)i * so.G + so.c;
        if (L < so.nwg) return so.next(i, u);
        const int x = (int)(L - so.nwg); if (x >= 64) return false;
        u.pm = 256 + (x >> 1); u.pn = 20 + (x & 1); return true;
    }
    __device__ __forceinline__ void a_ready(const Unit&) const {}
    __device__ __forceinline__ void done(const Unit&) const {}
};
struct MoeOrder {
    const PG8_LAS unsigned char* t2e; int nunits, G, c;
    __device__ __forceinline__ bool next(int i, Unit& u) const {
        const int L = i * G + c; if (L >= nunits) return false;
        const int pm = L >> 2; u.pm = pm; u.pn = (int)t2e[pm] * 4 + (L & 3); return true;
    }
    __device__ __forceinline__ void a_ready(const Unit&) const {}
    __device__ __forceinline__ void done(const Unit&) const {}
};

struct EpiProj {
    static constexpr bool PERM = true, AFTER_DRAIN = false;
    bf16_t* PROJ; bf16_t* GATES; bf16_t* KV; float qscale;
    __device__ __forceinline__ void operator()(const f32x4 (&acc)[2][2][4][2], const Unit& u, int wr, int wc, int fr, int fq) const {
        bf16_t* base; int ldc, colt, mode = 0; float sc = 1.f; int rowt = u.pm * BM;
        if (u.pm >= 256) { base = KV; ldc = 512; colt = (u.pn - 20) * BM; rowt -= 65536; }
        else if (u.pn < 8) { base = PROJ; ldc = 2048; colt = u.pn * BM; if (u.pn == 1 || u.pn == 2 || u.pn == 7) sc = qscale; }
        else { base = GATES; ldc = 3072; colt = (u.pn - 8) * BM; mode = 1; }
        const int row0 = rowt + wr * 64 + fr, col0 = colt + wc * 32 + 8 * fq;
#pragma unroll
        for (int ai = 0; ai < 2; ++ai)
#pragma unroll
            for (int m = 0; m < 4; ++m) { bf16_t* rowp = base + (size_t)(row0 + ai * HALF + m * 16) * ldc + col0;
#pragma unroll
                for (int bj = 0; bj < 2; ++bj) { f32x4 v0 = acc[ai][bj][m][0], v1 = acc[ai][bj][m][1];
                    if (mode) {
#pragma unroll
                        for (int i = 0; i < 4; ++i) { v0[i] = sigmoid_f(v0[i]); v1[i] = sigmoid_f(v1[i]); } }
                    else { v0 = v0 * sc; v1 = v1 * sc; }
                    *(u32x4*)(rowp + bj * HALF) = pack8(v0, v1); } }
    }
};
__device__ __forceinline__ float gclamp(float g) { return __builtin_fmaxf(g, 1e-18f); }
struct MidRescale {
    static constexpr bool ON = true; static constexpr int T0 = 4, T1 = 12;
    const bf16_t* GATES;
    __device__ __forceinline__ void operator()(f32x4 (&acc)[2][2][4][2], const Unit& u, int t, int wr, int wc, int fr, int fq) const {
        int fr_ = fr; asm volatile("" : "+v"(fr_));
        const int row0 = u.pm * BM + wr * 64 + fr_, col0 = u.pn * BM + wc * 32 + 8 * fq; const int gprev = (t == T0) ? 0 : 1024;
        const unsigned off0 = ((unsigned)row0 * 3072u + (unsigned)(gprev + col0)) * 2u;
#pragma unroll
        for (int ai = 0; ai < 2; ++ai) {
            u32x4 ga[4][2], gb[4][2];
#pragma unroll
            for (int m = 0; m < 4; ++m) { const char* gp = (const char*)GATES + (off0 + (unsigned)((ai * HALF + m * 16) * 3072 * 2));
#pragma unroll
                for (int bj = 0; bj < 2; ++bj) { ga[m][bj] = *(const u32x4*)(gp + bj * HALF * 2); gb[m][bj] = *(const u32x4*)(gp + 2048 + bj * HALF * 2); } }
#pragma unroll
            for (int m = 0; m < 4; ++m)
#pragma unroll
                for (int bj = 0; bj < 2; ++bj) { const u32x4 a = ga[m][bj], b = gb[m][bj];
                    f32x4 r0, r1;
                    r0[0] = bf_lo(a.x) * __builtin_amdgcn_rcpf(gclamp(bf_lo(b.x))); r0[1] = bf_hi(a.x) * __builtin_amdgcn_rcpf(gclamp(bf_hi(b.x)));
                    r0[2] = bf_lo(a.y) * __builtin_amdgcn_rcpf(gclamp(bf_lo(b.y))); r0[3] = bf_hi(a.y) * __builtin_amdgcn_rcpf(gclamp(bf_hi(b.y)));
                    r1[0] = bf_lo(a.z) * __builtin_amdgcn_rcpf(gclamp(bf_lo(b.z))); r1[1] = bf_hi(a.z) * __builtin_amdgcn_rcpf(gclamp(bf_hi(b.z)));
                    r1[2] = bf_lo(a.w) * __builtin_amdgcn_rcpf(gclamp(bf_lo(b.w))); r1[3] = bf_hi(a.w) * __builtin_amdgcn_rcpf(gclamp(bf_hi(b.w)));
                    acc[ai][bj][m][0] = acc[ai][bj][m][0] * r0; acc[ai][bj][m][1] = acc[ai][bj][m][1] * r1; }
            asm volatile("" ::: "memory"); }
    }
};
struct EpiMerge {
    static constexpr bool PERM = true, AFTER_DRAIN = false;
    const bf16_t* GATES; bf16_t* MERGED;
    __device__ __forceinline__ void operator()(const f32x4 (&acc)[2][2][4][2], const Unit& u, int wr, int wc, int fr, int fq) const {
        const int row0 = u.pm * BM + wr * 64 + fr, col0 = u.pn * BM + wc * 32 + 8 * fq;
        const unsigned off0 = ((unsigned)row0 * 3072u + (unsigned)(2048 + col0)) * 2u;
        u32x4 gg[2][4][2];
#pragma unroll
        for (int ai = 0; ai < 2; ++ai)
#pragma unroll
            for (int m = 0; m < 4; ++m)
#pragma unroll
                for (int bj = 0; bj < 2; ++bj) gg[ai][m][bj] = *(const u32x4*)((const char*)GATES + (off0 + (unsigned)((ai * HALF + m * 16) * 3072 * 2)) + bj * HALF * 2);
#pragma unroll
        for (int ai = 0; ai < 2; ++ai)
#pragma unroll
            for (int m = 0; m < 4; ++m) { const size_t r = (size_t)(row0 + ai * HALF + m * 16);
#pragma unroll
                for (int bj = 0; bj < 2; ++bj) { const int c = col0 + bj * HALF; const u32x4 g = gg[ai][m][bj];
                    f32x4 v0 = acc[ai][bj][m][0], v1 = acc[ai][bj][m][1];
                    v0[0] *= gclamp(bf_lo(g.x)); v0[1] *= gclamp(bf_hi(g.x)); v0[2] *= gclamp(bf_lo(g.y)); v0[3] *= gclamp(bf_hi(g.y));
                    v1[0] *= gclamp(bf_lo(g.z)); v1[1] *= gclamp(bf_hi(g.z)); v1[2] *= gclamp(bf_lo(g.w)); v1[3] *= gclamp(bf_hi(g.w));
                    *(u32x4*)(MERGED + r * 1024 + c) = pack8(v0, v1); } }
    }
};
struct EpiMix {
    static constexpr bool PERM = true, AFTER_DRAIN = false;
    bf16_t* MIX;
    __device__ __forceinline__ void operator()(const f32x4 (&acc)[2][2][4][2], const Unit& u, int wr, int wc, int fr, int fq) const {
        const int row0 = u.pm * BM + wr * 64 + fr, col0 = u.pn * BM + wc * 32 + 8 * fq;
#pragma unroll
        for (int ai = 0; ai < 2; ++ai)
#pragma unroll
            for (int m = 0; m < 4; ++m) { bf16_t* rowp = MIX + (size_t)(row0 + ai * HALF + m * 16) * 1024 + col0;
#pragma unroll
                for (int bj = 0; bj < 2; ++bj) *(u32x4*)(rowp + bj * HALF) = pack8(acc[ai][bj][m][0], acc[ai][bj][m][1]); }
    }
};
struct EpiWo {
    static constexpr bool PERM = false, AFTER_DRAIN = false;
    const float* X; float* X1;
    __device__ __forceinline__ void operator()(const f32x4 (&acc)[2][2][4][2], const Unit& u, int wr, int wc, int fr, int fq) const {
        const int row0 = u.pm * BM + wr * 64 + fr, col0 = u.pn * BM + wc * 32 + 4 * fq;
#pragma unroll
        for (int ai = 0; ai < 2; ++ai)
#pragma unroll
            for (int m = 0; m < 4; ++m) { const size_t off = (size_t)(row0 + ai * HALF + m * 16) * 1024 + col0;
#pragma unroll
                for (int bj = 0; bj < 2; ++bj)
#pragma unroll
                    for (int n = 0; n < 2; ++n) { const size_t o = off + bj * HALF + n * 16; *(f32x4*)(X1 + o) = *(const f32x4*)(X + o) + acc[ai][bj][m][n]; } }
    }
};
struct EpiGateUp {
    static constexpr bool PERM = true, AFTER_DRAIN = false;
    bf16_t* HID; const float* RWE; const PG8_LAS int* TB;
    __device__ __forceinline__ void operator()(const f32x4 (&acc)[2][2][4][2], const Unit& u, int wr, int wc, int fr, int fq) const {
        const int row0 = u.pm * BM + wr * 64 + fr, colh = (u.pn & 3) * 128 + wc * 32 + 8 * fq;
#pragma unroll
        for (int ai = 0; ai < 2; ++ai)
#pragma unroll
            for (int m = 0; m < 4; ++m) { const size_t r = (size_t)(row0 + ai * HALF + m * 16); const size_t es = (size_t)((u.pn >> 2) << 16) + (r - (size_t)TB[u.pn >> 2] * 256); const float ri = RWE[2 * es], w = RWE[2 * es + 1];
                f32x4 h0, h1;
#pragma unroll
                for (int i = 0; i < 4; ++i) { const float g0 = acc[ai][0][m][0][i] * ri, g1 = acc[ai][0][m][1][i] * ri; const float wr_ = w * ri;
                    h0[i] = g0 * sigmoid_f(g0) * acc[ai][1][m][0][i] * wr_; h1[i] = g1 * sigmoid_f(g1) * acc[ai][1][m][1][i] * wr_; }
                *(u32x4*)(HID + r * 512 + colh) = pack8(h0, h1); }
    }
};
struct EpiDown {
    static constexpr bool PERM = true, AFTER_DRAIN = false;
    bf16_t* Y;
    __device__ __forceinline__ void operator()(const f32x4 (&acc)[2][2][4][2], const Unit& u, int wr, int wc, int fr, int fq) const {
        const int row0 = u.pm * BM + wr * 64 + fr, col0 = (u.pn & 3) * BM + wc * 32 + 8 * fq;
#pragma unroll
        for (int ai = 0; ai < 2; ++ai)
#pragma unroll
            for (int m = 0; m < 4; ++m) { bf16_t* rowp = Y + (size_t)(row0 + ai * HALF + m * 16) * 1024 + col0;
#pragma unroll
                for (int bj = 0; bj < 2; ++bj) *(u32x4*)(rowp + bj * HALF) = pack8(acc[ai][bj][m][0], acc[ai][bj][m][1]); }
    }
};

struct NoMid { static constexpr bool ON = false; static constexpr int T0 = -1, T1 = -1; __device__ __forceinline__ void operator()(f32x4 (&)[2][2][4][2], const Unit&, int, int, int, int, int) const {} };
template <class Epi, class Sched, bool ALIGN_EPI = false, bool SP2 = false, class Mid = NoMid, bool GATHER = false>
__device__ __forceinline__ void gemm_phase(PG8_LAS unsigned char* lds, const Gemm g, const Sched& S, const Epi& E, const Mid& MH = Mid(), const PG8_LAS int* tokl = nullptr) {
    int tid_ = threadIdx.x; asm volatile("" : "+v"(tid_));
    const int tid = tid_, wid = __builtin_amdgcn_readfirstlane(tid >> 6), lane = tid & 63, wr = wid >> 2, wc = wid & 3, fr = lane & 15, fq = lane >> 4;
    static_assert(!GATHER || SP2, "GATHER is written for the SP2 loop");
    const int K = g.K, nt = K / BK;
    unsigned voffA[2], voffB[2];
#pragma unroll
    for (int i = 0; i < 2; ++i) { int R, C; stage_rc(tid * 16 + i * 8192, R, C); const int Rb = Epi::PERM ? ((R & ~31) + perm32(R & 31)) : R;
        voffA[i] = (unsigned)(R * K + C) * 2u; voffB[i] = (unsigned)(Rb * K + C) * 2u; }
    const size_t kstep = (size_t)(BK * 2);
    const size_t hstep = (size_t)HALF * K * 2;
    const size_t tstep = 2 * hstep;
    const unsigned ldsw = (unsigned)wid * 1024u;
    const int aoff = lds_byte(wr * 64 + fr, fq * 8), boff = lds_byte(wc * 32 + fr, fq * 8);
    unsigned vGc[2][2], vGn[2][2]; int gR[2], gC[2];
    if constexpr (GATHER) {
#pragma unroll
        for (int i = 0; i < 2; ++i) { stage_rc(tid * 16 + i * 8192, gR[i], gC[i]); }
    }
#define PG8_GOFFS(dst, u_) do { if constexpr (GATHER) { _Pragma("unroll") for (int hh_ = 0; hh_ < 2; ++hh_) _Pragma("unroll") for (int i_ = 0; i_ < 2; ++i_) \
        dst[hh_][i_] = ((unsigned)tokl[(u_) * 256 + hh_ * HALF + gR[i_]] * (unsigned)K + (unsigned)gC[i_]) * 2u; } } while (0)
#define PG8_STGA(bufoff, base, hh, nx) do { if constexpr (GATHER) { _Pragma("unroll") for (int _i = 0; _i < 2; ++_i) \
        __builtin_amdgcn_global_load_lds((const unsigned*)((const char*)(base) + ((nx) ? vGn[hh][_i] : vGc[hh][_i])), (PG8_LAS unsigned*)(lds + (bufoff) + ldsw + _i * 8192), 16, 0, 0); } \
      else { PG8_STAGE(bufoff, (base) + (hh) * hstep, voffA); } } while (0)
#define PG8_SA(b, h) (((b) * 2 + (h)) * HTB)
#define PG8_SB(b, h) ((4 + (b) * 2 + (h)) * HTB)
#define PG8_STAGE(bufoff, gbase, voff) do { _Pragma("unroll") for (int _i = 0; _i < 2; ++_i) \
        __builtin_amdgcn_global_load_lds((const unsigned*)((const char*)(gbase) + (voff)[_i]), (PG8_LAS unsigned*)(lds + (bufoff) + ldsw + _i * 8192), 16, 0, 0); } while (0)
#define PG8_LDA(dst, b, h) do { _Pragma("unroll") for (int m = 0; m < 4; ++m) _Pragma("unroll") for (int k = 0; k < 2; ++k) dst[m][k] = *(const PG8_LAS bf16x8*)(lds + PG8_SA(b, h) + aoff + m * 2048 + k * 1024); } while (0)
#define PG8_LDB(dst, b, h) do { _Pragma("unroll") for (int n = 0; n < 2; ++n) _Pragma("unroll") for (int k = 0; k < 2; ++k) dst[n][k] = *(const PG8_LAS bf16x8*)(lds + PG8_SB(b, h) + boff + n * 2048 + k * 1024); } while (0)
#define PG8_MMA(ai, bj, At, Bt) do { __builtin_amdgcn_s_setprio(1); _Pragma("unroll") for (int m = 0; m < 4; ++m) _Pragma("unroll") for (int n = 0; n < 2; ++n) _Pragma("unroll") for (int k = 0; k < 2; ++k) \
        acc[ai][bj][m][n] = __builtin_amdgcn_mfma_f32_16x16x32_bf16(Bt[n][k], At[m][k], acc[ai][bj][m][n], 0, 0, 0); __builtin_amdgcn_s_setprio(0); } while (0)
#define PG8_WAIT_V(n) asm volatile("s_waitcnt vmcnt(" #n ")" ::: "memory")
#define PG8_WAIT_L(n) asm volatile("s_waitcnt lgkmcnt(" #n ")" ::: "memory")
#define PG8_BAR __builtin_amdgcn_s_barrier()
#define PG8_SCHED __builtin_amdgcn_sched_barrier(0)
    Unit cur, nxt; int ui = 0;
    if (!S.next(0, cur)) return;
    f32x4 acc[2][2][4][2];
#pragma unroll
    for (int a = 0; a < 2; ++a)
#pragma unroll
        for (int b = 0; b < 2; ++b)
#pragma unroll
            for (int m = 0; m < 4; ++m)
#pragma unroll
                for (int n = 0; n < 2; ++n) acc[a][b][m][n] = (f32x4){0.f, 0.f, 0.f, 0.f};
    bf16x8 At[4][2], B0[2][2], B1[2][2];
    const char* cA = (const char*)g.A + (GATHER ? (size_t)0 : (size_t)cur.pm * tstep); const char* cB = (const char*)g.Bt + (size_t)cur.pn * tstep;
    PG8_GOFFS(vGc, 0); PG8_GOFFS(vGn, 0);
    S.a_ready(cur);
    if constexpr (SP2) {
        PG8_STAGE(PG8_SB(0, 0), cB, voffB); PG8_STAGE(PG8_SB(0, 1), cB + hstep, voffB); PG8_STGA(PG8_SA(0, 0), cA, 0, false); PG8_STGA(PG8_SA(0, 1), cA, 1, false);
        if (wr == 1) PG8_BAR;
        PG8_WAIT_V(2); PG8_BAR;
        PG8_STAGE(PG8_SB(1, 0), cB + kstep, voffB); PG8_STGA(PG8_SA(1, 0), cA + kstep, 0, false); PG8_STAGE(PG8_SB(1, 1), cB + hstep + kstep, voffB);
        PG8_WAIT_V(6); PG8_BAR;
    } else {
        PG8_STAGE(PG8_SB(0, 0), cB, voffB); PG8_STAGE(PG8_SA(0, 0), cA, voffA); PG8_STAGE(PG8_SB(0, 1), cB + hstep, voffB); PG8_STAGE(PG8_SA(0, 1), cA + hstep, voffA);
        if (wr == 1) PG8_BAR;
        PG8_WAIT_V(4); PG8_BAR;
        PG8_STAGE(PG8_SB(1, 0), cB + kstep, voffB); PG8_STAGE(PG8_SA(1, 0), cA + kstep, voffA); PG8_STAGE(PG8_SB(1, 1), cB + hstep + kstep, voffB);
        PG8_WAIT_V(6); PG8_BAR;
    }
    for (;;) {
        const bool has_next = S.next(ui + 1, nxt);
        if (has_next) PG8_GOFFS(vGn, ui + 1);
        const char* nA = (has_next && !GATHER) ? (const char*)g.A + (size_t)nxt.pm * tstep : cA; const char* nB = has_next ? (const char*)g.Bt + (size_t)nxt.pn * tstep : cB;
        for (int t = 0; t < nt; t += 2) {
            if constexpr (Mid::ON) { if (t == Mid::T0 || t == Mid::T1) MH(acc, cur, t, wr, wc, fr, fq); }
            const bool last = (t == nt - 2);
            const char* a1 = cA + (size_t)(t + 1) * kstep;
            const char* a2 = last ? nA : cA + (size_t)(t + 2) * kstep; const char* b2 = last ? nB : cB + (size_t)(t + 2) * kstep;
            const char* a3 = a2 + kstep; const char* b3 = b2 + kstep;
            if (last && has_next) S.a_ready(nxt);
            if constexpr (SP2) {
            PG8_LDB(B0, 0, 0); PG8_LDB(B1, 0, 1); PG8_SCHED; PG8_LDA(At, 0, 0); PG8_STGA(PG8_SA(1, 1), a1, 1, false);
            PG8_WAIT_V(8); PG8_WAIT_L(0); PG8_BAR; PG8_MMA(0, 0, At, B0); PG8_MMA(0, 1, At, B1); PG8_BAR; PG8_SCHED;
            PG8_LDA(At, 0, 1); PG8_STAGE(PG8_SB(0, 0), b2, voffB); PG8_STAGE(PG8_SB(0, 1), b2 + hstep, voffB); PG8_STGA(PG8_SA(0, 0), a2, 0, last && has_next);
            PG8_WAIT_V(8); PG8_WAIT_L(0); PG8_BAR; PG8_MMA(1, 0, At, B0); PG8_MMA(1, 1, At, B1); PG8_BAR; PG8_SCHED;
            PG8_LDB(B0, 1, 0); PG8_LDB(B1, 1, 1); PG8_SCHED; PG8_LDA(At, 1, 0); PG8_STGA(PG8_SA(0, 1), a2, 1, last && has_next);
            PG8_WAIT_V(8); PG8_WAIT_L(0); PG8_BAR; PG8_MMA(0, 0, At, B0); PG8_MMA(0, 1, At, B1); PG8_BAR; PG8_SCHED;
            PG8_LDA(At, 1, 1); PG8_STAGE(PG8_SB(1, 0), b3, voffB); PG8_STAGE(PG8_SB(1, 1), b3 + hstep, voffB); PG8_STGA(PG8_SA(1, 0), a3, 0, last && has_next);
            PG8_WAIT_V(8); PG8_WAIT_L(0); PG8_BAR; PG8_MMA(1, 0, At, B0); PG8_MMA(1, 1, At, B1); PG8_BAR; PG8_SCHED;
            } else {
            PG8_LDB(B0, 0, 0); PG8_SCHED; PG8_LDA(At, 0, 0); PG8_STAGE(PG8_SA(1, 1), a1 + hstep, voffA);
            PG8_WAIT_L(8); PG8_BAR; PG8_WAIT_L(0); PG8_MMA(0, 0, At, B0); PG8_BAR; PG8_SCHED;
            PG8_LDB(B1, 0, 1); PG8_STAGE(PG8_SB(0, 0), b2, voffB);
            PG8_BAR; PG8_WAIT_L(0); PG8_MMA(0, 1, At, B1); PG8_BAR;
            PG8_LDA(At, 0, 1); PG8_STAGE(PG8_SA(0, 0), a2, voffA);
            PG8_BAR; PG8_WAIT_L(0); PG8_MMA(1, 0, At, B0); PG8_BAR; PG8_SCHED;
            PG8_STAGE(PG8_SB(0, 1), b2 + hstep, voffB);
            PG8_WAIT_V(6); PG8_BAR; PG8_MMA(1, 1, At, B1); PG8_BAR;
            PG8_LDB(B0, 1, 0); PG8_SCHED; PG8_LDA(At, 1, 0); PG8_STAGE(PG8_SA(0, 1), a2 + hstep, voffA);
            PG8_WAIT_L(8); PG8_BAR; PG8_WAIT_L(0); PG8_MMA(0, 0, At, B0); PG8_BAR; PG8_SCHED;
            PG8_LDB(B1, 1, 1); PG8_STAGE(PG8_SB(1, 0), b3, voffB);
            PG8_BAR; PG8_WAIT_L(0); PG8_MMA(0, 1, At, B1); PG8_BAR;
            PG8_LDA(At, 1, 1); PG8_STAGE(PG8_SA(1, 0), a3, voffA);
            PG8_BAR; PG8_WAIT_L(0); PG8_MMA(1, 0, At, B0); PG8_BAR; PG8_SCHED;
            PG8_STAGE(PG8_SB(1, 1), b3 + hstep, voffB);
            PG8_WAIT_V(6); PG8_BAR; PG8_MMA(1, 1, At, B1); PG8_BAR;
            }
        }
        if constexpr (ALIGN_EPI) { if (wr == 0) PG8_BAR; }
        if constexpr (!Epi::AFTER_DRAIN) { E(acc, cur, wr, wc, fr, fq); S.done(cur); }
        if (!has_next) break;
#pragma unroll
        for (int a = 0; a < 2; ++a)
#pragma unroll
            for (int b = 0; b < 2; ++b)
#pragma unroll
                for (int m = 0; m < 4; ++m)
#pragma unroll
                    for (int n = 0; n < 2; ++n) acc[a][b][m][n] = (f32x4){0.f, 0.f, 0.f, 0.f};
        cur = nxt; cA = nA; cB = nB; ++ui;
        if constexpr (GATHER) { _Pragma("unroll") for (int hh_ = 0; hh_ < 2; ++hh_) _Pragma("unroll") for (int i_ = 0; i_ < 2; ++i_) vGc[hh_][i_] = vGn[hh_][i_]; }
        if constexpr (ALIGN_EPI) { if (wr == 1) PG8_BAR; }
    }
    PG8_WAIT_V(0);
    if constexpr (!ALIGN_EPI) { if (wr == 0) PG8_BAR; }
    PG8_BAR;
    if constexpr (Epi::AFTER_DRAIN) { E.fused(acc, cur, wr, wc, fr, fq, lds, wid, lane); S.done(cur); }
#undef PG8_SA
#undef PG8_SB
#undef PG8_STAGE
#undef PG8_STGA
#undef PG8_GOFFS
#undef PG8_LDA
#undef PG8_LDB
#undef PG8_MMA
#undef PG8_WAIT_V
#undef PG8_WAIT_L
#undef PG8_BAR
#undef PG8_SCHED
}
}
#include <hip/hip_bf16.h>
#include <cmath>
namespace attn_body {
using bf16=__hip_bfloat16;
using bf16x8=__attribute__((ext_vector_type(8)))short;
using s16x4=__attribute__((ext_vector_type(4)))short;
using f32x16=__attribute__((ext_vector_type(16)))float;
using u32x4=__attribute__((ext_vector_type(4)))unsigned;
constexpr int D=64;
constexpr int NW=8,QBLK=32,QB=QBLK*NW,KVBLK=64;
constexpr int ATTN_UNIT_ROWS=QB;
__device__ __forceinline__ int crow(int r,int hi){return (r&3)+8*(r>>2)+4*hi;}
#define SBAR() __builtin_amdgcn_sched_barrier(0)
__device__ __forceinline__ void cmask(f32x16&p0,f32x16&p1,int jb,int qrel,int hi){
  const float NEG=-INFINITY; int kb=64*jb+4*hi;
  #pragma unroll
  for(int r=0;r<16;++r){int kv=kb+(r&3)+8*(r>>2); if(kv>qrel)p0[r]=NEG; if(kv+32>qrel)p1[r]=NEG;}
}

constexpr int NSLOT=3, SLOTB=8192;
constexpr int LDS_K=0, LDS_V=NSLOT*SLOTB, LDS_WS=2*NSLOT*SLOTB, LDS_OST=LDS_WS+NW*64*4, LDS_BYTES=LDS_OST+NW*4096;
constexpr float C2=0.125f*1.4426950408889634f;
__device__ __forceinline__ void glds16(const void*gsrc,unsigned lds_dst){unsigned keep;
  asm volatile("s_mov_b32 %0, m0\n\ts_mov_b32 m0, %2\n\ts_nop 0\n\tglobal_load_lds_dwordx4 %1, off\n\ts_mov_b32 m0, %0":"=&s"(keep):"v"(gsrc),"s"(lds_dst):"memory");}
__device__ __forceinline__ float max3f(float a,float b,float c){float r;asm("v_max3_f32 %0, %1, %2, %3":"=v"(r):"v"(a),"v"(b),"v"(c));return r;}
__device__ __forceinline__ float max2f(float a,float b){float r;asm("v_max_f32_e32 %0, %1, %2":"=v"(r):"v"(a),"v"(b));return r;}
__device__ __forceinline__ float fadd_s(float a,float b){float r;asm("v_add_f32_e32 %0, %1, %2":"=v"(r):"v"(a),"v"(b));return r;}
__device__ __forceinline__ float fsub_s(float a,float b){float r;asm("v_sub_f32_e32 %0, %1, %2":"=v"(r):"v"(a),"v"(b));return r;}
typedef float f32x2_t __attribute__((ext_vector_type(2))); typedef __bf16 bf16x2_t __attribute__((ext_vector_type(2)));
__device__ __forceinline__ unsigned cvtpk_s(float lo,float hi){f32x2_t v={lo,hi};bf16x2_t b=__builtin_convertvector(v,bf16x2_t);return __builtin_bit_cast(unsigned,b);}
#define WAIT_BAR(N) asm volatile("s_waitcnt vmcnt(" #N ") lgkmcnt(0)\n\ts_barrier":::"memory")

__device__ __forceinline__ void qkt(f32x16&p0,f32x16&p1,const char*Kslot,const bf16x8*qr,const f32x16&negm,int r32,int hi){
  const char*kb=Kslot+hi*1024+r32*16;
  #pragma unroll
  for(int d0=0;d0<4;++d0){
    const bf16x8 b0=*reinterpret_cast<const bf16x8*>(kb+d0*2048);
    const bf16x8 b1=*reinterpret_cast<const bf16x8*>(kb+d0*2048+512);
    if(d0==0){p0=__builtin_amdgcn_mfma_f32_32x32x16_bf16(b0,qr[0],negm,0,0,0);p1=__builtin_amdgcn_mfma_f32_32x32x16_bf16(b1,qr[0],negm,0,0,0);}
    else{p0=__builtin_amdgcn_mfma_f32_32x32x16_bf16(b0,qr[d0],p0,0,0,0);p1=__builtin_amdgcn_mfma_f32_32x32x16_bf16(b1,qr[d0],p1,0,0,0);}}
}
typedef __attribute__((address_space(3))) const char* lds_cptr;
typedef short v4i16_t __attribute__((ext_vector_type(4)));
__device__ __forceinline__ void kload8(bf16x8*kf,lds_cptr kp){
  kf[0]=*(const __attribute__((address_space(3))) bf16x8*)(kp);      kf[1]=*(const __attribute__((address_space(3))) bf16x8*)(kp+512);
  kf[2]=*(const __attribute__((address_space(3))) bf16x8*)(kp+2048); kf[3]=*(const __attribute__((address_space(3))) bf16x8*)(kp+2560);
  kf[4]=*(const __attribute__((address_space(3))) bf16x8*)(kp+4096); kf[5]=*(const __attribute__((address_space(3))) bf16x8*)(kp+4608);
  kf[6]=*(const __attribute__((address_space(3))) bf16x8*)(kp+6144); kf[7]=*(const __attribute__((address_space(3))) bf16x8*)(kp+6656);
}
__device__ __forceinline__ void kload2(bf16x8*kf,lds_cptr kp,int j){ kf[2*j]=*(const __attribute__((address_space(3))) bf16x8*)(kp+j*2048); kf[2*j+1]=*(const __attribute__((address_space(3))) bf16x8*)(kp+j*2048+512); }
__device__ __forceinline__ s16x4 vtr(lds_cptr p){ return __builtin_bit_cast(s16x4,__builtin_amdgcn_ds_read_tr16_b64_v4i16((__attribute__((address_space(3))) v4i16_t*)p)); }
__device__ __forceinline__ float rowmax(const f32x16&p0,const f32x16&p1){
  float a=max3f(p0[0],p0[1],p1[0]),b=max3f(p0[2],p0[3],p1[1]);a=max3f(a,p1[2],p1[3]);
  #pragma unroll
  for(int r=4;r<16;r+=4){a=max3f(a,p0[r],p0[r+1]);b=max3f(b,p0[r+2],p0[r+3]);a=max3f(a,p1[r],p1[r+1]);b=max3f(b,p1[r+2],p1[r+3]);}
  const float m=max2f(a,b);
  auto rr=__builtin_amdgcn_permlane32_swap(__float_as_uint(m),__float_as_uint(m),false,false);
  return max2f(__uint_as_float(rr[0]),__uint_as_float(rr[1]));
}
__device__ __forceinline__ void pv(f32x16*o,int vb,bf16x8 pa0,bf16x8 pa1,bf16x8 pa2,bf16x8 pa3){
  #pragma unroll
  for(int d0=0;d0<2;++d0){s16x4 lo[4],hi[4];
    #pragma unroll
    for(int ks=0;ks<4;++ks){
      asm volatile("ds_read_b64_tr_b16 %0,%1 offset:%c2":"=&v"(lo[ks]):"v"(vb),"i"(d0*4096+ks*1024):"memory");
      asm volatile("ds_read_b64_tr_b16 %0,%1 offset:%c2":"=&v"(hi[ks]):"v"(vb),"i"(d0*4096+ks*1024+512):"memory");}
    asm volatile("s_waitcnt lgkmcnt(0)":::"memory");SBAR();
    #define PK(k) (bf16x8){lo[k][0],lo[k][1],lo[k][2],lo[k][3],hi[k][0],hi[k][1],hi[k][2],hi[k][3]}
    o[d0]=__builtin_amdgcn_mfma_f32_32x32x16_bf16(pa0,PK(0),o[d0],0,0,0);
    o[d0]=__builtin_amdgcn_mfma_f32_32x32x16_bf16(pa1,PK(1),o[d0],0,0,0);
    o[d0]=__builtin_amdgcn_mfma_f32_32x32x16_bf16(pa2,PK(2),o[d0],0,0,0);
    o[d0]=__builtin_amdgcn_mfma_f32_32x32x16_bf16(pa3,PK(3),o[d0],0,0,0);
    #undef PK
  }
}

#ifndef ATTN_STORE16
#define ATTN_STORE16(p,v) (*(u32x4*)(p)=(v))
#endif
template<int THRL,bool CAUSAL> __device__ __forceinline__ void attn_unit(const bf16*Qu,const int pQ,const bf16*__restrict__ Kh,const bf16*__restrict__ Vh,const int pKV,bf16*Ou,const int pO,const int NT,char*shm){
  int tid_=threadIdx.x; asm volatile("":"+v"(tid_));
  const int tid=tid_,lane=tid&63,r32=lane&31,hi=lane>>5; const int wid=__builtin_amdgcn_readfirstlane(tid>>6);
  const bf16*Qw=Qu+(long)(wid*QBLK)*pQ;
  const unsigned lds0=(unsigned)(uintptr_t)shm;
  float*wsf=(float*)(shm+LDS_WS)+wid*64;
  const bf16*ksrc=Kh+(long)lane*pKV+wid*8;
  const bf16*vsrc=Vh+(long)(16*(wid&3)+(lane>>2))*pKV+(wid>>2)*32+(lane&3)*8;
  const unsigned kdst=lds0+LDS_K+wid*1024, vdst=lds0+LDS_V+wid*1024;
  #define DMA_K(t,slot) glds16(ksrc+(long)(t)*KVBLK*pKV,(unsigned)__builtin_amdgcn_readfirstlane(kdst+(slot)))
  #define DMA_V(t,slot) glds16(vsrc+(long)(t)*KVBLK*pKV,(unsigned)__builtin_amdgcn_readfirstlane(vdst+(slot)))
  const int vb0=(int)(lds0+LDS_V)+((lane>>4)&1)*32+(lane&3)*8+(4*hi+((lane&15)>>2))*64;
  const char*Kbase=shm+LDS_K; bf16x8 kf[8];
  const lds_cptr shm3=(lds_cptr)shm; const lds_cptr kp0=shm3+LDS_K+hi*1024+r32*16; const lds_cptr vp0=shm3+LDS_V+((lane>>4)&1)*32+(lane&3)*8+(4*hi+((lane&15)>>2))*64;
  DMA_K(0,0);DMA_V(0,0);DMA_K(1,SLOTB);
  bf16x8 qr[4];
  #pragma unroll
  for(int d0=0;d0<4;++d0)qr[d0]=*reinterpret_cast<const bf16x8*>(&Qw[(long)r32*pQ+d0*16+hi*8]);
  float mhat=0.f,l_reg=0.f;f32x16 o[2];o[0]=f32x16{};o[1]=f32x16{};const f32x16 negm=f32x16{};
  const int qrel=wid*QBLK+r32;
  #define CMASK(P0,P1,t) do{ if(CAUSAL){int jb_=(t)-(NT-4); if(jb_>=0)cmask(P0,P1,jb_,qrel,hi);} }while(0)
  bool resc=false;
  #define START(P0,P1) do{ const float rm=rowmax(P0,P1); resc=false; \
    { const float dl=rm; mhat=fadd_s(mhat,dl); \
      _Pragma("unroll") for(int r=0;r<16;++r){P0[r]=fsub_s(P0[r],dl);P1[r]=fsub_s(P1[r],dl);} \
      } \
    _Pragma("unroll") for(int r=0;r<16;++r)P0[r]=__builtin_amdgcn_exp2f(P0[r]); }while(0)
  #define RESC() do{ if(resc){ asm volatile("s_waitcnt lgkmcnt(0)":::"memory"); \
      _Pragma("unroll") for(int d_=0;d_<2;++d_) _Pragma("unroll") for(int r=0;r<16;++r)o[d_][r]*=wsf[crow(r,hi)]; } }while(0)
  f32x16 pA0,pA1,pB0,pB1;
  int sl_prev=0,sl_cur=0,sl_next=SLOTB;
  #define ROT() do{sl_prev=sl_cur;sl_cur=sl_next;sl_next=(sl_next==(NSLOT-1)*SLOTB)?0:sl_next+SLOTB;}while(0)
  DMA_K(2,2*SLOTB);
  WAIT_BAR(3);
  qkt(pA0,pA1,Kbase,qr,negm,r32,hi);asm volatile("s_nop 15\n\ts_nop 7":"+v"(pA0),"+v"(pA1));CMASK(pA0,pA1,0);
  START(pA0,pA1);
  _Pragma("unroll") for(int r=0;r<16;++r)pA1[r]=__builtin_amdgcn_exp2f(pA1[r]);
  WAIT_BAR(0);
  DMA_K(3,0);DMA_V(1,SLOTB);
  ROT();
  kload8(kf,kp0+sl_cur);
  WAIT_BAR(2);
  s16x4 vlo[8],vhi[8]; u32x4 pw0,pw1,pw2,pw3;
  #define PKW(P,B) cvtpk_s(P[B],P[B+1])
  #define PAF(k) __builtin_bit_cast(bf16x8,pw##k)
  #define VFR(i) (bf16x8){vlo[i][0],vlo[i][1],vlo[i][2],vlo[i][3],vhi[i][0],vhi[i][1],vhi[i][2],vhi[i][3]}
  #define PIN(x) asm volatile("":"+v"(x))
  #define MX3(a,b,c) __builtin_fmaxf(__builtin_fmaxf((a),(b)),(c))
  #define GAPA(MF,A0,A1,A2,A3,W0,W1,PW) do{ MF; sacc+=A0; sacc+=A1; sacc+=A2; sacc+=A3; PIN(sacc); W0; W1; PIN(PW); SBAR(); }while(0)
  #define EX(v) __builtin_amdgcn_exp2f(v)
  #define GAPB(MF,X,B) do{ MF; X[B]=EX(X[B]); X[B+1]=EX(X[B+1]); X[B+2]=EX(X[B+2]); X[B+3]=EX(X[B+3]); PIN(X); SBAR(); }while(0)
  #define VRD(i) do{ vlo[i]=vtr(vp_+(((i)>>2)*4096+((i)&3)*1024)); vhi[i]=vtr(vp_+(((i)>>2)*4096+((i)&3)*1024+512)); }while(0)
  #define KRD(G,j) do{ if(G){ kload2(kf,kp0+sl_next,j); SBAR(); } }while(0)
  #define STEP(C0,C1,P0,P1,t,GK,GV,GL) do{ SBAR(); \
    const lds_cptr vp_=vp0+sl_prev; \
    VRD(0); SBAR(); float sacc=(P0[0]+P0[1]); \
    GAPA(C0=__builtin_amdgcn_mfma_f32_32x32x16_bf16(kf[0],qr[0],negm,0,0,0), P0[2],P0[3],P0[4],P0[5],     pw0[0]=PKW(P0,0), pw0[1]=PKW(P0,2), pw0); \
    VRD(4); SBAR(); GAPA(C1=__builtin_amdgcn_mfma_f32_32x32x16_bf16(kf[1],qr[0],negm,0,0,0), P0[6],P0[7],P0[8],P0[9],     pw0[2]=PKW(P0,4), pw0[3]=PKW(P0,6), pw0); \
    VRD(1); SBAR(); GAPA(C0=__builtin_amdgcn_mfma_f32_32x32x16_bf16(kf[2],qr[1],C0,0,0,0),   P0[10],P0[11],P0[12],P0[13], pw1[0]=PKW(P0,8), pw1[1]=PKW(P0,10), pw1); \
    VRD(5); SBAR(); GAPA(C1=__builtin_amdgcn_mfma_f32_32x32x16_bf16(kf[3],qr[1],C1,0,0,0),   P0[14],P0[15],P1[0],P1[1],   pw1[2]=PKW(P0,12),pw1[3]=PKW(P0,14), pw1); \
    VRD(2); SBAR(); GAPA(C0=__builtin_amdgcn_mfma_f32_32x32x16_bf16(kf[4],qr[2],C0,0,0,0),   P1[2],P1[3],P1[4],P1[5],     pw2[0]=PKW(P1,0), pw2[1]=PKW(P1,2), pw2); \
    VRD(6); SBAR(); GAPA(C1=__builtin_amdgcn_mfma_f32_32x32x16_bf16(kf[5],qr[2],C1,0,0,0),   P1[6],P1[7],P1[8],P1[9],     pw2[2]=PKW(P1,4), pw2[3]=PKW(P1,6), pw2); \
    VRD(3); SBAR(); GAPA(C0=__builtin_amdgcn_mfma_f32_32x32x16_bf16(kf[6],qr[3],C0,0,0,0),   P1[10],P1[11],P1[12],P1[13], pw3[0]=PKW(P1,8), pw3[1]=PKW(P1,10), pw3); \
    VRD(7); SBAR(); GAPA(C1=__builtin_amdgcn_mfma_f32_32x32x16_bf16(kf[7],qr[3],C1,0,0,0),   P1[14],P1[15],0.f,0.f,       pw3[2]=PKW(P1,12),pw3[3]=PKW(P1,14), pw3); \
    l_reg+=sacc; \
    if(GK){DMA_K((t)+3,sl_cur);} if(GV){DMA_V((t)+1,sl_next);} \
    CMASK(C0,C1,t); \
    _Pragma("unroll") for(int r=0;r<16;++r){C0[r]-=mhat;C1[r]-=mhat;} \
    { float a=MX3(C0[0],C0[1],C1[0]),b=MX3(C0[2],C0[3],C1[1]); a=MX3(a,C1[2],C1[3]); \
      _Pragma("unroll") for(int r=4;r<16;r+=4){a=MX3(a,C0[r],C0[r+1]);b=MX3(b,C0[r+2],C0[r+3]);a=MX3(a,C1[r],C1[r+1]);b=MX3(b,C1[r+2],C1[r+3]);} \
      float rm=__builtin_fmaxf(a,b); { auto rr=__builtin_amdgcn_permlane32_swap(__float_as_uint(rm),__float_as_uint(rm),false,false); rm=__builtin_fmaxf(__uint_as_float(rr[0]),__uint_as_float(rr[1])); } \
      resc=false; \
      if(__builtin_expect(__any(rm>(float)THRL),0)){ const float dl=__builtin_fmaxf(rm,0.f); mhat+=dl; \
        _Pragma("unroll") for(int r=0;r<16;++r){C0[r]-=dl;C1[r]-=dl;} \
        const float f=__builtin_amdgcn_exp2f(-dl); l_reg*=f; if(hi==0)wsf[r32]=f; resc=true; } } \
    SBAR(); \
    GAPB(o[0]=__builtin_amdgcn_mfma_f32_32x32x16_bf16(PAF(0),VFR(0),o[0],0,0,0), C0,0); \
    GAPB(o[1]=__builtin_amdgcn_mfma_f32_32x32x16_bf16(PAF(0),VFR(4),o[1],0,0,0), C0,4); \
    KRD(GL,0); GAPB(o[0]=__builtin_amdgcn_mfma_f32_32x32x16_bf16(PAF(1),VFR(1),o[0],0,0,0), C0,8); \
    KRD(GL,1); GAPB(o[1]=__builtin_amdgcn_mfma_f32_32x32x16_bf16(PAF(1),VFR(5),o[1],0,0,0), C0,12); \
    KRD(GL,2); GAPB(o[0]=__builtin_amdgcn_mfma_f32_32x32x16_bf16(PAF(2),VFR(2),o[0],0,0,0), C1,0); \
    KRD(GL,3); GAPB(o[1]=__builtin_amdgcn_mfma_f32_32x32x16_bf16(PAF(2),VFR(6),o[1],0,0,0), C1,4); \
    GAPB(o[0]=__builtin_amdgcn_mfma_f32_32x32x16_bf16(PAF(3),VFR(3),o[0],0,0,0), C1,8); \
    GAPB(o[1]=__builtin_amdgcn_mfma_f32_32x32x16_bf16(PAF(3),VFR(7),o[1],0,0,0), C1,12); \
    }while(0)
  int t=1;
  #undef CMASK
  #define CMASK(P0,P1,t) do{}while(0)
  for(;t+5<NT;t+=2){
    STEP(pB0,pB1,pA0,pA1,t,true,true,true);     WAIT_BAR(2); RESC(); ROT();
    STEP(pA0,pA1,pB0,pB1,t+1,true,true,true);   WAIT_BAR(2); RESC(); ROT();
  }
  #undef CMASK
  #define CMASK(P0,P1,t) do{ if(CAUSAL){int jb_=(t)-(NT-4); if(jb_>=0)cmask(P0,P1,jb_,qrel,hi);} }while(0)
  #define ENDW(tt) do{ if((tt)+3<NT){WAIT_BAR(2);} else if((tt)+2<NT){WAIT_BAR(1);} else {WAIT_BAR(0);} }while(0)
  for(;t+1<NT;t+=2){
    STEP(pB0,pB1,pA0,pA1,t,(t+3<NT),(t+1<NT),(t+1<NT));       ENDW(t);   RESC(); ROT();
    STEP(pA0,pA1,pB0,pB1,t+1,(t+4<NT),(t+2<NT),(t+2<NT));     ENDW(t+1); RESC(); ROT();
  }
  STEP(pB0,pB1,pA0,pA1,NT-1,false,false,false); RESC();
  { float sacc=pB0[0]+pB0[1]; _Pragma("unroll") for(int r=2;r<16;++r)sacc+=pB0[r]; _Pragma("unroll") for(int r=0;r<16;++r)sacc+=pB1[r]; l_reg+=sacc;
    pw0=(u32x4){PKW(pB0,0),PKW(pB0,2),PKW(pB0,4),PKW(pB0,6)};pw1=(u32x4){PKW(pB0,8),PKW(pB0,10),PKW(pB0,12),PKW(pB0,14)};pw2=(u32x4){PKW(pB1,0),PKW(pB1,2),PKW(pB1,4),PKW(pB1,6)};pw3=(u32x4){PKW(pB1,8),PKW(pB1,10),PKW(pB1,12),PKW(pB1,14)};
    SBAR(); pv(o,vb0+sl_cur,PAF(0),PAF(1),PAF(2),PAF(3)); }
  #undef PKW
  #undef PAF
  #undef VFR
  #undef PIN
  #undef MX3
  #undef GAPA
  #undef GAPB
  #undef EX
  #undef VRD
  #undef KRD
  #undef STEP
  #undef ENDW
  {auto rr=__builtin_amdgcn_permlane32_swap(__float_as_uint(l_reg),__float_as_uint(l_reg),false,false);l_reg=__uint_as_float(rr[0])+__uint_as_float(rr[1]);}
  if(hi==0)wsf[32+r32]=l_reg;asm volatile("s_waitcnt lgkmcnt(0)":::"memory");
  float rli[16];
  #pragma unroll
  for(int r=0;r<16;++r)rli[r]=__builtin_amdgcn_rcpf(wsf[32+crow(r,hi)]);
  bf16*Ow=Ou+(long)(wid*QBLK)*pO;
  { bf16*stg=(bf16*)(shm+LDS_OST)+wid*2048;
    #pragma unroll
    for(int r=0;r<16;++r){const int orow=crow(r,hi);
      #pragma unroll
      for(int d0=0;d0<2;++d0)stg[orow*64+d0*32+r32]=__float2bfloat16(o[d0][r]*rli[r]);}
    asm volatile("s_waitcnt lgkmcnt(0)":::"memory");
    #pragma unroll
    for(int i=0;i<4;++i){const int row=i*8+(lane>>3),ch=lane&7; const u32x4 v=*(const u32x4*)(stg+row*64+ch*8); ATTN_STORE16(Ow+(long)row*pO+ch*8,v);} }
  asm volatile("s_waitcnt lgkmcnt(0)\n\ts_barrier":::"memory");
  #undef DMA_K
  #undef DMA_V
  #undef CMASK
  #undef START
  #undef RESC
  #undef ROT
}
__device__ __forceinline__ void mem_attn(const bf16*Q0,const int pQ,const bf16*__restrict__ Kh,const bf16*__restrict__ Vh,const int pKV,bf16*O0,const int pO,const int nqb,char*shm){
  int tid_=threadIdx.x; asm volatile("":"+v"(tid_));
  const int tid=tid_,lane=tid&63,r32=lane&31,hi=lane>>5; const int wid=__builtin_amdgcn_readfirstlane(tid>>6);
  constexpr int MK=0,MV=32768,MWS=65536,MOST=65536+2048;
  const unsigned lds0=(unsigned)(uintptr_t)shm;
  const bf16*ksrc=Kh+(long)lane*pKV+wid*8;
  const bf16*vsrc=Vh+(long)(16*(wid&3)+(lane>>2))*pKV+(wid>>2)*32+(lane&3)*8;
  #pragma unroll
  for(int t=0;t<4;++t){ glds16(ksrc+(long)t*KVBLK*pKV,(unsigned)__builtin_amdgcn_readfirstlane(lds0+MK+t*8192+wid*1024)); glds16(vsrc+(long)t*KVBLK*pKV,(unsigned)__builtin_amdgcn_readfirstlane(lds0+MV+t*8192+wid*1024)); }
  WAIT_BAR(0);
  const int vb0=(int)(lds0+MV)+((lane>>4)&1)*32+(lane&3)*8+(4*hi+((lane&15)>>2))*64;
  float*wsf=(float*)(shm+MWS)+wid*64;
  const f32x16 zero=f32x16{};
  for(int qb=0;qb<nqb;++qb){
    const bf16*Qw=Q0+(long)(qb*QB+wid*QBLK)*pQ;
    bf16x8 qr[4];
    #pragma unroll
    for(int d0=0;d0<4;++d0)qr[d0]=*reinterpret_cast<const bf16x8*>(&Qw[(long)r32*pQ+d0*16+hi*8]);
    f32x16 p[4][2];
    #pragma unroll
    for(int t=0;t<4;++t)qkt(p[t][0],p[t][1],shm+MK+t*8192,qr,zero,r32,hi);
    float m=p[0][0][0];
    #pragma unroll
    for(int t=0;t<4;++t)
      #pragma unroll
      for(int j=0;j<2;++j)
        #pragma unroll
        for(int r=0;r<16;++r)m=__builtin_fmaxf(m,p[t][j][r]);
    { auto rr=__builtin_amdgcn_permlane32_swap(__float_as_uint(m),__float_as_uint(m),false,false); m=__builtin_fmaxf(__uint_as_float(rr[0]),__uint_as_float(rr[1])); }
    float l=0.f;
    #pragma unroll
    for(int t=0;t<4;++t)
      #pragma unroll
      for(int j=0;j<2;++j)
        #pragma unroll
        for(int r=0;r<16;++r){ const float e=__builtin_amdgcn_exp2f(p[t][j][r]-m); p[t][j][r]=e; l+=e; }
    { auto rr=__builtin_amdgcn_permlane32_swap(__float_as_uint(l),__float_as_uint(l),false,false); l=__uint_as_float(rr[0])+__uint_as_float(rr[1]); }
    f32x16 o[2]; o[0]=f32x16{}; o[1]=f32x16{};
    #pragma unroll
    for(int t=0;t<4;++t){
      const u32x4 w0={cvtpk_s(p[t][0][0],p[t][0][1]),cvtpk_s(p[t][0][2],p[t][0][3]),cvtpk_s(p[t][0][4],p[t][0][5]),cvtpk_s(p[t][0][6],p[t][0][7])};
      const u32x4 w1={cvtpk_s(p[t][0][8],p[t][0][9]),cvtpk_s(p[t][0][10],p[t][0][11]),cvtpk_s(p[t][0][12],p[t][0][13]),cvtpk_s(p[t][0][14],p[t][0][15])};
      const u32x4 w2={cvtpk_s(p[t][1][0],p[t][1][1]),cvtpk_s(p[t][1][2],p[t][1][3]),cvtpk_s(p[t][1][4],p[t][1][5]),cvtpk_s(p[t][1][6],p[t][1][7])};
      const u32x4 w3={cvtpk_s(p[t][1][8],p[t][1][9]),cvtpk_s(p[t][1][10],p[t][1][11]),cvtpk_s(p[t][1][12],p[t][1][13]),cvtpk_s(p[t][1][14],p[t][1][15])};
      pv(o,vb0+t*8192,__builtin_bit_cast(bf16x8,w0),__builtin_bit_cast(bf16x8,w1),__builtin_bit_cast(bf16x8,w2),__builtin_bit_cast(bf16x8,w3)); }
    if(hi==0)wsf[32+r32]=l; asm volatile("s_waitcnt lgkmcnt(0)":::"memory");
    float rli[16];
    #pragma unroll
    for(int r=0;r<16;++r)rli[r]=__builtin_amdgcn_rcpf(wsf[32+crow(r,hi)]);
    bf16*Ow=O0+(long)(qb*QB+wid*QBLK)*pO;
    { bf16*stg=(bf16*)(shm+MOST)+wid*2048;
      #pragma unroll
      for(int r=0;r<16;++r){const int orow=crow(r,hi);
        #pragma unroll
        for(int d0=0;d0<2;++d0)stg[orow*64+d0*32+r32]=__float2bfloat16(o[d0][r]*rli[r]);}
      asm volatile("s_waitcnt lgkmcnt(0)":::"memory");
      #pragma unroll
      for(int i=0;i<4;++i){const int row=i*8+(lane>>3),ch=lane&7; const u32x4 v=*(const u32x4*)(stg+row*64+ch*8); ATTN_STORE16(Ow+(long)row*pO+ch*8,v);}
      asm volatile("s_waitcnt lgkmcnt(0)":::"memory"); }
  }
  asm volatile("s_waitcnt lgkmcnt(0)\n\ts_barrier":::"memory");
}
constexpr int ATTN_LDS_BYTES=LDS_BYTES;
#undef SBAR
#undef WAIT_BAR
}
namespace attn2 {
using bf16=__hip_bfloat16;
using bf16x8=__attribute__((ext_vector_type(8)))short;
using s16x4=__attribute__((ext_vector_type(4)))short;
using f32x16=__attribute__((ext_vector_type(16)))float;
using u32x4=__attribute__((ext_vector_type(4)))unsigned;
constexpr int D=64;
constexpr int NW=8,QBLK=32,QB=QBLK*NW,KVBLK=64;
constexpr int ATTN_UNIT_ROWS=QB;
__device__ __forceinline__ int crow(int r,int hi){return (r&3)+8*(r>>2)+4*hi;}
#define SBAR() __builtin_amdgcn_sched_barrier(0)
__device__ __forceinline__ void cmask(f32x16&p0,f32x16&p1,int jb,int qrel,int hi){
  const float NEG=-INFINITY; int kb=64*jb+4*hi;
  #pragma unroll
  for(int r=0;r<16;++r){int kv=kb+(r&3)+8*(r>>2); if(kv>qrel)p0[r]=NEG; if(kv+32>qrel)p1[r]=NEG;}
}

constexpr int NSLOT=3, SLOTB=8192;
constexpr int LDS_K=0, LDS_V=NSLOT*SLOTB, LDS_WS=3*NSLOT*SLOTB, LDS_OST=LDS_WS+NW*64*4, LDS_BYTES=LDS_OST+NW*4096;
constexpr float C2=0.125f*1.4426950408889634f;
__device__ __forceinline__ void glds16(const void*gsrc,unsigned lds_dst){unsigned keep;
  asm volatile("s_mov_b32 %0, m0\n\ts_mov_b32 m0, %2\n\ts_nop 0\n\tglobal_load_lds_dwordx4 %1, off\n\ts_mov_b32 m0, %0":"=&s"(keep):"v"(gsrc),"s"(lds_dst):"memory");}
__device__ __forceinline__ float max3f(float a,float b,float c){float r;asm("v_max3_f32 %0, %1, %2, %3":"=v"(r):"v"(a),"v"(b),"v"(c));return r;}
__device__ __forceinline__ float max2f(float a,float b){float r;asm("v_max_f32_e32 %0, %1, %2":"=v"(r):"v"(a),"v"(b));return r;}
__device__ __forceinline__ float fadd_s(float a,float b){float r;asm("v_add_f32_e32 %0, %1, %2":"=v"(r):"v"(a),"v"(b));return r;}
__device__ __forceinline__ float fsub_s(float a,float b){float r;asm("v_sub_f32_e32 %0, %1, %2":"=v"(r):"v"(a),"v"(b));return r;}
typedef float f32x2_t __attribute__((ext_vector_type(2))); typedef __bf16 bf16x2_t __attribute__((ext_vector_type(2)));
__device__ __forceinline__ unsigned cvtpk_s(float lo,float hi){f32x2_t v={lo,hi};bf16x2_t b=__builtin_convertvector(v,bf16x2_t);return __builtin_bit_cast(unsigned,b);}
#define WAIT_BAR(N) asm volatile("s_waitcnt vmcnt(" #N ") lgkmcnt(0)\n\ts_barrier":::"memory")

__device__ __forceinline__ void qkt(f32x16&p0,f32x16&p1,const char*Kslot,const bf16x8*qr,const f32x16&negm,int r32,int hi){
  const char*kb=Kslot+hi*1024+r32*16;
  #pragma unroll
  for(int d0=0;d0<4;++d0){
    const bf16x8 b0=*reinterpret_cast<const bf16x8*>(kb+d0*2048);
    const bf16x8 b1=*reinterpret_cast<const bf16x8*>(kb+d0*2048+512);
    if(d0==0){p0=__builtin_amdgcn_mfma_f32_32x32x16_bf16(b0,qr[0],negm,0,0,0);p1=__builtin_amdgcn_mfma_f32_32x32x16_bf16(b1,qr[0],negm,0,0,0);}
    else{p0=__builtin_amdgcn_mfma_f32_32x32x16_bf16(b0,qr[d0],p0,0,0,0);p1=__builtin_amdgcn_mfma_f32_32x32x16_bf16(b1,qr[d0],p1,0,0,0);}}
}
typedef __attribute__((address_space(3))) const char* lds_cptr;
typedef short v4i16_t __attribute__((ext_vector_type(4)));
__device__ __forceinline__ void kload8(bf16x8*kf,lds_cptr kp){
  kf[0]=*(const __attribute__((address_space(3))) bf16x8*)(kp);      kf[1]=*(const __attribute__((address_space(3))) bf16x8*)(kp+512);
  kf[2]=*(const __attribute__((address_space(3))) bf16x8*)(kp+2048); kf[3]=*(const __attribute__((address_space(3))) bf16x8*)(kp+2560);
  kf[4]=*(const __attribute__((address_space(3))) bf16x8*)(kp+4096); kf[5]=*(const __attribute__((address_space(3))) bf16x8*)(kp+4608);
  kf[6]=*(const __attribute__((address_space(3))) bf16x8*)(kp+6144); kf[7]=*(const __attribute__((address_space(3))) bf16x8*)(kp+6656);
}
__device__ __forceinline__ void kload2(bf16x8*kf,lds_cptr kp,int j){ kf[2*j]=*(const __attribute__((address_space(3))) bf16x8*)(kp+j*2048); kf[2*j+1]=*(const __attribute__((address_space(3))) bf16x8*)(kp+j*2048+512); }
__device__ __forceinline__ s16x4 vtr(lds_cptr p){ return __builtin_bit_cast(s16x4,__builtin_amdgcn_ds_read_tr16_b64_v4i16((__attribute__((address_space(3))) v4i16_t*)p)); }
__device__ __forceinline__ float rowmax(const f32x16&p0,const f32x16&p1){
  float a=max3f(p0[0],p0[1],p1[0]),b=max3f(p0[2],p0[3],p1[1]);a=max3f(a,p1[2],p1[3]);
  #pragma unroll
  for(int r=4;r<16;r+=4){a=max3f(a,p0[r],p0[r+1]);b=max3f(b,p0[r+2],p0[r+3]);a=max3f(a,p1[r],p1[r+1]);b=max3f(b,p1[r+2],p1[r+3]);}
  const float m=max2f(a,b);
  auto rr=__builtin_amdgcn_permlane32_swap(__float_as_uint(m),__float_as_uint(m),false,false);
  return max2f(__uint_as_float(rr[0]),__uint_as_float(rr[1]));
}
__device__ __forceinline__ void pv(f32x16*o,int vb,bf16x8 pa0,bf16x8 pa1,bf16x8 pa2,bf16x8 pa3){
  #pragma unroll
  for(int d0=0;d0<4;++d0){s16x4 lo[4],hi[4];
    #pragma unroll
    for(int ks=0;ks<4;++ks){
      asm volatile("ds_read_b64_tr_b16 %0,%1 offset:%c2":"=&v"(lo[ks]):"v"(vb),"i"(d0*4096+ks*1024):"memory");
      asm volatile("ds_read_b64_tr_b16 %0,%1 offset:%c2":"=&v"(hi[ks]):"v"(vb),"i"(d0*4096+ks*1024+512):"memory");}
    asm volatile("s_waitcnt lgkmcnt(0)":::"memory");SBAR();
    #define PK(k) (bf16x8){lo[k][0],lo[k][1],lo[k][2],lo[k][3],hi[k][0],hi[k][1],hi[k][2],hi[k][3]}
    o[d0]=__builtin_amdgcn_mfma_f32_32x32x16_bf16(pa0,PK(0),o[d0],0,0,0);
    o[d0]=__builtin_amdgcn_mfma_f32_32x32x16_bf16(pa1,PK(1),o[d0],0,0,0);
    o[d0]=__builtin_amdgcn_mfma_f32_32x32x16_bf16(pa2,PK(2),o[d0],0,0,0);
    o[d0]=__builtin_amdgcn_mfma_f32_32x32x16_bf16(pa3,PK(3),o[d0],0,0,0);
    #undef PK
  }
}

#ifndef ATTN_STORE16
#define ATTN_STORE16(p,v) (*(u32x4*)(p)=(v))
#endif
template<int THRL,bool CAUSAL> __device__ __forceinline__ void attn_unit(const bf16*Qu,const int pQ,const bf16*__restrict__ Kh,const bf16*__restrict__ Vh,const int pKV,bf16*Ou,const int pO,const int NT,char*shm){
  int tid_=threadIdx.x; asm volatile("":"+v"(tid_));
  const int tid=tid_,lane=tid&63,r32=lane&31,hi=lane>>5; const int wid=__builtin_amdgcn_readfirstlane(tid>>6);
  const bf16*Qw=Qu+(long)(wid*QBLK)*pQ;
  const unsigned lds0=(unsigned)(uintptr_t)shm;
  float*wsf=(float*)(shm+LDS_WS)+wid*64;
  const bf16*ksrc=Kh+(long)lane*pKV+wid*8;
  const bf16*vsrc=Vh+(long)(16*(wid&3)+(lane>>2))*pKV+(wid>>2)*32+(lane&3)*8;
  const unsigned kdst=lds0+LDS_K+wid*1024, vdst=lds0+LDS_V+wid*1024;
  #define DMA_K(t,slot) glds16(ksrc+(long)(t)*KVBLK*pKV,(unsigned)__builtin_amdgcn_readfirstlane(kdst+(slot)))
  #define DMA_V(t,slot) do{ glds16(vsrc+(long)(t)*KVBLK*pKV,(unsigned)__builtin_amdgcn_readfirstlane(vdst+2*(slot))); glds16(vsrc+(long)(t)*KVBLK*pKV+64,(unsigned)__builtin_amdgcn_readfirstlane(vdst+2*(slot)+8192)); }while(0)
  const int vb0=(int)(lds0+LDS_V)+((lane>>4)&1)*32+(lane&3)*8+(4*hi+((lane&15)>>2))*64;
  const char*Kbase=shm+LDS_K; bf16x8 kf[8];
  const lds_cptr shm3=(lds_cptr)shm; const lds_cptr kp0=shm3+LDS_K+hi*1024+r32*16; const lds_cptr vp0=shm3+LDS_V+((lane>>4)&1)*32+(lane&3)*8+(4*hi+((lane&15)>>2))*64;
  DMA_K(0,0);DMA_V(0,0);DMA_K(1,SLOTB);
  bf16x8 qr[4];
  #pragma unroll
  for(int d0=0;d0<4;++d0)qr[d0]=*reinterpret_cast<const bf16x8*>(&Qw[(long)r32*pQ+d0*16+hi*8]);
  float mhat=0.f,l_reg=0.f;f32x16 o[4];o[0]=f32x16{};o[1]=f32x16{};o[2]=f32x16{};o[3]=f32x16{};const f32x16 negm=f32x16{};
  const int qrel=wid*QBLK+r32;
  #define CMASK(P0,P1,t) do{ if(CAUSAL){int jb_=(t)-(NT-4); if(jb_>=0)cmask(P0,P1,jb_,qrel,hi);} }while(0)
  bool resc=false;
  #define START(P0,P1) do{ const float rm=rowmax(P0,P1); resc=false; \
    { const float dl=rm; mhat=fadd_s(mhat,dl); \
      _Pragma("unroll") for(int r=0;r<16;++r){P0[r]=fsub_s(P0[r],dl);P1[r]=fsub_s(P1[r],dl);} \
      } \
    _Pragma("unroll") for(int r=0;r<16;++r)P0[r]=__builtin_amdgcn_exp2f(P0[r]); }while(0)
  #define RESC() do{ if(resc){ asm volatile("s_waitcnt lgkmcnt(0)":::"memory"); \
      _Pragma("unroll") for(int d_=0;d_<4;++d_) _Pragma("unroll") for(int r=0;r<16;++r)o[d_][r]*=wsf[crow(r,hi)]; } }while(0)
  f32x16 pA0,pA1,pB0,pB1;
  int sl_prev=0,sl_cur=0,sl_next=SLOTB;
  #define ROT() do{sl_prev=sl_cur;sl_cur=sl_next;sl_next=(sl_next==(NSLOT-1)*SLOTB)?0:sl_next+SLOTB;}while(0)
  DMA_K(2,2*SLOTB);
  WAIT_BAR(4);
  qkt(pA0,pA1,Kbase,qr,negm,r32,hi);asm volatile("s_nop 15\n\ts_nop 7":"+v"(pA0),"+v"(pA1));CMASK(pA0,pA1,0);
  START(pA0,pA1);
  _Pragma("unroll") for(int r=0;r<16;++r)pA1[r]=__builtin_amdgcn_exp2f(pA1[r]);
  WAIT_BAR(0);
  DMA_K(3,0);DMA_V(1,SLOTB);
  ROT();
  kload8(kf,kp0+sl_cur);
  WAIT_BAR(3);
  s16x4 vlo[8],vhi[8]; u32x4 pw0,pw1,pw2,pw3;
  #define PKW(P,B) cvtpk_s(P[B],P[B+1])
  #define PAF(k) __builtin_bit_cast(bf16x8,pw##k)
  #define VFR(i) (bf16x8){vlo[i][0],vlo[i][1],vlo[i][2],vlo[i][3],vhi[i][0],vhi[i][1],vhi[i][2],vhi[i][3]}
  #define PIN(x) asm volatile("":"+v"(x))
  #define MX3(a,b,c) __builtin_fmaxf(__builtin_fmaxf((a),(b)),(c))
  #define GAPA(MF,A0,A1,A2,A3,W0,W1,PW) do{ MF; sacc+=A0; sacc+=A1; sacc+=A2; sacc+=A3; PIN(sacc); W0; W1; PIN(PW); SBAR(); }while(0)
  #define EX(v) __builtin_amdgcn_exp2f(v)
  #define GAPB(MF,X,B) do{ MF; X[B]=EX(X[B]); X[B+1]=EX(X[B+1]); X[B+2]=EX(X[B+2]); X[B+3]=EX(X[B+3]); PIN(X); SBAR(); }while(0)
  #define VRD(i) do{ vlo[i]=vtr(vp_+(((i)>>2)*4096+((i)&3)*1024)); vhi[i]=vtr(vp_+(((i)>>2)*4096+((i)&3)*1024+512)); }while(0)
  #define VRD2(i) do{ vlo[i]=vtr(vp_+((((i)>>2)+2)*4096+((i)&3)*1024)); vhi[i]=vtr(vp_+((((i)>>2)+2)*4096+((i)&3)*1024+512)); }while(0)
  #define GAPB2(MF,X,B) do{ MF; X[B]=EX(X[B]); X[B+1]=EX(X[B+1]); PIN(X); SBAR(); }while(0)
  #define KRD(G,j) do{ if(G){ kload2(kf,kp0+sl_next,j); SBAR(); } }while(0)
  #define STEP(C0,C1,P0,P1,t,GK,GV,GL) do{ SBAR(); \
    const lds_cptr vp_=vp0+2*sl_prev; \
    VRD(0); SBAR(); float sacc=(P0[0]+P0[1]); \
    GAPA(C0=__builtin_amdgcn_mfma_f32_32x32x16_bf16(kf[0],qr[0],negm,0,0,0), P0[2],P0[3],P0[4],P0[5],     pw0[0]=PKW(P0,0), pw0[1]=PKW(P0,2), pw0); \
    VRD(4); SBAR(); GAPA(C1=__builtin_amdgcn_mfma_f32_32x32x16_bf16(kf[1],qr[0],negm,0,0,0), P0[6],P0[7],P0[8],P0[9],     pw0[2]=PKW(P0,4), pw0[3]=PKW(P0,6), pw0); \
    VRD(1); SBAR(); GAPA(C0=__builtin_amdgcn_mfma_f32_32x32x16_bf16(kf[2],qr[1],C0,0,0,0),   P0[10],P0[11],P0[12],P0[13], pw1[0]=PKW(P0,8), pw1[1]=PKW(P0,10), pw1); \
    VRD(5); SBAR(); GAPA(C1=__builtin_amdgcn_mfma_f32_32x32x16_bf16(kf[3],qr[1],C1,0,0,0),   P0[14],P0[15],P1[0],P1[1],   pw1[2]=PKW(P0,12),pw1[3]=PKW(P0,14), pw1); \
    VRD(2); SBAR(); GAPA(C0=__builtin_amdgcn_mfma_f32_32x32x16_bf16(kf[4],qr[2],C0,0,0,0),   P1[2],P1[3],P1[4],P1[5],     pw2[0]=PKW(P1,0), pw2[1]=PKW(P1,2), pw2); \
    VRD(6); SBAR(); GAPA(C1=__builtin_amdgcn_mfma_f32_32x32x16_bf16(kf[5],qr[2],C1,0,0,0),   P1[6],P1[7],P1[8],P1[9],     pw2[2]=PKW(P1,4), pw2[3]=PKW(P1,6), pw2); \
    VRD(3); SBAR(); GAPA(C0=__builtin_amdgcn_mfma_f32_32x32x16_bf16(kf[6],qr[3],C0,0,0,0),   P1[10],P1[11],P1[12],P1[13], pw3[0]=PKW(P1,8), pw3[1]=PKW(P1,10), pw3); \
    VRD(7); SBAR(); GAPA(C1=__builtin_amdgcn_mfma_f32_32x32x16_bf16(kf[7],qr[3],C1,0,0,0),   P1[14],P1[15],0.f,0.f,       pw3[2]=PKW(P1,12),pw3[3]=PKW(P1,14), pw3); \
    l_reg+=sacc; \
    if(GK){DMA_K((t)+3,sl_cur);} if(GV){DMA_V((t)+1,sl_next);} \
    CMASK(C0,C1,t); \
    _Pragma("unroll") for(int r=0;r<16;++r){C0[r]-=mhat;C1[r]-=mhat;} \
    { float a=MX3(C0[0],C0[1],C1[0]),b=MX3(C0[2],C0[3],C1[1]); a=MX3(a,C1[2],C1[3]); \
      _Pragma("unroll") for(int r=4;r<16;r+=4){a=MX3(a,C0[r],C0[r+1]);b=MX3(b,C0[r+2],C0[r+3]);a=MX3(a,C1[r],C1[r+1]);b=MX3(b,C1[r+2],C1[r+3]);} \
      float rm=__builtin_fmaxf(a,b); { auto rr=__builtin_amdgcn_permlane32_swap(__float_as_uint(rm),__float_as_uint(rm),false,false); rm=__builtin_fmaxf(__uint_as_float(rr[0]),__uint_as_float(rr[1])); } \
      resc=false; \
      if(__builtin_expect(__any(rm>(float)THRL),0)){ const float dl=__builtin_fmaxf(rm,0.f); mhat+=dl; \
        _Pragma("unroll") for(int r=0;r<16;++r){C0[r]-=dl;C1[r]-=dl;} \
        const float f=__builtin_amdgcn_exp2f(-dl); l_reg*=f; if(hi==0)wsf[r32]=f; resc=true; } } \
    SBAR(); \
    GAPB2(o[0]=__builtin_amdgcn_mfma_f32_32x32x16_bf16(PAF(0),VFR(0),o[0],0,0,0), C0,0); VRD2(0); SBAR(); \
    GAPB2(o[1]=__builtin_amdgcn_mfma_f32_32x32x16_bf16(PAF(0),VFR(4),o[1],0,0,0), C0,2); VRD2(4); SBAR(); \
    KRD(GL,0); GAPB2(o[0]=__builtin_amdgcn_mfma_f32_32x32x16_bf16(PAF(1),VFR(1),o[0],0,0,0), C0,4); VRD2(1); SBAR(); \
    KRD(GL,1); GAPB2(o[1]=__builtin_amdgcn_mfma_f32_32x32x16_bf16(PAF(1),VFR(5),o[1],0,0,0), C0,6); VRD2(5); SBAR(); \
    KRD(GL,2); GAPB2(o[0]=__builtin_amdgcn_mfma_f32_32x32x16_bf16(PAF(2),VFR(2),o[0],0,0,0), C0,8); VRD2(2); SBAR(); \
    KRD(GL,3); GAPB2(o[1]=__builtin_amdgcn_mfma_f32_32x32x16_bf16(PAF(2),VFR(6),o[1],0,0,0), C0,10); VRD2(6); SBAR(); \
    GAPB2(o[0]=__builtin_amdgcn_mfma_f32_32x32x16_bf16(PAF(3),VFR(3),o[0],0,0,0), C0,12); VRD2(3); SBAR(); \
    GAPB2(o[1]=__builtin_amdgcn_mfma_f32_32x32x16_bf16(PAF(3),VFR(7),o[1],0,0,0), C0,14); VRD2(7); SBAR(); \
    GAPB2(o[2]=__builtin_amdgcn_mfma_f32_32x32x16_bf16(PAF(0),VFR(0),o[2],0,0,0), C1,0); \
    GAPB2(o[3]=__builtin_amdgcn_mfma_f32_32x32x16_bf16(PAF(0),VFR(4),o[3],0,0,0), C1,2); \
    GAPB2(o[2]=__builtin_amdgcn_mfma_f32_32x32x16_bf16(PAF(1),VFR(1),o[2],0,0,0), C1,4); \
    GAPB2(o[3]=__builtin_amdgcn_mfma_f32_32x32x16_bf16(PAF(1),VFR(5),o[3],0,0,0), C1,6); \
    GAPB2(o[2]=__builtin_amdgcn_mfma_f32_32x32x16_bf16(PAF(2),VFR(2),o[2],0,0,0), C1,8); \
    GAPB2(o[3]=__builtin_amdgcn_mfma_f32_32x32x16_bf16(PAF(2),VFR(6),o[3],0,0,0), C1,10); \
    GAPB2(o[2]=__builtin_amdgcn_mfma_f32_32x32x16_bf16(PAF(3),VFR(3),o[2],0,0,0), C1,12); \
    GAPB2(o[3]=__builtin_amdgcn_mfma_f32_32x32x16_bf16(PAF(3),VFR(7),o[3],0,0,0), C1,14); \
    }while(0)
  int t=1;
  #undef CMASK
  #define CMASK(P0,P1,t) do{}while(0)
  for(;t+5<NT;t+=2){
    STEP(pB0,pB1,pA0,pA1,t,true,true,true);     WAIT_BAR(3); RESC(); ROT();
    STEP(pA0,pA1,pB0,pB1,t+1,true,true,true);   WAIT_BAR(3); RESC(); ROT();
  }
  #undef CMASK
  #define CMASK(P0,P1,t) do{ if(CAUSAL){int jb_=(t)-(NT-4); if(jb_>=0)cmask(P0,P1,jb_,qrel,hi);} }while(0)
  #define ENDW(tt) do{ if((tt)+3<NT){WAIT_BAR(3);} else if((tt)+2<NT){WAIT_BAR(2);} else {WAIT_BAR(0);} }while(0)
  for(;t+1<NT;t+=2){
    STEP(pB0,pB1,pA0,pA1,t,(t+3<NT),(t+1<NT),(t+1<NT));       ENDW(t);   RESC(); ROT();
    STEP(pA0,pA1,pB0,pB1,t+1,(t+4<NT),(t+2<NT),(t+2<NT));     ENDW(t+1); RESC(); ROT();
  }
  STEP(pB0,pB1,pA0,pA1,NT-1,false,false,false); RESC();
  { float sacc=pB0[0]+pB0[1]; _Pragma("unroll") for(int r=2;r<16;++r)sacc+=pB0[r]; _Pragma("unroll") for(int r=0;r<16;++r)sacc+=pB1[r]; l_reg+=sacc;
    pw0=(u32x4){PKW(pB0,0),PKW(pB0,2),PKW(pB0,4),PKW(pB0,6)};pw1=(u32x4){PKW(pB0,8),PKW(pB0,10),PKW(pB0,12),PKW(pB0,14)};pw2=(u32x4){PKW(pB1,0),PKW(pB1,2),PKW(pB1,4),PKW(pB1,6)};pw3=(u32x4){PKW(pB1,8),PKW(pB1,10),PKW(pB1,12),PKW(pB1,14)};
    SBAR(); pv(o,vb0+2*sl_cur,PAF(0),PAF(1),PAF(2),PAF(3)); }
  #undef PKW
  #undef PAF
  #undef VFR
  #undef PIN
  #undef MX3
  #undef GAPA
  #undef GAPB
  #undef EX
  #undef VRD
  #undef VRD2
  #undef GAPB2
  #undef KRD
  #undef STEP
  #undef ENDW
  {auto rr=__builtin_amdgcn_permlane32_swap(__float_as_uint(l_reg),__float_as_uint(l_reg),false,false);l_reg=__uint_as_float(rr[0])+__uint_as_float(rr[1]);}
  if(hi==0)wsf[32+r32]=l_reg;asm volatile("s_waitcnt lgkmcnt(0)":::"memory");
  float rli[16];
  #pragma unroll
  for(int r=0;r<16;++r)rli[r]=__builtin_amdgcn_rcpf(wsf[32+crow(r,hi)]);
  bf16*Ow=Ou+(long)(wid*QBLK)*pO;
  { bf16*stg=(bf16*)(shm+LDS_OST)+wid*2048;
    #pragma unroll
    for(int hf=0;hf<2;++hf){
      #pragma unroll
      for(int r=0;r<16;++r){const int orow=crow(r,hi);
        #pragma unroll
        for(int d0=0;d0<2;++d0)stg[orow*64+d0*32+r32]=__float2bfloat16(o[2*hf+d0][r]*rli[r]);}
      asm volatile("s_waitcnt lgkmcnt(0)":::"memory");
      #pragma unroll
      for(int i=0;i<4;++i){const int row=i*8+(lane>>3),ch=lane&7; const u32x4 v=*(const u32x4*)(stg+row*64+ch*8); ATTN_STORE16(Ow+(long)row*pO+hf*64+ch*8,v);}
      asm volatile("s_waitcnt lgkmcnt(0)":::"memory"); } }
  asm volatile("s_waitcnt lgkmcnt(0)\n\ts_barrier":::"memory");
  #undef DMA_K
  #undef DMA_V
  #undef CMASK
  #undef START
  #undef RESC
  #undef ROT
}
constexpr int ATTN_LDS_BYTES=LDS_BYTES;
#undef SBAR
#undef WAIT_BAR
}

constexpr int NWAVES = 8;
#ifndef MK_N_LAUNCHES
#define MK_N_LAUNCHES 1
#endif
constexpr int NPH = 10;
constexpr int BATCH = 32, SEQ = 2048, D = 1024, T = BATCH * SEQ, NMEM = 256, TM = BATCH * NMEM;
constexpr int INCOLS = 5120, PROJW = 2048, GATEW = 3072;
constexpr float RMS_EPS = 1e-6f;
constexpr int NEXP = 16, EH = 512;
constexpr int MAXROWS = 2 * T + NEXP * 256;
constexpr size_t MiB = 1u << 20;
constexpr size_t WS_CTL = 0, CTL_ZERO_BYTES = 64 * 1024;
constexpr size_t WS_WRF = 1 * MiB;
constexpr size_t WS_RINV = 1 * MiB + 128 * 1024;
constexpr size_t WS_WIN = 2 * MiB;
constexpr size_t WS_PC = 13 * MiB;
constexpr size_t WS_WO = 15 * MiB;
constexpr size_t WS_WGU = 17 * MiB;
constexpr size_t WS_WD = 49 * MiB;
constexpr size_t WS_ROUTE = 65 * MiB;
constexpr size_t WS_KV = 68 * MiB;
constexpr size_t WS_XN = 76 * MiB;
constexpr size_t WS_BR = 76 * MiB;
constexpr size_t WS_H2 = 76 * MiB;
constexpr size_t WS_PROJ = 220 * MiB;
constexpr size_t WS_MERGED = 220 * MiB;
constexpr size_t WS_MIX = 348 * MiB;
constexpr size_t WS_HID = 220 * MiB;
constexpr size_t WS_ATTO = 476 * MiB;
constexpr size_t WS_GATES = 604 * MiB;
constexpr size_t WS_LIST = 476 * MiB;
constexpr size_t WS_RWE = 480 * MiB;
constexpr size_t WS_Y = 604 * MiB;
constexpr size_t WS_END = 988 * MiB;
static_assert(WS_XN + (size_t)(T + TM) * D * 2 <= WS_PROJ && WS_PROJ + (size_t)T * PROJW * 2 <= WS_ATTO && WS_ATTO + (size_t)T * D * 2 <= WS_GATES && WS_GATES + (size_t)T * GATEW * 2 <= WS_END, "ws map");
static_assert(WS_Y + (size_t)MAXROWS * D * 2 <= WS_END && WS_HID + (size_t)MAXROWS * EH * 2 <= WS_ATTO && WS_RWE + (size_t)NEXP * 65536 * 8 <= WS_GATES, "ws map 2");
constexpr int CW_CNT = 64;
constexpr int RING_OFF = 0, RING_BYTES = 131072;
constexpr int LDSX_OFF = RING_BYTES;
constexpr int LDS_BYTES = 147456;

#define GAS __attribute__((address_space(1)))
#define LAS __attribute__((address_space(3)))
typedef unsigned short bf16;
typedef unsigned v4u __attribute__((ext_vector_type(4)));
typedef unsigned v2u __attribute__((ext_vector_type(2)));
typedef float f32x4 __attribute__((ext_vector_type(4)));
#define LDS_WAIT() asm volatile("s_waitcnt lgkmcnt(0)" ::: "memory")
__device__ __forceinline__ unsigned f2bf(float f) { unsigned u = __builtin_bit_cast(unsigned, f); return (u + 0x7fffu + ((u >> 16) & 1u)) >> 16; }
__device__ __forceinline__ unsigned pk2(float lo, float hi) { return f2bf(lo) | (f2bf(hi) << 16); }
typedef float f32x2_t __attribute__((ext_vector_type(2))); typedef __bf16 bf16x2_t __attribute__((ext_vector_type(2)));
typedef short bf16x8_t __attribute__((ext_vector_type(8))); typedef float f32x16_t __attribute__((ext_vector_type(16)));
__device__ __forceinline__ unsigned cvtpk(float lo, float hi) { f32x2_t v = {lo, hi}; bf16x2_t b = __builtin_convertvector(v, bf16x2_t); return __builtin_bit_cast(unsigned, b); }
__device__ __forceinline__ float bflo(unsigned w) { return __uint_as_float(w << 16); }
__device__ __forceinline__ float bfhi(unsigned w) { return __uint_as_float(w & 0xffff0000u); }
__device__ __forceinline__ float wave_sum(float v) {
#pragma unroll
    for (int o = 1; o < 64; o <<= 1) v += __shfl_xor(v, o);
    return v;
}

typedef GAS unsigned gu32;
#define RLX_AGENT __ATOMIC_RELAXED, __HIP_MEMORY_SCOPE_AGENT
constexpr int CW_BAR = 4096;
constexpr int CW_TS = 128;
#define XB_TMO      128
#define XB_XCNT(j)  (256  + 64 * (j))
#define XB_XSUB(j)  (1280 + 64 * (j))
#define XB_XGEN(j)  (2304 + 64 * (j))
#define XB_TOP      3328
#define XB_TOPGEN   3392
#define XCD_BAR_WORDS 3456
#define XB_SPIN_CAP (1u << 18)

__device__ __forceinline__ unsigned xb_ld(unsigned* p)              { return __hip_atomic_load(p, __ATOMIC_RELAXED, __HIP_MEMORY_SCOPE_AGENT); }
__device__ __forceinline__ unsigned xb_add(unsigned* p, unsigned v) { return __hip_atomic_fetch_add(p, v, __ATOMIC_RELAXED, __HIP_MEMORY_SCOPE_AGENT); }
__device__ __forceinline__ unsigned xb_xcc_id() { return (unsigned)__builtin_amdgcn_s_getreg((3 << 11) | 20) & 0xFu; }
#define XB_SPIN(cond, bar) do { unsigned _sp = 0; while (cond) { __builtin_amdgcn_s_sleep(1); \
    if ((++_sp & 255u) == 0u) { if (xb_ld(&(bar)[XB_TMO])) break; if (_sp > XB_SPIN_CAP) { atomicAdd(&(bar)[XB_TMO], 1u); break; } } } } while (0)

struct XcdBarrier {
    unsigned* bar; unsigned x;
    volatile LAS unsigned* st;
};

__device__ __forceinline__ XcdBarrier xcd_barrier_post(unsigned* bar, volatile LAS unsigned* st) {
    XcdBarrier b; b.bar = bar; b.x = xb_xcc_id(); b.st = st;
    if (threadIdx.x == 0) (void)xb_add(&bar[XB_XCNT(b.x)], 1u);
    return b;
}
__device__ __forceinline__ void xcd_barrier_complete(unsigned* bar, unsigned x, unsigned& nloc, unsigned& nx) {
    const unsigned G = gridDim.x * gridDim.y * gridDim.z;
    unsigned sum, cnt, mine, sp = 0u;
    for (;;) {
        sum = 0u; cnt = 0u; mine = 0u;
#pragma unroll
        for (unsigned j = 0; j < 16; ++j) { const unsigned c = xb_ld(&bar[XB_XCNT(j)]); sum += c; cnt += (c > 0u) ? 1u : 0u; mine = (j == x) ? c : mine; }
        if (sum == G) break;
        __builtin_amdgcn_s_sleep(1);
        if ((++sp & 255u) == 0u) { if (xb_ld(&bar[XB_TMO])) break; if (sp > XB_SPIN_CAP) { atomicAdd(&bar[XB_TMO], 1u); break; } }
    }
    nloc = mine > 0u ? mine : 1u; nx = cnt > 0u ? cnt : 1u;
}

__device__ __forceinline__ void xcd_barrier(const XcdBarrier& b) {
    asm volatile("s_waitcnt vmcnt(0)" ::: "memory");
    __syncthreads();
    if (threadIdx.x == 0) {
        unsigned* bar = b.bar;
        __builtin_amdgcn_s_waitcnt(0);
        unsigned nloc = b.st[0], nx = b.st[1];
        if (nloc == 0u) { xcd_barrier_complete(bar, b.x, nloc, nx); b.st[0] = nloc; b.st[1] = nx; }
        const unsigned old = xb_add(&bar[XB_XSUB(b.x)], 1u);
        const unsigned gen = old / nloc;
        if (old + 1u == (gen + 1u) * nloc) {
            __builtin_amdgcn_fence(__ATOMIC_RELEASE, "agent");
            asm volatile("s_waitcnt vmcnt(0)" ::: "memory");
            const unsigned og = xb_add(&bar[XB_TOP], 1u);
            const unsigned tg = og / nx;
            if (og + 1u == (tg + 1u) * nx) xb_add(&bar[XB_TOPGEN], 1u);
            else XB_SPIN(xb_ld(&bar[XB_TOPGEN]) == tg, bar);
            __builtin_amdgcn_fence(__ATOMIC_ACQUIRE, "agent");
            xb_add(&bar[XB_XGEN(b.x)], 1u);
            asm volatile("s_waitcnt vmcnt(0)" ::: "memory");
        } else {
            XB_SPIN(xb_ld(&bar[XB_XGEN(b.x)]) == gen, bar);
            __builtin_amdgcn_fence(__ATOMIC_ACQUIRE, "agent");
            asm volatile("s_waitcnt vmcnt(0)" ::: "memory");
        }
    }
    __syncthreads();
}

struct Frame {
    LAS unsigned char* lds;
    unsigned* ctl;
    int vcu, G;
};

__device__ __forceinline__ void p0_tile(const float* W, int N, int k0, int n0, bf16* WT, int Kd, int drow0, LAS float* scr, int lane, const float* gk = nullptr) {
    f32x4 w[8];
#pragma unroll
    for (int i = 0; i < 8; ++i) w[i] = *(const GAS f32x4*)(W + (size_t)(k0 + i * 8 + (lane >> 3)) * N + n0 + (lane & 7) * 4);
    if (gk) {
#pragma unroll
        for (int i = 0; i < 8; ++i) w[i] = w[i] * gk[k0 + i * 8 + (lane >> 3)]; }
#pragma unroll
    for (int i = 0; i < 8; ++i) { LAS float* d = scr + (i * 8 + (lane >> 3)) * 33 + (lane & 7) * 4; d[0] = w[i].x; d[1] = w[i].y; d[2] = w[i].z; d[3] = w[i].w; }
    LDS_WAIT(); asm volatile("" ::: "memory");
    const int c = lane & 7;
#pragma unroll
    for (int j = 0; j < 4; ++j) { const int n = (lane >> 3) + 8 * j; const LAS float* s = scr + (8 * c) * 33 + n;
        v4u o; o.x = pk2(s[0 * 33], s[1 * 33]); o.y = pk2(s[2 * 33], s[3 * 33]); o.z = pk2(s[4 * 33], s[5 * 33]); o.w = pk2(s[6 * 33], s[7 * 33]);
        *(GAS v4u*)(WT + (size_t)(drow0 + n) * Kd + k0 + 8 * c) = o; }
    LDS_WAIT(); asm volatile("" ::: "memory");
}
__device__ __forceinline__ void p0_plain(const float* W, int K, int N, bf16* WT, int row_off, int item, LAS float* scr, int lane) {
    const int nblk = N / 32, kb = item / nblk, nb = item % nblk;
    p0_tile(W, N, 64 * kb, 32 * nb, WT, K, row_off + 32 * nb, scr, lane);
}
__device__ __forceinline__ void rms_row_to_bf16(const float* xrow, const float* g, bf16* orow, int lane) {
    const GAS f32x4* xr = (const GAS f32x4*)xrow + lane; const GAS f32x4* gr = (const GAS f32x4*)g + lane;
    f32x4 v[4]; float s = 0.f;
#pragma unroll
    for (int j = 0; j < 4; ++j) { v[j] = xr[64 * j]; s += (v[j].x * v[j].x + v[j].y * v[j].y) + (v[j].z * v[j].z + v[j].w * v[j].w); }
    const float r = 1.f / sqrtf(wave_sum(s) * (1.f / D) + RMS_EPS);
    GAS unsigned long long* o8 = (GAS unsigned long long*)orow + lane;
#pragma unroll
    for (int j = 0; j < 4; ++j) { const f32x4 gg = gr[64 * j]; const f32x4 h = v[j] * r * gg;
        o8[64 * j] = (unsigned long long)pk2(h.x, h.y) | ((unsigned long long)pk2(h.z, h.w) << 32); }
}

__device__ __forceinline__ void rms_rows_stream(const float* src1, const float* g1, const float* src2, const float* g2, int nT, int nAll, bf16* dst, int m0, int mstep, int lane) {
    f32x4 cur[4][4], nxt[4][4];
    if (m0 >= nAll) return;
    { const GAS f32x4* xr = (const GAS f32x4*)((m0 < nT ? src1 + (size_t)m0 * D : src2 + (size_t)(m0 - nT) * D)) + lane;
#pragma unroll
      for (int q = 0; q < 4; ++q)
#pragma unroll
          for (int j = 0; j < 4; ++j) cur[q][j] = xr[q * 256 + 64 * j]; }
    for (int m = m0; m < nAll; m += mstep) {
        const int mn = m + mstep; const bool has = mn < nAll; const int ml = has ? mn : m;
        { const GAS f32x4* xr = (const GAS f32x4*)((ml < nT ? src1 + (size_t)ml * D : src2 + (size_t)(ml - nT) * D)) + lane;
#pragma unroll
          for (int q = 0; q < 4; ++q)
#pragma unroll
              for (int j = 0; j < 4; ++j) nxt[q][j] = xr[q * 256 + 64 * j]; }
        float s[4];
#pragma unroll
        for (int q = 0; q < 4; ++q) { s[q] = 0.f;
#pragma unroll
            for (int j = 0; j < 4; ++j) s[q] += (cur[q][j].x * cur[q][j].x + cur[q][j].y * cur[q][j].y) + (cur[q][j].z * cur[q][j].z + cur[q][j].w * cur[q][j].w); }
#pragma unroll
        for (int o = 1; o < 64; o <<= 1) {
#pragma unroll
            for (int q = 0; q < 4; ++q) s[q] += __shfl_xor(s[q], o); }
        const GAS f32x4* gr = (const GAS f32x4*)(m < nT ? g1 : g2) + lane;
        f32x4 gg[4];
#pragma unroll
        for (int j = 0; j < 4; ++j) gg[j] = gr[64 * j];
#pragma unroll
        for (int q = 0; q < 4; ++q) { const float r = 1.f / sqrtf(s[q] * (1.f / D) + RMS_EPS);
            GAS unsigned long long* o8 = (GAS unsigned long long*)(dst + (size_t)(m + q) * D) + lane;
#pragma unroll
            for (int j = 0; j < 4; ++j) { const f32x4 h = cur[q][j] * r * gg[j]; o8[64 * j] = (unsigned long long)pk2(h.x, h.y) | ((unsigned long long)pk2(h.z, h.w) << 32); } }
#pragma unroll
        for (int q = 0; q < 4; ++q)
#pragma unroll
            for (int j = 0; j < 4; ++j) cur[q][j] = nxt[q][j];
    }
}

__device__ __forceinline__ void build_tile_tables(Frame& F, const int tid) {
    LAS int* TB = (LAS int*)(F.lds + LDSX_OFF); LAS unsigned char* t2e = F.lds + LDSX_OFF + 128;
    __syncthreads();
    if (tid == 0) { int acc = 0;
        for (int e = 0; e < NEXP; ++e) { const int n = (int)__hip_atomic_load(F.ctl + CW_CNT + e, __ATOMIC_RELAXED, __HIP_MEMORY_SCOPE_AGENT); TB[e] = acc; acc += (n + 255) >> 8; }
        TB[NEXP] = acc; }
    __syncthreads();
    for (int t = tid; t < 1024; t += NWAVES * 64) { int e = 0;
#pragma unroll
        for (int k = 1; k < NEXP; ++k) e += (t >= TB[k]) ? 1 : 0;
        t2e[t] = (unsigned char)e; }
    __syncthreads();
}

struct Args { const float* in[26]; float* out; unsigned char* ws; int ph_lo, ph_hi; };

__global__ void __launch_bounds__(NWAVES * 64, 2) hybrid_fwd(Args args) {
    extern __shared__ __attribute__((aligned(16))) unsigned char lds[];
    __builtin_assume(__builtin_amdgcn_workitem_id_y() == 0); __builtin_assume(__builtin_amdgcn_workitem_id_z() == 0);
    Frame F;
    F.lds = (LAS unsigned char*)lds;
    F.G = gridDim.x; { const int bx = blockIdx.x; F.vcu = (F.G % 8 == 0) ? (bx % 8) * (F.G / 8) + bx / 8 : bx; }
    F.ctl = (unsigned*)(args.ws + WS_CTL);
#define x_in (args.in[0])
#define mem_in (args.in[1])
#define norm_mix_g (args.in[2])
#define w_in (args.in[3])
#define pool_w (args.in[4])
#define pool_scale (args.in[5])
#define lam_q1 (args.in[6])
#define lam_k1 (args.in[7])
#define lam_q2 (args.in[8])
#define lam_k2 (args.in[9])
#define subln_g (args.in[10])
#define norm_mem_g (args.in[11])
#define w_mem_kv (args.in[12])
#define p_pool (args.in[13])
#define p_diff (args.in[14])
#define p_mem (args.in[15])
#define w_o (args.in[16])
#define norm_ffn_g (args.in[17])
#define w_rg (args.in[18])
#define b_rg (args.in[19])
#define w_re (args.in[20])
#define b_re (args.in[21])
#define w_eg (args.in[22])
#define w_eu (args.in[23])
#define w_ed (args.in[24])
#define final_g (args.in[25])
#define Win_t ((bf16*)(args.ws + WS_WIN))
#define Pc_t ((bf16*)(args.ws + WS_PC))
#define Wo_t ((bf16*)(args.ws + WS_WO))
#define Wgu_t ((bf16*)(args.ws + WS_WGU))
#define Wd_t ((bf16*)(args.ws + WS_WD))
#define KV ((bf16*)(args.ws + WS_KV))
#define XN ((bf16*)(args.ws + WS_XN))
#define BR ((bf16*)(args.ws + WS_BR))
#define H2 ((bf16*)(args.ws + WS_H2))
#define PROJ ((bf16*)(args.ws + WS_PROJ))
#define MERGED ((bf16*)(args.ws + WS_MERGED))
#define MIX ((bf16*)(args.ws + WS_MIX))
#define HID ((bf16*)(args.ws + WS_HID))
#define ATTO ((bf16*)(args.ws + WS_ATTO))
#define GATES ((bf16*)(args.ws + WS_GATES))
#define Y ((bf16*)(args.ws + WS_Y))
#define ROUTE ((v4u*)(args.ws + WS_ROUTE))
#define RWE ((float*)(args.ws + WS_RWE))
#define LIST ((int*)(args.ws + WS_LIST))
#define WRF ((bf16*)(args.ws + WS_WRF))
#define RINV ((float*)(args.ws + WS_RINV))
#define X1 (args.out)
    const int NGW = F.G * NWAVES;
#define PHASE_IDS int tid = threadIdx.x; asm volatile("" : "+v"(tid)); const int lane = tid & 63, wave = __builtin_amdgcn_readfirstlane(tid >> 6), gw = F.vcu * NWAVES + wave; (void)lane; (void)gw;
    const int lo = args.ph_lo, hi = args.ph_hi;
    cg::grid_group grid = cg::this_grid();
#ifndef PH_MASK
#define PH_MASK 0x3ff
#endif
#define IN(k) (((PH_MASK >> (k)) & 1) && lo <= (k) && (k) < hi)
#ifndef PROBE_A
#define PROBE_A -1
#endif
#ifndef PROBE_B
#define PROBE_B -1
#endif
#ifndef PROBE_A2
#define PROBE_A2 (PROBE_A + 1)
#endif
#ifndef PROBE_B2
#define PROBE_B2 (PROBE_B + 1)
#endif
#define STAMP(k) do { if ((PROBE_A >= 0 || PROBE_B >= 0) && blockIdx.x == 0 && threadIdx.x == 0) ((unsigned long long*)(F.ctl + CW_TS))[k] = __builtin_amdgcn_s_memrealtime(); } while (0)
#define SEAM(k) do { if (IN(k) && IN((k) + 1)) { if (hi > NPH) grid.sync(); else { XcdBarrier b_; b_.bar = (unsigned*)(args.ws + WS_CTL) + CW_BAR; b_.x = xb_xcc_id(); b_.st = (volatile LAS unsigned*)(F.lds + LDSX_OFF + 2048); xcd_barrier(b_); } } STAMP((k) + 1); } while (0)
    if (threadIdx.x < 2) ((LAS unsigned*)(F.lds + LDSX_OFF + 2048))[threadIdx.x] = 0u;
    __syncthreads();
    if (lo < hi - 1) (void)xcd_barrier_post((unsigned*)(args.ws + WS_CTL) + CW_BAR, (volatile LAS unsigned*)(F.lds + LDSX_OFF + 2048));
    STAMP(0);

    if (IN(0)) {
        PHASE_IDS
        LAS float* scr = (LAS float*)(F.lds + RING_OFF + wave * 16384);
        constexpr int I_IN = 16 * 160, I_KV = 16 * 16, I_PD = 8 * 32, I_PM = 4 * 32, I_WO = 16 * 32, I_EG = 16 * 256, I_EU = 16 * 256, I_ED = 16 * 256;
        constexpr int NITEMS = I_IN + I_KV + I_PD + I_PM + I_WO + I_EG + I_EU + I_ED;
        for (int it = gw; it < NITEMS; it += NGW) {
            int r = it;
            if (r < I_IN) { p0_plain(w_in, D, INCOLS, Win_t, 0, r, scr, lane); continue; } r -= I_IN;
            if (r < I_KV) { p0_plain(w_mem_kv, D, 512, Win_t, INCOLS, r, scr, lane); continue; } r -= I_KV;
            if (r < I_PD) { const int kb = r >> 5, nb = r & 31; p0_tile(p_diff, D, 64 * kb, 32 * nb, Pc_t + 256, D, 32 * nb, scr, lane); continue; } r -= I_PD;
            if (r < I_PM) { const int kb = r >> 5, nb = r & 31; p0_tile(p_mem, D, 64 * kb, 32 * nb, Pc_t + 768, D, 32 * nb, scr, lane); continue; } r -= I_PM;
            if (r < I_WO) { p0_plain(w_o, D, D, Wo_t, 0, r, scr, lane); continue; } r -= I_WO;
            if (r < I_EG + I_EU) { const bool up = r >= I_EG; if (up) r -= I_EG;
                const int e = r >> 8, rr = r & 255, kb = rr >> 4, nb = rr & 15, n0 = 32 * nb;
                p0_tile((up ? w_eu : w_eg) + (size_t)e * D * EH, EH, 64 * kb, n0, Wgu_t + (size_t)e * D * D, D, (n0 >> 7) * 256 + (n0 & 127) + (up ? 128 : 0), scr, lane, norm_ffn_g); continue; }
            r -= I_EG + I_EU;
            { const int e = r >> 8, rr = r & 255, kb = rr >> 5, nb = rr & 31;
              p0_tile(w_ed + (size_t)e * EH * D, D, 64 * kb, 32 * nb, Wd_t + (size_t)e * D * EH, EH, 32 * nb, scr, lane); }
        }
        STAMP(12);
        for (int idx = (F.vcu * NWAVES * 64 + tid); idx < 5120; idx += F.G * NWAVES * 64) {
            const int q = idx % 20, h = (idx / 20) & 1, hl = (idx / 40) & 1, st = idx / 80, k0 = 32 * (st >> 1) + 16 * h + 8 * (st & 1);
            float v[8];
#pragma unroll
            for (int j = 0; j < 8; ++j) { const int k = k0 + j; const float w = norm_ffn_g[k] * (q < 4 ? w_rg[k * 4 + q] : w_re[k * 16 + (q - 4)]); const float hi = bflo(f2bf(w) ); v[j] = hl ? (w - hi) : w; }
            v4u o; o.x = pk2(v[0], v[1]); o.y = pk2(v[2], v[3]); o.z = pk2(v[4], v[5]); o.w = pk2(v[6], v[7]);
            *((GAS v4u*)WRF + idx) = o;
        }
        for (int idx = (F.vcu * NWAVES * 64 + tid); idx < 256 * 1024; idx += F.G * NWAVES * 64) {
            const int kc = idx >> 10, n = idx & 1023, g = kc >> 6; float a = 0.f;
#pragma unroll 16
            for (int d = 0; d < 64; ++d) a += pool_w[kc * 64 + d] * pool_scale[g * 64 + d] * p_pool[(size_t)(g * 64 + d) * D + n];
            Pc_t[(size_t)n * D + kc] = (bf16)f2bf(a);
        }
        STAMP(13);
        rms_rows_stream(x_in, norm_mix_g, mem_in, norm_mem_g, T, T + TM, XN, gw * 4, NGW * 4, lane);
    }
    SEAM(0);

    if (IN(1)) {
        pg8::Gemm g{XN, Win_t, T, INCOLS, D};
        pg8::ProjOrder S; S.so.init(T, INCOLS, F.G, (int)blockIdx.x);
        pg8::EpiProj E{PROJ, GATES, KV, attn_body::C2};
        pg8::gemm_phase<pg8::EpiProj, pg8::ProjOrder, true, true>(F.lds + RING_OFF, g, S, E);
    }
    SEAM(1);

    if (IN(2)) {
        PHASE_IDS
        typedef attn_body::bf16 abf;
        struct DiffOrder { int vcu, G;
            __device__ __forceinline__ bool next(int i, int& bhm, int& qb) const { bhm = vcu + (i >> 3) * G; if (bhm >= BATCH * 8) return false; const int k = i & 7; qb = (k & 1) ? (k >> 1) : 7 - (k >> 1); return true; } };
        { const DiffOrder S{F.vcu, F.G}; int bhm, qb;
          for (int i = 0; S.next(i, bhm, qb); ++i) {
            const int b = bhm >> 3, h = (bhm >> 1) & 3, m = bhm & 1; const size_t rb = (size_t)b * SEQ;
            const attn2::bf16* Qu = (const attn2::bf16*)PROJ + (rb + qb * 256) * PROJW + 256 + h * 128 + m * 64;
            const attn2::bf16* Kh = (const attn2::bf16*)PROJ + rb * PROJW + 768 + h * 128 + m * 64;
            const attn2::bf16* Vh = (const attn2::bf16*)PROJ + rb * PROJW + 1280 + h * 128;
            attn2::bf16* Ou = (attn2::bf16*)ATTO + (rb + qb * 256) * D + m * 512 + h * 128;
            asm volatile("" : "+s"(Qu), "+s"(Kh), "+s"(Vh), "+s"(Ou));
            attn2::attn_unit<8, true>(Qu, PROJW, Kh, Vh, PROJW, Ou, D, 4 * (qb + 1), (char*)lds + RING_OFF); } }
        for (int mu = F.vcu; mu < BATCH * 8; mu += F.G) {
            const int b = mu >> 3, mh = (mu >> 1) & 3, half = mu & 1;
            const abf* Q0 = (const abf*)PROJ + ((size_t)b * SEQ + half * 1024) * PROJW + 1792 + mh * 64;
            const abf* Kh = (const abf*)KV + (size_t)b * NMEM * 512 + mh * 64;
            const abf* Vh = (const abf*)KV + (size_t)b * NMEM * 512 + 256 + mh * 64;
            abf* O0 = (abf*)BR + ((size_t)b * SEQ + half * 1024) * D + 768 + mh * 64;
            asm volatile("" : "+s"(Q0), "+s"(Kh), "+s"(Vh), "+s"(O0));
            attn_body::mem_attn(Q0, PROJW, Kh, Vh, 512, O0, D, 4, (char*)lds + RING_OFF); }
    }
    SEAM(2);

    if (IN(3)) {
        PHASE_IDS
        float lam;
        { const float s1 = wave_sum(lam_q1[lane] * lam_k1[lane]), s2 = wave_sum(lam_q2[lane] * lam_k2[lane]); lam = __expf(s1) - __expf(s2) + 0.2f; }
        const int gi = lane >> 4, w = 2 << gi;
        float sg[8];
#pragma unroll
        for (int i = 0; i < 8; ++i) sg[i] = subln_g[((8 * lane) & 127) + i] * 0.8f;
        for (int tb = gw * 32; tb < T; tb += NGW * 32)
        for (int tp = 0; tp < 32; tp += 2) {
            const int t = tb + tp, s0 = t & (SEQ - 1);
            const GAS v2u* up = (const GAS v2u*)(PROJ + (size_t)(t + 1) * PROJW) + lane;
            const int nw0 = (w < s0 + 1) ? w : s0 + 1, nw1 = (w < s0 + 2) ? w : s0 + 2;
            v2u wq[17];
#pragma unroll
            for (int k = 0; k < 17; ++k) { wq[k] = (v2u){0u, 0u}; if (k < nw1 || (k >= 1 && k - 1 < nw0)) wq[k] = *(const GAS v2u*)((const GAS bf16*)up - (size_t)k * PROJW); }
            v4u oa[2], ob[2];
#pragma unroll
            for (int q = 0; q < 2; ++q) { oa[q] = *((const GAS v4u*)(ATTO + (size_t)(t + q) * D) + lane); ob[q] = *((const GAS v4u*)(ATTO + (size_t)(t + q) * D + 512) + lane); }
#pragma unroll
            for (int q = 0; q < 2; ++q) {
                const int nwq = q ? nw1 : nw0; float a0 = 0.f, a1 = 0.f, a2 = 0.f, a3 = 0.f;
#pragma unroll
                for (int k = 0; k < 16; ++k) { const v2u x = wq[k + 1 - q]; const bool in = k < nwq; a0 += in ? bflo(x.x) : 0.f; a1 += in ? bfhi(x.x) : 0.f; a2 += in ? bflo(x.y) : 0.f; a3 += in ? bfhi(x.y) : 0.f; }
                const v2u ut = wq[1 - q]; const float inv = 1.f / (float)nwq;
                v2u po; po.x = pk2(a0 * inv - bflo(ut.x), a1 * inv - bfhi(ut.x)); po.y = pk2(a2 * inv - bflo(ut.y), a3 * inv - bfhi(ut.y));
                *((GAS v2u*)(BR + (size_t)(t + q) * D) + lane) = po;
                const v4u o0 = oa[q], o1 = ob[q];
                float xv[8];
                xv[0] = bflo(o0.x) - lam * bflo(o1.x); xv[1] = bfhi(o0.x) - lam * bfhi(o1.x); xv[2] = bflo(o0.y) - lam * bflo(o1.y); xv[3] = bfhi(o0.y) - lam * bfhi(o1.y);
                xv[4] = bflo(o0.z) - lam * bflo(o1.z); xv[5] = bfhi(o0.z) - lam * bfhi(o1.z); xv[6] = bflo(o0.w) - lam * bflo(o1.w); xv[7] = bfhi(o0.w) - lam * bfhi(o1.w);
                float ss = 0.f;
#pragma unroll
                for (int i = 0; i < 8; ++i) ss += xv[i] * xv[i];
                ss += __shfl_xor(ss, 1); ss += __shfl_xor(ss, 2); ss += __shfl_xor(ss, 4); ss += __shfl_xor(ss, 8);
                const float r = 1.f / sqrtf(ss * (1.f / 128.f) + RMS_EPS);
                v4u od; od.x = pk2(xv[0] * r * sg[0], xv[1] * r * sg[1]); od.y = pk2(xv[2] * r * sg[2], xv[3] * r * sg[3]); od.z = pk2(xv[4] * r * sg[4], xv[5] * r * sg[5]); od.w = pk2(xv[6] * r * sg[6], xv[7] * r * sg[7]);
                *((GAS v4u*)(BR + (size_t)(t + q) * D + 256) + lane) = od; }
        }
    }
    SEAM(3);

    if (IN(4)) {
        pg8::StaticOrder S; S.init(T, D, F.G, (int)blockIdx.x);
        pg8::Gemm g{BR, Pc_t, T, D, D}; pg8::EpiMerge E{GATES, MERGED}; pg8::MidRescale MH{GATES};
        pg8::gemm_phase<pg8::EpiMerge, pg8::StaticOrder, true, true, pg8::MidRescale>(F.lds + RING_OFF, g, S, E, MH);
    }
    SEAM(4);

    if (IN(5)) {
        pg8::Gemm g{MERGED, Wo_t, T, D, D}; pg8::StaticOrder S; S.init(T, D, F.G, (int)blockIdx.x);
        pg8::EpiMix E{MIX};
        pg8::gemm_phase<pg8::EpiMix, pg8::StaticOrder, true, true>(F.lds + RING_OFF, g, S, E);
    }
    SEAM(5);

    if (IN(6)) {
        PHASE_IDS
        LAS v4u* WL = (LAS v4u*)(F.lds + RING_OFF);
        LAS float* SC = (LAS float*)(F.lds + RING_OFF + 81920) + wave * 1024;
        LAS v4u* REC = (LAS v4u*)(F.lds + RING_OFF + 81920 + 32768);
        LAS unsigned* LCNT = (LAS unsigned*)(F.lds + RING_OFF + 81920 + 32768 + 4096);
        LAS unsigned* LBASE = LCNT + 16; LAS float* RIL = (LAS float*)(LCNT + 32);
        for (int idx = tid; idx < 5120; idx += NWAVES * 64) WL[idx] = *((const GAS v4u*)WRF + idx);
        float bg[4], be[16];
#pragma unroll
        for (int i = 0; i < 4; ++i) bg[i] = b_rg[i];
#pragma unroll
        for (int i = 0; i < 16; ++i) be[i] = b_re[i];
        const int r32 = lane & 31, hh = lane >> 5;
        for (int rb0 = F.vcu * 256; rb0 < T; rb0 += F.G * 256) {
            if (tid < 16) LCNT[tid] = 0u;
            __syncthreads();
            const int li = wave * 32 + r32, row = rb0 + li;
            const GAS f32x4* xp = (const GAS f32x4*)(x_in + (size_t)row * D + 16 * hh);
            const GAS v4u* mp = (const GAS v4u*)(MIX + (size_t)row * D + 16 * hh);
            GAS v4u* hp = (GAS v4u*)(H2 + (size_t)row * D + 16 * hh);
            const LAS v4u* wl = WL + hh * 20 + r32;
            f32x16_t acc = {}; float ss = 0.f;
            f32x4 cur[8]; v4u curm[4];
#pragma unroll
            for (int i = 0; i < 8; ++i) cur[i] = xp[(i >> 2) * 8 + (i & 3)];
#pragma unroll
            for (int i = 0; i < 4; ++i) curm[i] = mp[(i >> 1) * 4 + (i & 1)];
#pragma unroll 1
            for (int sp2 = 0; sp2 < 16; ++sp2) {
                f32x4 nxt[8]; v4u nxtm[4];
                const int spn = (sp2 + 1 < 16) ? sp2 + 1 : sp2;
#pragma unroll
                for (int i = 0; i < 8; ++i) nxt[i] = xp[(2 * spn + (i >> 2)) * 8 + (i & 3)];
#pragma unroll
                for (int i = 0; i < 4; ++i) nxtm[i] = mp[(2 * spn + (i >> 1)) * 4 + (i & 1)];
#pragma unroll
                for (int i = 0; i < 4; ++i) { const v4u mm = curm[i];
                    cur[2 * i].x += bflo(mm.x); cur[2 * i].y += bfhi(mm.x); cur[2 * i].z += bflo(mm.y); cur[2 * i].w += bfhi(mm.y);
                    cur[2 * i + 1].x += bflo(mm.z); cur[2 * i + 1].y += bfhi(mm.z); cur[2 * i + 1].z += bflo(mm.w); cur[2 * i + 1].w += bfhi(mm.w); }
#pragma unroll
                for (int u = 0; u < 2; ++u) { const int sp = 2 * sp2 + u;
                    v4u ahi[2], alo[2];
#pragma unroll
                    for (int e = 0; e < 2; ++e) { const f32x4 a = cur[4 * u + 2 * e], b = cur[4 * u + 2 * e + 1];
                        ss += (a.x * a.x + a.y * a.y) + (a.z * a.z + a.w * a.w) + (b.x * b.x + b.y * b.y) + (b.z * b.z + b.w * b.w);
                        v4u h; h.x = cvtpk(a.x, a.y); h.y = cvtpk(a.z, a.w); h.z = cvtpk(b.x, b.y); h.w = cvtpk(b.z, b.w); ahi[e] = h;
                        v4u l; l.x = cvtpk(a.x - bflo(h.x), a.y - bfhi(h.x)); l.y = cvtpk(a.z - bflo(h.y), a.w - bfhi(h.y)); l.z = cvtpk(b.x - bflo(h.z), b.y - bfhi(h.z)); l.w = cvtpk(b.z - bflo(h.w), b.w - bfhi(h.w)); alo[e] = l; }
                    hp[sp * 4] = ahi[0]; hp[sp * 4 + 1] = ahi[1];
#pragma unroll
                    for (int e = 0; e < 2; ++e) { const int st = 2 * sp + e;
                        v4u bh = {0u, 0u, 0u, 0u}, bl = {0u, 0u, 0u, 0u};
                        if (r32 < 20) { bh = wl[(st * 4) * 20]; bl = wl[(st * 4 + 2) * 20]; }
                        acc = __builtin_amdgcn_mfma_f32_32x32x16_bf16(__builtin_bit_cast(bf16x8_t, ahi[e]), __builtin_bit_cast(bf16x8_t, bh), acc, 0, 0, 0);
                        acc = __builtin_amdgcn_mfma_f32_32x32x16_bf16(__builtin_bit_cast(bf16x8_t, alo[e]), __builtin_bit_cast(bf16x8_t, bh), acc, 0, 0, 0);
                        acc = __builtin_amdgcn_mfma_f32_32x32x16_bf16(__builtin_bit_cast(bf16x8_t, ahi[e]), __builtin_bit_cast(bf16x8_t, bl), acc, 0, 0, 0); } }
#pragma unroll
                for (int i = 0; i < 8; ++i) cur[i] = nxt[i];
#pragma unroll
                for (int i = 0; i < 4; ++i) curm[i] = nxtm[i];
            }
            ss += __shfl_xor(ss, 32);
            const float rinv = 1.f / sqrtf(ss * (1.f / D) + RMS_EPS);
#pragma unroll
            for (int r = 0; r < 16; ++r) SC[((r & 3) + 8 * (r >> 2) + 4 * hh) * 32 + r32] = acc[r];
            LDS_WAIT();
            if (lane < 32) {
                float lg[20];
#pragma unroll
                for (int q4 = 0; q4 < 5; ++q4) { const f32x4 t4 = *(const LAS f32x4*)(SC + lane * 32 + 4 * q4); lg[4 * q4] = t4.x * rinv; lg[4 * q4 + 1] = t4.y * rinv; lg[4 * q4 + 2] = t4.z * rinv; lg[4 * q4 + 3] = t4.w * rinv; }
                float gl[4];
#pragma unroll
                for (int i = 0; i < 4; ++i) gl[i] = lg[i] + bg[i];
                int gidx = 0; float gmax = gl[0];
#pragma unroll
                for (int i = 1; i < 4; ++i) if (gl[i] > gmax) { gmax = gl[i]; gidx = i; }
                float gsum = 0.f;
#pragma unroll
                for (int i = 0; i < 4; ++i) gsum += __expf(gl[i] - gmax);
                const float gp = 1.f / gsum;
                float el[4];
#pragma unroll
                for (int j = 0; j < 4; ++j) { const float l0 = lg[4 + j] + be[j], l1 = lg[8 + j] + be[4 + j], l2 = lg[12 + j] + be[8 + j], l3 = lg[16 + j] + be[12 + j];
                    el[j] = gidx == 0 ? l0 : gidx == 1 ? l1 : gidx == 2 ? l2 : l3; }
                int i0 = 0; float m0 = el[0];
#pragma unroll
                for (int j = 1; j < 4; ++j) if (el[j] > m0) { m0 = el[j]; i0 = j; }
                int i1 = -1; float m1 = -3.0e38f;
#pragma unroll
                for (int j = 0; j < 4; ++j) if (j != i0 && el[j] > m1) { m1 = el[j]; i1 = j; }
                if (i1 < 0) { i1 = (i0 + 1) & 3; m1 = m0; }
                const float p1 = __expf(m1 - m0);
                const float w0 = gp / (1.f + p1), w1 = gp * p1 / (1.f + p1);
                const unsigned e0 = (unsigned)(gidx * 4 + i0), e1 = (unsigned)(gidx * 4 + i1);
                const unsigned s0 = __hip_atomic_fetch_add(LCNT + e0, 1u, __ATOMIC_RELAXED, __HIP_MEMORY_SCOPE_WORKGROUP), s1 = __hip_atomic_fetch_add(LCNT + e1, 1u, __ATOMIC_RELAXED, __HIP_MEMORY_SCOPE_WORKGROUP);
                v4u rc; rc.x = (e0 << 20) | s0; rc.y = (e1 << 20) | s1; rc.z = __float_as_uint(w0); rc.w = __float_as_uint(w1); REC[li] = rc;
                RINV[row] = rinv; RIL[li] = rinv;
            }
            __syncthreads();
            if (tid < 16) LBASE[tid] = __hip_atomic_fetch_add(F.ctl + CW_CNT + tid, LCNT[tid], __ATOMIC_RELAXED, __HIP_MEMORY_SCOPE_AGENT);
            __syncthreads();
            if (tid < 256) { v4u rc = REC[tid]; rc.x += LBASE[rc.x >> 20]; rc.y += LBASE[rc.y >> 20]; *((GAS v4u*)ROUTE + rb0 + tid) = rc;
                const unsigned i0 = ((rc.x >> 20) << 16) + (rc.x & 0xFFFFFu), i1 = ((rc.y >> 20) << 16) + (rc.y & 0xFFFFFu); const float ri = RIL[tid];
                LIST[i0] = rb0 + tid; LIST[i1] = rb0 + tid; RWE[2 * i0] = ri; RWE[2 * i0 + 1] = __uint_as_float(rc.z); RWE[2 * i1] = ri; RWE[2 * i1 + 1] = __uint_as_float(rc.w); }
            __syncthreads();
        }
    }
    SEAM(6);

    if (IN(7)) {
        PHASE_IDS
        build_tile_tables(F, tid);
        const LAS int* TB = (const LAS int*)(F.lds + LDSX_OFF); const LAS unsigned char* t2e = (const LAS unsigned char*)(F.lds + LDSX_OFF + 128);
        LAS int* TOKL = (LAS int*)(F.lds + LDSX_OFF + 4096);
        const int nunits = TB[NEXP] * 4;
        for (int i = 0; i < 11; ++i) { const int L = i * F.G + F.vcu; if (L >= nunits) break;
            const int pm = L >> 2, e = t2e[pm], lt = pm - TB[e];
            if (tid < 256) { unsigned tok = (unsigned)LIST[(e << 16) + lt * 256 + tid]; tok = tok < (unsigned)T ? tok : (unsigned)(T - 1); TOKL[i * 256 + tid] = (int)tok; } }
        __syncthreads();
        pg8::Gemm g{H2, Wgu_t, T, NEXP * D, D};
        pg8::MoeOrder S{t2e, nunits, F.G, F.vcu};
        pg8::EpiGateUp E{HID, RWE, TB};
        pg8::gemm_phase<pg8::EpiGateUp, pg8::MoeOrder, true, true, pg8::NoMid, true>(F.lds + RING_OFF, g, S, E, pg8::NoMid(), TOKL);
    }
    SEAM(7);

    if (IN(8)) {
        PHASE_IDS
        build_tile_tables(F, tid);
        const LAS int* TB = (const LAS int*)(F.lds + LDSX_OFF);
        pg8::Gemm g{HID, Wd_t, MAXROWS, NEXP * D, EH};
        pg8::MoeOrder S{(const LAS unsigned char*)(F.lds + LDSX_OFF + 128), TB[NEXP] * 4, F.G, F.vcu};
        pg8::EpiDown E{Y};
        pg8::gemm_phase<pg8::EpiDown, pg8::MoeOrder, true, true>(F.lds + RING_OFF, g, S, E);
    }
    SEAM(8);

    if (IN(9)) {
        PHASE_IDS
        build_tile_tables(F, tid);
        const LAS int* TB = (const LAS int*)(F.lds + LDSX_OFF);
        for (int t = gw; t < T; t += NGW) {
            const v4u rc = *((const GAS v4u*)ROUTE + t);
            const size_t r0 = (size_t)TB[rc.x >> 20] * 256 + (rc.x & 0xFFFFFu), r1 = (size_t)TB[rc.y >> 20] * 256 + (rc.y & 0xFFFFFu);
            GAS f32x4* xr = (GAS f32x4*)(X1 + (size_t)t * D) + lane; const GAS f32x4* gr = (const GAS f32x4*)final_g + lane; const GAS v2u* hr = (const GAS v2u*)(H2 + (size_t)t * D) + lane;
            const GAS v2u* y0 = (const GAS v2u*)(Y + r0 * D) + lane; const GAS v2u* y1 = (const GAS v2u*)(Y + r1 * D) + lane;
            f32x4 v[4]; float s = 0.f;
#pragma unroll
            for (int j = 0; j < 4; ++j) { const v2u hx = hr[64 * j]; v[j] = (f32x4){bflo(hx.x), bfhi(hx.x), bflo(hx.y), bfhi(hx.y)}; const v2u a = y0[64 * j], b = y1[64 * j];
                v[j].x += bflo(a.x) + bflo(b.x); v[j].y += bfhi(a.x) + bfhi(b.x); v[j].z += bflo(a.y) + bflo(b.y); v[j].w += bfhi(a.y) + bfhi(b.y);
                s += (v[j].x * v[j].x + v[j].y * v[j].y) + (v[j].z * v[j].z + v[j].w * v[j].w); }
            const float r = 1.f / sqrtf(wave_sum(s) * (1.f / D) + RMS_EPS);
#pragma unroll
            for (int j = 0; j < 4; ++j) { f32x4 o = v[j] * r * gr[64 * j];
                if (PROBE_B >= 0 && blockIdx.x == 0 && (t / NGW) < 8) {
                    const unsigned long long* ts = (const unsigned long long*)(F.ctl + CW_TS); const float amp = sqrtf((float)((ts[PROBE_B2] - ts[PROBE_B]) / 100) * 1e-3f);
                    o.x += amp; o.y += amp; o.z += amp; o.w += amp; }
                xr[64 * j] = o; }
        }
        STAMP(10);
        if (PROBE_A >= 0 && blockIdx.x == 0 && threadIdx.x == 0) {
            const unsigned long long* ts = (const unsigned long long*)(F.ctl + CW_TS);
            X1[0] += 4.f + (float)((ts[PROBE_A2] - ts[PROBE_A]) / 100) * 0.01f; }
    }
#undef IN
#undef SEAM
#undef STAMP
#undef PHASE_IDS
#undef x_in
#undef mem_in
#undef norm_mix_g
#undef w_in
#undef pool_w
#undef pool_scale
#undef lam_q1
#undef lam_k1
#undef lam_q2
#undef lam_k2
#undef subln_g
#undef norm_mem_g
#undef w_mem_kv
#undef p_pool
#undef p_diff
#undef p_mem
#undef w_o
#undef norm_ffn_g
#undef w_rg
#undef b_rg
#undef w_re
#undef b_re
#undef w_eg
#undef w_eu
#undef w_ed
#undef final_g
#undef Win_t
#undef Pc_t
#undef Wo_t
#undef Wgu_t
#undef Wd_t
#undef KV
#undef XN
#undef BR
#undef H2
#undef PROJ
#undef MERGED
#undef MIX
#undef HID
#undef ATTO
#undef GATES
#undef Y
#undef ROUTE
#undef RWE
#undef LIST
#undef WRF
#undef RINV
#undef X1
}

extern "C" void kernel_launch(void* const* d_in, const int* in_sizes, int n_in, void* d_out, int out_size, void* d_ws, size_t ws_size, hipStream_t stream) {
    static int grid = 0;
    if (grid == 0) {
        if (n_in != 26 || in_sizes[0] != T * D || out_size != T * D || ws_size < WS_END) { fprintf(stderr, "kernel_launch: unexpected problem: n_in %d in0 %d out %d ws %zu (need %zu)\n", n_in, n_in > 0 ? in_sizes[0] : -1, out_size, ws_size, (size_t)WS_END); grid = -1; return; }
        int dev = 0, cus = 0, per_cu = 0;
        if (hipGetDevice(&dev) != hipSuccess || hipDeviceGetAttribute(&cus, hipDeviceAttributeMultiprocessorCount, dev) != hipSuccess) { fprintf(stderr, "kernel_launch: device query failed\n"); grid = -1; return; }
        if (hipFuncSetAttribute((const void*)hybrid_fwd, hipFuncAttributeMaxDynamicSharedMemorySize, LDS_BYTES) != hipSuccess) { fprintf(stderr, "kernel_launch: hipFuncSetAttribute failed\n"); grid = -1; return; }
        if (hipOccupancyMaxActiveBlocksPerMultiprocessor(&per_cu, (const void*)hybrid_fwd, NWAVES * 64, LDS_BYTES) != hipSuccess || per_cu < 1) { fprintf(stderr, "kernel_launch: occupancy query says %d blocks per CU\n", per_cu); grid = -1; return; }
        (void)hipGetLastError();
        grid = cus;
        if (grid > 256) grid = 256;
    }
    if (grid < 0) return;
    if (hipMemsetAsync((char*)d_ws + WS_CTL, 0, CTL_ZERO_BYTES, stream) != hipSuccess) { fprintf(stderr, "kernel_launch: memset failed\n"); return; }
    Args a{};
    for (int i = 0; i < 26; ++i) a.in[i] = (const float*)d_in[i];
    a.out = (float*)d_out; a.ws = (unsigned char*)d_ws;
#if MK_N_LAUNCHES == 1
    a.ph_lo = 0; a.ph_hi = NPH;
    void* kargs[] = {&a};
    hipError_t e = hipLaunchCooperativeKernel((const void*)hybrid_fwd, dim3(grid), dim3(NWAVES * 64), kargs, LDS_BYTES, stream);
    if (e != hipSuccess) fprintf(stderr, "kernel_launch: cooperative launch failed: %s (grid %d)\n", hipGetErrorString(e), grid);
#else
    for (int p = 0; p < NPH; ++p) { a.ph_lo = p; a.ph_hi = p + 1;
        hipLaunchKernelGGL(hybrid_fwd, dim3(grid), dim3(NWAVES * 64), LDS_BYTES, stream, a);
        const hipError_t le = hipPeekAtLastError(); if (le != hipSuccess) { fprintf(stderr, "kernel_launch: launch %d failed: %s\n", p, hipGetErrorName(le)); break; } }
#endif
}
```

```cpp
#include <hip/hip_runtime.h>
#include <hip/hip_cooperative_groups.h>
#include <cstdio>
#include <cstdint>
namespace cg = cooperative_groups;
__device__ __forceinline__ int tid_of(int wv) { unsigned z = 0u; asm volatile("" : "+v"(z));
    return (wv << 6) | (int)__builtin_amdgcn_mbcnt_hi(~0u, __builtin_amdgcn_mbcnt_lo(~0u, z)); }
namespace pg8 {
#define PG8_LAS __attribute__((address_space(3)))
typedef unsigned short bf16_t;
typedef short bf16x8 __attribute__((ext_vector_type(8)));
typedef float f32x4 __attribute__((ext_vector_type(4)));
typedef unsigned u32x4 __attribute__((ext_vector_type(4)));
constexpr int BM = 256, BK = 64, HALF = 128, HTB = HALF * BK * 2  , STAGE_BYTES = 8 * HTB, NXCD = 8, WGM = 8;

__host__ __device__ __forceinline__ int lds_byte(int r, int c) { const int st = (r >> 4) * 2 + (c >> 5), rr = r & 15, cc = c & 31, ob = rr * 64 + cc * 2; return st * 1024 + (ob ^ (((ob >> 9) & 1) << 5)); }
__host__ __device__ __forceinline__ void stage_rc(int b, int& R, int& C) { const int st = b / 1024, sb = b % 1024, swz = sb ^ (((sb >> 9) & 1) << 5); R = (st >> 1) * 16 + swz / 64; C = (st & 1) * 32 + (swz % 64) / 2; }
__host__ __device__ __forceinline__ int perm32(int rho) { const int n = rho >> 4, i = rho & 15; return 8 * (i >> 2) + 4 * n + (i & 3); }

struct Unit { int pm, pn; };
struct Gemm { const bf16_t* A; const bf16_t* Bt; int M, N, K; };

struct StaticOrder {
    int nM, nN, nwg, G, c;
    __host__ __device__ void init(int M, int N, int G_, int c_) { nM = M / BM; nN = N / BM; nwg = nM * nN; G = G_; c = c_; }
    __host__ __device__ bool next(int i, Unit& u) const {
        const long L = (long)i * G + c; if (L >= nwg) return false;
        int wgid = (int)L; { const int q = nwg / NXCD, r = nwg % NXCD, xcd = wgid % NXCD, off = wgid / NXCD; wgid = (xcd < r ? xcd * (q + 1) : r * (q + 1) + (xcd - r) * q) + off; }
        const int nig = WGM * nN, gid = wgid / nig, fm = gid * WGM, gsz = (nM - fm) < WGM ? (nM - fm) : WGM;
        u.pm = fm + ((wgid % nig) % gsz); u.pn = (wgid % nig) / gsz; return true;
    }
    __device__ __forceinline__ void a_ready(const Unit&) const {}
    __device__ __forceinline__ void done(const Unit&) const {}
};

__device__ __forceinline__ unsigned cvt_pk_bf16(float lo, float hi) { unsigned r; asm volatile("v_cvt_pk_bf16_f32 %0, %1, %2" : "=v"(r) : "v"(lo), "v"(hi)); return r; }
typedef unsigned u32x2 __attribute__((ext_vector_type(2)));
__device__ __forceinline__ float bf_lo(unsigned w) { return __uint_as_float(w << 16); }
__device__ __forceinline__ float bf_hi(unsigned w) { return __uint_as_float(w & 0xffff0000u); }
__device__ __forceinline__ float sigmoid_f(float x) { return __builtin_amdgcn_rcpf(1.0f + __builtin_amdgcn_exp2f(-1.4426950408889634f * x)); }
__device__ __forceinline__ u32x4 pack8(const f32x4 a, const f32x4 b) { u32x4 w; w.x = cvt_pk_bf16(a[0], a[1]); w.y = cvt_pk_bf16(a[2], a[3]); w.z = cvt_pk_bf16(b[0], b[1]); w.w = cvt_pk_bf16(b[2], b[3]); return w; }

struct ProjOrder {
    StaticOrder so;
    __device__ __forceinline__ bool next(int i, Unit& u) const {
        const long L = (long)i * so.G + so.c;
        if (L < so.nwg) return so.next(i, u);
        const int x = (int)(L - so.nwg); if (x >= 64) return false;
        u.pm = 256 + (x >> 1); u.pn = 20 + (x & 1); return true;
    }
    __device__ __forceinline__ void a_ready(const Unit&) const {}
    __device__ __forceinline__ void done(const Unit&) const {}
};
struct MoeOrder {
    const PG8_LAS unsigned char* t2e; int nunits, G, c;
    __device__ __forceinline__ bool next(int i, Unit& u) const {
        const int L = i * G + c; if (L >= nunits) return false;
        const int pm = L >> 2; u.pm = pm; u.pn = (int)t2e[pm] * 4 + (L & 3); return true;
    }
    __device__ __forceinline__ void a_ready(const Unit&) const {}
    __device__ __forceinline__ void done(const Unit&) const {}
};

struct EpiProj {
    static constexpr bool PERM = true, AFTER_DRAIN = false;
    bf16_t* PROJ; bf16_t* GATES; bf16_t* KV; float qscale;
    __device__ __forceinline__ void operator()(const f32x4 (&acc)[2][2][4][2], const Unit& u, int wr, int wc, int fr, int fq) const {
        bf16_t* base; int ldc, colt, mode = 0; float sc = 1.f; int rowt = u.pm * BM;
        if (u.pm >= 256) { base = KV; ldc = 512; colt = (u.pn - 20) * BM; rowt -= 65536; }
        else if (u.pn < 8) { base = PROJ; ldc = 2048; colt = u.pn * BM; if (u.pn == 1 || u.pn == 2 || u.pn == 7) sc = qscale; }
        else { base = GATES; ldc = 3072; colt = (u.pn - 8) * BM; mode = 1; }
        const int row0 = rowt + wr * 64 + fr, col0 = colt + wc * 32 + 8 * fq;
#pragma unroll
        for (int ai = 0; ai < 2; ++ai)
#pragma unroll
            for (int m = 0; m < 4; ++m) { bf16_t* rowp = base + (size_t)(row0 + ai * HALF + m * 16) * ldc + col0;
#pragma unroll
                for (int bj = 0; bj < 2; ++bj) { f32x4 v0 = acc[ai][bj][m][0], v1 = acc[ai][bj][m][1];
                    if (mode) {
#pragma unroll
                        for (int i = 0; i < 4; ++i) { v0[i] = sigmoid_f(v0[i]); v1[i] = sigmoid_f(v1[i]); } }
                    else { v0 = v0 * sc; v1 = v1 * sc; }
                    *(u32x4*)(rowp + bj * HALF) = pack8(v0, v1); } }
    }
};
__device__ __forceinline__ float gclamp(float g) { return __builtin_fmaxf(g, 1e-18f); }
struct MidRescale {
    static constexpr bool ON = true; static constexpr int T0 = 4, T1 = 12;
    const bf16_t* GATES;
    __device__ __forceinline__ void operator()(f32x4 (&acc)[2][2][4][2], const Unit& u, int t, int wr, int wc, int fr, int fq) const {
        int fr_ = fr; asm volatile("" : "+v"(fr_));
        const int row0 = u.pm * BM + wr * 64 + fr_, col0 = u.pn * BM + wc * 32 + 8 * fq; const int gprev = (t == T0) ? 0 : 1024;
        const unsigned off0 = ((unsigned)row0 * 3072u + (unsigned)(gprev + col0)) * 2u;
#pragma unroll
        for (int ai = 0; ai < 2; ++ai) {
            u32x4 ga[4][2], gb[4][2];
#pragma unroll
            for (int m = 0; m < 4; ++m) { const char* gp = (const char*)GATES + (off0 + (unsigned)((ai * HALF + m * 16) * 3072 * 2));
#pragma unroll
                for (int bj = 0; bj < 2; ++bj) { ga[m][bj] = *(const u32x4*)(gp + bj * HALF * 2); gb[m][bj] = *(const u32x4*)(gp + 2048 + bj * HALF * 2); } }
#pragma unroll
            for (int m = 0; m < 4; ++m)
#pragma unroll
                for (int bj = 0; bj < 2; ++bj) { const u32x4 a = ga[m][bj], b = gb[m][bj];
                    f32x4 r0, r1;
                    r0[0] = bf_lo(a.x) * __builtin_amdgcn_rcpf(gclamp(bf_lo(b.x))); r0[1] = bf_hi(a.x) * __builtin_amdgcn_rcpf(gclamp(bf_hi(b.x)));
                    r0[2] = bf_lo(a.y) * __builtin_amdgcn_rcpf(gclamp(bf_lo(b.y))); r0[3] = bf_hi(a.y) * __builtin_amdgcn_rcpf(gclamp(bf_hi(b.y)));
                    r1[0] = bf_lo(a.z) * __builtin_amdgcn_rcpf(gclamp(bf_lo(b.z))); r1[1] = bf_hi(a.z) * __builtin_amdgcn_rcpf(gclamp(bf_hi(b.z)));
                    r1[2] = bf_lo(a.w) * __builtin_amdgcn_rcpf(gclamp(bf_lo(b.w))); r1[3] = bf_hi(a.w) * __builtin_amdgcn_rcpf(gclamp(bf_hi(b.w)));
                    acc[ai][bj][m][0] = acc[ai][bj][m][0] * r0; acc[ai][bj][m][1] = acc[ai][bj][m][1] * r1; }
            asm volatile("" ::: "memory"); }
    }
};
struct EpiMerge {
    static constexpr bool PERM = true, AFTER_DRAIN = false;
    const bf16_t* GATES; bf16_t* MERGED;
    __device__ __forceinline__ void operator()(const f32x4 (&acc)[2][2][4][2], const Unit& u, int wr, int wc, int fr, int fq) const {
        const int row0 = u.pm * BM + wr * 64 + fr, col0 = u.pn * BM + wc * 32 + 8 * fq;
        const unsigned off0 = ((unsigned)row0 * 3072u + (unsigned)(2048 + col0)) * 2u;
        u32x4 gg[2][4][2];
#pragma unroll
        for (int ai = 0; ai < 2; ++ai)
#pragma unroll
            for (int m = 0; m < 4; ++m)
#pragma unroll
                for (int bj = 0; bj < 2; ++bj) gg[ai][m][bj] = *(const u32x4*)((const char*)GATES + (off0 + (unsigned)((ai * HALF + m * 16) * 3072 * 2)) + bj * HALF * 2);
#pragma unroll
        for (int ai = 0; ai < 2; ++ai)
#pragma unroll
            for (int m = 0; m < 4; ++m) { const size_t r = (size_t)(row0 + ai * HALF + m * 16);
#pragma unroll
                for (int bj = 0; bj < 2; ++bj) { const int c = col0 + bj * HALF; const u32x4 g = gg[ai][m][bj];
                    f32x4 v0 = acc[ai][bj][m][0], v1 = acc[ai][bj][m][1];
                    v0[0] *= gclamp(bf_lo(g.x)); v0[1] *= gclamp(bf_hi(g.x)); v0[2] *= gclamp(bf_lo(g.y)); v0[3] *= gclamp(bf_hi(g.y));
                    v1[0] *= gclamp(bf_lo(g.z)); v1[1] *= gclamp(bf_hi(g.z)); v1[2] *= gclamp(bf_lo(g.w)); v1[3] *= gclamp(bf_hi(g.w));
                    *(u32x4*)(MERGED + r * 1024 + c) = pack8(v0, v1); } }
    }
};
struct EpiMix {
    static constexpr bool PERM = true, AFTER_DRAIN = false;
    bf16_t* MIX;
    __device__ __forceinline__ void operator()(const f32x4 (&acc)[2][2][4][2], const Unit& u, int wr, int wc, int fr, int fq) const {
        const int row0 = u.pm * BM + wr * 64 + fr, col0 = u.pn * BM + wc * 32 + 8 * fq;
#pragma unroll
        for (int ai = 0; ai < 2; ++ai)
#pragma unroll
            for (int m = 0; m < 4; ++m) { bf16_t* rowp = MIX + (size_t)(row0 + ai * HALF + m * 16) * 1024 + col0;
#pragma unroll
                for (int bj = 0; bj < 2; ++bj) *(u32x4*)(rowp + bj * HALF) = pack8(acc[ai][bj][m][0], acc[ai][bj][m][1]); }
    }
};
struct EpiWo {
    static constexpr bool PERM = false, AFTER_DRAIN = false;
    const float* X; float* X1;
    __device__ __forceinline__ void operator()(const f32x4 (&acc)[2][2][4][2], const Unit& u, int wr, int wc, int fr, int fq) const {
        const int row0 = u.pm * BM + wr * 64 + fr, col0 = u.pn * BM + wc * 32 + 4 * fq;
#pragma unroll
        for (int ai = 0; ai < 2; ++ai)
#pragma unroll
            for (int m = 0; m < 4; ++m) { const size_t off = (size_t)(row0 + ai * HALF + m * 16) * 1024 + col0;
#pragma unroll
                for (int bj = 0; bj < 2; ++bj)
#pragma unroll
                    for (int n = 0; n < 2; ++n) { const size_t o = off + bj * HALF + n * 16; *(f32x4*)(X1 + o) = *(const f32x4*)(X + o) + acc[ai][bj][m][n]; } }
    }
};
struct EpiGateUp {
    static constexpr bool PERM = true, AFTER_DRAIN = false;
    bf16_t* HID; const float* RWE; const PG8_LAS int* TB;
    __device__ __forceinline__ void operator()(const f32x4 (&acc)[2][2][4][2], const Unit& u, int wr, int wc, int fr, int fq) const {
        const int row0 = u.pm * BM + wr * 64 + fr, colh = (u.pn & 3) * 128 + wc * 32 + 8 * fq;
#pragma unroll
        for (int ai = 0; ai < 2; ++ai)
#pragma unroll
            for (int m = 0; m < 4; ++m) { const size_t r = (size_t)(row0 + ai * HALF + m * 16); const size_t es = (size_t)((u.pn >> 2) << 16) + (r - (size_t)TB[u.pn >> 2] * 256); const float ri = RWE[2 * es], w = RWE[2 * es + 1];
                f32x4 h0, h1;
#pragma unroll
                for (int i = 0; i < 4; ++i) { const float g0 = acc[ai][0][m][0][i] * ri, g1 = acc[ai][0][m][1][i] * ri; const float wr_ = w * ri;
                    h0[i] = g0 * sigmoid_f(g0) * acc[ai][1][m][0][i] * wr_; h1[i] = g1 * sigmoid_f(g1) * acc[ai][1][m][1][i] * wr_; }
                *(u32x4*)(HID + r * 512 + colh) = pack8(h0, h1); }
    }
};
struct EpiDown {
    static constexpr bool PERM = true, AFTER_DRAIN = false;
    bf16_t* Y;
    __device__ __forceinline__ void operator()(const f32x4 (&acc)[2][2][4][2], const Unit& u, int wr, int wc, int fr, int fq) const {
        const int row0 = u.pm * BM + wr * 64 + fr, col0 = (u.pn & 3) * BM + wc * 32 + 8 * fq;
#pragma unroll
        for (int ai = 0; ai < 2; ++ai)
#pragma unroll
            for (int m = 0; m < 4; ++m) { bf16_t* rowp = Y + (size_t)(row0 + ai * HALF + m * 16) * 1024 + col0;
#pragma unroll
                for (int bj = 0; bj < 2; ++bj) *(u32x4*)(rowp + bj * HALF) = pack8(acc[ai][bj][m][0], acc[ai][bj][m][1]); }
    }
};

struct NoMid { static constexpr bool ON = false; static constexpr int T0 = -1, T1 = -1; __device__ __forceinline__ void operator()(f32x4 (&)[2][2][4][2], const Unit&, int, int, int, int, int) const {} };
template <class Epi, class Sched, bool ALIGN_EPI = false, bool SP2 = false, class Mid = NoMid, bool GATHER = false>
__device__ __forceinline__ void gemm_phase(const int wv, PG8_LAS unsigned char* lds, const Gemm g, const Sched& S, const Epi& E, const Mid& MH = Mid(), const PG8_LAS int* tokl = nullptr) {
    int tid_ = tid_of(wv); asm volatile("" : "+v"(tid_));
    const int tid = tid_, wid = __builtin_amdgcn_readfirstlane(tid >> 6), lane = tid & 63, wr = wid >> 2, wc = wid & 3, fr = lane & 15, fq = lane >> 4;
    static_assert(!GATHER || SP2, "GATHER is written for the SP2 loop");
    const int K = g.K, nt = K / BK;
    unsigned voffA[2], voffB[2];
#pragma unroll
    for (int i = 0; i < 2; ++i) { int R, C; stage_rc(tid * 16 + i * 8192, R, C); const int Rb = Epi::PERM ? ((R & ~31) + perm32(R & 31)) : R;
        voffA[i] = (unsigned)(R * K + C) * 2u; voffB[i] = (unsigned)(Rb * K + C) * 2u; }
    const size_t kstep = (size_t)(BK * 2);
    const size_t hstep = (size_t)HALF * K * 2;
    const size_t tstep = 2 * hstep;
    const unsigned ldsw = (unsigned)wid * 1024u;
    const int aoff = lds_byte(wr * 64 + fr, fq * 8), boff = lds_byte(wc * 32 + fr, fq * 8);
    unsigned vGc[2][2], vGn[2][2]; int gR[2], gC[2];
    if constexpr (GATHER) {
#pragma unroll
        for (int i = 0; i < 2; ++i) { stage_rc(tid * 16 + i * 8192, gR[i], gC[i]); }
    }
#define PG8_GOFFS(dst, u_) do { if constexpr (GATHER) { _Pragma("unroll") for (int hh_ = 0; hh_ < 2; ++hh_) _Pragma("unroll") for (int i_ = 0; i_ < 2; ++i_) \
        dst[hh_][i_] = ((unsigned)tokl[(u_) * 256 + hh_ * HALF + gR[i_]] * (unsigned)K + (unsigned)gC[i_]) * 2u; } } while (0)
#define PG8_STGA(bufoff, base, hh, nx) do { if constexpr (GATHER) { _Pragma("unroll") for (int _i = 0; _i < 2; ++_i) \
        __builtin_amdgcn_global_load_lds((const unsigned*)((const char*)(base) + ((nx) ? vGn[hh][_i] : vGc[hh][_i])), (PG8_LAS unsigned*)(lds + (bufoff) + ldsw + _i * 8192), 16, 0, 0); } \
      else { PG8_STAGE(bufoff, (base) + (hh) * hstep, voffA); } } while (0)
#define PG8_SA(b, h) (((b) * 2 + (h)) * HTB)
#define PG8_SB(b, h) ((4 + (b) * 2 + (h)) * HTB)
#define PG8_STAGE(bufoff, gbase, voff) do { _Pragma("unroll") for (int _i = 0; _i < 2; ++_i) \
        __builtin_amdgcn_global_load_lds((const unsigned*)((const char*)(gbase) + (voff)[_i]), (PG8_LAS unsigned*)(lds + (bufoff) + ldsw + _i * 8192), 16, 0, 0); } while (0)
#define PG8_LDA(dst, b, h) do { _Pragma("unroll") for (int m = 0; m < 4; ++m) _Pragma("unroll") for (int k = 0; k < 2; ++k) dst[m][k] = *(const PG8_LAS bf16x8*)(lds + PG8_SA(b, h) + aoff + m * 2048 + k * 1024); } while (0)
#define PG8_LDB(dst, b, h) do { _Pragma("unroll") for (int n = 0; n < 2; ++n) _Pragma("unroll") for (int k = 0; k < 2; ++k) dst[n][k] = *(const PG8_LAS bf16x8*)(lds + PG8_SB(b, h) + boff + n * 2048 + k * 1024); } while (0)
#define PG8_MMA(ai, bj, At, Bt) do { __builtin_amdgcn_s_setprio(1); _Pragma("unroll") for (int m = 0; m < 4; ++m) _Pragma("unroll") for (int n = 0; n < 2; ++n) _Pragma("unroll") for (int k = 0; k < 2; ++k) \
        acc[ai][bj][m][n] = __builtin_amdgcn_mfma_f32_16x16x32_bf16(Bt[n][k], At[m][k], acc[ai][bj][m][n], 0, 0, 0); __builtin_amdgcn_s_setprio(0); } while (0)
#define PG8_WAIT_V(n) asm volatile("s_waitcnt vmcnt(" #n ")" ::: "memory")
#define PG8_WAIT_L(n) asm volatile("s_waitcnt lgkmcnt(" #n ")" ::: "memory")
#define PG8_BAR __builtin_amdgcn_s_barrier()
#define PG8_SCHED __builtin_amdgcn_sched_barrier(0)
    Unit cur, nxt; int ui = 0;
    if (!S.next(0, cur)) return;
    f32x4 acc[2][2][4][2];
#pragma unroll
    for (int a = 0; a < 2; ++a)
#pragma unroll
        for (int b = 0; b < 2; ++b)
#pragma unroll
            for (int m = 0; m < 4; ++m)
#pragma unroll
                for (int n = 0; n < 2; ++n) acc[a][b][m][n] = (f32x4){0.f, 0.f, 0.f, 0.f};
    bf16x8 At[4][2], B0[2][2], B1[2][2];
    const char* cA = (const char*)g.A + (GATHER ? (size_t)0 : (size_t)cur.pm * tstep); const char* cB = (const char*)g.Bt + (size_t)cur.pn * tstep;
    PG8_GOFFS(vGc, 0); PG8_GOFFS(vGn, 0);
    S.a_ready(cur);
    if constexpr (SP2) {
        PG8_STAGE(PG8_SB(0, 0), cB, voffB); PG8_STAGE(PG8_SB(0, 1), cB + hstep, voffB); PG8_STGA(PG8_SA(0, 0), cA, 0, false); PG8_STGA(PG8_SA(0, 1), cA, 1, false);
        if (wr == 1) PG8_BAR;
        PG8_WAIT_V(2); PG8_BAR;
        PG8_STAGE(PG8_SB(1, 0), cB + kstep, voffB); PG8_STGA(PG8_SA(1, 0), cA + kstep, 0, false); PG8_STAGE(PG8_SB(1, 1), cB + hstep + kstep, voffB);
        PG8_WAIT_V(6); PG8_BAR;
    } else {
        PG8_STAGE(PG8_SB(0, 0), cB, voffB); PG8_STAGE(PG8_SA(0, 0), cA, voffA); PG8_STAGE(PG8_SB(0, 1), cB + hstep, voffB); PG8_STAGE(PG8_SA(0, 1), cA + hstep, voffA);
        if (wr == 1) PG8_BAR;
        PG8_WAIT_V(4); PG8_BAR;
        PG8_STAGE(PG8_SB(1, 0), cB + kstep, voffB); PG8_STAGE(PG8_SA(1, 0), cA + kstep, voffA); PG8_STAGE(PG8_SB(1, 1), cB + hstep + kstep, voffB);
        PG8_WAIT_V(6); PG8_BAR;
    }
    for (;;) {
        const bool has_next = S.next(ui + 1, nxt);
        if (has_next) PG8_GOFFS(vGn, ui + 1);
        const char* nA = (has_next && !GATHER) ? (const char*)g.A + (size_t)nxt.pm * tstep : cA; const char* nB = has_next ? (const char*)g.Bt + (size_t)nxt.pn * tstep : cB;
        for (int t = 0; t < nt; t += 2) {
            if constexpr (Mid::ON) { if (t == Mid::T0 || t == Mid::T1) MH(acc, cur, t, wr, wc, fr, fq); }
            const bool last = (t == nt - 2);
            const char* a1 = cA + (size_t)(t + 1) * kstep;
            const char* a2 = last ? nA : cA + (size_t)(t + 2) * kstep; const char* b2 = last ? nB : cB + (size_t)(t + 2) * kstep;
            const char* a3 = a2 + kstep; const char* b3 = b2 + kstep;
            if (last && has_next) S.a_ready(nxt);
            if constexpr (SP2) {
            PG8_LDB(B0, 0, 0); PG8_LDB(B1, 0, 1); PG8_SCHED; PG8_LDA(At, 0, 0); PG8_STGA(PG8_SA(1, 1), a1, 1, false);
            PG8_WAIT_V(8); PG8_WAIT_L(0); PG8_BAR; PG8_MMA(0, 0, At, B0); PG8_MMA(0, 1, At, B1); PG8_BAR; PG8_SCHED;
            PG8_LDA(At, 0, 1); PG8_STAGE(PG8_SB(0, 0), b2, voffB); PG8_STAGE(PG8_SB(0, 1), b2 + hstep, voffB); PG8_STGA(PG8_SA(0, 0), a2, 0, last && has_next);
            PG8_WAIT_V(8); PG8_WAIT_L(0); PG8_BAR; PG8_MMA(1, 0, At, B0); PG8_MMA(1, 1, At, B1); PG8_BAR; PG8_SCHED;
            PG8_LDB(B0, 1, 0); PG8_LDB(B1, 1, 1); PG8_SCHED; PG8_LDA(At, 1, 0); PG8_STGA(PG8_SA(0, 1), a2, 1, last && has_next);
            PG8_WAIT_V(8); PG8_WAIT_L(0); PG8_BAR; PG8_MMA(0, 0, At, B0); PG8_MMA(0, 1, At, B1); PG8_BAR; PG8_SCHED;
            PG8_LDA(At, 1, 1); PG8_STAGE(PG8_SB(1, 0), b3, voffB); PG8_STAGE(PG8_SB(1, 1), b3 + hstep, voffB); PG8_STGA(PG8_SA(1, 0), a3, 0, last && has_next);
            PG8_WAIT_V(8); PG8_WAIT_L(0); PG8_BAR; PG8_MMA(1, 0, At, B0); PG8_MMA(1, 1, At, B1); PG8_BAR; PG8_SCHED;
            } else {
            PG8_LDB(B0, 0, 0); PG8_SCHED; PG8_LDA(At, 0, 0); PG8_STAGE(PG8_SA(1, 1), a1 + hstep, voffA);
            PG8_WAIT_L(8); PG8_BAR; PG8_WAIT_L(0); PG8_MMA(0, 0, At, B0); PG8_BAR; PG8_SCHED;
            PG8_LDB(B1, 0, 1); PG8_STAGE(PG8_SB(0, 0), b2, voffB);
            PG8_BAR; PG8_WAIT_L(0); PG8_MMA(0, 1, At, B1); PG8_BAR;
            PG8_LDA(At, 0, 1); PG8_STAGE(PG8_SA(0, 0), a2, voffA);
            PG8_BAR; PG8_WAIT_L(0); PG8_MMA(1, 0, At, B0); PG8_BAR; PG8_SCHED;
            PG8_STAGE(PG8_SB(0, 1), b2 + hstep, voffB);
            PG8_WAIT_V(6); PG8_BAR; PG8_MMA(1, 1, At, B1); PG8_BAR;
            PG8_LDB(B0, 1, 0); PG8_SCHED; PG8_LDA(At, 1, 0); PG8_STAGE(PG8_SA(0, 1), a2 + hstep, voffA);
            PG8_WAIT_L(8); PG8_BAR; PG8_WAIT_L(0); PG8_MMA(0, 0, At, B0); PG8_BAR; PG8_SCHED;
            PG8_LDB(B1, 1, 1); PG8_STAGE(PG8_SB(1, 0), b3, voffB);
            PG8_BAR; PG8_WAIT_L(0); PG8_MMA(0, 1, At, B1); PG8_BAR;
            PG8_LDA(At, 1, 1); PG8_STAGE(PG8_SA(1, 0), a3, voffA);
            PG8_BAR; PG8_WAIT_L(0); PG8_MMA(1, 0, At, B0); PG8_BAR; PG8_SCHED;
            PG8_STAGE(PG8_SB(1, 1), b3 + hstep, voffB);
            PG8_WAIT_V(6); PG8_BAR; PG8_MMA(1, 1, At, B1); PG8_BAR;
            }
        }
        if constexpr (ALIGN_EPI) { if (wr == 0) PG8_BAR; }
        if constexpr (!Epi::AFTER_DRAIN) { E(acc, cur, wr, wc, fr, fq); S.done(cur); }
        if (!has_next) break;
#pragma unroll
        for (int a = 0; a < 2; ++a)
#pragma unroll
            for (int b = 0; b < 2; ++b)
#pragma unroll
                for (int m = 0; m < 4; ++m)
#pragma unroll
                    for (int n = 0; n < 2; ++n) acc[a][b][m][n] = (f32x4){0.f, 0.f, 0.f, 0.f};
        cur = nxt; cA = nA; cB = nB; ++ui;
        if constexpr (GATHER) { _Pragma("unroll") for (int hh_ = 0; hh_ < 2; ++hh_) _Pragma("unroll") for (int i_ = 0; i_ < 2; ++i_) vGc[hh_][i_] = vGn[hh_][i_]; }
        if constexpr (ALIGN_EPI) { if (wr == 1) PG8_BAR; }
    }
    PG8_WAIT_V(0);
    if constexpr (!ALIGN_EPI) { if (wr == 0) PG8_BAR; }
    PG8_BAR;
    if constexpr (Epi::AFTER_DRAIN) { E.fused(acc, cur, wr, wc, fr, fq, lds, wid, lane); S.done(cur); }
#undef PG8_SA
#undef PG8_SB
#undef PG8_STAGE
#undef PG8_STGA
#undef PG8_GOFFS
#undef PG8_LDA
#undef PG8_LDB
#undef PG8_MMA
#undef PG8_WAIT_V
#undef PG8_WAIT_L
#undef PG8_BAR
#undef PG8_SCHED
}
}
#include <hip/hip_bf16.h>
#include <cmath>
namespace attn_body {
using bf16=__hip_bfloat16;
using bf16x8=__attribute__((ext_vector_type(8)))short;
using s16x4=__attribute__((ext_vector_type(4)))short;
using f32x16=__attribute__((ext_vector_type(16)))float;
using u32x4=__attribute__((ext_vector_type(4)))unsigned;
constexpr int D=64;
constexpr int NW=8,QBLK=32,QB=QBLK*NW,KVBLK=64;
constexpr int ATTN_UNIT_ROWS=QB;
__device__ __forceinline__ int crow(int r,int hi){return (r&3)+8*(r>>2)+4*hi;}
#define SBAR() __builtin_amdgcn_sched_barrier(0)
__device__ __forceinline__ void cmask(f32x16&p0,f32x16&p1,int jb,int qrel,int hi){
  const float NEG=-INFINITY; int kb=64*jb+4*hi;
  #pragma unroll
  for(int r=0;r<16;++r){int kv=kb+(r&3)+8*(r>>2); if(kv>qrel)p0[r]=NEG; if(kv+32>qrel)p1[r]=NEG;}
}

constexpr int NSLOT=3, SLOTB=8192;
constexpr int LDS_K=0, LDS_V=NSLOT*SLOTB, LDS_WS=2*NSLOT*SLOTB, LDS_OST=LDS_WS+NW*64*4, LDS_BYTES=LDS_OST+NW*4096;
constexpr float C2=0.125f*1.4426950408889634f;
__device__ __forceinline__ void glds16(const void*gsrc,unsigned lds_dst){unsigned keep;
  asm volatile("s_mov_b32 %0, m0\n\ts_mov_b32 m0, %2\n\ts_nop 0\n\tglobal_load_lds_dwordx4 %1, off\n\ts_mov_b32 m0, %0":"=&s"(keep):"v"(gsrc),"s"(lds_dst):"memory");}
__device__ __forceinline__ float max3f(float a,float b,float c){float r;asm("v_max3_f32 %0, %1, %2, %3":"=v"(r):"v"(a),"v"(b),"v"(c));return r;}
__device__ __forceinline__ float max2f(float a,float b){float r;asm("v_max_f32_e32 %0, %1, %2":"=v"(r):"v"(a),"v"(b));return r;}
__device__ __forceinline__ float fadd_s(float a,float b){float r;asm("v_add_f32_e32 %0, %1, %2":"=v"(r):"v"(a),"v"(b));return r;}
__device__ __forceinline__ float fsub_s(float a,float b){float r;asm("v_sub_f32_e32 %0, %1, %2":"=v"(r):"v"(a),"v"(b));return r;}
typedef float f32x2_t __attribute__((ext_vector_type(2))); typedef __bf16 bf16x2_t __attribute__((ext_vector_type(2)));
__device__ __forceinline__ unsigned cvtpk_s(float lo,float hi){f32x2_t v={lo,hi};bf16x2_t b=__builtin_convertvector(v,bf16x2_t);return __builtin_bit_cast(unsigned,b);}
#define WAIT_BAR(N) asm volatile("s_waitcnt vmcnt(" #N ") lgkmcnt(0)\n\ts_barrier":::"memory")

__device__ __forceinline__ void qkt(f32x16&p0,f32x16&p1,const char*Kslot,const bf16x8*qr,const f32x16&negm,int r32,int hi){
  const char*kb=Kslot+hi*1024+r32*16;
  #pragma unroll
  for(int d0=0;d0<4;++d0){
    const bf16x8 b0=*reinterpret_cast<const bf16x8*>(kb+d0*2048);
    const bf16x8 b1=*reinterpret_cast<const bf16x8*>(kb+d0*2048+512);
    if(d0==0){p0=__builtin_amdgcn_mfma_f32_32x32x16_bf16(b0,qr[0],negm,0,0,0);p1=__builtin_amdgcn_mfma_f32_32x32x16_bf16(b1,qr[0],negm,0,0,0);}
    else{p0=__builtin_amdgcn_mfma_f32_32x32x16_bf16(b0,qr[d0],p0,0,0,0);p1=__builtin_amdgcn_mfma_f32_32x32x16_bf16(b1,qr[d0],p1,0,0,0);}}
}
typedef __attribute__((address_space(3))) const char* lds_cptr;
typedef short v4i16_t __attribute__((ext_vector_type(4)));
__device__ __forceinline__ void kload8(bf16x8*kf,lds_cptr kp){
  kf[0]=*(const __attribute__((address_space(3))) bf16x8*)(kp);      kf[1]=*(const __attribute__((address_space(3))) bf16x8*)(kp+512);
  kf[2]=*(const __attribute__((address_space(3))) bf16x8*)(kp+2048); kf[3]=*(const __attribute__((address_space(3))) bf16x8*)(kp+2560);
  kf[4]=*(const __attribute__((address_space(3))) bf16x8*)(kp+4096); kf[5]=*(const __attribute__((address_space(3))) bf16x8*)(kp+4608);
  kf[6]=*(const __attribute__((address_space(3))) bf16x8*)(kp+6144); kf[7]=*(const __attribute__((address_space(3))) bf16x8*)(kp+6656);
}
__device__ __forceinline__ void kload2(bf16x8*kf,lds_cptr kp,int j){ kf[2*j]=*(const __attribute__((address_space(3))) bf16x8*)(kp+j*2048); kf[2*j+1]=*(const __attribute__((address_space(3))) bf16x8*)(kp+j*2048+512); }
__device__ __forceinline__ s16x4 vtr(lds_cptr p){ return __builtin_bit_cast(s16x4,__builtin_amdgcn_ds_read_tr16_b64_v4i16((__attribute__((address_space(3))) v4i16_t*)p)); }
__device__ __forceinline__ float rowmax(const f32x16&p0,const f32x16&p1){
  float a=max3f(p0[0],p0[1],p1[0]),b=max3f(p0[2],p0[3],p1[1]);a=max3f(a,p1[2],p1[3]);
  #pragma unroll
  for(int r=4;r<16;r+=4){a=max3f(a,p0[r],p0[r+1]);b=max3f(b,p0[r+2],p0[r+3]);a=max3f(a,p1[r],p1[r+1]);b=max3f(b,p1[r+2],p1[r+3]);}
  const float m=max2f(a,b);
  auto rr=__builtin_amdgcn_permlane32_swap(__float_as_uint(m),__float_as_uint(m),false,false);
  return max2f(__uint_as_float(rr[0]),__uint_as_float(rr[1]));
}
__device__ __forceinline__ void pv(f32x16*o,int vb,bf16x8 pa0,bf16x8 pa1,bf16x8 pa2,bf16x8 pa3){
  #pragma unroll
  for(int d0=0;d0<2;++d0){s16x4 lo[4],hi[4];
    #pragma unroll
    for(int ks=0;ks<4;++ks){
      asm volatile("ds_read_b64_tr_b16 %0,%1 offset:%c2":"=&v"(lo[ks]):"v"(vb),"i"(d0*4096+ks*1024):"memory");
      asm volatile("ds_read_b64_tr_b16 %0,%1 offset:%c2":"=&v"(hi[ks]):"v"(vb),"i"(d0*4096+ks*1024+512):"memory");}
    asm volatile("s_waitcnt lgkmcnt(0)":::"memory");SBAR();
    #define PK(k) (bf16x8){lo[k][0],lo[k][1],lo[k][2],lo[k][3],hi[k][0],hi[k][1],hi[k][2],hi[k][3]}
    o[d0]=__builtin_amdgcn_mfma_f32_32x32x16_bf16(pa0,PK(0),o[d0],0,0,0);
    o[d0]=__builtin_amdgcn_mfma_f32_32x32x16_bf16(pa1,PK(1),o[d0],0,0,0);
    o[d0]=__builtin_amdgcn_mfma_f32_32x32x16_bf16(pa2,PK(2),o[d0],0,0,0);
    o[d0]=__builtin_amdgcn_mfma_f32_32x32x16_bf16(pa3,PK(3),o[d0],0,0,0);
    #undef PK
  }
}

#ifndef ATTN_STORE16
#define ATTN_STORE16(p,v) (*(u32x4*)(p)=(v))
#endif
template<int THRL,bool CAUSAL> __device__ __forceinline__ void attn_unit(const bf16*Qu,const int pQ,const bf16*__restrict__ Kh,const bf16*__restrict__ Vh,const int pKV,bf16*Ou,const int pO,const int NT,char*shm,const int wv=0){
  int tid_=tid_of(wv); asm volatile("":"+v"(tid_));
  const int tid=tid_,lane=tid&63,r32=lane&31,hi=lane>>5; const int wid=__builtin_amdgcn_readfirstlane(tid>>6);
  const bf16*Qw=Qu+(long)(wid*QBLK)*pQ;
  const unsigned lds0=(unsigned)(uintptr_t)shm;
  float*wsf=(float*)(shm+LDS_WS)+wid*64;
  const bf16*ksrc=Kh+(long)lane*pKV+wid*8;
  const bf16*vsrc=Vh+(long)(16*(wid&3)+(lane>>2))*pKV+(wid>>2)*32+(lane&3)*8;
  const unsigned kdst=lds0+LDS_K+wid*1024, vdst=lds0+LDS_V+wid*1024;
  #define DMA_K(t,slot) glds16(ksrc+(long)(t)*KVBLK*pKV,(unsigned)__builtin_amdgcn_readfirstlane(kdst+(slot)))
  #define DMA_V(t,slot) glds16(vsrc+(long)(t)*KVBLK*pKV,(unsigned)__builtin_amdgcn_readfirstlane(vdst+(slot)))
  const int vb0=(int)(lds0+LDS_V)+((lane>>4)&1)*32+(lane&3)*8+(4*hi+((lane&15)>>2))*64;
  const char*Kbase=shm+LDS_K; bf16x8 kf[8];
  const lds_cptr shm3=(lds_cptr)shm; const lds_cptr kp0=shm3+LDS_K+hi*1024+r32*16; const lds_cptr vp0=shm3+LDS_V+((lane>>4)&1)*32+(lane&3)*8+(4*hi+((lane&15)>>2))*64;
  DMA_K(0,0);DMA_V(0,0);DMA_K(1,SLOTB);
  bf16x8 qr[4];
  #pragma unroll
  for(int d0=0;d0<4;++d0)qr[d0]=*reinterpret_cast<const bf16x8*>(&Qw[(long)r32*pQ+d0*16+hi*8]);
  float mhat=0.f,l_reg=0.f;f32x16 o[2];o[0]=f32x16{};o[1]=f32x16{};const f32x16 negm=f32x16{};
  const int qrel=wid*QBLK+r32;
  #define CMASK(P0,P1,t) do{ if(CAUSAL){int jb_=(t)-(NT-4); if(jb_>=0)cmask(P0,P1,jb_,qrel,hi);} }while(0)
  bool resc=false;
  #define START(P0,P1) do{ const float rm=rowmax(P0,P1); resc=false; \
    { const float dl=rm; mhat=fadd_s(mhat,dl); \
      _Pragma("unroll") for(int r=0;r<16;++r){P0[r]=fsub_s(P0[r],dl);P1[r]=fsub_s(P1[r],dl);} \
      } \
    _Pragma("unroll") for(int r=0;r<16;++r)P0[r]=__builtin_amdgcn_exp2f(P0[r]); }while(0)
  #define RESC() do{ if(resc){ asm volatile("s_waitcnt lgkmcnt(0)":::"memory"); \
      _Pragma("unroll") for(int d_=0;d_<2;++d_) _Pragma("unroll") for(int r=0;r<16;++r)o[d_][r]*=wsf[crow(r,hi)]; } }while(0)
  f32x16 pA0,pA1,pB0,pB1;
  int sl_prev=0,sl_cur=0,sl_next=SLOTB;
  #define ROT() do{sl_prev=sl_cur;sl_cur=sl_next;sl_next=(sl_next==(NSLOT-1)*SLOTB)?0:sl_next+SLOTB;}while(0)
  DMA_K(2,2*SLOTB);
  WAIT_BAR(3);
  qkt(pA0,pA1,Kbase,qr,negm,r32,hi);asm volatile("s_nop 15\n\ts_nop 7":"+v"(pA0),"+v"(pA1));CMASK(pA0,pA1,0);
  START(pA0,pA1);
  _Pragma("unroll") for(int r=0;r<16;++r)pA1[r]=__builtin_amdgcn_exp2f(pA1[r]);
  WAIT_BAR(0);
  DMA_K(3,0);DMA_V(1,SLOTB);
  ROT();
  kload8(kf,kp0+sl_cur);
  WAIT_BAR(2);
  s16x4 vlo[8],vhi[8]; u32x4 pw0,pw1,pw2,pw3;
  #define PKW(P,B) cvtpk_s(P[B],P[B+1])
  #define PAF(k) __builtin_bit_cast(bf16x8,pw##k)
  #define VFR(i) (bf16x8){vlo[i][0],vlo[i][1],vlo[i][2],vlo[i][3],vhi[i][0],vhi[i][1],vhi[i][2],vhi[i][3]}
  #define PIN(x) asm volatile("":"+v"(x))
  #define MX3(a,b,c) __builtin_fmaxf(__builtin_fmaxf((a),(b)),(c))
  #define GAPA(MF,A0,A1,A2,A3,W0,W1,PW) do{ MF; sacc+=A0; sacc+=A1; sacc+=A2; sacc+=A3; PIN(sacc); W0; W1; PIN(PW); SBAR(); }while(0)
  #define EX(v) __builtin_amdgcn_exp2f(v)
  #define GAPB(MF,X,B) do{ MF; X[B]=EX(X[B]); X[B+1]=EX(X[B+1]); X[B+2]=EX(X[B+2]); X[B+3]=EX(X[B+3]); PIN(X); SBAR(); }while(0)
  #define VRD(i) do{ vlo[i]=vtr(vp_+(((i)>>2)*4096+((i)&3)*1024)); vhi[i]=vtr(vp_+(((i)>>2)*4096+((i)&3)*1024+512)); }while(0)
  #define KRD(G,j) do{ if(G){ kload2(kf,kp0+sl_next,j); SBAR(); } }while(0)
  #define STEP(C0,C1,P0,P1,t,GK,GV,GL) do{ SBAR(); \
    const lds_cptr vp_=vp0+sl_prev; \
    VRD(0); SBAR(); float sacc=(P0[0]+P0[1]); \
    GAPA(C0=__builtin_amdgcn_mfma_f32_32x32x16_bf16(kf[0],qr[0],negm,0,0,0), P0[2],P0[3],P0[4],P0[5],     pw0[0]=PKW(P0,0), pw0[1]=PKW(P0,2), pw0); \
    VRD(4); SBAR(); GAPA(C1=__builtin_amdgcn_mfma_f32_32x32x16_bf16(kf[1],qr[0],negm,0,0,0), P0[6],P0[7],P0[8],P0[9],     pw0[2]=PKW(P0,4), pw0[3]=PKW(P0,6), pw0); \
    VRD(1); SBAR(); GAPA(C0=__builtin_amdgcn_mfma_f32_32x32x16_bf16(kf[2],qr[1],C0,0,0,0),   P0[10],P0[11],P0[12],P0[13], pw1[0]=PKW(P0,8), pw1[1]=PKW(P0,10), pw1); \
    VRD(5); SBAR(); GAPA(C1=__builtin_amdgcn_mfma_f32_32x32x16_bf16(kf[3],qr[1],C1,0,0,0),   P0[14],P0[15],P1[0],P1[1],   pw1[2]=PKW(P0,12),pw1[3]=PKW(P0,14), pw1); \
    VRD(2); SBAR(); GAPA(C0=__builtin_amdgcn_mfma_f32_32x32x16_bf16(kf[4],qr[2],C0,0,0,0),   P1[2],P1[3],P1[4],P1[5],     pw2[0]=PKW(P1,0), pw2[1]=PKW(P1,2), pw2); \
    VRD(6); SBAR(); GAPA(C1=__builtin_amdgcn_mfma_f32_32x32x16_bf16(kf[5],qr[2],C1,0,0,0),   P1[6],P1[7],P1[8],P1[9],     pw2[2]=PKW(P1,4), pw2[3]=PKW(P1,6), pw2); \
    VRD(3); SBAR(); GAPA(C0=__builtin_amdgcn_mfma_f32_32x32x16_bf16(kf[6],qr[3],C0,0,0,0),   P1[10],P1[11],P1[12],P1[13], pw3[0]=PKW(P1,8), pw3[1]=PKW(P1,10), pw3); \
    VRD(7); SBAR(); GAPA(C1=__builtin_amdgcn_mfma_f32_32x32x16_bf16(kf[7],qr[3],C1,0,0,0),   P1[14],P1[15],0.f,0.f,       pw3[2]=PKW(P1,12),pw3[3]=PKW(P1,14), pw3); \
    l_reg+=sacc; \
    if(GK){DMA_K((t)+3,sl_cur);} if(GV){DMA_V((t)+1,sl_next);} \
    CMASK(C0,C1,t); \
    _Pragma("unroll") for(int r=0;r<16;++r){C0[r]-=mhat;C1[r]-=mhat;} \
    { float a=MX3(C0[0],C0[1],C1[0]),b=MX3(C0[2],C0[3],C1[1]); a=MX3(a,C1[2],C1[3]); \
      _Pragma("unroll") for(int r=4;r<16;r+=4){a=MX3(a,C0[r],C0[r+1]);b=MX3(b,C0[r+2],C0[r+3]);a=MX3(a,C1[r],C1[r+1]);b=MX3(b,C1[r+2],C1[r+3]);} \
      float rm=__builtin_fmaxf(a,b); { auto rr=__builtin_amdgcn_permlane32_swap(__float_as_uint(rm),__float_as_uint(rm),false,false); rm=__builtin_fmaxf(__uint_as_float(rr[0]),__uint_as_float(rr[1])); } \
      resc=false; \
      if(__builtin_expect(__any(rm>(float)THRL),0)){ const float dl=__builtin_fmaxf(rm,0.f); mhat+=dl; \
        _Pragma("unroll") for(int r=0;r<16;++r){C0[r]-=dl;C1[r]-=dl;} \
        const float f=__builtin_amdgcn_exp2f(-dl); l_reg*=f; if(hi==0)wsf[r32]=f; resc=true; } } \
    SBAR(); \
    GAPB(o[0]=__builtin_amdgcn_mfma_f32_32x32x16_bf16(PAF(0),VFR(0),o[0],0,0,0), C0,0); \
    GAPB(o[1]=__builtin_amdgcn_mfma_f32_32x32x16_bf16(PAF(0),VFR(4),o[1],0,0,0), C0,4); \
    KRD(GL,0); GAPB(o[0]=__builtin_amdgcn_mfma_f32_32x32x16_bf16(PAF(1),VFR(1),o[0],0,0,0), C0,8); \
    KRD(GL,1); GAPB(o[1]=__builtin_amdgcn_mfma_f32_32x32x16_bf16(PAF(1),VFR(5),o[1],0,0,0), C0,12); \
    KRD(GL,2); GAPB(o[0]=__builtin_amdgcn_mfma_f32_32x32x16_bf16(PAF(2),VFR(2),o[0],0,0,0), C1,0); \
    KRD(GL,3); GAPB(o[1]=__builtin_amdgcn_mfma_f32_32x32x16_bf16(PAF(2),VFR(6),o[1],0,0,0), C1,4); \
    GAPB(o[0]=__builtin_amdgcn_mfma_f32_32x32x16_bf16(PAF(3),VFR(3),o[0],0,0,0), C1,8); \
    GAPB(o[1]=__builtin_amdgcn_mfma_f32_32x32x16_bf16(PAF(3),VFR(7),o[1],0,0,0), C1,12); \
    }while(0)
  int t=1;
  #undef CMASK
  #define CMASK(P0,P1,t) do{}while(0)
  for(;t+5<NT;t+=2){
    STEP(pB0,pB1,pA0,pA1,t,true,true,true);     WAIT_BAR(2); RESC(); ROT();
    STEP(pA0,pA1,pB0,pB1,t+1,true,true,true);   WAIT_BAR(2); RESC(); ROT();
  }
  #undef CMASK
  #define CMASK(P0,P1,t) do{ if(CAUSAL){int jb_=(t)-(NT-4); if(jb_>=0)cmask(P0,P1,jb_,qrel,hi);} }while(0)
  #define ENDW(tt) do{ if((tt)+3<NT){WAIT_BAR(2);} else if((tt)+2<NT){WAIT_BAR(1);} else {WAIT_BAR(0);} }while(0)
  for(;t+1<NT;t+=2){
    STEP(pB0,pB1,pA0,pA1,t,(t+3<NT),(t+1<NT),(t+1<NT));       ENDW(t);   RESC(); ROT();
    STEP(pA0,pA1,pB0,pB1,t+1,(t+4<NT),(t+2<NT),(t+2<NT));     ENDW(t+1); RESC(); ROT();
  }
  STEP(pB0,pB1,pA0,pA1,NT-1,false,false,false); RESC();
  { float sacc=pB0[0]+pB0[1]; _Pragma("unroll") for(int r=2;r<16;++r)sacc+=pB0[r]; _Pragma("unroll") for(int r=0;r<16;++r)sacc+=pB1[r]; l_reg+=sacc;
    pw0=(u32x4){PKW(pB0,0),PKW(pB0,2),PKW(pB0,4),PKW(pB0,6)};pw1=(u32x4){PKW(pB0,8),PKW(pB0,10),PKW(pB0,12),PKW(pB0,14)};pw2=(u32x4){PKW(pB1,0),PKW(pB1,2),PKW(pB1,4),PKW(pB1,6)};pw3=(u32x4){PKW(pB1,8),PKW(pB1,10),PKW(pB1,12),PKW(pB1,14)};
    SBAR(); pv(o,vb0+sl_cur,PAF(0),PAF(1),PAF(2),PAF(3)); }
  #undef PKW
  #undef PAF
  #undef VFR
  #undef PIN
  #undef MX3
  #undef GAPA
  #undef GAPB
  #undef EX
  #undef VRD
  #undef KRD
  #undef STEP
  #undef ENDW
  {auto rr=__builtin_amdgcn_permlane32_swap(__float_as_uint(l_reg),__float_as_uint(l_reg),false,false);l_reg=__uint_as_float(rr[0])+__uint_as_float(rr[1]);}
  if(hi==0)wsf[32+r32]=l_reg;asm volatile("s_waitcnt lgkmcnt(0)":::"memory");
  float rli[16];
  #pragma unroll
  for(int r=0;r<16;++r)rli[r]=__builtin_amdgcn_rcpf(wsf[32+crow(r,hi)]);
  bf16*Ow=Ou+(long)(wid*QBLK)*pO;
  { bf16*stg=(bf16*)(shm+LDS_OST)+wid*2048;
    #pragma unroll
    for(int r=0;r<16;++r){const int orow=crow(r,hi);
      #pragma unroll
      for(int d0=0;d0<2;++d0)stg[orow*64+d0*32+r32]=__float2bfloat16(o[d0][r]*rli[r]);}
    asm volatile("s_waitcnt lgkmcnt(0)":::"memory");
    #pragma unroll
    for(int i=0;i<4;++i){const int row=i*8+(lane>>3),ch=lane&7; const u32x4 v=*(const u32x4*)(stg+row*64+ch*8); ATTN_STORE16(Ow+(long)row*pO+ch*8,v);} }
  asm volatile("s_waitcnt lgkmcnt(0)\n\ts_barrier":::"memory");
  #undef DMA_K
  #undef DMA_V
  #undef CMASK
  #undef START
  #undef RESC
  #undef ROT
}
__device__ __forceinline__ void mem_attn(const int wv,const bf16*Q0,const int pQ,const bf16*__restrict__ Kh,const bf16*__restrict__ Vh,const int pKV,bf16*O0,const int pO,const int nqb,char*shm){
  int tid_=tid_of(wv); asm volatile("":"+v"(tid_));
  const int tid=tid_,lane=tid&63,r32=lane&31,hi=lane>>5; const int wid=__builtin_amdgcn_readfirstlane(tid>>6);
  constexpr int MK=0,MV=32768,MWS=65536,MOST=65536+2048;
  const unsigned lds0=(unsigned)(uintptr_t)shm;
  const bf16*ksrc=Kh+(long)lane*pKV+wid*8;
  const bf16*vsrc=Vh+(long)(16*(wid&3)+(lane>>2))*pKV+(wid>>2)*32+(lane&3)*8;
  #pragma unroll
  for(int t=0;t<4;++t){ glds16(ksrc+(long)t*KVBLK*pKV,(unsigned)__builtin_amdgcn_readfirstlane(lds0+MK+t*8192+wid*1024)); glds16(vsrc+(long)t*KVBLK*pKV,(unsigned)__builtin_amdgcn_readfirstlane(lds0+MV+t*8192+wid*1024)); }
  WAIT_BAR(0);
  const int vb0=(int)(lds0+MV)+((lane>>4)&1)*32+(lane&3)*8+(4*hi+((lane&15)>>2))*64;
  float*wsf=(float*)(shm+MWS)+wid*64;
  const f32x16 zero=f32x16{};
  for(int qb=0;qb<nqb;++qb){
    const bf16*Qw=Q0+(long)(qb*QB+wid*QBLK)*pQ;
    bf16x8 qr[4];
    #pragma unroll
    for(int d0=0;d0<4;++d0)qr[d0]=*reinterpret_cast<const bf16x8*>(&Qw[(long)r32*pQ+d0*16+hi*8]);
    f32x16 p[4][2];
    #pragma unroll
    for(int t=0;t<4;++t)qkt(p[t][0],p[t][1],shm+MK+t*8192,qr,zero,r32,hi);
    float m=p[0][0][0];
    #pragma unroll
    for(int t=0;t<4;++t)
      #pragma unroll
      for(int j=0;j<2;++j)
        #pragma unroll
        for(int r=0;r<16;++r)m=__builtin_fmaxf(m,p[t][j][r]);
    { auto rr=__builtin_amdgcn_permlane32_swap(__float_as_uint(m),__float_as_uint(m),false,false); m=__builtin_fmaxf(__uint_as_float(rr[0]),__uint_as_float(rr[1])); }
    float l=0.f;
    #pragma unroll
    for(int t=0;t<4;++t)
      #pragma unroll
      for(int j=0;j<2;++j)
        #pragma unroll
        for(int r=0;r<16;++r){ const float e=__builtin_amdgcn_exp2f(p[t][j][r]-m); p[t][j][r]=e; l+=e; }
    { auto rr=__builtin_amdgcn_permlane32_swap(__float_as_uint(l),__float_as_uint(l),false,false); l=__uint_as_float(rr[0])+__uint_as_float(rr[1]); }
    f32x16 o[2]; o[0]=f32x16{}; o[1]=f32x16{};
    #pragma unroll
    for(int t=0;t<4;++t){
      const u32x4 w0={cvtpk_s(p[t][0][0],p[t][0][1]),cvtpk_s(p[t][0][2],p[t][0][3]),cvtpk_s(p[t][0][4],p[t][0][5]),cvtpk_s(p[t][0][6],p[t][0][7])};
      const u32x4 w1={cvtpk_s(p[t][0][8],p[t][0][9]),cvtpk_s(p[t][0][10],p[t][0][11]),cvtpk_s(p[t][0][12],p[t][0][13]),cvtpk_s(p[t][0][14],p[t][0][15])};
      const u32x4 w2={cvtpk_s(p[t][1][0],p[t][1][1]),cvtpk_s(p[t][1][2],p[t][1][3]),cvtpk_s(p[t][1][4],p[t][1][5]),cvtpk_s(p[t][1][6],p[t][1][7])};
      const u32x4 w3={cvtpk_s(p[t][1][8],p[t][1][9]),cvtpk_s(p[t][1][10],p[t][1][11]),cvtpk_s(p[t][1][12],p[t][1][13]),cvtpk_s(p[t][1][14],p[t][1][15])};
      pv(o,vb0+t*8192,__builtin_bit_cast(bf16x8,w0),__builtin_bit_cast(bf16x8,w1),__builtin_bit_cast(bf16x8,w2),__builtin_bit_cast(bf16x8,w3)); }
    if(hi==0)wsf[32+r32]=l; asm volatile("s_waitcnt lgkmcnt(0)":::"memory");
    float rli[16];
    #pragma unroll
    for(int r=0;r<16;++r)rli[r]=__builtin_amdgcn_rcpf(wsf[32+crow(r,hi)]);
    bf16*Ow=O0+(long)(qb*QB+wid*QBLK)*pO;
    { bf16*stg=(bf16*)(shm+MOST)+wid*2048;
      #pragma unroll
      for(int r=0;r<16;++r){const int orow=crow(r,hi);
        #pragma unroll
        for(int d0=0;d0<2;++d0)stg[orow*64+d0*32+r32]=__float2bfloat16(o[d0][r]*rli[r]);}
      asm volatile("s_waitcnt lgkmcnt(0)":::"memory");
      #pragma unroll
      for(int i=0;i<4;++i){const int row=i*8+(lane>>3),ch=lane&7; const u32x4 v=*(const u32x4*)(stg+row*64+ch*8); ATTN_STORE16(Ow+(long)row*pO+ch*8,v);}
      asm volatile("s_waitcnt lgkmcnt(0)":::"memory"); }
  }
  asm volatile("s_waitcnt lgkmcnt(0)\n\ts_barrier":::"memory");
}
constexpr int ATTN_LDS_BYTES=LDS_BYTES;
#undef SBAR
#undef WAIT_BAR
}
namespace attn2 {
using bf16=__hip_bfloat16;
using bf16x8=__attribute__((ext_vector_type(8)))short;
using s16x4=__attribute__((ext_vector_type(4)))short;
using f32x16=__attribute__((ext_vector_type(16)))float;
using u32x4=__attribute__((ext_vector_type(4)))unsigned;
constexpr int D=64;
constexpr int NW=8,QBLK=32,QB=QBLK*NW,KVBLK=64;
constexpr int ATTN_UNIT_ROWS=QB;
__device__ __forceinline__ int crow(int r,int hi){return (r&3)+8*(r>>2)+4*hi;}
#define SBAR() __builtin_amdgcn_sched_barrier(0)
__device__ __forceinline__ void cmask(f32x16&p0,f32x16&p1,int jb,int qrel,int hi){
  const float NEG=-INFINITY; int kb=64*jb+4*hi;
  #pragma unroll
  for(int r=0;r<16;++r){int kv=kb+(r&3)+8*(r>>2); if(kv>qrel)p0[r]=NEG; if(kv+32>qrel)p1[r]=NEG;}
}

constexpr int NSLOT=3, SLOTB=8192;
constexpr int LDS_K=0, LDS_V=NSLOT*SLOTB, LDS_WS=3*NSLOT*SLOTB, LDS_OST=LDS_WS+NW*64*4, LDS_BYTES=LDS_OST+NW*4096;
constexpr float C2=0.125f*1.4426950408889634f;
__device__ __forceinline__ void glds16(const void*gsrc,unsigned lds_dst){unsigned keep;
  asm volatile("s_mov_b32 %0, m0\n\ts_mov_b32 m0, %2\n\ts_nop 0\n\tglobal_load_lds_dwordx4 %1, off\n\ts_mov_b32 m0, %0":"=&s"(keep):"v"(gsrc),"s"(lds_dst):"memory");}
__device__ __forceinline__ float max3f(float a,float b,float c){float r;asm("v_max3_f32 %0, %1, %2, %3":"=v"(r):"v"(a),"v"(b),"v"(c));return r;}
__device__ __forceinline__ float max2f(float a,float b){float r;asm("v_max_f32_e32 %0, %1, %2":"=v"(r):"v"(a),"v"(b));return r;}
__device__ __forceinline__ float fadd_s(float a,float b){float r;asm("v_add_f32_e32 %0, %1, %2":"=v"(r):"v"(a),"v"(b));return r;}
__device__ __forceinline__ float fsub_s(float a,float b){float r;asm("v_sub_f32_e32 %0, %1, %2":"=v"(r):"v"(a),"v"(b));return r;}
typedef float f32x2_t __attribute__((ext_vector_type(2))); typedef __bf16 bf16x2_t __attribute__((ext_vector_type(2)));
__device__ __forceinline__ unsigned cvtpk_s(float lo,float hi){f32x2_t v={lo,hi};bf16x2_t b=__builtin_convertvector(v,bf16x2_t);return __builtin_bit_cast(unsigned,b);}
#define WAIT_BAR(N) asm volatile("s_waitcnt vmcnt(" #N ") lgkmcnt(0)\n\ts_barrier":::"memory")

__device__ __forceinline__ void qkt(f32x16&p0,f32x16&p1,const char*Kslot,const bf16x8*qr,const f32x16&negm,int r32,int hi){
  const char*kb=Kslot+hi*1024+r32*16;
  #pragma unroll
  for(int d0=0;d0<4;++d0){
    const bf16x8 b0=*reinterpret_cast<const bf16x8*>(kb+d0*2048);
    const bf16x8 b1=*reinterpret_cast<const bf16x8*>(kb+d0*2048+512);
    if(d0==0){p0=__builtin_amdgcn_mfma_f32_32x32x16_bf16(b0,qr[0],negm,0,0,0);p1=__builtin_amdgcn_mfma_f32_32x32x16_bf16(b1,qr[0],negm,0,0,0);}
    else{p0=__builtin_amdgcn_mfma_f32_32x32x16_bf16(b0,qr[d0],p0,0,0,0);p1=__builtin_amdgcn_mfma_f32_32x32x16_bf16(b1,qr[d0],p1,0,0,0);}}
}
typedef __attribute__((address_space(3))) const char* lds_cptr;
typedef short v4i16_t __attribute__((ext_vector_type(4)));
__device__ __forceinline__ void kload8(bf16x8*kf,lds_cptr kp){
  kf[0]=*(const __attribute__((address_space(3))) bf16x8*)(kp);      kf[1]=*(const __attribute__((address_space(3))) bf16x8*)(kp+512);
  kf[2]=*(const __attribute__((address_space(3))) bf16x8*)(kp+2048); kf[3]=*(const __attribute__((address_space(3))) bf16x8*)(kp+2560);
  kf[4]=*(const __attribute__((address_space(3))) bf16x8*)(kp+4096); kf[5]=*(const __attribute__((address_space(3))) bf16x8*)(kp+4608);
  kf[6]=*(const __attribute__((address_space(3))) bf16x8*)(kp+6144); kf[7]=*(const __attribute__((address_space(3))) bf16x8*)(kp+6656);
}
__device__ __forceinline__ void kload2(bf16x8*kf,lds_cptr kp,int j){ kf[2*j]=*(const __attribute__((address_space(3))) bf16x8*)(kp+j*2048); kf[2*j+1]=*(const __attribute__((address_space(3))) bf16x8*)(kp+j*2048+512); }
__device__ __forceinline__ s16x4 vtr(lds_cptr p){ return __builtin_bit_cast(s16x4,__builtin_amdgcn_ds_read_tr16_b64_v4i16((__attribute__((address_space(3))) v4i16_t*)p)); }
__device__ __forceinline__ float rowmax(const f32x16&p0,const f32x16&p1){
  float a=max3f(p0[0],p0[1],p1[0]),b=max3f(p0[2],p0[3],p1[1]);a=max3f(a,p1[2],p1[3]);
  #pragma unroll
  for(int r=4;r<16;r+=4){a=max3f(a,p0[r],p0[r+1]);b=max3f(b,p0[r+2],p0[r+3]);a=max3f(a,p1[r],p1[r+1]);b=max3f(b,p1[r+2],p1[r+3]);}
  const float m=max2f(a,b);
  auto rr=__builtin_amdgcn_permlane32_swap(__float_as_uint(m),__float_as_uint(m),false,false);
  return max2f(__uint_as_float(rr[0]),__uint_as_float(rr[1]));
}
__device__ __forceinline__ void pv(f32x16*o,int vb,bf16x8 pa0,bf16x8 pa1,bf16x8 pa2,bf16x8 pa3){
  #pragma unroll
  for(int d0=0;d0<4;++d0){s16x4 lo[4],hi[4];
    #pragma unroll
    for(int ks=0;ks<4;++ks){
      asm volatile("ds_read_b64_tr_b16 %0,%1 offset:%c2":"=&v"(lo[ks]):"v"(vb),"i"(d0*4096+ks*1024):"memory");
      asm volatile("ds_read_b64_tr_b16 %0,%1 offset:%c2":"=&v"(hi[ks]):"v"(vb),"i"(d0*4096+ks*1024+512):"memory");}
    asm volatile("s_waitcnt lgkmcnt(0)":::"memory");SBAR();
    #define PK(k) (bf16x8){lo[k][0],lo[k][1],lo[k][2],lo[k][3],hi[k][0],hi[k][1],hi[k][2],hi[k][3]}
    o[d0]=__builtin_amdgcn_mfma_f32_32x32x16_bf16(pa0,PK(0),o[d0],0,0,0);
    o[d0]=__builtin_amdgcn_mfma_f32_32x32x16_bf16(pa1,PK(1),o[d0],0,0,0);
    o[d0]=__builtin_amdgcn_mfma_f32_32x32x16_bf16(pa2,PK(2),o[d0],0,0,0);
    o[d0]=__builtin_amdgcn_mfma_f32_32x32x16_bf16(pa3,PK(3),o[d0],0,0,0);
    #undef PK
  }
}

#ifndef ATTN_STORE16
#define ATTN_STORE16(p,v) (*(u32x4*)(p)=(v))
#endif
template<int THRL,bool CAUSAL,bool COMBINE=false> __device__ __forceinline__ void attn_unit(const bf16*Qu,const int pQ,const bf16*__restrict__ Kh,const bf16*__restrict__ Vh,const int pKV,const int wv,bf16*Ou,const int pO,const int NT,char*shm,const bf16*S0=nullptr,const int pS=0,const float lam=0.f,const float*sgp=nullptr){
  int tid_=tid_of(wv); asm volatile("":"+v"(tid_));
  const int tid=tid_,lane=tid&63,r32=lane&31,hi=lane>>5; const int wid=__builtin_amdgcn_readfirstlane(tid>>6);
  const bf16*Qw=Qu+(long)(wid*QBLK)*pQ;
  const unsigned lds0=(unsigned)(uintptr_t)shm;
  float*wsf=(float*)(shm+LDS_WS)+wid*64;
  const bf16*ksrc=Kh+(long)lane*pKV+wid*8;
  const bf16*vsrc=Vh+(long)(16*(wid&3)+(lane>>2))*pKV+(wid>>2)*32+(lane&3)*8;
  const unsigned kdst=lds0+LDS_K+wid*1024, vdst=lds0+LDS_V+wid*1024;
  #define DMA_K(t,slot) glds16(ksrc+(long)(t)*KVBLK*pKV,(unsigned)__builtin_amdgcn_readfirstlane(kdst+(slot)))
  #define DMA_V(t,slot) do{ glds16(vsrc+(long)(t)*KVBLK*pKV,(unsigned)__builtin_amdgcn_readfirstlane(vdst+2*(slot))); glds16(vsrc+(long)(t)*KVBLK*pKV+64,(unsigned)__builtin_amdgcn_readfirstlane(vdst+2*(slot)+8192)); }while(0)
  const int vb0=(int)(lds0+LDS_V)+((lane>>4)&1)*32+(lane&3)*8+(4*hi+((lane&15)>>2))*64;
  const char*Kbase=shm+LDS_K; bf16x8 kf[8];
  const lds_cptr shm3=(lds_cptr)shm; const lds_cptr kp0=shm3+LDS_K+hi*1024+r32*16; const lds_cptr vp0=shm3+LDS_V+((lane>>4)&1)*32+(lane&3)*8+(4*hi+((lane&15)>>2))*64;
  DMA_K(0,0);DMA_V(0,0);DMA_K(1,SLOTB);
  bf16x8 qr[4];
  #pragma unroll
  for(int d0=0;d0<4;++d0)qr[d0]=*reinterpret_cast<const bf16x8*>(&Qw[(long)r32*pQ+d0*16+hi*8]);
  float mhat=0.f,l_reg=0.f;f32x16 o[4];o[0]=f32x16{};o[1]=f32x16{};o[2]=f32x16{};o[3]=f32x16{};const f32x16 negm=f32x16{};
  const int qrel=wid*QBLK+r32;
  #define CMASK(P0,P1,t) do{ if(CAUSAL){int jb_=(t)-(NT-4); if(jb_>=0)cmask(P0,P1,jb_,qrel,hi);} }while(0)
  bool resc=false;
  #define START(P0,P1) do{ const float rm=rowmax(P0,P1); resc=false; \
    { const float dl=rm; mhat=fadd_s(mhat,dl); \
      _Pragma("unroll") for(int r=0;r<16;++r){P0[r]=fsub_s(P0[r],dl);P1[r]=fsub_s(P1[r],dl);} \
      } \
    _Pragma("unroll") for(int r=0;r<16;++r)P0[r]=__builtin_amdgcn_exp2f(P0[r]); }while(0)
  #define RESC() do{ if(resc){ asm volatile("s_waitcnt lgkmcnt(0)":::"memory"); \
      _Pragma("unroll") for(int d_=0;d_<4;++d_) _Pragma("unroll") for(int r=0;r<16;++r)o[d_][r]*=wsf[crow(r,hi)]; } }while(0)
  f32x16 pA0,pA1,pB0,pB1;
  int sl_prev=0,sl_cur=0,sl_next=SLOTB;
  #define ROT() do{sl_prev=sl_cur;sl_cur=sl_next;sl_next=(sl_next==(NSLOT-1)*SLOTB)?0:sl_next+SLOTB;}while(0)
  DMA_K(2,2*SLOTB);
  WAIT_BAR(4);
  qkt(pA0,pA1,Kbase,qr,negm,r32,hi);asm volatile("s_nop 15\n\ts_nop 7":"+v"(pA0),"+v"(pA1));CMASK(pA0,pA1,0);
  START(pA0,pA1);
  _Pragma("unroll") for(int r=0;r<16;++r)pA1[r]=__builtin_amdgcn_exp2f(pA1[r]);
  WAIT_BAR(0);
  DMA_K(3,0);DMA_V(1,SLOTB);
  ROT();
  kload8(kf,kp0+sl_cur);
  WAIT_BAR(3);
  s16x4 vlo[8],vhi[8]; u32x4 pw0,pw1,pw2,pw3;
  #define PKW(P,B) cvtpk_s(P[B],P[B+1])
  #define PAF(k) __builtin_bit_cast(bf16x8,pw##k)
  #define VFR(i) (bf16x8){vlo[i][0],vlo[i][1],vlo[i][2],vlo[i][3],vhi[i][0],vhi[i][1],vhi[i][2],vhi[i][3]}
  #define PIN(x) asm volatile("":"+v"(x))
  #define MX3(a,b,c) __builtin_fmaxf(__builtin_fmaxf((a),(b)),(c))
  #define GAPA(MF,A0,A1,A2,A3,W0,W1,PW) do{ MF; sacc+=A0; sacc+=A1; sacc+=A2; sacc+=A3; PIN(sacc); W0; W1; PIN(PW); SBAR(); }while(0)
  #define EX(v) __builtin_amdgcn_exp2f(v)
  #define GAPB(MF,X,B) do{ MF; X[B]=EX(X[B]); X[B+1]=EX(X[B+1]); X[B+2]=EX(X[B+2]); X[B+3]=EX(X[B+3]); PIN(X); SBAR(); }while(0)
  #define VRD(i) do{ vlo[i]=vtr(vp_+(((i)>>2)*4096+((i)&3)*1024)); vhi[i]=vtr(vp_+(((i)>>2)*4096+((i)&3)*1024+512)); }while(0)
  #define VRD2(i) do{ vlo[i]=vtr(vp_+((((i)>>2)+2)*4096+((i)&3)*1024)); vhi[i]=vtr(vp_+((((i)>>2)+2)*4096+((i)&3)*1024+512)); }while(0)
  #define GAPB2(MF,X,B) do{ MF; X[B]=EX(X[B]); X[B+1]=EX(X[B+1]); PIN(X); SBAR(); }while(0)
  #define KRD(G,j) do{ if(G){ kload2(kf,kp0+sl_next,j); SBAR(); } }while(0)
  #define STEP(C0,C1,P0,P1,t,GK,GV,GL) do{ SBAR(); \
    const lds_cptr vp_=vp0+2*sl_prev; \
    VRD(0); SBAR(); float sacc=(P0[0]+P0[1]); \
    GAPA(C0=__builtin_amdgcn_mfma_f32_32x32x16_bf16(kf[0],qr[0],negm,0,0,0), P0[2],P0[3],P0[4],P0[5],     pw0[0]=PKW(P0,0), pw0[1]=PKW(P0,2), pw0); \
    VRD(4); SBAR(); GAPA(C1=__builtin_amdgcn_mfma_f32_32x32x16_bf16(kf[1],qr[0],negm,0,0,0), P0[6],P0[7],P0[8],P0[9],     pw0[2]=PKW(P0,4), pw0[3]=PKW(P0,6), pw0); \
    VRD(1); SBAR(); GAPA(C0=__builtin_amdgcn_mfma_f32_32x32x16_bf16(kf[2],qr[1],C0,0,0,0),   P0[10],P0[11],P0[12],P0[13], pw1[0]=PKW(P0,8), pw1[1]=PKW(P0,10), pw1); \
    VRD(5); SBAR(); GAPA(C1=__builtin_amdgcn_mfma_f32_32x32x16_bf16(kf[3],qr[1],C1,0,0,0),   P0[14],P0[15],P1[0],P1[1],   pw1[2]=PKW(P0,12),pw1[3]=PKW(P0,14), pw1); \
    VRD(2); SBAR(); GAPA(C0=__builtin_amdgcn_mfma_f32_32x32x16_bf16(kf[4],qr[2],C0,0,0,0),   P1[2],P1[3],P1[4],P1[5],     pw2[0]=PKW(P1,0), pw2[1]=PKW(P1,2), pw2); \
    VRD(6); SBAR(); GAPA(C1=__builtin_amdgcn_mfma_f32_32x32x16_bf16(kf[5],qr[2],C1,0,0,0),   P1[6],P1[7],P1[8],P1[9],     pw2[2]=PKW(P1,4), pw2[3]=PKW(P1,6), pw2); \
    VRD(3); SBAR(); GAPA(C0=__builtin_amdgcn_mfma_f32_32x32x16_bf16(kf[6],qr[3],C0,0,0,0),   P1[10],P1[11],P1[12],P1[13], pw3[0]=PKW(P1,8), pw3[1]=PKW(P1,10), pw3); \
    VRD(7); SBAR(); GAPA(C1=__builtin_amdgcn_mfma_f32_32x32x16_bf16(kf[7],qr[3],C1,0,0,0),   P1[14],P1[15],0.f,0.f,       pw3[2]=PKW(P1,12),pw3[3]=PKW(P1,14), pw3); \
    l_reg+=sacc; \
    if(GK){DMA_K((t)+3,sl_cur);} if(GV){DMA_V((t)+1,sl_next);} \
    CMASK(C0,C1,t); \
    _Pragma("unroll") for(int r=0;r<16;++r){C0[r]-=mhat;C1[r]-=mhat;} \
    { float a=MX3(C0[0],C0[1],C1[0]),b=MX3(C0[2],C0[3],C1[1]); a=MX3(a,C1[2],C1[3]); \
      _Pragma("unroll") for(int r=4;r<16;r+=4){a=MX3(a,C0[r],C0[r+1]);b=MX3(b,C0[r+2],C0[r+3]);a=MX3(a,C1[r],C1[r+1]);b=MX3(b,C1[r+2],C1[r+3]);} \
      float rm=__builtin_fmaxf(a,b); { auto rr=__builtin_amdgcn_permlane32_swap(__float_as_uint(rm),__float_as_uint(rm),false,false); rm=__builtin_fmaxf(__uint_as_float(rr[0]),__uint_as_float(rr[1])); } \
      resc=false; \
      if(__builtin_expect(__any(rm>(float)THRL),0)){ const float dl=__builtin_fmaxf(rm,0.f); mhat+=dl; \
        _Pragma("unroll") for(int r=0;r<16;++r){C0[r]-=dl;C1[r]-=dl;} \
        const float f=__builtin_amdgcn_exp2f(-dl); l_reg*=f; if(hi==0)wsf[r32]=f; resc=true; } } \
    SBAR(); \
    GAPB2(o[0]=__builtin_amdgcn_mfma_f32_32x32x16_bf16(PAF(0),VFR(0),o[0],0,0,0), C0,0); VRD2(0); SBAR(); \
    GAPB2(o[1]=__builtin_amdgcn_mfma_f32_32x32x16_bf16(PAF(0),VFR(4),o[1],0,0,0), C0,2); VRD2(4); SBAR(); \
    KRD(GL,0); GAPB2(o[0]=__builtin_amdgcn_mfma_f32_32x32x16_bf16(PAF(1),VFR(1),o[0],0,0,0), C0,4); VRD2(1); SBAR(); \
    KRD(GL,1); GAPB2(o[1]=__builtin_amdgcn_mfma_f32_32x32x16_bf16(PAF(1),VFR(5),o[1],0,0,0), C0,6); VRD2(5); SBAR(); \
    KRD(GL,2); GAPB2(o[0]=__builtin_amdgcn_mfma_f32_32x32x16_bf16(PAF(2),VFR(2),o[0],0,0,0), C0,8); VRD2(2); SBAR(); \
    KRD(GL,3); GAPB2(o[1]=__builtin_amdgcn_mfma_f32_32x32x16_bf16(PAF(2),VFR(6),o[1],0,0,0), C0,10); VRD2(6); SBAR(); \
    GAPB2(o[0]=__builtin_amdgcn_mfma_f32_32x32x16_bf16(PAF(3),VFR(3),o[0],0,0,0), C0,12); VRD2(3); SBAR(); \
    GAPB2(o[1]=__builtin_amdgcn_mfma_f32_32x32x16_bf16(PAF(3),VFR(7),o[1],0,0,0), C0,14); VRD2(7); SBAR(); \
    GAPB2(o[2]=__builtin_amdgcn_mfma_f32_32x32x16_bf16(PAF(0),VFR(0),o[2],0,0,0), C1,0); \
    GAPB2(o[3]=__builtin_amdgcn_mfma_f32_32x32x16_bf16(PAF(0),VFR(4),o[3],0,0,0), C1,2); \
    GAPB2(o[2]=__builtin_amdgcn_mfma_f32_32x32x16_bf16(PAF(1),VFR(1),o[2],0,0,0), C1,4); \
    GAPB2(o[3]=__builtin_amdgcn_mfma_f32_32x32x16_bf16(PAF(1),VFR(5),o[3],0,0,0), C1,6); \
    GAPB2(o[2]=__builtin_amdgcn_mfma_f32_32x32x16_bf16(PAF(2),VFR(2),o[2],0,0,0), C1,8); \
    GAPB2(o[3]=__builtin_amdgcn_mfma_f32_32x32x16_bf16(PAF(2),VFR(6),o[3],0,0,0), C1,10); \
    GAPB2(o[2]=__builtin_amdgcn_mfma_f32_32x32x16_bf16(PAF(3),VFR(3),o[2],0,0,0), C1,12); \
    GAPB2(o[3]=__builtin_amdgcn_mfma_f32_32x32x16_bf16(PAF(3),VFR(7),o[3],0,0,0), C1,14); \
    }while(0)
  int t=1;
  #undef CMASK
  #define CMASK(P0,P1,t) do{}while(0)
  for(;t+5<NT;t+=2){
    STEP(pB0,pB1,pA0,pA1,t,true,true,true);     WAIT_BAR(3); RESC(); ROT();
    STEP(pA0,pA1,pB0,pB1,t+1,true,true,true);   WAIT_BAR(3); RESC(); ROT();
  }
  #undef CMASK
  #define CMASK(P0,P1,t) do{ if(CAUSAL){int jb_=(t)-(NT-4); if(jb_>=0)cmask(P0,P1,jb_,qrel,hi);} }while(0)
  #define ENDW(tt) do{ if((tt)+3<NT){WAIT_BAR(3);} else if((tt)+2<NT){WAIT_BAR(2);} else {WAIT_BAR(0);} }while(0)
  for(;t+1<NT;t+=2){
    STEP(pB0,pB1,pA0,pA1,t,(t+3<NT),(t+1<NT),(t+1<NT));       ENDW(t);   RESC(); ROT();
    STEP(pA0,pA1,pB0,pB1,t+1,(t+4<NT),(t+2<NT),(t+2<NT));     ENDW(t+1); RESC(); ROT();
  }
  STEP(pB0,pB1,pA0,pA1,NT-1,false,false,false); RESC();
  { float sacc=pB0[0]+pB0[1]; _Pragma("unroll") for(int r=2;r<16;++r)sacc+=pB0[r]; _Pragma("unroll") for(int r=0;r<16;++r)sacc+=pB1[r]; l_reg+=sacc;
    pw0=(u32x4){PKW(pB0,0),PKW(pB0,2),PKW(pB0,4),PKW(pB0,6)};pw1=(u32x4){PKW(pB0,8),PKW(pB0,10),PKW(pB0,12),PKW(pB0,14)};pw2=(u32x4){PKW(pB1,0),PKW(pB1,2),PKW(pB1,4),PKW(pB1,6)};pw3=(u32x4){PKW(pB1,8),PKW(pB1,10),PKW(pB1,12),PKW(pB1,14)};
    SBAR(); pv(o,vb0+2*sl_cur,PAF(0),PAF(1),PAF(2),PAF(3)); }
  #undef PKW
  #undef PAF
  #undef VFR
  #undef PIN
  #undef MX3
  #undef GAPA
  #undef GAPB
  #undef EX
  #undef VRD
  #undef VRD2
  #undef GAPB2
  #undef KRD
  #undef STEP
  #undef ENDW
  {auto rr=__builtin_amdgcn_permlane32_swap(__float_as_uint(l_reg),__float_as_uint(l_reg),false,false);l_reg=__uint_as_float(rr[0])+__uint_as_float(rr[1]);}
  if(hi==0)wsf[32+r32]=l_reg;asm volatile("s_waitcnt lgkmcnt(0)":::"memory");
  float rli[16];
  #pragma unroll
  for(int r=0;r<16;++r)rli[r]=__builtin_amdgcn_rcpf(wsf[32+crow(r,hi)]);
  bf16*Ow=Ou+(long)(wid*QBLK)*pO;
  { bf16*stg=(bf16*)(shm+LDS_OST)+wid*2048;
    const bf16*Sw=S0+(long)(wid*QBLK)*pS;
    float xs[2][4][8];
    #pragma unroll
    for(int hf=0;hf<2;++hf){
      #pragma unroll
      for(int r=0;r<16;++r){const int orow=crow(r,hi);
        #pragma unroll
        for(int d0=0;d0<2;++d0)stg[orow*64+d0*32+r32]=__float2bfloat16(o[2*hf+d0][r]*rli[r]);}
      asm volatile("s_waitcnt lgkmcnt(0)":::"memory");
      #pragma unroll
      for(int i=0;i<4;++i){const int row=i*8+(lane>>3),ch=lane&7; const u32x4 v=*(const u32x4*)(stg+row*64+ch*8);
        if constexpr(!COMBINE){ ATTN_STORE16(Ow+(long)row*pO+hf*64+ch*8,v); }
        else { const u32x4 a=*(const u32x4*)(Sw+(long)row*pS+hf*64+ch*8);
          #define BL(w) __uint_as_float((w)<<16)
          #define BH(w) __uint_as_float((w)&0xffff0000u)
          xs[hf][i][0]=BL(a.x)-lam*BL(v.x); xs[hf][i][1]=BH(a.x)-lam*BH(v.x); xs[hf][i][2]=BL(a.y)-lam*BL(v.y); xs[hf][i][3]=BH(a.y)-lam*BH(v.y);
          xs[hf][i][4]=BL(a.z)-lam*BL(v.z); xs[hf][i][5]=BH(a.z)-lam*BH(v.z); xs[hf][i][6]=BL(a.w)-lam*BL(v.w); xs[hf][i][7]=BH(a.w)-lam*BH(v.w);
          #undef BL
          #undef BH
        } }
      asm volatile("s_waitcnt lgkmcnt(0)":::"memory"); }
    if constexpr(COMBINE){
      float sg[16];
      #pragma unroll
      for(int q=0;q<16;++q)sg[q]=sgp[(q>>3)*64+(lane&7)*8+(q&7)]*0.8f;
      #pragma unroll
      for(int i=0;i<4;++i){ const int row=i*8+(lane>>3),ch=lane&7; float ss=0.f;
        #pragma unroll
        for(int hf=0;hf<2;++hf)
          #pragma unroll
          for(int q=0;q<8;++q)ss+=xs[hf][i][q]*xs[hf][i][q];
        ss+=__shfl_xor(ss,1);ss+=__shfl_xor(ss,2);ss+=__shfl_xor(ss,4);
        const float rn=1.f/sqrtf(ss*(1.f/128.f)+1e-6f);
        #pragma unroll
        for(int hf=0;hf<2;++hf){ u32x4 w;
          w.x=cvtpk_s(xs[hf][i][0]*rn*sg[hf*8+0],xs[hf][i][1]*rn*sg[hf*8+1]); w.y=cvtpk_s(xs[hf][i][2]*rn*sg[hf*8+2],xs[hf][i][3]*rn*sg[hf*8+3]);
          w.z=cvtpk_s(xs[hf][i][4]*rn*sg[hf*8+4],xs[hf][i][5]*rn*sg[hf*8+5]); w.w=cvtpk_s(xs[hf][i][6]*rn*sg[hf*8+6],xs[hf][i][7]*rn*sg[hf*8+7]);
          ATTN_STORE16(Ow+(long)row*pO+hf*64+ch*8,w); } } } }
  asm volatile("s_waitcnt lgkmcnt(0)\n\ts_barrier":::"memory");
  #undef DMA_K
  #undef DMA_V
  #undef CMASK
  #undef START
  #undef RESC
  #undef ROT
}
constexpr int ATTN_LDS_BYTES=LDS_BYTES;
#undef SBAR
#undef WAIT_BAR
}

constexpr int NWAVES = 8;
#ifndef MK_N_LAUNCHES
#define MK_N_LAUNCHES 1
#endif
constexpr int NPH = 10;
constexpr int BATCH = 32, SEQ = 2048, D = 1024, T = BATCH * SEQ, NMEM = 256, TM = BATCH * NMEM;
constexpr int INCOLS = 5120, PROJW = 2048, GATEW = 3072;
constexpr float RMS_EPS = 1e-6f;
constexpr int NEXP = 16, EH = 512;
constexpr int MAXROWS = 2 * T + NEXP * 256;
constexpr size_t MiB = 1u << 20;
constexpr size_t WS_CTL = 0, CTL_ZERO_BYTES = 64 * 1024;
constexpr size_t WS_WRF = 1 * MiB;
constexpr size_t WS_RINV = 1 * MiB + 128 * 1024;
constexpr size_t WS_WIN = 2 * MiB;
constexpr size_t WS_PC = 13 * MiB;
constexpr size_t WS_WO = 15 * MiB;
constexpr size_t WS_WGU = 17 * MiB;
constexpr size_t WS_WD = 49 * MiB;
constexpr size_t WS_ROUTE = 65 * MiB;
constexpr size_t WS_KV = 68 * MiB;
constexpr size_t WS_XN = 76 * MiB;
constexpr size_t WS_BR = 76 * MiB;
constexpr size_t WS_H2 = 76 * MiB;
constexpr size_t WS_PROJ = 220 * MiB;
constexpr size_t WS_MERGED = 220 * MiB;
constexpr size_t WS_MIX = 348 * MiB;
constexpr size_t WS_HID = 220 * MiB;
constexpr size_t WS_ATTO = 476 * MiB;
constexpr size_t WS_GATES = 604 * MiB;
constexpr size_t WS_LIST = 476 * MiB;
constexpr size_t WS_RWE = 480 * MiB;
constexpr size_t WS_Y = 604 * MiB;
constexpr size_t WS_END = 988 * MiB;
static_assert(WS_XN + (size_t)(T + TM) * D * 2 <= WS_PROJ && WS_PROJ + (size_t)T * PROJW * 2 <= WS_ATTO && WS_ATTO + (size_t)T * D * 2 <= WS_GATES && WS_GATES + (size_t)T * GATEW * 2 <= WS_END, "ws map");
static_assert(WS_Y + (size_t)MAXROWS * D * 2 <= WS_END && WS_HID + (size_t)MAXROWS * EH * 2 <= WS_ATTO && WS_RWE + (size_t)NEXP * 65536 * 8 <= WS_GATES, "ws map 2");
constexpr int CW_CNT = 64;
constexpr int RING_OFF = 0, RING_BYTES = 131072;
constexpr int LDSX_OFF = RING_BYTES;
constexpr int LDS_BYTES = 147456;

#define GAS __attribute__((address_space(1)))
#define LAS __attribute__((address_space(3)))
typedef unsigned short bf16;
typedef unsigned v4u __attribute__((ext_vector_type(4)));
typedef unsigned v2u __attribute__((ext_vector_type(2)));
typedef float f32x4 __attribute__((ext_vector_type(4)));
#define LDS_WAIT() asm volatile("s_waitcnt lgkmcnt(0)" ::: "memory")
__device__ __forceinline__ unsigned f2bf(float f) { unsigned u = __builtin_bit_cast(unsigned, f); return (u + 0x7fffu + ((u >> 16) & 1u)) >> 16; }
__device__ __forceinline__ unsigned pk2(float lo, float hi) { return f2bf(lo) | (f2bf(hi) << 16); }
typedef float f32x2_t __attribute__((ext_vector_type(2))); typedef __bf16 bf16x2_t __attribute__((ext_vector_type(2)));
typedef short bf16x8_t __attribute__((ext_vector_type(8))); typedef float f32x16_t __attribute__((ext_vector_type(16)));
__device__ __forceinline__ unsigned cvtpk(float lo, float hi) { f32x2_t v = {lo, hi}; bf16x2_t b = __builtin_convertvector(v, bf16x2_t); return __builtin_bit_cast(unsigned, b); }
__device__ __forceinline__ float bflo(unsigned w) { return __uint_as_float(w << 16); }
__device__ __forceinline__ float bfhi(unsigned w) { return __uint_as_float(w & 0xffff0000u); }
__device__ __forceinline__ float wave_sum(float v) {
#pragma unroll
    for (int o = 1; o < 64; o <<= 1) v += __shfl_xor(v, o);
    return v;
}

typedef GAS unsigned gu32;
#define RLX_AGENT __ATOMIC_RELAXED, __HIP_MEMORY_SCOPE_AGENT
constexpr int CW_BAR = 4096;
constexpr int CW_TS = 128;
#define XB_TMO      128
#define XB_XCNT(j)  (256  + 64 * (j))
#define XB_XSUB(j)  (1280 + 64 * (j))
#define XB_XGEN(j)  (2304 + 64 * (j))
#define XB_TOP      3328
#define XB_TOPGEN   3392
#define XCD_BAR_WORDS 3456
#define XB_SPIN_CAP (1u << 18)

__device__ __forceinline__ unsigned xb_ld(unsigned* p)              { return __hip_atomic_load(p, __ATOMIC_RELAXED, __HIP_MEMORY_SCOPE_AGENT); }
__device__ __forceinline__ unsigned xb_add(unsigned* p, unsigned v) { return __hip_atomic_fetch_add(p, v, __ATOMIC_RELAXED, __HIP_MEMORY_SCOPE_AGENT); }
__device__ __forceinline__ unsigned xb_xcc_id() { return (unsigned)__builtin_amdgcn_s_getreg((3 << 11) | 20) & 0xFu; }
#define XB_SPIN(cond, bar) do { unsigned _sp = 0; while (cond) { __builtin_amdgcn_s_sleep(1); \
    if ((++_sp & 255u) == 0u) { if (xb_ld(&(bar)[XB_TMO])) break; if (_sp > XB_SPIN_CAP) { atomicAdd(&(bar)[XB_TMO], 1u); break; } } } } while (0)

struct XcdBarrier {
    unsigned* bar; unsigned x;
    volatile LAS unsigned* st;
};

__device__ __forceinline__ XcdBarrier xcd_barrier_post(unsigned* bar, volatile LAS unsigned* st) {
    XcdBarrier b; b.bar = bar; b.x = xb_xcc_id(); b.st = st;
    if (threadIdx.x == 0) (void)xb_add(&bar[XB_XCNT(b.x)], 1u);
    return b;
}
__device__ __forceinline__ void xcd_barrier_complete(unsigned* bar, unsigned x, unsigned& nloc, unsigned& nx) {
    const unsigned G = gridDim.x * gridDim.y * gridDim.z;
    unsigned sum, cnt, mine, sp = 0u;
    for (;;) {
        sum = 0u; cnt = 0u; mine = 0u;
#pragma unroll
        for (unsigned j = 0; j < 16; ++j) { const unsigned c = xb_ld(&bar[XB_XCNT(j)]); sum += c; cnt += (c > 0u) ? 1u : 0u; mine = (j == x) ? c : mine; }
        if (sum == G) break;
        __builtin_amdgcn_s_sleep(1);
        if ((++sp & 255u) == 0u) { if (xb_ld(&bar[XB_TMO])) break; if (sp > XB_SPIN_CAP) { atomicAdd(&bar[XB_TMO], 1u); break; } }
    }
    nloc = mine > 0u ? mine : 1u; nx = cnt > 0u ? cnt : 1u;
}

__device__ __forceinline__ void xcd_barrier(const XcdBarrier& b, const bool leader) {
    asm volatile("s_waitcnt vmcnt(0)" ::: "memory");
    __syncthreads();
    if (leader) {
        unsigned* bar = b.bar;
        __builtin_amdgcn_s_waitcnt(0);
        unsigned nloc = b.st[0], nx = b.st[1];
        if (nloc == 0u) { xcd_barrier_complete(bar, b.x, nloc, nx); b.st[0] = nloc; b.st[1] = nx; }
        const unsigned old = xb_add(&bar[XB_XSUB(b.x)], 1u);
        const unsigned gen = old / nloc;
        if (old + 1u == (gen + 1u) * nloc) {
            __builtin_amdgcn_fence(__ATOMIC_RELEASE, "agent");
            asm volatile("s_waitcnt vmcnt(0)" ::: "memory");
            const unsigned og = xb_add(&bar[XB_TOP], 1u);
            const unsigned tg = og / nx;
            if (og + 1u == (tg + 1u) * nx) xb_add(&bar[XB_TOPGEN], 1u);
            else XB_SPIN(xb_ld(&bar[XB_TOPGEN]) == tg, bar);
            __builtin_amdgcn_fence(__ATOMIC_ACQUIRE, "agent");
            xb_add(&bar[XB_XGEN(b.x)], 1u);
            asm volatile("s_waitcnt vmcnt(0)" ::: "memory");
        } else {
            XB_SPIN(xb_ld(&bar[XB_XGEN(b.x)]) == gen, bar);
            __builtin_amdgcn_fence(__ATOMIC_ACQUIRE, "agent");
            asm volatile("s_waitcnt vmcnt(0)" ::: "memory");
        }
    }
    __syncthreads();
}

struct Frame {
    LAS unsigned char* lds;
    unsigned* ctl;
    int vcu, G;
};

__device__ __forceinline__ void p0_tile(const float* W, int N, int k0, int n0, bf16* WT, int Kd, int drow0, LAS float* scr, int lane, const float* gk = nullptr) {
    f32x4 w[8];
#pragma unroll
    for (int i = 0; i < 8; ++i) w[i] = *(const GAS f32x4*)(W + (size_t)(k0 + i * 8 + (lane >> 3)) * N + n0 + (lane & 7) * 4);
    if (gk) {
#pragma unroll
        for (int i = 0; i < 8; ++i) w[i] = w[i] * gk[k0 + i * 8 + (lane >> 3)]; }
#pragma unroll
    for (int i = 0; i < 8; ++i) { LAS float* d = scr + (i * 8 + (lane >> 3)) * 33 + (lane & 7) * 4; d[0] = w[i].x; d[1] = w[i].y; d[2] = w[i].z; d[3] = w[i].w; }
    LDS_WAIT(); asm volatile("" ::: "memory");
    const int c = lane & 7;
#pragma unroll
    for (int j = 0; j < 4; ++j) { const int n = (lane >> 3) + 8 * j; const LAS float* s = scr + (8 * c) * 33 + n;
        v4u o; o.x = pk2(s[0 * 33], s[1 * 33]); o.y = pk2(s[2 * 33], s[3 * 33]); o.z = pk2(s[4 * 33], s[5 * 33]); o.w = pk2(s[6 * 33], s[7 * 33]);
        *(GAS v4u*)(WT + (size_t)(drow0 + n) * Kd + k0 + 8 * c) = o; }
    LDS_WAIT(); asm volatile("" ::: "memory");
}
__device__ __forceinline__ void p0_plain(const float* W, int K, int N, bf16* WT, int row_off, int item, LAS float* scr, int lane) {
    const int nblk = N / 32, kb = item / nblk, nb = item % nblk;
    p0_tile(W, N, 64 * kb, 32 * nb, WT, K, row_off + 32 * nb, scr, lane);
}
__device__ __forceinline__ void rms_row_to_bf16(const float* xrow, const float* g, bf16* orow, int lane) {
    const GAS f32x4* xr = (const GAS f32x4*)xrow + lane; const GAS f32x4* gr = (const GAS f32x4*)g + lane;
    f32x4 v[4]; float s = 0.f;
#pragma unroll
    for (int j = 0; j < 4; ++j) { v[j] = xr[64 * j]; s += (v[j].x * v[j].x + v[j].y * v[j].y) + (v[j].z * v[j].z + v[j].w * v[j].w); }
    const float r = 1.f / sqrtf(wave_sum(s) * (1.f / D) + RMS_EPS);
    GAS unsigned long long* o8 = (GAS unsigned long long*)orow + lane;
#pragma unroll
    for (int j = 0; j < 4; ++j) { const f32x4 gg = gr[64 * j]; const f32x4 h = v[j] * r * gg;
        o8[64 * j] = (unsigned long long)pk2(h.x, h.y) | ((unsigned long long)pk2(h.z, h.w) << 32); }
}

__device__ __forceinline__ void rms_rows_stream(const float* src1, const float* g1, const float* src2, const float* g2, int nT, int nAll, bf16* dst, int m0, int mstep, int lane) {
    f32x4 cur[4][4], nxt[4][4];
    if (m0 >= nAll) return;
    { const GAS f32x4* xr = (const GAS f32x4*)((m0 < nT ? src1 + (size_t)m0 * D : src2 + (size_t)(m0 - nT) * D)) + lane;
#pragma unroll
      for (int q = 0; q < 4; ++q)
#pragma unroll
          for (int j = 0; j < 4; ++j) cur[q][j] = xr[q * 256 + 64 * j]; }
    for (int m = m0; m < nAll; m += mstep) {
        const int mn = m + mstep; const bool has = mn < nAll; const int ml = has ? mn : m;
        { const GAS f32x4* xr = (const GAS f32x4*)((ml < nT ? src1 + (size_t)ml * D : src2 + (size_t)(ml - nT) * D)) + lane;
#pragma unroll
          for (int q = 0; q < 4; ++q)
#pragma unroll
              for (int j = 0; j < 4; ++j) nxt[q][j] = xr[q * 256 + 64 * j]; }
        float s[4];
#pragma unroll
        for (int q = 0; q < 4; ++q) { s[q] = 0.f;
#pragma unroll
            for (int j = 0; j < 4; ++j) s[q] += (cur[q][j].x * cur[q][j].x + cur[q][j].y * cur[q][j].y) + (cur[q][j].z * cur[q][j].z + cur[q][j].w * cur[q][j].w); }
#pragma unroll
        for (int o = 1; o < 64; o <<= 1) {
#pragma unroll
            for (int q = 0; q < 4; ++q) s[q] += __shfl_xor(s[q], o); }
        const GAS f32x4* gr = (const GAS f32x4*)(m < nT ? g1 : g2) + lane;
        f32x4 gg[4];
#pragma unroll
        for (int j = 0; j < 4; ++j) gg[j] = gr[64 * j];
#pragma unroll
        for (int q = 0; q < 4; ++q) { const float r = 1.f / sqrtf(s[q] * (1.f / D) + RMS_EPS);
            GAS unsigned long long* o8 = (GAS unsigned long long*)(dst + (size_t)(m + q) * D) + lane;
#pragma unroll
            for (int j = 0; j < 4; ++j) { const f32x4 h = cur[q][j] * r * gg[j]; o8[64 * j] = (unsigned long long)pk2(h.x, h.y) | ((unsigned long long)pk2(h.z, h.w) << 32); } }
#pragma unroll
        for (int q = 0; q < 4; ++q)
#pragma unroll
            for (int j = 0; j < 4; ++j) cur[q][j] = nxt[q][j];
    }
}

__device__ __forceinline__ void build_tile_tables(Frame& F, const int tid) {
    LAS int* TB = (LAS int*)(F.lds + LDSX_OFF); LAS unsigned char* t2e = F.lds + LDSX_OFF + 128;
    __syncthreads();
    if (tid == 0) { int acc = 0;
        for (int e = 0; e < NEXP; ++e) { const int n = (int)__hip_atomic_load(F.ctl + CW_CNT + e, __ATOMIC_RELAXED, __HIP_MEMORY_SCOPE_AGENT); TB[e] = acc; acc += (n + 255) >> 8; }
        TB[NEXP] = acc; }
    __syncthreads();
    for (int t = tid; t < 1024; t += NWAVES * 64) { int e = 0;
#pragma unroll
        for (int k = 1; k < NEXP; ++k) e += (t >= TB[k]) ? 1 : 0;
        t2e[t] = (unsigned char)e; }
    __syncthreads();
}

struct Args { const float* in[26]; float* out; unsigned char* ws; int ph_lo, ph_hi; };

__global__ void __launch_bounds__(NWAVES * 64, 2) hybrid_fwd(Args args) {
    extern __shared__ __attribute__((aligned(16))) unsigned char lds[];
    __builtin_assume(__builtin_amdgcn_workitem_id_y() == 0); __builtin_assume(__builtin_amdgcn_workitem_id_z() == 0);
    Frame F;
    F.lds = (LAS unsigned char*)lds;
    F.G = gridDim.x; { const int bx = blockIdx.x; F.vcu = (F.G % 8 == 0) ? (bx % 8) * (F.G / 8) + bx / 8 : bx; }
    F.ctl = (unsigned*)(args.ws + WS_CTL);
#define x_in (args.in[0])
#define mem_in (args.in[1])
#define norm_mix_g (args.in[2])
#define w_in (args.in[3])
#define pool_w (args.in[4])
#define pool_scale (args.in[5])
#define lam_q1 (args.in[6])
#define lam_k1 (args.in[7])
#define lam_q2 (args.in[8])
#define lam_k2 (args.in[9])
#define subln_g (args.in[10])
#define norm_mem_g (args.in[11])
#define w_mem_kv (args.in[12])
#define p_pool (args.in[13])
#define p_diff (args.in[14])
#define p_mem (args.in[15])
#define w_o (args.in[16])
#define norm_ffn_g (args.in[17])
#define w_rg (args.in[18])
#define b_rg (args.in[19])
#define w_re (args.in[20])
#define b_re (args.in[21])
#define w_eg (args.in[22])
#define w_eu (args.in[23])
#define w_ed (args.in[24])
#define final_g (args.in[25])
#define Win_t ((bf16*)(args.ws + WS_WIN))
#define Pc_t ((bf16*)(args.ws + WS_PC))
#define Wo_t ((bf16*)(args.ws + WS_WO))
#define Wgu_t ((bf16*)(args.ws + WS_WGU))
#define Wd_t ((bf16*)(args.ws + WS_WD))
#define KV ((bf16*)(args.ws + WS_KV))
#define XN ((bf16*)(args.ws + WS_XN))
#define BR ((bf16*)(args.ws + WS_BR))
#define H2 ((bf16*)(args.ws + WS_H2))
#define PROJ ((bf16*)(args.ws + WS_PROJ))
#define MERGED ((bf16*)(args.ws + WS_MERGED))
#define MIX ((bf16*)(args.ws + WS_MIX))
#define HID ((bf16*)(args.ws + WS_HID))
#define ATTO ((bf16*)(args.ws + WS_ATTO))
#define GATES ((bf16*)(args.ws + WS_GATES))
#define Y ((bf16*)(args.ws + WS_Y))
#define ROUTE ((v4u*)(args.ws + WS_ROUTE))
#define RWE ((float*)(args.ws + WS_RWE))
#define LIST ((int*)(args.ws + WS_LIST))
#define WRF ((bf16*)(args.ws + WS_WRF))
#define RINV ((float*)(args.ws + WS_RINV))
#define X1 (args.out)
    const int NGW = F.G * NWAVES;
#define PHASE_IDS int tid = tid_of(wv); asm volatile("" : "+v"(tid)); const int lane = tid & 63, wave = __builtin_amdgcn_readfirstlane(tid >> 6), gw = F.vcu * NWAVES + wave; (void)lane; (void)gw;
    const int lo = args.ph_lo, hi = args.ph_hi;
    cg::grid_group grid = cg::this_grid();
#ifndef PH_MASK
#define PH_MASK 0x3ff
#endif
#define IN(k) (((PH_MASK >> (k)) & 1) && lo <= (k) && (k) < hi)
#ifndef PROBE_A
#define PROBE_A -1
#endif
#ifndef PROBE_B
#define PROBE_B -1
#endif
#ifndef PROBE_A2
#define PROBE_A2 (PROBE_A + 1)
#endif
#ifndef PROBE_B2
#define PROBE_B2 (PROBE_B + 1)
#endif
#define STAMP(k) do { if ((PROBE_A >= 0 || PROBE_B >= 0) && blockIdx.x == 0 && tid_of(wv) == 0) ((unsigned long long*)(F.ctl + CW_TS))[k] = __builtin_amdgcn_s_memrealtime(); } while (0)
#define SEAM(k) do { if (IN(k) && IN((k) + 1)) { { XcdBarrier b_; b_.bar = (unsigned*)(args.ws + WS_CTL) + CW_BAR; b_.x = xb_xcc_id(); b_.st = (volatile LAS unsigned*)(F.lds + LDSX_OFF + 2048); xcd_barrier(b_, tid_of(wv) == 0); } } STAMP((k) + 1); } while (0)
    const int wv = __builtin_amdgcn_readfirstlane((int)threadIdx.x >> 6);
    if (hi > NPH) grid.sync();
    if (threadIdx.x < 2) ((LAS unsigned*)(F.lds + LDSX_OFF + 2048))[threadIdx.x] = 0u;
    __syncthreads();
    if (lo < hi - 1) (void)xcd_barrier_post((unsigned*)(args.ws + WS_CTL) + CW_BAR, (volatile LAS unsigned*)(F.lds + LDSX_OFF + 2048));
    STAMP(0);

    if (IN(0)) {
        PHASE_IDS
        LAS float* scr = (LAS float*)(F.lds + RING_OFF + wave * 16384);
        constexpr int I_IN = 16 * 160, I_KV = 16 * 16, I_PD = 8 * 32, I_PM = 4 * 32, I_WO = 16 * 32, I_EG = 16 * 256, I_EU = 16 * 256, I_ED = 16 * 256;
        constexpr int NITEMS = I_IN + I_KV + I_PD + I_PM + I_WO + I_EG + I_EU + I_ED;
        for (int it = gw; it < NITEMS; it += NGW) {
            int r = it;
            if (r < I_IN) { p0_plain(w_in, D, INCOLS, Win_t, 0, r, scr, lane); continue; } r -= I_IN;
            if (r < I_KV) { p0_plain(w_mem_kv, D, 512, Win_t, INCOLS, r, scr, lane); continue; } r -= I_KV;
            if (r < I_PD) { const int kb = r >> 5, nb = r & 31; p0_tile(p_diff, D, 64 * kb, 32 * nb, Pc_t + 256, D, 32 * nb, scr, lane); continue; } r -= I_PD;
            if (r < I_PM) { const int kb = r >> 5, nb = r & 31; p0_tile(p_mem, D, 64 * kb, 32 * nb, Pc_t + 768, D, 32 * nb, scr, lane); continue; } r -= I_PM;
            if (r < I_WO) { p0_plain(w_o, D, D, Wo_t, 0, r, scr, lane); continue; } r -= I_WO;
            if (r < I_EG + I_EU) { const bool up = r >= I_EG; if (up) r -= I_EG;
                const int e = r >> 8, rr = r & 255, kb = rr >> 4, nb = rr & 15, n0 = 32 * nb;
                p0_tile((up ? w_eu : w_eg) + (size_t)e * D * EH, EH, 64 * kb, n0, Wgu_t + (size_t)e * D * D, D, (n0 >> 7) * 256 + (n0 & 127) + (up ? 128 : 0), scr, lane, norm_ffn_g); continue; }
            r -= I_EG + I_EU;
            { const int e = r >> 8, rr = r & 255, kb = rr >> 5, nb = rr & 31;
              p0_tile(w_ed + (size_t)e * EH * D, D, 64 * kb, 32 * nb, Wd_t + (size_t)e * D * EH, EH, 32 * nb, scr, lane); }
        }
        STAMP(12);
        for (int idx = (F.vcu * NWAVES * 64 + tid); idx < 5120; idx += F.G * NWAVES * 64) {
            const int q = idx % 20, h = (idx / 20) & 1, hl = (idx / 40) & 1, st = idx / 80, k0 = 32 * (st >> 1) + 16 * h + 8 * (st & 1);
            float v[8];
#pragma unroll
            for (int j = 0; j < 8; ++j) { const int k = k0 + j; const float w = norm_ffn_g[k] * (q < 4 ? w_rg[k * 4 + q] : w_re[k * 16 + (q - 4)]); const float hi = bflo(f2bf(w) ); v[j] = hl ? (w - hi) : w; }
            v4u o; o.x = pk2(v[0], v[1]); o.y = pk2(v[2], v[3]); o.z = pk2(v[4], v[5]); o.w = pk2(v[6], v[7]);
            *((GAS v4u*)WRF + idx) = o;
        }
        for (int idx = (F.vcu * NWAVES * 64 + tid); idx < 256 * 1024; idx += F.G * NWAVES * 64) {
            const int kc = idx >> 10, n = idx & 1023, g = kc >> 6; float a = 0.f;
#pragma unroll 16
            for (int d = 0; d < 64; ++d) a += pool_w[kc * 64 + d] * pool_scale[g * 64 + d] * p_pool[(size_t)(g * 64 + d) * D + n];
            Pc_t[(size_t)n * D + kc] = (bf16)f2bf(a);
        }
        STAMP(13);
        rms_rows_stream(x_in, norm_mix_g, mem_in, norm_mem_g, T, T + TM, XN, gw * 4, NGW * 4, lane);
    }
    SEAM(0);

    if (IN(1)) {
        pg8::Gemm g{XN, Win_t, T, INCOLS, D};
        pg8::ProjOrder S; S.so.init(T, INCOLS, F.G, (int)blockIdx.x);
        pg8::EpiProj E{PROJ, GATES, KV, attn_body::C2};
        pg8::gemm_phase<pg8::EpiProj, pg8::ProjOrder, true, true>(wv, F.lds + RING_OFF, g, S, E);
    }
    SEAM(1);

    if (IN(2)) {
        PHASE_IDS
        typedef attn_body::bf16 abf;
        struct DiffOrder { int vcu, G;
            __device__ __forceinline__ bool next(int i, int& bh, int& m, int& qb) const { const int u = vcu + (i >> 3) * G; if (u >= BATCH * 8) return false; bh = u >> 1; m = (i >> 2) & 1; const int k = i & 3, st = u & 1;
                qb = (k == 0) ? 7 - st : (k == 1) ? st : (k == 2) ? 4 + st : 3 - st; return true; } };
        float lam;
        { const float s1 = wave_sum(lam_q1[lane] * lam_k1[lane]), s2 = wave_sum(lam_q2[lane] * lam_k2[lane]); lam = __uint_as_float(__builtin_amdgcn_readfirstlane(__float_as_uint(__expf(s1) - __expf(s2) + 0.2f))); }
        { const DiffOrder S{F.vcu, F.G}; int bh, m, qb;
          for (int i = 0; S.next(i, bh, m, qb); ++i) {
            const int b = bh >> 2, h = bh & 3; const size_t rb = (size_t)b * SEQ;
            const attn2::bf16* Qu = (const attn2::bf16*)PROJ + (rb + qb * 256) * PROJW + 256 + h * 128 + m * 64;
            const attn2::bf16* Kh = (const attn2::bf16*)PROJ + rb * PROJW + 768 + h * 128 + m * 64;
            const attn2::bf16* Vh = (const attn2::bf16*)PROJ + rb * PROJW + 1280 + h * 128;
            attn2::bf16* S0 = (attn2::bf16*)ATTO + (rb + qb * 256) * 512 + h * 128;
            attn2::bf16* Od = (attn2::bf16*)BR + (rb + qb * 256) * D + 256 + h * 128;
            asm volatile("" : "+s"(Qu), "+s"(Kh), "+s"(Vh), "+s"(S0), "+s"(Od));
            if (m == 0) attn2::attn_unit<8, true, false>(Qu, PROJW, Kh, Vh, PROJW, wv, S0, 512, 4 * (qb + 1), (char*)lds + RING_OFF);
            else attn2::attn_unit<8, true, true>(Qu, PROJW, Kh, Vh, PROJW, wv, Od, D, 4 * (qb + 1), (char*)lds + RING_OFF, S0, 512, lam, subln_g); } }
        for (int mu = F.vcu; mu < BATCH * 8; mu += F.G) {
            const int b = mu >> 3, mh = (mu >> 1) & 3, half = mu & 1;
            const abf* Q0 = (const abf*)PROJ + ((size_t)b * SEQ + half * 1024) * PROJW + 1792 + mh * 64;
            const abf* Kh = (const abf*)KV + (size_t)b * NMEM * 512 + mh * 64;
            const abf* Vh = (const abf*)KV + (size_t)b * NMEM * 512 + 256 + mh * 64;
            abf* O0 = (abf*)BR + ((size_t)b * SEQ + half * 1024) * D + 768 + mh * 64;
            asm volatile("" : "+s"(Q0), "+s"(Kh), "+s"(Vh), "+s"(O0));
            attn_body::mem_attn(wv, Q0, PROJW, Kh, Vh, 512, O0, D, 4, (char*)lds + RING_OFF); }
    }
    SEAM(2);

    if (IN(3)) {
        PHASE_IDS
        const int gi = lane >> 4, w = 2 << gi;
        for (int tb = gw * 32; tb < T; tb += NGW * 32)
        for (int tp = 0; tp < 32; tp += 2) {
            const int t = tb + tp, s0 = t & (SEQ - 1);
            const GAS v2u* up = (const GAS v2u*)(PROJ + (size_t)(t + 1) * PROJW) + lane;
            const int nw0 = (w < s0 + 1) ? w : s0 + 1, nw1 = (w < s0 + 2) ? w : s0 + 2;
            v2u wq[17];
#pragma unroll
            for (int k = 0; k < 17; ++k) { wq[k] = (v2u){0u, 0u}; if (k < nw1 || (k >= 1 && k - 1 < nw0)) wq[k] = *(const GAS v2u*)((const GAS bf16*)up - (size_t)k * PROJW); }
#pragma unroll
            for (int q = 0; q < 2; ++q) {
                const int nwq = q ? nw1 : nw0; float a0 = 0.f, a1 = 0.f, a2 = 0.f, a3 = 0.f;
#pragma unroll
                for (int k = 0; k < 16; ++k) { const v2u x = wq[k + 1 - q]; const bool in = k < nwq; a0 += in ? bflo(x.x) : 0.f; a1 += in ? bfhi(x.x) : 0.f; a2 += in ? bflo(x.y) : 0.f; a3 += in ? bfhi(x.y) : 0.f; }
                const v2u ut = wq[1 - q]; const float inv = 1.f / (float)nwq;
                v2u po; po.x = pk2(a0 * inv - bflo(ut.x), a1 * inv - bfhi(ut.x)); po.y = pk2(a2 * inv - bflo(ut.y), a3 * inv - bfhi(ut.y));
                *((GAS v2u*)(BR + (size_t)(t + q) * D) + lane) = po; }
        }
    }
    SEAM(3);

    if (IN(4)) {
        pg8::StaticOrder S; S.init(T, D, F.G, (int)blockIdx.x);
        pg8::Gemm g{BR, Pc_t, T, D, D}; pg8::EpiMerge E{GATES, MERGED}; pg8::MidRescale MH{GATES};
        pg8::gemm_phase<pg8::EpiMerge, pg8::StaticOrder, true, true, pg8::MidRescale>(wv, F.lds + RING_OFF, g, S, E, MH);
    }
    SEAM(4);

    if (IN(5)) {
        pg8::Gemm g{MERGED, Wo_t, T, D, D}; pg8::StaticOrder S; S.init(T, D, F.G, (int)blockIdx.x);
        pg8::EpiMix E{MIX};
        pg8::gemm_phase<pg8::EpiMix, pg8::StaticOrder, true, true>(wv, F.lds + RING_OFF, g, S, E);
    }
    SEAM(5);

    if (IN(6)) {
        PHASE_IDS
        LAS v4u* WL = (LAS v4u*)(F.lds + RING_OFF);
        LAS float* SC = (LAS float*)(F.lds + RING_OFF + 81920) + wave * 1024;
        LAS v4u* REC = (LAS v4u*)(F.lds + RING_OFF + 81920 + 32768);
        LAS unsigned* LCNT = (LAS unsigned*)(F.lds + RING_OFF + 81920 + 32768 + 4096);
        LAS unsigned* LBASE = LCNT + 16; LAS float* RIL = (LAS float*)(LCNT + 32);
        for (int idx = tid; idx < 5120; idx += NWAVES * 64) WL[idx] = *((const GAS v4u*)WRF + idx);
        float bg[4], be[16];
#pragma unroll
        for (int i = 0; i < 4; ++i) bg[i] = b_rg[i];
#pragma unroll
        for (int i = 0; i < 16; ++i) be[i] = b_re[i];
        const int r32 = lane & 31, hh = lane >> 5;
        for (int rb0 = F.vcu * 256; rb0 < T; rb0 += F.G * 256) {
            if (tid < 16) LCNT[tid] = 0u;
            __syncthreads();
            const int li = wave * 32 + r32, row = rb0 + li;
            const GAS f32x4* xp = (const GAS f32x4*)(x_in + (size_t)row * D + 16 * hh);
            const GAS v4u* mp = (const GAS v4u*)(MIX + (size_t)row * D + 16 * hh);
            GAS v4u* hp = (GAS v4u*)(H2 + (size_t)row * D + 16 * hh);
            const LAS v4u* wl = WL + hh * 20 + r32;
            f32x16_t acc = {}; float ss = 0.f;
            f32x4 cur[8]; v4u curm[4];
#pragma unroll
            for (int i = 0; i < 8; ++i) cur[i] = xp[(i >> 2) * 8 + (i & 3)];
#pragma unroll
            for (int i = 0; i < 4; ++i) curm[i] = mp[(i >> 1) * 4 + (i & 1)];
#pragma unroll 1
            for (int sp2 = 0; sp2 < 16; ++sp2) {
                f32x4 nxt[8]; v4u nxtm[4];
                const int spn = (sp2 + 1 < 16) ? sp2 + 1 : sp2;
#pragma unroll
                for (int i = 0; i < 8; ++i) nxt[i] = xp[(2 * spn + (i >> 2)) * 8 + (i & 3)];
#pragma unroll
                for (int i = 0; i < 4; ++i) nxtm[i] = mp[(2 * spn + (i >> 1)) * 4 + (i & 1)];
#pragma unroll
                for (int i = 0; i < 4; ++i) { const v4u mm = curm[i];
                    cur[2 * i].x += bflo(mm.x); cur[2 * i].y += bfhi(mm.x); cur[2 * i].z += bflo(mm.y); cur[2 * i].w += bfhi(mm.y);
                    cur[2 * i + 1].x += bflo(mm.z); cur[2 * i + 1].y += bfhi(mm.z); cur[2 * i + 1].z += bflo(mm.w); cur[2 * i + 1].w += bfhi(mm.w); }
#pragma unroll
                for (int u = 0; u < 2; ++u) { const int sp = 2 * sp2 + u;
                    v4u ahi[2], alo[2];
#pragma unroll
                    for (int e = 0; e < 2; ++e) { const f32x4 a = cur[4 * u + 2 * e], b = cur[4 * u + 2 * e + 1];
                        ss += (a.x * a.x + a.y * a.y) + (a.z * a.z + a.w * a.w) + (b.x * b.x + b.y * b.y) + (b.z * b.z + b.w * b.w);
                        v4u h; h.x = cvtpk(a.x, a.y); h.y = cvtpk(a.z, a.w); h.z = cvtpk(b.x, b.y); h.w = cvtpk(b.z, b.w); ahi[e] = h;
                        v4u l; l.x = cvtpk(a.x - bflo(h.x), a.y - bfhi(h.x)); l.y = cvtpk(a.z - bflo(h.y), a.w - bfhi(h.y)); l.z = cvtpk(b.x - bflo(h.z), b.y - bfhi(h.z)); l.w = cvtpk(b.z - bflo(h.w), b.w - bfhi(h.w)); alo[e] = l; }
                    hp[sp * 4] = ahi[0]; hp[sp * 4 + 1] = ahi[1];
#pragma unroll
                    for (int e = 0; e < 2; ++e) { const int st = 2 * sp + e;
                        v4u bh = {0u, 0u, 0u, 0u}, bl = {0u, 0u, 0u, 0u};
                        if (r32 < 20) { bh = wl[(st * 4) * 20]; bl = wl[(st * 4 + 2) * 20]; }
                        acc = __builtin_amdgcn_mfma_f32_32x32x16_bf16(__builtin_bit_cast(bf16x8_t, ahi[e]), __builtin_bit_cast(bf16x8_t, bh), acc, 0, 0, 0);
                        acc = __builtin_amdgcn_mfma_f32_32x32x16_bf16(__builtin_bit_cast(bf16x8_t, alo[e]), __builtin_bit_cast(bf16x8_t, bh), acc, 0, 0, 0);
                        acc = __builtin_amdgcn_mfma_f32_32x32x16_bf16(__builtin_bit_cast(bf16x8_t, ahi[e]), __builtin_bit_cast(bf16x8_t, bl), acc, 0, 0, 0); } }
#pragma unroll
                for (int i = 0; i < 8; ++i) cur[i] = nxt[i];
#pragma unroll
                for (int i = 0; i < 4; ++i) curm[i] = nxtm[i];
            }
            ss += __shfl_xor(ss, 32);
            const float rinv = 1.f / sqrtf(ss * (1.f / D) + RMS_EPS);
#pragma unroll
            for (int r = 0; r < 16; ++r) SC[((r & 3) + 8 * (r >> 2) + 4 * hh) * 32 + r32] = acc[r];
            LDS_WAIT();
            if (lane < 32) {
                float lg[20];
#pragma unroll
                for (int q4 = 0; q4 < 5; ++q4) { const f32x4 t4 = *(const LAS f32x4*)(SC + lane * 32 + 4 * q4); lg[4 * q4] = t4.x * rinv; lg[4 * q4 + 1] = t4.y * rinv; lg[4 * q4 + 2] = t4.z * rinv; lg[4 * q4 + 3] = t4.w * rinv; }
                float gl[4];
#pragma unroll
                for (int i = 0; i < 4; ++i) gl[i] = lg[i] + bg[i];
                int gidx = 0; float gmax = gl[0];
#pragma unroll
                for (int i = 1; i < 4; ++i) if (gl[i] > gmax) { gmax = gl[i]; gidx = i; }
                float gsum = 0.f;
#pragma unroll
                for (int i = 0; i < 4; ++i) gsum += __expf(gl[i] - gmax);
                const float gp = 1.f / gsum;
                float el[4];
#pragma unroll
                for (int j = 0; j < 4; ++j) { const float l0 = lg[4 + j] + be[j], l1 = lg[8 + j] + be[4 + j], l2 = lg[12 + j] + be[8 + j], l3 = lg[16 + j] + be[12 + j];
                    el[j] = gidx == 0 ? l0 : gidx == 1 ? l1 : gidx == 2 ? l2 : l3; }
                int i0 = 0; float m0 = el[0];
#pragma unroll
                for (int j = 1; j < 4; ++j) if (el[j] > m0) { m0 = el[j]; i0 = j; }
                int i1 = -1; float m1 = -3.0e38f;
#pragma unroll
                for (int j = 0; j < 4; ++j) if (j != i0 && el[j] > m1) { m1 = el[j]; i1 = j; }
                if (i1 < 0) { i1 = (i0 + 1) & 3; m1 = m0; }
                const float p1 = __expf(m1 - m0);
                const float w0 = gp / (1.f + p1), w1 = gp * p1 / (1.f + p1);
                const unsigned e0 = (unsigned)(gidx * 4 + i0), e1 = (unsigned)(gidx * 4 + i1);
                const unsigned s0 = __hip_atomic_fetch_add(LCNT + e0, 1u, __ATOMIC_RELAXED, __HIP_MEMORY_SCOPE_WORKGROUP), s1 = __hip_atomic_fetch_add(LCNT + e1, 1u, __ATOMIC_RELAXED, __HIP_MEMORY_SCOPE_WORKGROUP);
                v4u rc; rc.x = (e0 << 20) | s0; rc.y = (e1 << 20) | s1; rc.z = __float_as_uint(w0); rc.w = __float_as_uint(w1); REC[li] = rc;
                RINV[row] = rinv; RIL[li] = rinv;
            }
            __syncthreads();
            if (tid < 16) LBASE[tid] = __hip_atomic_fetch_add(F.ctl + CW_CNT + tid, LCNT[tid], __ATOMIC_RELAXED, __HIP_MEMORY_SCOPE_AGENT);
            __syncthreads();
            if (tid < 256) { v4u rc = REC[tid]; rc.x += LBASE[rc.x >> 20]; rc.y += LBASE[rc.y >> 20]; *((GAS v4u*)ROUTE + rb0 + tid) = rc;
                const unsigned i0 = ((rc.x >> 20) << 16) + (rc.x & 0xFFFFFu), i1 = ((rc.y >> 20) << 16) + (rc.y & 0xFFFFFu); const float ri = RIL[tid];
                LIST[i0] = rb0 + tid; LIST[i1] = rb0 + tid; RWE[2 * i0] = ri; RWE[2 * i0 + 1] = __uint_as_float(rc.z); RWE[2 * i1] = ri; RWE[2 * i1 + 1] = __uint_as_float(rc.w); }
            __syncthreads();
        }
    }
    SEAM(6);

    if (IN(7)) {
        PHASE_IDS
        build_tile_tables(F, tid);
        const LAS int* TB = (const LAS int*)(F.lds + LDSX_OFF); const LAS unsigned char* t2e = (const LAS unsigned char*)(F.lds + LDSX_OFF + 128);
        LAS int* TOKL = (LAS int*)(F.lds + LDSX_OFF + 4096);
        const int nunits = TB[NEXP] * 4;
        for (int i = 0; i < 11; ++i) { const int L = i * F.G + F.vcu; if (L >= nunits) break;
            const int pm = L >> 2, e = t2e[pm], lt = pm - TB[e];
            if (tid < 256) { unsigned tok = (unsigned)LIST[(e << 16) + lt * 256 + tid]; tok = tok < (unsigned)T ? tok : (unsigned)(T - 1); TOKL[i * 256 + tid] = (int)tok; } }
        __syncthreads();
        pg8::Gemm g{H2, Wgu_t, T, NEXP * D, D};
        pg8::MoeOrder S{t2e, nunits, F.G, F.vcu};
        pg8::EpiGateUp E{HID, RWE, TB};
        pg8::gemm_phase<pg8::EpiGateUp, pg8::MoeOrder, true, true, pg8::NoMid, true>(wv, F.lds + RING_OFF, g, S, E, pg8::NoMid(), TOKL);
    }
    SEAM(7);

    if (IN(8)) {
        PHASE_IDS
        build_tile_tables(F, tid);
        const LAS int* TB = (const LAS int*)(F.lds + LDSX_OFF);
        pg8::Gemm g{HID, Wd_t, MAXROWS, NEXP * D, EH};
        pg8::MoeOrder S{(const LAS unsigned char*)(F.lds + LDSX_OFF + 128), TB[NEXP] * 4, F.G, F.vcu};
        pg8::EpiDown E{Y};
        pg8::gemm_phase<pg8::EpiDown, pg8::MoeOrder, true, true>(wv, F.lds + RING_OFF, g, S, E);
    }
    SEAM(8);

    if (IN(9)) {
        PHASE_IDS
        build_tile_tables(F, tid);
        const LAS int* TB = (const LAS int*)(F.lds + LDSX_OFF);
        for (int t = gw; t < T; t += NGW) {
            const v4u rc = *((const GAS v4u*)ROUTE + t);
            const size_t r0 = (size_t)TB[rc.x >> 20] * 256 + (rc.x & 0xFFFFFu), r1 = (size_t)TB[rc.y >> 20] * 256 + (rc.y & 0xFFFFFu);
            GAS f32x4* xr = (GAS f32x4*)(X1 + (size_t)t * D) + lane; const GAS f32x4* gr = (const GAS f32x4*)final_g + lane; const GAS v2u* hr = (const GAS v2u*)(H2 + (size_t)t * D) + lane;
            const GAS v2u* y0 = (const GAS v2u*)(Y + r0 * D) + lane; const GAS v2u* y1 = (const GAS v2u*)(Y + r1 * D) + lane;
            f32x4 v[4]; float s = 0.f;
#pragma unroll
            for (int j = 0; j < 4; ++j) { const v2u hx = hr[64 * j]; v[j] = (f32x4){bflo(hx.x), bfhi(hx.x), bflo(hx.y), bfhi(hx.y)}; const v2u a = y0[64 * j], b = y1[64 * j];
                v[j].x += bflo(a.x) + bflo(b.x); v[j].y += bfhi(a.x) + bfhi(b.x); v[j].z += bflo(a.y) + bflo(b.y); v[j].w += bfhi(a.y) + bfhi(b.y);
                s += (v[j].x * v[j].x + v[j].y * v[j].y) + (v[j].z * v[j].z + v[j].w * v[j].w); }
            const float r = 1.f / sqrtf(wave_sum(s) * (1.f / D) + RMS_EPS);
#pragma unroll
            for (int j = 0; j < 4; ++j) { f32x4 o = v[j] * r * gr[64 * j];
                if (PROBE_B >= 0 && blockIdx.x == 0 && (t / NGW) < 8) {
                    const unsigned long long* ts = (const unsigned long long*)(F.ctl + CW_TS); const float amp = sqrtf((float)((ts[PROBE_B2] - ts[PROBE_B]) / 100) * 1e-3f);
                    o.x += amp; o.y += amp; o.z += amp; o.w += amp; }
                xr[64 * j] = o; }
        }
        STAMP(10);
        if (PROBE_A >= 0 && blockIdx.x == 0 && tid_of(wv) == 0) {
            const unsigned long long* ts = (const unsigned long long*)(F.ctl + CW_TS);
            X1[0] += 4.f + (float)((ts[PROBE_A2] - ts[PROBE_A]) / 100) * 0.01f; }
    }
#undef IN
#undef SEAM
#undef STAMP
#undef PHASE_IDS
#undef x_in
#undef mem_in
#undef norm_mix_g
#undef w_in
#undef pool_w
#undef pool_scale
#undef lam_q1
#undef lam_k1
#undef lam_q2
#undef lam_k2
#undef subln_g
#undef norm_mem_g
#undef w_mem_kv
#undef p_pool
#undef p_diff
#undef p_mem
#undef w_o
#undef norm_ffn_g
#undef w_rg
#undef b_rg
#undef w_re
#undef b_re
#undef w_eg
#undef w_eu
#undef w_ed
#undef final_g
#undef Win_t
#undef Pc_t
#undef Wo_t
#undef Wgu_t
#undef Wd_t
#undef KV
#undef XN
#undef BR
#undef H2
#undef PROJ
#undef MERGED
#undef MIX
#undef HID
#undef ATTO
#undef GATES
#undef Y
#undef ROUTE
#undef RWE
#undef LIST
#undef WRF
#undef RINV
#undef X1
}

extern "C" void kernel_launch(void* const* d_in, const int* in_sizes, int n_in, void* d_out, int out_size, void* d_ws, size_t ws_size, hipStream_t stream) {
    static int grid = 0;
    if (grid == 0) {
        if (n_in != 26 || in_sizes[0] != T * D || out_size != T * D || ws_size < WS_END) { fprintf(stderr, "kernel_launch: unexpected problem: n_in %d in0 %d out %d ws %zu (need %zu)\n", n_in, n_in > 0 ? in_sizes[0] : -1, out_size, ws_size, (size_t)WS_END); grid = -1; return; }
        int dev = 0, cus = 0, per_cu = 0;
        if (hipGetDevice(&dev) != hipSuccess || hipDeviceGetAttribute(&cus, hipDeviceAttributeMultiprocessorCount, dev) != hipSuccess) { fprintf(stderr, "kernel_launch: device query failed\n"); grid = -1; return; }
        if (hipFuncSetAttribute((const void*)hybrid_fwd, hipFuncAttributeMaxDynamicSharedMemorySize, LDS_BYTES) != hipSuccess) { fprintf(stderr, "kernel_launch: hipFuncSetAttribute failed\n"); grid = -1; return; }
        if (hipOccupancyMaxActiveBlocksPerMultiprocessor(&per_cu, (const void*)hybrid_fwd, NWAVES * 64, LDS_BYTES) != hipSuccess || per_cu < 1) { fprintf(stderr, "kernel_launch: occupancy query says %d blocks per CU\n", per_cu); grid = -1; return; }
        (void)hipGetLastError();
        grid = cus;
        if (grid > 256) grid = 256;
    }
    if (grid < 0) return;
    if (hipMemsetAsync((char*)d_ws + WS_CTL, 0, CTL_ZERO_BYTES, stream) != hipSuccess) { fprintf(stderr, "kernel_launch: memset failed\n"); return; }
    Args a{};
    for (int i = 0; i < 26; ++i) a.in[i] = (const float*)d_in[i];
    a.out = (float*)d_out; a.ws = (unsigned char*)d_ws;
#if MK_N_LAUNCHES == 1
    a.ph_lo = 0; a.ph_hi = NPH;
    void* kargs[] = {&a};
    hipError_t e = hipLaunchCooperativeKernel((const void*)hybrid_fwd, dim3(grid), dim3(NWAVES * 64), kargs, LDS_BYTES, stream);
    if (e != hipSuccess) fprintf(stderr, "kernel_launch: cooperative launch failed: %s (grid %d)\n", hipGetErrorString(e), grid);
#else
    for (int p = 0; p < NPH; ++p) { a.ph_lo = p; a.ph_hi = p + 1;
        hipLaunchKernelGGL(hybrid_fwd, dim3(grid), dim3(NWAVES * 64), LDS_BYTES, stream, a);
        const hipError_t le = hipPeekAtLastError(); if (le != hipSuccess) { fprintf(stderr, "kernel_launch: launch %d failed: %s\n", p, hipGetErrorName(le)); break; } }
#endif
}
```

```cpp
#include <hip/hip_runtime.h>
#include <hip/hip_cooperative_groups.h>
#include <cstdio>
#include <cstdint>
namespace cg = cooperative_groups;
__device__ __forceinline__ int tid_of(int wv) { unsigned z = 0u; asm volatile("" : "+v"(z));
    return (wv << 6) | (int)__builtin_amdgcn_mbcnt_hi(~0u, __builtin_amdgcn_mbcnt_lo(~0u, z)); }
namespace pg8 {
#define PG8_LAS __attribute__((address_space(3)))
typedef unsigned short bf16_t;
typedef short bf16x8 __attribute__((ext_vector_type(8)));
typedef float f32x4 __attribute__((ext_vector_type(4)));
typedef unsigned u32x4 __attribute__((ext_vector_type(4)));
constexpr int BM = 256, BK = 64, HALF = 128, HTB = HALF * BK * 2  , STAGE_BYTES = 8 * HTB, NXCD = 8, WGM = 8;

__host__ __device__ __forceinline__ int lds_byte(int r, int c) { const int st = (r >> 4) * 2 + (c >> 5), rr = r & 15, cc = c & 31, ob = rr * 64 + cc * 2; return st * 1024 + (ob ^ (((ob >> 9) & 1) << 5)); }
__host__ __device__ __forceinline__ void stage_rc(int b, int& R, int& C) { const int st = b / 1024, sb = b % 1024, swz = sb ^ (((sb >> 9) & 1) << 5); R = (st >> 1) * 16 + swz / 64; C = (st & 1) * 32 + (swz % 64) / 2; }
__host__ __device__ __forceinline__ int perm32(int rho) { const int n = rho >> 4, i = rho & 15; return 8 * (i >> 2) + 4 * n + (i & 3); }

struct Unit { int pm, pn; };
struct Gemm { const bf16_t* A; const bf16_t* Bt; int M, N, K; };

struct StaticOrder {
    int nM, nN, nwg, G, c;
    __host__ __device__ void init(int M, int N, int G_, int c_) { nM = M / BM; nN = N / BM; nwg = nM * nN; G = G_; c = c_; }
    __host__ __device__ bool next(int i, Unit& u) const {
        const long L = (long)i * G + c; if (L >= nwg) return false;
        int wgid = (int)L; { const int q = nwg / NXCD, r = nwg % NXCD, xcd = wgid % NXCD, off = wgid / NXCD; wgid = (xcd < r ? xcd * (q + 1) : r * (q + 1) + (xcd - r) * q) + off; }
        const int nig = WGM * nN, gid = wgid / nig, fm = gid * WGM, gsz = (nM - fm) < WGM ? (nM - fm) : WGM;
        u.pm = fm + ((wgid % nig) % gsz); u.pn = (wgid % nig) / gsz; return true;
    }
    __device__ __forceinline__ void a_ready(const Unit&) const {}
    __device__ __forceinline__ void done(const Unit&) const {}
};

__device__ __forceinline__ unsigned cvt_pk_bf16(float lo, float hi) { unsigned r; asm volatile("v_cvt_pk_bf16_f32 %0, %1, %2" : "=v"(r) : "v"(lo), "v"(hi)); return r; }
typedef unsigned u32x2 __attribute__((ext_vector_type(2)));
__device__ __forceinline__ float bf_lo(unsigned w) { return __uint_as_float(w << 16); }
__device__ __forceinline__ float bf_hi(unsigned w) { return __uint_as_float(w & 0xffff0000u); }
__device__ __forceinline__ float sigmoid_f(float x) { return __builtin_amdgcn_rcpf(1.0f + __builtin_amdgcn_exp2f(-1.4426950408889634f * x)); }
__device__ __forceinline__ u32x4 pack8(const f32x4 a, const f32x4 b) { u32x4 w; w.x = cvt_pk_bf16(a[0], a[1]); w.y = cvt_pk_bf16(a[2], a[3]); w.z = cvt_pk_bf16(b[0], b[1]); w.w = cvt_pk_bf16(b[2], b[3]); return w; }

struct ProjOrder {
    StaticOrder so;
    __device__ __forceinline__ bool next(int i, Unit& u) const {
        const long L = (long)i * so.G + so.c;
        if (L < so.nwg) return so.next(i, u);
        const int x = (int)(L - so.nwg); if (x >= 64) return false;
        u.pm = 256 + (x >> 1); u.pn = 20 + (x & 1); return true;
    }
    __device__ __forceinline__ void a_ready(const Unit&) const {}
    __device__ __forceinline__ void done(const Unit&) const {}
};
struct MoeOrder {
    const PG8_LAS unsigned char* t2e; int nunits, G, c;
    __device__ __forceinline__ bool next(int i, Unit& u) const {
        const int L = i * G + c; if (L >= nunits) return false;
        const int pm = L >> 2; u.pm = pm; u.pn = (int)t2e[pm] * 4 + (L & 3); return true;
    }
    __device__ __forceinline__ void a_ready(const Unit&) const {}
    __device__ __forceinline__ void done(const Unit&) const {}
};

struct EpiProj {
    static constexpr bool PERM = true, AFTER_DRAIN = false;
    bf16_t* PROJ; bf16_t* GATES; bf16_t* KV; float qscale;
    __device__ __forceinline__ void operator()(const f32x4 (&acc)[2][2][4][2], const Unit& u, int wr, int wc, int fr, int fq) const {
        bf16_t* base; int ldc, colt, mode = 0; float sc = 1.f; int rowt = u.pm * BM;
        if (u.pm >= 256) { base = KV; ldc = 512; colt = (u.pn - 20) * BM; rowt -= 65536; }
        else if (u.pn < 8) { base = PROJ; ldc = 2048; colt = u.pn * BM; if (u.pn == 1 || u.pn == 2 || u.pn == 7) sc = qscale; }
        else { base = GATES; ldc = 3072; colt = (u.pn - 8) * BM; mode = 1; }
        const int row0 = rowt + wr * 64 + fr, col0 = colt + wc * 32 + 8 * fq;
#pragma unroll
        for (int ai = 0; ai < 2; ++ai)
#pragma unroll
            for (int m = 0; m < 4; ++m) { bf16_t* rowp = base + (size_t)(row0 + ai * HALF + m * 16) * ldc + col0;
#pragma unroll
                for (int bj = 0; bj < 2; ++bj) { f32x4 v0 = acc[ai][bj][m][0], v1 = acc[ai][bj][m][1];
                    if (mode) {
#pragma unroll
                        for (int i = 0; i < 4; ++i) { v0[i] = sigmoid_f(v0[i]); v1[i] = sigmoid_f(v1[i]); } }
                    else { v0 = v0 * sc; v1 = v1 * sc; }
                    *(u32x4*)(rowp + bj * HALF) = pack8(v0, v1); } }
    }
};
__device__ __forceinline__ float gclamp(float g) { return __builtin_fmaxf(g, 1e-18f); }
struct MidRescale {
    static constexpr bool ON = true; static constexpr int T0 = 4, T1 = 12;
    const bf16_t* GATES;
    __device__ __forceinline__ void operator()(f32x4 (&acc)[2][2][4][2], const Unit& u, int t, int wr, int wc, int fr, int fq) const {
        int fr_ = fr; asm volatile("" : "+v"(fr_));
        const int row0 = u.pm * BM + wr * 64 + fr_, col0 = u.pn * BM + wc * 32 + 8 * fq; const int gprev = (t == T0) ? 0 : 1024;
        const unsigned off0 = ((unsigned)row0 * 3072u + (unsigned)(gprev + col0)) * 2u;
#pragma unroll
        for (int ai = 0; ai < 2; ++ai) {
            u32x4 ga[4][2], gb[4][2];
#pragma unroll
            for (int m = 0; m < 4; ++m) { const char* gp = (const char*)GATES + (off0 + (unsigned)((ai * HALF + m * 16) * 3072 * 2));
#pragma unroll
                for (int bj = 0; bj < 2; ++bj) { ga[m][bj] = *(const u32x4*)(gp + bj * HALF * 2); gb[m][bj] = *(const u32x4*)(gp + 2048 + bj * HALF * 2); } }
#pragma unroll
            for (int m = 0; m < 4; ++m)
#pragma unroll
                for (int bj = 0; bj < 2; ++bj) { const u32x4 a = ga[m][bj], b = gb[m][bj];
                    f32x4 r0, r1;
                    r0[0] = bf_lo(a.x) * __builtin_amdgcn_rcpf(gclamp(bf_lo(b.x))); r0[1] = bf_hi(a.x) * __builtin_amdgcn_rcpf(gclamp(bf_hi(b.x)));
                    r0[2] = bf_lo(a.y) * __builtin_amdgcn_rcpf(gclamp(bf_lo(b.y))); r0[3] = bf_hi(a.y) * __builtin_amdgcn_rcpf(gclamp(bf_hi(b.y)));
                    r1[0] = bf_lo(a.z) * __builtin_amdgcn_rcpf(gclamp(bf_lo(b.z))); r1[1] = bf_hi(a.z) * __builtin_amdgcn_rcpf(gclamp(bf_hi(b.z)));
                    r1[2] = bf_lo(a.w) * __builtin_amdgcn_rcpf(gclamp(bf_lo(b.w))); r1[3] = bf_hi(a.w) * __builtin_amdgcn_rcpf(gclamp(bf_hi(b.w)));
                    acc[ai][bj][m][0] = acc[ai][bj][m][0] * r0; acc[ai][bj][m][1] = acc[ai][bj][m][1] * r1; }
            asm volatile("" ::: "memory"); }
    }
};
struct EpiMerge {
    static constexpr bool PERM = true, AFTER_DRAIN = false;
    const bf16_t* GATES; bf16_t* MERGED;
    __device__ __forceinline__ void operator()(const f32x4 (&acc)[2][2][4][2], const Unit& u, int wr, int wc, int fr, int fq) const {
        const int row0 = u.pm * BM + wr * 64 + fr, col0 = u.pn * BM + wc * 32 + 8 * fq;
        const unsigned off0 = ((unsigned)row0 * 3072u + (unsigned)(2048 + col0)) * 2u;
        u32x4 gg[2][4][2];
#pragma unroll
        for (int ai = 0; ai < 2; ++ai)
#pragma unroll
            for (int m = 0; m < 4; ++m)
#pragma unroll
                for (int bj = 0; bj < 2; ++bj) gg[ai][m][bj] = *(const u32x4*)((const char*)GATES + (off0 + (unsigned)((ai * HALF + m * 16) * 3072 * 2)) + bj * HALF * 2);
#pragma unroll
        for (int ai = 0; ai < 2; ++ai)
#pragma unroll
            for (int m = 0; m < 4; ++m) { const size_t r = (size_t)(row0 + ai * HALF + m * 16);
#pragma unroll
                for (int bj = 0; bj < 2; ++bj) { const int c = col0 + bj * HALF; const u32x4 g = gg[ai][m][bj];
                    f32x4 v0 = acc[ai][bj][m][0], v1 = acc[ai][bj][m][1];
                    v0[0] *= gclamp(bf_lo(g.x)); v0[1] *= gclamp(bf_hi(g.x)); v0[2] *= gclamp(bf_lo(g.y)); v0[3] *= gclamp(bf_hi(g.y));
                    v1[0] *= gclamp(bf_lo(g.z)); v1[1] *= gclamp(bf_hi(g.z)); v1[2] *= gclamp(bf_lo(g.w)); v1[3] *= gclamp(bf_hi(g.w));
                    *(u32x4*)(MERGED + r * 1024 + c) = pack8(v0, v1); } }
    }
};
struct EpiMix {
    static constexpr bool PERM = true, AFTER_DRAIN = false;
    bf16_t* MIX;
    __device__ __forceinline__ void operator()(const f32x4 (&acc)[2][2][4][2], const Unit& u, int wr, int wc, int fr, int fq) const {
        const int row0 = u.pm * BM + wr * 64 + fr, col0 = u.pn * BM + wc * 32 + 8 * fq;
#pragma unroll
        for (int ai = 0; ai < 2; ++ai)
#pragma unroll
            for (int m = 0; m < 4; ++m) { bf16_t* rowp = MIX + (size_t)(row0 + ai * HALF + m * 16) * 1024 + col0;
#pragma unroll
                for (int bj = 0; bj < 2; ++bj) *(u32x4*)(rowp + bj * HALF) = pack8(acc[ai][bj][m][0], acc[ai][bj][m][1]); }
    }
};
struct EpiWo {
    static constexpr bool PERM = false, AFTER_DRAIN = false;
    const float* X; float* X1;
    __device__ __forceinline__ void operator()(const f32x4 (&acc)[2][2][4][2], const Unit& u, int wr, int wc, int fr, int fq) const {
        const int row0 = u.pm * BM + wr * 64 + fr, col0 = u.pn * BM + wc * 32 + 4 * fq;
#pragma unroll
        for (int ai = 0; ai < 2; ++ai)
#pragma unroll
            for (int m = 0; m < 4; ++m) { const size_t off = (size_t)(row0 + ai * HALF + m * 16) * 1024 + col0;
#pragma unroll
                for (int bj = 0; bj < 2; ++bj)
#pragma unroll
                    for (int n = 0; n < 2; ++n) { const size_t o = off + bj * HALF + n * 16; *(f32x4*)(X1 + o) = *(const f32x4*)(X + o) + acc[ai][bj][m][n]; } }
    }
};
struct EpiGateUp {
    static constexpr bool PERM = true, AFTER_DRAIN = false;
    bf16_t* HID; const float* RWE; const PG8_LAS int* TB;
    __device__ __forceinline__ void operator()(const f32x4 (&acc)[2][2][4][2], const Unit& u, int wr, int wc, int fr, int fq) const {
        const int row0 = u.pm * BM + wr * 64 + fr, colh = (u.pn & 3) * 128 + wc * 32 + 8 * fq;
#pragma unroll
        for (int ai = 0; ai < 2; ++ai)
#pragma unroll
            for (int m = 0; m < 4; ++m) { const size_t r = (size_t)(row0 + ai * HALF + m * 16); const size_t es = (size_t)((u.pn >> 2) << 16) + (r - (size_t)TB[u.pn >> 2] * 256); const float ri = RWE[2 * es], w = RWE[2 * es + 1];
                f32x4 h0, h1;
#pragma unroll
                for (int i = 0; i < 4; ++i) { const float g0 = acc[ai][0][m][0][i] * ri, g1 = acc[ai][0][m][1][i] * ri; const float wr_ = w * ri;
                    h0[i] = g0 * sigmoid_f(g0) * acc[ai][1][m][0][i] * wr_; h1[i] = g1 * sigmoid_f(g1) * acc[ai][1][m][1][i] * wr_; }
                *(u32x4*)(HID + r * 512 + colh) = pack8(h0, h1); }
    }
};
struct EpiDown {
    static constexpr bool PERM = true, AFTER_DRAIN = false;
    bf16_t* Y;
    __device__ __forceinline__ void operator()(const f32x4 (&acc)[2][2][4][2], const Unit& u, int wr, int wc, int fr, int fq) const {
        const int row0 = u.pm * BM + wr * 64 + fr, col0 = (u.pn & 3) * BM + wc * 32 + 8 * fq;
#pragma unroll
        for (int ai = 0; ai < 2; ++ai)
#pragma unroll
            for (int m = 0; m < 4; ++m) { bf16_t* rowp = Y + (size_t)(row0 + ai * HALF + m * 16) * 1024 + col0;
#pragma unroll
                for (int bj = 0; bj < 2; ++bj) *(u32x4*)(rowp + bj * HALF) = pack8(acc[ai][bj][m][0], acc[ai][bj][m][1]); }
    }
};

struct NoMid { static constexpr bool ON = false; static constexpr int T0 = -1, T1 = -1; __device__ __forceinline__ void operator()(f32x4 (&)[2][2][4][2], const Unit&, int, int, int, int, int) const {} };
template <class Epi, class Sched, bool ALIGN_EPI = false, bool SP2 = false, class Mid = NoMid, bool GATHER = false>
__device__ __forceinline__ void gemm_phase(const int wv, PG8_LAS unsigned char* lds, const Gemm g, const Sched& S, const Epi& E, const Mid& MH = Mid(), const PG8_LAS int* tokl = nullptr) {
    int tid_ = tid_of(wv); asm volatile("" : "+v"(tid_));
    const int tid = tid_, wid = __builtin_amdgcn_readfirstlane(tid >> 6), lane = tid & 63, wr = wid >> 2, wc = wid & 3, fr = lane & 15, fq = lane >> 4;
    static_assert(!GATHER || SP2, "GATHER is written for the SP2 loop");
    const int K = g.K, nt = K / BK;
    unsigned voffA[2], voffB[2];
#pragma unroll
    for (int i = 0; i < 2; ++i) { int R, C; stage_rc(tid * 16 + i * 8192, R, C); const int Rb = Epi::PERM ? ((R & ~31) + perm32(R & 31)) : R;
        voffA[i] = (unsigned)(R * K + C) * 2u; voffB[i] = (unsigned)(Rb * K + C) * 2u; }
    const size_t kstep = (size_t)(BK * 2);
    const size_t hstep = (size_t)HALF * K * 2;
    const size_t tstep = 2 * hstep;
    const unsigned ldsw = (unsigned)wid * 1024u;
    const int aoff = lds_byte(wr * 64 + fr, fq * 8), boff = lds_byte(wc * 32 + fr, fq * 8);
    unsigned vGc[2][2], vGn[2][2]; int gR[2], gC[2];
    if constexpr (GATHER) {
#pragma unroll
        for (int i = 0; i < 2; ++i) { stage_rc(tid * 16 + i * 8192, gR[i], gC[i]); }
    }
#define PG8_GOFFS(dst, u_) do { if constexpr (GATHER) { _Pragma("unroll") for (int hh_ = 0; hh_ < 2; ++hh_) _Pragma("unroll") for (int i_ = 0; i_ < 2; ++i_) \
        dst[hh_][i_] = ((unsigned)tokl[(u_) * 256 + hh_ * HALF + gR[i_]] * (unsigned)K + (unsigned)gC[i_]) * 2u; } } while (0)
#define PG8_STGA(bufoff, base, hh, nx) do { if constexpr (GATHER) { _Pragma("unroll") for (int _i = 0; _i < 2; ++_i) \
        __builtin_amdgcn_global_load_lds((const unsigned*)((const char*)(base) + ((nx) ? vGn[hh][_i] : vGc[hh][_i])), (PG8_LAS unsigned*)(lds + (bufoff) + ldsw + _i * 8192), 16, 0, 0); } \
      else { PG8_STAGE(bufoff, (base) + (hh) * hstep, voffA); } } while (0)
#define PG8_SA(b, h) (((b) * 2 + (h)) * HTB)
#define PG8_SB(b, h) ((4 + (b) * 2 + (h)) * HTB)
#define PG8_STAGE(bufoff, gbase, voff) do { _Pragma("unroll") for (int _i = 0; _i < 2; ++_i) \
        __builtin_amdgcn_global_load_lds((const unsigned*)((const char*)(gbase) + (voff)[_i]), (PG8_LAS unsigned*)(lds + (bufoff) + ldsw + _i * 8192), 16, 0, 0); } while (0)
#define PG8_LDA(dst, b, h) do { _Pragma("unroll") for (int m = 0; m < 4; ++m) _Pragma("unroll") for (int k = 0; k < 2; ++k) dst[m][k] = *(const PG8_LAS bf16x8*)(lds + PG8_SA(b, h) + aoff + m * 2048 + k * 1024); } while (0)
#define PG8_LDB(dst, b, h) do { _Pragma("unroll") for (int n = 0; n < 2; ++n) _Pragma("unroll") for (int k = 0; k < 2; ++k) dst[n][k] = *(const PG8_LAS bf16x8*)(lds + PG8_SB(b, h) + boff + n * 2048 + k * 1024); } while (0)
#define PG8_MMA(ai, bj, At, Bt) do { __builtin_amdgcn_s_setprio(1); _Pragma("unroll") for (int m = 0; m < 4; ++m) _Pragma("unroll") for (int n = 0; n < 2; ++n) _Pragma("unroll") for (int k = 0; k < 2; ++k) \
        acc[ai][bj][m][n] = __builtin_amdgcn_mfma_f32_16x16x32_bf16(Bt[n][k], At[m][k], acc[ai][bj][m][n], 0, 0, 0); __builtin_amdgcn_s_setprio(0); } while (0)
#define PG8_WAIT_V(n) asm volatile("s_waitcnt vmcnt(" #n ")" ::: "memory")
#define PG8_WAIT_L(n) asm volatile("s_waitcnt lgkmcnt(" #n ")" ::: "memory")
#define PG8_BAR __builtin_amdgcn_s_barrier()
#define PG8_SCHED __builtin_amdgcn_sched_barrier(0)
    Unit cur, nxt; int ui = 0;
    if (!S.next(0, cur)) return;
    f32x4 acc[2][2][4][2];
#pragma unroll
    for (int a = 0; a < 2; ++a)
#pragma unroll
        for (int b = 0; b < 2; ++b)
#pragma unroll
            for (int m = 0; m < 4; ++m)
#pragma unroll
                for (int n = 0; n < 2; ++n) acc[a][b][m][n] = (f32x4){0.f, 0.f, 0.f, 0.f};
    bf16x8 At[4][2], B0[2][2], B1[2][2];
    const char* cA = (const char*)g.A + (GATHER ? (size_t)0 : (size_t)cur.pm * tstep); const char* cB = (const char*)g.Bt + (size_t)cur.pn * tstep;
    PG8_GOFFS(vGc, 0); PG8_GOFFS(vGn, 0);
    S.a_ready(cur);
    if constexpr (SP2) {
        PG8_STAGE(PG8_SB(0, 0), cB, voffB); PG8_STAGE(PG8_SB(0, 1), cB + hstep, voffB); PG8_STGA(PG8_SA(0, 0), cA, 0, false); PG8_STGA(PG8_SA(0, 1), cA, 1, false);
        if (wr == 1) PG8_BAR;
        PG8_WAIT_V(2); PG8_BAR;
        PG8_STAGE(PG8_SB(1, 0), cB + kstep, voffB); PG8_STGA(PG8_SA(1, 0), cA + kstep, 0, false); PG8_STAGE(PG8_SB(1, 1), cB + hstep + kstep, voffB);
        PG8_WAIT_V(6); PG8_BAR;
    } else {
        PG8_STAGE(PG8_SB(0, 0), cB, voffB); PG8_STAGE(PG8_SA(0, 0), cA, voffA); PG8_STAGE(PG8_SB(0, 1), cB + hstep, voffB); PG8_STAGE(PG8_SA(0, 1), cA + hstep, voffA);
        if (wr == 1) PG8_BAR;
        PG8_WAIT_V(4); PG8_BAR;
        PG8_STAGE(PG8_SB(1, 0), cB + kstep, voffB); PG8_STAGE(PG8_SA(1, 0), cA + kstep, voffA); PG8_STAGE(PG8_SB(1, 1), cB + hstep + kstep, voffB);
        PG8_WAIT_V(6); PG8_BAR;
    }
    for (;;) {
        const bool has_next = S.next(ui + 1, nxt);
        if (has_next) PG8_GOFFS(vGn, ui + 1);
        const char* nA = (has_next && !GATHER) ? (const char*)g.A + (size_t)nxt.pm * tstep : cA; const char* nB = has_next ? (const char*)g.Bt + (size_t)nxt.pn * tstep : cB;
        for (int t = 0; t < nt; t += 2) {
            if constexpr (Mid::ON) { if (t == Mid::T0 || t == Mid::T1) MH(acc, cur, t, wr, wc, fr, fq); }
            const bool last = (t == nt - 2);
            const char* a1 = cA + (size_t)(t + 1) * kstep;
            const char* a2 = last ? nA : cA + (size_t)(t + 2) * kstep; const char* b2 = last ? nB : cB + (size_t)(t + 2) * kstep;
            const char* a3 = a2 + kstep; const char* b3 = b2 + kstep;
            if (last && has_next) S.a_ready(nxt);
            if constexpr (SP2) {
            PG8_LDB(B0, 0, 0); PG8_LDB(B1, 0, 1); PG8_SCHED; PG8_LDA(At, 0, 0); PG8_STGA(PG8_SA(1, 1), a1, 1, false);
            PG8_WAIT_V(8); PG8_WAIT_L(0); PG8_BAR; PG8_MMA(0, 0, At, B0); PG8_MMA(0, 1, At, B1); PG8_BAR; PG8_SCHED;
            PG8_LDA(At, 0, 1); PG8_STAGE(PG8_SB(0, 0), b2, voffB); PG8_STAGE(PG8_SB(0, 1), b2 + hstep, voffB); PG8_STGA(PG8_SA(0, 0), a2, 0, last && has_next);
            PG8_WAIT_V(8); PG8_WAIT_L(0); PG8_BAR; PG8_MMA(1, 0, At, B0); PG8_MMA(1, 1, At, B1); PG8_BAR; PG8_SCHED;
            PG8_LDB(B0, 1, 0); PG8_LDB(B1, 1, 1); PG8_SCHED; PG8_LDA(At, 1, 0); PG8_STGA(PG8_SA(0, 1), a2, 1, last && has_next);
            PG8_WAIT_V(8); PG8_WAIT_L(0); PG8_BAR; PG8_MMA(0, 0, At, B0); PG8_MMA(0, 1, At, B1); PG8_BAR; PG8_SCHED;
            PG8_LDA(At, 1, 1); PG8_STAGE(PG8_SB(1, 0), b3, voffB); PG8_STAGE(PG8_SB(1, 1), b3 + hstep, voffB); PG8_STGA(PG8_SA(1, 0), a3, 0, last && has_next);
            PG8_WAIT_V(8); PG8_WAIT_L(0); PG8_BAR; PG8_MMA(1, 0, At, B0); PG8_MMA(1, 1, At, B1); PG8_BAR; PG8_SCHED;
            } else {
            PG8_LDB(B0, 0, 0); PG8_SCHED; PG8_LDA(At, 0, 0); PG8_STAGE(PG8_SA(1, 1), a1 + hstep, voffA);
            PG8_WAIT_L(8); PG8_BAR; PG8_WAIT_L(0); PG8_MMA(0, 0, At, B0); PG8_BAR; PG8_SCHED;
            PG8_LDB(B1, 0, 1); PG8_STAGE(PG8_SB(0, 0), b2, voffB);
            PG8_BAR; PG8_WAIT_L(0); PG8_MMA(0, 1, At, B1); PG8_BAR;
            PG8_LDA(At, 0, 1); PG8_STAGE(PG8_SA(0, 0), a2, voffA);
            PG8_BAR; PG8_WAIT_L(0); PG8_MMA(1, 0, At, B0); PG8_BAR; PG8_SCHED;
            PG8_STAGE(PG8_SB(0, 1), b2 + hstep, voffB);
            PG8_WAIT_V(6); PG8_BAR; PG8_MMA(1, 1, At, B1); PG8_BAR;
            PG8_LDB(B0, 1, 0); PG8_SCHED; PG8_LDA(At, 1, 0); PG8_STAGE(PG8_SA(0, 1), a2 + hstep, voffA);
            PG8_WAIT_L(8); PG8_BAR; PG8_WAIT_L(0); PG8_MMA(0, 0, At, B0); PG8_BAR; PG8_SCHED;
            PG8_LDB(B1, 1, 1); PG8_STAGE(PG8_SB(1, 0), b3, voffB);
            PG8_BAR; PG8_WAIT_L(0); PG8_MMA(0, 1, At, B1); PG8_BAR;
            PG8_LDA(At, 1, 1); PG8_STAGE(PG8_SA(1, 0), a3, voffA);
            PG8_BAR; PG8_WAIT_L(0); PG8_MMA(1, 0, At, B0); PG8_BAR; PG8_SCHED;
            PG8_STAGE(PG8_SB(1, 1), b3 + hstep, voffB);
            PG8_WAIT_V(6); PG8_BAR; PG8_MMA(1, 1, At, B1); PG8_BAR;
            }
        }
        if constexpr (ALIGN_EPI) { if (wr == 0) PG8_BAR; }
        if constexpr (!Epi::AFTER_DRAIN) { E(acc, cur, wr, wc, fr, fq); S.done(cur); }
        if (!has_next) break;
#pragma unroll
        for (int a = 0; a < 2; ++a)
#pragma unroll
            for (int b = 0; b < 2; ++b)
#pragma unroll
                for (int m = 0; m < 4; ++m)
#pragma unroll
                    for (int n = 0; n < 2; ++n) acc[a][b][m][n] = (f32x4){0.f, 0.f, 0.f, 0.f};
        cur = nxt; cA = nA; cB = nB; ++ui;
        if constexpr (GATHER) { _Pragma("unroll") for (int hh_ = 0; hh_ < 2; ++hh_) _Pragma("unroll") for (int i_ = 0; i_ < 2; ++i_) vGc[hh_][i_] = vGn[hh_][i_]; }
        if constexpr (ALIGN_EPI) { if (wr == 1) PG8_BAR; }
    }
    PG8_WAIT_V(0);
    if constexpr (!ALIGN_EPI) { if (wr == 0) PG8_BAR; }
    PG8_BAR;
    if constexpr (Epi::AFTER_DRAIN) { E.fused(acc, cur, wr, wc, fr, fq, lds, wid, lane); S.done(cur); }
#undef PG8_SA
#undef PG8_SB
#undef PG8_STAGE
#undef PG8_STGA
#undef PG8_GOFFS
#undef PG8_LDA
#undef PG8_LDB
#undef PG8_MMA
#undef PG8_WAIT_V
#undef PG8_WAIT_L
#undef PG8_BAR
#undef PG8_SCHED
}
}
#include <hip/hip_bf16.h>
#include <cmath>
namespace attn_body {
using bf16=__hip_bfloat16;
using bf16x8=__attribute__((ext_vector_type(8)))short;
using s16x4=__attribute__((ext_vector_type(4)))short;
using f32x16=__attribute__((ext_vector_type(16)))float;
using u32x4=__attribute__((ext_vector_type(4)))unsigned;
constexpr int D=64;
constexpr int NW=8,QBLK=32,QB=QBLK*NW,KVBLK=64;
constexpr int ATTN_UNIT_ROWS=QB;
__device__ __forceinline__ int crow(int r,int hi){return (r&3)+8*(r>>2)+4*hi;}
#define SBAR() __builtin_amdgcn_sched_barrier(0)
__device__ __forceinline__ void cmask(f32x16&p0,f32x16&p1,int jb,int qrel,int hi){
  const float NEG=-INFINITY; int kb=64*jb+4*hi;
  #pragma unroll
  for(int r=0;r<16;++r){int kv=kb+(r&3)+8*(r>>2); if(kv>qrel)p0[r]=NEG; if(kv+32>qrel)p1[r]=NEG;}
}

constexpr int NSLOT=3, SLOTB=8192;
constexpr int LDS_K=0, LDS_V=NSLOT*SLOTB, LDS_WS=2*NSLOT*SLOTB, LDS_OST=LDS_WS+NW*64*4, LDS_BYTES=LDS_OST+NW*4096;
constexpr float C2=0.125f*1.4426950408889634f;
__device__ __forceinline__ void glds16(const void*gsrc,unsigned lds_dst){unsigned keep;
  asm volatile("s_mov_b32 %0, m0\n\ts_mov_b32 m0, %2\n\ts_nop 0\n\tglobal_load_lds_dwordx4 %1, off\n\ts_mov_b32 m0, %0":"=&s"(keep):"v"(gsrc),"s"(lds_dst):"memory");}
__device__ __forceinline__ float max3f(float a,float b,float c){float r;asm("v_max3_f32 %0, %1, %2, %3":"=v"(r):"v"(a),"v"(b),"v"(c));return r;}
__device__ __forceinline__ float max2f(float a,float b){float r;asm("v_max_f32_e32 %0, %1, %2":"=v"(r):"v"(a),"v"(b));return r;}
__device__ __forceinline__ float fadd_s(float a,float b){float r;asm("v_add_f32_e32 %0, %1, %2":"=v"(r):"v"(a),"v"(b));return r;}
__device__ __forceinline__ float fsub_s(float a,float b){float r;asm("v_sub_f32_e32 %0, %1, %2":"=v"(r):"v"(a),"v"(b));return r;}
typedef float f32x2_t __attribute__((ext_vector_type(2))); typedef __bf16 bf16x2_t __attribute__((ext_vector_type(2)));
__device__ __forceinline__ unsigned cvtpk_s(float lo,float hi){f32x2_t v={lo,hi};bf16x2_t b=__builtin_convertvector(v,bf16x2_t);return __builtin_bit_cast(unsigned,b);}
#define WAIT_BAR(N) asm volatile("s_waitcnt vmcnt(" #N ") lgkmcnt(0)\n\ts_barrier":::"memory")

__device__ __forceinline__ void qkt(f32x16&p0,f32x16&p1,const char*Kslot,const bf16x8*qr,const f32x16&negm,int r32,int hi){
  const char*kb=Kslot+hi*1024+r32*16;
  #pragma unroll
  for(int d0=0;d0<4;++d0){
    const bf16x8 b0=*reinterpret_cast<const bf16x8*>(kb+d0*2048);
    const bf16x8 b1=*reinterpret_cast<const bf16x8*>(kb+d0*2048+512);
    if(d0==0){p0=__builtin_amdgcn_mfma_f32_32x32x16_bf16(b0,qr[0],negm,0,0,0);p1=__builtin_amdgcn_mfma_f32_32x32x16_bf16(b1,qr[0],negm,0,0,0);}
    else{p0=__builtin_amdgcn_mfma_f32_32x32x16_bf16(b0,qr[d0],p0,0,0,0);p1=__builtin_amdgcn_mfma_f32_32x32x16_bf16(b1,qr[d0],p1,0,0,0);}}
}
typedef __attribute__((address_space(3))) const char* lds_cptr;
typedef short v4i16_t __attribute__((ext_vector_type(4)));
__device__ __forceinline__ void kload8(bf16x8*kf,lds_cptr kp){
  kf[0]=*(const __attribute__((address_space(3))) bf16x8*)(kp);      kf[1]=*(const __attribute__((address_space(3))) bf16x8*)(kp+512);
  kf[2]=*(const __attribute__((address_space(3))) bf16x8*)(kp+2048); kf[3]=*(const __attribute__((address_space(3))) bf16x8*)(kp+2560);
  kf[4]=*(const __attribute__((address_space(3))) bf16x8*)(kp+4096); kf[5]=*(const __attribute__((address_space(3))) bf16x8*)(kp+4608);
  kf[6]=*(const __attribute__((address_space(3))) bf16x8*)(kp+6144); kf[7]=*(const __attribute__((address_space(3))) bf16x8*)(kp+6656);
}
__device__ __forceinline__ void kload2(bf16x8*kf,lds_cptr kp,int j){ kf[2*j]=*(const __attribute__((address_space(3))) bf16x8*)(kp+j*2048); kf[2*j+1]=*(const __attribute__((address_space(3))) bf16x8*)(kp+j*2048+512); }
__device__ __forceinline__ s16x4 vtr(lds_cptr p){ return __builtin_bit_cast(s16x4,__builtin_amdgcn_ds_read_tr16_b64_v4i16((__attribute__((address_space(3))) v4i16_t*)p)); }
__device__ __forceinline__ float rowmax(const f32x16&p0,const f32x16&p1){
  float a=max3f(p0[0],p0[1],p1[0]),b=max3f(p0[2],p0[3],p1[1]);a=max3f(a,p1[2],p1[3]);
  #pragma unroll
  for(int r=4;r<16;r+=4){a=max3f(a,p0[r],p0[r+1]);b=max3f(b,p0[r+2],p0[r+3]);a=max3f(a,p1[r],p1[r+1]);b=max3f(b,p1[r+2],p1[r+3]);}
  const float m=max2f(a,b);
  auto rr=__builtin_amdgcn_permlane32_swap(__float_as_uint(m),__float_as_uint(m),false,false);
  return max2f(__uint_as_float(rr[0]),__uint_as_float(rr[1]));
}
__device__ __forceinline__ void pv(f32x16*o,int vb,bf16x8 pa0,bf16x8 pa1,bf16x8 pa2,bf16x8 pa3){
  #pragma unroll
  for(int d0=0;d0<2;++d0){s16x4 lo[4],hi[4];
    #pragma unroll
    for(int ks=0;ks<4;++ks){
      asm volatile("ds_read_b64_tr_b16 %0,%1 offset:%c2":"=&v"(lo[ks]):"v"(vb),"i"(d0*4096+ks*1024):"memory");
      asm volatile("ds_read_b64_tr_b16 %0,%1 offset:%c2":"=&v"(hi[ks]):"v"(vb),"i"(d0*4096+ks*1024+512):"memory");}
    asm volatile("s_waitcnt lgkmcnt(0)":::"memory");SBAR();
    #define PK(k) (bf16x8){lo[k][0],lo[k][1],lo[k][2],lo[k][3],hi[k][0],hi[k][1],hi[k][2],hi[k][3]}
    o[d0]=__builtin_amdgcn_mfma_f32_32x32x16_bf16(pa0,PK(0),o[d0],0,0,0);
    o[d0]=__builtin_amdgcn_mfma_f32_32x32x16_bf16(pa1,PK(1),o[d0],0,0,0);
    o[d0]=__builtin_amdgcn_mfma_f32_32x32x16_bf16(pa2,PK(2),o[d0],0,0,0);
    o[d0]=__builtin_amdgcn_mfma_f32_32x32x16_bf16(pa3,PK(3),o[d0],0,0,0);
    #undef PK
  }
}

#ifndef ATTN_STORE16
#define ATTN_STORE16(p,v) (*(u32x4*)(p)=(v))
#endif
template<int THRL,bool CAUSAL> __device__ __forceinline__ void attn_unit(const bf16*Qu,const int pQ,const bf16*__restrict__ Kh,const bf16*__restrict__ Vh,const int pKV,bf16*Ou,const int pO,const int NT,char*shm,const int wv=0){
  int tid_=tid_of(wv); asm volatile("":"+v"(tid_));
  const int tid=tid_,lane=tid&63,r32=lane&31,hi=lane>>5; const int wid=__builtin_amdgcn_readfirstlane(tid>>6);
  const bf16*Qw=Qu+(long)(wid*QBLK)*pQ;
  const unsigned lds0=(unsigned)(uintptr_t)shm;
  float*wsf=(float*)(shm+LDS_WS)+wid*64;
  const bf16*ksrc=Kh+(long)lane*pKV+wid*8;
  const bf16*vsrc=Vh+(long)(16*(wid&3)+(lane>>2))*pKV+(wid>>2)*32+(lane&3)*8;
  const unsigned kdst=lds0+LDS_K+wid*1024, vdst=lds0+LDS_V+wid*1024;
  #define DMA_K(t,slot) glds16(ksrc+(long)(t)*KVBLK*pKV,(unsigned)__builtin_amdgcn_readfirstlane(kdst+(slot)))
  #define DMA_V(t,slot) glds16(vsrc+(long)(t)*KVBLK*pKV,(unsigned)__builtin_amdgcn_readfirstlane(vdst+(slot)))
  const int vb0=(int)(lds0+LDS_V)+((lane>>4)&1)*32+(lane&3)*8+(4*hi+((lane&15)>>2))*64;
  const char*Kbase=shm+LDS_K; bf16x8 kf[8];
  const lds_cptr shm3=(lds_cptr)shm; const lds_cptr kp0=shm3+LDS_K+hi*1024+r32*16; const lds_cptr vp0=shm3+LDS_V+((lane>>4)&1)*32+(lane&3)*8+(4*hi+((lane&15)>>2))*64;
  DMA_K(0,0);DMA_V(0,0);DMA_K(1,SLOTB);
  bf16x8 qr[4];
  #pragma unroll
  for(int d0=0;d0<4;++d0)qr[d0]=*reinterpret_cast<const bf16x8*>(&Qw[(long)r32*pQ+d0*16+hi*8]);
  float mhat=0.f,l_reg=0.f;f32x16 o[2];o[0]=f32x16{};o[1]=f32x16{};const f32x16 negm=f32x16{};
  const int qrel=wid*QBLK+r32;
  #define CMASK(P0,P1,t) do{ if(CAUSAL){int jb_=(t)-(NT-4); if(jb_>=0)cmask(P0,P1,jb_,qrel,hi);} }while(0)
  bool resc=false;
  #define START(P0,P1) do{ const float rm=rowmax(P0,P1); resc=false; \
    { const float dl=rm; mhat=fadd_s(mhat,dl); \
      _Pragma("unroll") for(int r=0;r<16;++r){P0[r]=fsub_s(P0[r],dl);P1[r]=fsub_s(P1[r],dl);} \
      } \
    _Pragma("unroll") for(int r=0;r<16;++r)P0[r]=__builtin_amdgcn_exp2f(P0[r]); }while(0)
  #define RESC() do{ if(resc){ asm volatile("s_waitcnt lgkmcnt(0)":::"memory"); \
      _Pragma("unroll") for(int d_=0;d_<2;++d_) _Pragma("unroll") for(int r=0;r<16;++r)o[d_][r]*=wsf[crow(r,hi)]; } }while(0)
  f32x16 pA0,pA1,pB0,pB1;
  int sl_prev=0,sl_cur=0,sl_next=SLOTB;
  #define ROT() do{sl_prev=sl_cur;sl_cur=sl_next;sl_next=(sl_next==(NSLOT-1)*SLOTB)?0:sl_next+SLOTB;}while(0)
  DMA_K(2,2*SLOTB);
  WAIT_BAR(3);
  qkt(pA0,pA1,Kbase,qr,negm,r32,hi);asm volatile("s_nop 15\n\ts_nop 7":"+v"(pA0),"+v"(pA1));CMASK(pA0,pA1,0);
  START(pA0,pA1);
  _Pragma("unroll") for(int r=0;r<16;++r)pA1[r]=__builtin_amdgcn_exp2f(pA1[r]);
  WAIT_BAR(0);
  DMA_K(3,0);DMA_V(1,SLOTB);
  ROT();
  kload8(kf,kp0+sl_cur);
  WAIT_BAR(2);
  s16x4 vlo[8],vhi[8]; u32x4 pw0,pw1,pw2,pw3;
  #define PKW(P,B) cvtpk_s(P[B],P[B+1])
  #define PAF(k) __builtin_bit_cast(bf16x8,pw##k)
  #define VFR(i) (bf16x8){vlo[i][0],vlo[i][1],vlo[i][2],vlo[i][3],vhi[i][0],vhi[i][1],vhi[i][2],vhi[i][3]}
  #define PIN(x) asm volatile("":"+v"(x))
  #define MX3(a,b,c) __builtin_fmaxf(__builtin_fmaxf((a),(b)),(c))
  #define GAPA(MF,A0,A1,A2,A3,W0,W1,PW) do{ MF; sacc+=A0; sacc+=A1; sacc+=A2; sacc+=A3; PIN(sacc); W0; W1; PIN(PW); SBAR(); }while(0)
  #define EX(v) __builtin_amdgcn_exp2f(v)
  #define GAPB(MF,X,B) do{ MF; X[B]=EX(X[B]); X[B+1]=EX(X[B+1]); X[B+2]=EX(X[B+2]); X[B+3]=EX(X[B+3]); PIN(X); SBAR(); }while(0)
  #define VRD(i) do{ vlo[i]=vtr(vp_+(((i)>>2)*4096+((i)&3)*1024)); vhi[i]=vtr(vp_+(((i)>>2)*4096+((i)&3)*1024+512)); }while(0)
  #define KRD(G,j) do{ if(G){ kload2(kf,kp0+sl_next,j); SBAR(); } }while(0)
  #define STEP(C0,C1,P0,P1,t,GK,GV,GL) do{ SBAR(); \
    const lds_cptr vp_=vp0+sl_prev; \
    VRD(0); SBAR(); float sacc=(P0[0]+P0[1]); \
    GAPA(C0=__builtin_amdgcn_mfma_f32_32x32x16_bf16(kf[0],qr[0],negm,0,0,0), P0[2],P0[3],P0[4],P0[5],     pw0[0]=PKW(P0,0), pw0[1]=PKW(P0,2), pw0); \
    VRD(4); SBAR(); GAPA(C1=__builtin_amdgcn_mfma_f32_32x32x16_bf16(kf[1],qr[0],negm,0,0,0), P0[6],P0[7],P0[8],P0[9],     pw0[2]=PKW(P0,4), pw0[3]=PKW(P0,6), pw0); \
    VRD(1); SBAR(); GAPA(C0=__builtin_amdgcn_mfma_f32_32x32x16_bf16(kf[2],qr[1],C0,0,0,0),   P0[10],P0[11],P0[12],P0[13], pw1[0]=PKW(P0,8), pw1[1]=PKW(P0,10), pw1); \
    VRD(5); SBAR(); GAPA(C1=__builtin_amdgcn_mfma_f32_32x32x16_bf16(kf[3],qr[1],C1,0,0,0),   P0[14],P0[15],P1[0],P1[1],   pw1[2]=PKW(P0,12),pw1[3]=PKW(P0,14), pw1); \
    VRD(2); SBAR(); GAPA(C0=__builtin_amdgcn_mfma_f32_32x32x16_bf16(kf[4],qr[2],C0,0,0,0),   P1[2],P1[3],P1[4],P1[5],     pw2[0]=PKW(P1,0), pw2[1]=PKW(P1,2), pw2); \
    VRD(6); SBAR(); GAPA(C1=__builtin_amdgcn_mfma_f32_32x32x16_bf16(kf[5],qr[2],C1,0,0,0),   P1[6],P1[7],P1[8],P1[9],     pw2[2]=PKW(P1,4), pw2[3]=PKW(P1,6), pw2); \
    VRD(3); SBAR(); GAPA(C0=__builtin_amdgcn_mfma_f32_32x32x16_bf16(kf[6],qr[3],C0,0,0,0),   P1[10],P1[11],P1[12],P1[13], pw3[0]=PKW(P1,8), pw3[1]=PKW(P1,10), pw3); \
    VRD(7); SBAR(); GAPA(C1=__builtin_amdgcn_mfma_f32_32x32x16_bf16(kf[7],qr[3],C1,0,0,0),   P1[14],P1[15],0.f,0.f,       pw3[2]=PKW(P1,12),pw3[3]=PKW(P1,14), pw3); \
    l_reg+=sacc; \
    if(GK){DMA_K((t)+3,sl_cur);} if(GV){DMA_V((t)+1,sl_next);} \
    CMASK(C0,C1,t); \
    _Pragma("unroll") for(int r=0;r<16;++r){C0[r]-=mhat;C1[r]-=mhat;} \
    { float a=MX3(C0[0],C0[1],C1[0]),b=MX3(C0[2],C0[3],C1[1]); a=MX3(a,C1[2],C1[3]); \
      _Pragma("unroll") for(int r=4;r<16;r+=4){a=MX3(a,C0[r],C0[r+1]);b=MX3(b,C0[r+2],C0[r+3]);a=MX3(a,C1[r],C1[r+1]);b=MX3(b,C1[r+2],C1[r+3]);} \
      float rm=__builtin_fmaxf(a,b); { auto rr=__builtin_amdgcn_permlane32_swap(__float_as_uint(rm),__float_as_uint(rm),false,false); rm=__builtin_fmaxf(__uint_as_float(rr[0]),__uint_as_float(rr[1])); } \
      resc=false; \
      if(__builtin_expect(__any(rm>(float)THRL),0)){ const float dl=__builtin_fmaxf(rm,0.f); mhat+=dl; \
        _Pragma("unroll") for(int r=0;r<16;++r){C0[r]-=dl;C1[r]-=dl;} \
        const float f=__builtin_amdgcn_exp2f(-dl); l_reg*=f; if(hi==0)wsf[r32]=f; resc=true; } } \
    SBAR(); \
    GAPB(o[0]=__builtin_amdgcn_mfma_f32_32x32x16_bf16(PAF(0),VFR(0),o[0],0,0,0), C0,0); \
    GAPB(o[1]=__builtin_amdgcn_mfma_f32_32x32x16_bf16(PAF(0),VFR(4),o[1],0,0,0), C0,4); \
    KRD(GL,0); GAPB(o[0]=__builtin_amdgcn_mfma_f32_32x32x16_bf16(PAF(1),VFR(1),o[0],0,0,0), C0,8); \
    KRD(GL,1); GAPB(o[1]=__builtin_amdgcn_mfma_f32_32x32x16_bf16(PAF(1),VFR(5),o[1],0,0,0), C0,12); \
    KRD(GL,2); GAPB(o[0]=__builtin_amdgcn_mfma_f32_32x32x16_bf16(PAF(2),VFR(2),o[0],0,0,0), C1,0); \
    KRD(GL,3); GAPB(o[1]=__builtin_amdgcn_mfma_f32_32x32x16_bf16(PAF(2),VFR(6),o[1],0,0,0), C1,4); \
    GAPB(o[0]=__builtin_amdgcn_mfma_f32_32x32x16_bf16(PAF(3),VFR(3),o[0],0,0,0), C1,8); \
    GAPB(o[1]=__builtin_amdgcn_mfma_f32_32x32x16_bf16(PAF(3),VFR(7),o[1],0,0,0), C1,12); \
    }while(0)
  int t=1;
  #undef CMASK
  #define CMASK(P0,P1,t) do{}while(0)
  for(;t+5<NT;t+=2){
    STEP(pB0,pB1,pA0,pA1,t,true,true,true);     WAIT_BAR(2); RESC(); ROT();
    STEP(pA0,pA1,pB0,pB1,t+1,true,true,true);   WAIT_BAR(2); RESC(); ROT();
  }
  #undef CMASK
  #define CMASK(P0,P1,t) do{ if(CAUSAL){int jb_=(t)-(NT-4); if(jb_>=0)cmask(P0,P1,jb_,qrel,hi);} }while(0)
  #define ENDW(tt) do{ if((tt)+3<NT){WAIT_BAR(2);} else if((tt)+2<NT){WAIT_BAR(1);} else {WAIT_BAR(0);} }while(0)
  for(;t+1<NT;t+=2){
    STEP(pB0,pB1,pA0,pA1,t,(t+3<NT),(t+1<NT),(t+1<NT));       ENDW(t);   RESC(); ROT();
    STEP(pA0,pA1,pB0,pB1,t+1,(t+4<NT),(t+2<NT),(t+2<NT));     ENDW(t+1); RESC(); ROT();
  }
  STEP(pB0,pB1,pA0,pA1,NT-1,false,false,false); RESC();
  { float sacc=pB0[0]+pB0[1]; _Pragma("unroll") for(int r=2;r<16;++r)sacc+=pB0[r]; _Pragma("unroll") for(int r=0;r<16;++r)sacc+=pB1[r]; l_reg+=sacc;
    pw0=(u32x4){PKW(pB0,0),PKW(pB0,2),PKW(pB0,4),PKW(pB0,6)};pw1=(u32x4){PKW(pB0,8),PKW(pB0,10),PKW(pB0,12),PKW(pB0,14)};pw2=(u32x4){PKW(pB1,0),PKW(pB1,2),PKW(pB1,4),PKW(pB1,6)};pw3=(u32x4){PKW(pB1,8),PKW(pB1,10),PKW(pB1,12),PKW(pB1,14)};
    SBAR(); pv(o,vb0+sl_cur,PAF(0),PAF(1),PAF(2),PAF(3)); }
  #undef PKW
  #undef PAF
  #undef VFR
  #undef PIN
  #undef MX3
  #undef GAPA
  #undef GAPB
  #undef EX
  #undef VRD
  #undef KRD
  #undef STEP
  #undef ENDW
  {auto rr=__builtin_amdgcn_permlane32_swap(__float_as_uint(l_reg),__float_as_uint(l_reg),false,false);l_reg=__uint_as_float(rr[0])+__uint_as_float(rr[1]);}
  if(hi==0)wsf[32+r32]=l_reg;asm volatile("s_waitcnt lgkmcnt(0)":::"memory");
  float rli[16];
  #pragma unroll
  for(int r=0;r<16;++r)rli[r]=__builtin_amdgcn_rcpf(wsf[32+crow(r,hi)]);
  bf16*Ow=Ou+(long)(wid*QBLK)*pO;
  { bf16*stg=(bf16*)(shm+LDS_OST)+wid*2048;
    #pragma unroll
    for(int r=0;r<16;++r){const int orow=crow(r,hi);
      #pragma unroll
      for(int d0=0;d0<2;++d0)stg[orow*64+d0*32+r32]=__float2bfloat16(o[d0][r]*rli[r]);}
    asm volatile("s_waitcnt lgkmcnt(0)":::"memory");
    #pragma unroll
    for(int i=0;i<4;++i){const int row=i*8+(lane>>3),ch=lane&7; const u32x4 v=*(const u32x4*)(stg+row*64+ch*8); ATTN_STORE16(Ow+(long)row*pO+ch*8,v);} }
  asm volatile("s_waitcnt lgkmcnt(0)\n\ts_barrier":::"memory");
  #undef DMA_K
  #undef DMA_V
  #undef CMASK
  #undef START
  #undef RESC
  #undef ROT
}
__device__ __forceinline__ void mem_attn(const int wv,const bf16*Q0,const int pQ,const bf16*__restrict__ Kh,const bf16*__restrict__ Vh,const int pKV,bf16*O0,const int pO,const int nqb,char*shm){
  int tid_=tid_of(wv); asm volatile("":"+v"(tid_));
  const int tid=tid_,lane=tid&63,r32=lane&31,hi=lane>>5; const int wid=__builtin_amdgcn_readfirstlane(tid>>6);
  constexpr int MK=0,MV=32768,MWS=65536,MOST=65536+2048;
  const unsigned lds0=(unsigned)(uintptr_t)shm;
  const bf16*ksrc=Kh+(long)lane*pKV+wid*8;
  const bf16*vsrc=Vh+(long)(16*(wid&3)+(lane>>2))*pKV+(wid>>2)*32+(lane&3)*8;
  #pragma unroll
  for(int t=0;t<4;++t){ glds16(ksrc+(long)t*KVBLK*pKV,(unsigned)__builtin_amdgcn_readfirstlane(lds0+MK+t*8192+wid*1024)); glds16(vsrc+(long)t*KVBLK*pKV,(unsigned)__builtin_amdgcn_readfirstlane(lds0+MV+t*8192+wid*1024)); }
  WAIT_BAR(0);
  const int vb0=(int)(lds0+MV)+((lane>>4)&1)*32+(lane&3)*8+(4*hi+((lane&15)>>2))*64;
  float*wsf=(float*)(shm+MWS)+wid*64;
  const f32x16 zero=f32x16{};
  for(int qb=0;qb<nqb;++qb){
    const bf16*Qw=Q0+(long)(qb*QB+wid*QBLK)*pQ;
    bf16x8 qr[4];
    #pragma unroll
    for(int d0=0;d0<4;++d0)qr[d0]=*reinterpret_cast<const bf16x8*>(&Qw[(long)r32*pQ+d0*16+hi*8]);
    f32x16 p[4][2];
    #pragma unroll
    for(int t=0;t<4;++t)qkt(p[t][0],p[t][1],shm+MK+t*8192,qr,zero,r32,hi);
    float m=p[0][0][0];
    #pragma unroll
    for(int t=0;t<4;++t)
      #pragma unroll
      for(int j=0;j<2;++j)
        #pragma unroll
        for(int r=0;r<16;++r)m=__builtin_fmaxf(m,p[t][j][r]);
    { auto rr=__builtin_amdgcn_permlane32_swap(__float_as_uint(m),__float_as_uint(m),false,false); m=__builtin_fmaxf(__uint_as_float(rr[0]),__uint_as_float(rr[1])); }
    float l=0.f;
    #pragma unroll
    for(int t=0;t<4;++t)
      #pragma unroll
      for(int j=0;j<2;++j)
        #pragma unroll
        for(int r=0;r<16;++r){ const float e=__builtin_amdgcn_exp2f(p[t][j][r]-m); p[t][j][r]=e; l+=e; }
    { auto rr=__builtin_amdgcn_permlane32_swap(__float_as_uint(l),__float_as_uint(l),false,false); l=__uint_as_float(rr[0])+__uint_as_float(rr[1]); }
    f32x16 o[2]; o[0]=f32x16{}; o[1]=f32x16{};
    #pragma unroll
    for(int t=0;t<4;++t){
      const u32x4 w0={cvtpk_s(p[t][0][0],p[t][0][1]),cvtpk_s(p[t][0][2],p[t][0][3]),cvtpk_s(p[t][0][4],p[t][0][5]),cvtpk_s(p[t][0][6],p[t][0][7])};
      const u32x4 w1={cvtpk_s(p[t][0][8],p[t][0][9]),cvtpk_s(p[t][0][10],p[t][0][11]),cvtpk_s(p[t][0][12],p[t][0][13]),cvtpk_s(p[t][0][14],p[t][0][15])};
      const u32x4 w2={cvtpk_s(p[t][1][0],p[t][1][1]),cvtpk_s(p[t][1][2],p[t][1][3]),cvtpk_s(p[t][1][4],p[t][1][5]),cvtpk_s(p[t][1][6],p[t][1][7])};
      const u32x4 w3={cvtpk_s(p[t][1][8],p[t][1][9]),cvtpk_s(p[t][1][10],p[t][1][11]),cvtpk_s(p[t][1][12],p[t][1][13]),cvtpk_s(p[t][1][14],p[t][1][15])};
      pv(o,vb0+t*8192,__builtin_bit_cast(bf16x8,w0),__builtin_bit_cast(bf16x8,w1),__builtin_bit_cast(bf16x8,w2),__builtin_bit_cast(bf16x8,w3)); }
    if(hi==0)wsf[32+r32]=l; asm volatile("s_waitcnt lgkmcnt(0)":::"memory");
    float rli[16];
    #pragma unroll
    for(int r=0;r<16;++r)rli[r]=__builtin_amdgcn_rcpf(wsf[32+crow(r,hi)]);
    bf16*Ow=O0+(long)(qb*QB+wid*QBLK)*pO;
    { bf16*stg=(bf16*)(shm+MOST)+wid*2048;
      #pragma unroll
      for(int r=0;r<16;++r){const int orow=crow(r,hi);
        #pragma unroll
        for(int d0=0;d0<2;++d0)stg[orow*64+d0*32+r32]=__float2bfloat16(o[d0][r]*rli[r]);}
      asm volatile("s_waitcnt lgkmcnt(0)":::"memory");
      #pragma unroll
      for(int i=0;i<4;++i){const int row=i*8+(lane>>3),ch=lane&7; const u32x4 v=*(const u32x4*)(stg+row*64+ch*8); ATTN_STORE16(Ow+(long)row*pO+ch*8,v);}
      asm volatile("s_waitcnt lgkmcnt(0)":::"memory"); }
  }
  asm volatile("s_waitcnt lgkmcnt(0)\n\ts_barrier":::"memory");
}
constexpr int ATTN_LDS_BYTES=LDS_BYTES;
#undef SBAR
#undef WAIT_BAR
}
namespace attn2 {
using bf16=__hip_bfloat16;
using bf16x8=__attribute__((ext_vector_type(8)))short;
using s16x4=__attribute__((ext_vector_type(4)))short;
using f32x16=__attribute__((ext_vector_type(16)))float;
using u32x4=__attribute__((ext_vector_type(4)))unsigned;
constexpr int D=64;
constexpr int NW=8,QBLK=32,QB=QBLK*NW,KVBLK=64;
constexpr int ATTN_UNIT_ROWS=QB;
__device__ __forceinline__ int crow(int r,int hi){return (r&3)+8*(r>>2)+4*hi;}
#define SBAR() __builtin_amdgcn_sched_barrier(0)
__device__ __forceinline__ void cmask(f32x16&p0,f32x16&p1,int jb,int qrel,int hi){
  const float NEG=-INFINITY; int kb=64*jb+4*hi;
  #pragma unroll
  for(int r=0;r<16;++r){int kv=kb+(r&3)+8*(r>>2); if(kv>qrel)p0[r]=NEG; if(kv+32>qrel)p1[r]=NEG;}
}

constexpr int NSLOT=3, SLOTB=8192;
constexpr int LDS_K=0, LDS_V=NSLOT*SLOTB, LDS_WS=3*NSLOT*SLOTB, LDS_OST=LDS_WS+NW*64*4, LDS_BYTES=LDS_OST+NW*4096;
constexpr float C2=0.125f*1.4426950408889634f;
__device__ __forceinline__ void glds16(const void*gsrc,unsigned lds_dst){unsigned keep;
  asm volatile("s_mov_b32 %0, m0\n\ts_mov_b32 m0, %2\n\ts_nop 0\n\tglobal_load_lds_dwordx4 %1, off\n\ts_mov_b32 m0, %0":"=&s"(keep):"v"(gsrc),"s"(lds_dst):"memory");}
__device__ __forceinline__ float max3f(float a,float b,float c){float r;asm("v_max3_f32 %0, %1, %2, %3":"=v"(r):"v"(a),"v"(b),"v"(c));return r;}
__device__ __forceinline__ float max2f(float a,float b){float r;asm("v_max_f32_e32 %0, %1, %2":"=v"(r):"v"(a),"v"(b));return r;}
__device__ __forceinline__ float fadd_s(float a,float b){float r;asm("v_add_f32_e32 %0, %1, %2":"=v"(r):"v"(a),"v"(b));return r;}
__device__ __forceinline__ float fsub_s(float a,float b){float r;asm("v_sub_f32_e32 %0, %1, %2":"=v"(r):"v"(a),"v"(b));return r;}
typedef float f32x2_t __attribute__((ext_vector_type(2))); typedef __bf16 bf16x2_t __attribute__((ext_vector_type(2)));
__device__ __forceinline__ unsigned cvtpk_s(float lo,float hi){f32x2_t v={lo,hi};bf16x2_t b=__builtin_convertvector(v,bf16x2_t);return __builtin_bit_cast(unsigned,b);}
#define WAIT_BAR(N) asm volatile("s_waitcnt vmcnt(" #N ") lgkmcnt(0)\n\ts_barrier":::"memory")

__device__ __forceinline__ void qkt(f32x16&p0,f32x16&p1,const char*Kslot,const bf16x8*qr,const f32x16&negm,int r32,int hi){
  const char*kb=Kslot+hi*1024+r32*16;
  #pragma unroll
  for(int d0=0;d0<4;++d0){
    const bf16x8 b0=*reinterpret_cast<const bf16x8*>(kb+d0*2048);
    const bf16x8 b1=*reinterpret_cast<const bf16x8*>(kb+d0*2048+512);
    if(d0==0){p0=__builtin_amdgcn_mfma_f32_32x32x16_bf16(b0,qr[0],negm,0,0,0);p1=__builtin_amdgcn_mfma_f32_32x32x16_bf16(b1,qr[0],negm,0,0,0);}
    else{p0=__builtin_amdgcn_mfma_f32_32x32x16_bf16(b0,qr[d0],p0,0,0,0);p1=__builtin_amdgcn_mfma_f32_32x32x16_bf16(b1,qr[d0],p1,0,0,0);}}
}
typedef __attribute__((address_space(3))) const char* lds_cptr;
typedef short v4i16_t __attribute__((ext_vector_type(4)));
__device__ __forceinline__ void kload8(bf16x8*kf,lds_cptr kp){
  kf[0]=*(const __attribute__((address_space(3))) bf16x8*)(kp);      kf[1]=*(const __attribute__((address_space(3))) bf16x8*)(kp+512);
  kf[2]=*(const __attribute__((address_space(3))) bf16x8*)(kp+2048); kf[3]=*(const __attribute__((address_space(3))) bf16x8*)(kp+2560);
  kf[4]=*(const __attribute__((address_space(3))) bf16x8*)(kp+4096); kf[5]=*(const __attribute__((address_space(3))) bf16x8*)(kp+4608);
  kf[6]=*(const __attribute__((address_space(3))) bf16x8*)(kp+6144); kf[7]=*(const __attribute__((address_space(3))) bf16x8*)(kp+6656);
}
__device__ __forceinline__ void kload2(bf16x8*kf,lds_cptr kp,int j){ kf[2*j]=*(const __attribute__((address_space(3))) bf16x8*)(kp+j*2048); kf[2*j+1]=*(const __attribute__((address_space(3))) bf16x8*)(kp+j*2048+512); }
__device__ __forceinline__ s16x4 vtr(lds_cptr p){ return __builtin_bit_cast(s16x4,__builtin_amdgcn_ds_read_tr16_b64_v4i16((__attribute__((address_space(3))) v4i16_t*)p)); }
__device__ __forceinline__ float rowmax(const f32x16&p0,const f32x16&p1){
  float a=max3f(p0[0],p0[1],p1[0]),b=max3f(p0[2],p0[3],p1[1]);a=max3f(a,p1[2],p1[3]);
  #pragma unroll
  for(int r=4;r<16;r+=4){a=max3f(a,p0[r],p0[r+1]);b=max3f(b,p0[r+2],p0[r+3]);a=max3f(a,p1[r],p1[r+1]);b=max3f(b,p1[r+2],p1[r+3]);}
  const float m=max2f(a,b);
  auto rr=__builtin_amdgcn_permlane32_swap(__float_as_uint(m),__float_as_uint(m),false,false);
  return max2f(__uint_as_float(rr[0]),__uint_as_float(rr[1]));
}
__device__ __forceinline__ void pv(f32x16*o,int vb,bf16x8 pa0,bf16x8 pa1,bf16x8 pa2,bf16x8 pa3){
  #pragma unroll
  for(int d0=0;d0<4;++d0){s16x4 lo[4],hi[4];
    #pragma unroll
    for(int ks=0;ks<4;++ks){
      asm volatile("ds_read_b64_tr_b16 %0,%1 offset:%c2":"=&v"(lo[ks]):"v"(vb),"i"(d0*4096+ks*1024):"memory");
      asm volatile("ds_read_b64_tr_b16 %0,%1 offset:%c2":"=&v"(hi[ks]):"v"(vb),"i"(d0*4096+ks*1024+512):"memory");}
    asm volatile("s_waitcnt lgkmcnt(0)":::"memory");SBAR();
    #define PK(k) (bf16x8){lo[k][0],lo[k][1],lo[k][2],lo[k][3],hi[k][0],hi[k][1],hi[k][2],hi[k][3]}
    o[d0]=__builtin_amdgcn_mfma_f32_32x32x16_bf16(pa0,PK(0),o[d0],0,0,0);
    o[d0]=__builtin_amdgcn_mfma_f32_32x32x16_bf16(pa1,PK(1),o[d0],0,0,0);
    o[d0]=__builtin_amdgcn_mfma_f32_32x32x16_bf16(pa2,PK(2),o[d0],0,0,0);
    o[d0]=__builtin_amdgcn_mfma_f32_32x32x16_bf16(pa3,PK(3),o[d0],0,0,0);
    #undef PK
  }
}

#ifndef ATTN_STORE16
#define ATTN_STORE16(p,v) (*(u32x4*)(p)=(v))
#endif
template<int THRL,bool CAUSAL,bool COMBINE=false> __device__ __forceinline__ void attn_unit(const bf16*Qu,const int pQ,const bf16*__restrict__ Kh,const bf16*__restrict__ Vh,const int pKV,const int wv,bf16*Ou,const int pO,const int NT,char*shm,const bf16*S0=nullptr,const int pS=0,const float lam=0.f,const float*sgp=nullptr){
  int tid_=tid_of(wv); asm volatile("":"+v"(tid_));
  const int tid=tid_,lane=tid&63,r32=lane&31,hi=lane>>5; const int wid=__builtin_amdgcn_readfirstlane(tid>>6);
  const bf16*Qw=Qu+(long)(wid*QBLK)*pQ;
  const unsigned lds0=(unsigned)(uintptr_t)shm;
  float*wsf=(float*)(shm+LDS_WS)+wid*64;
  const bf16*ksrc=Kh+(long)lane*pKV+wid*8;
  const bf16*vsrc=Vh+(long)(16*(wid&3)+(lane>>2))*pKV+(wid>>2)*32+(lane&3)*8;
  const unsigned kdst=lds0+LDS_K+wid*1024, vdst=lds0+LDS_V+wid*1024;
  #define DMA_K(t,slot) glds16(ksrc+(long)(t)*KVBLK*pKV,(unsigned)__builtin_amdgcn_readfirstlane(kdst+(slot)))
  #define DMA_V(t,slot) do{ glds16(vsrc+(long)(t)*KVBLK*pKV,(unsigned)__builtin_amdgcn_readfirstlane(vdst+2*(slot))); glds16(vsrc+(long)(t)*KVBLK*pKV+64,(unsigned)__builtin_amdgcn_readfirstlane(vdst+2*(slot)+8192)); }while(0)
  const int vb0=(int)(lds0+LDS_V)+((lane>>4)&1)*32+(lane&3)*8+(4*hi+((lane&15)>>2))*64;
  const char*Kbase=shm+LDS_K; bf16x8 kf[8];
  const lds_cptr shm3=(lds_cptr)shm; const lds_cptr kp0=shm3+LDS_K+hi*1024+r32*16; const lds_cptr vp0=shm3+LDS_V+((lane>>4)&1)*32+(lane&3)*8+(4*hi+((lane&15)>>2))*64;
  DMA_K(0,0);DMA_V(0,0);DMA_K(1,SLOTB);
  bf16x8 qr[4];
  #pragma unroll
  for(int d0=0;d0<4;++d0)qr[d0]=*reinterpret_cast<const bf16x8*>(&Qw[(long)r32*pQ+d0*16+hi*8]);
  float mhat=0.f,l_reg=0.f;f32x16 o[4];o[0]=f32x16{};o[1]=f32x16{};o[2]=f32x16{};o[3]=f32x16{};const f32x16 negm=f32x16{};
  const int qrel=wid*QBLK+r32;
  #define CMASK(P0,P1,t) do{ if(CAUSAL){int jb_=(t)-(NT-4); if(jb_>=0)cmask(P0,P1,jb_,qrel,hi);} }while(0)
  bool resc=false;
  #define START(P0,P1) do{ const float rm=rowmax(P0,P1); resc=false; \
    { const float dl=rm; mhat=fadd_s(mhat,dl); \
      _Pragma("unroll") for(int r=0;r<16;++r){P0[r]=fsub_s(P0[r],dl);P1[r]=fsub_s(P1[r],dl);} \
      } \
    _Pragma("unroll") for(int r=0;r<16;++r)P0[r]=__builtin_amdgcn_exp2f(P0[r]); }while(0)
  #define RESC() do{ if(resc){ asm volatile("s_waitcnt lgkmcnt(0)":::"memory"); \
      _Pragma("unroll") for(int d_=0;d_<4;++d_) _Pragma("unroll") for(int r=0;r<16;++r)o[d_][r]*=wsf[crow(r,hi)]; } }while(0)
  f32x16 pA0,pA1,pB0,pB1;
  int sl_prev=0,sl_cur=0,sl_next=SLOTB;
  #define ROT() do{sl_prev=sl_cur;sl_cur=sl_next;sl_next=(sl_next==(NSLOT-1)*SLOTB)?0:sl_next+SLOTB;}while(0)
  DMA_K(2,2*SLOTB);
  WAIT_BAR(4);
  qkt(pA0,pA1,Kbase,qr,negm,r32,hi);asm volatile("s_nop 15\n\ts_nop 7":"+v"(pA0),"+v"(pA1));CMASK(pA0,pA1,0);
  START(pA0,pA1);
  _Pragma("unroll") for(int r=0;r<16;++r)pA1[r]=__builtin_amdgcn_exp2f(pA1[r]);
  WAIT_BAR(0);
  DMA_K(3,0);DMA_V(1,SLOTB);
  ROT();
  kload8(kf,kp0+sl_cur);
  WAIT_BAR(3);
  s16x4 vlo[8],vhi[8]; u32x4 pw0,pw1,pw2,pw3;
  #define PKW(P,B) cvtpk_s(P[B],P[B+1])
  #define PAF(k) __builtin_bit_cast(bf16x8,pw##k)
  #define VFR(i) (bf16x8){vlo[i][0],vlo[i][1],vlo[i][2],vlo[i][3],vhi[i][0],vhi[i][1],vhi[i][2],vhi[i][3]}
  #define PIN(x) asm volatile("":"+v"(x))
  #define MX3(a,b,c) __builtin_fmaxf(__builtin_fmaxf((a),(b)),(c))
  #define GAPA(MF,A0,A1,A2,A3,W0,W1,PW) do{ MF; sacc+=A0; sacc+=A1; sacc+=A2; sacc+=A3; PIN(sacc); W0; W1; PIN(PW); SBAR(); }while(0)
  #define EX(v) __builtin_amdgcn_exp2f(v)
  #define GAPB(MF,X,B) do{ MF; X[B]=EX(X[B]); X[B+1]=EX(X[B+1]); X[B+2]=EX(X[B+2]); X[B+3]=EX(X[B+3]); PIN(X); SBAR(); }while(0)
  #define VRD(i) do{ vlo[i]=vtr(vp_+(((i)>>2)*4096+((i)&3)*1024)); vhi[i]=vtr(vp_+(((i)>>2)*4096+((i)&3)*1024+512)); }while(0)
  #define VRD2(i) do{ vlo[i]=vtr(vp_+((((i)>>2)+2)*4096+((i)&3)*1024)); vhi[i]=vtr(vp_+((((i)>>2)+2)*4096+((i)&3)*1024+512)); }while(0)
  #define GAPB2(MF,X,B) do{ MF; X[B]=EX(X[B]); X[B+1]=EX(X[B+1]); PIN(X); SBAR(); }while(0)
  #define KRD(G,j) do{ if(G){ kload2(kf,kp0+sl_next,j); SBAR(); } }while(0)
  #define STEP(C0,C1,P0,P1,t,GK,GV,GL) do{ SBAR(); \
    const lds_cptr vp_=vp0+2*sl_prev; \
    VRD(0); SBAR(); float sacc=(P0[0]+P0[1]); \
    GAPA(C0=__builtin_amdgcn_mfma_f32_32x32x16_bf16(kf[0],qr[0],negm,0,0,0), P0[2],P0[3],P0[4],P0[5],     pw0[0]=PKW(P0,0), pw0[1]=PKW(P0,2), pw0); \
    VRD(4); SBAR(); GAPA(C1=__builtin_amdgcn_mfma_f32_32x32x16_bf16(kf[1],qr[0],negm,0,0,0), P0[6],P0[7],P0[8],P0[9],     pw0[2]=PKW(P0,4), pw0[3]=PKW(P0,6), pw0); \
    VRD(1); SBAR(); GAPA(C0=__builtin_amdgcn_mfma_f32_32x32x16_bf16(kf[2],qr[1],C0,0,0,0),   P0[10],P0[11],P0[12],P0[13], pw1[0]=PKW(P0,8), pw1[1]=PKW(P0,10), pw1); \
    VRD(5); SBAR(); GAPA(C1=__builtin_amdgcn_mfma_f32_32x32x16_bf16(kf[3],qr[1],C1,0,0,0),   P0[14],P0[15],P1[0],P1[1],   pw1[2]=PKW(P0,12),pw1[3]=PKW(P0,14), pw1); \
    VRD(2); SBAR(); GAPA(C0=__builtin_amdgcn_mfma_f32_32x32x16_bf16(kf[4],qr[2],C0,0,0,0),   P1[2],P1[3],P1[4],P1[5],     pw2[0]=PKW(P1,0), pw2[1]=PKW(P1,2), pw2); \
    VRD(6); SBAR(); GAPA(C1=__builtin_amdgcn_mfma_f32_32x32x16_bf16(kf[5],qr[2],C1,0,0,0),   P1[6],P1[7],P1[8],P1[9],     pw2[2]=PKW(P1,4), pw2[3]=PKW(P1,6), pw2); \
    VRD(3); SBAR(); GAPA(C0=__builtin_amdgcn_mfma_f32_32x32x16_bf16(kf[6],qr[3],C0,0,0,0),   P1[10],P1[11],P1[12],P1[13], pw3[0]=PKW(P1,8), pw3[1]=PKW(P1,10), pw3); \
    VRD(7); SBAR(); GAPA(C1=__builtin_amdgcn_mfma_f32_32x32x16_bf16(kf[7],qr[3],C1,0,0,0),   P1[14],P1[15],0.f,0.f,       pw3[2]=PKW(P1,12),pw3[3]=PKW(P1,14), pw3); \
    l_reg+=sacc; \
    if(GK){DMA_K((t)+3,sl_cur);} if(GV){DMA_V((t)+1,sl_next);} \
    CMASK(C0,C1,t); \
    _Pragma("unroll") for(int r=0;r<16;++r){C0[r]-=mhat;C1[r]-=mhat;} \
    { float a=MX3(C0[0],C0[1],C1[0]),b=MX3(C0[2],C0[3],C1[1]); a=MX3(a,C1[2],C1[3]); \
      _Pragma("unroll") for(int r=4;r<16;r+=4){a=MX3(a,C0[r],C0[r+1]);b=MX3(b,C0[r+2],C0[r+3]);a=MX3(a,C1[r],C1[r+1]);b=MX3(b,C1[r+2],C1[r+3]);} \
      float rm=__builtin_fmaxf(a,b); { auto rr=__builtin_amdgcn_permlane32_swap(__float_as_uint(rm),__float_as_uint(rm),false,false); rm=__builtin_fmaxf(__uint_as_float(rr[0]),__uint_as_float(rr[1])); } \
      resc=false; \
      if(__builtin_expect(__any(rm>(float)THRL),0)){ const float dl=__builtin_fmaxf(rm,0.f); mhat+=dl; \
        _Pragma("unroll") for(int r=0;r<16;++r){C0[r]-=dl;C1[r]-=dl;} \
        const float f=__builtin_amdgcn_exp2f(-dl); l_reg*=f; if(hi==0)wsf[r32]=f; resc=true; } } \
    SBAR(); \
    GAPB2(o[0]=__builtin_amdgcn_mfma_f32_32x32x16_bf16(PAF(0),VFR(0),o[0],0,0,0), C0,0); VRD2(0); SBAR(); \
    GAPB2(o[1]=__builtin_amdgcn_mfma_f32_32x32x16_bf16(PAF(0),VFR(4),o[1],0,0,0), C0,2); VRD2(4); SBAR(); \
    KRD(GL,0); GAPB2(o[0]=__builtin_amdgcn_mfma_f32_32x32x16_bf16(PAF(1),VFR(1),o[0],0,0,0), C0,4); VRD2(1); SBAR(); \
    KRD(GL,1); GAPB2(o[1]=__builtin_amdgcn_mfma_f32_32x32x16_bf16(PAF(1),VFR(5),o[1],0,0,0), C0,6); VRD2(5); SBAR(); \
    KRD(GL,2); GAPB2(o[0]=__builtin_amdgcn_mfma_f32_32x32x16_bf16(PAF(2),VFR(2),o[0],0,0,0), C0,8); VRD2(2); SBAR(); \
    KRD(GL,3); GAPB2(o[1]=__builtin_amdgcn_mfma_f32_32x32x16_bf16(PAF(2),VFR(6),o[1],0,0,0), C0,10); VRD2(6); SBAR(); \
    GAPB2(o[0]=__builtin_amdgcn_mfma_f32_32x32x16_bf16(PAF(3),VFR(3),o[0],0,0,0), C0,12); VRD2(3); SBAR(); \
    GAPB2(o[1]=__builtin_amdgcn_mfma_f32_32x32x16_bf16(PAF(3),VFR(7),o[1],0,0,0), C0,14); VRD2(7); SBAR(); \
    GAPB2(o[2]=__builtin_amdgcn_mfma_f32_32x32x16_bf16(PAF(0),VFR(0),o[2],0,0,0), C1,0); \
    GAPB2(o[3]=__builtin_amdgcn_mfma_f32_32x32x16_bf16(PAF(0),VFR(4),o[3],0,0,0), C1,2); \
    GAPB2(o[2]=__builtin_amdgcn_mfma_f32_32x32x16_bf16(PAF(1),VFR(1),o[2],0,0,0), C1,4); \
    GAPB2(o[3]=__builtin_amdgcn_mfma_f32_32x32x16_bf16(PAF(1),VFR(5),o[3],0,0,0), C1,6); \
    GAPB2(o[2]=__builtin_amdgcn_mfma_f32_32x32x16_bf16(PAF(2),VFR(2),o[2],0,0,0), C1,8); \
    GAPB2(o[3]=__builtin_amdgcn_mfma_f32_32x32x16_bf16(PAF(2),VFR(6),o[3],0,0,0), C1,10); \
    GAPB2(o[2]=__builtin_amdgcn_mfma_f32_32x32x16_bf16(PAF(3),VFR(3),o[2],0,0,0), C1,12); \
    GAPB2(o[3]=__builtin_amdgcn_mfma_f32_32x32x16_bf16(PAF(3),VFR(7),o[3],0,0,0), C1,14); \
    }while(0)
  int t=1;
  #undef CMASK
  #define CMASK(P0,P1,t) do{}while(0)
  for(;t+5<NT;t+=2){
    STEP(pB0,pB1,pA0,pA1,t,true,true,true);     WAIT_BAR(3); RESC(); ROT();
    STEP(pA0,pA1,pB0,pB1,t+1,true,true,true);   WAIT_BAR(3); RESC(); ROT();
  }
  #undef CMASK
  #define CMASK(P0,P1,t) do{ if(CAUSAL){int jb_=(t)-(NT-4); if(jb_>=0)cmask(P0,P1,jb_,qrel,hi);} }while(0)
  #define ENDW(tt) do{ if((tt)+3<NT){WAIT_BAR(3);} else if((tt)+2<NT){WAIT_BAR(2);} else {WAIT_BAR(0);} }while(0)
  for(;t+1<NT;t+=2){
    STEP(pB0,pB1,pA0,pA1,t,(t+3<NT),(t+1<NT),(t+1<NT));       ENDW(t);   RESC(); ROT();
    STEP(pA0,pA1,pB0,pB1,t+1,(t+4<NT),(t+2<NT),(t+2<NT));     ENDW(t+1); RESC(); ROT();
  }
  STEP(pB0,pB1,pA0,pA1,NT-1,false,false,false); RESC();
  { float sacc=pB0[0]+pB0[1]; _Pragma("unroll") for(int r=2;r<16;++r)sacc+=pB0[r]; _Pragma("unroll") for(int r=0;r<16;++r)sacc+=pB1[r]; l_reg+=sacc;
    pw0=(u32x4){PKW(pB0,0),PKW(pB0,2),PKW(pB0,4),PKW(pB0,6)};pw1=(u32x4){PKW(pB0,8),PKW(pB0,10),PKW(pB0,12),PKW(pB0,14)};pw2=(u32x4){PKW(pB1,0),PKW(pB1,2),PKW(pB1,4),PKW(pB1,6)};pw3=(u32x4){PKW(pB1,8),PKW(pB1,10),PKW(pB1,12),PKW(pB1,14)};
    SBAR(); pv(o,vb0+2*sl_cur,PAF(0),PAF(1),PAF(2),PAF(3)); }
  #undef PKW
  #undef PAF
  #undef VFR
  #undef PIN
  #undef MX3
  #undef GAPA
  #undef GAPB
  #undef EX
  #undef VRD
  #undef VRD2
  #undef GAPB2
  #undef KRD
  #undef STEP
  #undef ENDW
  {auto rr=__builtin_amdgcn_permlane32_swap(__float_as_uint(l_reg),__float_as_uint(l_reg),false,false);l_reg=__uint_as_float(rr[0])+__uint_as_float(rr[1]);}
  if(hi==0)wsf[32+r32]=l_reg;asm volatile("s_waitcnt lgkmcnt(0)":::"memory");
  float rli[16];
  #pragma unroll
  for(int r=0;r<16;++r)rli[r]=__builtin_amdgcn_rcpf(wsf[32+crow(r,hi)]);
  bf16*Ow=Ou+(long)(wid*QBLK)*pO;
  { bf16*stg=(bf16*)(shm+LDS_OST)+wid*2048;
    const bf16*Sw=S0+(long)(wid*QBLK)*pS;
    float xs[2][4][8];
    #pragma unroll
    for(int hf=0;hf<2;++hf){
      #pragma unroll
      for(int r=0;r<16;++r){const int orow=crow(r,hi);
        #pragma unroll
        for(int d0=0;d0<2;++d0)stg[orow*64+d0*32+r32]=__float2bfloat16(o[2*hf+d0][r]*rli[r]);}
      asm volatile("s_waitcnt lgkmcnt(0)":::"memory");
      #pragma unroll
      for(int i=0;i<4;++i){const int row=i*8+(lane>>3),ch=lane&7; const u32x4 v=*(const u32x4*)(stg+row*64+ch*8);
        if constexpr(!COMBINE){ ATTN_STORE16(Ow+(long)row*pO+hf*64+ch*8,v); }
        else { const u32x4 a=*(const u32x4*)(Sw+(long)row*pS+hf*64+ch*8);
          #define BL(w) __uint_as_float((w)<<16)
          #define BH(w) __uint_as_float((w)&0xffff0000u)
          xs[hf][i][0]=BL(a.x)-lam*BL(v.x); xs[hf][i][1]=BH(a.x)-lam*BH(v.x); xs[hf][i][2]=BL(a.y)-lam*BL(v.y); xs[hf][i][3]=BH(a.y)-lam*BH(v.y);
          xs[hf][i][4]=BL(a.z)-lam*BL(v.z); xs[hf][i][5]=BH(a.z)-lam*BH(v.z); xs[hf][i][6]=BL(a.w)-lam*BL(v.w); xs[hf][i][7]=BH(a.w)-lam*BH(v.w);
          #undef BL
          #undef BH
        } }
      asm volatile("s_waitcnt lgkmcnt(0)":::"memory"); }
    if constexpr(COMBINE){
      float sg[16];
      #pragma unroll
      for(int q=0;q<16;++q)sg[q]=sgp[(q>>3)*64+(lane&7)*8+(q&7)]*0.8f;
      #pragma unroll
      for(int i=0;i<4;++i){ const int row=i*8+(lane>>3),ch=lane&7; float ss=0.f;
        #pragma unroll
        for(int hf=0;hf<2;++hf)
          #pragma unroll
          for(int q=0;q<8;++q)ss+=xs[hf][i][q]*xs[hf][i][q];
        ss+=__shfl_xor(ss,1);ss+=__shfl_xor(ss,2);ss+=__shfl_xor(ss,4);
        const float rn=1.f/sqrtf(ss*(1.f/128.f)+1e-6f);
        #pragma unroll
        for(int hf=0;hf<2;++hf){ u32x4 w;
          w.x=cvtpk_s(xs[hf][i][0]*rn*sg[hf*8+0],xs[hf][i][1]*rn*sg[hf*8+1]); w.y=cvtpk_s(xs[hf][i][2]*rn*sg[hf*8+2],xs[hf][i][3]*rn*sg[hf*8+3]);
          w.z=cvtpk_s(xs[hf][i][4]*rn*sg[hf*8+4],xs[hf][i][5]*rn*sg[hf*8+5]); w.w=cvtpk_s(xs[hf][i][6]*rn*sg[hf*8+6],xs[hf][i][7]*rn*sg[hf*8+7]);
          ATTN_STORE16(Ow+(long)row*pO+hf*64+ch*8,w); } } } }
  asm volatile("s_waitcnt lgkmcnt(0)\n\ts_barrier":::"memory");
  #undef DMA_K
  #undef DMA_V
  #undef CMASK
  #undef START
  #undef RESC
  #undef ROT
}
constexpr int ATTN_LDS_BYTES=LDS_BYTES;
#undef SBAR
#undef WAIT_BAR
}

constexpr int NWAVES = 8;
#ifndef MK_N_LAUNCHES
#define MK_N_LAUNCHES 1
#endif
constexpr int NPH = 10;
constexpr int BATCH = 32, SEQ = 2048, D = 1024, T = BATCH * SEQ, NMEM = 256, TM = BATCH * NMEM;
constexpr int INCOLS = 5120, PROJW = 2048, GATEW = 3072;
constexpr float RMS_EPS = 1e-6f;
constexpr int NEXP = 16, EH = 512;
constexpr int MAXROWS = 2 * T + NEXP * 256;
constexpr size_t MiB = 1u << 20;
constexpr size_t WS_CTL = 0, CTL_ZERO_BYTES = 64 * 1024;
constexpr size_t WS_WRF = 1 * MiB;
constexpr size_t WS_RINV = 1 * MiB + 128 * 1024;
constexpr size_t WS_WIN = 2 * MiB;
constexpr size_t WS_PC = 13 * MiB;
constexpr size_t WS_WO = 15 * MiB;
constexpr size_t WS_WGU = 17 * MiB;
constexpr size_t WS_WD = 49 * MiB;
constexpr size_t WS_ROUTE = 65 * MiB;
constexpr size_t WS_KV = 68 * MiB;
constexpr size_t WS_XN = 76 * MiB;
constexpr size_t WS_BR = 76 * MiB;
constexpr size_t WS_H2 = 76 * MiB;
constexpr size_t WS_PROJ = 220 * MiB;
constexpr size_t WS_MERGED = 220 * MiB;
constexpr size_t WS_MIX = 348 * MiB;
constexpr size_t WS_HID = 220 * MiB;
constexpr size_t WS_ATTO = 476 * MiB;
constexpr size_t WS_GATES = 604 * MiB;
constexpr size_t WS_LIST = 476 * MiB;
constexpr size_t WS_RWE = 480 * MiB;
constexpr size_t WS_Y = 604 * MiB;
constexpr size_t WS_END = 988 * MiB;
static_assert(WS_XN + (size_t)(T + TM) * D * 2 <= WS_PROJ && WS_PROJ + (size_t)T * PROJW * 2 <= WS_ATTO && WS_ATTO + (size_t)T * D * 2 <= WS_GATES && WS_GATES + (size_t)T * GATEW * 2 <= WS_END, "ws map");
static_assert(WS_Y + (size_t)MAXROWS * D * 2 <= WS_END && WS_HID + (size_t)MAXROWS * EH * 2 <= WS_ATTO && WS_RWE + (size_t)NEXP * 65536 * 8 <= WS_GATES, "ws map 2");
constexpr int CW_CNT = 64;
constexpr int RING_OFF = 0, RING_BYTES = 131072;
constexpr int LDSX_OFF = RING_BYTES;
constexpr int LDS_BYTES = 147456;

#define GAS __attribute__((address_space(1)))
#define LAS __attribute__((address_space(3)))
typedef unsigned short bf16;
typedef unsigned v4u __attribute__((ext_vector_type(4)));
typedef unsigned v2u __attribute__((ext_vector_type(2)));
typedef float f32x4 __attribute__((ext_vector_type(4)));
#define LDS_WAIT() asm volatile("s_waitcnt lgkmcnt(0)" ::: "memory")
__device__ __forceinline__ unsigned f2bf(float f) { unsigned u = __builtin_bit_cast(unsigned, f); return (u + 0x7fffu + ((u >> 16) & 1u)) >> 16; }
__device__ __forceinline__ unsigned pk2(float lo, float hi) { return f2bf(lo) | (f2bf(hi) << 16); }
typedef float f32x2_t __attribute__((ext_vector_type(2))); typedef __bf16 bf16x2_t __attribute__((ext_vector_type(2)));
typedef short bf16x8_t __attribute__((ext_vector_type(8))); typedef float f32x16_t __attribute__((ext_vector_type(16)));
__device__ __forceinline__ unsigned cvtpk(float lo, float hi) { f32x2_t v = {lo, hi}; bf16x2_t b = __builtin_convertvector(v, bf16x2_t); return __builtin_bit_cast(unsigned, b); }
__device__ __forceinline__ float bflo(unsigned w) { return __uint_as_float(w << 16); }
__device__ __forceinline__ float bfhi(unsigned w) { return __uint_as_float(w & 0xffff0000u); }
__device__ __forceinline__ float wave_sum(float v) {
#pragma unroll
    for (int o = 1; o < 64; o <<= 1) v += __shfl_xor(v, o);
    return v;
}

typedef GAS unsigned gu32;
#define RLX_AGENT __ATOMIC_RELAXED, __HIP_MEMORY_SCOPE_AGENT
constexpr int CW_BAR = 4096;
constexpr int CW_TS = 128;
#define XB_TMO      128
#define XB_XCNT(j)  (256  + 64 * (j))
#define XB_XSUB(j)  (1280 + 64 * (j))
#define XB_XGEN(j)  (2304 + 64 * (j))
#define XB_TOP      3328
#define XB_TOPGEN   3392
#define XCD_BAR_WORDS 3456
#define XB_SPIN_CAP (1u << 18)

__device__ __forceinline__ unsigned xb_ld(unsigned* p)              { return __hip_atomic_load(p, __ATOMIC_RELAXED, __HIP_MEMORY_SCOPE_AGENT); }
__device__ __forceinline__ unsigned xb_add(unsigned* p, unsigned v) { return __hip_atomic_fetch_add(p, v, __ATOMIC_RELAXED, __HIP_MEMORY_SCOPE_AGENT); }
__device__ __forceinline__ unsigned xb_xcc_id() { return (unsigned)__builtin_amdgcn_s_getreg((3 << 11) | 20) & 0xFu; }
#define XB_SPIN(cond, bar) do { unsigned _sp = 0; while (cond) { __builtin_amdgcn_s_sleep(1); \
    if ((++_sp & 255u) == 0u) { if (xb_ld(&(bar)[XB_TMO])) break; if (_sp > XB_SPIN_CAP) { atomicAdd(&(bar)[XB_TMO], 1u); break; } } } } while (0)

struct XcdBarrier {
    unsigned* bar; unsigned x;
    volatile LAS unsigned* st;
};

__device__ __forceinline__ XcdBarrier xcd_barrier_post(unsigned* bar, volatile LAS unsigned* st) {
    XcdBarrier b; b.bar = bar; b.x = xb_xcc_id(); b.st = st;
    if (threadIdx.x == 0) (void)xb_add(&bar[XB_XCNT(b.x)], 1u);
    return b;
}
__device__ __forceinline__ void xcd_barrier_complete(unsigned* bar, unsigned x, unsigned& nloc, unsigned& nx) {
    const unsigned G = gridDim.x * gridDim.y * gridDim.z;
    unsigned sum, cnt, mine, sp = 0u;
    for (;;) {
        sum = 0u; cnt = 0u; mine = 0u;
#pragma unroll
        for (unsigned j = 0; j < 16; ++j) { const unsigned c = xb_ld(&bar[XB_XCNT(j)]); sum += c; cnt += (c > 0u) ? 1u : 0u; mine = (j == x) ? c : mine; }
        if (sum == G) break;
        __builtin_amdgcn_s_sleep(1);
        if ((++sp & 255u) == 0u) { if (xb_ld(&bar[XB_TMO])) break; if (sp > XB_SPIN_CAP) { atomicAdd(&bar[XB_TMO], 1u); break; } }
    }
    nloc = mine > 0u ? mine : 1u; nx = cnt > 0u ? cnt : 1u;
}

__device__ __forceinline__ void xcd_barrier(const XcdBarrier& b, const bool leader) {
    asm volatile("s_waitcnt vmcnt(0)" ::: "memory");
    __syncthreads();
    if (leader) {
        unsigned* bar = b.bar;
        __builtin_amdgcn_s_waitcnt(0);
        unsigned nloc = b.st[0], nx = b.st[1];
        if (nloc == 0u) { xcd_barrier_complete(bar, b.x, nloc, nx); b.st[0] = nloc; b.st[1] = nx; }
        const unsigned old = xb_add(&bar[XB_XSUB(b.x)], 1u);
        const unsigned gen = old / nloc;
        if (old + 1u == (gen + 1u) * nloc) {
            __builtin_amdgcn_fence(__ATOMIC_RELEASE, "agent");
            asm volatile("s_waitcnt vmcnt(0)" ::: "memory");
            const unsigned og = xb_add(&bar[XB_TOP], 1u);
            const unsigned tg = og / nx;
            if (og + 1u == (tg + 1u) * nx) xb_add(&bar[XB_TOPGEN], 1u);
            else XB_SPIN(xb_ld(&bar[XB_TOPGEN]) == tg, bar);
            __builtin_amdgcn_fence(__ATOMIC_ACQUIRE, "agent");
            xb_add(&bar[XB_XGEN(b.x)], 1u);
            asm volatile("s_waitcnt vmcnt(0)" ::: "memory");
        } else {
            XB_SPIN(xb_ld(&bar[XB_XGEN(b.x)]) == gen, bar);
            __builtin_amdgcn_fence(__ATOMIC_ACQUIRE, "agent");
            asm volatile("s_waitcnt vmcnt(0)" ::: "memory");
        }
    }
    __syncthreads();
}

struct Frame {
    LAS unsigned char* lds;
    unsigned* ctl;
    int vcu, G;
};

__device__ __forceinline__ void p0_tile(const float* W, int N, int k0, int n0, bf16* WT, int Kd, int drow0, LAS float* scr, int lane, const float* gk = nullptr) {
    f32x4 w[8];
#pragma unroll
    for (int i = 0; i < 8; ++i) w[i] = *(const GAS f32x4*)(W + (size_t)(k0 + i * 8 + (lane >> 3)) * N + n0 + (lane & 7) * 4);
    if (gk) {
#pragma unroll
        for (int i = 0; i < 8; ++i) w[i] = w[i] * gk[k0 + i * 8 + (lane >> 3)]; }
#pragma unroll
    for (int i = 0; i < 8; ++i) { LAS float* d = scr + (i * 8 + (lane >> 3)) * 33 + (lane & 7) * 4; d[0] = w[i].x; d[1] = w[i].y; d[2] = w[i].z; d[3] = w[i].w; }
    LDS_WAIT(); asm volatile("" ::: "memory");
    const int c = lane & 7;
#pragma unroll
    for (int j = 0; j < 4; ++j) { const int n = (lane >> 3) + 8 * j; const LAS float* s = scr + (8 * c) * 33 + n;
        v4u o; o.x = pk2(s[0 * 33], s[1 * 33]); o.y = pk2(s[2 * 33], s[3 * 33]); o.z = pk2(s[4 * 33], s[5 * 33]); o.w = pk2(s[6 * 33], s[7 * 33]);
        *(GAS v4u*)(WT + (size_t)(drow0 + n) * Kd + k0 + 8 * c) = o; }
    LDS_WAIT(); asm volatile("" ::: "memory");
}
__device__ __forceinline__ void p0_plain(const float* W, int K, int N, bf16* WT, int row_off, int item, LAS float* scr, int lane) {
    const int nblk = N / 32, kb = item / nblk, nb = item % nblk;
    p0_tile(W, N, 64 * kb, 32 * nb, WT, K, row_off + 32 * nb, scr, lane);
}
__device__ __forceinline__ void rms_row_to_bf16(const float* xrow, const float* g, bf16* orow, int lane) {
    const GAS f32x4* xr = (const GAS f32x4*)xrow + lane; const GAS f32x4* gr = (const GAS f32x4*)g + lane;
    f32x4 v[4]; float s = 0.f;
#pragma unroll
    for (int j = 0; j < 4; ++j) { v[j] = xr[64 * j]; s += (v[j].x * v[j].x + v[j].y * v[j].y) + (v[j].z * v[j].z + v[j].w * v[j].w); }
    const float r = 1.f / sqrtf(wave_sum(s) * (1.f / D) + RMS_EPS);
    GAS unsigned long long* o8 = (GAS unsigned long long*)orow + lane;
#pragma unroll
    for (int j = 0; j < 4; ++j) { const f32x4 gg = gr[64 * j]; const f32x4 h = v[j] * r * gg;
        o8[64 * j] = (unsigned long long)pk2(h.x, h.y) | ((unsigned long long)pk2(h.z, h.w) << 32); }
}

__device__ __forceinline__ void rms_rows_stream(const float* src1, const float* g1, const float* src2, const float* g2, int nT, int nAll, bf16* dst, int m0, int mstep, int lane) {
    f32x4 cur[4][4], nxt[4][4];
    if (m0 >= nAll) return;
    { const GAS f32x4* xr = (const GAS f32x4*)((m0 < nT ? src1 + (size_t)m0 * D : src2 + (size_t)(m0 - nT) * D)) + lane;
#pragma unroll
      for (int q = 0; q < 4; ++q)
#pragma unroll
          for (int j = 0; j < 4; ++j) cur[q][j] = xr[q * 256 + 64 * j]; }
    for (int m = m0; m < nAll; m += mstep) {
        const int mn = m + mstep; const bool has = mn < nAll; const int ml = has ? mn : m;
        { const GAS f32x4* xr = (const GAS f32x4*)((ml < nT ? src1 + (size_t)ml * D : src2 + (size_t)(ml - nT) * D)) + lane;
#pragma unroll
          for (int q = 0; q < 4; ++q)
#pragma unroll
              for (int j = 0; j < 4; ++j) nxt[q][j] = xr[q * 256 + 64 * j]; }
        float s[4];
#pragma unroll
        for (int q = 0; q < 4; ++q) { s[q] = 0.f;
#pragma unroll
            for (int j = 0; j < 4; ++j) s[q] += (cur[q][j].x * cur[q][j].x + cur[q][j].y * cur[q][j].y) + (cur[q][j].z * cur[q][j].z + cur[q][j].w * cur[q][j].w); }
#pragma unroll
        for (int o = 1; o < 64; o <<= 1) {
#pragma unroll
            for (int q = 0; q < 4; ++q) s[q] += __shfl_xor(s[q], o); }
        const GAS f32x4* gr = (const GAS f32x4*)(m < nT ? g1 : g2) + lane;
        f32x4 gg[4];
#pragma unroll
        for (int j = 0; j < 4; ++j) gg[j] = gr[64 * j];
#pragma unroll
        for (int q = 0; q < 4; ++q) { const float r = 1.f / sqrtf(s[q] * (1.f / D) + RMS_EPS);
            GAS unsigned long long* o8 = (GAS unsigned long long*)(dst + (size_t)(m + q) * D) + lane;
#pragma unroll
            for (int j = 0; j < 4; ++j) { const f32x4 h = cur[q][j] * r * gg[j]; o8[64 * j] = (unsigned long long)pk2(h.x, h.y) | ((unsigned long long)pk2(h.z, h.w) << 32); } }
#pragma unroll
        for (int q = 0; q < 4; ++q)
#pragma unroll
            for (int j = 0; j < 4; ++j) cur[q][j] = nxt[q][j];
    }
}

__device__ __forceinline__ void build_tile_tables(Frame& F, const int tid) {
    LAS int* TB = (LAS int*)(F.lds + LDSX_OFF); LAS unsigned char* t2e = F.lds + LDSX_OFF + 128;
    __syncthreads();
    if (tid == 0) { int acc = 0;
        for (int e = 0; e < NEXP; ++e) { const int n = (int)__hip_atomic_load(F.ctl + CW_CNT + e, __ATOMIC_RELAXED, __HIP_MEMORY_SCOPE_AGENT); TB[e] = acc; acc += (n + 255) >> 8; }
        TB[NEXP] = acc; }
    __syncthreads();
    for (int t = tid; t < 1024; t += NWAVES * 64) { int e = 0;
#pragma unroll
        for (int k = 1; k < NEXP; ++k) e += (t >= TB[k]) ? 1 : 0;
        t2e[t] = (unsigned char)e; }
    __syncthreads();
}

struct Args { const float* in[26]; float* out; unsigned char* ws; int ph_lo, ph_hi; };

__global__ void __launch_bounds__(NWAVES * 64, 2) hybrid_fwd(Args args) {
    extern __shared__ __attribute__((aligned(16))) unsigned char lds[];
    __builtin_assume(__builtin_amdgcn_workitem_id_y() == 0); __builtin_assume(__builtin_amdgcn_workitem_id_z() == 0);
    Frame F;
    F.lds = (LAS unsigned char*)lds;
    F.G = gridDim.x; { const int bx = blockIdx.x; F.vcu = (F.G % 8 == 0) ? (bx % 8) * (F.G / 8) + bx / 8 : bx; }
    F.ctl = (unsigned*)(args.ws + WS_CTL);
#define x_in (args.in[0])
#define mem_in (args.in[1])
#define norm_mix_g (args.in[2])
#define w_in (args.in[3])
#define pool_w (args.in[4])
#define pool_scale (args.in[5])
#define lam_q1 (args.in[6])
#define lam_k1 (args.in[7])
#define lam_q2 (args.in[8])
#define lam_k2 (args.in[9])
#define subln_g (args.in[10])
#define norm_mem_g (args.in[11])
#define w_mem_kv (args.in[12])
#define p_pool (args.in[13])
#define p_diff (args.in[14])
#define p_mem (args.in[15])
#define w_o (args.in[16])
#define norm_ffn_g (args.in[17])
#define w_rg (args.in[18])
#define b_rg (args.in[19])
#define w_re (args.in[20])
#define b_re (args.in[21])
#define w_eg (args.in[22])
#define w_eu (args.in[23])
#define w_ed (args.in[24])
#define final_g (args.in[25])
#define Win_t ((bf16*)(args.ws + WS_WIN))
#define Pc_t ((bf16*)(args.ws + WS_PC))
#define Wo_t ((bf16*)(args.ws + WS_WO))
#define Wgu_t ((bf16*)(args.ws + WS_WGU))
#define Wd_t ((bf16*)(args.ws + WS_WD))
#define KV ((bf16*)(args.ws + WS_KV))
#define XN ((bf16*)(args.ws + WS_XN))
#define BR ((bf16*)(args.ws + WS_BR))
#define H2 ((bf16*)(args.ws + WS_H2))
#define PROJ ((bf16*)(args.ws + WS_PROJ))
#define MERGED ((bf16*)(args.ws + WS_MERGED))
#define MIX ((bf16*)(args.ws + WS_MIX))
#define HID ((bf16*)(args.ws + WS_HID))
#define ATTO ((bf16*)(args.ws + WS_ATTO))
#define GATES ((bf16*)(args.ws + WS_GATES))
#define Y ((bf16*)(args.ws + WS_Y))
#define ROUTE ((v4u*)(args.ws + WS_ROUTE))
#define RWE ((float*)(args.ws + WS_RWE))
#define LIST ((int*)(args.ws + WS_LIST))
#define WRF ((bf16*)(args.ws + WS_WRF))
#define RINV ((float*)(args.ws + WS_RINV))
#define X1 (args.out)
    const int NGW = F.G * NWAVES;
#define PHASE_IDS int tid = tid_of(wv); asm volatile("" : "+v"(tid)); const int lane = tid & 63, wave = __builtin_amdgcn_readfirstlane(tid >> 6), gw = F.vcu * NWAVES + wave; (void)lane; (void)gw;
    const int lo = args.ph_lo, hi = args.ph_hi;
    cg::grid_group grid = cg::this_grid();
#ifndef PH_MASK
#define PH_MASK 0x3ff
#endif
#define IN(k) (((PH_MASK >> (k)) & 1) && lo <= (k) && (k) < hi)
#ifndef PROBE_A
#define PROBE_A -1
#endif
#ifndef PROBE_B
#define PROBE_B -1
#endif
#ifndef PROBE_A2
#define PROBE_A2 (PROBE_A + 1)
#endif
#ifndef PROBE_B2
#define PROBE_B2 (PROBE_B + 1)
#endif
#define STAMP(k) do { if ((PROBE_A >= 0 || PROBE_B >= 0) && blockIdx.x == 0 && tid_of(wv) == 0) ((unsigned long long*)(F.ctl + CW_TS))[k] = __builtin_amdgcn_s_memrealtime(); } while (0)
#define SEAM(k) do { if (IN(k) && IN((k) + 1)) { { XcdBarrier b_; b_.bar = (unsigned*)(args.ws + WS_CTL) + CW_BAR; b_.x = xb_xcc_id(); b_.st = (volatile LAS unsigned*)(F.lds + LDSX_OFF + 2048); xcd_barrier(b_, tid_of(wv) == 0); } } STAMP((k) + 1); } while (0)
    const int wv = __builtin_amdgcn_readfirstlane((int)threadIdx.x >> 6);
    if (hi > NPH) grid.sync();
    if (threadIdx.x < 2) ((LAS unsigned*)(F.lds + LDSX_OFF + 2048))[threadIdx.x] = 0u;
    __syncthreads();
    if (lo < hi - 1) (void)xcd_barrier_post((unsigned*)(args.ws + WS_CTL) + CW_BAR, (volatile LAS unsigned*)(F.lds + LDSX_OFF + 2048));
    STAMP(0);

    if (IN(0)) {
        PHASE_IDS
        LAS float* scr = (LAS float*)(F.lds + RING_OFF + wave * 16384);
        constexpr int I_IN = 16 * 160, I_KV = 16 * 16, I_PD = 8 * 32, I_PM = 4 * 32, I_WO = 16 * 32, I_EG = 16 * 256, I_EU = 16 * 256, I_ED = 16 * 256;
        constexpr int NITEMS = I_IN + I_KV + I_PD + I_PM + I_WO + I_EG + I_EU + I_ED;
        for (int it = gw; it < NITEMS; it += NGW) {
            int r = it;
            if (r < I_IN) { p0_plain(w_in, D, INCOLS, Win_t, 0, r, scr, lane); continue; } r -= I_IN;
            if (r < I_KV) { p0_plain(w_mem_kv, D, 512, Win_t, INCOLS, r, scr, lane); continue; } r -= I_KV;
            if (r < I_PD) { const int kb = r >> 5, nb = r & 31; p0_tile(p_diff, D, 64 * kb, 32 * nb, Pc_t + 256, D, 32 * nb, scr, lane); continue; } r -= I_PD;
            if (r < I_PM) { const int kb = r >> 5, nb = r & 31; p0_tile(p_mem, D, 64 * kb, 32 * nb, Pc_t + 768, D, 32 * nb, scr, lane); continue; } r -= I_PM;
            if (r < I_WO) { p0_plain(w_o, D, D, Wo_t, 0, r, scr, lane); continue; } r -= I_WO;
            if (r < I_EG + I_EU) { const bool up = r >= I_EG; if (up) r -= I_EG;
                const int e = r >> 8, rr = r & 255, kb = rr >> 4, nb = rr & 15, n0 = 32 * nb;
                p0_tile((up ? w_eu : w_eg) + (size_t)e * D * EH, EH, 64 * kb, n0, Wgu_t + (size_t)e * D * D, D, (n0 >> 7) * 256 + (n0 & 127) + (up ? 128 : 0), scr, lane, norm_ffn_g); continue; }
            r -= I_EG + I_EU;
            { const int e = r >> 8, rr = r & 255, kb = rr >> 5, nb = rr & 31;
              p0_tile(w_ed + (size_t)e * EH * D, D, 64 * kb, 32 * nb, Wd_t + (size_t)e * D * EH, EH, 32 * nb, scr, lane); }
        }
        STAMP(12);
        for (int idx = (F.vcu * NWAVES * 64 + tid); idx < 5120; idx += F.G * NWAVES * 64) {
            const int q = idx % 20, h = (idx / 20) & 1, hl = (idx / 40) & 1, st = idx / 80, k0 = 32 * (st >> 1) + 16 * h + 8 * (st & 1);
            float v[8];
#pragma unroll
            for (int j = 0; j < 8; ++j) { const int k = k0 + j; const float w = norm_ffn_g[k] * (q < 4 ? w_rg[k * 4 + q] : w_re[k * 16 + (q - 4)]); const float hi = bflo(f2bf(w) ); v[j] = hl ? (w - hi) : w; }
            v4u o; o.x = pk2(v[0], v[1]); o.y = pk2(v[2], v[3]); o.z = pk2(v[4], v[5]); o.w = pk2(v[6], v[7]);
            *((GAS v4u*)WRF + idx) = o;
        }
        for (int idx = (F.vcu * NWAVES * 64 + tid); idx < 256 * 1024; idx += F.G * NWAVES * 64) {
            const int kc = idx >> 10, n = idx & 1023, g = kc >> 6; float a = 0.f;
#pragma unroll 16
            for (int d = 0; d < 64; ++d) a += pool_w[kc * 64 + d] * pool_scale[g * 64 + d] * p_pool[(size_t)(g * 64 + d) * D + n];
            Pc_t[(size_t)n * D + kc] = (bf16)f2bf(a);
        }
        STAMP(13);
        rms_rows_stream(x_in, norm_mix_g, mem_in, norm_mem_g, T, T + TM, XN, gw * 4, NGW * 4, lane);
    }
    SEAM(0);

    if (IN(1)) {
        pg8::Gemm g{XN, Win_t, T, INCOLS, D};
        pg8::ProjOrder S; S.so.init(T, INCOLS, F.G, (int)blockIdx.x);
        pg8::EpiProj E{PROJ, GATES, KV, attn_body::C2};
        pg8::gemm_phase<pg8::EpiProj, pg8::ProjOrder, true, true>(wv, F.lds + RING_OFF, g, S, E);
    }
    SEAM(1);

    if (IN(2)) {
        PHASE_IDS
        typedef attn_body::bf16 abf;
        struct DiffOrder { int vcu, G;
            __device__ __forceinline__ bool next(int i, int& bh, int& m, int& qb) const { const int u = vcu + (i >> 3) * G; if (u >= BATCH * 8) return false; bh = u >> 1; m = (i >> 2) & 1; const int k = i & 3, st = u & 1;
                qb = (k == 0) ? 7 - st : (k == 1) ? st : (k == 2) ? 4 + st : 3 - st; return true; } };
        float lam;
        { const float s1 = wave_sum(lam_q1[lane] * lam_k1[lane]), s2 = wave_sum(lam_q2[lane] * lam_k2[lane]); lam = __uint_as_float(__builtin_amdgcn_readfirstlane(__float_as_uint(__expf(s1) - __expf(s2) + 0.2f))); }
        { const DiffOrder S{F.vcu, F.G}; int bh, m, qb;
          for (int i = 0; S.next(i, bh, m, qb); ++i) {
            const int b = bh >> 2, h = bh & 3; const size_t rb = (size_t)b * SEQ;
            const attn2::bf16* Qu = (const attn2::bf16*)PROJ + (rb + qb * 256) * PROJW + 256 + h * 128 + m * 64;
            const attn2::bf16* Kh = (const attn2::bf16*)PROJ + rb * PROJW + 768 + h * 128 + m * 64;
            const attn2::bf16* Vh = (const attn2::bf16*)PROJ + rb * PROJW + 1280 + h * 128;
            attn2::bf16* S0 = (attn2::bf16*)ATTO + (rb + qb * 256) * 512 + h * 128;
            attn2::bf16* Od = (attn2::bf16*)BR + (rb + qb * 256) * D + 256 + h * 128;
            asm volatile("" : "+s"(Qu), "+s"(Kh), "+s"(Vh), "+s"(S0), "+s"(Od));
            if (m == 0) attn2::attn_unit<8, true, false>(Qu, PROJW, Kh, Vh, PROJW, wv, S0, 512, 4 * (qb + 1), (char*)lds + RING_OFF);
            else attn2::attn_unit<8, true, true>(Qu, PROJW, Kh, Vh, PROJW, wv, Od, D, 4 * (qb + 1), (char*)lds + RING_OFF, S0, 512, lam, subln_g); } }
        for (int mu = F.vcu; mu < BATCH * 8; mu += F.G) {
            const int b = mu >> 3, mh = (mu >> 1) & 3, half = mu & 1;
            const abf* Q0 = (const abf*)PROJ + ((size_t)b * SEQ + half * 1024) * PROJW + 1792 + mh * 64;
            const abf* Kh = (const abf*)KV + (size_t)b * NMEM * 512 + mh * 64;
            const abf* Vh = (const abf*)KV + (size_t)b * NMEM * 512 + 256 + mh * 64;
            abf* O0 = (abf*)BR + ((size_t)b * SEQ + half * 1024) * D + 768 + mh * 64;
            asm volatile("" : "+s"(Q0), "+s"(Kh), "+s"(Vh), "+s"(O0));
            attn_body::mem_attn(wv, Q0, PROJW, Kh, Vh, 512, O0, D, 4, (char*)lds + RING_OFF); }
        { int tidp = tid_of(wv); asm volatile("" : "+v"(tidp)); const int lane = tidp & 63, gw = F.vcu * NWAVES + wv;
        const int gi = lane >> 4, w = 2 << gi;
        for (int tb = gw * 32; tb < T; tb += NGW * 32)
        for (int tp = 0; tp < 32; tp += 2) {
            const int t = tb + tp, s0 = t & (SEQ - 1);
            const GAS v2u* up = (const GAS v2u*)(PROJ + (size_t)(t + 1) * PROJW) + lane;
            const int nw0 = (w < s0 + 1) ? w : s0 + 1, nw1 = (w < s0 + 2) ? w : s0 + 2;
            v2u wq[17];
#pragma unroll
            for (int k = 0; k < 17; ++k) { wq[k] = (v2u){0u, 0u}; if (k < nw1 || (k >= 1 && k - 1 < nw0)) wq[k] = *(const GAS v2u*)((const GAS bf16*)up - (size_t)k * PROJW); }
#pragma unroll
            for (int q = 0; q < 2; ++q) {
                const int nwq = q ? nw1 : nw0; float a0 = 0.f, a1 = 0.f, a2 = 0.f, a3 = 0.f;
#pragma unroll
                for (int k = 0; k < 16; ++k) { const v2u x = wq[k + 1 - q]; const bool in = k < nwq; a0 += in ? bflo(x.x) : 0.f; a1 += in ? bfhi(x.x) : 0.f; a2 += in ? bflo(x.y) : 0.f; a3 += in ? bfhi(x.y) : 0.f; }
                const v2u ut = wq[1 - q]; const float inv = 1.f / (float)nwq;
                v2u po; po.x = pk2(a0 * inv - bflo(ut.x), a1 * inv - bfhi(ut.x)); po.y = pk2(a2 * inv - bflo(ut.y), a3 * inv - bfhi(ut.y));
                *((GAS v2u*)(BR + (size_t)(t + q) * D) + lane) = po; }
        }
        }
    }
    SEAM(2); STAMP(4);


    if (IN(4)) {
        pg8::StaticOrder S; S.init(T, D, F.G, (int)blockIdx.x);
        pg8::Gemm g{BR, Pc_t, T, D, D}; pg8::EpiMerge E{GATES, MERGED}; pg8::MidRescale MH{GATES};
        pg8::gemm_phase<pg8::EpiMerge, pg8::StaticOrder, true, true, pg8::MidRescale>(wv, F.lds + RING_OFF, g, S, E, MH);
    }
    SEAM(4);

    if (IN(5)) {
        pg8::Gemm g{MERGED, Wo_t, T, D, D}; pg8::StaticOrder S; S.init(T, D, F.G, (int)blockIdx.x);
        pg8::EpiMix E{MIX};
        pg8::gemm_phase<pg8::EpiMix, pg8::StaticOrder, true, true>(wv, F.lds + RING_OFF, g, S, E);
    }
    SEAM(5);

    if (IN(6)) {
        PHASE_IDS
        LAS v4u* WL = (LAS v4u*)(F.lds + RING_OFF);
        LAS float* SC = (LAS float*)(F.lds + RING_OFF + 81920) + wave * 1024;
        LAS v4u* REC = (LAS v4u*)(F.lds + RING_OFF + 81920 + 32768);
        LAS unsigned* LCNT = (LAS unsigned*)(F.lds + RING_OFF + 81920 + 32768 + 4096);
        LAS unsigned* LBASE = LCNT + 16; LAS float* RIL = (LAS float*)(LCNT + 32);
        for (int idx = tid; idx < 5120; idx += NWAVES * 64) WL[idx] = *((const GAS v4u*)WRF + idx);
        float bg[4], be[16];
#pragma unroll
        for (int i = 0; i < 4; ++i) bg[i] = b_rg[i];
#pragma unroll
        for (int i = 0; i < 16; ++i) be[i] = b_re[i];
        const int r32 = lane & 31, hh = lane >> 5;
        for (int rb0 = F.vcu * 256; rb0 < T; rb0 += F.G * 256) {
            if (tid < 16) LCNT[tid] = 0u;
            __syncthreads();
            const int li = wave * 32 + r32, row = rb0 + li;
            const GAS f32x4* xp = (const GAS f32x4*)(x_in + (size_t)row * D + 16 * hh);
            const GAS v4u* mp = (const GAS v4u*)(MIX + (size_t)row * D + 16 * hh);
            GAS v4u* hp = (GAS v4u*)(H2 + (size_t)row * D + 16 * hh);
            const LAS v4u* wl = WL + hh * 20 + r32;
            f32x16_t acc = {}; float ss = 0.f;
            f32x4 cur[8]; v4u curm[4];
#pragma unroll
            for (int i = 0; i < 8; ++i) cur[i] = xp[(i >> 2) * 8 + (i & 3)];
#pragma unroll
            for (int i = 0; i < 4; ++i) curm[i] = mp[(i >> 1) * 4 + (i & 1)];
#pragma unroll 1
            for (int sp2 = 0; sp2 < 16; ++sp2) {
                f32x4 nxt[8]; v4u nxtm[4];
                const int spn = (sp2 + 1 < 16) ? sp2 + 1 : sp2;
#pragma unroll
                for (int i = 0; i < 8; ++i) nxt[i] = xp[(2 * spn + (i >> 2)) * 8 + (i & 3)];
#pragma unroll
                for (int i = 0; i < 4; ++i) nxtm[i] = mp[(2 * spn + (i >> 1)) * 4 + (i & 1)];
#pragma unroll
                for (int i = 0; i < 4; ++i) { const v4u mm = curm[i];
                    cur[2 * i].x += bflo(mm.x); cur[2 * i].y += bfhi(mm.x); cur[2 * i].z += bflo(mm.y); cur[2 * i].w += bfhi(mm.y);
                    cur[2 * i + 1].x += bflo(mm.z); cur[2 * i + 1].y += bfhi(mm.z); cur[2 * i + 1].z += bflo(mm.w); cur[2 * i + 1].w += bfhi(mm.w); }
#pragma unroll
                for (int u = 0; u < 2; ++u) { const int sp = 2 * sp2 + u;
                    v4u ahi[2], alo[2];
#pragma unroll
                    for (int e = 0; e < 2; ++e) { const f32x4 a = cur[4 * u + 2 * e], b = cur[4 * u + 2 * e + 1];
                        ss += (a.x * a.x + a.y * a.y) + (a.z * a.z + a.w * a.w) + (b.x * b.x + b.y * b.y) + (b.z * b.z + b.w * b.w);
                        v4u h; h.x = cvtpk(a.x, a.y); h.y = cvtpk(a.z, a.w); h.z = cvtpk(b.x, b.y); h.w = cvtpk(b.z, b.w); ahi[e] = h;
                        v4u l; l.x = cvtpk(a.x - bflo(h.x), a.y - bfhi(h.x)); l.y = cvtpk(a.z - bflo(h.y), a.w - bfhi(h.y)); l.z = cvtpk(b.x - bflo(h.z), b.y - bfhi(h.z)); l.w = cvtpk(b.z - bflo(h.w), b.w - bfhi(h.w)); alo[e] = l; }
                    hp[sp * 4] = ahi[0]; hp[sp * 4 + 1] = ahi[1];
#pragma unroll
                    for (int e = 0; e < 2; ++e) { const int st = 2 * sp + e;
                        v4u bh = {0u, 0u, 0u, 0u}, bl = {0u, 0u, 0u, 0u};
                        if (r32 < 20) { bh = wl[(st * 4) * 20]; bl = wl[(st * 4 + 2) * 20]; }
                        acc = __builtin_amdgcn_mfma_f32_32x32x16_bf16(__builtin_bit_cast(bf16x8_t, ahi[e]), __builtin_bit_cast(bf16x8_t, bh), acc, 0, 0, 0);
                        acc = __builtin_amdgcn_mfma_f32_32x32x16_bf16(__builtin_bit_cast(bf16x8_t, alo[e]), __builtin_bit_cast(bf16x8_t, bh), acc, 0, 0, 0);
                        acc = __builtin_amdgcn_mfma_f32_32x32x16_bf16(__builtin_bit_cast(bf16x8_t, ahi[e]), __builtin_bit_cast(bf16x8_t, bl), acc, 0, 0, 0); } }
#pragma unroll
                for (int i = 0; i < 8; ++i) cur[i] = nxt[i];
#pragma unroll
                for (int i = 0; i < 4; ++i) curm[i] = nxtm[i];
            }
            ss += __shfl_xor(ss, 32);
            const float rinv = 1.f / sqrtf(ss * (1.f / D) + RMS_EPS);
#pragma unroll
            for (int r = 0; r < 16; ++r) SC[((r & 3) + 8 * (r >> 2) + 4 * hh) * 32 + r32] = acc[r];
            LDS_WAIT();
            if (lane < 32) {
                float lg[20];
#pragma unroll
                for (int q4 = 0; q4 < 5; ++q4) { const f32x4 t4 = *(const LAS f32x4*)(SC + lane * 32 + 4 * q4); lg[4 * q4] = t4.x * rinv; lg[4 * q4 + 1] = t4.y * rinv; lg[4 * q4 + 2] = t4.z * rinv; lg[4 * q4 + 3] = t4.w * rinv; }
                float gl[4];
#pragma unroll
                for (int i = 0; i < 4; ++i) gl[i] = lg[i] + bg[i];
                int gidx = 0; float gmax = gl[0];
#pragma unroll
                for (int i = 1; i < 4; ++i) if (gl[i] > gmax) { gmax = gl[i]; gidx = i; }
                float gsum = 0.f;
#pragma unroll
                for (int i = 0; i < 4; ++i) gsum += __expf(gl[i] - gmax);
                const float gp = 1.f / gsum;
                float el[4];
#pragma unroll
                for (int j = 0; j < 4; ++j) { const float l0 = lg[4 + j] + be[j], l1 = lg[8 + j] + be[4 + j], l2 = lg[12 + j] + be[8 + j], l3 = lg[16 + j] + be[12 + j];
                    el[j] = gidx == 0 ? l0 : gidx == 1 ? l1 : gidx == 2 ? l2 : l3; }
                int i0 = 0; float m0 = el[0];
#pragma unroll
                for (int j = 1; j < 4; ++j) if (el[j] > m0) { m0 = el[j]; i0 = j; }
                int i1 = -1; float m1 = -3.0e38f;
#pragma unroll
                for (int j = 0; j < 4; ++j) if (j != i0 && el[j] > m1) { m1 = el[j]; i1 = j; }
                if (i1 < 0) { i1 = (i0 + 1) & 3; m1 = m0; }
                const float p1 = __expf(m1 - m0);
                const float w0 = gp / (1.f + p1), w1 = gp * p1 / (1.f + p1);
                const unsigned e0 = (unsigned)(gidx * 4 + i0), e1 = (unsigned)(gidx * 4 + i1);
                const unsigned s0 = __hip_atomic_fetch_add(LCNT + e0, 1u, __ATOMIC_RELAXED, __HIP_MEMORY_SCOPE_WORKGROUP), s1 = __hip_atomic_fetch_add(LCNT + e1, 1u, __ATOMIC_RELAXED, __HIP_MEMORY_SCOPE_WORKGROUP);
                v4u rc; rc.x = (e0 << 20) | s0; rc.y = (e1 << 20) | s1; rc.z = __float_as_uint(w0); rc.w = __float_as_uint(w1); REC[li] = rc;
                RINV[row] = rinv; RIL[li] = rinv;
            }
            __syncthreads();
            if (tid < 16) LBASE[tid] = __hip_atomic_fetch_add(F.ctl + CW_CNT + tid, LCNT[tid], __ATOMIC_RELAXED, __HIP_MEMORY_SCOPE_AGENT);
            __syncthreads();
            if (tid < 256) { v4u rc = REC[tid]; rc.x += LBASE[rc.x >> 20]; rc.y += LBASE[rc.y >> 20]; *((GAS v4u*)ROUTE + rb0 + tid) = rc;
                const unsigned i0 = ((rc.x >> 20) << 16) + (rc.x & 0xFFFFFu), i1 = ((rc.y >> 20) << 16) + (rc.y & 0xFFFFFu); const float ri = RIL[tid];
                LIST[i0] = rb0 + tid; LIST[i1] = rb0 + tid; RWE[2 * i0] = ri; RWE[2 * i0 + 1] = __uint_as_float(rc.z); RWE[2 * i1] = ri; RWE[2 * i1 + 1] = __uint_as_float(rc.w); }
            __syncthreads();
        }
    }
    SEAM(6);

    if (IN(7)) {
        PHASE_IDS
        build_tile_tables(F, tid);
        const LAS int* TB = (const LAS int*)(F.lds + LDSX_OFF); const LAS unsigned char* t2e = (const LAS unsigned char*)(F.lds + LDSX_OFF + 128);
        LAS int* TOKL = (LAS int*)(F.lds + LDSX_OFF + 4096);
        const int nunits = TB[NEXP] * 4;
        for (int i = 0; i < 11; ++i) { const int L = i * F.G + F.vcu; if (L >= nunits) break;
            const int pm = L >> 2, e = t2e[pm], lt = pm - TB[e];
            if (tid < 256) { unsigned tok = (unsigned)LIST[(e << 16) + lt * 256 + tid]; tok = tok < (unsigned)T ? tok : (unsigned)(T - 1); TOKL[i * 256 + tid] = (int)tok; } }
        __syncthreads();
        pg8::Gemm g{H2, Wgu_t, T, NEXP * D, D};
        pg8::MoeOrder S{t2e, nunits, F.G, F.vcu};
        pg8::EpiGateUp E{HID, RWE, TB};
        pg8::gemm_phase<pg8::EpiGateUp, pg8::MoeOrder, true, true, pg8::NoMid, true>(wv, F.lds + RING_OFF, g, S, E, pg8::NoMid(), TOKL);
    }
    SEAM(7);

    if (IN(8)) {
        PHASE_IDS
        build_tile_tables(F, tid);
        const LAS int* TB = (const LAS int*)(F.lds + LDSX_OFF);
        pg8::Gemm g{HID, Wd_t, MAXROWS, NEXP * D, EH};
        pg8::MoeOrder S{(const LAS unsigned char*)(F.lds + LDSX_OFF + 128), TB[NEXP] * 4, F.G, F.vcu};
        pg8::EpiDown E{Y};
        pg8::gemm_phase<pg8::EpiDown, pg8::MoeOrder, true, true>(wv, F.lds + RING_OFF, g, S, E);
    }
    SEAM(8);

    if (IN(9)) {
        PHASE_IDS
        build_tile_tables(F, tid);
        const LAS int* TB = (const LAS int*)(F.lds + LDSX_OFF);
        for (int t = gw; t < T; t += NGW) {
            const v4u rc = *((const GAS v4u*)ROUTE + t);
            const size_t r0 = (size_t)TB[rc.x >> 20] * 256 + (rc.x & 0xFFFFFu), r1 = (size_t)TB[rc.y >> 20] * 256 + (rc.y & 0xFFFFFu);
            GAS f32x4* xr = (GAS f32x4*)(X1 + (size_t)t * D) + lane; const GAS f32x4* gr = (const GAS f32x4*)final_g + lane; const GAS v2u* hr = (const GAS v2u*)(H2 + (size_t)t * D) + lane;
            const GAS v2u* y0 = (const GAS v2u*)(Y + r0 * D) + lane; const GAS v2u* y1 = (const GAS v2u*)(Y + r1 * D) + lane;
            f32x4 v[4]; float s = 0.f;
#pragma unroll
            for (int j = 0; j < 4; ++j) { const v2u hx = hr[64 * j]; v[j] = (f32x4){bflo(hx.x), bfhi(hx.x), bflo(hx.y), bfhi(hx.y)}; const v2u a = y0[64 * j], b = y1[64 * j];
                v[j].x += bflo(a.x) + bflo(b.x); v[j].y += bfhi(a.x) + bfhi(b.x); v[j].z += bflo(a.y) + bflo(b.y); v[j].w += bfhi(a.y) + bfhi(b.y);
                s += (v[j].x * v[j].x + v[j].y * v[j].y) + (v[j].z * v[j].z + v[j].w * v[j].w); }
            const float r = 1.f / sqrtf(wave_sum(s) * (1.f / D) + RMS_EPS);
#pragma unroll
            for (int j = 0; j < 4; ++j) { f32x4 o = v[j] * r * gr[64 * j];
                if (PROBE_B >= 0 && blockIdx.x == 0 && (t / NGW) < 8) {
                    const unsigned long long* ts = (const unsigned long long*)(F.ctl + CW_TS); const float amp = sqrtf((float)((ts[PROBE_B2] - ts[PROBE_B]) / 100) * 1e-3f);
                    o.x += amp; o.y += amp; o.z += amp; o.w += amp; }
                xr[64 * j] = o; }
        }
        STAMP(10);
        if (PROBE_A >= 0 && blockIdx.x == 0 && tid_of(wv) == 0) {
            const unsigned long long* ts = (const unsigned long long*)(F.ctl + CW_TS);
            X1[0] += 4.f + (float)((ts[PROBE_A2] - ts[PROBE_A]) / 100) * 0.01f; }
    }
#undef IN
#undef SEAM
#undef STAMP
#undef PHASE_IDS
#undef x_in
#undef mem_in
#undef norm_mix_g
#undef w_in
#undef pool_w
#undef pool_scale
#undef lam_q1
#undef lam_k1
#undef lam_q2
#undef lam_k2
#undef subln_g
#undef norm_mem_g
#undef w_mem_kv
#undef p_pool
#undef p_diff
#undef p_mem
#undef w_o
#undef norm_ffn_g
#undef w_rg
#undef b_rg
#undef w_re
#undef b_re
#undef w_eg
#undef w_eu
#undef w_ed
#undef final_g
#undef Win_t
#undef Pc_t
#undef Wo_t
#undef Wgu_t
#undef Wd_t
#undef KV
#undef XN
#undef BR
#undef H2
#undef PROJ
#undef MERGED
#undef MIX
#undef HID
#undef ATTO
#undef GATES
#undef Y
#undef ROUTE
#undef RWE
#undef LIST
#undef WRF
#undef RINV
#undef X1
}

extern "C" void kernel_launch(void* const* d_in, const int* in_sizes, int n_in, void* d_out, int out_size, void* d_ws, size_t ws_size, hipStream_t stream) {
    static int grid = 0;
    if (grid == 0) {
        if (n_in != 26 || in_sizes[0] != T * D || out_size != T * D || ws_size < WS_END) { fprintf(stderr, "kernel_launch: unexpected problem: n_in %d in0 %d out %d ws %zu (need %zu)\n", n_in, n_in > 0 ? in_sizes[0] : -1, out_size, ws_size, (size_t)WS_END); grid = -1; return; }
        int dev = 0, cus = 0, per_cu = 0;
        if (hipGetDevice(&dev) != hipSuccess || hipDeviceGetAttribute(&cus, hipDeviceAttributeMultiprocessorCount, dev) != hipSuccess) { fprintf(stderr, "kernel_launch: device query failed\n"); grid = -1; return; }
        if (hipFuncSetAttribute((const void*)hybrid_fwd, hipFuncAttributeMaxDynamicSharedMemorySize, LDS_BYTES) != hipSuccess) { fprintf(stderr, "kernel_launch: hipFuncSetAttribute failed\n"); grid = -1; return; }
        if (hipOccupancyMaxActiveBlocksPerMultiprocessor(&per_cu, (const void*)hybrid_fwd, NWAVES * 64, LDS_BYTES) != hipSuccess || per_cu < 1) { fprintf(stderr, "kernel_launch: occupancy query says %d blocks per CU\n", per_cu); grid = -1; return; }
        (void)hipGetLastError();
        grid = cus;
        if (grid > 256) grid = 256;
    }
    if (grid < 0) return;
    if (hipMemsetAsync((char*)d_ws + WS_CTL, 0, CTL_ZERO_BYTES, stream) != hipSuccess) { fprintf(stderr, "kernel_launch: memset failed\n"); return; }
    Args a{};
    for (int i = 0; i < 26; ++i) a.in[i] = (const float*)d_in[i];
    a.out = (float*)d_out; a.ws = (unsigned char*)d_ws;
#if MK_N_LAUNCHES == 1
    a.ph_lo = 0; a.ph_hi = NPH;
    void* kargs[] = {&a};
    hipError_t e = hipLaunchCooperativeKernel((const void*)hybrid_fwd, dim3(grid), dim3(NWAVES * 64), kargs, LDS_BYTES, stream);
    if (e != hipSuccess) fprintf(stderr, "kernel_launch: cooperative launch failed: %s (grid %d)\n", hipGetErrorString(e), grid);
#else
    for (int p = 0; p < NPH; ++p) { a.ph_lo = p; a.ph_hi = p + 1;
        hipLaunchKernelGGL(hybrid_fwd, dim3(grid), dim3(NWAVES * 64), LDS_BYTES, stream, a);
        const hipError_t le = hipPeekAtLastError(); if (le != hipSuccess) { fprintf(stderr, "kernel_launch: launch %d failed: %s\n", p, hipGetErrorName(le)); break; } }
#endif
}
```

```cpp
#include <hip/hip_runtime.h>
#include <hip/hip_cooperative_groups.h>
#include <cstdio>
#include <cstdint>
namespace cg = cooperative_groups;
__device__ __forceinline__ int tid_of(int wv) { unsigned z = 0u; asm volatile("" : "+v"(z));
    return (wv << 6) | (int)__builtin_amdgcn_mbcnt_hi(~0u, __builtin_amdgcn_mbcnt_lo(~0u, z)); }
namespace pg8 {
#define PG8_LAS __attribute__((address_space(3)))
typedef unsigned short bf16_t;
typedef short bf16x8 __attribute__((ext_vector_type(8)));
typedef float f32x4 __attribute__((ext_vector_type(4)));
typedef unsigned u32x4 __attribute__((ext_vector_type(4)));
constexpr int BM = 256, BK = 64, HALF = 128, HTB = HALF * BK * 2  , STAGE_BYTES = 8 * HTB, NXCD = 8, WGM = 8;

__host__ __device__ __forceinline__ int lds_byte(int r, int c) { const int st = (r >> 4) * 2 + (c >> 5), rr = r & 15, cc = c & 31, ob = rr * 64 + cc * 2; return st * 1024 + (ob ^ (((ob >> 9) & 1) << 5)); }
__host__ __device__ __forceinline__ void stage_rc(int b, int& R, int& C) { const int st = b / 1024, sb = b % 1024, swz = sb ^ (((sb >> 9) & 1) << 5); R = (st >> 1) * 16 + swz / 64; C = (st & 1) * 32 + (swz % 64) / 2; }
__host__ __device__ __forceinline__ int perm32(int rho) { const int n = rho >> 4, i = rho & 15; return 8 * (i >> 2) + 4 * n + (i & 3); }

struct Unit { int pm, pn; };
struct Gemm { const bf16_t* A; const bf16_t* Bt; int M, N, K; };

struct StaticOrder {
    int nM, nN, nwg, G, c;
    __host__ __device__ void init(int M, int N, int G_, int c_) { nM = M / BM; nN = N / BM; nwg = nM * nN; G = G_; c = c_; }
    __host__ __device__ bool next(int i, Unit& u) const {
        const long L = (long)i * G + c; if (L >= nwg) return false;
        int wgid = (int)L; { const int q = nwg / NXCD, r = nwg % NXCD, xcd = wgid % NXCD, off = wgid / NXCD; wgid = (xcd < r ? xcd * (q + 1) : r * (q + 1) + (xcd - r) * q) + off; }
        const int nig = WGM * nN, gid = wgid / nig, fm = gid * WGM, gsz = (nM - fm) < WGM ? (nM - fm) : WGM;
        u.pm = fm + ((wgid % nig) % gsz); u.pn = (wgid % nig) / gsz; return true;
    }
    __device__ __forceinline__ void a_ready(const Unit&) const {}
    __device__ __forceinline__ void done(const Unit&) const {}
};

__device__ __forceinline__ unsigned cvt_pk_bf16(float lo, float hi) { unsigned r; asm volatile("v_cvt_pk_bf16_f32 %0, %1, %2" : "=v"(r) : "v"(lo), "v"(hi)); return r; }
typedef unsigned u32x2 __attribute__((ext_vector_type(2)));
__device__ __forceinline__ float bf_lo(unsigned w) { return __uint_as_float(w << 16); }
__device__ __forceinline__ float bf_hi(unsigned w) { return __uint_as_float(w & 0xffff0000u); }
__device__ __forceinline__ float sigmoid_f(float x) { return __builtin_amdgcn_rcpf(1.0f + __builtin_amdgcn_exp2f(-1.4426950408889634f * x)); }
__device__ __forceinline__ u32x4 pack8(const f32x4 a, const f32x4 b) { u32x4 w; w.x = cvt_pk_bf16(a[0], a[1]); w.y = cvt_pk_bf16(a[2], a[3]); w.z = cvt_pk_bf16(b[0], b[1]); w.w = cvt_pk_bf16(b[2], b[3]); return w; }

struct ProjOrder {
    StaticOrder so;
    __device__ __forceinline__ bool next(int i, Unit& u) const {
        const long L = (long)i * so.G + so.c;
        if (L < so.nwg) return so.next(i, u);
        const int x = (int)(L - so.nwg); if (x >= 64) return false;
        u.pm = 256 + (x >> 1); u.pn = 20 + (x & 1); return true;
    }
    __device__ __forceinline__ void a_ready(const Unit&) const {}
    __device__ __forceinline__ void done(const Unit&) const {}
};
struct MoeOrder {
    const PG8_LAS unsigned char* t2e; int nunits, G, c;
    __device__ __forceinline__ bool next(int i, Unit& u) const {
        const int L = i * G + c; if (L >= nunits) return false;
        const int pm = L >> 2; u.pm = pm; u.pn = (int)t2e[pm] * 4 + (L & 3); return true;
    }
    __device__ __forceinline__ void a_ready(const Unit&) const {}
    __device__ __forceinline__ void done(const Unit&) const {}
};

struct EpiProj {
    static constexpr bool PERM = true, AFTER_DRAIN = false;
    bf16_t* PROJ; bf16_t* GATES; bf16_t* KV; float qscale;
    __device__ __forceinline__ void operator()(const f32x4 (&acc)[2][2][4][2], const Unit& u, int wr, int wc, int fr, int fq) const {
        bf16_t* base; int ldc, colt, mode = 0; float sc = 1.f; int rowt = u.pm * BM;
        if (u.pm >= 256) { base = KV; ldc = 512; colt = (u.pn - 20) * BM; rowt -= 65536; }
        else if (u.pn < 8) { base = PROJ; ldc = 2048; colt = u.pn * BM; if (u.pn == 1 || u.pn == 2 || u.pn == 7) sc = qscale; }
        else { base = GATES; ldc = 3072; colt = (u.pn - 8) * BM; mode = 1; }
        const int row0 = rowt + wr * 64 + fr, col0 = colt + wc * 32 + 8 * fq;
#pragma unroll
        for (int ai = 0; ai < 2; ++ai)
#pragma unroll
            for (int m = 0; m < 4; ++m) { bf16_t* rowp = base + (size_t)(row0 + ai * HALF + m * 16) * ldc + col0;
#pragma unroll
                for (int bj = 0; bj < 2; ++bj) { f32x4 v0 = acc[ai][bj][m][0], v1 = acc[ai][bj][m][1];
                    if (mode) {
#pragma unroll
                        for (int i = 0; i < 4; ++i) { v0[i] = sigmoid_f(v0[i]); v1[i] = sigmoid_f(v1[i]); } }
                    else { v0 = v0 * sc; v1 = v1 * sc; }
                    *(u32x4*)(rowp + bj * HALF) = pack8(v0, v1); } }
    }
};
__device__ __forceinline__ float gclamp(float g) { return __builtin_fmaxf(g, 1e-18f); }
struct MidRescale {
    static constexpr bool ON = true; static constexpr int T0 = 4, T1 = 12;
    const bf16_t* GATES;
    __device__ __forceinline__ void operator()(f32x4 (&acc)[2][2][4][2], const Unit& u, int t, int wr, int wc, int fr, int fq) const {
        int fr_ = fr; asm volatile("" : "+v"(fr_));
        const int row0 = u.pm * BM + wr * 64 + fr_, col0 = u.pn * BM + wc * 32 + 8 * fq; const int gprev = (t == T0) ? 0 : 1024;
        const unsigned off0 = ((unsigned)row0 * 3072u + (unsigned)(gprev + col0)) * 2u;
#pragma unroll
        for (int ai = 0; ai < 2; ++ai) {
            u32x4 ga[4][2], gb[4][2];
#pragma unroll
            for (int m = 0; m < 4; ++m) { const char* gp = (const char*)GATES + (off0 + (unsigned)((ai * HALF + m * 16) * 3072 * 2));
#pragma unroll
                for (int bj = 0; bj < 2; ++bj) { ga[m][bj] = *(const u32x4*)(gp + bj * HALF * 2); gb[m][bj] = *(const u32x4*)(gp + 2048 + bj * HALF * 2); } }
#pragma unroll
            for (int m = 0; m < 4; ++m)
#pragma unroll
                for (int bj = 0; bj < 2; ++bj) { const u32x4 a = ga[m][bj], b = gb[m][bj];
                    f32x4 r0, r1;
                    r0[0] = bf_lo(a.x) * __builtin_amdgcn_rcpf(gclamp(bf_lo(b.x))); r0[1] = bf_hi(a.x) * __builtin_amdgcn_rcpf(gclamp(bf_hi(b.x)));
                    r0[2] = bf_lo(a.y) * __builtin_amdgcn_rcpf(gclamp(bf_lo(b.y))); r0[3] = bf_hi(a.y) * __builtin_amdgcn_rcpf(gclamp(bf_hi(b.y)));
                    r1[0] = bf_lo(a.z) * __builtin_amdgcn_rcpf(gclamp(bf_lo(b.z))); r1[1] = bf_hi(a.z) * __builtin_amdgcn_rcpf(gclamp(bf_hi(b.z)));
                    r1[2] = bf_lo(a.w) * __builtin_amdgcn_rcpf(gclamp(bf_lo(b.w))); r1[3] = bf_hi(a.w) * __builtin_amdgcn_rcpf(gclamp(bf_hi(b.w)));
                    acc[ai][bj][m][0] = acc[ai][bj][m][0] * r0; acc[ai][bj][m][1] = acc[ai][bj][m][1] * r1; }
            asm volatile("" ::: "memory"); }
    }
};
struct EpiMerge {
    static constexpr bool PERM = true, AFTER_DRAIN = false;
    const bf16_t* GATES; bf16_t* MERGED;
    __device__ __forceinline__ void operator()(const f32x4 (&acc)[2][2][4][2], const Unit& u, int wr, int wc, int fr, int fq) const {
        const int row0 = u.pm * BM + wr * 64 + fr, col0 = u.pn * BM + wc * 32 + 8 * fq;
        const unsigned off0 = ((unsigned)row0 * 3072u + (unsigned)(2048 + col0)) * 2u;
        u32x4 gg[2][4][2];
#pragma unroll
        for (int ai = 0; ai < 2; ++ai)
#pragma unroll
            for (int m = 0; m < 4; ++m)
#pragma unroll
                for (int bj = 0; bj < 2; ++bj) gg[ai][m][bj] = *(const u32x4*)((const char*)GATES + (off0 + (unsigned)((ai * HALF + m * 16) * 3072 * 2)) + bj * HALF * 2);
#pragma unroll
        for (int ai = 0; ai < 2; ++ai)
#pragma unroll
            for (int m = 0; m < 4; ++m) { const size_t r = (size_t)(row0 + ai * HALF + m * 16);
#pragma unroll
                for (int bj = 0; bj < 2; ++bj) { const int c = col0 + bj * HALF; const u32x4 g = gg[ai][m][bj];
                    f32x4 v0 = acc[ai][bj][m][0], v1 = acc[ai][bj][m][1];
                    v0[0] *= gclamp(bf_lo(g.x)); v0[1] *= gclamp(bf_hi(g.x)); v0[2] *= gclamp(bf_lo(g.y)); v0[3] *= gclamp(bf_hi(g.y));
                    v1[0] *= gclamp(bf_lo(g.z)); v1[1] *= gclamp(bf_hi(g.z)); v1[2] *= gclamp(bf_lo(g.w)); v1[3] *= gclamp(bf_hi(g.w));
                    *(u32x4*)(MERGED + r * 1024 + c) = pack8(v0, v1); } }
    }
};
struct EpiMix {
    static constexpr bool PERM = true, AFTER_DRAIN = false;
    bf16_t* MIX;
    __device__ __forceinline__ void operator()(const f32x4 (&acc)[2][2][4][2], const Unit& u, int wr, int wc, int fr, int fq) const {
        const int row0 = u.pm * BM + wr * 64 + fr, col0 = u.pn * BM + wc * 32 + 8 * fq;
#pragma unroll
        for (int ai = 0; ai < 2; ++ai)
#pragma unroll
            for (int m = 0; m < 4; ++m) { bf16_t* rowp = MIX + (size_t)(row0 + ai * HALF + m * 16) * 1024 + col0;
#pragma unroll
                for (int bj = 0; bj < 2; ++bj) *(u32x4*)(rowp + bj * HALF) = pack8(acc[ai][bj][m][0], acc[ai][bj][m][1]); }
    }
};
struct EpiWo {
    static constexpr bool PERM = false, AFTER_DRAIN = false;
    const float* X; float* X1;
    __device__ __forceinline__ void operator()(const f32x4 (&acc)[2][2][4][2], const Unit& u, int wr, int wc, int fr, int fq) const {
        const int row0 = u.pm * BM + wr * 64 + fr, col0 = u.pn * BM + wc * 32 + 4 * fq;
#pragma unroll
        for (int ai = 0; ai < 2; ++ai)
#pragma unroll
            for (int m = 0; m < 4; ++m) { const size_t off = (size_t)(row0 + ai * HALF + m * 16) * 1024 + col0;
#pragma unroll
                for (int bj = 0; bj < 2; ++bj)
#pragma unroll
                    for (int n = 0; n < 2; ++n) { const size_t o = off + bj * HALF + n * 16; *(f32x4*)(X1 + o) = *(const f32x4*)(X + o) + acc[ai][bj][m][n]; } }
    }
};
struct EpiGateUp {
    static constexpr bool PERM = true, AFTER_DRAIN = false;
    bf16_t* HID; const float* RWE; const PG8_LAS int* TB;
    __device__ __forceinline__ void operator()(const f32x4 (&acc)[2][2][4][2], const Unit& u, int wr, int wc, int fr, int fq) const {
        const int row0 = u.pm * BM + wr * 64 + fr, colh = (u.pn & 3) * 128 + wc * 32 + 8 * fq;
#pragma unroll
        for (int ai = 0; ai < 2; ++ai)
#pragma unroll
            for (int m = 0; m < 4; ++m) { const size_t r = (size_t)(row0 + ai * HALF + m * 16); const size_t es = (size_t)((u.pn >> 2) << 16) + (r - (size_t)TB[u.pn >> 2] * 256); const float ri = RWE[2 * es], w = RWE[2 * es + 1];
                f32x4 h0, h1;
#pragma unroll
                for (int i = 0; i < 4; ++i) { const float g0 = acc[ai][0][m][0][i] * ri, g1 = acc[ai][0][m][1][i] * ri; const float wr_ = w * ri;
                    h0[i] = g0 * sigmoid_f(g0) * acc[ai][1][m][0][i] * wr_; h1[i] = g1 * sigmoid_f(g1) * acc[ai][1][m][1][i] * wr_; }
                *(u32x4*)(HID + r * 512 + colh) = pack8(h0, h1); }
    }
};
struct EpiDown {
    static constexpr bool PERM = true, AFTER_DRAIN = false;
    bf16_t* Y;
    __device__ __forceinline__ void operator()(const f32x4 (&acc)[2][2][4][2], const Unit& u, int wr, int wc, int fr, int fq) const {
        const int row0 = u.pm * BM + wr * 64 + fr, col0 = (u.pn & 3) * BM + wc * 32 + 8 * fq;
#pragma unroll
        for (int ai = 0; ai < 2; ++ai)
#pragma unroll
            for (int m = 0; m < 4; ++m) { bf16_t* rowp = Y + (size_t)(row0 + ai * HALF + m * 16) * 1024 + col0;
#pragma unroll
                for (int bj = 0; bj < 2; ++bj) *(u32x4*)(rowp + bj * HALF) = pack8(acc[ai][bj][m][0], acc[ai][bj][m][1]); }
    }
};

struct NoMid { static constexpr bool ON = false; static constexpr int T0 = -1, T1 = -1; __device__ __forceinline__ void operator()(f32x4 (&)[2][2][4][2], const Unit&, int, int, int, int, int) const {} };
template <class Epi, class Sched, bool ALIGN_EPI = false, bool SP2 = false, class Mid = NoMid, bool GATHER = false>
__device__ __forceinline__ void gemm_phase(const int wv, PG8_LAS unsigned char* lds, const Gemm g, const Sched& S, const Epi& E, const Mid& MH = Mid(), const PG8_LAS int* tokl = nullptr) {
    int tid_ = tid_of(wv); asm volatile("" : "+v"(tid_));
    const int tid = tid_, wid = __builtin_amdgcn_readfirstlane(tid >> 6), lane = tid & 63, wr = wid >> 2, wc = wid & 3, fr = lane & 15, fq = lane >> 4;
    static_assert(!GATHER || SP2, "GATHER is written for the SP2 loop");
    const int K = g.K, nt = K / BK;
    unsigned voffA[2], voffB[2];
#pragma unroll
    for (int i = 0; i < 2; ++i) { int R, C; stage_rc(tid * 16 + i * 8192, R, C); const int Rb = Epi::PERM ? ((R & ~31) + perm32(R & 31)) : R;
        voffA[i] = (unsigned)(R * K + C) * 2u; voffB[i] = (unsigned)(Rb * K + C) * 2u; }
    const size_t kstep = (size_t)(BK * 2);
    const size_t hstep = (size_t)HALF * K * 2;
    const size_t tstep = 2 * hstep;
    const unsigned ldsw = (unsigned)wid * 1024u;
    const int aoff = lds_byte(wr * 64 + fr, fq * 8), boff = lds_byte(wc * 32 + fr, fq * 8);
    unsigned vGc[2][2], vGn[2][2]; int gR[2], gC[2];
    if constexpr (GATHER) {
#pragma unroll
        for (int i = 0; i < 2; ++i) { stage_rc(tid * 16 + i * 8192, gR[i], gC[i]); }
    }
#define PG8_GOFFS(dst, u_) do { if constexpr (GATHER) { _Pragma("unroll") for (int hh_ = 0; hh_ < 2; ++hh_) _Pragma("unroll") for (int i_ = 0; i_ < 2; ++i_) \
        dst[hh_][i_] = ((unsigned)tokl[(u_) * 256 + hh_ * HALF + gR[i_]] * (unsigned)K + (unsigned)gC[i_]) * 2u; } } while (0)
#define PG8_STGA(bufoff, base, hh, nx) do { if constexpr (GATHER) { _Pragma("unroll") for (int _i = 0; _i < 2; ++_i) \
        __builtin_amdgcn_global_load_lds((const unsigned*)((const char*)(base) + ((nx) ? vGn[hh][_i] : vGc[hh][_i])), (PG8_LAS unsigned*)(lds + (bufoff) + ldsw + _i * 8192), 16, 0, 0); } \
      else { PG8_STAGE(bufoff, (base) + (hh) * hstep, voffA); } } while (0)
#define PG8_SA(b, h) (((b) * 2 + (h)) * HTB)
#define PG8_SB(b, h) ((4 + (b) * 2 + (h)) * HTB)
#define PG8_STAGE(bufoff, gbase, voff) do { _Pragma("unroll") for (int _i = 0; _i < 2; ++_i) \
        __builtin_amdgcn_global_load_lds((const unsigned*)((const char*)(gbase) + (voff)[_i]), (PG8_LAS unsigned*)(lds + (bufoff) + ldsw + _i * 8192), 16, 0, 0); } while (0)
#define PG8_LDA(dst, b, h) do { _Pragma("unroll") for (int m = 0; m < 4; ++m) _Pragma("unroll") for (int k = 0; k < 2; ++k) dst[m][k] = *(const PG8_LAS bf16x8*)(lds + PG8_SA(b, h) + aoff + m * 2048 + k * 1024); } while (0)
#define PG8_LDB(dst, b, h) do { _Pragma("unroll") for (int n = 0; n < 2; ++n) _Pragma("unroll") for (int k = 0; k < 2; ++k) dst[n][k] = *(const PG8_LAS bf16x8*)(lds + PG8_SB(b, h) + boff + n * 2048 + k * 1024); } while (0)
#define PG8_MMA(ai, bj, At, Bt) do { __builtin_amdgcn_s_setprio(1); _Pragma("unroll") for (int m = 0; m < 4; ++m) _Pragma("unroll") for (int n = 0; n < 2; ++n) _Pragma("unroll") for (int k = 0; k < 2; ++k) \
        acc[ai][bj][m][n] = __builtin_amdgcn_mfma_f32_16x16x32_bf16(Bt[n][k], At[m][k], acc[ai][bj][m][n], 0, 0, 0); __builtin_amdgcn_s_setprio(0); } while (0)
#define PG8_WAIT_V(n) asm volatile("s_waitcnt vmcnt(" #n ")" ::: "memory")
#define PG8_WAIT_L(n) asm volatile("s_waitcnt lgkmcnt(" #n ")" ::: "memory")
#define PG8_BAR __builtin_amdgcn_s_barrier()
#define PG8_SCHED __builtin_amdgcn_sched_barrier(0)
    Unit cur, nxt; int ui = 0;
    if (!S.next(0, cur)) return;
    f32x4 acc[2][2][4][2];
#pragma unroll
    for (int a = 0; a < 2; ++a)
#pragma unroll
        for (int b = 0; b < 2; ++b)
#pragma unroll
            for (int m = 0; m < 4; ++m)
#pragma unroll
                for (int n = 0; n < 2; ++n) acc[a][b][m][n] = (f32x4){0.f, 0.f, 0.f, 0.f};
    bf16x8 At[4][2], B0[2][2], B1[2][2];
    const char* cA = (const char*)g.A + (GATHER ? (size_t)0 : (size_t)cur.pm * tstep); const char* cB = (const char*)g.Bt + (size_t)cur.pn * tstep;
    PG8_GOFFS(vGc, 0); PG8_GOFFS(vGn, 0);
    S.a_ready(cur);
    if constexpr (SP2) {
        PG8_STAGE(PG8_SB(0, 0), cB, voffB); PG8_STAGE(PG8_SB(0, 1), cB + hstep, voffB); PG8_STGA(PG8_SA(0, 0), cA, 0, false); PG8_STGA(PG8_SA(0, 1), cA, 1, false);
        if (wr == 1) PG8_BAR;
        PG8_WAIT_V(2); PG8_BAR;
        PG8_STAGE(PG8_SB(1, 0), cB + kstep, voffB); PG8_STGA(PG8_SA(1, 0), cA + kstep, 0, false); PG8_STAGE(PG8_SB(1, 1), cB + hstep + kstep, voffB);
        PG8_WAIT_V(6); PG8_BAR;
    } else {
        PG8_STAGE(PG8_SB(0, 0), cB, voffB); PG8_STAGE(PG8_SA(0, 0), cA, voffA); PG8_STAGE(PG8_SB(0, 1), cB + hstep, voffB); PG8_STAGE(PG8_SA(0, 1), cA + hstep, voffA);
        if (wr == 1) PG8_BAR;
        PG8_WAIT_V(4); PG8_BAR;
        PG8_STAGE(PG8_SB(1, 0), cB + kstep, voffB); PG8_STAGE(PG8_SA(1, 0), cA + kstep, voffA); PG8_STAGE(PG8_SB(1, 1), cB + hstep + kstep, voffB);
        PG8_WAIT_V(6); PG8_BAR;
    }
    for (;;) {
        const bool has_next = S.next(ui + 1, nxt);
        if (has_next) PG8_GOFFS(vGn, ui + 1);
        const char* nA = (has_next && !GATHER) ? (const char*)g.A + (size_t)nxt.pm * tstep : cA; const char* nB = has_next ? (const char*)g.Bt + (size_t)nxt.pn * tstep : cB;
        for (int t = 0; t < nt; t += 2) {
            if constexpr (Mid::ON) { if (t == Mid::T0 || t == Mid::T1) MH(acc, cur, t, wr, wc, fr, fq); }
            const bool last = (t == nt - 2);
            const char* a1 = cA + (size_t)(t + 1) * kstep;
            const char* a2 = last ? nA : cA + (size_t)(t + 2) * kstep; const char* b2 = last ? nB : cB + (size_t)(t + 2) * kstep;
            const char* a3 = a2 + kstep; const char* b3 = b2 + kstep;
            if (last && has_next) S.a_ready(nxt);
            if constexpr (SP2) {
            PG8_LDB(B0, 0, 0); PG8_LDB(B1, 0, 1); PG8_SCHED; PG8_LDA(At, 0, 0); PG8_STGA(PG8_SA(1, 1), a1, 1, false);
            PG8_WAIT_V(8); PG8_WAIT_L(0); PG8_BAR; PG8_MMA(0, 0, At, B0); PG8_MMA(0, 1, At, B1); PG8_BAR; PG8_SCHED;
            PG8_LDA(At, 0, 1); PG8_STAGE(PG8_SB(0, 0), b2, voffB); PG8_STAGE(PG8_SB(0, 1), b2 + hstep, voffB); PG8_STGA(PG8_SA(0, 0), a2, 0, last && has_next);
            PG8_WAIT_V(8); PG8_WAIT_L(0); PG8_BAR; PG8_MMA(1, 0, At, B0); PG8_MMA(1, 1, At, B1); PG8_BAR; PG8_SCHED;
            PG8_LDB(B0, 1, 0); PG8_LDB(B1, 1, 1); PG8_SCHED; PG8_LDA(At, 1, 0); PG8_STGA(PG8_SA(0, 1), a2, 1, last && has_next);
            PG8_WAIT_V(8); PG8_WAIT_L(0); PG8_BAR; PG8_MMA(0, 0, At, B0); PG8_MMA(0, 1, At, B1); PG8_BAR; PG8_SCHED;
            PG8_LDA(At, 1, 1); PG8_STAGE(PG8_SB(1, 0), b3, voffB); PG8_STAGE(PG8_SB(1, 1), b3 + hstep, voffB); PG8_STGA(PG8_SA(1, 0), a3, 0, last && has_next);
            PG8_WAIT_V(8); PG8_WAIT_L(0); PG8_BAR; PG8_MMA(1, 0, At, B0); PG8_MMA(1, 1, At, B1); PG8_BAR; PG8_SCHED;
            } else {
            PG8_LDB(B0, 0, 0); PG8_SCHED; PG8_LDA(At, 0, 0); PG8_STAGE(PG8_SA(1, 1), a1 + hstep, voffA);
            PG8_WAIT_L(8); PG8_BAR; PG8_WAIT_L(0); PG8_MMA(0, 0, At, B0); PG8_BAR; PG8_SCHED;
            PG8_LDB(B1, 0, 1); PG8_STAGE(PG8_SB(0, 0), b2, voffB);
            PG8_BAR; PG8_WAIT_L(0); PG8_MMA(0, 1, At, B1); PG8_BAR;
            PG8_LDA(At, 0, 1); PG8_STAGE(PG8_SA(0, 0), a2, voffA);
            PG8_BAR; PG8_WAIT_L(0); PG8_MMA(1, 0, At, B0); PG8_BAR; PG8_SCHED;
            PG8_STAGE(PG8_SB(0, 1), b2 + hstep, voffB);
            PG8_WAIT_V(6); PG8_BAR; PG8_MMA(1, 1, At, B1); PG8_BAR;
            PG8_LDB(B0, 1, 0); PG8_SCHED; PG8_LDA(At, 1, 0); PG8_STAGE(PG8_SA(0, 1), a2 + hstep, voffA);
            PG8_WAIT_L(8); PG8_BAR; PG8_WAIT_L(0); PG8_MMA(0, 0, At, B0); PG8_BAR; PG8_SCHED;
            PG8_LDB(B1, 1, 1); PG8_STAGE(PG8_SB(1, 0), b3, voffB);
            PG8_BAR; PG8_WAIT_L(0); PG8_MMA(0, 1, At, B1); PG8_BAR;
            PG8_LDA(At, 1, 1); PG8_STAGE(PG8_SA(1, 0), a3, voffA);
            PG8_BAR; PG8_WAIT_L(0); PG8_MMA(1, 0, At, B0); PG8_BAR; PG8_SCHED;
            PG8_STAGE(PG8_SB(1, 1), b3 + hstep, voffB);
            PG8_WAIT_V(6); PG8_BAR; PG8_MMA(1, 1, At, B1); PG8_BAR;
            }
        }
        if constexpr (ALIGN_EPI) { if (wr == 0) PG8_BAR; }
        if constexpr (!Epi::AFTER_DRAIN) { E(acc, cur, wr, wc, fr, fq); S.done(cur); }
        if (!has_next) break;
#pragma unroll
        for (int a = 0; a < 2; ++a)
#pragma unroll
            for (int b = 0; b < 2; ++b)
#pragma unroll
                for (int m = 0; m < 4; ++m)
#pragma unroll
                    for (int n = 0; n < 2; ++n) acc[a][b][m][n] = (f32x4){0.f, 0.f, 0.f, 0.f};
        cur = nxt; cA = nA; cB = nB; ++ui;
        if constexpr (GATHER) { _Pragma("unroll") for (int hh_ = 0; hh_ < 2; ++hh_) _Pragma("unroll") for (int i_ = 0; i_ < 2; ++i_) vGc[hh_][i_] = vGn[hh_][i_]; }
        if constexpr (ALIGN_EPI) { if (wr == 1) PG8_BAR; }
    }
    PG8_WAIT_V(0);
    if constexpr (!ALIGN_EPI) { if (wr == 0) PG8_BAR; }
    PG8_BAR;
    if constexpr (Epi::AFTER_DRAIN) { E.fused(acc, cur, wr, wc, fr, fq, lds, wid, lane); S.done(cur); }
#undef PG8_SA
#undef PG8_SB
#undef PG8_STAGE
#undef PG8_STGA
#undef PG8_GOFFS
#undef PG8_LDA
#undef PG8_LDB
#undef PG8_MMA
#undef PG8_WAIT_V
#undef PG8_WAIT_L
#undef PG8_BAR
#undef PG8_SCHED
}
}
#include <hip/hip_bf16.h>
#include <cmath>
namespace attn_body {
using bf16=__hip_bfloat16;
using bf16x8=__attribute__((ext_vector_type(8)))short;
using s16x4=__attribute__((ext_vector_type(4)))short;
using f32x16=__attribute__((ext_vector_type(16)))float;
using u32x4=__attribute__((ext_vector_type(4)))unsigned;
constexpr int D=64;
constexpr int NW=8,QBLK=32,QB=QBLK*NW,KVBLK=64;
constexpr int ATTN_UNIT_ROWS=QB;
__device__ __forceinline__ int crow(int r,int hi){return (r&3)+8*(r>>2)+4*hi;}
#define SBAR() __builtin_amdgcn_sched_barrier(0)
__device__ __forceinline__ void cmask(f32x16&p0,f32x16&p1,int jb,int qrel,int hi){
  const float NEG=-INFINITY; int kb=64*jb+4*hi;
  #pragma unroll
  for(int r=0;r<16;++r){int kv=kb+(r&3)+8*(r>>2); if(kv>qrel)p0[r]=NEG; if(kv+32>qrel)p1[r]=NEG;}
}

constexpr int NSLOT=3, SLOTB=8192;
constexpr int LDS_K=0, LDS_V=NSLOT*SLOTB, LDS_WS=2*NSLOT*SLOTB, LDS_OST=LDS_WS+NW*64*4, LDS_BYTES=LDS_OST+NW*4096;
constexpr float C2=0.125f*1.4426950408889634f;
__device__ __forceinline__ void glds16(const void*gsrc,unsigned lds_dst){unsigned keep;
  asm volatile("s_mov_b32 %0, m0\n\ts_mov_b32 m0, %2\n\ts_nop 0\n\tglobal_load_lds_dwordx4 %1, off\n\ts_mov_b32 m0, %0":"=&s"(keep):"v"(gsrc),"s"(lds_dst):"memory");}
__device__ __forceinline__ float max3f(float a,float b,float c){float r;asm("v_max3_f32 %0, %1, %2, %3":"=v"(r):"v"(a),"v"(b),"v"(c));return r;}
__device__ __forceinline__ float max2f(float a,float b){float r;asm("v_max_f32_e32 %0, %1, %2":"=v"(r):"v"(a),"v"(b));return r;}
__device__ __forceinline__ float fadd_s(float a,float b){float r;asm("v_add_f32_e32 %0, %1, %2":"=v"(r):"v"(a),"v"(b));return r;}
__device__ __forceinline__ float fsub_s(float a,float b){float r;asm("v_sub_f32_e32 %0, %1, %2":"=v"(r):"v"(a),"v"(b));return r;}
typedef float f32x2_t __attribute__((ext_vector_type(2))); typedef __bf16 bf16x2_t __attribute__((ext_vector_type(2)));
__device__ __forceinline__ unsigned cvtpk_s(float lo,float hi){f32x2_t v={lo,hi};bf16x2_t b=__builtin_convertvector(v,bf16x2_t);return __builtin_bit_cast(unsigned,b);}
#define WAIT_BAR(N) asm volatile("s_waitcnt vmcnt(" #N ") lgkmcnt(0)\n\ts_barrier":::"memory")

__device__ __forceinline__ void qkt(f32x16&p0,f32x16&p1,const char*Kslot,const bf16x8*qr,const f32x16&negm,int r32,int hi){
  const char*kb=Kslot+hi*1024+r32*16;
  #pragma unroll
  for(int d0=0;d0<4;++d0){
    const bf16x8 b0=*reinterpret_cast<const bf16x8*>(kb+d0*2048);
    const bf16x8 b1=*reinterpret_cast<const bf16x8*>(kb+d0*2048+512);
    if(d0==0){p0=__builtin_amdgcn_mfma_f32_32x32x16_bf16(b0,qr[0],negm,0,0,0);p1=__builtin_amdgcn_mfma_f32_32x32x16_bf16(b1,qr[0],negm,0,0,0);}
    else{p0=__builtin_amdgcn_mfma_f32_32x32x16_bf16(b0,qr[d0],p0,0,0,0);p1=__builtin_amdgcn_mfma_f32_32x32x16_bf16(b1,qr[d0],p1,0,0,0);}}
}
typedef __attribute__((address_space(3))) const char* lds_cptr;
typedef short v4i16_t __attribute__((ext_vector_type(4)));
__device__ __forceinline__ void kload8(bf16x8*kf,lds_cptr kp){
  kf[0]=*(const __attribute__((address_space(3))) bf16x8*)(kp);      kf[1]=*(const __attribute__((address_space(3))) bf16x8*)(kp+512);
  kf[2]=*(const __attribute__((address_space(3))) bf16x8*)(kp+2048); kf[3]=*(const __attribute__((address_space(3))) bf16x8*)(kp+2560);
  kf[4]=*(const __attribute__((address_space(3))) bf16x8*)(kp+4096); kf[5]=*(const __attribute__((address_space(3))) bf16x8*)(kp+4608);
  kf[6]=*(const __attribute__((address_space(3))) bf16x8*)(kp+6144); kf[7]=*(const __attribute__((address_space(3))) bf16x8*)(kp+6656);
}
__device__ __forceinline__ void kload2(bf16x8*kf,lds_cptr kp,int j){ kf[2*j]=*(const __attribute__((address_space(3))) bf16x8*)(kp+j*2048); kf[2*j+1]=*(const __attribute__((address_space(3))) bf16x8*)(kp+j*2048+512); }
__device__ __forceinline__ s16x4 vtr(lds_cptr p){ return __builtin_bit_cast(s16x4,__builtin_amdgcn_ds_read_tr16_b64_v4i16((__attribute__((address_space(3))) v4i16_t*)p)); }
__device__ __forceinline__ float rowmax(const f32x16&p0,const f32x16&p1){
  float a=max3f(p0[0],p0[1],p1[0]),b=max3f(p0[2],p0[3],p1[1]);a=max3f(a,p1[2],p1[3]);
  #pragma unroll
  for(int r=4;r<16;r+=4){a=max3f(a,p0[r],p0[r+1]);b=max3f(b,p0[r+2],p0[r+3]);a=max3f(a,p1[r],p1[r+1]);b=max3f(b,p1[r+2],p1[r+3]);}
  const float m=max2f(a,b);
  auto rr=__builtin_amdgcn_permlane32_swap(__float_as_uint(m),__float_as_uint(m),false,false);
  return max2f(__uint_as_float(rr[0]),__uint_as_float(rr[1]));
}
__device__ __forceinline__ void pv(f32x16*o,int vb,bf16x8 pa0,bf16x8 pa1,bf16x8 pa2,bf16x8 pa3){
  #pragma unroll
  for(int d0=0;d0<2;++d0){s16x4 lo[4],hi[4];
    #pragma unroll
    for(int ks=0;ks<4;++ks){
      asm volatile("ds_read_b64_tr_b16 %0,%1 offset:%c2":"=&v"(lo[ks]):"v"(vb),"i"(d0*4096+ks*1024):"memory");
      asm volatile("ds_read_b64_tr_b16 %0,%1 offset:%c2":"=&v"(hi[ks]):"v"(vb),"i"(d0*4096+ks*1024+512):"memory");}
    asm volatile("s_waitcnt lgkmcnt(0)":::"memory");SBAR();
    #define PK(k) (bf16x8){lo[k][0],lo[k][1],lo[k][2],lo[k][3],hi[k][0],hi[k][1],hi[k][2],hi[k][3]}
    o[d0]=__builtin_amdgcn_mfma_f32_32x32x16_bf16(pa0,PK(0),o[d0],0,0,0);
    o[d0]=__builtin_amdgcn_mfma_f32_32x32x16_bf16(pa1,PK(1),o[d0],0,0,0);
    o[d0]=__builtin_amdgcn_mfma_f32_32x32x16_bf16(pa2,PK(2),o[d0],0,0,0);
    o[d0]=__builtin_amdgcn_mfma_f32_32x32x16_bf16(pa3,PK(3),o[d0],0,0,0);
    #undef PK
  }
}

#ifndef ATTN_STORE16
#define ATTN_STORE16(p,v) (*(u32x4*)(p)=(v))
#endif
template<int THRL,bool CAUSAL> __device__ __forceinline__ void attn_unit(const bf16*Qu,const int pQ,const bf16*__restrict__ Kh,const bf16*__restrict__ Vh,const int pKV,bf16*Ou,const int pO,const int NT,char*shm,const int wv=0){
  int tid_=tid_of(wv); asm volatile("":"+v"(tid_));
  const int tid=tid_,lane=tid&63,r32=lane&31,hi=lane>>5; const int wid=__builtin_amdgcn_readfirstlane(tid>>6);
  const bf16*Qw=Qu+(long)(wid*QBLK)*pQ;
  const unsigned lds0=(unsigned)(uintptr_t)shm;
  float*wsf=(float*)(shm+LDS_WS)+wid*64;
  const bf16*ksrc=Kh+(long)lane*pKV+wid*8;
  const bf16*vsrc=Vh+(long)(16*(wid&3)+(lane>>2))*pKV+(wid>>2)*32+(lane&3)*8;
  const unsigned kdst=lds0+LDS_K+wid*1024, vdst=lds0+LDS_V+wid*1024;
  #define DMA_K(t,slot) glds16(ksrc+(long)(t)*KVBLK*pKV,(unsigned)__builtin_amdgcn_readfirstlane(kdst+(slot)))
  #define DMA_V(t,slot) glds16(vsrc+(long)(t)*KVBLK*pKV,(unsigned)__builtin_amdgcn_readfirstlane(vdst+(slot)))
  const int vb0=(int)(lds0+LDS_V)+((lane>>4)&1)*32+(lane&3)*8+(4*hi+((lane&15)>>2))*64;
  const char*Kbase=shm+LDS_K; bf16x8 kf[8];
  const lds_cptr shm3=(lds_cptr)shm; const lds_cptr kp0=shm3+LDS_K+hi*1024+r32*16; const lds_cptr vp0=shm3+LDS_V+((lane>>4)&1)*32+(lane&3)*8+(4*hi+((lane&15)>>2))*64;
  DMA_K(0,0);DMA_V(0,0);DMA_K(1,SLOTB);
  bf16x8 qr[4];
  #pragma unroll
  for(int d0=0;d0<4;++d0)qr[d0]=*reinterpret_cast<const bf16x8*>(&Qw[(long)r32*pQ+d0*16+hi*8]);
  float mhat=0.f,l_reg=0.f;f32x16 o[2];o[0]=f32x16{};o[1]=f32x16{};const f32x16 negm=f32x16{};
  const int qrel=wid*QBLK+r32;
  #define CMASK(P0,P1,t) do{ if(CAUSAL){int jb_=(t)-(NT-4); if(jb_>=0)cmask(P0,P1,jb_,qrel,hi);} }while(0)
  bool resc=false;
  #define START(P0,P1) do{ const float rm=rowmax(P0,P1); resc=false; \
    { const float dl=rm; mhat=fadd_s(mhat,dl); \
      _Pragma("unroll") for(int r=0;r<16;++r){P0[r]=fsub_s(P0[r],dl);P1[r]=fsub_s(P1[r],dl);} \
      } \
    _Pragma("unroll") for(int r=0;r<16;++r)P0[r]=__builtin_amdgcn_exp2f(P0[r]); }while(0)
  #define RESC() do{ if(resc){ asm volatile("s_waitcnt lgkmcnt(0)":::"memory"); \
      _Pragma("unroll") for(int d_=0;d_<2;++d_) _Pragma("unroll") for(int r=0;r<16;++r)o[d_][r]*=wsf[crow(r,hi)]; } }while(0)
  f32x16 pA0,pA1,pB0,pB1;
  int sl_prev=0,sl_cur=0,sl_next=SLOTB;
  #define ROT() do{sl_prev=sl_cur;sl_cur=sl_next;sl_next=(sl_next==(NSLOT-1)*SLOTB)?0:sl_next+SLOTB;}while(0)
  DMA_K(2,2*SLOTB);
  WAIT_BAR(3);
  qkt(pA0,pA1,Kbase,qr,negm,r32,hi);asm volatile("s_nop 15\n\ts_nop 7":"+v"(pA0),"+v"(pA1));CMASK(pA0,pA1,0);
  START(pA0,pA1);
  _Pragma("unroll") for(int r=0;r<16;++r)pA1[r]=__builtin_amdgcn_exp2f(pA1[r]);
  WAIT_BAR(0);
  DMA_K(3,0);DMA_V(1,SLOTB);
  ROT();
  kload8(kf,kp0+sl_cur);
  WAIT_BAR(2);
  s16x4 vlo[8],vhi[8]; u32x4 pw0,pw1,pw2,pw3;
  #define PKW(P,B) cvtpk_s(P[B],P[B+1])
  #define PAF(k) __builtin_bit_cast(bf16x8,pw##k)
  #define VFR(i) (bf16x8){vlo[i][0],vlo[i][1],vlo[i][2],vlo[i][3],vhi[i][0],vhi[i][1],vhi[i][2],vhi[i][3]}
  #define PIN(x) asm volatile("":"+v"(x))
  #define MX3(a,b,c) __builtin_fmaxf(__builtin_fmaxf((a),(b)),(c))
  #define GAPA(MF,A0,A1,A2,A3,W0,W1,PW) do{ MF; sacc+=A0; sacc+=A1; sacc+=A2; sacc+=A3; PIN(sacc); W0; W1; PIN(PW); SBAR(); }while(0)
  #define EX(v) __builtin_amdgcn_exp2f(v)
  #define GAPB(MF,X,B) do{ MF; X[B]=EX(X[B]); X[B+1]=EX(X[B+1]); X[B+2]=EX(X[B+2]); X[B+3]=EX(X[B+3]); PIN(X); SBAR(); }while(0)
  #define VRD(i) do{ vlo[i]=vtr(vp_+(((i)>>2)*4096+((i)&3)*1024)); vhi[i]=vtr(vp_+(((i)>>2)*4096+((i)&3)*1024+512)); }while(0)
  #define KRD(G,j) do{ if(G){ kload2(kf,kp0+sl_next,j); SBAR(); } }while(0)
  #define STEP(C0,C1,P0,P1,t,GK,GV,GL) do{ SBAR(); \
    const lds_cptr vp_=vp0+sl_prev; \
    VRD(0); SBAR(); float sacc=(P0[0]+P0[1]); \
    GAPA(C0=__builtin_amdgcn_mfma_f32_32x32x16_bf16(kf[0],qr[0],negm,0,0,0), P0[2],P0[3],P0[4],P0[5],     pw0[0]=PKW(P0,0), pw0[1]=PKW(P0,2), pw0); \
    VRD(4); SBAR(); GAPA(C1=__builtin_amdgcn_mfma_f32_32x32x16_bf16(kf[1],qr[0],negm,0,0,0), P0[6],P0[7],P0[8],P0[9],     pw0[2]=PKW(P0,4), pw0[3]=PKW(P0,6), pw0); \
    VRD(1); SBAR(); GAPA(C0=__builtin_amdgcn_mfma_f32_32x32x16_bf16(kf[2],qr[1],C0,0,0,0),   P0[10],P0[11],P0[12],P0[13], pw1[0]=PKW(P0,8), pw1[1]=PKW(P0,10), pw1); \
    VRD(5); SBAR(); GAPA(C1=__builtin_amdgcn_mfma_f32_32x32x16_bf16(kf[3],qr[1],C1,0,0,0),   P0[14],P0[15],P1[0],P1[1],   pw1[2]=PKW(P0,12),pw1[3]=PKW(P0,14), pw1); \
    VRD(2); SBAR(); GAPA(C0=__builtin_amdgcn_mfma_f32_32x32x16_bf16(kf[4],qr[2],C0,0,0,0),   P1[2],P1[3],P1[4],P1[5],     pw2[0]=PKW(P1,0), pw2[1]=PKW(P1,2), pw2); \
    VRD(6); SBAR(); GAPA(C1=__builtin_amdgcn_mfma_f32_32x32x16_bf16(kf[5],qr[2],C1,0,0,0),   P1[6],P1[7],P1[8],P1[9],     pw2[2]=PKW(P1,4), pw2[3]=PKW(P1,6), pw2); \
    VRD(3); SBAR(); GAPA(C0=__builtin_amdgcn_mfma_f32_32x32x16_bf16(kf[6],qr[3],C0,0,0,0),   P1[10],P1[11],P1[12],P1[13], pw3[0]=PKW(P1,8), pw3[1]=PKW(P1,10), pw3); \
    VRD(7); SBAR(); GAPA(C1=__builtin_amdgcn_mfma_f32_32x32x16_bf16(kf[7],qr[3],C1,0,0,0),   P1[14],P1[15],0.f,0.f,       pw3[2]=PKW(P1,12),pw3[3]=PKW(P1,14), pw3); \
    l_reg+=sacc; \
    if(GK){DMA_K((t)+3,sl_cur);} if(GV){DMA_V((t)+1,sl_next);} \
    CMASK(C0,C1,t); \
    _Pragma("unroll") for(int r=0;r<16;++r){C0[r]-=mhat;C1[r]-=mhat;} \
    { float a=MX3(C0[0],C0[1],C1[0]),b=MX3(C0[2],C0[3],C1[1]); a=MX3(a,C1[2],C1[3]); \
      _Pragma("unroll") for(int r=4;r<16;r+=4){a=MX3(a,C0[r],C0[r+1]);b=MX3(b,C0[r+2],C0[r+3]);a=MX3(a,C1[r],C1[r+1]);b=MX3(b,C1[r+2],C1[r+3]);} \
      float rm=__builtin_fmaxf(a,b); { auto rr=__builtin_amdgcn_permlane32_swap(__float_as_uint(rm),__float_as_uint(rm),false,false); rm=__builtin_fmaxf(__uint_as_float(rr[0]),__uint_as_float(rr[1])); } \
      resc=false; \
      if(__builtin_expect(__any(rm>(float)THRL),0)){ const float dl=__builtin_fmaxf(rm,0.f); mhat+=dl; \
        _Pragma("unroll") for(int r=0;r<16;++r){C0[r]-=dl;C1[r]-=dl;} \
        const float f=__builtin_amdgcn_exp2f(-dl); l_reg*=f; if(hi==0)wsf[r32]=f; resc=true; } } \
    SBAR(); \
    GAPB(o[0]=__builtin_amdgcn_mfma_f32_32x32x16_bf16(PAF(0),VFR(0),o[0],0,0,0), C0,0); \
    GAPB(o[1]=__builtin_amdgcn_mfma_f32_32x32x16_bf16(PAF(0),VFR(4),o[1],0,0,0), C0,4); \
    KRD(GL,0); GAPB(o[0]=__builtin_amdgcn_mfma_f32_32x32x16_bf16(PAF(1),VFR(1),o[0],0,0,0), C0,8); \
    KRD(GL,1); GAPB(o[1]=__builtin_amdgcn_mfma_f32_32x32x16_bf16(PAF(1),VFR(5),o[1],0,0,0), C0,12); \
    KRD(GL,2); GAPB(o[0]=__builtin_amdgcn_mfma_f32_32x32x16_bf16(PAF(2),VFR(2),o[0],0,0,0), C1,0); \
    KRD(GL,3); GAPB(o[1]=__builtin_amdgcn_mfma_f32_32x32x16_bf16(PAF(2),VFR(6),o[1],0,0,0), C1,4); \
    GAPB(o[0]=__builtin_amdgcn_mfma_f32_32x32x16_bf16(PAF(3),VFR(3),o[0],0,0,0), C1,8); \
    GAPB(o[1]=__builtin_amdgcn_mfma_f32_32x32x16_bf16(PAF(3),VFR(7),o[1],0,0,0), C1,12); \
    }while(0)
  int t=1;
  #undef CMASK
  #define CMASK(P0,P1,t) do{}while(0)
  for(;t+5<NT;t+=2){
    STEP(pB0,pB1,pA0,pA1,t,true,true,true);     WAIT_BAR(2); RESC(); ROT();
    STEP(pA0,pA1,pB0,pB1,t+1,true,true,true);   WAIT_BAR(2); RESC(); ROT();
  }
  #undef CMASK
  #define CMASK(P0,P1,t) do{ if(CAUSAL){int jb_=(t)-(NT-4); if(jb_>=0)cmask(P0,P1,jb_,qrel,hi);} }while(0)
  #define ENDW(tt) do{ if((tt)+3<NT){WAIT_BAR(2);} else if((tt)+2<NT){WAIT_BAR(1);} else {WAIT_BAR(0);} }while(0)
  for(;t+1<NT;t+=2){
    STEP(pB0,pB1,pA0,pA1,t,(t+3<NT),(t+1<NT),(t+1<NT));       ENDW(t);   RESC(); ROT();
    STEP(pA0,pA1,pB0,pB1,t+1,(t+4<NT),(t+2<NT),(t+2<NT));     ENDW(t+1); RESC(); ROT();
  }
  STEP(pB0,pB1,pA0,pA1,NT-1,false,false,false); RESC();
  { float sacc=pB0[0]+pB0[1]; _Pragma("unroll") for(int r=2;r<16;++r)sacc+=pB0[r]; _Pragma("unroll") for(int r=0;r<16;++r)sacc+=pB1[r]; l_reg+=sacc;
    pw0=(u32x4){PKW(pB0,0),PKW(pB0,2),PKW(pB0,4),PKW(pB0,6)};pw1=(u32x4){PKW(pB0,8),PKW(pB0,10),PKW(pB0,12),PKW(pB0,14)};pw2=(u32x4){PKW(pB1,0),PKW(pB1,2),PKW(pB1,4),PKW(pB1,6)};pw3=(u32x4){PKW(pB1,8),PKW(pB1,10),PKW(pB1,12),PKW(pB1,14)};
    SBAR(); pv(o,vb0+sl_cur,PAF(0),PAF(1),PAF(2),PAF(3)); }
  #undef PKW
  #undef PAF
  #undef VFR
  #undef PIN
  #undef MX3
  #undef GAPA
  #undef GAPB
  #undef EX
  #undef VRD
  #undef KRD
  #undef STEP
  #undef ENDW
  {auto rr=__builtin_amdgcn_permlane32_swap(__float_as_uint(l_reg),__float_as_uint(l_reg),false,false);l_reg=__uint_as_float(rr[0])+__uint_as_float(rr[1]);}
  if(hi==0)wsf[32+r32]=l_reg;asm volatile("s_waitcnt lgkmcnt(0)":::"memory");
  float rli[16];
  #pragma unroll
  for(int r=0;r<16;++r)rli[r]=__builtin_amdgcn_rcpf(wsf[32+crow(r,hi)]);
  bf16*Ow=Ou+(long)(wid*QBLK)*pO;
  { bf16*stg=(bf16*)(shm+LDS_OST)+wid*2048;
    #pragma unroll
    for(int r=0;r<16;++r){const int orow=crow(r,hi);
      #pragma unroll
      for(int d0=0;d0<2;++d0)stg[orow*64+d0*32+r32]=__float2bfloat16(o[d0][r]*rli[r]);}
    asm volatile("s_waitcnt lgkmcnt(0)":::"memory");
    #pragma unroll
    for(int i=0;i<4;++i){const int row=i*8+(lane>>3),ch=lane&7; const u32x4 v=*(const u32x4*)(stg+row*64+ch*8); ATTN_STORE16(Ow+(long)row*pO+ch*8,v);} }
  asm volatile("s_waitcnt lgkmcnt(0)\n\ts_barrier":::"memory");
  #undef DMA_K
  #undef DMA_V
  #undef CMASK
  #undef START
  #undef RESC
  #undef ROT
}
__device__ __forceinline__ void mem_attn(const int wv,const bf16*Q0,const int pQ,const bf16*__restrict__ Kh,const bf16*__restrict__ Vh,const int pKV,bf16*O0,const int pO,const int nqb,char*shm){
  int tid_=tid_of(wv); asm volatile("":"+v"(tid_));
  const int tid=tid_,lane=tid&63,r32=lane&31,hi=lane>>5; const int wid=__builtin_amdgcn_readfirstlane(tid>>6);
  constexpr int MK=0,MV=32768,MWS=65536,MOST=65536+2048;
  const unsigned lds0=(unsigned)(uintptr_t)shm;
  const bf16*ksrc=Kh+(long)lane*pKV+wid*8;
  const bf16*vsrc=Vh+(long)(16*(wid&3)+(lane>>2))*pKV+(wid>>2)*32+(lane&3)*8;
  #pragma unroll
  for(int t=0;t<4;++t){ glds16(ksrc+(long)t*KVBLK*pKV,(unsigned)__builtin_amdgcn_readfirstlane(lds0+MK+t*8192+wid*1024)); glds16(vsrc+(long)t*KVBLK*pKV,(unsigned)__builtin_amdgcn_readfirstlane(lds0+MV+t*8192+wid*1024)); }
  WAIT_BAR(0);
  const int vb0=(int)(lds0+MV)+((lane>>4)&1)*32+(lane&3)*8+(4*hi+((lane&15)>>2))*64;
  float*wsf=(float*)(shm+MWS)+wid*64;
  const f32x16 zero=f32x16{};
  for(int qb=0;qb<nqb;++qb){
    const bf16*Qw=Q0+(long)(qb*QB+wid*QBLK)*pQ;
    bf16x8 qr[4];
    #pragma unroll
    for(int d0=0;d0<4;++d0)qr[d0]=*reinterpret_cast<const bf16x8*>(&Qw[(long)r32*pQ+d0*16+hi*8]);
    f32x16 p[4][2];
    #pragma unroll
    for(int t=0;t<4;++t)qkt(p[t][0],p[t][1],shm+MK+t*8192,qr,zero,r32,hi);
    float m=p[0][0][0];
    #pragma unroll
    for(int t=0;t<4;++t)
      #pragma unroll
      for(int j=0;j<2;++j)
        #pragma unroll
        for(int r=0;r<16;++r)m=__builtin_fmaxf(m,p[t][j][r]);
    { auto rr=__builtin_amdgcn_permlane32_swap(__float_as_uint(m),__float_as_uint(m),false,false); m=__builtin_fmaxf(__uint_as_float(rr[0]),__uint_as_float(rr[1])); }
    float l=0.f;
    #pragma unroll
    for(int t=0;t<4;++t)
      #pragma unroll
      for(int j=0;j<2;++j)
        #pragma unroll
        for(int r=0;r<16;++r){ const float e=__builtin_amdgcn_exp2f(p[t][j][r]-m); p[t][j][r]=e; l+=e; }
    { auto rr=__builtin_amdgcn_permlane32_swap(__float_as_uint(l),__float_as_uint(l),false,false); l=__uint_as_float(rr[0])+__uint_as_float(rr[1]); }
    f32x16 o[2]; o[0]=f32x16{}; o[1]=f32x16{};
    #pragma unroll
    for(int t=0;t<4;++t){
      const u32x4 w0={cvtpk_s(p[t][0][0],p[t][0][1]),cvtpk_s(p[t][0][2],p[t][0][3]),cvtpk_s(p[t][0][4],p[t][0][5]),cvtpk_s(p[t][0][6],p[t][0][7])};
      const u32x4 w1={cvtpk_s(p[t][0][8],p[t][0][9]),cvtpk_s(p[t][0][10],p[t][0][11]),cvtpk_s(p[t][0][12],p[t][0][13]),cvtpk_s(p[t][0][14],p[t][0][15])};
      const u32x4 w2={cvtpk_s(p[t][1][0],p[t][1][1]),cvtpk_s(p[t][1][2],p[t][1][3]),cvtpk_s(p[t][1][4],p[t][1][5]),cvtpk_s(p[t][1][6],p[t][1][7])};
      const u32x4 w3={cvtpk_s(p[t][1][8],p[t][1][9]),cvtpk_s(p[t][1][10],p[t][1][11]),cvtpk_s(p[t][1][12],p[t][1][13]),cvtpk_s(p[t][1][14],p[t][1][15])};
      pv(o,vb0+t*8192,__builtin_bit_cast(bf16x8,w0),__builtin_bit_cast(bf16x8,w1),__builtin_bit_cast(bf16x8,w2),__builtin_bit_cast(bf16x8,w3)); }
    if(hi==0)wsf[32+r32]=l; asm volatile("s_waitcnt lgkmcnt(0)":::"memory");
    float rli[16];
    #pragma unroll
    for(int r=0;r<16;++r)rli[r]=__builtin_amdgcn_rcpf(wsf[32+crow(r,hi)]);
    bf16*Ow=O0+(long)(qb*QB+wid*QBLK)*pO;
    { bf16*stg=(bf16*)(shm+MOST)+wid*2048;
      #pragma unroll
      for(int r=0;r<16;++r){const int orow=crow(r,hi);
        #pragma unroll
        for(int d0=0;d0<2;++d0)stg[orow*64+d0*32+r32]=__float2bfloat16(o[d0][r]*rli[r]);}
      asm volatile("s_waitcnt lgkmcnt(0)":::"memory");
      #pragma unroll
      for(int i=0;i<4;++i){const int row=i*8+(lane>>3),ch=lane&7; const u32x4 v=*(const u32x4*)(stg+row*64+ch*8); ATTN_STORE16(Ow+(long)row*pO+ch*8,v);}
      asm volatile("s_waitcnt lgkmcnt(0)":::"memory"); }
  }
  asm volatile("s_waitcnt lgkmcnt(0)\n\ts_barrier":::"memory");
}
constexpr int ATTN_LDS_BYTES=LDS_BYTES;
#undef SBAR
#undef WAIT_BAR
}
namespace attn2 {
using bf16=__hip_bfloat16;
using bf16x8=__attribute__((ext_vector_type(8)))short;
using s16x4=__attribute__((ext_vector_type(4)))short;
using f32x16=__attribute__((ext_vector_type(16)))float;
using u32x4=__attribute__((ext_vector_type(4)))unsigned;
constexpr int D=64;
constexpr int NW=8,QBLK=32,QB=QBLK*NW,KVBLK=64;
constexpr int ATTN_UNIT_ROWS=QB;
__device__ __forceinline__ int crow(int r,int hi){return (r&3)+8*(r>>2)+4*hi;}
#define SBAR() __builtin_amdgcn_sched_barrier(0)
__device__ __forceinline__ void cmask(f32x16&p0,f32x16&p1,int jb,int qrel,int hi){
  const float NEG=-INFINITY; int kb=64*jb+4*hi;
  #pragma unroll
  for(int r=0;r<16;++r){int kv=kb+(r&3)+8*(r>>2); if(kv>qrel)p0[r]=NEG; if(kv+32>qrel)p1[r]=NEG;}
}

constexpr int NSLOT=3, SLOTB=8192;
constexpr int LDS_K=0, LDS_V=NSLOT*SLOTB, LDS_WS=3*NSLOT*SLOTB, LDS_OST=LDS_WS+NW*64*4, LDS_BYTES=LDS_OST+NW*4096;
constexpr float C2=0.125f*1.4426950408889634f;
__device__ __forceinline__ void glds16(const void*gsrc,unsigned lds_dst){unsigned keep;
  asm volatile("s_mov_b32 %0, m0\n\ts_mov_b32 m0, %2\n\ts_nop 0\n\tglobal_load_lds_dwordx4 %1, off\n\ts_mov_b32 m0, %0":"=&s"(keep):"v"(gsrc),"s"(lds_dst):"memory");}
__device__ __forceinline__ float max3f(float a,float b,float c){float r;asm("v_max3_f32 %0, %1, %2, %3":"=v"(r):"v"(a),"v"(b),"v"(c));return r;}
__device__ __forceinline__ float max2f(float a,float b){float r;asm("v_max_f32_e32 %0, %1, %2":"=v"(r):"v"(a),"v"(b));return r;}
__device__ __forceinline__ float fadd_s(float a,float b){float r;asm("v_add_f32_e32 %0, %1, %2":"=v"(r):"v"(a),"v"(b));return r;}
__device__ __forceinline__ float fsub_s(float a,float b){float r;asm("v_sub_f32_e32 %0, %1, %2":"=v"(r):"v"(a),"v"(b));return r;}
typedef float f32x2_t __attribute__((ext_vector_type(2))); typedef __bf16 bf16x2_t __attribute__((ext_vector_type(2)));
__device__ __forceinline__ unsigned cvtpk_s(float lo,float hi){f32x2_t v={lo,hi};bf16x2_t b=__builtin_convertvector(v,bf16x2_t);return __builtin_bit_cast(unsigned,b);}
#define WAIT_BAR(N) asm volatile("s_waitcnt vmcnt(" #N ") lgkmcnt(0)\n\ts_barrier":::"memory")

__device__ __forceinline__ void qkt(f32x16&p0,f32x16&p1,const char*Kslot,const bf16x8*qr,const f32x16&negm,int r32,int hi){
  const char*kb=Kslot+hi*1024+r32*16;
  #pragma unroll
  for(int d0=0;d0<4;++d0){
    const bf16x8 b0=*reinterpret_cast<const bf16x8*>(kb+d0*2048);
    const bf16x8 b1=*reinterpret_cast<const bf16x8*>(kb+d0*2048+512);
    if(d0==0){p0=__builtin_amdgcn_mfma_f32_32x32x16_bf16(b0,qr[0],negm,0,0,0);p1=__builtin_amdgcn_mfma_f32_32x32x16_bf16(b1,qr[0],negm,0,0,0);}
    else{p0=__builtin_amdgcn_mfma_f32_32x32x16_bf16(b0,qr[d0],p0,0,0,0);p1=__builtin_amdgcn_mfma_f32_32x32x16_bf16(b1,qr[d0],p1,0,0,0);}}
}
typedef __attribute__((address_space(3))) const char* lds_cptr;
typedef short v4i16_t __attribute__((ext_vector_type(4)));
__device__ __forceinline__ void kload8(bf16x8*kf,lds_cptr kp){
  kf[0]=*(const __attribute__((address_space(3))) bf16x8*)(kp);      kf[1]=*(const __attribute__((address_space(3))) bf16x8*)(kp+512);
  kf[2]=*(const __attribute__((address_space(3))) bf16x8*)(kp+2048); kf[3]=*(const __attribute__((address_space(3))) bf16x8*)(kp+2560);
  kf[4]=*(const __attribute__((address_space(3))) bf16x8*)(kp+4096); kf[5]=*(const __attribute__((address_space(3))) bf16x8*)(kp+4608);
  kf[6]=*(const __attribute__((address_space(3))) bf16x8*)(kp+6144); kf[7]=*(const __attribute__((address_space(3))) bf16x8*)(kp+6656);
}
__device__ __forceinline__ void kload2(bf16x8*kf,lds_cptr kp,int j){ kf[2*j]=*(const __attribute__((address_space(3))) bf16x8*)(kp+j*2048); kf[2*j+1]=*(const __attribute__((address_space(3))) bf16x8*)(kp+j*2048+512); }
__device__ __forceinline__ s16x4 vtr(lds_cptr p){ return __builtin_bit_cast(s16x4,__builtin_amdgcn_ds_read_tr16_b64_v4i16((__attribute__((address_space(3))) v4i16_t*)p)); }
__device__ __forceinline__ float rowmax(const f32x16&p0,const f32x16&p1){
  float a=max3f(p0[0],p0[1],p1[0]),b=max3f(p0[2],p0[3],p1[1]);a=max3f(a,p1[2],p1[3]);
  #pragma unroll
  for(int r=4;r<16;r+=4){a=max3f(a,p0[r],p0[r+1]);b=max3f(b,p0[r+2],p0[r+3]);a=max3f(a,p1[r],p1[r+1]);b=max3f(b,p1[r+2],p1[r+3]);}
  const float m=max2f(a,b);
  auto rr=__builtin_amdgcn_permlane32_swap(__float_as_uint(m),__float_as_uint(m),false,false);
  return max2f(__uint_as_float(rr[0]),__uint_as_float(rr[1]));
}
__device__ __forceinline__ void pv(f32x16*o,int vb,bf16x8 pa0,bf16x8 pa1,bf16x8 pa2,bf16x8 pa3){
  #pragma unroll
  for(int d0=0;d0<4;++d0){s16x4 lo[4],hi[4];
    #pragma unroll
    for(int ks=0;ks<4;++ks){
      asm volatile("ds_read_b64_tr_b16 %0,%1 offset:%c2":"=&v"(lo[ks]):"v"(vb),"i"(d0*4096+ks*1024):"memory");
      asm volatile("ds_read_b64_tr_b16 %0,%1 offset:%c2":"=&v"(hi[ks]):"v"(vb),"i"(d0*4096+ks*1024+512):"memory");}
    asm volatile("s_waitcnt lgkmcnt(0)":::"memory");SBAR();
    #define PK(k) (bf16x8){lo[k][0],lo[k][1],lo[k][2],lo[k][3],hi[k][0],hi[k][1],hi[k][2],hi[k][3]}
    o[d0]=__builtin_amdgcn_mfma_f32_32x32x16_bf16(pa0,PK(0),o[d0],0,0,0);
    o[d0]=__builtin_amdgcn_mfma_f32_32x32x16_bf16(pa1,PK(1),o[d0],0,0,0);
    o[d0]=__builtin_amdgcn_mfma_f32_32x32x16_bf16(pa2,PK(2),o[d0],0,0,0);
    o[d0]=__builtin_amdgcn_mfma_f32_32x32x16_bf16(pa3,PK(3),o[d0],0,0,0);
    #undef PK
  }
}

#ifndef ATTN_STORE16
#define ATTN_STORE16(p,v) (*(u32x4*)(p)=(v))
#endif
template<int THRL,bool CAUSAL,bool COMBINE=false> __device__ __forceinline__ void attn_unit(const bf16*Qu,const int pQ,const bf16*__restrict__ Kh,const bf16*__restrict__ Vh,const int pKV,const int wv,bf16*Ou,const int pO,const int NT,char*shm,const bf16*S0=nullptr,const int pS=0,const float lam=0.f,const float*sgp=nullptr){
  int tid_=tid_of(wv); asm volatile("":"+v"(tid_));
  const int tid=tid_,lane=tid&63,r32=lane&31,hi=lane>>5; const int wid=__builtin_amdgcn_readfirstlane(tid>>6);
  const bf16*Qw=Qu+(long)(wid*QBLK)*pQ;
  const unsigned lds0=(unsigned)(uintptr_t)shm;
  float*wsf=(float*)(shm+LDS_WS)+wid*64;
  const bf16*ksrc=Kh+(long)lane*pKV+wid*8;
  const bf16*vsrc=Vh+(long)(16*(wid&3)+(lane>>2))*pKV+(wid>>2)*32+(lane&3)*8;
  const unsigned kdst=lds0+LDS_K+wid*1024, vdst=lds0+LDS_V+wid*1024;
  #define DMA_K(t,slot) glds16(ksrc+(long)(t)*KVBLK*pKV,(unsigned)__builtin_amdgcn_readfirstlane(kdst+(slot)))
  #define DMA_V(t,slot) do{ glds16(vsrc+(long)(t)*KVBLK*pKV,(unsigned)__builtin_amdgcn_readfirstlane(vdst+2*(slot))); glds16(vsrc+(long)(t)*KVBLK*pKV+64,(unsigned)__builtin_amdgcn_readfirstlane(vdst+2*(slot)+8192)); }while(0)
  const int vb0=(int)(lds0+LDS_V)+((lane>>4)&1)*32+(lane&3)*8+(4*hi+((lane&15)>>2))*64;
  const char*Kbase=shm+LDS_K; bf16x8 kf[8];
  const lds_cptr shm3=(lds_cptr)shm; const lds_cptr kp0=shm3+LDS_K+hi*1024+r32*16; const lds_cptr vp0=shm3+LDS_V+((lane>>4)&1)*32+(lane&3)*8+(4*hi+((lane&15)>>2))*64;
  DMA_K(0,0);DMA_V(0,0);DMA_K(1,SLOTB);
  bf16x8 qr[4];
  #pragma unroll
  for(int d0=0;d0<4;++d0)qr[d0]=*reinterpret_cast<const bf16x8*>(&Qw[(long)r32*pQ+d0*16+hi*8]);
  float mhat=0.f,l_reg=0.f;f32x16 o[4];o[0]=f32x16{};o[1]=f32x16{};o[2]=f32x16{};o[3]=f32x16{};const f32x16 negm=f32x16{};
  const int qrel=wid*QBLK+r32;
  #define CMASK(P0,P1,t) do{ if(CAUSAL){int jb_=(t)-(NT-4); if(jb_>=0)cmask(P0,P1,jb_,qrel,hi);} }while(0)
  bool resc=false;
  #define START(P0,P1) do{ const float rm=rowmax(P0,P1); resc=false; \
    { const float dl=rm; mhat=fadd_s(mhat,dl); \
      _Pragma("unroll") for(int r=0;r<16;++r){P0[r]=fsub_s(P0[r],dl);P1[r]=fsub_s(P1[r],dl);} \
      } \
    _Pragma("unroll") for(int r=0;r<16;++r)P0[r]=__builtin_amdgcn_exp2f(P0[r]); }while(0)
  #define RESC() do{ if(resc){ asm volatile("s_waitcnt lgkmcnt(0)":::"memory"); \
      _Pragma("unroll") for(int d_=0;d_<4;++d_) _Pragma("unroll") for(int r=0;r<16;++r)o[d_][r]*=wsf[crow(r,hi)]; } }while(0)
  f32x16 pA0,pA1,pB0,pB1;
  int sl_prev=0,sl_cur=0,sl_next=SLOTB;
  #define ROT() do{sl_prev=sl_cur;sl_cur=sl_next;sl_next=(sl_next==(NSLOT-1)*SLOTB)?0:sl_next+SLOTB;}while(0)
  DMA_K(2,2*SLOTB);
  WAIT_BAR(4);
  qkt(pA0,pA1,Kbase,qr,negm,r32,hi);asm volatile("s_nop 15\n\ts_nop 7":"+v"(pA0),"+v"(pA1));CMASK(pA0,pA1,0);
  START(pA0,pA1);
  _Pragma("unroll") for(int r=0;r<16;++r)pA1[r]=__builtin_amdgcn_exp2f(pA1[r]);
  WAIT_BAR(0);
  DMA_K(3,0);DMA_V(1,SLOTB);
  ROT();
  kload8(kf,kp0+sl_cur);
  WAIT_BAR(3);
  s16x4 vlo[8],vhi[8]; u32x4 pw0,pw1,pw2,pw3;
  #define PKW(P,B) cvtpk_s(P[B],P[B+1])
  #define PAF(k) __builtin_bit_cast(bf16x8,pw##k)
  #define VFR(i) (bf16x8){vlo[i][0],vlo[i][1],vlo[i][2],vlo[i][3],vhi[i][0],vhi[i][1],vhi[i][2],vhi[i][3]}
  #define PIN(x) asm volatile("":"+v"(x))
  #define MX3(a,b,c) __builtin_fmaxf(__builtin_fmaxf((a),(b)),(c))
  #define GAPA(MF,A0,A1,A2,A3,W0,W1,PW) do{ MF; sacc+=A0; sacc+=A1; sacc+=A2; sacc+=A3; PIN(sacc); W0; W1; PIN(PW); SBAR(); }while(0)
  #define EX(v) __builtin_amdgcn_exp2f(v)
  #define GAPB(MF,X,B) do{ MF; X[B]=EX(X[B]); X[B+1]=EX(X[B+1]); X[B+2]=EX(X[B+2]); X[B+3]=EX(X[B+3]); PIN(X); SBAR(); }while(0)
  #define VRD(i) do{ vlo[i]=vtr(vp_+(((i)>>2)*4096+((i)&3)*1024)); vhi[i]=vtr(vp_+(((i)>>2)*4096+((i)&3)*1024+512)); }while(0)
  #define VRD2(i) do{ vlo[i]=vtr(vp_+((((i)>>2)+2)*4096+((i)&3)*1024)); vhi[i]=vtr(vp_+((((i)>>2)+2)*4096+((i)&3)*1024+512)); }while(0)
  #define GAPB2(MF,X,B) do{ MF; X[B]=EX(X[B]); X[B+1]=EX(X[B+1]); PIN(X); SBAR(); }while(0)
  #define KRD(G,j) do{ if(G){ kload2(kf,kp0+sl_next,j); SBAR(); } }while(0)
  #define STEP(C0,C1,P0,P1,t,GK,GV,GL) do{ SBAR(); \
    const lds_cptr vp_=vp0+2*sl_prev; \
    VRD(0); SBAR(); float sacc=(P0[0]+P0[1]); \
    GAPA(C0=__builtin_amdgcn_mfma_f32_32x32x16_bf16(kf[0],qr[0],negm,0,0,0), P0[2],P0[3],P0[4],P0[5],     pw0[0]=PKW(P0,0), pw0[1]=PKW(P0,2), pw0); \
    VRD(4); SBAR(); GAPA(C1=__builtin_amdgcn_mfma_f32_32x32x16_bf16(kf[1],qr[0],negm,0,0,0), P0[6],P0[7],P0[8],P0[9],     pw0[2]=PKW(P0,4), pw0[3]=PKW(P0,6), pw0); \
    VRD(1); SBAR(); GAPA(C0=__builtin_amdgcn_mfma_f32_32x32x16_bf16(kf[2],qr[1],C0,0,0,0),   P0[10],P0[11],P0[12],P0[13], pw1[0]=PKW(P0,8), pw1[1]=PKW(P0,10), pw1); \
    VRD(5); SBAR(); GAPA(C1=__builtin_amdgcn_mfma_f32_32x32x16_bf16(kf[3],qr[1],C1,0,0,0),   P0[14],P0[15],P1[0],P1[1],   pw1[2]=PKW(P0,12),pw1[3]=PKW(P0,14), pw1); \
    VRD(2); SBAR(); GAPA(C0=__builtin_amdgcn_mfma_f32_32x32x16_bf16(kf[4],qr[2],C0,0,0,0),   P1[2],P1[3],P1[4],P1[5],     pw2[0]=PKW(P1,0), pw2[1]=PKW(P1,2), pw2); \
    VRD(6); SBAR(); GAPA(C1=__builtin_amdgcn_mfma_f32_32x32x16_bf16(kf[5],qr[2],C1,0,0,0),   P1[6],P1[7],P1[8],P1[9],     pw2[2]=PKW(P1,4), pw2[3]=PKW(P1,6), pw2); \
    VRD(3); SBAR(); GAPA(C0=__builtin_amdgcn_mfma_f32_32x32x16_bf16(kf[6],qr[3],C0,0,0,0),   P1[10],P1[11],P1[12],P1[13], pw3[0]=PKW(P1,8), pw3[1]=PKW(P1,10), pw3); \
    VRD(7); SBAR(); GAPA(C1=__builtin_amdgcn_mfma_f32_32x32x16_bf16(kf[7],qr[3],C1,0,0,0),   P1[14],P1[15],0.f,0.f,       pw3[2]=PKW(P1,12),pw3[3]=PKW(P1,14), pw3); \
    l_reg+=sacc; \
    if(GK){DMA_K((t)+3,sl_cur);} if(GV){DMA_V((t)+1,sl_next);} \
    CMASK(C0,C1,t); \
    _Pragma("unroll") for(int r=0;r<16;++r){C0[r]-=mhat;C1[r]-=mhat;} \
    { float a=MX3(C0[0],C0[1],C1[0]),b=MX3(C0[2],C0[3],C1[1]); a=MX3(a,C1[2],C1[3]); \
      _Pragma("unroll") for(int r=4;r<16;r+=4){a=MX3(a,C0[r],C0[r+1]);b=MX3(b,C0[r+2],C0[r+3]);a=MX3(a,C1[r],C1[r+1]);b=MX3(b,C1[r+2],C1[r+3]);} \
      float rm=__builtin_fmaxf(a,b); { auto rr=__builtin_amdgcn_permlane32_swap(__float_as_uint(rm),__float_as_uint(rm),false,false); rm=__builtin_fmaxf(__uint_as_float(rr[0]),__uint_as_float(rr[1])); } \
      resc=false; \
      if(__builtin_expect(__any(rm>(float)THRL),0)){ const float dl=__builtin_fmaxf(rm,0.f); mhat+=dl; \
        _Pragma("unroll") for(int r=0;r<16;++r){C0[r]-=dl;C1[r]-=dl;} \
        const float f=__builtin_amdgcn_exp2f(-dl); l_reg*=f; if(hi==0)wsf[r32]=f; resc=true; } } \
    SBAR(); \
    GAPB2(o[0]=__builtin_amdgcn_mfma_f32_32x32x16_bf16(PAF(0),VFR(0),o[0],0,0,0), C0,0); VRD2(0); SBAR(); \
    GAPB2(o[1]=__builtin_amdgcn_mfma_f32_32x32x16_bf16(PAF(0),VFR(4),o[1],0,0,0), C0,2); VRD2(4); SBAR(); \
    KRD(GL,0); GAPB2(o[0]=__builtin_amdgcn_mfma_f32_32x32x16_bf16(PAF(1),VFR(1),o[0],0,0,0), C0,4); VRD2(1); SBAR(); \
    KRD(GL,1); GAPB2(o[1]=__builtin_amdgcn_mfma_f32_32x32x16_bf16(PAF(1),VFR(5),o[1],0,0,0), C0,6); VRD2(5); SBAR(); \
    KRD(GL,2); GAPB2(o[0]=__builtin_amdgcn_mfma_f32_32x32x16_bf16(PAF(2),VFR(2),o[0],0,0,0), C0,8); VRD2(2); SBAR(); \
    KRD(GL,3); GAPB2(o[1]=__builtin_amdgcn_mfma_f32_32x32x16_bf16(PAF(2),VFR(6),o[1],0,0,0), C0,10); VRD2(6); SBAR(); \
    GAPB2(o[0]=__builtin_amdgcn_mfma_f32_32x32x16_bf16(PAF(3),VFR(3),o[0],0,0,0), C0,12); VRD2(3); SBAR(); \
    GAPB2(o[1]=__builtin_amdgcn_mfma_f32_32x32x16_bf16(PAF(3),VFR(7),o[1],0,0,0), C0,14); VRD2(7); SBAR(); \
    GAPB2(o[2]=__builtin_amdgcn_mfma_f32_32x32x16_bf16(PAF(0),VFR(0),o[2],0,0,0), C1,0); \
    GAPB2(o[3]=__builtin_amdgcn_mfma_f32_32x32x16_bf16(PAF(0),VFR(4),o[3],0,0,0), C1,2); \
    GAPB2(o[2]=__builtin_amdgcn_mfma_f32_32x32x16_bf16(PAF(1),VFR(1),o[2],0,0,0), C1,4); \
    GAPB2(o[3]=__builtin_amdgcn_mfma_f32_32x32x16_bf16(PAF(1),VFR(5),o[3],0,0,0), C1,6); \
    GAPB2(o[2]=__builtin_amdgcn_mfma_f32_32x32x16_bf16(PAF(2),VFR(2),o[2],0,0,0), C1,8); \
    GAPB2(o[3]=__builtin_amdgcn_mfma_f32_32x32x16_bf16(PAF(2),VFR(6),o[3],0,0,0), C1,10); \
    GAPB2(o[2]=__builtin_amdgcn_mfma_f32_32x32x16_bf16(PAF(3),VFR(3),o[2],0,0,0), C1,12); \
    GAPB2(o[3]=__builtin_amdgcn_mfma_f32_32x32x16_bf16(PAF(3),VFR(7),o[3],0,0,0), C1,14); \
    }while(0)
  int t=1;
  #undef CMASK
  #define CMASK(P0,P1,t) do{}while(0)
  for(;t+5<NT;t+=2){
    STEP(pB0,pB1,pA0,pA1,t,true,true,true);     WAIT_BAR(3); RESC(); ROT();
    STEP(pA0,pA1,pB0,pB1,t+1,true,true,true);   WAIT_BAR(3); RESC(); ROT();
  }
  #undef CMASK
  #define CMASK(P0,P1,t) do{ if(CAUSAL){int jb_=(t)-(NT-4); if(jb_>=0)cmask(P0,P1,jb_,qrel,hi);} }while(0)
  #define ENDW(tt) do{ if((tt)+3<NT){WAIT_BAR(3);} else if((tt)+2<NT){WAIT_BAR(2);} else {WAIT_BAR(0);} }while(0)
  for(;t+1<NT;t+=2){
    STEP(pB0,pB1,pA0,pA1,t,(t+3<NT),(t+1<NT),(t+1<NT));       ENDW(t);   RESC(); ROT();
    STEP(pA0,pA1,pB0,pB1,t+1,(t+4<NT),(t+2<NT),(t+2<NT));     ENDW(t+1); RESC(); ROT();
  }
  STEP(pB0,pB1,pA0,pA1,NT-1,false,false,false); RESC();
  { float sacc=pB0[0]+pB0[1]; _Pragma("unroll") for(int r=2;r<16;++r)sacc+=pB0[r]; _Pragma("unroll") for(int r=0;r<16;++r)sacc+=pB1[r]; l_reg+=sacc;
    pw0=(u32x4){PKW(pB0,0),PKW(pB0,2),PKW(pB0,4),PKW(pB0,6)};pw1=(u32x4){PKW(pB0,8),PKW(pB0,10),PKW(pB0,12),PKW(pB0,14)};pw2=(u32x4){PKW(pB1,0),PKW(pB1,2),PKW(pB1,4),PKW(pB1,6)};pw3=(u32x4){PKW(pB1,8),PKW(pB1,10),PKW(pB1,12),PKW(pB1,14)};
    SBAR(); pv(o,vb0+2*sl_cur,PAF(0),PAF(1),PAF(2),PAF(3)); }
  #undef PKW
  #undef PAF
  #undef VFR
  #undef PIN
  #undef MX3
  #undef GAPA
  #undef GAPB
  #undef EX
  #undef VRD
  #undef VRD2
  #undef GAPB2
  #undef KRD
  #undef STEP
  #undef ENDW
  {auto rr=__builtin_amdgcn_permlane32_swap(__float_as_uint(l_reg),__float_as_uint(l_reg),false,false);l_reg=__uint_as_float(rr[0])+__uint_as_float(rr[1]);}
  if(hi==0)wsf[32+r32]=l_reg;asm volatile("s_waitcnt lgkmcnt(0)":::"memory");
  float rli[16];
  #pragma unroll
  for(int r=0;r<16;++r)rli[r]=__builtin_amdgcn_rcpf(wsf[32+crow(r,hi)]);
  bf16*Ow=Ou+(long)(wid*QBLK)*pO;
  { bf16*stg=(bf16*)(shm+LDS_OST)+wid*2048;
    const bf16*Sw=S0+(long)(wid*QBLK)*pS;
    float xs[2][4][8];
    #pragma unroll
    for(int hf=0;hf<2;++hf){
      #pragma unroll
      for(int r=0;r<16;++r){const int orow=crow(r,hi);
        #pragma unroll
        for(int d0=0;d0<2;++d0)stg[orow*64+d0*32+r32]=__float2bfloat16(o[2*hf+d0][r]*rli[r]);}
      asm volatile("s_waitcnt lgkmcnt(0)":::"memory");
      #pragma unroll
      for(int i=0;i<4;++i){const int row=i*8+(lane>>3),ch=lane&7; const u32x4 v=*(const u32x4*)(stg+row*64+ch*8);
        if constexpr(!COMBINE){ ATTN_STORE16(Ow+(long)row*pO+hf*64+ch*8,v); }
        else { const u32x4 a=*(const u32x4*)(Sw+(long)row*pS+hf*64+ch*8);
          #define BL(w) __uint_as_float((w)<<16)
          #define BH(w) __uint_as_float((w)&0xffff0000u)
          xs[hf][i][0]=BL(a.x)-lam*BL(v.x); xs[hf][i][1]=BH(a.x)-lam*BH(v.x); xs[hf][i][2]=BL(a.y)-lam*BL(v.y); xs[hf][i][3]=BH(a.y)-lam*BH(v.y);
          xs[hf][i][4]=BL(a.z)-lam*BL(v.z); xs[hf][i][5]=BH(a.z)-lam*BH(v.z); xs[hf][i][6]=BL(a.w)-lam*BL(v.w); xs[hf][i][7]=BH(a.w)-lam*BH(v.w);
          #undef BL
          #undef BH
        } }
      asm volatile("s_waitcnt lgkmcnt(0)":::"memory"); }
    if constexpr(COMBINE){
      float sg[16];
      #pragma unroll
      for(int q=0;q<16;++q)sg[q]=sgp[(q>>3)*64+(lane&7)*8+(q&7)]*0.8f;
      #pragma unroll
      for(int i=0;i<4;++i){ const int row=i*8+(lane>>3),ch=lane&7; float ss=0.f;
        #pragma unroll
        for(int hf=0;hf<2;++hf)
          #pragma unroll
          for(int q=0;q<8;++q)ss+=xs[hf][i][q]*xs[hf][i][q];
        ss+=__shfl_xor(ss,1);ss+=__shfl_xor(ss,2);ss+=__shfl_xor(ss,4);
        const float rn=1.f/sqrtf(ss*(1.f/128.f)+1e-6f);
        #pragma unroll
        for(int hf=0;hf<2;++hf){ u32x4 w;
          w.x=cvtpk_s(xs[hf][i][0]*rn*sg[hf*8+0],xs[hf][i][1]*rn*sg[hf*8+1]); w.y=cvtpk_s(xs[hf][i][2]*rn*sg[hf*8+2],xs[hf][i][3]*rn*sg[hf*8+3]);
          w.z=cvtpk_s(xs[hf][i][4]*rn*sg[hf*8+4],xs[hf][i][5]*rn*sg[hf*8+5]); w.w=cvtpk_s(xs[hf][i][6]*rn*sg[hf*8+6],xs[hf][i][7]*rn*sg[hf*8+7]);
          ATTN_STORE16(Ow+(long)row*pO+hf*64+ch*8,w); } } } }
  asm volatile("s_waitcnt lgkmcnt(0)\n\ts_barrier":::"memory");
  #undef DMA_K
  #undef DMA_V
  #undef CMASK
  #undef START
  #undef RESC
  #undef ROT
}
constexpr int ATTN_LDS_BYTES=LDS_BYTES;
#undef SBAR
#undef WAIT_BAR
}

constexpr int NWAVES = 8;
#ifndef MK_N_LAUNCHES
#define MK_N_LAUNCHES 1
#endif
constexpr int NPH = 10;
constexpr int BATCH = 32, SEQ = 2048, D = 1024, T = BATCH * SEQ, NMEM = 256, TM = BATCH * NMEM;
constexpr int INCOLS = 5120, PROJW = 2048, GATEW = 3072;
constexpr float RMS_EPS = 1e-6f;
constexpr int NEXP = 16, EH = 512;
constexpr int MAXROWS = 2 * T + NEXP * 256;
constexpr size_t MiB = 1u << 20;
constexpr size_t WS_CTL = 0, CTL_ZERO_BYTES = 64 * 1024;
constexpr size_t WS_WRF = 1 * MiB;
constexpr size_t WS_RINV = 1 * MiB + 128 * 1024;
constexpr size_t WS_WIN = 2 * MiB;
constexpr size_t WS_PC = 13 * MiB;
constexpr size_t WS_WO = 15 * MiB;
constexpr size_t WS_WGU = 17 * MiB;
constexpr size_t WS_WD = 49 * MiB;
constexpr size_t WS_ROUTE = 65 * MiB;
constexpr size_t WS_KV = 68 * MiB;
constexpr size_t WS_XN = 76 * MiB;
constexpr size_t WS_BR = 76 * MiB;
constexpr size_t WS_H2 = 76 * MiB;
constexpr size_t WS_PROJ = 220 * MiB;
constexpr size_t WS_MERGED = 220 * MiB;
constexpr size_t WS_MIX = 348 * MiB;
constexpr size_t WS_HID = 220 * MiB;
constexpr size_t WS_ATTO = 476 * MiB;
constexpr size_t WS_GATES = 604 * MiB;
constexpr size_t WS_LIST = 476 * MiB;
constexpr size_t WS_RWE = 480 * MiB;
constexpr size_t WS_Y = 604 * MiB;
constexpr size_t WS_END = 988 * MiB;
static_assert(WS_XN + (size_t)(T + TM) * D * 2 <= WS_PROJ && WS_PROJ + (size_t)T * PROJW * 2 <= WS_ATTO && WS_ATTO + (size_t)T * D * 2 <= WS_GATES && WS_GATES + (size_t)T * GATEW * 2 <= WS_END, "ws map");
static_assert(WS_Y + (size_t)MAXROWS * D * 2 <= WS_END && WS_HID + (size_t)MAXROWS * EH * 2 <= WS_ATTO && WS_RWE + (size_t)NEXP * 65536 * 8 <= WS_GATES, "ws map 2");
constexpr int CW_CNT = 64;
constexpr int RING_OFF = 0, RING_BYTES = 131072;
constexpr int LDSX_OFF = RING_BYTES;
constexpr int LDS_BYTES = 147456;

#define GAS __attribute__((address_space(1)))
#define LAS __attribute__((address_space(3)))
typedef unsigned short bf16;
typedef unsigned v4u __attribute__((ext_vector_type(4)));
typedef unsigned v2u __attribute__((ext_vector_type(2)));
typedef float f32x4 __attribute__((ext_vector_type(4)));
#define LDS_WAIT() asm volatile("s_waitcnt lgkmcnt(0)" ::: "memory")
__device__ __forceinline__ unsigned f2bf(float f) { unsigned u = __builtin_bit_cast(unsigned, f); return (u + 0x7fffu + ((u >> 16) & 1u)) >> 16; }
__device__ __forceinline__ unsigned pk2(float lo, float hi) { return f2bf(lo) | (f2bf(hi) << 16); }
typedef float f32x2_t __attribute__((ext_vector_type(2))); typedef __bf16 bf16x2_t __attribute__((ext_vector_type(2)));
typedef short bf16x8_t __attribute__((ext_vector_type(8))); typedef float f32x16_t __attribute__((ext_vector_type(16)));
__device__ __forceinline__ unsigned cvtpk(float lo, float hi) { f32x2_t v = {lo, hi}; bf16x2_t b = __builtin_convertvector(v, bf16x2_t); return __builtin_bit_cast(unsigned, b); }
__device__ __forceinline__ float bflo(unsigned w) { return __uint_as_float(w << 16); }
__device__ __forceinline__ float bfhi(unsigned w) { return __uint_as_float(w & 0xffff0000u); }
__device__ __forceinline__ float wave_sum(float v) {
#pragma unroll
    for (int o = 1; o < 64; o <<= 1) v += __shfl_xor(v, o);
    return v;
}

typedef GAS unsigned gu32;
#define RLX_AGENT __ATOMIC_RELAXED, __HIP_MEMORY_SCOPE_AGENT
constexpr int CW_BAR = 4096;
constexpr int CW_TS = 128;
#define XB_TMO      128
#define XB_XCNT(j)  (256  + 64 * (j))
#define XB_XSUB(j)  (1280 + 64 * (j))
#define XB_XGEN(j)  (2304 + 64 * (j))
#define XB_TOP      3328
#define XB_TOPGEN   3392
#define XCD_BAR_WORDS 3456
#define XB_SPIN_CAP (1u << 18)

__device__ __forceinline__ unsigned xb_ld(unsigned* p)              { return __hip_atomic_load(p, __ATOMIC_RELAXED, __HIP_MEMORY_SCOPE_AGENT); }
__device__ __forceinline__ unsigned xb_add(unsigned* p, unsigned v) { return __hip_atomic_fetch_add(p, v, __ATOMIC_RELAXED, __HIP_MEMORY_SCOPE_AGENT); }
__device__ __forceinline__ unsigned xb_xcc_id() { return (unsigned)__builtin_amdgcn_s_getreg((3 << 11) | 20) & 0xFu; }
#define XB_SPIN(cond, bar) do { unsigned _sp = 0; while (cond) { __builtin_amdgcn_s_sleep(1); \
    if ((++_sp & 255u) == 0u) { if (xb_ld(&(bar)[XB_TMO])) break; if (_sp > XB_SPIN_CAP) { atomicAdd(&(bar)[XB_TMO], 1u); break; } } } } while (0)

struct XcdBarrier {
    unsigned* bar; unsigned x;
    volatile LAS unsigned* st;
};

__device__ __forceinline__ XcdBarrier xcd_barrier_post(unsigned* bar, volatile LAS unsigned* st) {
    XcdBarrier b; b.bar = bar; b.x = xb_xcc_id(); b.st = st;
    if (threadIdx.x == 0) (void)xb_add(&bar[XB_XCNT(b.x)], 1u);
    return b;
}
__device__ __forceinline__ void xcd_barrier_complete(unsigned* bar, unsigned x, unsigned& nloc, unsigned& nx) {
    const unsigned G = gridDim.x * gridDim.y * gridDim.z;
    unsigned sum, cnt, mine, sp = 0u;
    for (;;) {
        sum = 0u; cnt = 0u; mine = 0u;
#pragma unroll
        for (unsigned j = 0; j < 16; ++j) { const unsigned c = xb_ld(&bar[XB_XCNT(j)]); sum += c; cnt += (c > 0u) ? 1u : 0u; mine = (j == x) ? c : mine; }
        if (sum == G) break;
        __builtin_amdgcn_s_sleep(1);
        if ((++sp & 255u) == 0u) { if (xb_ld(&bar[XB_TMO])) break; if (sp > XB_SPIN_CAP) { atomicAdd(&bar[XB_TMO], 1u); break; } }
    }
    nloc = mine > 0u ? mine : 1u; nx = cnt > 0u ? cnt : 1u;
}

__device__ __forceinline__ void xcd_barrier(const XcdBarrier& b, const bool leader) {
    asm volatile("s_waitcnt vmcnt(0)" ::: "memory");
    __syncthreads();
    if (leader) {
        unsigned* bar = b.bar;
        __builtin_amdgcn_s_waitcnt(0);
        unsigned nloc = b.st[0], nx = b.st[1];
        if (nloc == 0u) { xcd_barrier_complete(bar, b.x, nloc, nx); b.st[0] = nloc; b.st[1] = nx; }
        const unsigned old = xb_add(&bar[XB_XSUB(b.x)], 1u);
        const unsigned gen = old / nloc;
        if (old + 1u == (gen + 1u) * nloc) {
            __builtin_amdgcn_fence(__ATOMIC_RELEASE, "agent");
            asm volatile("s_waitcnt vmcnt(0)" ::: "memory");
            const unsigned og = xb_add(&bar[XB_TOP], 1u);
            const unsigned tg = og / nx;
            if (og + 1u == (tg + 1u) * nx) xb_add(&bar[XB_TOPGEN], 1u);
            else XB_SPIN(xb_ld(&bar[XB_TOPGEN]) == tg, bar);
            __builtin_amdgcn_fence(__ATOMIC_ACQUIRE, "agent");
            xb_add(&bar[XB_XGEN(b.x)], 1u);
            asm volatile("s_waitcnt vmcnt(0)" ::: "memory");
        } else {
            XB_SPIN(xb_ld(&bar[XB_XGEN(b.x)]) == gen, bar);
            __builtin_amdgcn_fence(__ATOMIC_ACQUIRE, "agent");
            asm volatile("s_waitcnt vmcnt(0)" ::: "memory");
        }
    }
    __syncthreads();
}

struct Frame {
    LAS unsigned char* lds;
    unsigned* ctl;
    int vcu, G;
};

__device__ __forceinline__ void p0_tile(const float* W, int N, int k0, int n0, bf16* WT, int Kd, int drow0, LAS float* scr, int lane, const float* gk = nullptr) {
    f32x4 w[8];
#pragma unroll
    for (int i = 0; i < 8; ++i) w[i] = __builtin_nontemporal_load((const GAS f32x4*)(W + (size_t)(k0 + i * 8 + (lane >> 3)) * N + n0 + (lane & 7) * 4));
    if (gk) {
#pragma unroll
        for (int i = 0; i < 8; ++i) w[i] = w[i] * gk[k0 + i * 8 + (lane >> 3)]; }
#pragma unroll
    for (int i = 0; i < 8; ++i) { LAS float* d = scr + (i * 8 + (lane >> 3)) * 33 + (lane & 7) * 4; d[0] = w[i].x; d[1] = w[i].y; d[2] = w[i].z; d[3] = w[i].w; }
    LDS_WAIT(); asm volatile("" ::: "memory");
    const int c = lane & 7;
#pragma unroll
    for (int j = 0; j < 4; ++j) { const int n = (lane >> 3) + 8 * j; const LAS float* s = scr + (8 * c) * 33 + n;
        v4u o; o.x = pk2(s[0 * 33], s[1 * 33]); o.y = pk2(s[2 * 33], s[3 * 33]); o.z = pk2(s[4 * 33], s[5 * 33]); o.w = pk2(s[6 * 33], s[7 * 33]);
        *(GAS v4u*)(WT + (size_t)(drow0 + n) * Kd + k0 + 8 * c) = o; }
    LDS_WAIT(); asm volatile("" ::: "memory");
}
__device__ __forceinline__ void p0_plain(const float* W, int K, int N, bf16* WT, int row_off, int item, LAS float* scr, int lane) {
    const int nblk = N / 32, kb = item / nblk, nb = item % nblk;
    p0_tile(W, N, 64 * kb, 32 * nb, WT, K, row_off + 32 * nb, scr, lane);
}
__device__ __forceinline__ void rms_row_to_bf16(const float* xrow, const float* g, bf16* orow, int lane) {
    const GAS f32x4* xr = (const GAS f32x4*)xrow + lane; const GAS f32x4* gr = (const GAS f32x4*)g + lane;
    f32x4 v[4]; float s = 0.f;
#pragma unroll
    for (int j = 0; j < 4; ++j) { v[j] = xr[64 * j]; s += (v[j].x * v[j].x + v[j].y * v[j].y) + (v[j].z * v[j].z + v[j].w * v[j].w); }
    const float r = 1.f / sqrtf(wave_sum(s) * (1.f / D) + RMS_EPS);
    GAS unsigned long long* o8 = (GAS unsigned long long*)orow + lane;
#pragma unroll
    for (int j = 0; j < 4; ++j) { const f32x4 gg = gr[64 * j]; const f32x4 h = v[j] * r * gg;
        o8[64 * j] = (unsigned long long)pk2(h.x, h.y) | ((unsigned long long)pk2(h.z, h.w) << 32); }
}

__device__ __forceinline__ void rms_rows_stream(const float* src1, const float* g1, const float* src2, const float* g2, int nT, int nAll, bf16* dst, int m0, int mstep, int lane) {
    f32x4 cur[4][4], nxt[4][4];
    if (m0 >= nAll) return;
    { const GAS f32x4* xr = (const GAS f32x4*)((m0 < nT ? src1 + (size_t)m0 * D : src2 + (size_t)(m0 - nT) * D)) + lane;
#pragma unroll
      for (int q = 0; q < 4; ++q)
#pragma unroll
          for (int j = 0; j < 4; ++j) cur[q][j] = __builtin_nontemporal_load(xr + q * 256 + 64 * j); }
    for (int m = m0; m < nAll; m += mstep) {
        const int mn = m + mstep; const bool has = mn < nAll; const int ml = has ? mn : m;
        { const GAS f32x4* xr = (const GAS f32x4*)((ml < nT ? src1 + (size_t)ml * D : src2 + (size_t)(ml - nT) * D)) + lane;
#pragma unroll
          for (int q = 0; q < 4; ++q)
#pragma unroll
              for (int j = 0; j < 4; ++j) nxt[q][j] = __builtin_nontemporal_load(xr + q * 256 + 64 * j); }
        float s[4];
#pragma unroll
        for (int q = 0; q < 4; ++q) { s[q] = 0.f;
#pragma unroll
            for (int j = 0; j < 4; ++j) s[q] += (cur[q][j].x * cur[q][j].x + cur[q][j].y * cur[q][j].y) + (cur[q][j].z * cur[q][j].z + cur[q][j].w * cur[q][j].w); }
#pragma unroll
        for (int o = 1; o < 64; o <<= 1) {
#pragma unroll
            for (int q = 0; q < 4; ++q) s[q] += __shfl_xor(s[q], o); }
        const GAS f32x4* gr = (const GAS f32x4*)(m < nT ? g1 : g2) + lane;
        f32x4 gg[4];
#pragma unroll
        for (int j = 0; j < 4; ++j) gg[j] = gr[64 * j];
#pragma unroll
        for (int q = 0; q < 4; ++q) { const float r = 1.f / sqrtf(s[q] * (1.f / D) + RMS_EPS);
            GAS unsigned long long* o8 = (GAS unsigned long long*)(dst + (size_t)(m + q) * D) + lane;
#pragma unroll
            for (int j = 0; j < 4; ++j) { const f32x4 h = cur[q][j] * r * gg[j]; o8[64 * j] = (unsigned long long)pk2(h.x, h.y) | ((unsigned long long)pk2(h.z, h.w) << 32); } }
#pragma unroll
        for (int q = 0; q < 4; ++q)
#pragma unroll
            for (int j = 0; j < 4; ++j) cur[q][j] = nxt[q][j];
    }
}

__device__ __forceinline__ void build_tile_tables(Frame& F, const int tid) {
    LAS int* TB = (LAS int*)(F.lds + LDSX_OFF); LAS unsigned char* t2e = F.lds + LDSX_OFF + 128;
    __syncthreads();
    if (tid == 0) { int acc = 0;
        for (int e = 0; e < NEXP; ++e) { const int n = (int)__hip_atomic_load(F.ctl + CW_CNT + e, __ATOMIC_RELAXED, __HIP_MEMORY_SCOPE_AGENT); TB[e] = acc; acc += (n + 255) >> 8; }
        TB[NEXP] = acc; }
    __syncthreads();
    for (int t = tid; t < 1024; t += NWAVES * 64) { int e = 0;
#pragma unroll
        for (int k = 1; k < NEXP; ++k) e += (t >= TB[k]) ? 1 : 0;
        t2e[t] = (unsigned char)e; }
    __syncthreads();
}

struct Args { const float* in[26]; float* out; unsigned char* ws; int ph_lo, ph_hi; };

__global__ void __launch_bounds__(NWAVES * 64, 2) hybrid_fwd(Args args) {
    extern __shared__ __attribute__((aligned(16))) unsigned char lds[];
    __builtin_assume(__builtin_amdgcn_workitem_id_y() == 0); __builtin_assume(__builtin_amdgcn_workitem_id_z() == 0);
    Frame F;
    F.lds = (LAS unsigned char*)lds;
    F.G = gridDim.x; { const int bx = blockIdx.x; F.vcu = (F.G % 8 == 0) ? (bx % 8) * (F.G / 8) + bx / 8 : bx; }
    F.ctl = (unsigned*)(args.ws + WS_CTL);
#define x_in (args.in[0])
#define mem_in (args.in[1])
#define norm_mix_g (args.in[2])
#define w_in (args.in[3])
#define pool_w (args.in[4])
#define pool_scale (args.in[5])
#define lam_q1 (args.in[6])
#define lam_k1 (args.in[7])
#define lam_q2 (args.in[8])
#define lam_k2 (args.in[9])
#define subln_g (args.in[10])
#define norm_mem_g (args.in[11])
#define w_mem_kv (args.in[12])
#define p_pool (args.in[13])
#define p_diff (args.in[14])
#define p_mem (args.in[15])
#define w_o (args.in[16])
#define norm_ffn_g (args.in[17])
#define w_rg (args.in[18])
#define b_rg (args.in[19])
#define w_re (args.in[20])
#define b_re (args.in[21])
#define w_eg (args.in[22])
#define w_eu (args.in[23])
#define w_ed (args.in[24])
#define final_g (args.in[25])
#define Win_t ((bf16*)(args.ws + WS_WIN))
#define Pc_t ((bf16*)(args.ws + WS_PC))
#define Wo_t ((bf16*)(args.ws + WS_WO))
#define Wgu_t ((bf16*)(args.ws + WS_WGU))
#define Wd_t ((bf16*)(args.ws + WS_WD))
#define KV ((bf16*)(args.ws + WS_KV))
#define XN ((bf16*)(args.ws + WS_XN))
#define BR ((bf16*)(args.ws + WS_BR))
#define H2 ((bf16*)(args.ws + WS_H2))
#define PROJ ((bf16*)(args.ws + WS_PROJ))
#define MERGED ((bf16*)(args.ws + WS_MERGED))
#define MIX ((bf16*)(args.ws + WS_MIX))
#define HID ((bf16*)(args.ws + WS_HID))
#define ATTO ((bf16*)(args.ws + WS_ATTO))
#define GATES ((bf16*)(args.ws + WS_GATES))
#define Y ((bf16*)(args.ws + WS_Y))
#define ROUTE ((v4u*)(args.ws + WS_ROUTE))
#define RWE ((float*)(args.ws + WS_RWE))
#define LIST ((int*)(args.ws + WS_LIST))
#define WRF ((bf16*)(args.ws + WS_WRF))
#define RINV ((float*)(args.ws + WS_RINV))
#define X1 (args.out)
    const int NGW = F.G * NWAVES;
#define PHASE_IDS int tid = tid_of(wv); asm volatile("" : "+v"(tid)); const int lane = tid & 63, wave = __builtin_amdgcn_readfirstlane(tid >> 6), gw = F.vcu * NWAVES + wave; (void)lane; (void)gw;
    const int lo = args.ph_lo, hi = args.ph_hi;
    cg::grid_group grid = cg::this_grid();
#ifndef PH_MASK
#define PH_MASK 0x3ff
#endif
#define IN(k) (((PH_MASK >> (k)) & 1) && lo <= (k) && (k) < hi)
#ifndef PROBE_A
#define PROBE_A -1
#endif
#ifndef PROBE_B
#define PROBE_B -1
#endif
#ifndef PROBE_A2
#define PROBE_A2 (PROBE_A + 1)
#endif
#ifndef PROBE_B2
#define PROBE_B2 (PROBE_B + 1)
#endif
#define STAMP(k) do { if ((PROBE_A >= 0 || PROBE_B >= 0) && blockIdx.x == 0 && tid_of(wv) == 0) ((unsigned long long*)(F.ctl + CW_TS))[k] = __builtin_amdgcn_s_memrealtime(); } while (0)
#define SEAM(k) do { if (IN(k) && IN((k) + 1)) { { XcdBarrier b_; b_.bar = (unsigned*)(args.ws + WS_CTL) + CW_BAR; b_.x = xb_xcc_id(); b_.st = (volatile LAS unsigned*)(F.lds + LDSX_OFF + 2048); xcd_barrier(b_, tid_of(wv) == 0); } } STAMP((k) + 1); } while (0)
    const int wv = __builtin_amdgcn_readfirstlane((int)threadIdx.x >> 6);
    if (hi > NPH) grid.sync();
    if (threadIdx.x < 2) ((LAS unsigned*)(F.lds + LDSX_OFF + 2048))[threadIdx.x] = 0u;
    __syncthreads();
    if (lo < hi - 1) (void)xcd_barrier_post((unsigned*)(args.ws + WS_CTL) + CW_BAR, (volatile LAS unsigned*)(F.lds + LDSX_OFF + 2048));
    STAMP(0);

    if (IN(0)) {
        PHASE_IDS
        LAS float* scr = (LAS float*)(F.lds + RING_OFF + wave * 16384);
        constexpr int I_IN = 16 * 160, I_KV = 16 * 16, I_PD = 8 * 32, I_PM = 4 * 32, I_WO = 16 * 32, I_EG = 16 * 256, I_EU = 16 * 256, I_ED = 16 * 256;
        constexpr int NITEMS = I_IN + I_KV + I_PD + I_PM + I_WO + I_EG + I_EU + I_ED;
        for (int it = gw; it < NITEMS; it += NGW) {
            int r = it;
            if (r < I_IN) { p0_plain(w_in, D, INCOLS, Win_t, 0, r, scr, lane); continue; } r -= I_IN;
            if (r < I_KV) { p0_plain(w_mem_kv, D, 512, Win_t, INCOLS, r, scr, lane); continue; } r -= I_KV;
            if (r < I_PD) { const int kb = r >> 5, nb = r & 31; p0_tile(p_diff, D, 64 * kb, 32 * nb, Pc_t + 256, D, 32 * nb, scr, lane); continue; } r -= I_PD;
            if (r < I_PM) { const int kb = r >> 5, nb = r & 31; p0_tile(p_mem, D, 64 * kb, 32 * nb, Pc_t + 768, D, 32 * nb, scr, lane); continue; } r -= I_PM;
            if (r < I_WO) { p0_plain(w_o, D, D, Wo_t, 0, r, scr, lane); continue; } r -= I_WO;
            if (r < I_EG + I_EU) { const bool up = r >= I_EG; if (up) r -= I_EG;
                const int e = r >> 8, rr = r & 255, kb = rr >> 4, nb = rr & 15, n0 = 32 * nb;
                p0_tile((up ? w_eu : w_eg) + (size_t)e * D * EH, EH, 64 * kb, n0, Wgu_t + (size_t)e * D * D, D, (n0 >> 7) * 256 + (n0 & 127) + (up ? 128 : 0), scr, lane, norm_ffn_g); continue; }
            r -= I_EG + I_EU;
            { const int e = r >> 8, rr = r & 255, kb = rr >> 5, nb = rr & 31;
              p0_tile(w_ed + (size_t)e * EH * D, D, 64 * kb, 32 * nb, Wd_t + (size_t)e * D * EH, EH, 32 * nb, scr, lane); }
        }
        STAMP(12);
        for (int idx = (F.vcu * NWAVES * 64 + tid); idx < 5120; idx += F.G * NWAVES * 64) {
            const int q = idx % 20, h = (idx / 20) & 1, hl = (idx / 40) & 1, st = idx / 80, k0 = 32 * (st >> 1) + 16 * h + 8 * (st & 1);
            float v[8];
#pragma unroll
            for (int j = 0; j < 8; ++j) { const int k = k0 + j; const float w = norm_ffn_g[k] * (q < 4 ? w_rg[k * 4 + q] : w_re[k * 16 + (q - 4)]); const float hi = bflo(f2bf(w) ); v[j] = hl ? (w - hi) : w; }
            v4u o; o.x = pk2(v[0], v[1]); o.y = pk2(v[2], v[3]); o.z = pk2(v[4], v[5]); o.w = pk2(v[6], v[7]);
            *((GAS v4u*)WRF + idx) = o;
        }
        for (int idx = (F.vcu * NWAVES * 64 + tid); idx < 256 * 1024; idx += F.G * NWAVES * 64) {
            const int kc = idx >> 10, n = idx & 1023, g = kc >> 6; float a = 0.f;
#pragma unroll 16
            for (int d = 0; d < 64; ++d) a += pool_w[kc * 64 + d] * pool_scale[g * 64 + d] * p_pool[(size_t)(g * 64 + d) * D + n];
            Pc_t[(size_t)n * D + kc] = (bf16)f2bf(a);
        }
        STAMP(13);
        rms_rows_stream(x_in, norm_mix_g, mem_in, norm_mem_g, T, T + TM, XN, gw * 4, NGW * 4, lane);
    }
    SEAM(0);

    if (IN(1)) {
        pg8::Gemm g{XN, Win_t, T, INCOLS, D};
        pg8::ProjOrder S; S.so.init(T, INCOLS, F.G, (int)blockIdx.x);
        pg8::EpiProj E{PROJ, GATES, KV, attn_body::C2};
        pg8::gemm_phase<pg8::EpiProj, pg8::ProjOrder, true, true>(wv, F.lds + RING_OFF, g, S, E);
    }
    SEAM(1);

    if (IN(2)) {
        PHASE_IDS
        typedef attn_body::bf16 abf;
        struct DiffOrder { int vcu, G;
            __device__ __forceinline__ bool next(int i, int& bh, int& m, int& qb) const { const int u = vcu + (i >> 3) * G; if (u >= BATCH * 8) return false; bh = u >> 1; m = (i >> 2) & 1; const int k = i & 3, st = u & 1;
                qb = (k == 0) ? 7 - st : (k == 1) ? st : (k == 2) ? 4 + st : 3 - st; return true; } };
        float lam;
        { const float s1 = wave_sum(lam_q1[lane] * lam_k1[lane]), s2 = wave_sum(lam_q2[lane] * lam_k2[lane]); lam = __uint_as_float(__builtin_amdgcn_readfirstlane(__float_as_uint(__expf(s1) - __expf(s2) + 0.2f))); }
        { const DiffOrder S{F.vcu, F.G}; int bh, m, qb;
          for (int i = 0; S.next(i, bh, m, qb); ++i) {
            const int b = bh >> 2, h = bh & 3; const size_t rb = (size_t)b * SEQ;
            const attn2::bf16* Qu = (const attn2::bf16*)PROJ + (rb + qb * 256) * PROJW + 256 + h * 128 + m * 64;
            const attn2::bf16* Kh = (const attn2::bf16*)PROJ + rb * PROJW + 768 + h * 128 + m * 64;
            const attn2::bf16* Vh = (const attn2::bf16*)PROJ + rb * PROJW + 1280 + h * 128;
            attn2::bf16* S0 = (attn2::bf16*)ATTO + (rb + qb * 256) * 512 + h * 128;
            attn2::bf16* Od = (attn2::bf16*)BR + (rb + qb * 256) * D + 256 + h * 128;
            asm volatile("" : "+s"(Qu), "+s"(Kh), "+s"(Vh), "+s"(S0), "+s"(Od));
            if (m == 0) attn2::attn_unit<8, true, false>(Qu, PROJW, Kh, Vh, PROJW, wv, S0, 512, 4 * (qb + 1), (char*)lds + RING_OFF);
            else attn2::attn_unit<8, true, true>(Qu, PROJW, Kh, Vh, PROJW, wv, Od, D, 4 * (qb + 1), (char*)lds + RING_OFF, S0, 512, lam, subln_g); } }
        for (int mu = F.vcu; mu < BATCH * 8; mu += F.G) {
            const int b = mu >> 3, mh = (mu >> 1) & 3, half = mu & 1;
            const abf* Q0 = (const abf*)PROJ + ((size_t)b * SEQ + half * 1024) * PROJW + 1792 + mh * 64;
            const abf* Kh = (const abf*)KV + (size_t)b * NMEM * 512 + mh * 64;
            const abf* Vh = (const abf*)KV + (size_t)b * NMEM * 512 + 256 + mh * 64;
            abf* O0 = (abf*)BR + ((size_t)b * SEQ + half * 1024) * D + 768 + mh * 64;
            asm volatile("" : "+s"(Q0), "+s"(Kh), "+s"(Vh), "+s"(O0));
            attn_body::mem_attn(wv, Q0, PROJW, Kh, Vh, 512, O0, D, 4, (char*)lds + RING_OFF); }
        { int tidp = tid_of(wv); asm volatile("" : "+v"(tidp)); const int lane = tidp & 63, gw = F.vcu * NWAVES + wv;
        const int gi = lane >> 4, w = 2 << gi;
        for (int tb = gw * 32; tb < T; tb += NGW * 32)
        for (int tp = 0; tp < 32; tp += 2) {
            const int t = tb + tp, s0 = t & (SEQ - 1);
            const GAS v2u* up = (const GAS v2u*)(PROJ + (size_t)(t + 1) * PROJW) + lane;
            const int nw0 = (w < s0 + 1) ? w : s0 + 1, nw1 = (w < s0 + 2) ? w : s0 + 2;
            v2u wq[17];
#pragma unroll
            for (int k = 0; k < 17; ++k) { wq[k] = (v2u){0u, 0u}; if (k < nw1 || (k >= 1 && k - 1 < nw0)) wq[k] = *(const GAS v2u*)((const GAS bf16*)up - (size_t)k * PROJW); }
#pragma unroll
            for (int q = 0; q < 2; ++q) {
                const int nwq = q ? nw1 : nw0; float a0 = 0.f, a1 = 0.f, a2 = 0.f, a3 = 0.f;
#pragma unroll
                for (int k = 0; k < 16; ++k) { const v2u x = wq[k + 1 - q]; const bool in = k < nwq; a0 += in ? bflo(x.x) : 0.f; a1 += in ? bfhi(x.x) : 0.f; a2 += in ? bflo(x.y) : 0.f; a3 += in ? bfhi(x.y) : 0.f; }
                const v2u ut = wq[1 - q]; const float inv = 1.f / (float)nwq;
                v2u po; po.x = pk2(a0 * inv - bflo(ut.x), a1 * inv - bfhi(ut.x)); po.y = pk2(a2 * inv - bflo(ut.y), a3 * inv - bfhi(ut.y));
                *((GAS v2u*)(BR + (size_t)(t + q) * D) + lane) = po; }
        }
        }
    }
    SEAM(2); STAMP(4);


    if (IN(4)) {
        pg8::StaticOrder S; S.init(T, D, F.G, (int)blockIdx.x);
        pg8::Gemm g{BR, Pc_t, T, D, D}; pg8::EpiMerge E{GATES, MERGED}; pg8::MidRescale MH{GATES};
        pg8::gemm_phase<pg8::EpiMerge, pg8::StaticOrder, true, true, pg8::MidRescale>(wv, F.lds + RING_OFF, g, S, E, MH);
    }
    SEAM(4);

    if (IN(5)) {
        pg8::Gemm g{MERGED, Wo_t, T, D, D}; pg8::StaticOrder S; S.init(T, D, F.G, (int)blockIdx.x);
        pg8::EpiMix E{MIX};
        pg8::gemm_phase<pg8::EpiMix, pg8::StaticOrder, true, true>(wv, F.lds + RING_OFF, g, S, E);
    }
    SEAM(5);

    if (IN(6)) {
        PHASE_IDS
        LAS v4u* WL = (LAS v4u*)(F.lds + RING_OFF);
        LAS float* SC = (LAS float*)(F.lds + RING_OFF + 81920) + wave * 1024;
        LAS v4u* REC = (LAS v4u*)(F.lds + RING_OFF + 81920 + 32768);
        LAS unsigned* LCNT = (LAS unsigned*)(F.lds + RING_OFF + 81920 + 32768 + 4096);
        LAS unsigned* LBASE = LCNT + 16; LAS float* RIL = (LAS float*)(LCNT + 32);
        for (int idx = tid; idx < 5120; idx += NWAVES * 64) WL[idx] = *((const GAS v4u*)WRF + idx);
        float bg[4], be[16];
#pragma unroll
        for (int i = 0; i < 4; ++i) bg[i] = b_rg[i];
#pragma unroll
        for (int i = 0; i < 16; ++i) be[i] = b_re[i];
        const int r32 = lane & 31, hh = lane >> 5;
        for (int rb0 = F.vcu * 256; rb0 < T; rb0 += F.G * 256) {
            if (tid < 16) LCNT[tid] = 0u;
            __syncthreads();
            const int li = wave * 32 + r32, row = rb0 + li;
            const GAS f32x4* xp = (const GAS f32x4*)(x_in + (size_t)row * D + 16 * hh);
            const GAS v4u* mp = (const GAS v4u*)(MIX + (size_t)row * D + 16 * hh);
            GAS v4u* hp = (GAS v4u*)(H2 + (size_t)row * D + 16 * hh);
            const LAS v4u* wl = WL + hh * 20 + r32;
            f32x16_t acc = {}; float ss = 0.f;
            f32x4 cur[8]; v4u curm[4];
#pragma unroll
            for (int i = 0; i < 8; ++i) cur[i] = xp[(i >> 2) * 8 + (i & 3)];
#pragma unroll
            for (int i = 0; i < 4; ++i) curm[i] = mp[(i >> 1) * 4 + (i & 1)];
#pragma unroll 1
            for (int sp2 = 0; sp2 < 16; ++sp2) {
                f32x4 nxt[8]; v4u nxtm[4];
                const int spn = (sp2 + 1 < 16) ? sp2 + 1 : sp2;
#pragma unroll
                for (int i = 0; i < 8; ++i) nxt[i] = xp[(2 * spn + (i >> 2)) * 8 + (i & 3)];
#pragma unroll
                for (int i = 0; i < 4; ++i) nxtm[i] = mp[(2 * spn + (i >> 1)) * 4 + (i & 1)];
#pragma unroll
                for (int i = 0; i < 4; ++i) { const v4u mm = curm[i];
                    cur[2 * i].x += bflo(mm.x); cur[2 * i].y += bfhi(mm.x); cur[2 * i].z += bflo(mm.y); cur[2 * i].w += bfhi(mm.y);
                    cur[2 * i + 1].x += bflo(mm.z); cur[2 * i + 1].y += bfhi(mm.z); cur[2 * i + 1].z += bflo(mm.w); cur[2 * i + 1].w += bfhi(mm.w); }
#pragma unroll
                for (int u = 0; u < 2; ++u) { const int sp = 2 * sp2 + u;
                    v4u ahi[2], alo[2];
#pragma unroll
                    for (int e = 0; e < 2; ++e) { const f32x4 a = cur[4 * u + 2 * e], b = cur[4 * u + 2 * e + 1];
                        ss += (a.x * a.x + a.y * a.y) + (a.z * a.z + a.w * a.w) + (b.x * b.x + b.y * b.y) + (b.z * b.z + b.w * b.w);
                        v4u h; h.x = cvtpk(a.x, a.y); h.y = cvtpk(a.z, a.w); h.z = cvtpk(b.x, b.y); h.w = cvtpk(b.z, b.w); ahi[e] = h;
                        v4u l; l.x = cvtpk(a.x - bflo(h.x), a.y - bfhi(h.x)); l.y = cvtpk(a.z - bflo(h.y), a.w - bfhi(h.y)); l.z = cvtpk(b.x - bflo(h.z), b.y - bfhi(h.z)); l.w = cvtpk(b.z - bflo(h.w), b.w - bfhi(h.w)); alo[e] = l; }
                    hp[sp * 4] = ahi[0]; hp[sp * 4 + 1] = ahi[1];
#pragma unroll
                    for (int e = 0; e < 2; ++e) { const int st = 2 * sp + e;
                        v4u bh = {0u, 0u, 0u, 0u}, bl = {0u, 0u, 0u, 0u};
                        if (r32 < 20) { bh = wl[(st * 4) * 20]; bl = wl[(st * 4 + 2) * 20]; }
                        acc = __builtin_amdgcn_mfma_f32_32x32x16_bf16(__builtin_bit_cast(bf16x8_t, ahi[e]), __builtin_bit_cast(bf16x8_t, bh), acc, 0, 0, 0);
                        acc = __builtin_amdgcn_mfma_f32_32x32x16_bf16(__builtin_bit_cast(bf16x8_t, alo[e]), __builtin_bit_cast(bf16x8_t, bh), acc, 0, 0, 0);
                        acc = __builtin_amdgcn_mfma_f32_32x32x16_bf16(__builtin_bit_cast(bf16x8_t, ahi[e]), __builtin_bit_cast(bf16x8_t, bl), acc, 0, 0, 0); } }
#pragma unroll
                for (int i = 0; i < 8; ++i) cur[i] = nxt[i];
#pragma unroll
                for (int i = 0; i < 4; ++i) curm[i] = nxtm[i];
            }
            ss += __shfl_xor(ss, 32);
            const float rinv = 1.f / sqrtf(ss * (1.f / D) + RMS_EPS);
#pragma unroll
            for (int r = 0; r < 16; ++r) SC[((r & 3) + 8 * (r >> 2) + 4 * hh) * 32 + r32] = acc[r];
            LDS_WAIT();
            if (lane < 32) {
                float lg[20];
#pragma unroll
                for (int q4 = 0; q4 < 5; ++q4) { const f32x4 t4 = *(const LAS f32x4*)(SC + lane * 32 + 4 * q4); lg[4 * q4] = t4.x * rinv; lg[4 * q4 + 1] = t4.y * rinv; lg[4 * q4 + 2] = t4.z * rinv; lg[4 * q4 + 3] = t4.w * rinv; }
                float gl[4];
#pragma unroll
                for (int i = 0; i < 4; ++i) gl[i] = lg[i] + bg[i];
                int gidx = 0; float gmax = gl[0];
#pragma unroll
                for (int i = 1; i < 4; ++i) if (gl[i] > gmax) { gmax = gl[i]; gidx = i; }
                float gsum = 0.f;
#pragma unroll
                for (int i = 0; i < 4; ++i) gsum += __expf(gl[i] - gmax);
                const float gp = 1.f / gsum;
                float el[4];
#pragma unroll
                for (int j = 0; j < 4; ++j) { const float l0 = lg[4 + j] + be[j], l1 = lg[8 + j] + be[4 + j], l2 = lg[12 + j] + be[8 + j], l3 = lg[16 + j] + be[12 + j];
                    el[j] = gidx == 0 ? l0 : gidx == 1 ? l1 : gidx == 2 ? l2 : l3; }
                int i0 = 0; float m0 = el[0];
#pragma unroll
                for (int j = 1; j < 4; ++j) if (el[j] > m0) { m0 = el[j]; i0 = j; }
                int i1 = -1; float m1 = -3.0e38f;
#pragma unroll
                for (int j = 0; j < 4; ++j) if (j != i0 && el[j] > m1) { m1 = el[j]; i1 = j; }
                if (i1 < 0) { i1 = (i0 + 1) & 3; m1 = m0; }
                const float p1 = __expf(m1 - m0);
                const float w0 = gp / (1.f + p1), w1 = gp * p1 / (1.f + p1);
                const unsigned e0 = (unsigned)(gidx * 4 + i0), e1 = (unsigned)(gidx * 4 + i1);
                const unsigned s0 = __hip_atomic_fetch_add(LCNT + e0, 1u, __ATOMIC_RELAXED, __HIP_MEMORY_SCOPE_WORKGROUP), s1 = __hip_atomic_fetch_add(LCNT + e1, 1u, __ATOMIC_RELAXED, __HIP_MEMORY_SCOPE_WORKGROUP);
                v4u rc; rc.x = (e0 << 20) | s0; rc.y = (e1 << 20) | s1; rc.z = __float_as_uint(w0); rc.w = __float_as_uint(w1); REC[li] = rc;
                RINV[row] = rinv; RIL[li] = rinv;
            }
            __syncthreads();
            if (tid < 16) LBASE[tid] = __hip_atomic_fetch_add(F.ctl + CW_CNT + tid, LCNT[tid], __ATOMIC_RELAXED, __HIP_MEMORY_SCOPE_AGENT);
            __syncthreads();
            if (tid < 256) { v4u rc = REC[tid]; rc.x += LBASE[rc.x >> 20]; rc.y += LBASE[rc.y >> 20]; *((GAS v4u*)ROUTE + rb0 + tid) = rc;
                const unsigned i0 = ((rc.x >> 20) << 16) + (rc.x & 0xFFFFFu), i1 = ((rc.y >> 20) << 16) + (rc.y & 0xFFFFFu); const float ri = RIL[tid];
                LIST[i0] = rb0 + tid; LIST[i1] = rb0 + tid; RWE[2 * i0] = ri; RWE[2 * i0 + 1] = __uint_as_float(rc.z); RWE[2 * i1] = ri; RWE[2 * i1 + 1] = __uint_as_float(rc.w); }
            __syncthreads();
        }
    }
    SEAM(6);

    if (IN(7)) {
        PHASE_IDS
        build_tile_tables(F, tid);
        const LAS int* TB = (const LAS int*)(F.lds + LDSX_OFF); const LAS unsigned char* t2e = (const LAS unsigned char*)(F.lds + LDSX_OFF + 128);
        LAS int* TOKL = (LAS int*)(F.lds + LDSX_OFF + 4096);
        const int nunits = TB[NEXP] * 4;
        for (int i = 0; i < 11; ++i) { const int L = i * F.G + F.vcu; if (L >= nunits) break;
            const int pm = L >> 2, e = t2e[pm], lt = pm - TB[e];
            if (tid < 256) { unsigned tok = (unsigned)LIST[(e << 16) + lt * 256 + tid]; tok = tok < (unsigned)T ? tok : (unsigned)(T - 1); TOKL[i * 256 + tid] = (int)tok; } }
        __syncthreads();
        pg8::Gemm g{H2, Wgu_t, T, NEXP * D, D};
        pg8::MoeOrder S{t2e, nunits, F.G, F.vcu};
        pg8::EpiGateUp E{HID, RWE, TB};
        pg8::gemm_phase<pg8::EpiGateUp, pg8::MoeOrder, true, true, pg8::NoMid, true>(wv, F.lds + RING_OFF, g, S, E, pg8::NoMid(), TOKL);
    }
    SEAM(7);

    if (IN(8)) {
        PHASE_IDS
        build_tile_tables(F, tid);
        const LAS int* TB = (const LAS int*)(F.lds + LDSX_OFF);
        pg8::Gemm g{HID, Wd_t, MAXROWS, NEXP * D, EH};
        pg8::MoeOrder S{(const LAS unsigned char*)(F.lds + LDSX_OFF + 128), TB[NEXP] * 4, F.G, F.vcu};
        pg8::EpiDown E{Y};
        pg8::gemm_phase<pg8::EpiDown, pg8::MoeOrder, true, true>(wv, F.lds + RING_OFF, g, S, E);
    }
    SEAM(8);

    if (IN(9)) {
        PHASE_IDS
        build_tile_tables(F, tid);
        const LAS int* TB = (const LAS int*)(F.lds + LDSX_OFF);
        f32x4 gg[4];
#pragma unroll
        for (int c = 0; c < 2; ++c) { gg[2 * c] = *((const GAS f32x4*)(final_g + 512 * c + 8 * lane)); gg[2 * c + 1] = *((const GAS f32x4*)(final_g + 512 * c + 8 * lane + 4)); }
        for (int t0 = gw * 2; t0 < T; t0 += NGW * 2) {
            v4u hx[2][2], ya[2][2], yb[2][2];
#pragma unroll
            for (int q = 0; q < 2; ++q) { const int t = t0 + q; const v4u rc = *((const GAS v4u*)ROUTE + t);
                const size_t r0 = (size_t)TB[rc.x >> 20] * 256 + (rc.x & 0xFFFFFu), r1 = (size_t)TB[rc.y >> 20] * 256 + (rc.y & 0xFFFFFu);
#pragma unroll
                for (int c = 0; c < 2; ++c) { hx[q][c] = *((const GAS v4u*)(H2 + (size_t)t * D + 512 * c) + lane); ya[q][c] = *((const GAS v4u*)(Y + r0 * D + 512 * c) + lane); yb[q][c] = *((const GAS v4u*)(Y + r1 * D + 512 * c) + lane); } }
#pragma unroll
            for (int q = 0; q < 2; ++q) { const int t = t0 + q; f32x4 v[4]; float s = 0.f;
#pragma unroll
                for (int c = 0; c < 2; ++c) { const v4u h = hx[q][c], a = ya[q][c], b = yb[q][c];
                    v[2 * c] = (f32x4){bflo(h.x) + bflo(a.x) + bflo(b.x), bfhi(h.x) + bfhi(a.x) + bfhi(b.x), bflo(h.y) + bflo(a.y) + bflo(b.y), bfhi(h.y) + bfhi(a.y) + bfhi(b.y)};
                    v[2 * c + 1] = (f32x4){bflo(h.z) + bflo(a.z) + bflo(b.z), bfhi(h.z) + bfhi(a.z) + bfhi(b.z), bflo(h.w) + bflo(a.w) + bflo(b.w), bfhi(h.w) + bfhi(a.w) + bfhi(b.w)}; }
#pragma unroll
                for (int k = 0; k < 4; ++k) s += (v[k].x * v[k].x + v[k].y * v[k].y) + (v[k].z * v[k].z + v[k].w * v[k].w);
                const float r = 1.f / sqrtf(wave_sum(s) * (1.f / D) + RMS_EPS);
#pragma unroll
                for (int k = 0; k < 4; ++k) { f32x4 o = v[k] * r * gg[k];
                    if (PROBE_B >= 0 && blockIdx.x == 0 && (t / (NGW * 2)) < 4) {
                        const unsigned long long* ts = (const unsigned long long*)(F.ctl + CW_TS); const float amp = sqrtf((float)((ts[PROBE_B2] - ts[PROBE_B]) / 100) * 1e-3f);
                        o.x += amp; o.y += amp; o.z += amp; o.w += amp; }
                    *((GAS f32x4*)(X1 + (size_t)t * D + 512 * (k >> 1) + 8 * lane + 4 * (k & 1))) = o; } }
        }
        STAMP(10);
        if (PROBE_A >= 0 && blockIdx.x == 0 && tid_of(wv) == 0) {
            const unsigned long long* ts = (const unsigned long long*)(F.ctl + CW_TS);
            X1[0] += 4.f + (float)((ts[PROBE_A2] - ts[PROBE_A]) / 100) * 0.01f; }
    }
#undef IN
#undef SEAM
#undef STAMP
#undef PHASE_IDS
#undef x_in
#undef mem_in
#undef norm_mix_g
#undef w_in
#undef pool_w
#undef pool_scale
#undef lam_q1
#undef lam_k1
#undef lam_q2
#undef lam_k2
#undef subln_g
#undef norm_mem_g
#undef w_mem_kv
#undef p_pool
#undef p_diff
#undef p_mem
#undef w_o
#undef norm_ffn_g
#undef w_rg
#undef b_rg
#undef w_re
#undef b_re
#undef w_eg
#undef w_eu
#undef w_ed
#undef final_g
#undef Win_t
#undef Pc_t
#undef Wo_t
#undef Wgu_t
#undef Wd_t
#undef KV
#undef XN
#undef BR
#undef H2
#undef PROJ
#undef MERGED
#undef MIX
#undef HID
#undef ATTO
#undef GATES
#undef Y
#undef ROUTE
#undef RWE
#undef LIST
#undef WRF
#undef RINV
#undef X1
}

extern "C" void kernel_launch(void* const* d_in, const int* in_sizes, int n_in, void* d_out, int out_size, void* d_ws, size_t ws_size, hipStream_t stream) {
    static int grid = 0;
    if (grid == 0) {
        if (n_in != 26 || in_sizes[0] != T * D || out_size != T * D || ws_size < WS_END) { fprintf(stderr, "kernel_launch: unexpected problem: n_in %d in0 %d out %d ws %zu (need %zu)\n", n_in, n_in > 0 ? in_sizes[0] : -1, out_size, ws_size, (size_t)WS_END); grid = -1; return; }
        int dev = 0, cus = 0, per_cu = 0;
        if (hipGetDevice(&dev) != hipSuccess || hipDeviceGetAttribute(&cus, hipDeviceAttributeMultiprocessorCount, dev) != hipSuccess) { fprintf(stderr, "kernel_launch: device query failed\n"); grid = -1; return; }
        if (hipFuncSetAttribute((const void*)hybrid_fwd, hipFuncAttributeMaxDynamicSharedMemorySize, LDS_BYTES) != hipSuccess) { fprintf(stderr, "kernel_launch: hipFuncSetAttribute failed\n"); grid = -1; return; }
        if (hipOccupancyMaxActiveBlocksPerMultiprocessor(&per_cu, (const void*)hybrid_fwd, NWAVES * 64, LDS_BYTES) != hipSuccess || per_cu < 1) { fprintf(stderr, "kernel_launch: occupancy query says %d blocks per CU\n", per_cu); grid = -1; return; }
        (void)hipGetLastError();
        grid = cus;
        if (grid > 256) grid = 256;
    }
    if (grid < 0) return;
    if (hipMemsetAsync((char*)d_ws + WS_CTL, 0, CTL_ZERO_BYTES, stream) != hipSuccess) { fprintf(stderr, "kernel_launch: memset failed\n"); return; }
    Args a{};
    for (int i = 0; i < 26; ++i) a.in[i] = (const float*)d_in[i];
    a.out = (float*)d_out; a.ws = (unsigned char*)d_ws;
#if MK_N_LAUNCHES == 1
    a.ph_lo = 0; a.ph_hi = NPH;
    void* kargs[] = {&a};
    hipError_t e = hipLaunchCooperativeKernel((const void*)hybrid_fwd, dim3(grid), dim3(NWAVES * 64), kargs, LDS_BYTES, stream);
    if (e != hipSuccess) fprintf(stderr, "kernel_launch: cooperative launch failed: %s (grid %d)\n", hipGetErrorString(e), grid);
#else
    for (int p = 0; p < NPH; ++p) { a.ph_lo = p; a.ph_hi = p + 1;
        hipLaunchKernelGGL(hybrid_fwd, dim3(grid), dim3(NWAVES * 64), LDS_BYTES, stream, a);
        const hipError_t le = hipPeekAtLastError(); if (le != hipSuccess) { fprintf(stderr, "kernel_launch: launch %d failed: %s\n", p, hipGetErrorName(le)); break; } }
#endif
}
```

```cpp
#include <hip/hip_runtime.h>
#include <hip/hip_cooperative_groups.h>
#include <cstdio>
#include <cstdint>
namespace cg = cooperative_groups;
__device__ __forceinline__ int tid_of(int wv) { unsigned z = 0u; asm volatile("" : "+v"(z));
    return (wv << 6) | (int)__builtin_amdgcn_mbcnt_hi(~0u, __builtin_amdgcn_mbcnt_lo(~0u, z)); }
namespace pg8 {
#define PG8_LAS __attribute__((address_space(3)))
typedef unsigned short bf16_t;
typedef short bf16x8 __attribute__((ext_vector_type(8)));
typedef float f32x4 __attribute__((ext_vector_type(4)));
typedef unsigned u32x4 __attribute__((ext_vector_type(4)));
constexpr int BM = 256, BK = 64, HALF = 128, HTB = HALF * BK * 2  , STAGE_BYTES = 8 * HTB, NXCD = 8, WGM = 8;

__host__ __device__ __forceinline__ int lds_byte(int r, int c) { const int st = (r >> 4) * 2 + (c >> 5), rr = r & 15, cc = c & 31, ob = rr * 64 + cc * 2; return st * 1024 + (ob ^ (((ob >> 9) & 1) << 5)); }
__host__ __device__ __forceinline__ void stage_rc(int b, int& R, int& C) { const int st = b / 1024, sb = b % 1024, swz = sb ^ (((sb >> 9) & 1) << 5); R = (st >> 1) * 16 + swz / 64; C = (st & 1) * 32 + (swz % 64) / 2; }
__host__ __device__ __forceinline__ int perm32(int rho) { const int n = rho >> 4, i = rho & 15; return 8 * (i >> 2) + 4 * n + (i & 3); }

struct Unit { int pm, pn; };
struct Gemm { const bf16_t* A; const bf16_t* Bt; int M, N, K; };

struct StaticOrder {
    int nM, nN, nwg, G, c;
    __host__ __device__ void init(int M, int N, int G_, int c_) { nM = M / BM; nN = N / BM; nwg = nM * nN; G = G_; c = c_; }
    __host__ __device__ bool next(int i, Unit& u) const {
        const long L = (long)i * G + c; if (L >= nwg) return false;
        int wgid = (int)L; { const int q = nwg / NXCD, r = nwg % NXCD, xcd = wgid % NXCD, off = wgid / NXCD; wgid = (xcd < r ? xcd * (q + 1) : r * (q + 1) + (xcd - r) * q) + off; }
        const int nig = WGM * nN, gid = wgid / nig, fm = gid * WGM, gsz = (nM - fm) < WGM ? (nM - fm) : WGM;
        u.pm = fm + ((wgid % nig) % gsz); u.pn = (wgid % nig) / gsz; return true;
    }
    __device__ __forceinline__ void a_ready(const Unit&) const {}
    __device__ __forceinline__ void done(const Unit&) const {}
};

__device__ __forceinline__ unsigned cvt_pk_bf16(float lo, float hi) { unsigned r; asm volatile("v_cvt_pk_bf16_f32 %0, %1, %2" : "=v"(r) : "v"(lo), "v"(hi)); return r; }
typedef unsigned u32x2 __attribute__((ext_vector_type(2)));
__device__ __forceinline__ float bf_lo(unsigned w) { return __uint_as_float(w << 16); }
__device__ __forceinline__ float bf_hi(unsigned w) { return __uint_as_float(w & 0xffff0000u); }
__device__ __forceinline__ float sigmoid_f(float x) { return __builtin_amdgcn_rcpf(1.0f + __builtin_amdgcn_exp2f(-1.4426950408889634f * x)); }
__device__ __forceinline__ u32x4 pack8(const f32x4 a, const f32x4 b) { u32x4 w; w.x = cvt_pk_bf16(a[0], a[1]); w.y = cvt_pk_bf16(a[2], a[3]); w.z = cvt_pk_bf16(b[0], b[1]); w.w = cvt_pk_bf16(b[2], b[3]); return w; }

struct ProjOrder {
    StaticOrder so;
    __device__ __forceinline__ bool next(int i, Unit& u) const {
        const long L = (long)i * so.G + so.c;
        if (L < so.nwg) return so.next(i, u);
        const int x = (int)(L - so.nwg); if (x >= 64) return false;
        u.pm = 256 + (x >> 1); u.pn = 20 + (x & 1); return true;
    }
    __device__ __forceinline__ void a_ready(const Unit&) const {}
    __device__ __forceinline__ void done(const Unit&) const {}
};
struct MoeOrder {
    const PG8_LAS unsigned char* t2e; int nunits, G, c;
    __device__ __forceinline__ bool next(int i, Unit& u) const {
        const int L = i * G + c; if (L >= nunits) return false;
        const int pm = L >> 2; u.pm = pm; u.pn = (int)t2e[pm] * 4 + (L & 3); return true;
    }
    __device__ __forceinline__ void a_ready(const Unit&) const {}
    __device__ __forceinline__ void done(const Unit&) const {}
};

struct EpiProj {
    static constexpr bool PERM = true, AFTER_DRAIN = false;
    bf16_t* PROJ; bf16_t* GATES; bf16_t* KV; float qscale;
    __device__ __forceinline__ void operator()(const f32x4 (&acc)[2][2][4][2], const Unit& u, int wr, int wc, int fr, int fq) const {
        bf16_t* base; int ldc, colt, mode = 0; float sc = 1.f; int rowt = u.pm * BM;
        if (u.pm >= 256) { base = KV; ldc = 512; colt = (u.pn - 20) * BM; rowt -= 65536; }
        else if (u.pn < 8) { base = PROJ; ldc = 2048; colt = u.pn * BM; if (u.pn == 1 || u.pn == 2 || u.pn == 7) sc = qscale; }
        else { base = GATES; ldc = 3072; colt = (u.pn - 8) * BM; mode = 1; }
        const int row0 = rowt + wr * 64 + fr, col0 = colt + wc * 32 + 8 * fq;
#pragma unroll
        for (int ai = 0; ai < 2; ++ai)
#pragma unroll
            for (int m = 0; m < 4; ++m) { bf16_t* rowp = base + (size_t)(row0 + ai * HALF + m * 16) * ldc + col0;
#pragma unroll
                for (int bj = 0; bj < 2; ++bj) { f32x4 v0 = acc[ai][bj][m][0], v1 = acc[ai][bj][m][1];
                    if (mode) {
#pragma unroll
                        for (int i = 0; i < 4; ++i) { v0[i] = sigmoid_f(v0[i]); v1[i] = sigmoid_f(v1[i]); } }
                    else { v0 = v0 * sc; v1 = v1 * sc; }
                    *(u32x4*)(rowp + bj * HALF) = pack8(v0, v1); } }
    }
};
__device__ __forceinline__ float gclamp(float g) { return __builtin_fmaxf(g, 1e-18f); }
struct MidRescale {
    static constexpr bool ON = true; static constexpr int T0 = 4, T1 = 12;
    const bf16_t* GATES;
    __device__ __forceinline__ void operator()(f32x4 (&acc)[2][2][4][2], const Unit& u, int t, int wr, int wc, int fr, int fq) const {
        int fr_ = fr; asm volatile("" : "+v"(fr_));
        const int row0 = u.pm * BM + wr * 64 + fr_, col0 = u.pn * BM + wc * 32 + 8 * fq; const int gprev = (t == T0) ? 0 : 1024;
        const unsigned off0 = ((unsigned)row0 * 3072u + (unsigned)(gprev + col0)) * 2u;
#pragma unroll
        for (int ai = 0; ai < 2; ++ai) {
            u32x4 ga[4][2], gb[4][2];
#pragma unroll
            for (int m = 0; m < 4; ++m) { const char* gp = (const char*)GATES + (off0 + (unsigned)((ai * HALF + m * 16) * 3072 * 2));
#pragma unroll
                for (int bj = 0; bj < 2; ++bj) { ga[m][bj] = *(const u32x4*)(gp + bj * HALF * 2); gb[m][bj] = *(const u32x4*)(gp + 2048 + bj * HALF * 2); } }
#pragma unroll
            for (int m = 0; m < 4; ++m)
#pragma unroll
                for (int bj = 0; bj < 2; ++bj) { const u32x4 a = ga[m][bj], b = gb[m][bj];
                    f32x4 r0, r1;
                    r0[0] = bf_lo(a.x) * __builtin_amdgcn_rcpf(gclamp(bf_lo(b.x))); r0[1] = bf_hi(a.x) * __builtin_amdgcn_rcpf(gclamp(bf_hi(b.x)));
                    r0[2] = bf_lo(a.y) * __builtin_amdgcn_rcpf(gclamp(bf_lo(b.y))); r0[3] = bf_hi(a.y) * __builtin_amdgcn_rcpf(gclamp(bf_hi(b.y)));
                    r1[0] = bf_lo(a.z) * __builtin_amdgcn_rcpf(gclamp(bf_lo(b.z))); r1[1] = bf_hi(a.z) * __builtin_amdgcn_rcpf(gclamp(bf_hi(b.z)));
                    r1[2] = bf_lo(a.w) * __builtin_amdgcn_rcpf(gclamp(bf_lo(b.w))); r1[3] = bf_hi(a.w) * __builtin_amdgcn_rcpf(gclamp(bf_hi(b.w)));
                    acc[ai][bj][m][0] = acc[ai][bj][m][0] * r0; acc[ai][bj][m][1] = acc[ai][bj][m][1] * r1; }
            asm volatile("" ::: "memory"); }
    }
};
struct EpiMerge {
    static constexpr bool PERM = true, AFTER_DRAIN = false;
    const bf16_t* GATES; bf16_t* MERGED;
    __device__ __forceinline__ void operator()(const f32x4 (&acc)[2][2][4][2], const Unit& u, int wr, int wc, int fr, int fq) const {
        const int row0 = u.pm * BM + wr * 64 + fr, col0 = u.pn * BM + wc * 32 + 8 * fq;
        const unsigned off0 = ((unsigned)row0 * 3072u + (unsigned)(2048 + col0)) * 2u;
        u32x4 gg[2][4][2];
#pragma unroll
        for (int ai = 0; ai < 2; ++ai)
#pragma unroll
            for (int m = 0; m < 4; ++m)
#pragma unroll
                for (int bj = 0; bj < 2; ++bj) gg[ai][m][bj] = *(const u32x4*)((const char*)GATES + (off0 + (unsigned)((ai * HALF + m * 16) * 3072 * 2)) + bj * HALF * 2);
#pragma unroll
        for (int ai = 0; ai < 2; ++ai)
#pragma unroll
            for (int m = 0; m < 4; ++m) { const size_t r = (size_t)(row0 + ai * HALF + m * 16);
#pragma unroll
                for (int bj = 0; bj < 2; ++bj) { const int c = col0 + bj * HALF; const u32x4 g = gg[ai][m][bj];
                    f32x4 v0 = acc[ai][bj][m][0], v1 = acc[ai][bj][m][1];
                    v0[0] *= gclamp(bf_lo(g.x)); v0[1] *= gclamp(bf_hi(g.x)); v0[2] *= gclamp(bf_lo(g.y)); v0[3] *= gclamp(bf_hi(g.y));
                    v1[0] *= gclamp(bf_lo(g.z)); v1[1] *= gclamp(bf_hi(g.z)); v1[2] *= gclamp(bf_lo(g.w)); v1[3] *= gclamp(bf_hi(g.w));
                    *(u32x4*)(MERGED + r * 1024 + c) = pack8(v0, v1); } }
    }
};
struct EpiMix {
    static constexpr bool PERM = true, AFTER_DRAIN = false;
    bf16_t* MIX;
    __device__ __forceinline__ void operator()(const f32x4 (&acc)[2][2][4][2], const Unit& u, int wr, int wc, int fr, int fq) const {
        const int row0 = u.pm * BM + wr * 64 + fr, col0 = u.pn * BM + wc * 32 + 8 * fq;
#pragma unroll
        for (int ai = 0; ai < 2; ++ai)
#pragma unroll
            for (int m = 0; m < 4; ++m) { bf16_t* rowp = MIX + (size_t)(row0 + ai * HALF + m * 16) * 1024 + col0;
#pragma unroll
                for (int bj = 0; bj < 2; ++bj) *(u32x4*)(rowp + bj * HALF) = pack8(acc[ai][bj][m][0], acc[ai][bj][m][1]); }
    }
};
struct EpiWo {
    static constexpr bool PERM = false, AFTER_DRAIN = false;
    const float* X; float* X1;
    __device__ __forceinline__ void operator()(const f32x4 (&acc)[2][2][4][2], const Unit& u, int wr, int wc, int fr, int fq) const {
        const int row0 = u.pm * BM + wr * 64 + fr, col0 = u.pn * BM + wc * 32 + 4 * fq;
#pragma unroll
        for (int ai = 0; ai < 2; ++ai)
#pragma unroll
            for (int m = 0; m < 4; ++m) { const size_t off = (size_t)(row0 + ai * HALF + m * 16) * 1024 + col0;
#pragma unroll
                for (int bj = 0; bj < 2; ++bj)
#pragma unroll
                    for (int n = 0; n < 2; ++n) { const size_t o = off + bj * HALF + n * 16; *(f32x4*)(X1 + o) = *(const f32x4*)(X + o) + acc[ai][bj][m][n]; } }
    }
};
struct EpiGateUp {
    static constexpr bool PERM = true, AFTER_DRAIN = false;
    bf16_t* HID; const float* RWE; const PG8_LAS int* TB;
    __device__ __forceinline__ void operator()(const f32x4 (&acc)[2][2][4][2], const Unit& u, int wr, int wc, int fr, int fq) const {
        const int row0 = u.pm * BM + wr * 64 + fr, colh = (u.pn & 3) * 128 + wc * 32 + 8 * fq;
#pragma unroll
        for (int ai = 0; ai < 2; ++ai)
#pragma unroll
            for (int m = 0; m < 4; ++m) { const size_t r = (size_t)(row0 + ai * HALF + m * 16); const size_t es = (size_t)((u.pn >> 2) << 16) + (r - (size_t)TB[u.pn >> 2] * 256); const float ri = RWE[2 * es], w = RWE[2 * es + 1];
                f32x4 h0, h1;
#pragma unroll
                for (int i = 0; i < 4; ++i) { const float g0 = acc[ai][0][m][0][i] * ri, g1 = acc[ai][0][m][1][i] * ri; const float wr_ = w * ri;
                    h0[i] = g0 * sigmoid_f(g0) * acc[ai][1][m][0][i] * wr_; h1[i] = g1 * sigmoid_f(g1) * acc[ai][1][m][1][i] * wr_; }
                *(u32x4*)(HID + r * 512 + colh) = pack8(h0, h1); }
    }
};
struct EpiDown {
    static constexpr bool PERM = true, AFTER_DRAIN = false;
    bf16_t* Y;
    __device__ __forceinline__ void operator()(const f32x4 (&acc)[2][2][4][2], const Unit& u, int wr, int wc, int fr, int fq) const {
        const int row0 = u.pm * BM + wr * 64 + fr, col0 = (u.pn & 3) * BM + wc * 32 + 8 * fq;
#pragma unroll
        for (int ai = 0; ai < 2; ++ai)
#pragma unroll
            for (int m = 0; m < 4; ++m) { bf16_t* rowp = Y + (size_t)(row0 + ai * HALF + m * 16) * 1024 + col0;
#pragma unroll
                for (int bj = 0; bj < 2; ++bj) *(u32x4*)(rowp + bj * HALF) = pack8(acc[ai][bj][m][0], acc[ai][bj][m][1]); }
    }
};

struct NoMid { static constexpr bool ON = false; static constexpr int T0 = -1, T1 = -1; __device__ __forceinline__ void operator()(f32x4 (&)[2][2][4][2], const Unit&, int, int, int, int, int) const {} };
template <class Epi, class Sched, bool ALIGN_EPI = false, bool SP2 = false, class Mid = NoMid, bool GATHER = false>
__device__ __forceinline__ void gemm_phase(const int wv, PG8_LAS unsigned char* lds, const Gemm g, const Sched& S, const Epi& E, const Mid& MH = Mid(), const PG8_LAS int* tokl = nullptr) {
    int tid_ = tid_of(wv); asm volatile("" : "+v"(tid_));
    const int tid = tid_, wid = __builtin_amdgcn_readfirstlane(tid >> 6), lane = tid & 63, wr = wid >> 2, wc = wid & 3, fr = lane & 15, fq = lane >> 4;
    static_assert(!GATHER || SP2, "GATHER is written for the SP2 loop");
    const int K = g.K, nt = K / BK;
    unsigned voffA[2], voffB[2];
#pragma unroll
    for (int i = 0; i < 2; ++i) { int R, C; stage_rc(tid * 16 + i * 8192, R, C); const int Rb = Epi::PERM ? ((R & ~31) + perm32(R & 31)) : R;
        voffA[i] = (unsigned)(R * K + C) * 2u; voffB[i] = (unsigned)(Rb * K + C) * 2u; }
    const size_t kstep = (size_t)(BK * 2);
    const size_t hstep = (size_t)HALF * K * 2;
    const size_t tstep = 2 * hstep;
    const unsigned ldsw = (unsigned)wid * 1024u;
    const int aoff = lds_byte(wr * 64 + fr, fq * 8), boff = lds_byte(wc * 32 + fr, fq * 8);
    unsigned vGc[2][2], vGn[2][2]; int gR[2], gC[2];
    if constexpr (GATHER) {
#pragma unroll
        for (int i = 0; i < 2; ++i) { stage_rc(tid * 16 + i * 8192, gR[i], gC[i]); }
    }
#define PG8_GOFFS(dst, u_) do { if constexpr (GATHER) { _Pragma("unroll") for (int hh_ = 0; hh_ < 2; ++hh_) _Pragma("unroll") for (int i_ = 0; i_ < 2; ++i_) \
        dst[hh_][i_] = ((unsigned)tokl[(u_) * 256 + hh_ * HALF + gR[i_]] * (unsigned)K + (unsigned)gC[i_]) * 2u; } } while (0)
#define PG8_STGA(bufoff, base, hh, nx) do { if constexpr (GATHER) { _Pragma("unroll") for (int _i = 0; _i < 2; ++_i) \
        __builtin_amdgcn_global_load_lds((const unsigned*)((const char*)(base) + ((nx) ? vGn[hh][_i] : vGc[hh][_i])), (PG8_LAS unsigned*)(lds + (bufoff) + ldsw + _i * 8192), 16, 0, 0); } \
      else { PG8_STAGE(bufoff, (base) + (hh) * hstep, voffA); } } while (0)
#define PG8_SA(b, h) (((b) * 2 + (h)) * HTB)
#define PG8_SB(b, h) ((4 + (b) * 2 + (h)) * HTB)
#define PG8_STAGE(bufoff, gbase, voff) do { _Pragma("unroll") for (int _i = 0; _i < 2; ++_i) \
        __builtin_amdgcn_global_load_lds((const unsigned*)((const char*)(gbase) + (voff)[_i]), (PG8_LAS unsigned*)(lds + (bufoff) + ldsw + _i * 8192), 16, 0, 0); } while (0)
#define PG8_LDA(dst, b, h) do { _Pragma("unroll") for (int m = 0; m < 4; ++m) _Pragma("unroll") for (int k = 0; k < 2; ++k) dst[m][k] = *(const PG8_LAS bf16x8*)(lds + PG8_SA(b, h) + aoff + m * 2048 + k * 1024); } while (0)
#define PG8_LDB(dst, b, h) do { _Pragma("unroll") for (int n = 0; n < 2; ++n) _Pragma("unroll") for (int k = 0; k < 2; ++k) dst[n][k] = *(const PG8_LAS bf16x8*)(lds + PG8_SB(b, h) + boff + n * 2048 + k * 1024); } while (0)
#define PG8_MMA(ai, bj, At, Bt) do { __builtin_amdgcn_s_setprio(1); _Pragma("unroll") for (int m = 0; m < 4; ++m) _Pragma("unroll") for (int n = 0; n < 2; ++n) _Pragma("unroll") for (int k = 0; k < 2; ++k) \
        acc[ai][bj][m][n] = __builtin_amdgcn_mfma_f32_16x16x32_bf16(Bt[n][k], At[m][k], acc[ai][bj][m][n], 0, 0, 0); __builtin_amdgcn_s_setprio(0); } while (0)
#define PG8_WAIT_V(n) asm volatile("s_waitcnt vmcnt(" #n ")" ::: "memory")
#define PG8_WAIT_L(n) asm volatile("s_waitcnt lgkmcnt(" #n ")" ::: "memory")
#define PG8_BAR __builtin_amdgcn_s_barrier()
#define PG8_SCHED __builtin_amdgcn_sched_barrier(0)
    Unit cur, nxt; int ui = 0;
    if (!S.next(0, cur)) return;
    f32x4 acc[2][2][4][2];
#pragma unroll
    for (int a = 0; a < 2; ++a)
#pragma unroll
        for (int b = 0; b < 2; ++b)
#pragma unroll
            for (int m = 0; m < 4; ++m)
#pragma unroll
                for (int n = 0; n < 2; ++n) acc[a][b][m][n] = (f32x4){0.f, 0.f, 0.f, 0.f};
    bf16x8 At[4][2], B0[2][2], B1[2][2];
    const char* cA = (const char*)g.A + (GATHER ? (size_t)0 : (size_t)cur.pm * tstep); const char* cB = (const char*)g.Bt + (size_t)cur.pn * tstep;
    PG8_GOFFS(vGc, 0); PG8_GOFFS(vGn, 0);
    S.a_ready(cur);
    if constexpr (SP2) {
        PG8_STAGE(PG8_SB(0, 0), cB, voffB); PG8_STAGE(PG8_SB(0, 1), cB + hstep, voffB); PG8_STGA(PG8_SA(0, 0), cA, 0, false); PG8_STGA(PG8_SA(0, 1), cA, 1, false);
        if (wr == 1) PG8_BAR;
        PG8_WAIT_V(2); PG8_BAR;
        PG8_STAGE(PG8_SB(1, 0), cB + kstep, voffB); PG8_STGA(PG8_SA(1, 0), cA + kstep, 0, false); PG8_STAGE(PG8_SB(1, 1), cB + hstep + kstep, voffB);
        PG8_WAIT_V(6); PG8_BAR;
    } else {
        PG8_STAGE(PG8_SB(0, 0), cB, voffB); PG8_STAGE(PG8_SA(0, 0), cA, voffA); PG8_STAGE(PG8_SB(0, 1), cB + hstep, voffB); PG8_STAGE(PG8_SA(0, 1), cA + hstep, voffA);
        if (wr == 1) PG8_BAR;
        PG8_WAIT_V(4); PG8_BAR;
        PG8_STAGE(PG8_SB(1, 0), cB + kstep, voffB); PG8_STAGE(PG8_SA(1, 0), cA + kstep, voffA); PG8_STAGE(PG8_SB(1, 1), cB + hstep + kstep, voffB);
        PG8_WAIT_V(6); PG8_BAR;
    }
    for (;;) {
        const bool has_next = S.next(ui + 1, nxt);
        if (has_next) PG8_GOFFS(vGn, ui + 1);
        const char* nA = (has_next && !GATHER) ? (const char*)g.A + (size_t)nxt.pm * tstep : cA; const char* nB = has_next ? (const char*)g.Bt + (size_t)nxt.pn * tstep : cB;
        for (int t = 0; t < nt; t += 2) {
            if constexpr (Mid::ON) { if (t == Mid::T0 || t == Mid::T1) MH(acc, cur, t, wr, wc, fr, fq); }
            const bool last = (t == nt - 2);
            const char* a1 = cA + (size_t)(t + 1) * kstep;
            const char* a2 = last ? nA : cA + (size_t)(t + 2) * kstep; const char* b2 = last ? nB : cB + (size_t)(t + 2) * kstep;
            const char* a3 = a2 + kstep; const char* b3 = b2 + kstep;
            if (last && has_next) S.a_ready(nxt);
            if constexpr (SP2) {
            PG8_LDB(B0, 0, 0); PG8_LDB(B1, 0, 1); PG8_SCHED; PG8_LDA(At, 0, 0); PG8_STGA(PG8_SA(1, 1), a1, 1, false);
            PG8_WAIT_V(8); PG8_WAIT_L(0); PG8_BAR; PG8_MMA(0, 0, At, B0); PG8_MMA(0, 1, At, B1); PG8_BAR; PG8_SCHED;
            PG8_LDA(At, 0, 1); PG8_STAGE(PG8_SB(0, 0), b2, voffB); PG8_STAGE(PG8_SB(0, 1), b2 + hstep, voffB); PG8_STGA(PG8_SA(0, 0), a2, 0, last && has_next);
            PG8_WAIT_V(8); PG8_WAIT_L(0); PG8_BAR; PG8_MMA(1, 0, At, B0); PG8_MMA(1, 1, At, B1); PG8_BAR; PG8_SCHED;
            PG8_LDB(B0, 1, 0); PG8_LDB(B1, 1, 1); PG8_SCHED; PG8_LDA(At, 1, 0); PG8_STGA(PG8_SA(0, 1), a2, 1, last && has_next);
            PG8_WAIT_V(8); PG8_WAIT_L(0); PG8_BAR; PG8_MMA(0, 0, At, B0); PG8_MMA(0, 1, At, B1); PG8_BAR; PG8_SCHED;
            PG8_LDA(At, 1, 1); PG8_STAGE(PG8_SB(1, 0), b3, voffB); PG8_STAGE(PG8_SB(1, 1), b3 + hstep, voffB); PG8_STGA(PG8_SA(1, 0), a3, 0, last && has_next);
            PG8_WAIT_V(8); PG8_WAIT_L(0); PG8_BAR; PG8_MMA(1, 0, At, B0); PG8_MMA(1, 1, At, B1); PG8_BAR; PG8_SCHED;
            } else {
            PG8_LDB(B0, 0, 0); PG8_SCHED; PG8_LDA(At, 0, 0); PG8_STAGE(PG8_SA(1, 1), a1 + hstep, voffA);
            PG8_WAIT_L(8); PG8_BAR; PG8_WAIT_L(0); PG8_MMA(0, 0, At, B0); PG8_BAR; PG8_SCHED;
            PG8_LDB(B1, 0, 1); PG8_STAGE(PG8_SB(0, 0), b2, voffB);
            PG8_BAR; PG8_WAIT_L(0); PG8_MMA(0, 1, At, B1); PG8_BAR;
            PG8_LDA(At, 0, 1); PG8_STAGE(PG8_SA(0, 0), a2, voffA);
            PG8_BAR; PG8_WAIT_L(0); PG8_MMA(1, 0, At, B0); PG8_BAR; PG8_SCHED;
            PG8_STAGE(PG8_SB(0, 1), b2 + hstep, voffB);
            PG8_WAIT_V(6); PG8_BAR; PG8_MMA(1, 1, At, B1); PG8_BAR;
            PG8_LDB(B0, 1, 0); PG8_SCHED; PG8_LDA(At, 1, 0); PG8_STAGE(PG8_SA(0, 1), a2 + hstep, voffA);
            PG8_WAIT_L(8); PG8_BAR; PG8_WAIT_L(0); PG8_MMA(0, 0, At, B0); PG8_BAR; PG8_SCHED;
            PG8_LDB(B1, 1, 1); PG8_STAGE(PG8_SB(1, 0), b3, voffB);
            PG8_BAR; PG8_WAIT_L(0); PG8_MMA(0, 1, At, B1); PG8_BAR;
            PG8_LDA(At, 1, 1); PG8_STAGE(PG8_SA(1, 0), a3, voffA);
            PG8_BAR; PG8_WAIT_L(0); PG8_MMA(1, 0, At, B0); PG8_BAR; PG8_SCHED;
            PG8_STAGE(PG8_SB(1, 1), b3 + hstep, voffB);
            PG8_WAIT_V(6); PG8_BAR; PG8_MMA(1, 1, At, B1); PG8_BAR;
            }
        }
        if constexpr (ALIGN_EPI) { if (wr == 0) PG8_BAR; }
        if constexpr (!Epi::AFTER_DRAIN) { E(acc, cur, wr, wc, fr, fq); S.done(cur); }
        if (!has_next) break;
#pragma unroll
        for (int a = 0; a < 2; ++a)
#pragma unroll
            for (int b = 0; b < 2; ++b)
#pragma unroll
                for (int m = 0; m < 4; ++m)
#pragma unroll
                    for (int n = 0; n < 2; ++n) acc[a][b][m][n] = (f32x4){0.f, 0.f, 0.f, 0.f};
        cur = nxt; cA = nA; cB = nB; ++ui;
        if constexpr (GATHER) { _Pragma("unroll") for (int hh_ = 0; hh_ < 2; ++hh_) _Pragma("unroll") for (int i_ = 0; i_ < 2; ++i_) vGc[hh_][i_] = vGn[hh_][i_]; }
        if constexpr (ALIGN_EPI) { if (wr == 1) PG8_BAR; }
    }
    PG8_WAIT_V(0);
    if constexpr (!ALIGN_EPI) { if (wr == 0) PG8_BAR; }
    PG8_BAR;
    if constexpr (Epi::AFTER_DRAIN) { E.fused(acc, cur, wr, wc, fr, fq, lds, wid, lane); S.done(cur); }
#undef PG8_SA
#undef PG8_SB
#undef PG8_STAGE
#undef PG8_STGA
#undef PG8_GOFFS
#undef PG8_LDA
#undef PG8_LDB
#undef PG8_MMA
#undef PG8_WAIT_V
#undef PG8_WAIT_L
#undef PG8_BAR
#undef PG8_SCHED
}
}
#include <hip/hip_bf16.h>
#include <cmath>
namespace attn_body {
using bf16=__hip_bfloat16;
using bf16x8=__attribute__((ext_vector_type(8)))short;
using s16x4=__attribute__((ext_vector_type(4)))short;
using f32x16=__attribute__((ext_vector_type(16)))float;
using u32x4=__attribute__((ext_vector_type(4)))unsigned;
constexpr int D=64;
constexpr int NW=8,QBLK=32,QB=QBLK*NW,KVBLK=64;
constexpr int ATTN_UNIT_ROWS=QB;
__device__ __forceinline__ int crow(int r,int hi){return (r&3)+8*(r>>2)+4*hi;}
#define SBAR() __builtin_amdgcn_sched_barrier(0)
__device__ __forceinline__ void cmask(f32x16&p0,f32x16&p1,int jb,int qrel,int hi){
  const float NEG=-INFINITY; int kb=64*jb+4*hi;
  #pragma unroll
  for(int r=0;r<16;++r){int kv=kb+(r&3)+8*(r>>2); if(kv>qrel)p0[r]=NEG; if(kv+32>qrel)p1[r]=NEG;}
}

constexpr int NSLOT=3, SLOTB=8192;
constexpr int LDS_K=0, LDS_V=NSLOT*SLOTB, LDS_WS=2*NSLOT*SLOTB, LDS_OST=LDS_WS+NW*64*4, LDS_BYTES=LDS_OST+NW*4096;
constexpr float C2=0.125f*1.4426950408889634f;
__device__ __forceinline__ void glds16(const void*gsrc,unsigned lds_dst){unsigned keep;
  asm volatile("s_mov_b32 %0, m0\n\ts_mov_b32 m0, %2\n\ts_nop 0\n\tglobal_load_lds_dwordx4 %1, off\n\ts_mov_b32 m0, %0":"=&s"(keep):"v"(gsrc),"s"(lds_dst):"memory");}
__device__ __forceinline__ float max3f(float a,float b,float c){float r;asm("v_max3_f32 %0, %1, %2, %3":"=v"(r):"v"(a),"v"(b),"v"(c));return r;}
__device__ __forceinline__ float max2f(float a,float b){float r;asm("v_max_f32_e32 %0, %1, %2":"=v"(r):"v"(a),"v"(b));return r;}
__device__ __forceinline__ float fadd_s(float a,float b){float r;asm("v_add_f32_e32 %0, %1, %2":"=v"(r):"v"(a),"v"(b));return r;}
__device__ __forceinline__ float fsub_s(float a,float b){float r;asm("v_sub_f32_e32 %0, %1, %2":"=v"(r):"v"(a),"v"(b));return r;}
typedef float f32x2_t __attribute__((ext_vector_type(2))); typedef __bf16 bf16x2_t __attribute__((ext_vector_type(2)));
__device__ __forceinline__ unsigned cvtpk_s(float lo,float hi){f32x2_t v={lo,hi};bf16x2_t b=__builtin_convertvector(v,bf16x2_t);return __builtin_bit_cast(unsigned,b);}
#define WAIT_BAR(N) asm volatile("s_waitcnt vmcnt(" #N ") lgkmcnt(0)\n\ts_barrier":::"memory")

__device__ __forceinline__ void qkt(f32x16&p0,f32x16&p1,const char*Kslot,const bf16x8*qr,const f32x16&negm,int r32,int hi){
  const char*kb=Kslot+hi*1024+r32*16;
  #pragma unroll
  for(int d0=0;d0<4;++d0){
    const bf16x8 b0=*reinterpret_cast<const bf16x8*>(kb+d0*2048);
    const bf16x8 b1=*reinterpret_cast<const bf16x8*>(kb+d0*2048+512);
    if(d0==0){p0=__builtin_amdgcn_mfma_f32_32x32x16_bf16(b0,qr[0],negm,0,0,0);p1=__builtin_amdgcn_mfma_f32_32x32x16_bf16(b1,qr[0],negm,0,0,0);}
    else{p0=__builtin_amdgcn_mfma_f32_32x32x16_bf16(b0,qr[d0],p0,0,0,0);p1=__builtin_amdgcn_mfma_f32_32x32x16_bf16(b1,qr[d0],p1,0,0,0);}}
}
typedef __attribute__((address_space(3))) const char* lds_cptr;
typedef short v4i16_t __attribute__((ext_vector_type(4)));
__device__ __forceinline__ void kload8(bf16x8*kf,lds_cptr kp){
  kf[0]=*(const __attribute__((address_space(3))) bf16x8*)(kp);      kf[1]=*(const __attribute__((address_space(3))) bf16x8*)(kp+512);
  kf[2]=*(const __attribute__((address_space(3))) bf16x8*)(kp+2048); kf[3]=*(const __attribute__((address_space(3))) bf16x8*)(kp+2560);
  kf[4]=*(const __attribute__((address_space(3))) bf16x8*)(kp+4096); kf[5]=*(const __attribute__((address_space(3))) bf16x8*)(kp+4608);
  kf[6]=*(const __attribute__((address_space(3))) bf16x8*)(kp+6144); kf[7]=*(const __attribute__((address_space(3))) bf16x8*)(kp+6656);
}
__device__ __forceinline__ void kload2(bf16x8*kf,lds_cptr kp,int j){ kf[2*j]=*(const __attribute__((address_space(3))) bf16x8*)(kp+j*2048); kf[2*j+1]=*(const __attribute__((address_space(3))) bf16x8*)(kp+j*2048+512); }
__device__ __forceinline__ s16x4 vtr(lds_cptr p){ return __builtin_bit_cast(s16x4,__builtin_amdgcn_ds_read_tr16_b64_v4i16((__attribute__((address_space(3))) v4i16_t*)p)); }
__device__ __forceinline__ float rowmax(const f32x16&p0,const f32x16&p1){
  float a=max3f(p0[0],p0[1],p1[0]),b=max3f(p0[2],p0[3],p1[1]);a=max3f(a,p1[2],p1[3]);
  #pragma unroll
  for(int r=4;r<16;r+=4){a=max3f(a,p0[r],p0[r+1]);b=max3f(b,p0[r+2],p0[r+3]);a=max3f(a,p1[r],p1[r+1]);b=max3f(b,p1[r+2],p1[r+3]);}
  const float m=max2f(a,b);
  auto rr=__builtin_amdgcn_permlane32_swap(__float_as_uint(m),__float_as_uint(m),false,false);
  return max2f(__uint_as_float(rr[0]),__uint_as_float(rr[1]));
}
__device__ __forceinline__ void pv(f32x16*o,int vb,bf16x8 pa0,bf16x8 pa1,bf16x8 pa2,bf16x8 pa3){
  #pragma unroll
  for(int d0=0;d0<2;++d0){s16x4 lo[4],hi[4];
    #pragma unroll
    for(int ks=0;ks<4;++ks){
      asm volatile("ds_read_b64_tr_b16 %0,%1 offset:%c2":"=&v"(lo[ks]):"v"(vb),"i"(d0*4096+ks*1024):"memory");
      asm volatile("ds_read_b64_tr_b16 %0,%1 offset:%c2":"=&v"(hi[ks]):"v"(vb),"i"(d0*4096+ks*1024+512):"memory");}
    asm volatile("s_waitcnt lgkmcnt(0)":::"memory");SBAR();
    #define PK(k) (bf16x8){lo[k][0],lo[k][1],lo[k][2],lo[k][3],hi[k][0],hi[k][1],hi[k][2],hi[k][3]}
    o[d0]=__builtin_amdgcn_mfma_f32_32x32x16_bf16(pa0,PK(0),o[d0],0,0,0);
    o[d0]=__builtin_amdgcn_mfma_f32_32x32x16_bf16(pa1,PK(1),o[d0],0,0,0);
    o[d0]=__builtin_amdgcn_mfma_f32_32x32x16_bf16(pa2,PK(2),o[d0],0,0,0);
    o[d0]=__builtin_amdgcn_mfma_f32_32x32x16_bf16(pa3,PK(3),o[d0],0,0,0);
    #undef PK
  }
}

#ifndef ATTN_STORE16
#define ATTN_STORE16(p,v) (*(u32x4*)(p)=(v))
#endif
template<int THRL,bool CAUSAL> __device__ __forceinline__ void attn_unit(const bf16*Qu,const int pQ,const bf16*__restrict__ Kh,const bf16*__restrict__ Vh,const int pKV,bf16*Ou,const int pO,const int NT,char*shm,const int wv=0){
  int tid_=tid_of(wv); asm volatile("":"+v"(tid_));
  const int tid=tid_,lane=tid&63,r32=lane&31,hi=lane>>5; const int wid=__builtin_amdgcn_readfirstlane(tid>>6);
  const bf16*Qw=Qu+(long)(wid*QBLK)*pQ;
  const unsigned lds0=(unsigned)(uintptr_t)shm;
  float*wsf=(float*)(shm+LDS_WS)+wid*64;
  const bf16*ksrc=Kh+(long)lane*pKV+wid*8;
  const bf16*vsrc=Vh+(long)(16*(wid&3)+(lane>>2))*pKV+(wid>>2)*32+(lane&3)*8;
  const unsigned kdst=lds0+LDS_K+wid*1024, vdst=lds0+LDS_V+wid*1024;
  #define DMA_K(t,slot) glds16(ksrc+(long)(t)*KVBLK*pKV,(unsigned)__builtin_amdgcn_readfirstlane(kdst+(slot)))
  #define DMA_V(t,slot) glds16(vsrc+(long)(t)*KVBLK*pKV,(unsigned)__builtin_amdgcn_readfirstlane(vdst+(slot)))
  const int vb0=(int)(lds0+LDS_V)+((lane>>4)&1)*32+(lane&3)*8+(4*hi+((lane&15)>>2))*64;
  const char*Kbase=shm+LDS_K; bf16x8 kf[8];
  const lds_cptr shm3=(lds_cptr)shm; const lds_cptr kp0=shm3+LDS_K+hi*1024+r32*16; const lds_cptr vp0=shm3+LDS_V+((lane>>4)&1)*32+(lane&3)*8+(4*hi+((lane&15)>>2))*64;
  DMA_K(0,0);DMA_V(0,0);DMA_K(1,SLOTB);
  bf16x8 qr[4];
  #pragma unroll
  for(int d0=0;d0<4;++d0)qr[d0]=*reinterpret_cast<const bf16x8*>(&Qw[(long)r32*pQ+d0*16+hi*8]);
  float mhat=0.f,l_reg=0.f;f32x16 o[2];o[0]=f32x16{};o[1]=f32x16{};const f32x16 negm=f32x16{};
  const int qrel=wid*QBLK+r32;
  #define CMASK(P0,P1,t) do{ if(CAUSAL){int jb_=(t)-(NT-4); if(jb_>=0)cmask(P0,P1,jb_,qrel,hi);} }while(0)
  bool resc=false;
  #define START(P0,P1) do{ const float rm=rowmax(P0,P1); resc=false; \
    { const float dl=rm; mhat=fadd_s(mhat,dl); \
      _Pragma("unroll") for(int r=0;r<16;++r){P0[r]=fsub_s(P0[r],dl);P1[r]=fsub_s(P1[r],dl);} \
      } \
    _Pragma("unroll") for(int r=0;r<16;++r)P0[r]=__builtin_amdgcn_exp2f(P0[r]); }while(0)
  #define RESC() do{ if(resc){ asm volatile("s_waitcnt lgkmcnt(0)":::"memory"); \
      _Pragma("unroll") for(int d_=0;d_<2;++d_) _Pragma("unroll") for(int r=0;r<16;++r)o[d_][r]*=wsf[crow(r,hi)]; } }while(0)
  f32x16 pA0,pA1,pB0,pB1;
  int sl_prev=0,sl_cur=0,sl_next=SLOTB;
  #define ROT() do{sl_prev=sl_cur;sl_cur=sl_next;sl_next=(sl_next==(NSLOT-1)*SLOTB)?0:sl_next+SLOTB;}while(0)
  DMA_K(2,2*SLOTB);
  WAIT_BAR(3);
  qkt(pA0,pA1,Kbase,qr,negm,r32,hi);asm volatile("s_nop 15\n\ts_nop 7":"+v"(pA0),"+v"(pA1));CMASK(pA0,pA1,0);
  START(pA0,pA1);
  _Pragma("unroll") for(int r=0;r<16;++r)pA1[r]=__builtin_amdgcn_exp2f(pA1[r]);
  WAIT_BAR(0);
  DMA_K(3,0);DMA_V(1,SLOTB);
  ROT();
  kload8(kf,kp0+sl_cur);
  WAIT_BAR(2);
  s16x4 vlo[8],vhi[8]; u32x4 pw0,pw1,pw2,pw3;
  #define PKW(P,B) cvtpk_s(P[B],P[B+1])
  #define PAF(k) __builtin_bit_cast(bf16x8,pw##k)
  #define VFR(i) (bf16x8){vlo[i][0],vlo[i][1],vlo[i][2],vlo[i][3],vhi[i][0],vhi[i][1],vhi[i][2],vhi[i][3]}
  #define PIN(x) asm volatile("":"+v"(x))
  #define MX3(a,b,c) __builtin_fmaxf(__builtin_fmaxf((a),(b)),(c))
  #define GAPA(MF,A0,A1,A2,A3,W0,W1,PW) do{ MF; sacc+=A0; sacc+=A1; sacc+=A2; sacc+=A3; PIN(sacc); W0; W1; PIN(PW); SBAR(); }while(0)
  #define EX(v) __builtin_amdgcn_exp2f(v)
  #define GAPB(MF,X,B) do{ MF; X[B]=EX(X[B]); X[B+1]=EX(X[B+1]); X[B+2]=EX(X[B+2]); X[B+3]=EX(X[B+3]); PIN(X); SBAR(); }while(0)
  #define VRD(i) do{ vlo[i]=vtr(vp_+(((i)>>2)*4096+((i)&3)*1024)); vhi[i]=vtr(vp_+(((i)>>2)*4096+((i)&3)*1024+512)); }while(0)
  #define KRD(G,j) do{ if(G){ kload2(kf,kp0+sl_next,j); SBAR(); } }while(0)
  #define STEP(C0,C1,P0,P1,t,GK,GV,GL) do{ SBAR(); \
    const lds_cptr vp_=vp0+sl_prev; \
    VRD(0); SBAR(); float sacc=(P0[0]+P0[1]); \
    GAPA(C0=__builtin_amdgcn_mfma_f32_32x32x16_bf16(kf[0],qr[0],negm,0,0,0), P0[2],P0[3],P0[4],P0[5],     pw0[0]=PKW(P0,0), pw0[1]=PKW(P0,2), pw0); \
    VRD(4); SBAR(); GAPA(C1=__builtin_amdgcn_mfma_f32_32x32x16_bf16(kf[1],qr[0],negm,0,0,0), P0[6],P0[7],P0[8],P0[9],     pw0[2]=PKW(P0,4), pw0[3]=PKW(P0,6), pw0); \
    VRD(1); SBAR(); GAPA(C0=__builtin_amdgcn_mfma_f32_32x32x16_bf16(kf[2],qr[1],C0,0,0,0),   P0[10],P0[11],P0[12],P0[13], pw1[0]=PKW(P0,8), pw1[1]=PKW(P0,10), pw1); \
    VRD(5); SBAR(); GAPA(C1=__builtin_amdgcn_mfma_f32_32x32x16_bf16(kf[3],qr[1],C1,0,0,0),   P0[14],P0[15],P1[0],P1[1],   pw1[2]=PKW(P0,12),pw1[3]=PKW(P0,14), pw1); \
    VRD(2); SBAR(); GAPA(C0=__builtin_amdgcn_mfma_f32_32x32x16_bf16(kf[4],qr[2],C0,0,0,0),   P1[2],P1[3],P1[4],P1[5],     pw2[0]=PKW(P1,0), pw2[1]=PKW(P1,2), pw2); \
    VRD(6); SBAR(); GAPA(C1=__builtin_amdgcn_mfma_f32_32x32x16_bf16(kf[5],qr[2],C1,0,0,0),   P1[6],P1[7],P1[8],P1[9],     pw2[2]=PKW(P1,4), pw2[3]=PKW(P1,6), pw2); \
    VRD(3); SBAR(); GAPA(C0=__builtin_amdgcn_mfma_f32_32x32x16_bf16(kf[6],qr[3],C0,0,0,0),   P1[10],P1[11],P1[12],P1[13], pw3[0]=PKW(P1,8), pw3[1]=PKW(P1,10), pw3); \
    VRD(7); SBAR(); GAPA(C1=__builtin_amdgcn_mfma_f32_32x32x16_bf16(kf[7],qr[3],C1,0,0,0),   P1[14],P1[15],0.f,0.f,       pw3[2]=PKW(P1,12),pw3[3]=PKW(P1,14), pw3); \
    l_reg+=sacc; \
    if(GK){DMA_K((t)+3,sl_cur);} if(GV){DMA_V((t)+1,sl_next);} \
    CMASK(C0,C1,t); \
    _Pragma("unroll") for(int r=0;r<16;++r){C0[r]-=mhat;C1[r]-=mhat;} \
    { float a=MX3(C0[0],C0[1],C1[0]),b=MX3(C0[2],C0[3],C1[1]); a=MX3(a,C1[2],C1[3]); \
      _Pragma("unroll") for(int r=4;r<16;r+=4){a=MX3(a,C0[r],C0[r+1]);b=MX3(b,C0[r+2],C0[r+3]);a=MX3(a,C1[r],C1[r+1]);b=MX3(b,C1[r+2],C1[r+3]);} \
      float rm=__builtin_fmaxf(a,b); { auto rr=__builtin_amdgcn_permlane32_swap(__float_as_uint(rm),__float_as_uint(rm),false,false); rm=__builtin_fmaxf(__uint_as_float(rr[0]),__uint_as_float(rr[1])); } \
      resc=false; \
      if(__builtin_expect(__any(rm>(float)THRL),0)){ const float dl=__builtin_fmaxf(rm,0.f); mhat+=dl; \
        _Pragma("unroll") for(int r=0;r<16;++r){C0[r]-=dl;C1[r]-=dl;} \
        const float f=__builtin_amdgcn_exp2f(-dl); l_reg*=f; if(hi==0)wsf[r32]=f; resc=true; } } \
    SBAR(); \
    GAPB(o[0]=__builtin_amdgcn_mfma_f32_32x32x16_bf16(PAF(0),VFR(0),o[0],0,0,0), C0,0); \
    GAPB(o[1]=__builtin_amdgcn_mfma_f32_32x32x16_bf16(PAF(0),VFR(4),o[1],0,0,0), C0,4); \
    KRD(GL,0); GAPB(o[0]=__builtin_amdgcn_mfma_f32_32x32x16_bf16(PAF(1),VFR(1),o[0],0,0,0), C0,8); \
    KRD(GL,1); GAPB(o[1]=__builtin_amdgcn_mfma_f32_32x32x16_bf16(PAF(1),VFR(5),o[1],0,0,0), C0,12); \
    KRD(GL,2); GAPB(o[0]=__builtin_amdgcn_mfma_f32_32x32x16_bf16(PAF(2),VFR(2),o[0],0,0,0), C1,0); \
    KRD(GL,3); GAPB(o[1]=__builtin_amdgcn_mfma_f32_32x32x16_bf16(PAF(2),VFR(6),o[1],0,0,0), C1,4); \
    GAPB(o[0]=__builtin_amdgcn_mfma_f32_32x32x16_bf16(PAF(3),VFR(3),o[0],0,0,0), C1,8); \
    GAPB(o[1]=__builtin_amdgcn_mfma_f32_32x32x16_bf16(PAF(3),VFR(7),o[1],0,0,0), C1,12); \
    }while(0)
  int t=1;
  #undef CMASK
  #define CMASK(P0,P1,t) do{}while(0)
  for(;t+5<NT;t+=2){
    STEP(pB0,pB1,pA0,pA1,t,true,true,true);     WAIT_BAR(2); RESC(); ROT();
    STEP(pA0,pA1,pB0,pB1,t+1,true,true,true);   WAIT_BAR(2); RESC(); ROT();
  }
  #undef CMASK
  #define CMASK(P0,P1,t) do{ if(CAUSAL){int jb_=(t)-(NT-4); if(jb_>=0)cmask(P0,P1,jb_,qrel,hi);} }while(0)
  #define ENDW(tt) do{ if((tt)+3<NT){WAIT_BAR(2);} else if((tt)+2<NT){WAIT_BAR(1);} else {WAIT_BAR(0);} }while(0)
  for(;t+1<NT;t+=2){
    STEP(pB0,pB1,pA0,pA1,t,(t+3<NT),(t+1<NT),(t+1<NT));       ENDW(t);   RESC(); ROT();
    STEP(pA0,pA1,pB0,pB1,t+1,(t+4<NT),(t+2<NT),(t+2<NT));     ENDW(t+1); RESC(); ROT();
  }
  STEP(pB0,pB1,pA0,pA1,NT-1,false,false,false); RESC();
  { float sacc=pB0[0]+pB0[1]; _Pragma("unroll") for(int r=2;r<16;++r)sacc+=pB0[r]; _Pragma("unroll") for(int r=0;r<16;++r)sacc+=pB1[r]; l_reg+=sacc;
    pw0=(u32x4){PKW(pB0,0),PKW(pB0,2),PKW(pB0,4),PKW(pB0,6)};pw1=(u32x4){PKW(pB0,8),PKW(pB0,10),PKW(pB0,12),PKW(pB0,14)};pw2=(u32x4){PKW(pB1,0),PKW(pB1,2),PKW(pB1,4),PKW(pB1,6)};pw3=(u32x4){PKW(pB1,8),PKW(pB1,10),PKW(pB1,12),PKW(pB1,14)};
    SBAR(); pv(o,vb0+sl_cur,PAF(0),PAF(1),PAF(2),PAF(3)); }
  #undef PKW
  #undef PAF
  #undef VFR
  #undef PIN
  #undef MX3
  #undef GAPA
  #undef GAPB
  #undef EX
  #undef VRD
  #undef KRD
  #undef STEP
  #undef ENDW
  {auto rr=__builtin_amdgcn_permlane32_swap(__float_as_uint(l_reg),__float_as_uint(l_reg),false,false);l_reg=__uint_as_float(rr[0])+__uint_as_float(rr[1]);}
  if(hi==0)wsf[32+r32]=l_reg;asm volatile("s_waitcnt lgkmcnt(0)":::"memory");
  float rli[16];
  #pragma unroll
  for(int r=0;r<16;++r)rli[r]=__builtin_amdgcn_rcpf(wsf[32+crow(r,hi)]);
  bf16*Ow=Ou+(long)(wid*QBLK)*pO;
  { bf16*stg=(bf16*)(shm+LDS_OST)+wid*2048;
    #pragma unroll
    for(int r=0;r<16;++r){const int orow=crow(r,hi);
      #pragma unroll
      for(int d0=0;d0<2;++d0)stg[orow*64+d0*32+r32]=__float2bfloat16(o[d0][r]*rli[r]);}
    asm volatile("s_waitcnt lgkmcnt(0)":::"memory");
    #pragma unroll
    for(int i=0;i<4;++i){const int row=i*8+(lane>>3),ch=lane&7; const u32x4 v=*(const u32x4*)(stg+row*64+ch*8); ATTN_STORE16(Ow+(long)row*pO+ch*8,v);} }
  asm volatile("s_waitcnt lgkmcnt(0)\n\ts_barrier":::"memory");
  #undef DMA_K
  #undef DMA_V
  #undef CMASK
  #undef START
  #undef RESC
  #undef ROT
}
__device__ __forceinline__ void mem_attn(const int wv,const bf16*Q0,const int pQ,const bf16*__restrict__ Kh,const bf16*__restrict__ Vh,const int pKV,bf16*O0,const int pO,const int nqb,char*shm){
  int tid_=tid_of(wv); asm volatile("":"+v"(tid_));
  const int tid=tid_,lane=tid&63,r32=lane&31,hi=lane>>5; const int wid=__builtin_amdgcn_readfirstlane(tid>>6);
  constexpr int MK=0,MV=32768,MWS=65536,MOST=65536+2048;
  const unsigned lds0=(unsigned)(uintptr_t)shm;
  const bf16*ksrc=Kh+(long)lane*pKV+wid*8;
  const bf16*vsrc=Vh+(long)(16*(wid&3)+(lane>>2))*pKV+(wid>>2)*32+(lane&3)*8;
  #pragma unroll
  for(int t=0;t<4;++t){ glds16(ksrc+(long)t*KVBLK*pKV,(unsigned)__builtin_amdgcn_readfirstlane(lds0+MK+t*8192+wid*1024)); glds16(vsrc+(long)t*KVBLK*pKV,(unsigned)__builtin_amdgcn_readfirstlane(lds0+MV+t*8192+wid*1024)); }
  WAIT_BAR(0);
  const int vb0=(int)(lds0+MV)+((lane>>4)&1)*32+(lane&3)*8+(4*hi+((lane&15)>>2))*64;
  float*wsf=(float*)(shm+MWS)+wid*64;
  const f32x16 zero=f32x16{};
  for(int qb=0;qb<nqb;++qb){
    const bf16*Qw=Q0+(long)(qb*QB+wid*QBLK)*pQ;
    bf16x8 qr[4];
    #pragma unroll
    for(int d0=0;d0<4;++d0)qr[d0]=*reinterpret_cast<const bf16x8*>(&Qw[(long)r32*pQ+d0*16+hi*8]);
    f32x16 p[4][2];
    #pragma unroll
    for(int t=0;t<4;++t)qkt(p[t][0],p[t][1],shm+MK+t*8192,qr,zero,r32,hi);
    float m=p[0][0][0];
    #pragma unroll
    for(int t=0;t<4;++t)
      #pragma unroll
      for(int j=0;j<2;++j)
        #pragma unroll
        for(int r=0;r<16;++r)m=__builtin_fmaxf(m,p[t][j][r]);
    { auto rr=__builtin_amdgcn_permlane32_swap(__float_as_uint(m),__float_as_uint(m),false,false); m=__builtin_fmaxf(__uint_as_float(rr[0]),__uint_as_float(rr[1])); }
    float l=0.f;
    #pragma unroll
    for(int t=0;t<4;++t)
      #pragma unroll
      for(int j=0;j<2;++j)
        #pragma unroll
        for(int r=0;r<16;++r){ const float e=__builtin_amdgcn_exp2f(p[t][j][r]-m); p[t][j][r]=e; l+=e; }
    { auto rr=__builtin_amdgcn_permlane32_swap(__float_as_uint(l),__float_as_uint(l),false,false); l=__uint_as_float(rr[0])+__uint_as_float(rr[1]); }
    f32x16 o[2]; o[0]=f32x16{}; o[1]=f32x16{};
    #pragma unroll
    for(int t=0;t<4;++t){
      const u32x4 w0={cvtpk_s(p[t][0][0],p[t][0][1]),cvtpk_s(p[t][0][2],p[t][0][3]),cvtpk_s(p[t][0][4],p[t][0][5]),cvtpk_s(p[t][0][6],p[t][0][7])};
      const u32x4 w1={cvtpk_s(p[t][0][8],p[t][0][9]),cvtpk_s(p[t][0][10],p[t][0][11]),cvtpk_s(p[t][0][12],p[t][0][13]),cvtpk_s(p[t][0][14],p[t][0][15])};
      const u32x4 w2={cvtpk_s(p[t][1][0],p[t][1][1]),cvtpk_s(p[t][1][2],p[t][1][3]),cvtpk_s(p[t][1][4],p[t][1][5]),cvtpk_s(p[t][1][6],p[t][1][7])};
      const u32x4 w3={cvtpk_s(p[t][1][8],p[t][1][9]),cvtpk_s(p[t][1][10],p[t][1][11]),cvtpk_s(p[t][1][12],p[t][1][13]),cvtpk_s(p[t][1][14],p[t][1][15])};
      pv(o,vb0+t*8192,__builtin_bit_cast(bf16x8,w0),__builtin_bit_cast(bf16x8,w1),__builtin_bit_cast(bf16x8,w2),__builtin_bit_cast(bf16x8,w3)); }
    if(hi==0)wsf[32+r32]=l; asm volatile("s_waitcnt lgkmcnt(0)":::"memory");
    float rli[16];
    #pragma unroll
    for(int r=0;r<16;++r)rli[r]=__builtin_amdgcn_rcpf(wsf[32+crow(r,hi)]);
    bf16*Ow=O0+(long)(qb*QB+wid*QBLK)*pO;
    { bf16*stg=(bf16*)(shm+MOST)+wid*2048;
      #pragma unroll
      for(int r=0;r<16;++r){const int orow=crow(r,hi);
        #pragma unroll
        for(int d0=0;d0<2;++d0)stg[orow*64+d0*32+r32]=__float2bfloat16(o[d0][r]*rli[r]);}
      asm volatile("s_waitcnt lgkmcnt(0)":::"memory");
      #pragma unroll
      for(int i=0;i<4;++i){const int row=i*8+(lane>>3),ch=lane&7; const u32x4 v=*(const u32x4*)(stg+row*64+ch*8); ATTN_STORE16(Ow+(long)row*pO+ch*8,v);}
      asm volatile("s_waitcnt lgkmcnt(0)":::"memory"); }
  }
  asm volatile("s_waitcnt lgkmcnt(0)\n\ts_barrier":::"memory");
}
constexpr int ATTN_LDS_BYTES=LDS_BYTES;
#undef SBAR
#undef WAIT_BAR
}
namespace attn2 {
using bf16=__hip_bfloat16;
using bf16x8=__attribute__((ext_vector_type(8)))short;
using s16x4=__attribute__((ext_vector_type(4)))short;
using f32x16=__attribute__((ext_vector_type(16)))float;
using u32x4=__attribute__((ext_vector_type(4)))unsigned;
constexpr int D=64;
constexpr int NW=8,QBLK=32,QB=QBLK*NW,KVBLK=64;
constexpr int ATTN_UNIT_ROWS=QB;
__device__ __forceinline__ int crow(int r,int hi){return (r&3)+8*(r>>2)+4*hi;}
#define SBAR() __builtin_amdgcn_sched_barrier(0)
__device__ __forceinline__ void cmask(f32x16&p0,f32x16&p1,int jb,int qrel,int hi){
  const float NEG=-INFINITY; int kb=64*jb+4*hi;
  #pragma unroll
  for(int r=0;r<16;++r){int kv=kb+(r&3)+8*(r>>2); if(kv>qrel)p0[r]=NEG; if(kv+32>qrel)p1[r]=NEG;}
}

constexpr int NSLOT=3, SLOTB=8192;
constexpr int LDS_K=0, LDS_V=NSLOT*SLOTB, LDS_WS=3*NSLOT*SLOTB, LDS_OST=LDS_WS+NW*64*4, LDS_BYTES=LDS_OST+NW*4096;
constexpr float C2=0.125f*1.4426950408889634f;
__device__ __forceinline__ void glds16(const void*gsrc,unsigned lds_dst){unsigned keep;
  asm volatile("s_mov_b32 %0, m0\n\ts_mov_b32 m0, %2\n\ts_nop 0\n\tglobal_load_lds_dwordx4 %1, off\n\ts_mov_b32 m0, %0":"=&s"(keep):"v"(gsrc),"s"(lds_dst):"memory");}
__device__ __forceinline__ float max3f(float a,float b,float c){float r;asm("v_max3_f32 %0, %1, %2, %3":"=v"(r):"v"(a),"v"(b),"v"(c));return r;}
__device__ __forceinline__ float max2f(float a,float b){float r;asm("v_max_f32_e32 %0, %1, %2":"=v"(r):"v"(a),"v"(b));return r;}
__device__ __forceinline__ float fadd_s(float a,float b){float r;asm("v_add_f32_e32 %0, %1, %2":"=v"(r):"v"(a),"v"(b));return r;}
__device__ __forceinline__ float fsub_s(float a,float b){float r;asm("v_sub_f32_e32 %0, %1, %2":"=v"(r):"v"(a),"v"(b));return r;}
typedef float f32x2_t __attribute__((ext_vector_type(2))); typedef __bf16 bf16x2_t __attribute__((ext_vector_type(2)));
__device__ __forceinline__ unsigned cvtpk_s(float lo,float hi){f32x2_t v={lo,hi};bf16x2_t b=__builtin_convertvector(v,bf16x2_t);return __builtin_bit_cast(unsigned,b);}
#define WAIT_BAR(N) asm volatile("s_waitcnt vmcnt(" #N ") lgkmcnt(0)\n\ts_barrier":::"memory")

__device__ __forceinline__ void qkt(f32x16&p0,f32x16&p1,const char*Kslot,const bf16x8*qr,const f32x16&negm,int r32,int hi){
  const char*kb=Kslot+hi*1024+r32*16;
  #pragma unroll
  for(int d0=0;d0<4;++d0){
    const bf16x8 b0=*reinterpret_cast<const bf16x8*>(kb+d0*2048);
    const bf16x8 b1=*reinterpret_cast<const bf16x8*>(kb+d0*2048+512);
    if(d0==0){p0=__builtin_amdgcn_mfma_f32_32x32x16_bf16(b0,qr[0],negm,0,0,0);p1=__builtin_amdgcn_mfma_f32_32x32x16_bf16(b1,qr[0],negm,0,0,0);}
    else{p0=__builtin_amdgcn_mfma_f32_32x32x16_bf16(b0,qr[d0],p0,0,0,0);p1=__builtin_amdgcn_mfma_f32_32x32x16_bf16(b1,qr[d0],p1,0,0,0);}}
}
typedef __attribute__((address_space(3))) const char* lds_cptr;
typedef short v4i16_t __attribute__((ext_vector_type(4)));
__device__ __forceinline__ void kload8(bf16x8*kf,lds_cptr kp){
  kf[0]=*(const __attribute__((address_space(3))) bf16x8*)(kp);      kf[1]=*(const __attribute__((address_space(3))) bf16x8*)(kp+512);
  kf[2]=*(const __attribute__((address_space(3))) bf16x8*)(kp+2048); kf[3]=*(const __attribute__((address_space(3))) bf16x8*)(kp+2560);
  kf[4]=*(const __attribute__((address_space(3))) bf16x8*)(kp+4096); kf[5]=*(const __attribute__((address_space(3))) bf16x8*)(kp+4608);
  kf[6]=*(const __attribute__((address_space(3))) bf16x8*)(kp+6144); kf[7]=*(const __attribute__((address_space(3))) bf16x8*)(kp+6656);
}
__device__ __forceinline__ void kload2(bf16x8*kf,lds_cptr kp,int j){ kf[2*j]=*(const __attribute__((address_space(3))) bf16x8*)(kp+j*2048); kf[2*j+1]=*(const __attribute__((address_space(3))) bf16x8*)(kp+j*2048+512); }
__device__ __forceinline__ s16x4 vtr(lds_cptr p){ return __builtin_bit_cast(s16x4,__builtin_amdgcn_ds_read_tr16_b64_v4i16((__attribute__((address_space(3))) v4i16_t*)p)); }
__device__ __forceinline__ float rowmax(const f32x16&p0,const f32x16&p1){
  float a=max3f(p0[0],p0[1],p1[0]),b=max3f(p0[2],p0[3],p1[1]);a=max3f(a,p1[2],p1[3]);
  #pragma unroll
  for(int r=4;r<16;r+=4){a=max3f(a,p0[r],p0[r+1]);b=max3f(b,p0[r+2],p0[r+3]);a=max3f(a,p1[r],p1[r+1]);b=max3f(b,p1[r+2],p1[r+3]);}
  const float m=max2f(a,b);
  auto rr=__builtin_amdgcn_permlane32_swap(__float_as_uint(m),__float_as_uint(m),false,false);
  return max2f(__uint_as_float(rr[0]),__uint_as_float(rr[1]));
}
__device__ __forceinline__ void pv(f32x16*o,int vb,bf16x8 pa0,bf16x8 pa1,bf16x8 pa2,bf16x8 pa3){
  #pragma unroll
  for(int d0=0;d0<4;++d0){s16x4 lo[4],hi[4];
    #pragma unroll
    for(int ks=0;ks<4;++ks){
      asm volatile("ds_read_b64_tr_b16 %0,%1 offset:%c2":"=&v"(lo[ks]):"v"(vb),"i"(d0*4096+ks*1024):"memory");
      asm volatile("ds_read_b64_tr_b16 %0,%1 offset:%c2":"=&v"(hi[ks]):"v"(vb),"i"(d0*4096+ks*1024+512):"memory");}
    asm volatile("s_waitcnt lgkmcnt(0)":::"memory");SBAR();
    #define PK(k) (bf16x8){lo[k][0],lo[k][1],lo[k][2],lo[k][3],hi[k][0],hi[k][1],hi[k][2],hi[k][3]}
    o[d0]=__builtin_amdgcn_mfma_f32_32x32x16_bf16(pa0,PK(0),o[d0],0,0,0);
    o[d0]=__builtin_amdgcn_mfma_f32_32x32x16_bf16(pa1,PK(1),o[d0],0,0,0);
    o[d0]=__builtin_amdgcn_mfma_f32_32x32x16_bf16(pa2,PK(2),o[d0],0,0,0);
    o[d0]=__builtin_amdgcn_mfma_f32_32x32x16_bf16(pa3,PK(3),o[d0],0,0,0);
    #undef PK
  }
}

#ifndef ATTN_STORE16
#define ATTN_STORE16(p,v) (*(u32x4*)(p)=(v))
#endif
template<int THRL,bool CAUSAL,bool COMBINE=false> __device__ __forceinline__ void attn_unit(const bf16*Qu,const int pQ,const bf16*__restrict__ Kh,const bf16*__restrict__ Vh,const int pKV,const int wv,bf16*Ou,const int pO,const int NT,char*shm,const bf16*S0=nullptr,const int pS=0,const float lam=0.f,const float*sgp=nullptr){
  int tid_=tid_of(wv); asm volatile("":"+v"(tid_));
  const int tid=tid_,lane=tid&63,r32=lane&31,hi=lane>>5; const int wid=__builtin_amdgcn_readfirstlane(tid>>6);
  const bf16*Qw=Qu+(long)(wid*QBLK)*pQ;
  const unsigned lds0=(unsigned)(uintptr_t)shm;
  float*wsf=(float*)(shm+LDS_WS)+wid*64;
  const bf16*ksrc=Kh+(long)lane*pKV+wid*8;
  const bf16*vsrc=Vh+(long)(16*(wid&3)+(lane>>2))*pKV+(wid>>2)*32+(lane&3)*8;
  const unsigned kdst=lds0+LDS_K+wid*1024, vdst=lds0+LDS_V+wid*1024;
  #define DMA_K(t,slot) glds16(ksrc+(long)(t)*KVBLK*pKV,(unsigned)__builtin_amdgcn_readfirstlane(kdst+(slot)))
  #define DMA_V(t,slot) do{ glds16(vsrc+(long)(t)*KVBLK*pKV,(unsigned)__builtin_amdgcn_readfirstlane(vdst+2*(slot))); glds16(vsrc+(long)(t)*KVBLK*pKV+64,(unsigned)__builtin_amdgcn_readfirstlane(vdst+2*(slot)+8192)); }while(0)
  const int vb0=(int)(lds0+LDS_V)+((lane>>4)&1)*32+(lane&3)*8+(4*hi+((lane&15)>>2))*64;
  const char*Kbase=shm+LDS_K; bf16x8 kf[8];
  const lds_cptr shm3=(lds_cptr)shm; const lds_cptr kp0=shm3+LDS_K+hi*1024+r32*16; const lds_cptr vp0=shm3+LDS_V+((lane>>4)&1)*32+(lane&3)*8+(4*hi+((lane&15)>>2))*64;
  DMA_K(0,0);DMA_V(0,0);DMA_K(1,SLOTB);
  bf16x8 qr[4];
  #pragma unroll
  for(int d0=0;d0<4;++d0)qr[d0]=*reinterpret_cast<const bf16x8*>(&Qw[(long)r32*pQ+d0*16+hi*8]);
  float mhat=0.f,l_reg=0.f;f32x16 o[4];o[0]=f32x16{};o[1]=f32x16{};o[2]=f32x16{};o[3]=f32x16{};const f32x16 negm=f32x16{};
  const int qrel=wid*QBLK+r32;
  #define CMASK(P0,P1,t) do{ if(CAUSAL){int jb_=(t)-(NT-4); if(jb_>=0)cmask(P0,P1,jb_,qrel,hi);} }while(0)
  bool resc=false;
  #define START(P0,P1) do{ const float rm=rowmax(P0,P1); resc=false; \
    { const float dl=rm; mhat=fadd_s(mhat,dl); \
      _Pragma("unroll") for(int r=0;r<16;++r){P0[r]=fsub_s(P0[r],dl);P1[r]=fsub_s(P1[r],dl);} \
      } \
    _Pragma("unroll") for(int r=0;r<16;++r)P0[r]=__builtin_amdgcn_exp2f(P0[r]); }while(0)
  #define RESC() do{ if(resc){ asm volatile("s_waitcnt lgkmcnt(0)":::"memory"); \
      _Pragma("unroll") for(int d_=0;d_<4;++d_) _Pragma("unroll") for(int r=0;r<16;++r)o[d_][r]*=wsf[crow(r,hi)]; } }while(0)
  f32x16 pA0,pA1,pB0,pB1;
  int sl_prev=0,sl_cur=0,sl_next=SLOTB;
  #define ROT() do{sl_prev=sl_cur;sl_cur=sl_next;sl_next=(sl_next==(NSLOT-1)*SLOTB)?0:sl_next+SLOTB;}while(0)
  DMA_K(2,2*SLOTB);
  WAIT_BAR(4);
  qkt(pA0,pA1,Kbase,qr,negm,r32,hi);asm volatile("s_nop 15\n\ts_nop 7":"+v"(pA0),"+v"(pA1));CMASK(pA0,pA1,0);
  START(pA0,pA1);
  _Pragma("unroll") for(int r=0;r<16;++r)pA1[r]=__builtin_amdgcn_exp2f(pA1[r]);
  WAIT_BAR(0);
  DMA_K(3,0);DMA_V(1,SLOTB);
  ROT();
  kload8(kf,kp0+sl_cur);
  WAIT_BAR(3);
  s16x4 vlo[8],vhi[8]; u32x4 pw0,pw1,pw2,pw3;
  #define PKW(P,B) cvtpk_s(P[B],P[B+1])
  #define PAF(k) __builtin_bit_cast(bf16x8,pw##k)
  #define VFR(i) (bf16x8){vlo[i][0],vlo[i][1],vlo[i][2],vlo[i][3],vhi[i][0],vhi[i][1],vhi[i][2],vhi[i][3]}
  #define PIN(x) asm volatile("":"+v"(x))
  #define MX3(a,b,c) __builtin_fmaxf(__builtin_fmaxf((a),(b)),(c))
  #define GAPA(MF,A0,A1,A2,A3,W0,W1,PW) do{ MF; sacc+=A0; sacc+=A1; sacc+=A2; sacc+=A3; PIN(sacc); W0; W1; PIN(PW); SBAR(); }while(0)
  #define EX(v) __builtin_amdgcn_exp2f(v)
  #define GAPB(MF,X,B) do{ MF; X[B]=EX(X[B]); X[B+1]=EX(X[B+1]); X[B+2]=EX(X[B+2]); X[B+3]=EX(X[B+3]); PIN(X); SBAR(); }while(0)
  #define VRD(i) do{ vlo[i]=vtr(vp_+(((i)>>2)*4096+((i)&3)*1024)); vhi[i]=vtr(vp_+(((i)>>2)*4096+((i)&3)*1024+512)); }while(0)
  #define VRD2(i) do{ vlo[i]=vtr(vp_+((((i)>>2)+2)*4096+((i)&3)*1024)); vhi[i]=vtr(vp_+((((i)>>2)+2)*4096+((i)&3)*1024+512)); }while(0)
  #define GAPB2(MF,X,B) do{ MF; X[B]=EX(X[B]); X[B+1]=EX(X[B+1]); PIN(X); SBAR(); }while(0)
  #define KRD(G,j) do{ if(G){ kload2(kf,kp0+sl_next,j); SBAR(); } }while(0)
  #define STEP(C0,C1,P0,P1,t,GK,GV,GL) do{ SBAR(); \
    const lds_cptr vp_=vp0+2*sl_prev; \
    VRD(0); SBAR(); float sacc=(P0[0]+P0[1]); \
    GAPA(C0=__builtin_amdgcn_mfma_f32_32x32x16_bf16(kf[0],qr[0],negm,0,0,0), P0[2],P0[3],P0[4],P0[5],     pw0[0]=PKW(P0,0), pw0[1]=PKW(P0,2), pw0); \
    VRD(4); SBAR(); GAPA(C1=__builtin_amdgcn_mfma_f32_32x32x16_bf16(kf[1],qr[0],negm,0,0,0), P0[6],P0[7],P0[8],P0[9],     pw0[2]=PKW(P0,4), pw0[3]=PKW(P0,6), pw0); \
    VRD(1); SBAR(); GAPA(C0=__builtin_amdgcn_mfma_f32_32x32x16_bf16(kf[2],qr[1],C0,0,0,0),   P0[10],P0[11],P0[12],P0[13], pw1[0]=PKW(P0,8), pw1[1]=PKW(P0,10), pw1); \
    VRD(5); SBAR(); GAPA(C1=__builtin_amdgcn_mfma_f32_32x32x16_bf16(kf[3],qr[1],C1,0,0,0),   P0[14],P0[15],P1[0],P1[1],   pw1[2]=PKW(P0,12),pw1[3]=PKW(P0,14), pw1); \
    VRD(2); SBAR(); GAPA(C0=__builtin_amdgcn_mfma_f32_32x32x16_bf16(kf[4],qr[2],C0,0,0,0),   P1[2],P1[3],P1[4],P1[5],     pw2[0]=PKW(P1,0), pw2[1]=PKW(P1,2), pw2); \
    VRD(6); SBAR(); GAPA(C1=__builtin_amdgcn_mfma_f32_32x32x16_bf16(kf[5],qr[2],C1,0,0,0),   P1[6],P1[7],P1[8],P1[9],     pw2[2]=PKW(P1,4), pw2[3]=PKW(P1,6), pw2); \
    VRD(3); SBAR(); GAPA(C0=__builtin_amdgcn_mfma_f32_32x32x16_bf16(kf[6],qr[3],C0,0,0,0),   P1[10],P1[11],P1[12],P1[13], pw3[0]=PKW(P1,8), pw3[1]=PKW(P1,10), pw3); \
    VRD(7); SBAR(); GAPA(C1=__builtin_amdgcn_mfma_f32_32x32x16_bf16(kf[7],qr[3],C1,0,0,0),   P1[14],P1[15],0.f,0.f,       pw3[2]=PKW(P1,12),pw3[3]=PKW(P1,14), pw3); \
    l_reg+=sacc; \
    if(GK){DMA_K((t)+3,sl_cur);} if(GV){DMA_V((t)+1,sl_next);} \
    CMASK(C0,C1,t); \
    _Pragma("unroll") for(int r=0;r<16;++r){C0[r]-=mhat;C1[r]-=mhat;} \
    { float a=MX3(C0[0],C0[1],C1[0]),b=MX3(C0[2],C0[3],C1[1]); a=MX3(a,C1[2],C1[3]); \
      _Pragma("unroll") for(int r=4;r<16;r+=4){a=MX3(a,C0[r],C0[r+1]);b=MX3(b,C0[r+2],C0[r+3]);a=MX3(a,C1[r],C1[r+1]);b=MX3(b,C1[r+2],C1[r+3]);} \
      float rm=__builtin_fmaxf(a,b); { auto rr=__builtin_amdgcn_permlane32_swap(__float_as_uint(rm),__float_as_uint(rm),false,false); rm=__builtin_fmaxf(__uint_as_float(rr[0]),__uint_as_float(rr[1])); } \
      resc=false; \
      if(__builtin_expect(__any(rm>(float)THRL),0)){ const float dl=__builtin_fmaxf(rm,0.f); mhat+=dl; \
        _Pragma("unroll") for(int r=0;r<16;++r){C0[r]-=dl;C1[r]-=dl;} \
        const float f=__builtin_amdgcn_exp2f(-dl); l_reg*=f; if(hi==0)wsf[r32]=f; resc=true; } } \
    SBAR(); \
    GAPB2(o[0]=__builtin_amdgcn_mfma_f32_32x32x16_bf16(PAF(0),VFR(0),o[0],0,0,0), C0,0); VRD2(0); SBAR(); \
    GAPB2(o[1]=__builtin_amdgcn_mfma_f32_32x32x16_bf16(PAF(0),VFR(4),o[1],0,0,0), C0,2); VRD2(4); SBAR(); \
    KRD(GL,0); GAPB2(o[0]=__builtin_amdgcn_mfma_f32_32x32x16_bf16(PAF(1),VFR(1),o[0],0,0,0), C0,4); VRD2(1); SBAR(); \
    KRD(GL,1); GAPB2(o[1]=__builtin_amdgcn_mfma_f32_32x32x16_bf16(PAF(1),VFR(5),o[1],0,0,0), C0,6); VRD2(5); SBAR(); \
    KRD(GL,2); GAPB2(o[0]=__builtin_amdgcn_mfma_f32_32x32x16_bf16(PAF(2),VFR(2),o[0],0,0,0), C0,8); VRD2(2); SBAR(); \
    KRD(GL,3); GAPB2(o[1]=__builtin_amdgcn_mfma_f32_32x32x16_bf16(PAF(2),VFR(6),o[1],0,0,0), C0,10); VRD2(6); SBAR(); \
    GAPB2(o[0]=__builtin_amdgcn_mfma_f32_32x32x16_bf16(PAF(3),VFR(3),o[0],0,0,0), C0,12); VRD2(3); SBAR(); \
    GAPB2(o[1]=__builtin_amdgcn_mfma_f32_32x32x16_bf16(PAF(3),VFR(7),o[1],0,0,0), C0,14); VRD2(7); SBAR(); \
    GAPB2(o[2]=__builtin_amdgcn_mfma_f32_32x32x16_bf16(PAF(0),VFR(0),o[2],0,0,0), C1,0); \
    GAPB2(o[3]=__builtin_amdgcn_mfma_f32_32x32x16_bf16(PAF(0),VFR(4),o[3],0,0,0), C1,2); \
    GAPB2(o[2]=__builtin_amdgcn_mfma_f32_32x32x16_bf16(PAF(1),VFR(1),o[2],0,0,0), C1,4); \
    GAPB2(o[3]=__builtin_amdgcn_mfma_f32_32x32x16_bf16(PAF(1),VFR(5),o[3],0,0,0), C1,6); \
    GAPB2(o[2]=__builtin_amdgcn_mfma_f32_32x32x16_bf16(PAF(2),VFR(2),o[2],0,0,0), C1,8); \
    GAPB2(o[3]=__builtin_amdgcn_mfma_f32_32x32x16_bf16(PAF(2),VFR(6),o[3],0,0,0), C1,10); \
    GAPB2(o[2]=__builtin_amdgcn_mfma_f32_32x32x16_bf16(PAF(3),VFR(3),o[2],0,0,0), C1,12); \
    GAPB2(o[3]=__builtin_amdgcn_mfma_f32_32x32x16_bf16(PAF(3),VFR(7),o[3],0,0,0), C1,14); \
    }while(0)
  int t=1;
  #undef CMASK
  #define CMASK(P0,P1,t) do{}while(0)
  for(;t+5<NT;t+=2){
    STEP(pB0,pB1,pA0,pA1,t,true,true,true);     WAIT_BAR(3); RESC(); ROT();
    STEP(pA0,pA1,pB0,pB1,t+1,true,true,true);   WAIT_BAR(3); RESC(); ROT();
  }
  #undef CMASK
  #define CMASK(P0,P1,t) do{ if(CAUSAL){int jb_=(t)-(NT-4); if(jb_>=0)cmask(P0,P1,jb_,qrel,hi);} }while(0)
  #define ENDW(tt) do{ if((tt)+3<NT){WAIT_BAR(3);} else if((tt)+2<NT){WAIT_BAR(2);} else {WAIT_BAR(0);} }while(0)
  for(;t+1<NT;t+=2){
    STEP(pB0,pB1,pA0,pA1,t,(t+3<NT),(t+1<NT),(t+1<NT));       ENDW(t);   RESC(); ROT();
    STEP(pA0,pA1,pB0,pB1,t+1,(t+4<NT),(t+2<NT),(t+2<NT));     ENDW(t+1); RESC(); ROT();
  }
  STEP(pB0,pB1,pA0,pA1,NT-1,false,false,false); RESC();
  { float sacc=pB0[0]+pB0[1]; _Pragma("unroll") for(int r=2;r<16;++r)sacc+=pB0[r]; _Pragma("unroll") for(int r=0;r<16;++r)sacc+=pB1[r]; l_reg+=sacc;
    pw0=(u32x4){PKW(pB0,0),PKW(pB0,2),PKW(pB0,4),PKW(pB0,6)};pw1=(u32x4){PKW(pB0,8),PKW(pB0,10),PKW(pB0,12),PKW(pB0,14)};pw2=(u32x4){PKW(pB1,0),PKW(pB1,2),PKW(pB1,4),PKW(pB1,6)};pw3=(u32x4){PKW(pB1,8),PKW(pB1,10),PKW(pB1,12),PKW(pB1,14)};
    SBAR(); pv(o,vb0+2*sl_cur,PAF(0),PAF(1),PAF(2),PAF(3)); }
  #undef PKW
  #undef PAF
  #undef VFR
  #undef PIN
  #undef MX3
  #undef GAPA
  #undef GAPB
  #undef EX
  #undef VRD
  #undef VRD2
  #undef GAPB2
  #undef KRD
  #undef STEP
  #undef ENDW
  {auto rr=__builtin_amdgcn_permlane32_swap(__float_as_uint(l_reg),__float_as_uint(l_reg),false,false);l_reg=__uint_as_float(rr[0])+__uint_as_float(rr[1]);}
  if(hi==0)wsf[32+r32]=l_reg;asm volatile("s_waitcnt lgkmcnt(0)":::"memory");
  float rli[16];
  #pragma unroll
  for(int r=0;r<16;++r)rli[r]=__builtin_amdgcn_rcpf(wsf[32+crow(r,hi)]);
  bf16*Ow=Ou+(long)(wid*QBLK)*pO;
  { bf16*stg=(bf16*)(shm+LDS_OST)+wid*2048;
    const bf16*Sw=S0+(long)(wid*QBLK)*pS;
    float xs[2][4][8];
    #pragma unroll
    for(int hf=0;hf<2;++hf){
      #pragma unroll
      for(int r=0;r<16;++r){const int orow=crow(r,hi);
        #pragma unroll
        for(int d0=0;d0<2;++d0)stg[orow*64+d0*32+r32]=__float2bfloat16(o[2*hf+d0][r]*rli[r]);}
      asm volatile("s_waitcnt lgkmcnt(0)":::"memory");
      #pragma unroll
      for(int i=0;i<4;++i){const int row=i*8+(lane>>3),ch=lane&7; const u32x4 v=*(const u32x4*)(stg+row*64+ch*8);
        if constexpr(!COMBINE){ ATTN_STORE16(Ow+(long)row*pO+hf*64+ch*8,v); }
        else { const u32x4 a=*(const u32x4*)(Sw+(long)row*pS+hf*64+ch*8);
          #define BL(w) __uint_as_float((w)<<16)
          #define BH(w) __uint_as_float((w)&0xffff0000u)
          xs[hf][i][0]=BL(a.x)-lam*BL(v.x); xs[hf][i][1]=BH(a.x)-lam*BH(v.x); xs[hf][i][2]=BL(a.y)-lam*BL(v.y); xs[hf][i][3]=BH(a.y)-lam*BH(v.y);
          xs[hf][i][4]=BL(a.z)-lam*BL(v.z); xs[hf][i][5]=BH(a.z)-lam*BH(v.z); xs[hf][i][6]=BL(a.w)-lam*BL(v.w); xs[hf][i][7]=BH(a.w)-lam*BH(v.w);
          #undef BL
          #undef BH
        } }
      asm volatile("s_waitcnt lgkmcnt(0)":::"memory"); }
    if constexpr(COMBINE){
      float sg[16];
      #pragma unroll
      for(int q=0;q<16;++q)sg[q]=sgp[(q>>3)*64+(lane&7)*8+(q&7)]*0.8f;
      #pragma unroll
      for(int i=0;i<4;++i){ const int row=i*8+(lane>>3),ch=lane&7; float ss=0.f;
        #pragma unroll
        for(int hf=0;hf<2;++hf)
          #pragma unroll
          for(int q=0;q<8;++q)ss+=xs[hf][i][q]*xs[hf][i][q];
        ss+=__shfl_xor(ss,1);ss+=__shfl_xor(ss,2);ss+=__shfl_xor(ss,4);
        const float rn=1.f/sqrtf(ss*(1.f/128.f)+1e-6f);
        #pragma unroll
        for(int hf=0;hf<2;++hf){ u32x4 w;
          w.x=cvtpk_s(xs[hf][i][0]*rn*sg[hf*8+0],xs[hf][i][1]*rn*sg[hf*8+1]); w.y=cvtpk_s(xs[hf][i][2]*rn*sg[hf*8+2],xs[hf][i][3]*rn*sg[hf*8+3]);
          w.z=cvtpk_s(xs[hf][i][4]*rn*sg[hf*8+4],xs[hf][i][5]*rn*sg[hf*8+5]); w.w=cvtpk_s(xs[hf][i][6]*rn*sg[hf*8+6],xs[hf][i][7]*rn*sg[hf*8+7]);
          ATTN_STORE16(Ow+(long)row*pO+hf*64+ch*8,w); } } } }
  asm volatile("s_waitcnt lgkmcnt(0)\n\ts_barrier":::"memory");
  #undef DMA_K
  #undef DMA_V
  #undef CMASK
  #undef START
  #undef RESC
  #undef ROT
}
constexpr int ATTN_LDS_BYTES=LDS_BYTES;
#undef SBAR
#undef WAIT_BAR
}

constexpr int NWAVES = 8;
#ifndef MK_N_LAUNCHES
#define MK_N_LAUNCHES 1
#endif
constexpr int NPH = 10;
constexpr int BATCH = 32, SEQ = 2048, D = 1024, T = BATCH * SEQ, NMEM = 256, TM = BATCH * NMEM;
constexpr int INCOLS = 5120, PROJW = 2048, GATEW = 3072;
constexpr float RMS_EPS = 1e-6f;
constexpr int NEXP = 16, EH = 512;
constexpr int MAXROWS = 2 * T + NEXP * 256;
constexpr size_t MiB = 1u << 20;
constexpr size_t WS_CTL = 0, CTL_ZERO_BYTES = 64 * 1024;
constexpr size_t WS_WRF = 1 * MiB;
constexpr size_t WS_RINV = 1 * MiB + 128 * 1024;
constexpr size_t WS_WIN = 2 * MiB;
constexpr size_t WS_PC = 13 * MiB;
constexpr size_t WS_WO = 15 * MiB;
constexpr size_t WS_WGU = 17 * MiB;
constexpr size_t WS_WD = 49 * MiB;
constexpr size_t WS_ROUTE = 65 * MiB;
constexpr size_t WS_KV = 68 * MiB;
constexpr size_t WS_XN = 76 * MiB;
constexpr size_t WS_BR = 76 * MiB;
constexpr size_t WS_H2 = 76 * MiB;
constexpr size_t WS_PROJ = 220 * MiB;
constexpr size_t WS_MERGED = 220 * MiB;
constexpr size_t WS_MIX = 348 * MiB;
constexpr size_t WS_HID = 220 * MiB;
constexpr size_t WS_ATTO = 476 * MiB;
constexpr size_t WS_GATES = 604 * MiB;
constexpr size_t WS_LIST = 476 * MiB;
constexpr size_t WS_RWE = 480 * MiB;
constexpr size_t WS_Y = 604 * MiB;
constexpr size_t WS_END = 988 * MiB;
static_assert(WS_XN + (size_t)(T + TM) * D * 2 <= WS_PROJ && WS_PROJ + (size_t)T * PROJW * 2 <= WS_ATTO && WS_ATTO + (size_t)T * D * 2 <= WS_GATES && WS_GATES + (size_t)T * GATEW * 2 <= WS_END, "ws map");
static_assert(WS_Y + (size_t)MAXROWS * D * 2 <= WS_END && WS_HID + (size_t)MAXROWS * EH * 2 <= WS_ATTO && WS_RWE + (size_t)NEXP * 65536 * 8 <= WS_GATES, "ws map 2");
constexpr int CW_CNT = 64;
constexpr int RING_OFF = 0, RING_BYTES = 131072;
constexpr int LDSX_OFF = RING_BYTES;
constexpr int LDS_BYTES = 147456;

#define GAS __attribute__((address_space(1)))
#define LAS __attribute__((address_space(3)))
typedef unsigned short bf16;
typedef unsigned v4u __attribute__((ext_vector_type(4)));
typedef unsigned v2u __attribute__((ext_vector_type(2)));
typedef float f32x4 __attribute__((ext_vector_type(4)));
#define LDS_WAIT() asm volatile("s_waitcnt lgkmcnt(0)" ::: "memory")
__device__ __forceinline__ unsigned f2bf(float f) { unsigned u = __builtin_bit_cast(unsigned, f); return (u + 0x7fffu + ((u >> 16) & 1u)) >> 16; }
__device__ __forceinline__ unsigned pk2(float lo, float hi) { return f2bf(lo) | (f2bf(hi) << 16); }
typedef float f32x2_t __attribute__((ext_vector_type(2))); typedef __bf16 bf16x2_t __attribute__((ext_vector_type(2)));
typedef short bf16x8_t __attribute__((ext_vector_type(8))); typedef float f32x16_t __attribute__((ext_vector_type(16)));
__device__ __forceinline__ unsigned cvtpk(float lo, float hi) { f32x2_t v = {lo, hi}; bf16x2_t b = __builtin_convertvector(v, bf16x2_t); return __builtin_bit_cast(unsigned, b); }
__device__ __forceinline__ float bflo(unsigned w) { return __uint_as_float(w << 16); }
__device__ __forceinline__ float bfhi(unsigned w) { return __uint_as_float(w & 0xffff0000u); }
__device__ __forceinline__ float wave_sum(float v) {
#pragma unroll
    for (int o = 1; o < 64; o <<= 1) v += __shfl_xor(v, o);
    return v;
}

typedef GAS unsigned gu32;
#define RLX_AGENT __ATOMIC_RELAXED, __HIP_MEMORY_SCOPE_AGENT
constexpr int CW_BAR = 4096;
constexpr int CW_TS = 128;
#define XB_TMO      128
#define XB_XCNT(j)  (256  + 64 * (j))
#define XB_XSUB(j)  (1280 + 64 * (j))
#define XB_XGEN(j)  (2304 + 64 * (j))
#define XB_TOP      3328
#define XB_TOPGEN   3392
#define XCD_BAR_WORDS 3456
#define XB_SPIN_CAP (1u << 18)

__device__ __forceinline__ unsigned xb_ld(unsigned* p)              { return __hip_atomic_load(p, __ATOMIC_RELAXED, __HIP_MEMORY_SCOPE_AGENT); }
__device__ __forceinline__ unsigned xb_add(unsigned* p, unsigned v) { return __hip_atomic_fetch_add(p, v, __ATOMIC_RELAXED, __HIP_MEMORY_SCOPE_AGENT); }
__device__ __forceinline__ unsigned xb_xcc_id() { return (unsigned)__builtin_amdgcn_s_getreg((3 << 11) | 20) & 0xFu; }
#define XB_SPIN(cond, bar) do { unsigned _sp = 0; while (cond) { __builtin_amdgcn_s_sleep(1); \
    if ((++_sp & 255u) == 0u) { if (xb_ld(&(bar)[XB_TMO])) break; if (_sp > XB_SPIN_CAP) { atomicAdd(&(bar)[XB_TMO], 1u); break; } } } } while (0)

struct XcdBarrier {
    unsigned* bar; unsigned x;
    volatile LAS unsigned* st;
};

__device__ __forceinline__ XcdBarrier xcd_barrier_post(unsigned* bar, volatile LAS unsigned* st) {
    XcdBarrier b; b.bar = bar; b.x = xb_xcc_id(); b.st = st;
    if (threadIdx.x == 0) (void)xb_add(&bar[XB_XCNT(b.x)], 1u);
    return b;
}
__device__ __forceinline__ void xcd_barrier_complete(unsigned* bar, unsigned x, unsigned& nloc, unsigned& nx) {
    const unsigned G = gridDim.x * gridDim.y * gridDim.z;
    unsigned sum, cnt, mine, sp = 0u;
    for (;;) {
        sum = 0u; cnt = 0u; mine = 0u;
#pragma unroll
        for (unsigned j = 0; j < 16; ++j) { const unsigned c = xb_ld(&bar[XB_XCNT(j)]); sum += c; cnt += (c > 0u) ? 1u : 0u; mine = (j == x) ? c : mine; }
        if (sum == G) break;
        __builtin_amdgcn_s_sleep(1);
        if ((++sp & 255u) == 0u) { if (xb_ld(&bar[XB_TMO])) break; if (sp > XB_SPIN_CAP) { atomicAdd(&bar[XB_TMO], 1u); break; } }
    }
    nloc = mine > 0u ? mine : 1u; nx = cnt > 0u ? cnt : 1u;
}

__device__ __forceinline__ void xcd_barrier(const XcdBarrier& b, const bool leader) {
    asm volatile("s_waitcnt vmcnt(0)" ::: "memory");
    __syncthreads();
    if (leader) {
        unsigned* bar = b.bar;
        __builtin_amdgcn_s_waitcnt(0);
        unsigned nloc = b.st[0], nx = b.st[1];
        if (nloc == 0u) { xcd_barrier_complete(bar, b.x, nloc, nx); b.st[0] = nloc; b.st[1] = nx; }
        const unsigned old = xb_add(&bar[XB_XSUB(b.x)], 1u);
        const unsigned gen = old / nloc;
        if (old + 1u == (gen + 1u) * nloc) {
            __builtin_amdgcn_fence(__ATOMIC_RELEASE, "agent");
            asm volatile("s_waitcnt vmcnt(0)" ::: "memory");
            const unsigned og = xb_add(&bar[XB_TOP], 1u);
            const unsigned tg = og / nx;
            if (og + 1u == (tg + 1u) * nx) xb_add(&bar[XB_TOPGEN], 1u);
            else XB_SPIN(xb_ld(&bar[XB_TOPGEN]) == tg, bar);
            __builtin_amdgcn_fence(__ATOMIC_ACQUIRE, "agent");
            xb_add(&bar[XB_XGEN(b.x)], 1u);
            asm volatile("s_waitcnt vmcnt(0)" ::: "memory");
        } else {
            XB_SPIN(xb_ld(&bar[XB_XGEN(b.x)]) == gen, bar);
            __builtin_amdgcn_fence(__ATOMIC_ACQUIRE, "agent");
            asm volatile("s_waitcnt vmcnt(0)" ::: "memory");
        }
    }
    __syncthreads();
}

struct Frame {
    LAS unsigned char* lds;
    unsigned* ctl;
    int vcu, G;
};

__device__ __forceinline__ void p0_tile(const float* W, int N, int k0, int n0, bf16* WT, int Kd, int drow0, LAS float* scr, int lane, const float* gk = nullptr) {
    f32x4 w[8];
#pragma unroll
    for (int i = 0; i < 8; ++i) w[i] = __builtin_nontemporal_load((const GAS f32x4*)(W + (size_t)(k0 + i * 8 + (lane >> 3)) * N + n0 + (lane & 7) * 4));
    if (gk) {
#pragma unroll
        for (int i = 0; i < 8; ++i) w[i] = w[i] * gk[k0 + i * 8 + (lane >> 3)]; }
#pragma unroll
    for (int i = 0; i < 8; ++i) { LAS float* d = scr + (i * 8 + (lane >> 3)) * 33 + (lane & 7) * 4; d[0] = w[i].x; d[1] = w[i].y; d[2] = w[i].z; d[3] = w[i].w; }
    LDS_WAIT(); asm volatile("" ::: "memory");
    const int c = lane & 7;
#pragma unroll
    for (int j = 0; j < 4; ++j) { const int n = (lane >> 3) + 8 * j; const LAS float* s = scr + (8 * c) * 33 + n;
        v4u o; o.x = pk2(s[0 * 33], s[1 * 33]); o.y = pk2(s[2 * 33], s[3 * 33]); o.z = pk2(s[4 * 33], s[5 * 33]); o.w = pk2(s[6 * 33], s[7 * 33]);
        *(GAS v4u*)(WT + (size_t)(drow0 + n) * Kd + k0 + 8 * c) = o; }
    LDS_WAIT(); asm volatile("" ::: "memory");
}
__device__ __forceinline__ void p0_plain(const float* W, int K, int N, bf16* WT, int row_off, int item, LAS float* scr, int lane) {
    const int nblk = N / 32, kb = item / nblk, nb = item % nblk;
    p0_tile(W, N, 64 * kb, 32 * nb, WT, K, row_off + 32 * nb, scr, lane);
}
__device__ __forceinline__ void rms_row_to_bf16(const float* xrow, const float* g, bf16* orow, int lane) {
    const GAS f32x4* xr = (const GAS f32x4*)xrow + lane; const GAS f32x4* gr = (const GAS f32x4*)g + lane;
    f32x4 v[4]; float s = 0.f;
#pragma unroll
    for (int j = 0; j < 4; ++j) { v[j] = xr[64 * j]; s += (v[j].x * v[j].x + v[j].y * v[j].y) + (v[j].z * v[j].z + v[j].w * v[j].w); }
    const float r = 1.f / sqrtf(wave_sum(s) * (1.f / D) + RMS_EPS);
    GAS unsigned long long* o8 = (GAS unsigned long long*)orow + lane;
#pragma unroll
    for (int j = 0; j < 4; ++j) { const f32x4 gg = gr[64 * j]; const f32x4 h = v[j] * r * gg;
        o8[64 * j] = (unsigned long long)pk2(h.x, h.y) | ((unsigned long long)pk2(h.z, h.w) << 32); }
}

__device__ __forceinline__ void rms_rows_stream(const float* src1, const float* g1, const float* src2, const float* g2, int nT, int nAll, bf16* dst, int m0, int mstep, int lane) {
    f32x4 cur[4][4], nxt[4][4];
    if (m0 >= nAll) return;
    { const GAS f32x4* xr = (const GAS f32x4*)((m0 < nT ? src1 + (size_t)m0 * D : src2 + (size_t)(m0 - nT) * D)) + lane;
#pragma unroll
      for (int q = 0; q < 4; ++q)
#pragma unroll
          for (int j = 0; j < 4; ++j) cur[q][j] = __builtin_nontemporal_load(xr + q * 256 + 64 * j); }
    for (int m = m0; m < nAll; m += mstep) {
        const int mn = m + mstep; const bool has = mn < nAll; const int ml = has ? mn : m;
        { const GAS f32x4* xr = (const GAS f32x4*)((ml < nT ? src1 + (size_t)ml * D : src2 + (size_t)(ml - nT) * D)) + lane;
#pragma unroll
          for (int q = 0; q < 4; ++q)
#pragma unroll
              for (int j = 0; j < 4; ++j) nxt[q][j] = __builtin_nontemporal_load(xr + q * 256 + 64 * j); }
        float s[4];
#pragma unroll
        for (int q = 0; q < 4; ++q) { s[q] = 0.f;
#pragma unroll
            for (int j = 0; j < 4; ++j) s[q] += (cur[q][j].x * cur[q][j].x + cur[q][j].y * cur[q][j].y) + (cur[q][j].z * cur[q][j].z + cur[q][j].w * cur[q][j].w); }
#pragma unroll
        for (int o = 1; o < 64; o <<= 1) {
#pragma unroll
            for (int q = 0; q < 4; ++q) s[q] += __shfl_xor(s[q], o); }
        const GAS f32x4* gr = (const GAS f32x4*)(m < nT ? g1 : g2) + lane;
        f32x4 gg[4];
#pragma unroll
        for (int j = 0; j < 4; ++j) gg[j] = gr[64 * j];
#pragma unroll
        for (int q = 0; q < 4; ++q) { const float r = 1.f / sqrtf(s[q] * (1.f / D) + RMS_EPS);
            GAS unsigned long long* o8 = (GAS unsigned long long*)(dst + (size_t)(m + q) * D) + lane;
#pragma unroll
            for (int j = 0; j < 4; ++j) { const f32x4 h = cur[q][j] * r * gg[j]; o8[64 * j] = (unsigned long long)pk2(h.x, h.y) | ((unsigned long long)pk2(h.z, h.w) << 32); } }
#pragma unroll
        for (int q = 0; q < 4; ++q)
#pragma unroll
            for (int j = 0; j < 4; ++j) cur[q][j] = nxt[q][j];
    }
}

__device__ __forceinline__ void build_tile_tables(Frame& F, const int tid) {
    LAS int* TB = (LAS int*)(F.lds + LDSX_OFF); LAS unsigned char* t2e = F.lds + LDSX_OFF + 128;
    __syncthreads();
    if (tid == 0) { int acc = 0;
        for (int e = 0; e < NEXP; ++e) { const int n = (int)__hip_atomic_load(F.ctl + CW_CNT + e, __ATOMIC_RELAXED, __HIP_MEMORY_SCOPE_AGENT); TB[e] = acc; acc += (n + 255) >> 8; }
        TB[NEXP] = acc; }
    __syncthreads();
    for (int t = tid; t < 1024; t += NWAVES * 64) { int e = 0;
#pragma unroll
        for (int k = 1; k < NEXP; ++k) e += (t >= TB[k]) ? 1 : 0;
        t2e[t] = (unsigned char)e; }
    __syncthreads();
}

struct Args { const float* in[26]; float* out; unsigned char* ws; int ph_lo, ph_hi; };

__global__ void __launch_bounds__(NWAVES * 64, 2) hybrid_fwd(Args args) {
    extern __shared__ __attribute__((aligned(16))) unsigned char lds[];
    __builtin_assume(__builtin_amdgcn_workitem_id_y() == 0); __builtin_assume(__builtin_amdgcn_workitem_id_z() == 0);
    Frame F;
    F.lds = (LAS unsigned char*)lds;
    F.G = gridDim.x; { const int bx = blockIdx.x; F.vcu = (F.G % 8 == 0) ? (bx % 8) * (F.G / 8) + bx / 8 : bx; }
    F.ctl = (unsigned*)(args.ws + WS_CTL);
#define x_in (args.in[0])
#define mem_in (args.in[1])
#define norm_mix_g (args.in[2])
#define w_in (args.in[3])
#define pool_w (args.in[4])
#define pool_scale (args.in[5])
#define lam_q1 (args.in[6])
#define lam_k1 (args.in[7])
#define lam_q2 (args.in[8])
#define lam_k2 (args.in[9])
#define subln_g (args.in[10])
#define norm_mem_g (args.in[11])
#define w_mem_kv (args.in[12])
#define p_pool (args.in[13])
#define p_diff (args.in[14])
#define p_mem (args.in[15])
#define w_o (args.in[16])
#define norm_ffn_g (args.in[17])
#define w_rg (args.in[18])
#define b_rg (args.in[19])
#define w_re (args.in[20])
#define b_re (args.in[21])
#define w_eg (args.in[22])
#define w_eu (args.in[23])
#define w_ed (args.in[24])
#define final_g (args.in[25])
#define Win_t ((bf16*)(args.ws + WS_WIN))
#define Pc_t ((bf16*)(args.ws + WS_PC))
#define Wo_t ((bf16*)(args.ws + WS_WO))
#define Wgu_t ((bf16*)(args.ws + WS_WGU))
#define Wd_t ((bf16*)(args.ws + WS_WD))
#define KV ((bf16*)(args.ws + WS_KV))
#define XN ((bf16*)(args.ws + WS_XN))
#define BR ((bf16*)(args.ws + WS_BR))
#define H2 ((bf16*)(args.ws + WS_H2))
#define PROJ ((bf16*)(args.ws + WS_PROJ))
#define MERGED ((bf16*)(args.ws + WS_MERGED))
#define MIX ((bf16*)(args.ws + WS_MIX))
#define HID ((bf16*)(args.ws + WS_HID))
#define ATTO ((bf16*)(args.ws + WS_ATTO))
#define GATES ((bf16*)(args.ws + WS_GATES))
#define Y ((bf16*)(args.ws + WS_Y))
#define ROUTE ((v4u*)(args.ws + WS_ROUTE))
#define RWE ((float*)(args.ws + WS_RWE))
#define LIST ((int*)(args.ws + WS_LIST))
#define WRF ((bf16*)(args.ws + WS_WRF))
#define RINV ((float*)(args.ws + WS_RINV))
#define X1 (args.out)
    const int NGW = F.G * NWAVES;
#define PHASE_IDS int tid = tid_of(wv); asm volatile("" : "+v"(tid)); const int lane = tid & 63, wave = __builtin_amdgcn_readfirstlane(tid >> 6), gw = F.vcu * NWAVES + wave; (void)lane; (void)gw;
    const int lo = args.ph_lo, hi = args.ph_hi;
    cg::grid_group grid = cg::this_grid();
#ifndef PH_MASK
#define PH_MASK 0x3ff
#endif
#define IN(k) (((PH_MASK >> (k)) & 1) && lo <= (k) && (k) < hi)
#ifndef PROBE_A
#define PROBE_A -1
#endif
#ifndef PROBE_B
#define PROBE_B -1
#endif
#ifndef PROBE_A2
#define PROBE_A2 (PROBE_A + 1)
#endif
#ifndef PROBE_B2
#define PROBE_B2 (PROBE_B + 1)
#endif
#define STAMP(k) do { if ((PROBE_A >= 0 || PROBE_B >= 0) && blockIdx.x == 0 && tid_of(wv) == 0) ((unsigned long long*)(F.ctl + CW_TS))[k] = __builtin_amdgcn_s_memrealtime(); } while (0)
#define SEAM(k) do { if (IN(k) && IN((k) + 1)) { { XcdBarrier b_; b_.bar = (unsigned*)(args.ws + WS_CTL) + CW_BAR; b_.x = xb_xcc_id(); b_.st = (volatile LAS unsigned*)(F.lds + LDSX_OFF + 2048); xcd_barrier(b_, tid_of(wv) == 0); } } STAMP((k) + 1); } while (0)
    const int wv = __builtin_amdgcn_readfirstlane((int)threadIdx.x >> 6);
    if (hi > NPH) grid.sync();
    if (threadIdx.x < 2) ((LAS unsigned*)(F.lds + LDSX_OFF + 2048))[threadIdx.x] = 0u;
    __syncthreads();
    if (lo < hi - 1) (void)xcd_barrier_post((unsigned*)(args.ws + WS_CTL) + CW_BAR, (volatile LAS unsigned*)(F.lds + LDSX_OFF + 2048));
    STAMP(0);

    if (IN(0)) {
        PHASE_IDS
        LAS float* scr = (LAS float*)(F.lds + RING_OFF + wave * 16384);
        constexpr int I_IN = 16 * 160, I_KV = 16 * 16, I_PD = 8 * 32, I_PM = 4 * 32, I_WO = 16 * 32, I_EG = 16 * 256, I_EU = 16 * 256, I_ED = 16 * 256;
        constexpr int NITEMS0 = I_IN + I_KV + I_PD + I_PM + I_WO;
        for (int it = gw; it < NITEMS0; it += NGW) {
            int r = it;
            if (r < I_IN) { p0_plain(w_in, D, INCOLS, Win_t, 0, r, scr, lane); continue; } r -= I_IN;
            if (r < I_KV) { p0_plain(w_mem_kv, D, 512, Win_t, INCOLS, r, scr, lane); continue; } r -= I_KV;
            if (r < I_PD) { const int kb = r >> 5, nb = r & 31; p0_tile(p_diff, D, 64 * kb, 32 * nb, Pc_t + 256, D, 32 * nb, scr, lane); continue; } r -= I_PD;
            if (r < I_PM) { const int kb = r >> 5, nb = r & 31; p0_tile(p_mem, D, 64 * kb, 32 * nb, Pc_t + 768, D, 32 * nb, scr, lane); continue; } r -= I_PM;
            p0_plain(w_o, D, D, Wo_t, 0, r, scr, lane);
        }
        STAMP(12);
        STAMP(13);
        rms_rows_stream(x_in, norm_mix_g, mem_in, norm_mem_g, T, T + TM, XN, gw * 4, NGW * 4, lane);
    }
    SEAM(0);

    if (IN(1)) {
        pg8::Gemm g{XN, Win_t, T, INCOLS, D};
        pg8::ProjOrder S; S.so.init(T, INCOLS, F.G, (int)blockIdx.x);
        pg8::EpiProj E{PROJ, GATES, KV, attn_body::C2};
        pg8::gemm_phase<pg8::EpiProj, pg8::ProjOrder, true, true>(wv, F.lds + RING_OFF, g, S, E);
        {
            constexpr int UNITS = (T / 256) * (INCOLS / 256) + 64;
            const int maxu = (UNITS + F.G - 1) / F.G, rem = UNITS - (maxu - 1) * F.G;
            const int nshort = (rem == F.G) ? F.G : F.G - rem, si = (rem == F.G) ? (int)blockIdx.x : (int)blockIdx.x - rem;
            if (si >= 0) {
                PHASE_IDS
                LAS float* scr = (LAS float*)(F.lds + RING_OFF + wave * 16384);
                constexpr int I_EG = 16 * 256, I_EU = 16 * 256, I_ED = 16 * 256;
                const int gw2 = si * NWAVES + wave, NGW2 = nshort * NWAVES;
                for (int it = gw2; it < I_EG + I_EU + I_ED; it += NGW2) {
                    int r = it;
                    if (r < I_EG + I_EU) { const bool up = r >= I_EG; if (up) r -= I_EG;
                        const int e = r >> 8, rr = r & 255, kb = rr >> 4, nb = rr & 15, n0 = 32 * nb;
                        p0_tile((up ? w_eu : w_eg) + (size_t)e * D * EH, EH, 64 * kb, n0, Wgu_t + (size_t)e * D * D, D, (n0 >> 7) * 256 + (n0 & 127) + (up ? 128 : 0), scr, lane, norm_ffn_g); continue; }
                    r -= I_EG + I_EU;
                    { const int e = r >> 8, rr = r & 255, kb = rr >> 5, nb = rr & 31;
                      p0_tile(w_ed + (size_t)e * EH * D, D, 64 * kb, 32 * nb, Wd_t + (size_t)e * D * EH, EH, 32 * nb, scr, lane); }
                }
                for (int idx = (si * NWAVES * 64 + tid); idx < 5120; idx += nshort * NWAVES * 64) {
                    const int q = idx % 20, h = (idx / 20) & 1, hl = (idx / 40) & 1, st = idx / 80, k0 = 32 * (st >> 1) + 16 * h + 8 * (st & 1);
                    float v[8];
#pragma unroll
                    for (int j = 0; j < 8; ++j) { const int k = k0 + j; const float w = norm_ffn_g[k] * (q < 4 ? w_rg[k * 4 + q] : w_re[k * 16 + (q - 4)]); const float hi = bflo(f2bf(w) ); v[j] = hl ? (w - hi) : w; }
                    v4u o; o.x = pk2(v[0], v[1]); o.y = pk2(v[2], v[3]); o.z = pk2(v[4], v[5]); o.w = pk2(v[6], v[7]);
                    *((GAS v4u*)WRF + idx) = o;
                }
                for (int idx = (si * NWAVES * 64 + tid); idx < 256 * 1024; idx += nshort * NWAVES * 64) {
                    const int kc = idx >> 10, n = idx & 1023, g = kc >> 6; float a = 0.f;
#pragma unroll 16
                    for (int d = 0; d < 64; ++d) a += pool_w[kc * 64 + d] * pool_scale[g * 64 + d] * p_pool[(size_t)(g * 64 + d) * D + n];
                    Pc_t[(size_t)n * D + kc] = (bf16)f2bf(a);
                }
            }
        }
    }
    SEAM(1);

    if (IN(2)) {
        PHASE_IDS
        typedef attn_body::bf16 abf;
        struct DiffOrder { int vcu, G;
            __device__ __forceinline__ bool next(int i, int& bh, int& m, int& qb) const { const int u = vcu + (i >> 3) * G; if (u >= BATCH * 8) return false; bh = u >> 1; m = (i >> 2) & 1; const int k = i & 3, st = u & 1;
                qb = (k == 0) ? 7 - st : (k == 1) ? st : (k == 2) ? 4 + st : 3 - st; return true; } };
        float lam;
        { const float s1 = wave_sum(lam_q1[lane] * lam_k1[lane]), s2 = wave_sum(lam_q2[lane] * lam_k2[lane]); lam = __uint_as_float(__builtin_amdgcn_readfirstlane(__float_as_uint(__expf(s1) - __expf(s2) + 0.2f))); }
        { const DiffOrder S{F.vcu, F.G}; int bh, m, qb;
          for (int i = 0; S.next(i, bh, m, qb); ++i) {
            const int b = bh >> 2, h = bh & 3; const size_t rb = (size_t)b * SEQ;
            const attn2::bf16* Qu = (const attn2::bf16*)PROJ + (rb + qb * 256) * PROJW + 256 + h * 128 + m * 64;
            const attn2::bf16* Kh = (const attn2::bf16*)PROJ + rb * PROJW + 768 + h * 128 + m * 64;
            const attn2::bf16* Vh = (const attn2::bf16*)PROJ + rb * PROJW + 1280 + h * 128;
            attn2::bf16* S0 = (attn2::bf16*)ATTO + (rb + qb * 256) * 512 + h * 128;
            attn2::bf16* Od = (attn2::bf16*)BR + (rb + qb * 256) * D + 256 + h * 128;
            asm volatile("" : "+s"(Qu), "+s"(Kh), "+s"(Vh), "+s"(S0), "+s"(Od));
            if (m == 0) attn2::attn_unit<8, true, false>(Qu, PROJW, Kh, Vh, PROJW, wv, S0, 512, 4 * (qb + 1), (char*)lds + RING_OFF);
            else attn2::attn_unit<8, true, true>(Qu, PROJW, Kh, Vh, PROJW, wv, Od, D, 4 * (qb + 1), (char*)lds + RING_OFF, S0, 512, lam, subln_g); } }
        for (int mu = F.vcu; mu < BATCH * 8; mu += F.G) {
            const int b = mu >> 3, mh = (mu >> 1) & 3, half = mu & 1;
            const abf* Q0 = (const abf*)PROJ + ((size_t)b * SEQ + half * 1024) * PROJW + 1792 + mh * 64;
            const abf* Kh = (const abf*)KV + (size_t)b * NMEM * 512 + mh * 64;
            const abf* Vh = (const abf*)KV + (size_t)b * NMEM * 512 + 256 + mh * 64;
            abf* O0 = (abf*)BR + ((size_t)b * SEQ + half * 1024) * D + 768 + mh * 64;
            asm volatile("" : "+s"(Q0), "+s"(Kh), "+s"(Vh), "+s"(O0));
            attn_body::mem_attn(wv, Q0, PROJW, Kh, Vh, 512, O0, D, 4, (char*)lds + RING_OFF); }
        { int tidp = tid_of(wv); asm volatile("" : "+v"(tidp)); const int lane = tidp & 63, gw = F.vcu * NWAVES + wv;
        const int gi = lane >> 4, w = 2 << gi;
        for (int tb = gw * 32; tb < T; tb += NGW * 32)
        for (int tp = 0; tp < 32; tp += 2) {
            const int t = tb + tp, s0 = t & (SEQ - 1);
            const GAS v2u* up = (const GAS v2u*)(PROJ + (size_t)(t + 1) * PROJW) + lane;
            const int nw0 = (w < s0 + 1) ? w : s0 + 1, nw1 = (w < s0 + 2) ? w : s0 + 2;
            v2u wq[17];
#pragma unroll
            for (int k = 0; k < 17; ++k) { wq[k] = (v2u){0u, 0u}; if (k < nw1 || (k >= 1 && k - 1 < nw0)) wq[k] = *(const GAS v2u*)((const GAS bf16*)up - (size_t)k * PROJW); }
#pragma unroll
            for (int q = 0; q < 2; ++q) {
                const int nwq = q ? nw1 : nw0; float a0 = 0.f, a1 = 0.f, a2 = 0.f, a3 = 0.f;
#pragma unroll
                for (int k = 0; k < 16; ++k) { const v2u x = wq[k + 1 - q]; const bool in = k < nwq; a0 += in ? bflo(x.x) : 0.f; a1 += in ? bfhi(x.x) : 0.f; a2 += in ? bflo(x.y) : 0.f; a3 += in ? bfhi(x.y) : 0.f; }
                const v2u ut = wq[1 - q]; const float inv = 1.f / (float)nwq;
                v2u po; po.x = pk2(a0 * inv - bflo(ut.x), a1 * inv - bfhi(ut.x)); po.y = pk2(a2 * inv - bflo(ut.y), a3 * inv - bfhi(ut.y));
                *((GAS v2u*)(BR + (size_t)(t + q) * D) + lane) = po; }
        }
        }
    }
    SEAM(2); STAMP(4);


    if (IN(4)) {
        pg8::StaticOrder S; S.init(T, D, F.G, (int)blockIdx.x);
        pg8::Gemm g{BR, Pc_t, T, D, D}; pg8::EpiMerge E{GATES, MERGED}; pg8::MidRescale MH{GATES};
        pg8::gemm_phase<pg8::EpiMerge, pg8::StaticOrder, true, true, pg8::MidRescale>(wv, F.lds + RING_OFF, g, S, E, MH);
    }
    SEAM(4);

    if (IN(5)) {
        pg8::Gemm g{MERGED, Wo_t, T, D, D}; pg8::StaticOrder S; S.init(T, D, F.G, (int)blockIdx.x);
        pg8::EpiMix E{MIX};
        pg8::gemm_phase<pg8::EpiMix, pg8::StaticOrder, true, true>(wv, F.lds + RING_OFF, g, S, E);
    }
    SEAM(5);

    if (IN(6)) {
        PHASE_IDS
        LAS v4u* WL = (LAS v4u*)(F.lds + RING_OFF);
        LAS float* SC = (LAS float*)(F.lds + RING_OFF + 81920) + wave * 1024;
        LAS v4u* REC = (LAS v4u*)(F.lds + RING_OFF + 81920 + 32768);
        LAS unsigned* LCNT = (LAS unsigned*)(F.lds + RING_OFF + 81920 + 32768 + 4096);
        LAS unsigned* LBASE = LCNT + 16; LAS float* RIL = (LAS float*)(LCNT + 32);
        for (int idx = tid; idx < 5120; idx += NWAVES * 64) WL[idx] = *((const GAS v4u*)WRF + idx);
        float bg[4], be[16];
#pragma unroll
        for (int i = 0; i < 4; ++i) bg[i] = b_rg[i];
#pragma unroll
        for (int i = 0; i < 16; ++i) be[i] = b_re[i];
        const int r32 = lane & 31, hh = lane >> 5;
        for (int rb0 = F.vcu * 256; rb0 < T; rb0 += F.G * 256) {
            if (tid < 16) LCNT[tid] = 0u;
            __syncthreads();
            const int li = wave * 32 + r32, row = rb0 + li;
            const GAS f32x4* xp = (const GAS f32x4*)(x_in + (size_t)row * D + 16 * hh);
            const GAS v4u* mp = (const GAS v4u*)(MIX + (size_t)row * D + 16 * hh);
            GAS v4u* hp = (GAS v4u*)(H2 + (size_t)row * D + 16 * hh);
            const LAS v4u* wl = WL + hh * 20 + r32;
            f32x16_t acc = {}; float ss = 0.f;
            f32x4 cur[8]; v4u curm[4];
#pragma unroll
            for (int i = 0; i < 8; ++i) cur[i] = xp[(i >> 2) * 8 + (i & 3)];
#pragma unroll
            for (int i = 0; i < 4; ++i) curm[i] = mp[(i >> 1) * 4 + (i & 1)];
#pragma unroll 1
            for (int sp2 = 0; sp2 < 16; ++sp2) {
                f32x4 nxt[8]; v4u nxtm[4];
                const int spn = (sp2 + 1 < 16) ? sp2 + 1 : sp2;
#pragma unroll
                for (int i = 0; i < 8; ++i) nxt[i] = xp[(2 * spn + (i >> 2)) * 8 + (i & 3)];
#pragma unroll
                for (int i = 0; i < 4; ++i) nxtm[i] = mp[(2 * spn + (i >> 1)) * 4 + (i & 1)];
#pragma unroll
                for (int i = 0; i < 4; ++i) { const v4u mm = curm[i];
                    cur[2 * i].x += bflo(mm.x); cur[2 * i].y += bfhi(mm.x); cur[2 * i].z += bflo(mm.y); cur[2 * i].w += bfhi(mm.y);
                    cur[2 * i + 1].x += bflo(mm.z); cur[2 * i + 1].y += bfhi(mm.z); cur[2 * i + 1].z += bflo(mm.w); cur[2 * i + 1].w += bfhi(mm.w); }
#pragma unroll
                for (int u = 0; u < 2; ++u) { const int sp = 2 * sp2 + u;
                    v4u ahi[2], alo[2];
#pragma unroll
                    for (int e = 0; e < 2; ++e) { const f32x4 a = cur[4 * u + 2 * e], b = cur[4 * u + 2 * e + 1];
                        ss += (a.x * a.x + a.y * a.y) + (a.z * a.z + a.w * a.w) + (b.x * b.x + b.y * b.y) + (b.z * b.z + b.w * b.w);
                        v4u h; h.x = cvtpk(a.x, a.y); h.y = cvtpk(a.z, a.w); h.z = cvtpk(b.x, b.y); h.w = cvtpk(b.z, b.w); ahi[e] = h;
                        v4u l; l.x = cvtpk(a.x - bflo(h.x), a.y - bfhi(h.x)); l.y = cvtpk(a.z - bflo(h.y), a.w - bfhi(h.y)); l.z = cvtpk(b.x - bflo(h.z), b.y - bfhi(h.z)); l.w = cvtpk(b.z - bflo(h.w), b.w - bfhi(h.w)); alo[e] = l; }
                    hp[sp * 4] = ahi[0]; hp[sp * 4 + 1] = ahi[1];
#pragma unroll
                    for (int e = 0; e < 2; ++e) { const int st = 2 * sp + e;
                        v4u bh = {0u, 0u, 0u, 0u}, bl = {0u, 0u, 0u, 0u};
                        if (r32 < 20) { bh = wl[(st * 4) * 20]; bl = wl[(st * 4 + 2) * 20]; }
                        acc = __builtin_amdgcn_mfma_f32_32x32x16_bf16(__builtin_bit_cast(bf16x8_t, ahi[e]), __builtin_bit_cast(bf16x8_t, bh), acc, 0, 0, 0);
                        acc = __builtin_amdgcn_mfma_f32_32x32x16_bf16(__builtin_bit_cast(bf16x8_t, alo[e]), __builtin_bit_cast(bf16x8_t, bh), acc, 0, 0, 0);
                        acc = __builtin_amdgcn_mfma_f32_32x32x16_bf16(__builtin_bit_cast(bf16x8_t, ahi[e]), __builtin_bit_cast(bf16x8_t, bl), acc, 0, 0, 0); } }
#pragma unroll
                for (int i = 0; i < 8; ++i) cur[i] = nxt[i];
#pragma unroll
                for (int i = 0; i < 4; ++i) curm[i] = nxtm[i];
            }
            ss += __shfl_xor(ss, 32);
            const float rinv = 1.f / sqrtf(ss * (1.f / D) + RMS_EPS);
#pragma unroll
            for (int r = 0; r < 16; ++r) SC[((r & 3) + 8 * (r >> 2) + 4 * hh) * 32 + r32] = acc[r];
            LDS_WAIT();
            if (lane < 32) {
                float lg[20];
#pragma unroll
                for (int q4 = 0; q4 < 5; ++q4) { const f32x4 t4 = *(const LAS f32x4*)(SC + lane * 32 + 4 * q4); lg[4 * q4] = t4.x * rinv; lg[4 * q4 + 1] = t4.y * rinv; lg[4 * q4 + 2] = t4.z * rinv; lg[4 * q4 + 3] = t4.w * rinv; }
                float gl[4];
#pragma unroll
                for (int i = 0; i < 4; ++i) gl[i] = lg[i] + bg[i];
                int gidx = 0; float gmax = gl[0];
#pragma unroll
                for (int i = 1; i < 4; ++i) if (gl[i] > gmax) { gmax = gl[i]; gidx = i; }
                float gsum = 0.f;
#pragma unroll
                for (int i = 0; i < 4; ++i) gsum += __expf(gl[i] - gmax);
                const float gp = 1.f / gsum;
                float el[4];
#pragma unroll
                for (int j = 0; j < 4; ++j) { const float l0 = lg[4 + j] + be[j], l1 = lg[8 + j] + be[4 + j], l2 = lg[12 + j] + be[8 + j], l3 = lg[16 + j] + be[12 + j];
                    el[j] = gidx == 0 ? l0 : gidx == 1 ? l1 : gidx == 2 ? l2 : l3; }
                int i0 = 0; float m0 = el[0];
#pragma unroll
                for (int j = 1; j < 4; ++j) if (el[j] > m0) { m0 = el[j]; i0 = j; }
                int i1 = -1; float m1 = -3.0e38f;
#pragma unroll
                for (int j = 0; j < 4; ++j) if (j != i0 && el[j] > m1) { m1 = el[j]; i1 = j; }
                if (i1 < 0) { i1 = (i0 + 1) & 3; m1 = m0; }
                const float p1 = __expf(m1 - m0);
                const float w0 = gp / (1.f + p1), w1 = gp * p1 / (1.f + p1);
                const unsigned e0 = (unsigned)(gidx * 4 + i0), e1 = (unsigned)(gidx * 4 + i1);
                const unsigned s0 = __hip_atomic_fetch_add(LCNT + e0, 1u, __ATOMIC_RELAXED, __HIP_MEMORY_SCOPE_WORKGROUP), s1 = __hip_atomic_fetch_add(LCNT + e1, 1u, __ATOMIC_RELAXED, __HIP_MEMORY_SCOPE_WORKGROUP);
                v4u rc; rc.x = (e0 << 20) | s0; rc.y = (e1 << 20) | s1; rc.z = __float_as_uint(w0); rc.w = __float_as_uint(w1); REC[li] = rc;
                RINV[row] = rinv; RIL[li] = rinv;
            }
            __syncthreads();
            if (tid < 16) LBASE[tid] = __hip_atomic_fetch_add(F.ctl + CW_CNT + tid, LCNT[tid], __ATOMIC_RELAXED, __HIP_MEMORY_SCOPE_AGENT);
            __syncthreads();
            if (tid < 256) { v4u rc = REC[tid]; rc.x += LBASE[rc.x >> 20]; rc.y += LBASE[rc.y >> 20]; *((GAS v4u*)ROUTE + rb0 + tid) = rc;
                const unsigned i0 = ((rc.x >> 20) << 16) + (rc.x & 0xFFFFFu), i1 = ((rc.y >> 20) << 16) + (rc.y & 0xFFFFFu); const float ri = RIL[tid];
                LIST[i0] = rb0 + tid; LIST[i1] = rb0 + tid; RWE[2 * i0] = ri; RWE[2 * i0 + 1] = __uint_as_float(rc.z); RWE[2 * i1] = ri; RWE[2 * i1 + 1] = __uint_as_float(rc.w); }
            __syncthreads();
        }
    }
    SEAM(6);

    if (IN(7)) {
        PHASE_IDS
        build_tile_tables(F, tid);
        const LAS int* TB = (const LAS int*)(F.lds + LDSX_OFF); const LAS unsigned char* t2e = (const LAS unsigned char*)(F.lds + LDSX_OFF + 128);
        LAS int* TOKL = (LAS int*)(F.lds + LDSX_OFF + 4096);
        const int nunits = TB[NEXP] * 4;
        for (int i = 0; i < 11; ++i) { const int L = i * F.G + F.vcu; if (L >= nunits) break;
            const int pm = L >> 2, e = t2e[pm], lt = pm - TB[e];
            if (tid < 256) { unsigned tok = (unsigned)LIST[(e << 16) + lt * 256 + tid]; tok = tok < (unsigned)T ? tok : (unsigned)(T - 1); TOKL[i * 256 + tid] = (int)tok; } }
        __syncthreads();
        pg8::Gemm g{H2, Wgu_t, T, NEXP * D, D};
        pg8::MoeOrder S{t2e, nunits, F.G, F.vcu};
        pg8::EpiGateUp E{HID, RWE, TB};
        pg8::gemm_phase<pg8::EpiGateUp, pg8::MoeOrder, true, true, pg8::NoMid, true>(wv, F.lds + RING_OFF, g, S, E, pg8::NoMid(), TOKL);
    }
    SEAM(7);

    if (IN(8)) {
        PHASE_IDS
        build_tile_tables(F, tid);
        const LAS int* TB = (const LAS int*)(F.lds + LDSX_OFF);
        pg8::Gemm g{HID, Wd_t, MAXROWS, NEXP * D, EH};
        pg8::MoeOrder S{(const LAS unsigned char*)(F.lds + LDSX_OFF + 128), TB[NEXP] * 4, F.G, F.vcu};
        pg8::EpiDown E{Y};
        pg8::gemm_phase<pg8::EpiDown, pg8::MoeOrder, true, true>(wv, F.lds + RING_OFF, g, S, E);
    }
    SEAM(8);

    if (IN(9)) {
        PHASE_IDS
        build_tile_tables(F, tid);
        const LAS int* TB = (const LAS int*)(F.lds + LDSX_OFF);
        f32x4 gg[4];
#pragma unroll
        for (int c = 0; c < 2; ++c) { gg[2 * c] = *((const GAS f32x4*)(final_g + 512 * c + 8 * lane)); gg[2 * c + 1] = *((const GAS f32x4*)(final_g + 512 * c + 8 * lane + 4)); }
        for (int t0 = gw * 2; t0 < T; t0 += NGW * 2) {
            v4u hx[2][2], ya[2][2], yb[2][2];
#pragma unroll
            for (int q = 0; q < 2; ++q) { const int t = t0 + q; const v4u rc = *((const GAS v4u*)ROUTE + t);
                const size_t r0 = (size_t)TB[rc.x >> 20] * 256 + (rc.x & 0xFFFFFu), r1 = (size_t)TB[rc.y >> 20] * 256 + (rc.y & 0xFFFFFu);
#pragma unroll
                for (int c = 0; c < 2; ++c) { hx[q][c] = *((const GAS v4u*)(H2 + (size_t)t * D + 512 * c) + lane); ya[q][c] = *((const GAS v4u*)(Y + r0 * D + 512 * c) + lane); yb[q][c] = *((const GAS v4u*)(Y + r1 * D + 512 * c) + lane); } }
#pragma unroll
            for (int q = 0; q < 2; ++q) { const int t = t0 + q; f32x4 v[4]; float s = 0.f;
#pragma unroll
                for (int c = 0; c < 2; ++c) { const v4u h = hx[q][c], a = ya[q][c], b = yb[q][c];
                    v[2 * c] = (f32x4){bflo(h.x) + bflo(a.x) + bflo(b.x), bfhi(h.x) + bfhi(a.x) + bfhi(b.x), bflo(h.y) + bflo(a.y) + bflo(b.y), bfhi(h.y) + bfhi(a.y) + bfhi(b.y)};
                    v[2 * c + 1] = (f32x4){bflo(h.z) + bflo(a.z) + bflo(b.z), bfhi(h.z) + bfhi(a.z) + bfhi(b.z), bflo(h.w) + bflo(a.w) + bflo(b.w), bfhi(h.w) + bfhi(a.w) + bfhi(b.w)}; }
#pragma unroll
                for (int k = 0; k < 4; ++k) s += (v[k].x * v[k].x + v[k].y * v[k].y) + (v[k].z * v[k].z + v[k].w * v[k].w);
                const float r = 1.f / sqrtf(wave_sum(s) * (1.f / D) + RMS_EPS);
#pragma unroll
                for (int k = 0; k < 4; ++k) { f32x4 o = v[k] * r * gg[k];
                    if (PROBE_B >= 0 && blockIdx.x == 0 && (t / (NGW * 2)) < 4) {
                        const unsigned long long* ts = (const unsigned long long*)(F.ctl + CW_TS); const float amp = sqrtf((float)((ts[PROBE_B2] - ts[PROBE_B]) / 100) * 1e-3f);
                        o.x += amp; o.y += amp; o.z += amp; o.w += amp; }
                    *((GAS f32x4*)(X1 + (size_t)t * D + 512 * (k >> 1) + 8 * lane + 4 * (k & 1))) = o; } }
        }
        STAMP(10);
        if (PROBE_A >= 0 && blockIdx.x == 0 && tid_of(wv) == 0) {
            const unsigned long long* ts = (const unsigned long long*)(F.ctl + CW_TS);
            X1[0] += 4.f + (float)((ts[PROBE_A2] - ts[PROBE_A]) / 100) * 0.01f; }
    }
#undef IN
#undef SEAM
#undef STAMP
#undef PHASE_IDS
#undef x_in
#undef mem_in
#undef norm_mix_g
#undef w_in
#undef pool_w
#undef pool_scale
#undef lam_q1
#undef lam_k1
#undef lam_q2
#undef lam_k2
#undef subln_g
#undef norm_mem_g
#undef w_mem_kv
#undef p_pool
#undef p_diff
#undef p_mem
#undef w_o
#undef norm_ffn_g
#undef w_rg
#undef b_rg
#undef w_re
#undef b_re
#undef w_eg
#undef w_eu
#undef w_ed
#undef final_g
#undef Win_t
#undef Pc_t
#undef Wo_t
#undef Wgu_t
#undef Wd_t
#undef KV
#undef XN
#undef BR
#undef H2
#undef PROJ
#undef MERGED
#undef MIX
#undef HID
#undef ATTO
#undef GATES
#undef Y
#undef ROUTE
#undef RWE
#undef LIST
#undef WRF
#undef RINV
#undef X1
}

extern "C" void kernel_launch(void* const* d_in, const int* in_sizes, int n_in, void* d_out, int out_size, void* d_ws, size_t ws_size, hipStream_t stream) {
    static int grid = 0;
    if (grid == 0) {
        if (n_in != 26 || in_sizes[0] != T * D || out_size != T * D || ws_size < WS_END) { fprintf(stderr, "kernel_launch: unexpected problem: n_in %d in0 %d out %d ws %zu (need %zu)\n", n_in, n_in > 0 ? in_sizes[0] : -1, out_size, ws_size, (size_t)WS_END); grid = -1; return; }
        int dev = 0, cus = 0, per_cu = 0;
        if (hipGetDevice(&dev) != hipSuccess || hipDeviceGetAttribute(&cus, hipDeviceAttributeMultiprocessorCount, dev) != hipSuccess) { fprintf(stderr, "kernel_launch: device query failed\n"); grid = -1; return; }
        if (hipFuncSetAttribute((const void*)hybrid_fwd, hipFuncAttributeMaxDynamicSharedMemorySize, LDS_BYTES) != hipSuccess) { fprintf(stderr, "kernel_launch: hipFuncSetAttribute failed\n"); grid = -1; return; }
        if (hipOccupancyMaxActiveBlocksPerMultiprocessor(&per_cu, (const void*)hybrid_fwd, NWAVES * 64, LDS_BYTES) != hipSuccess || per_cu < 1) { fprintf(stderr, "kernel_launch: occupancy query says %d blocks per CU\n", per_cu); grid = -1; return; }
        (void)hipGetLastError();
        grid = cus;
        if (grid > 256) grid = 256;
    }
    if (grid < 0) return;
    if (hipMemsetAsync((char*)d_ws + WS_CTL, 0, CTL_ZERO_BYTES, stream) != hipSuccess) { fprintf(stderr, "kernel_launch: memset failed\n"); return; }
    Args a{};
    for (int i = 0; i < 26; ++i) a.in[i] = (const float*)d_in[i];
    a.out = (float*)d_out; a.ws = (unsigned char*)d_ws;
#if MK_N_LAUNCHES == 1
    a.ph_lo = 0; a.ph_hi = NPH;
    void* kargs[] = {&a};
    hipError_t e = hipLaunchCooperativeKernel((const void*)hybrid_fwd, dim3(grid), dim3(NWAVES * 64), kargs, LDS_BYTES, stream);
    if (e != hipSuccess) fprintf(stderr, "kernel_launch: cooperative launch failed: %s (grid %d)\n", hipGetErrorString(e), grid);
#else
    for (int p = 0; p < NPH; ++p) { a.ph_lo = p; a.ph_hi = p + 1;
        hipLaunchKernelGGL(hybrid_fwd, dim3(grid), dim3(NWAVES * 64), LDS_BYTES, stream, a);
        const hipError_t le = hipPeekAtLastError(); if (le != hipSuccess) { fprintf(stderr, "kernel_launch: launch %d failed: %s\n", p, hipGetErrorName(le)); break; } }
#endif
}
```
